# Optimizing an MI355X kernel written in HIP

```python
import math
import jax, jax.numpy as jnp
from jax import lax
import numpy as np

D_MODEL = 1024
BATCH = 8
SEQ = 2048
DEPTH = 1
DEC_BATCH = 128
DEC_SEQ = 1
PAST_LEN = 16384
PAGE_SIZE = 128

D_INNER_M = 2 * D_MODEL
P_M = 64
H_M = D_INNER_M // P_M
G_M = 4
HG_M = H_M // G_M
N_M = 128
CONV_M = D_INNER_M + 2 * G_M * N_M
H_G = 8
DK = 128
DV = 128
CONV_G = 2 * H_G * DK + H_G * DV
CONV_K = 4
CHUNK = 64
D_FF = ((8 * D_MODEL // 3 + 255) // 256) * 256
PLE_DIM = 256
DT_MIN = 0.001
DT_MAX = 0.1
EPS = 1e-6
IN_SIZES = (D_INNER_M, CONV_M, H_M, CONV_G, H_G * DV, H_G, H_G, 2 * D_MODEL)
N_IN = sum(IN_SIZES)

kernel_name = "hybrid_ssd_gdn_gated_merge_step"


def _rms_norm(x, g):
    xf = x.astype(jnp.float32)
    y = xf * lax.rsqrt(jnp.mean(xf * xf, axis=-1, keepdims=True) + EPS)
    return (y * g.astype(jnp.float32)).astype(x.dtype)


def _l2norm(t):
    return t * lax.rsqrt(jnp.sum(t * t, axis=-1, keepdims=True) + EPS)


def _split(t, sizes):
    outs, start = [], 0
    for s in sizes:
        outs.append(t[..., start:start + s])
        start += s
    return outs


def _causal_conv(u, buf, w, b):
    seq = u.shape[1]
    full = jnp.concatenate([buf, u], axis=1)
    out = full[:, 0:seq] * w[0]
    for j in range(1, CONV_K):
        out = out + full[:, j:j + seq] * w[j]
    if b is not None:
        out = out + b
    return out, full[:, seq:]


def _chunking(seq):
    c = min(CHUNK, seq)
    n = -(-seq // c)
    return c, n, n * c - seq


def _pad_seq(t, pad):
    return jnp.pad(t, [(0, 0), (0, pad)] + [(0, 0)] * (t.ndim - 2))


def _ssd_chunked(x, dt, a, bm, cm, s0):
    bsz, seq = x.shape[:2]
    c, n, pad = _chunking(seq)
    x, dt, bm, cm = (_pad_seq(t, pad) for t in (x, dt, bm, cm))
    xdt = (x * dt[..., None]).reshape(bsz, n, c, G_M, HG_M, P_M)
    da = (dt * a).reshape(bsz, n, c, G_M, HG_M)
    bm = bm.reshape(bsz, n, c, G_M, N_M)
    cm = cm.reshape(bsz, n, c, G_M, N_M)
    acum = jnp.cumsum(da, axis=2)
    acum_t = jnp.moveaxis(acum, 2, -1)
    tril = jnp.tril(jnp.ones((c, c), bool))
    lmat = jnp.exp(jnp.where(tril, acum_t[..., :, None] - acum_t[..., None, :], -jnp.inf))
    cb = jnp.einsum('bnlgd,bnsgd->bngls', cm, bm)
    y_diag = jnp.einsum('bngls,bnghls,bnsghp->bnlghp', cb, lmat, xdt)
    decay_out = jnp.exp(acum[:, :, -1:] - acum)
    chunk_states = jnp.einsum('bnlgd,bnlgh,bnlghp->bnghpd', bm, decay_out, xdt)
    chunk_decay = jnp.exp(acum[:, :, -1])

    def step(s, inp):
        st, dec = inp
        return s * dec[..., None, None] + st, s

    s0 = s0.reshape(bsz, G_M, HG_M, P_M, N_M)
    s_final, prev = lax.scan(step, s0, (jnp.moveaxis(chunk_states, 1, 0), jnp.moveaxis(chunk_decay, 1, 0)))
    prev = jnp.moveaxis(prev, 0, 1)
    y_off = jnp.einsum('bnlgd,bnghpd,bnlgh->bnlghp', cm, prev, jnp.exp(acum))
    y = (y_diag + y_off).reshape(bsz, n * c, H_M, P_M)[:, :seq]
    return y, s_final.reshape(bsz, H_M, P_M, N_M)


def _gated_delta_chunked(q, k, v, g, beta, s0):
    bsz, seq = q.shape[:2]
    c, n, pad = _chunking(seq)
    q, k, v, g, beta = (_pad_seq(t, pad) for t in (q, k, v, g, beta))
    to_chunks = lambda t: jnp.moveaxis(t.reshape((bsz, n, c) + t.shape[2:]), 3, 1)
    q, k, v, g, beta = (to_chunks(t) for t in (q, k, v, g, beta))
    gcum = jnp.cumsum(g, axis=-1)
    tril = jnp.tril(jnp.ones((c, c), bool))
    strict = jnp.tril(jnp.ones((c, c), bool), -1)
    dmask = jnp.exp(jnp.where(tril, gcum[..., :, None] - gcum[..., None, :], -jnp.inf))
    kb = k * beta[..., None]
    a_mat = jnp.where(strict, jnp.einsum('bhnld,bhnsd->bhnls', kb, k) * dmask, 0.0)
    rhs = jnp.concatenate([v * beta[..., None], kb * jnp.exp(gcum)[..., None]], axis=-1)
    eye = jnp.eye(c, dtype=a_mat.dtype)
    sol = lax.linalg.triangular_solve(a_mat + eye, rhs, left_side=True, lower=True, unit_diagonal=True)
    u, w = sol[..., :DV], sol[..., DV:]
    qk = jnp.where(tril, jnp.einsum('bhnld,bhnsd->bhnls', q, k) * dmask, 0.0)
    qg = q * jnp.exp(gcum)[..., None]
    kg = k * jnp.exp(gcum[..., -1:] - gcum)[..., None]
    glast = jnp.exp(gcum[..., -1])

    def step(s, inp):
        u_c, w_c, qg_c, kg_c, qk_c, gl_c = inp
        v_new = u_c - jnp.einsum('bhld,bhde->bhle', w_c, s)
        o = jnp.einsum('bhld,bhde->bhle', qg_c, s) + jnp.einsum('bhls,bhse->bhle', qk_c, v_new)
        s = s * gl_c[..., None, None] + jnp.einsum('bhld,bhle->bhde', kg_c, v_new)
        return s, o

    xs = tuple(jnp.moveaxis(t, 2, 0) for t in (u, w, qg, kg, qk, glast))
    s_final, o = lax.scan(step, s0, xs)
    o = jnp.transpose(o, (1, 0, 3, 2, 4)).reshape(bsz, n * c, H_G, DV)[:, :seq]
    return o, s_final


def _layer(x, p, s_ssm, s_ssm_conv, s_gdn, s_gdn_conv,
           norm_mix, w_in, ssm_conv_w, ssm_conv_b, ssm_dt_bias, ssm_a_log, ssm_d, ssm_norm,
           gdn_conv_w, gdn_dt_bias, gdn_a_log, gdn_norm, w_branch_ssm, w_branch_gdn, w_out,
           norm_ffn, w_ffn_in, w_ffn_out, norm_pl, w_pl_gate, w_pl_proj):
    bsz, seq, _ = x.shape
    f32 = jnp.float32
    dtype = x.dtype
    h = _rms_norm(x, norm_mix)
    proj = jnp.einsum('bld,de->ble', h, w_in).astype(f32)
    z, xbc, dt_raw, qkv, gate, b_raw, a_raw, mgate = _split(proj, IN_SIZES)

    xbc, new_ssm_conv = _causal_conv(xbc, s_ssm_conv.astype(f32), ssm_conv_w.astype(f32), ssm_conv_b.astype(f32))
    xbc = jax.nn.silu(xbc)
    xs_m, bm, cm = _split(xbc, (D_INNER_M, G_M * N_M, G_M * N_M))
    xs_m = xs_m.reshape(bsz, seq, H_M, P_M)
    bm = bm.reshape(bsz, seq, G_M, N_M)
    cm = cm.reshape(bsz, seq, G_M, N_M)
    dt = jax.nn.softplus(dt_raw + ssm_dt_bias.astype(f32))
    a = -jnp.exp(ssm_a_log.astype(f32))
    y, new_ssm = _ssd_chunked(xs_m, dt, a, bm, cm, s_ssm.astype(f32))
    y = (y + xs_m * ssm_d.astype(f32)[:, None]).reshape(bsz, seq, D_INNER_M) * jax.nn.silu(z)
    y = _rms_norm(y.reshape(bsz, seq, G_M, D_INNER_M // G_M), ssm_norm.reshape(G_M, D_INNER_M // G_M))
    y = y.reshape(bsz, seq, D_INNER_M)

    qkv, new_gdn_conv = _causal_conv(qkv, s_gdn_conv.astype(f32), gdn_conv_w.astype(f32), None)
    qkv = jax.nn.silu(qkv)
    q, k, v = _split(qkv, (H_G * DK, H_G * DK, H_G * DV))
    q = _l2norm(q.reshape(bsz, seq, H_G, DK)) * (DK ** -0.5)
    k = _l2norm(k.reshape(bsz, seq, H_G, DK))
    v = v.reshape(bsz, seq, H_G, DV)
    beta = jax.nn.sigmoid(b_raw)
    g = -jnp.exp(gdn_a_log.astype(f32)) * jax.nn.softplus(a_raw + gdn_dt_bias.astype(f32))
    o, new_gdn = _gated_delta_chunked(q, k, v, g, beta, s_gdn.astype(f32))
    o = _rms_norm(o, gdn_norm) * jax.nn.silu(gate.reshape(bsz, seq, H_G, DV))
    o = o.reshape(bsz, seq, H_G * DV)

    g_ssm, g_gdn = jnp.split(jax.nn.sigmoid(mgate).astype(dtype), 2, axis=-1)
    mix = (g_ssm * jnp.einsum('ble,ed->bld', y.astype(dtype), w_branch_ssm)
           + g_gdn * jnp.einsum('ble,ed->bld', o.astype(dtype), w_branch_gdn))
    x = x + jnp.einsum('bld,de->ble', mix, w_out)

    gu = jnp.einsum('bld,df->blf', _rms_norm(x, norm_ffn), w_ffn_in)
    gt, up = jnp.split(gu, 2, axis=-1)
    x = x + jnp.einsum('blf,fd->bld', jax.nn.silu(gt) * up, w_ffn_out)

    pe = jnp.einsum('blp,pd->bld', p, w_pl_proj)
    x = x + pe * jax.nn.sigmoid(jnp.einsum('bld,de->ble', _rms_norm(x, norm_pl), w_pl_gate))
    return x, (new_ssm.astype(dtype), new_ssm_conv.astype(dtype), new_gdn.astype(dtype), new_gdn_conv.astype(dtype))


def setup_inputs(seed: int = 0) -> dict:
    key = jax.random.key(seed)
    ks = iter(jax.random.split(key, 48))
    f32 = jnp.float32

    def nrm(shape, scale):
        return jax.random.normal(next(ks), shape, f32) * scale

    def gain(shape):
        return 1.0 + nrm(shape, 0.02)

    def dt_bias(shape):
        u = jax.random.uniform(next(ks), shape, f32)
        dt = jnp.exp(u * (math.log(DT_MAX) - math.log(DT_MIN)) + math.log(DT_MIN))
        return dt + jnp.log(-jnp.expm1(-dt))

    def a_log(shape):
        return jnp.log(jax.random.uniform(next(ks), shape, f32, 1.0, 16.0))

    L = DEPTH
    return {
        "x_prompt": nrm((BATCH, SEQ, D_MODEL), 1.0),
        "x_sample": nrm((DEC_BATCH, DEC_SEQ, D_MODEL), 1.0),
        "p_prompt": nrm((DEPTH, BATCH, SEQ, PLE_DIM), 1.0),
        "p_sample": nrm((DEPTH, DEC_BATCH, DEC_SEQ, PLE_DIM), 1.0),
        "state_ssm": nrm((DEPTH, DEC_BATCH, H_M, P_M, N_M), 0.1),
        "state_ssm_conv": nrm((DEPTH, DEC_BATCH, CONV_K - 1, CONV_M), 1.0),
        "state_gdn": nrm((DEPTH, DEC_BATCH, H_G, DK, DV), 0.1),
        "state_gdn_conv": nrm((DEPTH, DEC_BATCH, CONV_K - 1, CONV_G), 1.0),
        "norm_mix": gain((L, D_MODEL)),
        "w_in": nrm((L, D_MODEL, N_IN), D_MODEL ** -0.5),
        "ssm_conv_w": nrm((L, CONV_K, CONV_M), CONV_K ** -0.5),
        "ssm_conv_b": nrm((L, CONV_M), 0.01),
        "ssm_dt_bias": dt_bias((L, H_M)),
        "ssm_a_log": a_log((L, H_M)),
        "ssm_d": 1.0 + nrm((L, H_M), 0.1),
        "ssm_norm": gain((L, D_INNER_M)),
        "gdn_conv_w": nrm((L, CONV_K, CONV_G), CONV_K ** -0.5),
        "gdn_dt_bias": dt_bias((L, H_G)),
        "gdn_a_log": a_log((L, H_G)),
        "gdn_norm": gain((L, DV)),
        "w_branch_ssm": nrm((L, D_INNER_M, D_MODEL), D_INNER_M ** -0.5),
        "w_branch_gdn": nrm((L, H_G * DV, D_MODEL), (H_G * DV) ** -0.5),
        "w_out": nrm((L, D_MODEL, D_MODEL), D_MODEL ** -0.5),
        "norm_ffn": gain((L, D_MODEL)),
        "w_ffn_in": nrm((L, D_MODEL, 2 * D_FF), D_MODEL ** -0.5),
        "w_ffn_out": nrm((L, D_FF, D_MODEL), D_FF ** -0.5),
        "norm_pl": gain((L, D_MODEL)),
        "w_pl_gate": nrm((L, D_MODEL, D_MODEL), D_MODEL ** -0.5),
        "w_pl_proj": nrm((L, PLE_DIM, D_MODEL), PLE_DIM ** -0.5),
        "norm_final": gain((D_MODEL,)),
    }


def reference(x_prompt, x_sample, p_prompt, p_sample, state_ssm, state_ssm_conv, state_gdn, state_gdn_conv,
              norm_mix, w_in, ssm_conv_w, ssm_conv_b, ssm_dt_bias, ssm_a_log, ssm_d, ssm_norm,
              gdn_conv_w, gdn_dt_bias, gdn_a_log, gdn_norm, w_branch_ssm, w_branch_gdn, w_out,
              norm_ffn, w_ffn_in, w_ffn_out, norm_pl, w_pl_gate, w_pl_proj, norm_final):
    def run(x, p, st_ssm, st_ssm_conv, st_gdn, st_gdn_conv):
        new = ([], [], [], [])
        for i in range(DEPTH):
            x, states = _layer(x, p[i], st_ssm[i], st_ssm_conv[i], st_gdn[i], st_gdn_conv[i],
                               norm_mix[i], w_in[i], ssm_conv_w[i], ssm_conv_b[i], ssm_dt_bias[i],
                               ssm_a_log[i], ssm_d[i], ssm_norm[i], gdn_conv_w[i], gdn_dt_bias[i],
                               gdn_a_log[i], gdn_norm[i], w_branch_ssm[i], w_branch_gdn[i], w_out[i],
                               norm_ffn[i], w_ffn_in[i], w_ffn_out[i], norm_pl[i], w_pl_gate[i], w_pl_proj[i])
            for lst, s in zip(new, states):
                lst.append(s)
        return _rms_norm(x, norm_final), [jnp.stack(lst) for lst in new]

    bp = x_prompt.shape[0]
    dt = x_prompt.dtype
    z_ssm = jnp.zeros((DEPTH, bp, H_M, P_M, N_M), dt)
    z_ssm_conv = jnp.zeros((DEPTH, bp, CONV_K - 1, CONV_M), dt)
    z_gdn = jnp.zeros((DEPTH, bp, H_G, DK, DV), dt)
    z_gdn_conv = jnp.zeros((DEPTH, bp, CONV_K - 1, CONV_G), dt)
    y_prompt, ps = run(x_prompt, p_prompt, z_ssm, z_ssm_conv, z_gdn, z_gdn_conv)
    y_sample, ss = run(x_sample, p_sample, state_ssm, state_ssm_conv, state_gdn, state_gdn_conv)
    return (y_prompt, y_sample, ps[0], ps[1], ps[2], ps[3], ss[0], ss[1], ss[2], ss[3])
```

```cpp
#include <hip/hip_runtime.h>
#include <hip/hip_cooperative_groups.h>
#include <cstdio>
#include <cstdint>
namespace cg = cooperative_groups;

#ifndef MK_ONE_LAUNCH
#define MK_ONE_LAUNCH 1
#endif

#define LAS __attribute__((address_space(3)))
typedef unsigned short bf16_t;
typedef short bf16x8 __attribute__((ext_vector_type(8)));
typedef float f32x4 __attribute__((ext_vector_type(4)));
typedef float f32x2 __attribute__((ext_vector_type(2)));
typedef unsigned u32x4 __attribute__((ext_vector_type(4)));
typedef unsigned u32x2 __attribute__((ext_vector_type(2)));

constexpr int D = 1024, SEQ = 2048, NBATCH = 8, MPR = NBATCH * SEQ, NSMP = 128, MTOT = MPR + NSMP, MP = 16640;
constexpr int LDP = 11264, LDF = LDP / 2;
constexpr int C_Z = 0, C_XS = 2048, C_B = 4096, C_C = 4608, C_Q = 5120, C_K = 6144, C_V = 7168, C_GATE = 8192, C_MG = 9216;
constexpr int NIN = 11312;
constexpr int NPROJ = 11520;
constexpr int DFF = 2816;
constexpr float EPS = 1e-6f;
constexpr int NCH = 6144;

constexpr size_t O_Y = 0, O_YS = 16777216, O_SSMP = 16908288, O_SCONVP = 19005440, O_GDNP = 19079168, O_GCONVP = 20127744,
                 O_SSMS = 20201472, O_SCONVS = 53755904, O_GDNS = 54935552, O_GCONVS = 71712768;

constexpr size_t MiB = 1u << 20;
constexpr size_t WS_CTL = 0, CTL_BYTES = 1 * MiB;
constexpr size_t WS_SS1 = 65536, WS_SS2 = WS_SS1 + 69632, WS_SS3 = WS_SS2 + 69632;
constexpr size_t WS_WIN = 1 * MiB, WS_WBS = 25 * MiB, WS_WBG = 29 * MiB, WS_WOUT = 31 * MiB, WS_WFI = 33 * MiB, WS_WFO = 44 * MiB, WS_WPG = 50 * MiB, WS_WPP = 52 * MiB;
constexpr size_t WS_XN = 53 * MiB, WS_PB = 86 * MiB, WS_SMALL = 95 * MiB, WS_HALO = 100 * MiB, WS_PROJ = 110 * MiB;
constexpr size_t WS_END = WS_PROJ + (size_t)MP * LDP * 2;
static_assert(WS_END <= 512 * MiB, "ws map");
static_assert(WS_SS3 + 69632 <= CTL_BYTES, "ctl");

__device__ __forceinline__ unsigned cvt_pk_bf16(float lo, float hi) { unsigned r; asm volatile("v_cvt_pk_bf16_f32 %0, %1, %2" : "=v"(r) : "v"(lo), "v"(hi)); return r; }
__device__ __forceinline__ float bflo(unsigned w) { return __uint_as_float(w << 16); }
__device__ __forceinline__ float bfhi(unsigned w) { return __uint_as_float(w & 0xffff0000u); }
__device__ __forceinline__ float bf2f(bf16_t b) { return __uint_as_float((unsigned)b << 16); }
__device__ __forceinline__ void unpack8(const u32x4 w, float (&f)[8]) { f[0] = bflo(w.x); f[1] = bfhi(w.x); f[2] = bflo(w.y); f[3] = bfhi(w.y); f[4] = bflo(w.z); f[5] = bfhi(w.z); f[6] = bflo(w.w); f[7] = bfhi(w.w); }
__device__ __forceinline__ u32x4 pack8(const float (&f)[8]) { u32x4 w; w.x = cvt_pk_bf16(f[0], f[1]); w.y = cvt_pk_bf16(f[2], f[3]); w.z = cvt_pk_bf16(f[4], f[5]); w.w = cvt_pk_bf16(f[6], f[7]); return w; }
__device__ __forceinline__ float sigmoidf_(float x) { return __builtin_amdgcn_rcpf(1.0f + __builtin_amdgcn_exp2f(-1.4426950408889634f * x)); }
__device__ __forceinline__ float siluf_(float x) { return x * sigmoidf_(x); }
__device__ __forceinline__ float softplusf_(float x) { return x > 20.f ? x : log1pf(__expf(x)); }
__device__ __forceinline__ float wave_sum(float v) {
#pragma unroll
    for (int o = 1; o < 64; o <<= 1) v += __shfl_xor(v, o);
    return v;
}

namespace pg8 {
constexpr int BM = 256, BK = 64, HALF = 128, HTB = HALF * BK * 2, STAGE_BYTES = 8 * HTB, NXCD = 8, WGM = 8;
__host__ __device__ __forceinline__ int lds_byte(int r, int c) { const int st = (r >> 4) * 2 + (c >> 5), rr = r & 15, cc = c & 31, ob = rr * 64 + cc * 2; return st * 1024 + (ob ^ (((ob >> 9) & 1) << 5)); }
__host__ __device__ __forceinline__ void stage_rc(int b, int& R, int& C) { const int st = b / 1024, sb = b % 1024, swz = sb ^ (((sb >> 9) & 1) << 5); R = (st >> 1) * 16 + swz / 64; C = (st & 1) * 32 + (swz % 64) / 2; }
__host__ __device__ __forceinline__ int perm32(int rho) { const int n = rho >> 4, i = rho & 15; return 8 * (i >> 2) + 4 * n + (i & 3); }

struct Unit { int pm, pn; };
struct Gemm { const bf16_t* A; const bf16_t* Bt; int M, N, K, lda, ldb; };

struct StaticOrder {
    int nM, nN, nwg, G, c;
    __host__ __device__ void init(int M, int N, int G_, int c_) { nM = M / BM; nN = N / BM; nwg = nM * nN; G = G_; c = c_; }
    __host__ __device__ bool next(int i, Unit& u) const {
        const long L = (long)i * G + c; if (L >= nwg) return false;
        int wgid = (int)L; { const int q = nwg / NXCD, r = nwg % NXCD, xcd = wgid % NXCD, off = wgid / NXCD; wgid = (xcd < r ? xcd * (q + 1) : r * (q + 1) + (xcd - r) * q) + off; }
        const int nig = WGM * nN, gid = wgid / nig, fm = gid * WGM, gsz = (nM - fm) < WGM ? (nM - fm) : WGM;
        u.pm = fm + ((wgid % nig) % gsz); u.pn = (wgid % nig) / gsz; return true;
    }
    __device__ __forceinline__ void a_ready(const Unit&) const {}
    __device__ __forceinline__ void done(const Unit&) const {}
};

template <class Epi, class Sched, bool ALIGN_EPI = true, bool SP2 = true>
__device__ __forceinline__ void gemm_phase(LAS unsigned char* lds, const Gemm g, const Sched& S, const Epi& E) {
    const int tid = threadIdx.x, wid = __builtin_amdgcn_readfirstlane(tid >> 6), lane = tid & 63, wr = wid >> 2, wc = wid & 3, fr = lane & 15, fq = lane >> 4;
    int nt = g.K / BK; asm volatile("" : "+s"(nt));
    unsigned voffA[2], voffB[2];
#pragma unroll
    for (int i = 0; i < 2; ++i) { int R, C; stage_rc(tid * 16 + i * 8192, R, C); const int Rb = Epi::PERM ? ((R & ~31) + perm32(R & 31)) : R;
        voffA[i] = (unsigned)(R * g.lda + C) * 2u; voffB[i] = (unsigned)(Rb * g.ldb + C) * 2u; }
    const size_t kstep = (size_t)(BK * 2);
    const size_t hstepA = (size_t)HALF * g.lda * 2, hstepB = (size_t)HALF * g.ldb * 2;
    const size_t tstepA = 2 * hstepA, tstepB = 2 * hstepB;
    const unsigned ldsw = (unsigned)wid * 1024u;
    const int aoff = lds_byte(wr * 64 + fr, fq * 8), boff = lds_byte(wc * 32 + fr, fq * 8);
#define PG8_SA(b, h) (((b) * 2 + (h)) * HTB)
#define PG8_SB(b, h) ((4 + (b) * 2 + (h)) * HTB)
#define PG8_STAGE(bufoff, gbase, voff) do { _Pragma("unroll") for (int _i = 0; _i < 2; ++_i) \
        __builtin_amdgcn_global_load_lds((const unsigned*)((const char*)(gbase) + (voff)[_i]), (LAS unsigned*)(lds + (bufoff) + ldsw + _i * 8192), 16, 0, 0); } while (0)
#define PG8_LDA(dst, b, h) do { _Pragma("unroll") for (int m = 0; m < 4; ++m) _Pragma("unroll") for (int k = 0; k < 2; ++k) dst[m][k] = *(const LAS bf16x8*)(lds + PG8_SA(b, h) + aoff + m * 2048 + k * 1024); } while (0)
#define PG8_LDB(dst, b, h) do { _Pragma("unroll") for (int n = 0; n < 2; ++n) _Pragma("unroll") for (int k = 0; k < 2; ++k) dst[n][k] = *(const LAS bf16x8*)(lds + PG8_SB(b, h) + boff + n * 2048 + k * 1024); } while (0)
#define PG8_MMA(ai, bj, At, Bt) do { __builtin_amdgcn_s_setprio(1); _Pragma("unroll") for (int m = 0; m < 4; ++m) _Pragma("unroll") for (int n = 0; n < 2; ++n) _Pragma("unroll") for (int k = 0; k < 2; ++k) \
        acc[ai][bj][m][n] = __builtin_amdgcn_mfma_f32_16x16x32_bf16(Bt[n][k], At[m][k], acc[ai][bj][m][n], 0, 0, 0); __builtin_amdgcn_s_setprio(0); } while (0)
#define PG8_WAIT_V(n) asm volatile("s_waitcnt vmcnt(" #n ")" ::: "memory")
#define PG8_WAIT_L(n) asm volatile("s_waitcnt lgkmcnt(" #n ")" ::: "memory")
#define PG8_BAR __builtin_amdgcn_s_barrier()
#define PG8_SCHED __builtin_amdgcn_sched_barrier(0)
    Unit cur, nxt; int ui = 0;
    if (!S.next(0, cur)) return;
    f32x4 acc[2][2][4][2];
#pragma unroll
    for (int a = 0; a < 2; ++a)
#pragma unroll
        for (int b = 0; b < 2; ++b)
#pragma unroll
            for (int m = 0; m < 4; ++m)
#pragma unroll
                for (int n = 0; n < 2; ++n) acc[a][b][m][n] = (f32x4){0.f, 0.f, 0.f, 0.f};
    bf16x8 At[4][2], B0[2][2], B1[2][2];
    const char* cA = (const char*)g.A + (size_t)cur.pm * tstepA; const char* cB = (const char*)g.Bt + (size_t)cur.pn * tstepB;
    S.a_ready(cur);
    if constexpr (SP2) {
        PG8_STAGE(PG8_SB(0, 0), cB, voffB); PG8_STAGE(PG8_SB(0, 1), cB + hstepB, voffB); PG8_STAGE(PG8_SA(0, 0), cA, voffA); PG8_STAGE(PG8_SA(0, 1), cA + hstepA, voffA);
        if (wr == 1) PG8_BAR;
        PG8_WAIT_V(2); PG8_BAR;
        PG8_STAGE(PG8_SB(1, 0), cB + kstep, voffB); PG8_STAGE(PG8_SA(1, 0), cA + kstep, voffA); PG8_STAGE(PG8_SB(1, 1), cB + hstepB + kstep, voffB);
        PG8_WAIT_V(6); PG8_BAR;
    } else {
        PG8_STAGE(PG8_SB(0, 0), cB, voffB); PG8_STAGE(PG8_SA(0, 0), cA, voffA); PG8_STAGE(PG8_SB(0, 1), cB + hstepB, voffB); PG8_STAGE(PG8_SA(0, 1), cA + hstepA, voffA);
        if (wr == 1) PG8_BAR;
        PG8_WAIT_V(4); PG8_BAR;
        PG8_STAGE(PG8_SB(1, 0), cB + kstep, voffB); PG8_STAGE(PG8_SA(1, 0), cA + kstep, voffA); PG8_STAGE(PG8_SB(1, 1), cB + hstepB + kstep, voffB);
        PG8_WAIT_V(6); PG8_BAR;
    }
    for (;;) {
        const bool has_next = S.next(ui + 1, nxt);
        const char* nA = has_next ? (const char*)g.A + (size_t)nxt.pm * tstepA : cA; const char* nB = has_next ? (const char*)g.Bt + (size_t)nxt.pn * tstepB : cB;
        for (int t = 0; t < nt; t += 2) {
            const bool last = (t == nt - 2);
            const char* a1 = cA + (size_t)(t + 1) * kstep;
            const char* a2 = last ? nA : cA + (size_t)(t + 2) * kstep; const char* b2 = last ? nB : cB + (size_t)(t + 2) * kstep;
            const char* a3 = a2 + kstep; const char* b3 = b2 + kstep;
            if (last && has_next) S.a_ready(nxt);
            if constexpr (SP2) {
            PG8_LDB(B0, 0, 0); PG8_LDB(B1, 0, 1); PG8_SCHED; PG8_LDA(At, 0, 0); PG8_STAGE(PG8_SA(1, 1), a1 + hstepA, voffA);
            PG8_WAIT_V(8); PG8_WAIT_L(0); PG8_BAR; PG8_MMA(0, 0, At, B0); PG8_MMA(0, 1, At, B1); PG8_BAR; PG8_SCHED;
            PG8_LDA(At, 0, 1); PG8_STAGE(PG8_SB(0, 0), b2, voffB); PG8_STAGE(PG8_SB(0, 1), b2 + hstepB, voffB); PG8_STAGE(PG8_SA(0, 0), a2, voffA);
            PG8_WAIT_V(8); PG8_WAIT_L(0); PG8_BAR; PG8_MMA(1, 0, At, B0); PG8_MMA(1, 1, At, B1); PG8_BAR; PG8_SCHED;
            PG8_LDB(B0, 1, 0); PG8_LDB(B1, 1, 1); PG8_SCHED; PG8_LDA(At, 1, 0); PG8_STAGE(PG8_SA(0, 1), a2 + hstepA, voffA);
            PG8_WAIT_V(8); PG8_WAIT_L(0); PG8_BAR; PG8_MMA(0, 0, At, B0); PG8_MMA(0, 1, At, B1); PG8_BAR; PG8_SCHED;
            PG8_LDA(At, 1, 1); PG8_STAGE(PG8_SB(1, 0), b3, voffB); PG8_STAGE(PG8_SB(1, 1), b3 + hstepB, voffB); PG8_STAGE(PG8_SA(1, 0), a3, voffA);
            PG8_WAIT_V(8); PG8_WAIT_L(0); PG8_BAR; PG8_MMA(1, 0, At, B0); PG8_MMA(1, 1, At, B1); PG8_BAR; PG8_SCHED;
            } else {
            PG8_LDB(B0, 0, 0); PG8_SCHED; PG8_LDA(At, 0, 0); PG8_STAGE(PG8_SA(1, 1), a1 + hstepA, voffA);
            PG8_WAIT_L(8); PG8_BAR; PG8_WAIT_L(0); PG8_MMA(0, 0, At, B0); PG8_BAR; PG8_SCHED;
            PG8_LDB(B1, 0, 1); PG8_STAGE(PG8_SB(0, 0), b2, voffB);
            PG8_BAR; PG8_WAIT_L(0); PG8_MMA(0, 1, At, B1); PG8_BAR;
            PG8_LDA(At, 0, 1); PG8_STAGE(PG8_SA(0, 0), a2, voffA);
            PG8_BAR; PG8_WAIT_L(0); PG8_MMA(1, 0, At, B0); PG8_BAR; PG8_SCHED;
            PG8_STAGE(PG8_SB(0, 1), b2 + hstepB, voffB);
            PG8_WAIT_V(6); PG8_BAR; PG8_MMA(1, 1, At, B1); PG8_BAR;
            PG8_LDB(B0, 1, 0); PG8_SCHED; PG8_LDA(At, 1, 0); PG8_STAGE(PG8_SA(0, 1), a2 + hstepA, voffA);
            PG8_WAIT_L(8); PG8_BAR; PG8_WAIT_L(0); PG8_MMA(0, 0, At, B0); PG8_BAR; PG8_SCHED;
            PG8_LDB(B1, 1, 1); PG8_STAGE(PG8_SB(1, 0), b3, voffB);
            PG8_BAR; PG8_WAIT_L(0); PG8_MMA(0, 1, At, B1); PG8_BAR;
            PG8_LDA(At, 1, 1); PG8_STAGE(PG8_SA(1, 0), a3, voffA);
            PG8_BAR; PG8_WAIT_L(0); PG8_MMA(1, 0, At, B0); PG8_BAR; PG8_SCHED;
            PG8_STAGE(PG8_SB(1, 1), b3 + hstepB, voffB);
            PG8_WAIT_V(6); PG8_BAR; PG8_MMA(1, 1, At, B1); PG8_BAR;
            }
        }
        if constexpr (ALIGN_EPI) { if (wr == 0) PG8_BAR; }
        E(acc, cur, wr, wc, fr, fq); S.done(cur);
        if (!has_next) break;
#pragma unroll
        for (int a = 0; a < 2; ++a)
#pragma unroll
            for (int b = 0; b < 2; ++b)
#pragma unroll
                for (int m = 0; m < 4; ++m)
#pragma unroll
                    for (int n = 0; n < 2; ++n) acc[a][b][m][n] = (f32x4){0.f, 0.f, 0.f, 0.f};
        cur = nxt; cA = nA; cB = nB; ++ui;
        if constexpr (ALIGN_EPI) { if (wr == 1) PG8_BAR; }
    }
    PG8_WAIT_V(0);
    if constexpr (!ALIGN_EPI) { if (wr == 0) PG8_BAR; }
    PG8_BAR;
#undef PG8_SA
#undef PG8_SB
#undef PG8_STAGE
#undef PG8_LDA
#undef PG8_LDB
#undef PG8_MMA
#undef PG8_WAIT_V
#undef PG8_WAIT_L
#undef PG8_BAR
#undef PG8_SCHED
}
}
using pg8::Unit;

struct Args {
    const float* in[30];
    float* out;
    unsigned char* ws;
    int ph_lo, ph_hi;
};

struct Frame {
    LAS unsigned char* lds;
    int tid, lane, wave, G;
    const float* const* in;
    float* out;
    unsigned char* ws;
    bf16_t* PROJ; bf16_t* HALO; float* SMALL; bf16_t* XN; bf16_t* PB;
    float *SS1, *SS2, *SS3;
};

constexpr int NWAVES = 8;
constexpr int RING_BYTES = 131072, LDS_BYTES = 147456;

struct EpiInProj {
    static constexpr bool PERM = true;
    bf16_t* PROJ; bf16_t* HALO; float* SMALL;
    __device__ __forceinline__ void operator()(const f32x4 (&acc)[2][2][4][2], const Unit& u, int wr, int wc, int fr, int fq) const {
        const int row0 = u.pm * 256 + wr * 64 + fr;
        if (u.pn < 44) {
            const int col0 = u.pn * 256 + wc * 32 + 8 * fq;
            const bool conv_tile = (u.pn >= 8 && u.pn < 32);
#pragma unroll
            for (int ai = 0; ai < 2; ++ai)
#pragma unroll
                for (int m = 0; m < 4; ++m) {
                    const int row = row0 + ai * 128 + m * 16;
                    bf16_t* rowp = PROJ + (size_t)row * LDP + col0;
#pragma unroll
                    for (int bj = 0; bj < 2; ++bj) {
                        const f32x4 v0 = acc[ai][bj][m][0], v1 = acc[ai][bj][m][1];
                        u32x4 w; w.x = cvt_pk_bf16(v0[0], v0[1]); w.y = cvt_pk_bf16(v0[2], v0[3]); w.z = cvt_pk_bf16(v1[0], v1[1]); w.w = cvt_pk_bf16(v1[2], v1[3]);
                        *(u32x4*)(rowp + bj * 128) = w;
                        if (m == 3 && conv_tile && fr >= 13) {
                            bf16_t* hp = HALO + ((size_t)(row >> 6) * 3 + (fr - 13)) * NCH + (col0 - C_XS) + bj * 128;
                            *(u32x4*)hp = w;
                        }
                    }
                }
        } else {
            if (wc < 2) {
                const int col0 = wc * 32 + 8 * fq;
#pragma unroll
                for (int ai = 0; ai < 2; ++ai)
#pragma unroll
                    for (int m = 0; m < 4; ++m) {
                        const int row = row0 + ai * 128 + m * 16;
                        float* sp = SMALL + (size_t)row * 64 + col0;
                        *(f32x4*)sp = acc[ai][0][m][0]; *(f32x4*)(sp + 4) = acc[ai][0][m][1];
                    }
            }
        }
    }
};

struct EpiT1 {
    static constexpr bool PERM = true;
    bf16_t* PROJ;
    __device__ __forceinline__ void operator()(const f32x4 (&acc)[2][2][4][2], const Unit& u, int wr, int wc, int fr, int fq) const {
        const int row0 = u.pm * 256 + wr * 64 + fr, col0 = u.pn * 256 + wc * 32 + 8 * fq;
#pragma unroll
        for (int ai = 0; ai < 2; ++ai)
#pragma unroll
            for (int m = 0; m < 4; ++m) {
                const int row = row0 + ai * 128 + m * 16;
#pragma unroll
                for (int bj = 0; bj < 2; ++bj) {
                    const int col = col0 + bj * 128;
                    const u32x4 mgw = *(const u32x4*)(PROJ + (size_t)row * LDP + C_MG + col);
                    float mg[8]; unpack8(mgw, mg);
                    const f32x4 v0 = acc[ai][bj][m][0], v1 = acc[ai][bj][m][1];
                    f32x4 o0, o1;
#pragma unroll
                    for (int i = 0; i < 4; ++i) { o0[i] = v0[i] * sigmoidf_(mg[i]); o1[i] = v1[i] * sigmoidf_(mg[4 + i]); }
                    float* tp = (float*)PROJ + (size_t)row * LDF + col;
                    *(f32x4*)tp = o0; *(f32x4*)(tp + 4) = o1;
                }
            }
    }
};

struct EpiMix {
    static constexpr bool PERM = true;
    bf16_t* PROJ;
    __device__ __forceinline__ void operator()(const f32x4 (&acc)[2][2][4][2], const Unit& u, int wr, int wc, int fr, int fq) const {
        const int row0 = u.pm * 256 + wr * 64 + fr, col0 = u.pn * 256 + wc * 32 + 8 * fq;
#pragma unroll
        for (int ai = 0; ai < 2; ++ai)
#pragma unroll
            for (int m = 0; m < 4; ++m) {
                const int row = row0 + ai * 128 + m * 16;
#pragma unroll
                for (int bj = 0; bj < 2; ++bj) {
                    const int col = col0 + bj * 128;
                    const u32x4 mgw = *(const u32x4*)(PROJ + (size_t)row * LDP + C_MG + 1024 + col);
                    float mg[8]; unpack8(mgw, mg);
                    const float* tp = (const float*)PROJ + (size_t)row * LDF + col;
                    const f32x4 t0 = *(const f32x4*)tp, t1 = *(const f32x4*)(tp + 4);
                    const f32x4 v0 = acc[ai][bj][m][0], v1 = acc[ai][bj][m][1];
                    float o[8];
#pragma unroll
                    for (int i = 0; i < 4; ++i) { o[i] = t0[i] + v0[i] * sigmoidf_(mg[i]); o[4 + i] = t1[i] + v1[i] * sigmoidf_(mg[4 + i]); }
                    *(u32x4*)(PROJ + (size_t)row * LDP + C_Q + col) = pack8(o);
                }
            }
    }
};

template <int MODE> struct EpiResid {
    static constexpr bool PERM = true;
    bf16_t* PROJ; const float* xp; const float* xs; int res_col  , dst_col  , dstb_col; float* SS;
    __device__ __forceinline__ void operator()(const f32x4 (&acc)[2][2][4][2], const Unit& u, int wr, int wc, int fr, int fq) const {
        const int row0 = u.pm * 256 + wr * 64 + fr, col0 = u.pn * 256 + wc * 32 + 8 * fq;
#pragma unroll
        for (int ai = 0; ai < 2; ++ai)
#pragma unroll
            for (int m = 0; m < 4; ++m) {
                const int row = row0 + ai * 128 + m * 16;
                float ss = 0.f;
#pragma unroll
                for (int bj = 0; bj < 2; ++bj) {
                    const int col = col0 + bj * 128;
                    f32x4 r0 = (f32x4){0.f, 0.f, 0.f, 0.f}, r1 = r0;
                    if (MODE == 0) {
                        if (row < MTOT) { const float* rp = (row < MPR ? xp + (size_t)row * D : xs + (size_t)(row - MPR) * D) + col; r0 = *(const f32x4*)rp; r1 = *(const f32x4*)(rp + 4); }
                    } else {
                        const float* rp = (const float*)(PROJ + res_col) + (size_t)row * LDF + col; r0 = *(const f32x4*)rp; r1 = *(const f32x4*)(rp + 4);
                    }
                    const f32x4 x0 = r0 + acc[ai][bj][m][0], x1 = r1 + acc[ai][bj][m][1];
                    float* dp = (float*)(PROJ + dst_col) + (size_t)row * LDF + col;
                    *(f32x4*)dp = x0; *(f32x4*)(dp + 4) = x1;
                    u32x4 w; w.x = cvt_pk_bf16(x0[0], x0[1]); w.y = cvt_pk_bf16(x0[2], x0[3]); w.z = cvt_pk_bf16(x1[0], x1[1]); w.w = cvt_pk_bf16(x1[2], x1[3]);
                    *(u32x4*)(PROJ + (size_t)row * LDP + dstb_col + col) = w;
                    ss += (x0[0] * x0[0] + x0[1] * x0[1]) + (x0[2] * x0[2] + x0[3] * x0[3]) + (x1[0] * x1[0] + x1[1] * x1[1]) + (x1[2] * x1[2] + x1[3] * x1[3]);
                }
                ss += __shfl_xor(ss, 16); ss += __shfl_xor(ss, 32);
                if (fq == 0) atomicAdd(SS + row, ss);
            }
    }
};

struct EpiSwiGLU {
    static constexpr bool PERM = true;
    bf16_t* PROJ; const float* SS;
    __device__ __forceinline__ void operator()(const f32x4 (&acc)[2][2][4][2], const Unit& u, int wr, int wc, int fr, int fq) const {
        const int row0 = u.pm * 256 + wr * 64 + fr, col0 = u.pn * 128 + wc * 32 + 8 * fq;
#pragma unroll
        for (int ai = 0; ai < 2; ++ai)
#pragma unroll
            for (int m = 0; m < 4; ++m) {
                const int row = row0 + ai * 128 + m * 16;
                const float r = rsqrtf(SS[row] * (1.0f / D) + EPS);
                const f32x4 g0 = acc[ai][0][m][0], g1 = acc[ai][0][m][1], u0 = acc[ai][1][m][0], u1 = acc[ai][1][m][1];
                float o[8];
#pragma unroll
                for (int i = 0; i < 4; ++i) { o[i] = siluf_(r * g0[i]) * (r * u0[i]); o[4 + i] = siluf_(r * g1[i]) * (r * u1[i]); }
                *(u32x4*)(PROJ + (size_t)row * LDP + C_XS + col0) = pack8(o);
            }
    }
};

struct EpiPE {
    static constexpr bool PERM = true;
    bf16_t* PROJ;
    __device__ __forceinline__ void operator()(const f32x4 (&acc)[2][2][4][2], const Unit& u, int wr, int wc, int fr, int fq) const {
        const int row0 = u.pm * 256 + wr * 64 + fr, col0 = u.pn * 256 + wc * 32 + 8 * fq;
#pragma unroll
        for (int ai = 0; ai < 2; ++ai)
#pragma unroll
            for (int m = 0; m < 4; ++m) {
                const int row = row0 + ai * 128 + m * 16;
#pragma unroll
                for (int bj = 0; bj < 2; ++bj) {
                    float* tp = (float*)PROJ + (size_t)row * LDF + col0 + bj * 128;
                    *(f32x4*)tp = acc[ai][bj][m][0]; *(f32x4*)(tp + 4) = acc[ai][bj][m][1];
                }
            }
    }
};

struct EpiX3 {
    static constexpr bool PERM = true;
    bf16_t* PROJ; const float* SS2; float* SS3; float* out;
    __device__ __forceinline__ void operator()(const f32x4 (&acc)[2][2][4][2], const Unit& u, int wr, int wc, int fr, int fq) const {
        const int row0 = u.pm * 256 + wr * 64 + fr, col0 = u.pn * 256 + wc * 32 + 8 * fq;
#pragma unroll
        for (int ai = 0; ai < 2; ++ai)
#pragma unroll
            for (int m = 0; m < 4; ++m) {
                const int row = row0 + ai * 128 + m * 16;
                const float r = rsqrtf(SS2[row] * (1.0f / D) + EPS);
                float ss = 0.f;
#pragma unroll
                for (int bj = 0; bj < 2; ++bj) {
                    const int col = col0 + bj * 128;
                    const float* x2p = (const float*)(PROJ + C_MG) + (size_t)row * LDF + col;
                    const float* pep = (const float*)PROJ + (size_t)row * LDF + col;
                    const f32x4 a0 = *(const f32x4*)x2p, a1 = *(const f32x4*)(x2p + 4), p0 = *(const f32x4*)pep, p1 = *(const f32x4*)(pep + 4);
                    const f32x4 v0 = acc[ai][bj][m][0], v1 = acc[ai][bj][m][1];
                    f32x4 x0, x1;
#pragma unroll
                    for (int i = 0; i < 4; ++i) { x0[i] = a0[i] + p0[i] * sigmoidf_(r * v0[i]); x1[i] = a1[i] + p1[i] * sigmoidf_(r * v1[i]); }
                    if (row < MTOT) { float* op = out + (row < MPR ? O_Y + (size_t)row * D : O_YS + (size_t)(row - MPR) * D) + col; *(f32x4*)op = x0; *(f32x4*)(op + 4) = x1; }
                    ss += (x0[0] * x0[0] + x0[1] * x0[1]) + (x0[2] * x0[2] + x0[3] * x0[3]) + (x1[0] * x1[0] + x1[1] * x1[1]) + (x1[2] * x1[2] + x1[3] * x1[3]);
                }
                ss += __shfl_xor(ss, 16); ss += __shfl_xor(ss, 32);
                if (fq == 0) atomicAdd(SS3 + row, ss);
            }
    }
};

struct MapIdent { __device__ __forceinline__ int operator()(int n) const { return n; } };
struct MapWin {
    __device__ __forceinline__ int operator()(int n) const {
        if (n < 5120) return n;
        if (n < 9216) return n + 32;
        if (n < 11264) return n + 48;
        const int j = n - 11264;
        if (j < 32) return 5120 + j;
        if (j < 48) return 9216 + j;
        return -1;
    }
};
struct MapFfn {
    __device__ __forceinline__ int operator()(int n) const { const int j = n >> 8, r = n & 255; return r < 128 ? 128 * j + r : DFF + 128 * j + (r - 128); }
};
template <class Map>
__device__ __forceinline__ void transpose_item(const float* W, int K, int Nsrc, int Ndst, bf16_t* WT, const float* gain, LAS float* scr, int item, int lane, Map map) {
    const int nblk = Ndst / 32, kb = item / nblk, nb = item % nblk, k0 = 64 * kb, n0 = 32 * nb;
    const int sc = map(n0 + (lane & 31));
#pragma unroll 8
    for (int i = 0; i < 32; ++i) { const int kk = 2 * i + (lane >> 5); float v = sc >= 0 ? W[(size_t)(k0 + kk) * Nsrc + sc] : 0.f; if (gain) v *= gain[k0 + kk]; scr[kk * 33 + (lane & 31)] = v; }
    asm volatile("s_waitcnt lgkmcnt(0)" ::: "memory");
    const int c = lane & 7;
#pragma unroll
    for (int j = 0; j < 4; ++j) { const int n = (lane >> 3) + 8 * j; const LAS float* s = scr + (8 * c) * 33 + n;
        u32x4 o; o.x = cvt_pk_bf16(s[0 * 33], s[1 * 33]); o.y = cvt_pk_bf16(s[2 * 33], s[3 * 33]); o.z = cvt_pk_bf16(s[4 * 33], s[5 * 33]); o.w = cvt_pk_bf16(s[6 * 33], s[7 * 33]);
        *(u32x4*)(WT + (size_t)(n0 + n) * K + k0 + 8 * c) = o; }
    asm volatile("s_waitcnt lgkmcnt(0)" ::: "memory");
}

__device__ __forceinline__ void p0_prologue(Frame& F) {
    LAS float* scr = (LAS float*)(F.lds + F.wave * 16384);
    const int gw = blockIdx.x * NWAVES + F.wave, NGW = F.G * NWAVES;
    unsigned char* ws = F.ws;
    constexpr int I_WIN = 16 * (NPROJ / 32), I_WBS = 32 * 32, I_WBG = 16 * 32, I_WOUT = 16 * 32, I_WFI = 16 * (2 * DFF / 32), I_WFO = (DFF / 64) * 32, I_WPG = 16 * 32, I_WPP = 4 * 32;
    constexpr int NITEMS = I_WIN + I_WBS + I_WBG + I_WOUT + I_WFI + I_WFO + I_WPG + I_WPP;
    for (int it = gw; it < NITEMS; it += NGW) {
        int r = it;
        if (r < I_WIN) { transpose_item(F.in[9], D, NIN, NPROJ, (bf16_t*)(ws + WS_WIN), nullptr, scr, r, F.lane, MapWin()); continue; } r -= I_WIN;
        if (r < I_WBS) { transpose_item(F.in[20], 2048, D, D, (bf16_t*)(ws + WS_WBS), nullptr, scr, r, F.lane, MapIdent()); continue; } r -= I_WBS;
        if (r < I_WBG) { transpose_item(F.in[21], D, D, D, (bf16_t*)(ws + WS_WBG), nullptr, scr, r, F.lane, MapIdent()); continue; } r -= I_WBG;
        if (r < I_WOUT) { transpose_item(F.in[22], D, D, D, (bf16_t*)(ws + WS_WOUT), nullptr, scr, r, F.lane, MapIdent()); continue; } r -= I_WOUT;
        if (r < I_WFI) { transpose_item(F.in[24], D, 2 * DFF, 2 * DFF, (bf16_t*)(ws + WS_WFI), F.in[23], scr, r, F.lane, MapFfn()); continue; } r -= I_WFI;
        if (r < I_WFO) { transpose_item(F.in[25], DFF, D, D, (bf16_t*)(ws + WS_WFO), nullptr, scr, r, F.lane, MapIdent()); continue; } r -= I_WFO;
        if (r < I_WPG) { transpose_item(F.in[27], D, D, D, (bf16_t*)(ws + WS_WPG), F.in[26], scr, r, F.lane, MapIdent()); continue; } r -= I_WPG;
        transpose_item(F.in[28], 256, D, D, (bf16_t*)(ws + WS_WPP), nullptr, scr, r, F.lane, MapIdent());
    }
    const float* gmix = F.in[8];
    for (int m = gw; m < MP; m += NGW) {
        u32x2* o8 = (u32x2*)(F.XN + (size_t)m * D) + F.lane;
        u32x2* p8 = (u32x2*)(F.PB + (size_t)m * 256) + F.lane;
        if (m >= MTOT) {
#pragma unroll
            for (int j = 0; j < 4; ++j) o8[64 * j] = (u32x2){0u, 0u};
            p8[0] = (u32x2){0u, 0u};
            continue;
        }
        const float* xrow = m < MPR ? F.in[0] + (size_t)m * D : F.in[1] + (size_t)(m - MPR) * D;
        const f32x4* xr = (const f32x4*)xrow + F.lane;
        f32x4 v[4]; float s = 0.f;
#pragma unroll
        for (int j = 0; j < 4; ++j) { v[j] = xr[64 * j]; s += (v[j][0] * v[j][0] + v[j][1] * v[j][1]) + (v[j][2] * v[j][2] + v[j][3] * v[j][3]); }
        const float rs = rsqrtf(wave_sum(s) * (1.0f / D) + EPS);
#pragma unroll
        for (int j = 0; j < 4; ++j) { const f32x4 gv = ((const f32x4*)gmix)[64 * j + F.lane]; const f32x4 y = v[j] * rs * gv;
            o8[64 * j] = (u32x2){cvt_pk_bf16(y[0], y[1]), cvt_pk_bf16(y[2], y[3])}; }
        const float* prow = m < MPR ? F.in[2] + (size_t)m * 256 : F.in[3] + (size_t)(m - MPR) * 256;
        const f32x4 pv = ((const f32x4*)prow)[F.lane];
        p8[0] = (u32x2){cvt_pk_bf16(pv[0], pv[1]), cvt_pk_bf16(pv[2], pv[3])};
    }
}

__device__ __forceinline__ void p2_conv(Frame& F) {
    const int gt = blockIdx.x * (NWAVES * 64) + F.tid, NT = F.G * NWAVES * 64;
    constexpr int NCG = NCH / 8;
    constexpr int NU_P = (MPR / 64) * NCG, NU_S = NSMP * NCG;
    for (int u = gt; u < NU_P + NU_S; u += NT) {
        const bool smp = u >= NU_P;
        const int uu = smp ? u - NU_P : u;
        const int ch = uu / NCG, cgi = uu % NCG;
        const bool is_ssm = cgi < 384;
        const int cc = is_ssm ? cgi * 8 : (cgi - 384) * 8;
        const int kind = is_ssm ? 0 : 1 + (cgi - 384) / 128;
        const float* cw = is_ssm ? F.in[10] : F.in[16];
        float w[4][8], bias[8];
#pragma unroll
        for (int j = 0; j < 4; ++j) { const f32x4 a = *(const f32x4*)(cw + j * 3072 + cc), b = *(const f32x4*)(cw + j * 3072 + cc + 4);
#pragma unroll
            for (int i = 0; i < 4; ++i) { w[j][i] = a[i]; w[j][4 + i] = b[i]; } }
        if (is_ssm) { const f32x4 a = *(const f32x4*)(F.in[11] + cc), b = *(const f32x4*)(F.in[11] + cc + 4);
#pragma unroll
            for (int i = 0; i < 4; ++i) { bias[i] = a[i]; bias[4 + i] = b[i]; } }
        else {
#pragma unroll
            for (int i = 0; i < 8; ++i) bias[i] = 0.f; }
        float h0[8], h1[8], h2[8];
        const int pcol = C_XS + cgi * 8;
        if (smp) {
            const float* st = (is_ssm ? F.in[5] : F.in[7]) + (size_t)ch * 3 * 3072 + cc;
#pragma unroll
            for (int i = 0; i < 8; ++i) { h0[i] = st[i]; h1[i] = st[3072 + i]; h2[i] = st[2 * 3072 + i]; }
            bf16_t* rp = F.PROJ + (size_t)(MPR + ch) * LDP + pcol;
            float x[8]; unpack8(*(const u32x4*)rp, x);
            float o[8]; float ss = 0.f;
#pragma unroll
            for (int i = 0; i < 8; ++i) { float v = w[0][i] * h0[i] + w[1][i] * h1[i] + w[2][i] * h2[i] + w[3][i] * x[i] + bias[i]; v = siluf_(v); o[i] = v; ss += v * v; }
            if (kind == 1 || kind == 2) {
                ss += __shfl_xor(ss, 1); ss += __shfl_xor(ss, 2); ss += __shfl_xor(ss, 4); ss += __shfl_xor(ss, 8);
                const float rn = rsqrtf(ss + EPS) * (kind == 1 ? 0.08838834764831845f : 1.0f);
#pragma unroll
                for (int i = 0; i < 8; ++i) o[i] *= rn;
            }
            *(u32x4*)rp = pack8(o);
            float* ns = F.out + (is_ssm ? O_SCONVS : O_GCONVS) + (size_t)ch * 3 * 3072 + cc;
#pragma unroll
            for (int i = 0; i < 8; ++i) { ns[i] = h1[i]; ns[3072 + i] = h2[i]; ns[2 * 3072 + i] = x[i]; }
            continue;
        }
        const int rowbase = ch * 64, t0 = rowbase & (SEQ - 1);
        if (t0 == 0) {
#pragma unroll
            for (int i = 0; i < 8; ++i) { h0[i] = 0.f; h1[i] = 0.f; h2[i] = 0.f; }
        } else {
            const bf16_t* hp = F.HALO + (size_t)(ch - 1) * 3 * NCH + cgi * 8;
            unpack8(*(const u32x4*)hp, h0); unpack8(*(const u32x4*)(hp + NCH), h1); unpack8(*(const u32x4*)(hp + 2 * NCH), h2);
        }
        const bool lastc = (t0 == SEQ - 64);
        float* ns = F.out + (is_ssm ? O_SCONVP : O_GCONVP) + (size_t)(rowbase >> 11) * 3 * 3072 + cc;
        bf16_t* rp = F.PROJ + (size_t)rowbase * LDP + pcol;
        for (int rb = 0; rb < 64; rb += 8) {
            u32x4 raw[8];
#pragma unroll
            for (int r = 0; r < 8; ++r) raw[r] = *(const u32x4*)(rp + (size_t)(rb + r) * LDP);
#pragma unroll
            for (int r = 0; r < 8; ++r) {
                float x[8]; unpack8(raw[r], x);
                float o[8]; float ss = 0.f;
#pragma unroll
                for (int i = 0; i < 8; ++i) { float v = w[0][i] * h0[i] + w[1][i] * h1[i] + w[2][i] * h2[i] + w[3][i] * x[i] + bias[i]; v = siluf_(v); o[i] = v; ss += v * v; }
                if (kind == 1 || kind == 2) {
                    ss += __shfl_xor(ss, 1); ss += __shfl_xor(ss, 2); ss += __shfl_xor(ss, 4); ss += __shfl_xor(ss, 8);
                    const float rn = rsqrtf(ss + EPS) * (kind == 1 ? 0.08838834764831845f : 1.0f);
#pragma unroll
                    for (int i = 0; i < 8; ++i) o[i] *= rn;
                }
                *(u32x4*)(rp + (size_t)(rb + r) * LDP) = pack8(o);
                if (lastc && rb == 56 && r >= 5) {
#pragma unroll
                    for (int i = 0; i < 8; ++i) ns[(r - 5) * 3072 + i] = x[i];
                }
#pragma unroll
                for (int i = 0; i < 8; ++i) { h0[i] = h1[i]; h1[i] = h2[i]; h2[i] = x[i]; }
            }
        }
    }
}

__device__ __forceinline__ void ssd_item(Frame& F, int item) {
    const bool smp = item >= NBATCH * 32;
    const int sq = smp ? (item - NBATCH * 32) >> 5 : item >> 5, h = item & 31, g = h >> 3;
    const int row0 = smp ? MPR + sq : sq * SEQ, T = smp ? 1 : SEQ;
    const int tid = F.tid, p = tid >> 3, nq = tid & 7;
    LAS bf16_t* Bs = (LAS bf16_t*)(F.lds);
    LAS bf16_t* Cs = (LAS bf16_t*)(F.lds + 16384);
    LAS bf16_t* Xs = (LAS bf16_t*)(F.lds + 32768);
    LAS float* dts = (LAS float*)(F.lds + 40960);
    LAS float* decs = (LAS float*)(F.lds + 41216);
    LAS float* Ys = (LAS float*)(F.lds + 41472);
    float hst[16];
    if (smp) {
        const float* sp = F.in[4] + ((size_t)(sq * 32 + h) * 64 + p) * 128 + nq * 16;
#pragma unroll
        for (int i = 0; i < 4; ++i) { const f32x4 v = ((const f32x4*)sp)[i]; hst[4 * i] = v[0]; hst[4 * i + 1] = v[1]; hst[4 * i + 2] = v[2]; hst[4 * i + 3] = v[3]; }
    } else {
#pragma unroll
        for (int i = 0; i < 16; ++i) hst[i] = 0.f;
    }
    const float a_h = -__expf(F.in[13][h]), dtb = F.in[12][h], Dh = F.in[14][h];
    for (int tb = 0; tb < T; tb += 64) {
        const int rows = (T - tb) < 64 ? (T - tb) : 64;
#pragma unroll
        for (int i = 0; i < 2; ++i) {
            const int pc = tid + i * 512, r = pc >> 4, c8 = (pc & 15) * 8;
            if (r < rows) {
                const bf16_t* src = F.PROJ + (size_t)(row0 + tb + r) * LDP;
                *(LAS u32x4*)(Bs + r * 128 + c8) = *(const u32x4*)(src + C_B + g * 128 + c8);
                *(LAS u32x4*)(Cs + r * 128 + c8) = *(const u32x4*)(src + C_C + g * 128 + c8);
            }
        }
        { const int r = tid >> 3, c8 = (tid & 7) * 8;
          if (r < rows) *(LAS u32x4*)(Xs + r * 64 + c8) = *(const u32x4*)(F.PROJ + (size_t)(row0 + tb + r) * LDP + C_XS + h * 64 + c8); }
        if (tid < rows) { const float dt = softplusf_(F.SMALL[(size_t)(row0 + tb + tid) * 64 + h] + dtb); dts[tid] = dt; decs[tid] = __expf(dt * a_h); }
        __syncthreads();
        for (int tt = 0; tt < rows; ++tt) {
            const float xv = bf2f(Xs[tt * 64 + p]), dtv = dts[tt], dc = decs[tt], dx = dtv * xv;
            float bv[16], cv[16];
            { float t8[8]; unpack8(*(const LAS u32x4*)(Bs + tt * 128 + nq * 16), t8);
#pragma unroll
              for (int i = 0; i < 8; ++i) bv[i] = t8[i];
              unpack8(*(const LAS u32x4*)(Bs + tt * 128 + nq * 16 + 8), t8);
#pragma unroll
              for (int i = 0; i < 8; ++i) bv[8 + i] = t8[i];
              unpack8(*(const LAS u32x4*)(Cs + tt * 128 + nq * 16), t8);
#pragma unroll
              for (int i = 0; i < 8; ++i) cv[i] = t8[i];
              unpack8(*(const LAS u32x4*)(Cs + tt * 128 + nq * 16 + 8), t8);
#pragma unroll
              for (int i = 0; i < 8; ++i) cv[8 + i] = t8[i]; }
            float yp = 0.f;
#pragma unroll
            for (int i = 0; i < 16; ++i) { hst[i] = dc * hst[i] + dx * bv[i]; yp += cv[i] * hst[i]; }
            yp += __shfl_xor(yp, 1); yp += __shfl_xor(yp, 2); yp += __shfl_xor(yp, 4);
            if (nq == 0) Ys[tt * 64 + p] = yp + Dh * xv;
        }
        __syncthreads();
        { const int r = tid >> 3, c8 = (tid & 7) * 8;
          if (r < rows) { float o[8];
#pragma unroll
              for (int i = 0; i < 8; ++i) o[i] = Ys[r * 64 + c8 + i];
              *(u32x4*)(F.PROJ + (size_t)(row0 + tb + r) * LDP + C_XS + h * 64 + c8) = pack8(o); } }
        __syncthreads();
    }
    float* op = F.out + (smp ? O_SSMS : O_SSMP) + ((size_t)(sq * 32 + h) * 64 + p) * 128 + nq * 16;
#pragma unroll
    for (int i = 0; i < 4; ++i) ((f32x4*)op)[i] = (f32x4){hst[4 * i], hst[4 * i + 1], hst[4 * i + 2], hst[4 * i + 3]};
}

__device__ __forceinline__ void gdn_item(Frame& F, int item) {
    const bool smp = item >= NBATCH * 32;
    const int sq = smp ? (item - NBATCH * 32) >> 5 : item >> 5, h = (item >> 2) & 7, dvq = item & 3;
    const int row0 = smp ? MPR + sq : sq * SEQ, T = smp ? 1 : SEQ;
    const int tid = F.tid, e = tid >> 4, kg = tid & 15;
    LAS bf16_t* Qs = (LAS bf16_t*)(F.lds);
    LAS bf16_t* Ks = (LAS bf16_t*)(F.lds + 16384);
    LAS bf16_t* Vs = (LAS bf16_t*)(F.lds + 32768);
    LAS float* egs = (LAS float*)(F.lds + 36864);
    LAS float* bts = (LAS float*)(F.lds + 37120);
    LAS float* Os = (LAS float*)(F.lds + 37376);
    float S[8];
    const size_t sbase = ((size_t)(sq * 8 + h) * 128 + kg * 8) * 128 + dvq * 32 + e;
    if (smp) {
#pragma unroll
        for (int j = 0; j < 8; ++j) S[j] = F.in[6][sbase + (size_t)j * 128];
    } else {
#pragma unroll
        for (int j = 0; j < 8; ++j) S[j] = 0.f;
    }
    const float na = -__expf(F.in[18][h]), dtb = F.in[17][h];
    for (int tb = 0; tb < T; tb += 64) {
        const int rows = (T - tb) < 64 ? (T - tb) : 64;
#pragma unroll
        for (int i = 0; i < 2; ++i) {
            const int pc = tid + i * 512, r = pc >> 4, c8 = (pc & 15) * 8;
            if (r < rows) {
                const bf16_t* src = F.PROJ + (size_t)(row0 + tb + r) * LDP;
                *(LAS u32x4*)(Qs + r * 128 + c8) = *(const u32x4*)(src + C_Q + h * 128 + c8);
                *(LAS u32x4*)(Ks + r * 128 + c8) = *(const u32x4*)(src + C_K + h * 128 + c8);
            }
        }
        if (tid < 256) { const int r = tid >> 2, c8 = (tid & 3) * 8;
          if (r < rows) *(LAS u32x4*)(Vs + r * 32 + c8) = *(const u32x4*)(F.PROJ + (size_t)(row0 + tb + r) * LDP + C_V + h * 128 + dvq * 32 + c8); }
        if (tid < rows) { const float* sm = F.SMALL + (size_t)(row0 + tb + tid) * 64;
            egs[tid] = __expf(na * softplusf_(sm[40 + h] + dtb)); bts[tid] = sigmoidf_(sm[32 + h]); }
        __syncthreads();
        for (int tt = 0; tt < rows; ++tt) {
            float k8[8], q8[8];
            unpack8(*(const LAS u32x4*)(Ks + tt * 128 + kg * 8), k8);
            unpack8(*(const LAS u32x4*)(Qs + tt * 128 + kg * 8), q8);
            const float eg = egs[tt], bt = bts[tt], v = bf2f(Vs[tt * 32 + e]);
            float ks = 0.f;
#pragma unroll
            for (int j = 0; j < 8; ++j) ks += k8[j] * S[j];
            ks += __shfl_xor(ks, 1); ks += __shfl_xor(ks, 2); ks += __shfl_xor(ks, 4); ks += __shfl_xor(ks, 8);
            const float vn = bt * (v - eg * ks);
            float op = 0.f;
#pragma unroll
            for (int j = 0; j < 8; ++j) { S[j] = eg * S[j] + k8[j] * vn; op += q8[j] * S[j]; }
            op += __shfl_xor(op, 1); op += __shfl_xor(op, 2); op += __shfl_xor(op, 4); op += __shfl_xor(op, 8);
            if (kg == 0) Os[tt * 32 + e] = op;
        }
        __syncthreads();
        if (tid < 256) { const int r = tid >> 2, c8 = (tid & 3) * 8;
          if (r < rows) { float o[8];
#pragma unroll
              for (int i = 0; i < 8; ++i) o[i] = Os[r * 32 + c8 + i];
              *(u32x4*)(F.PROJ + (size_t)(row0 + tb + r) * LDP + C_V + h * 128 + dvq * 32 + c8) = pack8(o); } }
        __syncthreads();
    }
    float* op = F.out + (smp ? O_GDNS : O_GDNP);
#pragma unroll
    for (int j = 0; j < 8; ++j) op[sbase + (size_t)j * 128] = S[j];
}

__device__ __forceinline__ void p3_scan(Frame& F) {
    constexpr int NSSD = NBATCH * 32 + NSMP * 32, NGDN = NBATCH * 32 + NSMP * 32;
    for (int it = blockIdx.x; it < NSSD; it += F.G) ssd_item(F, it);
    for (int it = blockIdx.x; it < NGDN; it += F.G) gdn_item(F, it);
}

__device__ __forceinline__ void p4_norm(Frame& F) {
    const int gw = blockIdx.x * NWAVES + F.wave, NGW = F.G * NWAVES, lane = F.lane;
    const float* gs = F.in[15]; const float* gg = F.in[19];
    for (int m = gw; m < MTOT; m += NGW) {
        bf16_t* row = F.PROJ + (size_t)m * LDP;
#pragma unroll
        for (int g = 0; g < 4; ++g) {
            const int c = g * 512 + lane * 8;
            float y[8], z[8]; unpack8(*(const u32x4*)(row + C_XS + c), y); unpack8(*(const u32x4*)(row + C_Z + c), z);
            float ss = 0.f;
#pragma unroll
            for (int i = 0; i < 8; ++i) { y[i] *= siluf_(z[i]); ss += y[i] * y[i]; }
            const float r = rsqrtf(wave_sum(ss) * (1.0f / 512.0f) + EPS);
            const f32x4 g0 = *(const f32x4*)(gs + c), g1 = *(const f32x4*)(gs + c + 4);
#pragma unroll
            for (int i = 0; i < 4; ++i) { y[i] *= r * g0[i]; y[4 + i] *= r * g1[i]; }
            *(u32x4*)(row + C_XS + c) = pack8(y);
        }
#pragma unroll
        for (int hh = 0; hh < 2; ++hh) {
            const int c = hh * 512 + lane * 8;
            float o[8], gt[8]; unpack8(*(const u32x4*)(row + C_V + c), o); unpack8(*(const u32x4*)(row + C_GATE + c), gt);
            float ss = 0.f;
#pragma unroll
            for (int i = 0; i < 8; ++i) ss += o[i] * o[i];
            ss += __shfl_xor(ss, 1); ss += __shfl_xor(ss, 2); ss += __shfl_xor(ss, 4); ss += __shfl_xor(ss, 8);
            const float r = rsqrtf(ss * (1.0f / 128.0f) + EPS);
            const int e = (lane & 15) * 8;
            const f32x4 g0 = *(const f32x4*)(gg + e), g1 = *(const f32x4*)(gg + e + 4);
#pragma unroll
            for (int i = 0; i < 4; ++i) { o[i] = o[i] * r * g0[i] * siluf_(gt[i]); o[4 + i] = o[4 + i] * r * g1[i] * siluf_(gt[4 + i]); }
            *(u32x4*)(row + C_V + c) = pack8(o);
        }
    }
}

__device__ __forceinline__ void p12_final(Frame& F) {
    const int gw = blockIdx.x * NWAVES + F.wave, NGW = F.G * NWAVES, lane = F.lane;
    const float* gf = F.in[29];
    for (int m = gw; m < MTOT; m += NGW) {
        float* orow = F.out + (m < MPR ? O_Y + (size_t)m * D : O_YS + (size_t)(m - MPR) * D);
        const float r = rsqrtf(F.SS3[m] * (1.0f / D) + EPS);
#pragma unroll
        for (int j = 0; j < 4; ++j) { f32x4* p = (f32x4*)orow + 64 * j + lane; const f32x4 gv = ((const f32x4*)gf)[64 * j + lane]; *p = *p * r * gv; }
    }
}

__global__ void __launch_bounds__(NWAVES * 64, 2) mega_fwd(Args args) {
    extern __shared__ __attribute__((aligned(16))) unsigned char lds_raw[];
    Frame F;
    F.lds = (LAS unsigned char*)lds_raw;
    F.tid = threadIdx.x; F.lane = F.tid & 63; F.wave = __builtin_amdgcn_readfirstlane(F.tid >> 6); F.G = gridDim.x;
    F.in = args.in;
    F.out = args.out; F.ws = args.ws;
    unsigned char* ws = args.ws;
    F.PROJ = (bf16_t*)(ws + WS_PROJ); F.HALO = (bf16_t*)(ws + WS_HALO); F.SMALL = (float*)(ws + WS_SMALL); F.XN = (bf16_t*)(ws + WS_XN); F.PB = (bf16_t*)(ws + WS_PB);
    F.SS1 = (float*)(ws + WS_SS1); F.SS2 = (float*)(ws + WS_SS2); F.SS3 = (float*)(ws + WS_SS3);
    const int lo = args.ph_lo, hi = args.ph_hi;
#if MK_ONE_LAUNCH
    cg::grid_group grid = cg::this_grid();
#define SEAM(k) do { if (lo <= (k) && (k) + 1 < hi) grid.sync(); } while (0)
#else
#define SEAM(k) do { } while (0)
#endif
#ifndef PHASE_MASK
#define PHASE_MASK 0xffff
#endif
#define IN(k) (((PHASE_MASK >> (k)) & 1) && lo <= (k) && (k) < hi)
    const int bid = (int)blockIdx.x;
    typedef pg8::StaticOrder SO;

    if (IN(0)) { p0_prologue(F); SEAM(0); }
    if (IN(1)) {
        pg8::Gemm g{F.XN, (const bf16_t*)(ws + WS_WIN), MP, NPROJ, D, D, D}; SO S; S.init(MP, NPROJ, F.G, bid);
        EpiInProj E{F.PROJ, F.HALO, F.SMALL};
        pg8::gemm_phase<EpiInProj, SO>(F.lds, g, S, E); SEAM(1);
    }
    if (IN(2)) { p2_conv(F); SEAM(2); }
    if (IN(3)) { p3_scan(F); SEAM(3); }
    if (IN(4)) { p4_norm(F); SEAM(4); }
    if (IN(5)) {
        pg8::Gemm g{F.PROJ + C_XS, (const bf16_t*)(ws + WS_WBS), MP, D, 2048, LDP, 2048}; SO S; S.init(MP, D, F.G, bid);
        EpiT1 E{F.PROJ};
        pg8::gemm_phase<EpiT1, SO>(F.lds, g, S, E); SEAM(5);
    }
    if (IN(6)) {
        pg8::Gemm g{F.PROJ + C_V, (const bf16_t*)(ws + WS_WBG), MP, D, D, LDP, D}; SO S; S.init(MP, D, F.G, bid);
        EpiMix E{F.PROJ};
        pg8::gemm_phase<EpiMix, SO>(F.lds, g, S, E); SEAM(6);
    }
    if (IN(7)) {
        pg8::Gemm g{F.PROJ + C_Q, (const bf16_t*)(ws + WS_WOUT), MP, D, D, LDP, D}; SO S; S.init(MP, D, F.G, bid);
        EpiResid<0> E{F.PROJ, F.in[0], F.in[1], 0, C_Z, C_K, F.SS1};
        pg8::gemm_phase<EpiResid<0>, SO>(F.lds, g, S, E); SEAM(7);
    }
    if (IN(8)) {
        pg8::Gemm g{F.PROJ + C_K, (const bf16_t*)(ws + WS_WFI), MP, 2 * DFF, D, LDP, D}; SO S; S.init(MP, 2 * DFF, F.G, bid);
        EpiSwiGLU E{F.PROJ, F.SS1};
        pg8::gemm_phase<EpiSwiGLU, SO>(F.lds, g, S, E); SEAM(8);
    }
    if (IN(9)) {
        pg8::Gemm g{F.PROJ + C_XS, (const bf16_t*)(ws + WS_WFO), MP, D, DFF, LDP, DFF}; SO S; S.init(MP, D, F.G, bid);
        EpiResid<1> E{F.PROJ, nullptr, nullptr, C_Z, C_MG, C_GATE, F.SS2};
        pg8::gemm_phase<EpiResid<1>, SO>(F.lds, g, S, E); SEAM(9);
    }
    if (IN(10)) {
        pg8::Gemm g{F.PB, (const bf16_t*)(ws + WS_WPP), MP, D, 256, 256, 256}; SO S; S.init(MP, D, F.G, bid);
        EpiPE E{F.PROJ};
        pg8::gemm_phase<EpiPE, SO>(F.lds, g, S, E); SEAM(10);
    }
    if (IN(11)) {
        pg8::Gemm g{F.PROJ + C_GATE, (const bf16_t*)(ws + WS_WPG), MP, D, D, LDP, D}; SO S; S.init(MP, D, F.G, bid);
        EpiX3 E{F.PROJ, F.SS2, F.SS3, F.out};
        pg8::gemm_phase<EpiX3, SO>(F.lds, g, S, E); SEAM(11);
    }
    if (IN(12)) { p12_final(F); }
#undef IN
#undef SEAM
}

constexpr int NPHASES = 13;

extern "C" void kernel_launch(void* const* d_in, const int* in_sizes, int n_in, void* d_out, int out_size, void* d_ws, size_t ws_size, hipStream_t stream) {
    static int grid = 0;
    if (grid == 0) {
        if (n_in != 30 || ws_size < WS_END) { fprintf(stderr, "kernel_launch: bad call: n_in %d ws %zu (need %zu)\n", n_in, ws_size, (size_t)WS_END); grid = -1; return; }
        int dev = 0, cus = 0, per_cu = 0;
        if (hipGetDevice(&dev) != hipSuccess || hipDeviceGetAttribute(&cus, hipDeviceAttributeMultiprocessorCount, dev) != hipSuccess) { grid = -1; return; }
        if (hipFuncSetAttribute((const void*)mega_fwd, hipFuncAttributeMaxDynamicSharedMemorySize, LDS_BYTES) != hipSuccess) { fprintf(stderr, "kernel_launch: hipFuncSetAttribute failed\n"); grid = -1; return; }
        if (hipOccupancyMaxActiveBlocksPerMultiprocessor(&per_cu, (const void*)mega_fwd, NWAVES * 64, LDS_BYTES) != hipSuccess || per_cu < 1) { fprintf(stderr, "kernel_launch: occupancy query says %d\n", per_cu); per_cu = 1; }
        (void)hipGetLastError();
        grid = cus;
    }
    if (grid < 0) return;
    (void)hipMemsetAsync((char*)d_ws + WS_CTL, 0, CTL_BYTES, stream);
    Args a{};
    for (int i = 0; i < 30; ++i) a.in[i] = (const float*)d_in[i];
    a.out = (float*)d_out; a.ws = (unsigned char*)d_ws;
#if MK_ONE_LAUNCH
    a.ph_lo = 0; a.ph_hi = NPHASES;
    void* kargs[] = {&a};
    hipError_t e = hipLaunchCooperativeKernel((const void*)mega_fwd, dim3(grid), dim3(NWAVES * 64), kargs, LDS_BYTES, stream);
    if (e != hipSuccess) fprintf(stderr, "cooperative launch failed: %s (grid %d)\n", hipGetErrorString(e), grid);
#else
    for (int ph = 0; ph < NPHASES; ++ph) {
        a.ph_lo = ph; a.ph_hi = ph + 1;
        hipLaunchKernelGGL(mega_fwd, dim3(grid), dim3(NWAVES * 64), LDS_BYTES, stream, a);
    }
#endif
}
```

```cpp
#include <hip/hip_runtime.h>
#include <hip/hip_cooperative_groups.h>
#include <cstdio>
#include <cstdint>
namespace cg = cooperative_groups;

#ifndef MK_ONE_LAUNCH
#define MK_ONE_LAUNCH 1
#endif

#define LAS __attribute__((address_space(3)))
typedef unsigned short bf16_t;
typedef short bf16x8 __attribute__((ext_vector_type(8)));
typedef float f32x4 __attribute__((ext_vector_type(4)));
typedef float f32x2 __attribute__((ext_vector_type(2)));
typedef unsigned u32x4 __attribute__((ext_vector_type(4)));
typedef unsigned u32x2 __attribute__((ext_vector_type(2)));

constexpr int D = 1024, SEQ = 2048, NBATCH = 8, MPR = NBATCH * SEQ, NSMP = 128, MTOT = MPR + NSMP, MP = 16640;
constexpr int LDP = 11264, LDF = LDP / 2;
constexpr int C_Z = 0, C_XS = 2048, C_B = 4096, C_C = 4608, C_Q = 5120, C_K = 6144, C_V = 7168, C_GATE = 8192, C_MG = 9216;
constexpr int NIN = 11312;
constexpr int NPROJ = 11520;
constexpr int DFF = 2816;
constexpr float EPS = 1e-6f;
constexpr int NCH = 6144;

constexpr size_t O_Y = 0, O_YS = 16777216, O_SSMP = 16908288, O_SCONVP = 19005440, O_GDNP = 19079168, O_GCONVP = 20127744,
                 O_SSMS = 20201472, O_SCONVS = 53755904, O_GDNS = 54935552, O_GCONVS = 71712768;

constexpr size_t MiB = 1u << 20;
constexpr size_t WS_CTL = 0, CTL_BYTES = 1 * MiB;
constexpr size_t WS_BAR = 16384;
constexpr size_t WS_SS1 = 65536, WS_SS2 = WS_SS1 + 69632, WS_SS3 = WS_SS2 + 69632;
constexpr size_t WS_WIN = 1 * MiB, WS_WBS = 25 * MiB, WS_WBG = 29 * MiB, WS_WOUT = 31 * MiB, WS_WFI = 33 * MiB, WS_WFO = 44 * MiB, WS_WPG = 50 * MiB, WS_WPP = 52 * MiB;
constexpr size_t WS_XN = 53 * MiB, WS_PB = 86 * MiB, WS_SMALL = 95 * MiB, WS_HALO = 100 * MiB, WS_PROJ = 110 * MiB;
constexpr size_t WS_END = WS_PROJ + (size_t)MP * LDP * 2;
static_assert(WS_END <= 512 * MiB, "ws map");
static_assert(WS_SS3 + 69632 <= CTL_BYTES, "ctl");

__device__ __forceinline__ unsigned cvt_pk_bf16(float lo, float hi) { unsigned r; asm volatile("v_cvt_pk_bf16_f32 %0, %1, %2" : "=v"(r) : "v"(lo), "v"(hi)); return r; }
__device__ __forceinline__ float bflo(unsigned w) { return __uint_as_float(w << 16); }
__device__ __forceinline__ float bfhi(unsigned w) { return __uint_as_float(w & 0xffff0000u); }
__device__ __forceinline__ float bf2f(bf16_t b) { return __uint_as_float((unsigned)b << 16); }
__device__ __forceinline__ void unpack8(const u32x4 w, float (&f)[8]) { f[0] = bflo(w.x); f[1] = bfhi(w.x); f[2] = bflo(w.y); f[3] = bfhi(w.y); f[4] = bflo(w.z); f[5] = bfhi(w.z); f[6] = bflo(w.w); f[7] = bfhi(w.w); }
__device__ __forceinline__ u32x4 pack8(const float (&f)[8]) { u32x4 w; w.x = cvt_pk_bf16(f[0], f[1]); w.y = cvt_pk_bf16(f[2], f[3]); w.z = cvt_pk_bf16(f[4], f[5]); w.w = cvt_pk_bf16(f[6], f[7]); return w; }
__device__ __forceinline__ float sigmoidf_(float x) { return __builtin_amdgcn_rcpf(1.0f + __builtin_amdgcn_exp2f(-1.4426950408889634f * x)); }
__device__ __forceinline__ float siluf_(float x) { return x * sigmoidf_(x); }
__device__ __forceinline__ float softplusf_(float x) { return x > 20.f ? x : log1pf(__expf(x)); }
__device__ __forceinline__ float wave_sum(float v) {
#pragma unroll
    for (int o = 1; o < 64; o <<= 1) v += __shfl_xor(v, o);
    return v;
}

namespace pg8 {
constexpr int BM = 256, BK = 64, HALF = 128, HTB = HALF * BK * 2, STAGE_BYTES = 8 * HTB, NXCD = 8, WGM = 8;
__host__ __device__ __forceinline__ int lds_byte(int r, int c) { const int st = (r >> 4) * 2 + (c >> 5), rr = r & 15, cc = c & 31, ob = rr * 64 + cc * 2; return st * 1024 + (ob ^ (((ob >> 9) & 1) << 5)); }
__host__ __device__ __forceinline__ void stage_rc(int b, int& R, int& C) { const int st = b / 1024, sb = b % 1024, swz = sb ^ (((sb >> 9) & 1) << 5); R = (st >> 1) * 16 + swz / 64; C = (st & 1) * 32 + (swz % 64) / 2; }
__host__ __device__ __forceinline__ int perm32(int rho) { const int n = rho >> 4, i = rho & 15; return 8 * (i >> 2) + 4 * n + (i & 3); }

struct Unit { int pm, pn; };
struct Gemm { const bf16_t* A; const bf16_t* Bt; int M, N, K, lda, ldb; };

struct StaticOrder {
    int nM, nN, nwg, G, c;
    __host__ __device__ void init(int M, int N, int G_, int c_) { nM = M / BM; nN = N / BM; nwg = nM * nN; G = G_; c = c_; }
    __host__ __device__ bool next(int i, Unit& u) const {
        const long L = (long)i * G + c; if (L >= nwg) return false;
        int wgid = (int)L; { const int q = nwg / NXCD, r = nwg % NXCD, xcd = wgid % NXCD, off = wgid / NXCD; wgid = (xcd < r ? xcd * (q + 1) : r * (q + 1) + (xcd - r) * q) + off; }
        const int nig = WGM * nN, gid = wgid / nig, fm = gid * WGM, gsz = (nM - fm) < WGM ? (nM - fm) : WGM;
        u.pm = fm + ((wgid % nig) % gsz); u.pn = (wgid % nig) / gsz; return true;
    }
    __device__ __forceinline__ void a_ready(const Unit&) const {}
    __device__ __forceinline__ void done(const Unit&) const {}
};

template <class Epi, class Sched, bool ALIGN_EPI = true, bool SP2 = true>
__device__ __forceinline__ void gemm_phase(LAS unsigned char* lds, const Gemm g, const Sched& S, const Epi& E) {
    const int tid = threadIdx.x, wid = __builtin_amdgcn_readfirstlane(tid >> 6), lane = tid & 63, wr = wid >> 2, wc = wid & 3, fr = lane & 15, fq = lane >> 4;
    int nt = g.K / BK; asm volatile("" : "+s"(nt));
    unsigned voffA[2], voffB[2];
#pragma unroll
    for (int i = 0; i < 2; ++i) { int R, C; stage_rc(tid * 16 + i * 8192, R, C); const int Rb = Epi::PERM ? ((R & ~31) + perm32(R & 31)) : R;
        voffA[i] = (unsigned)(R * g.lda + C) * 2u; voffB[i] = (unsigned)(Rb * g.ldb + C) * 2u; }
    const size_t kstep = (size_t)(BK * 2);
    const size_t hstepA = (size_t)HALF * g.lda * 2, hstepB = (size_t)HALF * g.ldb * 2;
    const size_t tstepA = 2 * hstepA, tstepB = 2 * hstepB;
    const unsigned ldsw = (unsigned)wid * 1024u;
    const int aoff = lds_byte(wr * 64 + fr, fq * 8), boff = lds_byte(wc * 32 + fr, fq * 8);
#define PG8_SA(b, h) (((b) * 2 + (h)) * HTB)
#define PG8_SB(b, h) ((4 + (b) * 2 + (h)) * HTB)
#define PG8_STAGE(bufoff, gbase, voff) do { _Pragma("unroll") for (int _i = 0; _i < 2; ++_i) \
        __builtin_amdgcn_global_load_lds((const unsigned*)((const char*)(gbase) + (voff)[_i]), (LAS unsigned*)(lds + (bufoff) + ldsw + _i * 8192), 16, 0, 0); } while (0)
#define PG8_LDA(dst, b, h) do { _Pragma("unroll") for (int m = 0; m < 4; ++m) _Pragma("unroll") for (int k = 0; k < 2; ++k) dst[m][k] = *(const LAS bf16x8*)(lds + PG8_SA(b, h) + aoff + m * 2048 + k * 1024); } while (0)
#define PG8_LDB(dst, b, h) do { _Pragma("unroll") for (int n = 0; n < 2; ++n) _Pragma("unroll") for (int k = 0; k < 2; ++k) dst[n][k] = *(const LAS bf16x8*)(lds + PG8_SB(b, h) + boff + n * 2048 + k * 1024); } while (0)
#define PG8_MMA(ai, bj, At, Bt) do { __builtin_amdgcn_s_setprio(1); _Pragma("unroll") for (int m = 0; m < 4; ++m) _Pragma("unroll") for (int n = 0; n < 2; ++n) _Pragma("unroll") for (int k = 0; k < 2; ++k) \
        acc[ai][bj][m][n] = __builtin_amdgcn_mfma_f32_16x16x32_bf16(Bt[n][k], At[m][k], acc[ai][bj][m][n], 0, 0, 0); __builtin_amdgcn_s_setprio(0); } while (0)
#define PG8_WAIT_V(n) asm volatile("s_waitcnt vmcnt(" #n ")" ::: "memory")
#define PG8_WAIT_L(n) asm volatile("s_waitcnt lgkmcnt(" #n ")" ::: "memory")
#define PG8_BAR __builtin_amdgcn_s_barrier()
#define PG8_SCHED __builtin_amdgcn_sched_barrier(0)
    Unit cur, nxt; int ui = 0;
    if (!S.next(0, cur)) return;
    f32x4 acc[2][2][4][2];
#pragma unroll
    for (int a = 0; a < 2; ++a)
#pragma unroll
        for (int b = 0; b < 2; ++b)
#pragma unroll
            for (int m = 0; m < 4; ++m)
#pragma unroll
                for (int n = 0; n < 2; ++n) acc[a][b][m][n] = (f32x4){0.f, 0.f, 0.f, 0.f};
    bf16x8 At[4][2], B0[2][2], B1[2][2];
    const char* cA = (const char*)g.A + (size_t)cur.pm * tstepA; const char* cB = (const char*)g.Bt + (size_t)cur.pn * tstepB;
    S.a_ready(cur);
    if constexpr (SP2) {
        PG8_STAGE(PG8_SB(0, 0), cB, voffB); PG8_STAGE(PG8_SB(0, 1), cB + hstepB, voffB); PG8_STAGE(PG8_SA(0, 0), cA, voffA); PG8_STAGE(PG8_SA(0, 1), cA + hstepA, voffA);
        if (wr == 1) PG8_BAR;
        PG8_WAIT_V(2); PG8_BAR;
        PG8_STAGE(PG8_SB(1, 0), cB + kstep, voffB); PG8_STAGE(PG8_SA(1, 0), cA + kstep, voffA); PG8_STAGE(PG8_SB(1, 1), cB + hstepB + kstep, voffB);
        PG8_WAIT_V(6); PG8_BAR;
    } else {
        PG8_STAGE(PG8_SB(0, 0), cB, voffB); PG8_STAGE(PG8_SA(0, 0), cA, voffA); PG8_STAGE(PG8_SB(0, 1), cB + hstepB, voffB); PG8_STAGE(PG8_SA(0, 1), cA + hstepA, voffA);
        if (wr == 1) PG8_BAR;
        PG8_WAIT_V(4); PG8_BAR;
        PG8_STAGE(PG8_SB(1, 0), cB + kstep, voffB); PG8_STAGE(PG8_SA(1, 0), cA + kstep, voffA); PG8_STAGE(PG8_SB(1, 1), cB + hstepB + kstep, voffB);
        PG8_WAIT_V(6); PG8_BAR;
    }
    for (;;) {
        const bool has_next = S.next(ui + 1, nxt);
        const char* nA = has_next ? (const char*)g.A + (size_t)nxt.pm * tstepA : cA; const char* nB = has_next ? (const char*)g.Bt + (size_t)nxt.pn * tstepB : cB;
        for (int t = 0; t < nt; t += 2) {
            const bool last = (t == nt - 2);
            const char* a1 = cA + (size_t)(t + 1) * kstep;
            const char* a2 = last ? nA : cA + (size_t)(t + 2) * kstep; const char* b2 = last ? nB : cB + (size_t)(t + 2) * kstep;
            const char* a3 = a2 + kstep; const char* b3 = b2 + kstep;
            if (last && has_next) S.a_ready(nxt);
            if constexpr (SP2) {
            PG8_LDB(B0, 0, 0); PG8_LDB(B1, 0, 1); PG8_SCHED; PG8_LDA(At, 0, 0); PG8_STAGE(PG8_SA(1, 1), a1 + hstepA, voffA);
            PG8_WAIT_V(8); PG8_WAIT_L(0); PG8_BAR; PG8_MMA(0, 0, At, B0); PG8_MMA(0, 1, At, B1); PG8_BAR; PG8_SCHED;
            PG8_LDA(At, 0, 1); PG8_STAGE(PG8_SB(0, 0), b2, voffB); PG8_STAGE(PG8_SB(0, 1), b2 + hstepB, voffB); PG8_STAGE(PG8_SA(0, 0), a2, voffA);
            PG8_WAIT_V(8); PG8_WAIT_L(0); PG8_BAR; PG8_MMA(1, 0, At, B0); PG8_MMA(1, 1, At, B1); PG8_BAR; PG8_SCHED;
            PG8_LDB(B0, 1, 0); PG8_LDB(B1, 1, 1); PG8_SCHED; PG8_LDA(At, 1, 0); PG8_STAGE(PG8_SA(0, 1), a2 + hstepA, voffA);
            PG8_WAIT_V(8); PG8_WAIT_L(0); PG8_BAR; PG8_MMA(0, 0, At, B0); PG8_MMA(0, 1, At, B1); PG8_BAR; PG8_SCHED;
            PG8_LDA(At, 1, 1); PG8_STAGE(PG8_SB(1, 0), b3, voffB); PG8_STAGE(PG8_SB(1, 1), b3 + hstepB, voffB); PG8_STAGE(PG8_SA(1, 0), a3, voffA);
            PG8_WAIT_V(8); PG8_WAIT_L(0); PG8_BAR; PG8_MMA(1, 0, At, B0); PG8_MMA(1, 1, At, B1); PG8_BAR; PG8_SCHED;
            } else {
            PG8_LDB(B0, 0, 0); PG8_SCHED; PG8_LDA(At, 0, 0); PG8_STAGE(PG8_SA(1, 1), a1 + hstepA, voffA);
            PG8_WAIT_L(8); PG8_BAR; PG8_WAIT_L(0); PG8_MMA(0, 0, At, B0); PG8_BAR; PG8_SCHED;
            PG8_LDB(B1, 0, 1); PG8_STAGE(PG8_SB(0, 0), b2, voffB);
            PG8_BAR; PG8_WAIT_L(0); PG8_MMA(0, 1, At, B1); PG8_BAR;
            PG8_LDA(At, 0, 1); PG8_STAGE(PG8_SA(0, 0), a2, voffA);
            PG8_BAR; PG8_WAIT_L(0); PG8_MMA(1, 0, At, B0); PG8_BAR; PG8_SCHED;
            PG8_STAGE(PG8_SB(0, 1), b2 + hstepB, voffB);
            PG8_WAIT_V(6); PG8_BAR; PG8_MMA(1, 1, At, B1); PG8_BAR;
            PG8_LDB(B0, 1, 0); PG8_SCHED; PG8_LDA(At, 1, 0); PG8_STAGE(PG8_SA(0, 1), a2 + hstepA, voffA);
            PG8_WAIT_L(8); PG8_BAR; PG8_WAIT_L(0); PG8_MMA(0, 0, At, B0); PG8_BAR; PG8_SCHED;
            PG8_LDB(B1, 1, 1); PG8_STAGE(PG8_SB(1, 0), b3, voffB);
            PG8_BAR; PG8_WAIT_L(0); PG8_MMA(0, 1, At, B1); PG8_BAR;
            PG8_LDA(At, 1, 1); PG8_STAGE(PG8_SA(1, 0), a3, voffA);
            PG8_BAR; PG8_WAIT_L(0); PG8_MMA(1, 0, At, B0); PG8_BAR; PG8_SCHED;
            PG8_STAGE(PG8_SB(1, 1), b3 + hstepB, voffB);
            PG8_WAIT_V(6); PG8_BAR; PG8_MMA(1, 1, At, B1); PG8_BAR;
            }
        }
        if constexpr (ALIGN_EPI) { if (wr == 0) PG8_BAR; }
        E(acc, cur, wr, wc, fr, fq); S.done(cur);
        if (!has_next) break;
#pragma unroll
        for (int a = 0; a < 2; ++a)
#pragma unroll
            for (int b = 0; b < 2; ++b)
#pragma unroll
                for (int m = 0; m < 4; ++m)
#pragma unroll
                    for (int n = 0; n < 2; ++n) acc[a][b][m][n] = (f32x4){0.f, 0.f, 0.f, 0.f};
        cur = nxt; cA = nA; cB = nB; ++ui;
        if constexpr (ALIGN_EPI) { if (wr == 1) PG8_BAR; }
    }
    PG8_WAIT_V(0);
    if constexpr (!ALIGN_EPI) { if (wr == 0) PG8_BAR; }
    PG8_BAR;
#undef PG8_SA
#undef PG8_SB
#undef PG8_STAGE
#undef PG8_LDA
#undef PG8_LDB
#undef PG8_MMA
#undef PG8_WAIT_V
#undef PG8_WAIT_L
#undef PG8_BAR
#undef PG8_SCHED
}
}
using pg8::Unit;


#define XB_TMO      128
#define XB_XCNT(j)  (256  + 64 * (j))
#define XB_XSUB(j)  (1280 + 64 * (j))
#define XB_XGEN(j)  (2304 + 64 * (j))
#define XB_TOP      3328
#define XB_TOPGEN   3392
#define XCD_BAR_WORDS 3456
#define XB_SPIN_CAP (1u << 22)
__device__ __forceinline__ unsigned xb_ld(unsigned* p)              { return __hip_atomic_load(p, __ATOMIC_RELAXED, __HIP_MEMORY_SCOPE_AGENT); }
__device__ __forceinline__ unsigned xb_add(unsigned* p, unsigned v) { return __hip_atomic_fetch_add(p, v, __ATOMIC_RELAXED, __HIP_MEMORY_SCOPE_AGENT); }
__device__ __forceinline__ unsigned xb_xcc_id() { return (unsigned)__builtin_amdgcn_s_getreg((3 << 11) | 20) & 0xFu; }
#define XB_SPIN(cond, bar) do { unsigned _sp = 0; while (cond) { __builtin_amdgcn_s_sleep(1); \
    if ((++_sp & 255u) == 0u) { if (xb_ld(&(bar)[XB_TMO])) break; if (_sp > XB_SPIN_CAP) { atomicAdd(&(bar)[XB_TMO], 1u); break; } } } } while (0)
struct XcdBarrier { unsigned* bar; unsigned x; volatile LAS unsigned* st; };
__device__ __forceinline__ XcdBarrier xcd_barrier_post(unsigned* bar, volatile LAS unsigned* st) {
    XcdBarrier b; b.bar = bar; b.x = xb_xcc_id(); b.st = st;
    if (threadIdx.x == 0) (void)xb_add(&bar[XB_XCNT(b.x)], 1u);
    return b;
}
__device__ __forceinline__ void xcd_barrier_complete(unsigned* bar, unsigned x, unsigned& nloc, unsigned& nx) {
    const unsigned G = gridDim.x * gridDim.y * gridDim.z;
    unsigned sum, cnt, mine, sp = 0u;
    for (;;) {
        sum = 0u; cnt = 0u; mine = 0u;
#pragma unroll
        for (unsigned j = 0; j < 16; ++j) { const unsigned c = xb_ld(&bar[XB_XCNT(j)]); sum += c; cnt += (c > 0u) ? 1u : 0u; mine = (j == x) ? c : mine; }
        if (sum == G) break;
        __builtin_amdgcn_s_sleep(1);
        if ((++sp & 255u) == 0u) { if (xb_ld(&bar[XB_TMO])) break; if (sp > XB_SPIN_CAP) { atomicAdd(&bar[XB_TMO], 1u); break; } }
    }
    nloc = mine > 0u ? mine : 1u; nx = cnt > 0u ? cnt : 1u;
}
__device__ __forceinline__ void xcd_barrier(const XcdBarrier& b) {
    asm volatile("s_waitcnt vmcnt(0)" ::: "memory");
    __syncthreads();
    if (threadIdx.x == 0) {
        unsigned* bar = b.bar;
        __builtin_amdgcn_s_waitcnt(0);
        unsigned nloc = b.st[0], nx = b.st[1];
        if (nloc == 0u) { xcd_barrier_complete(bar, b.x, nloc, nx); b.st[0] = nloc; b.st[1] = nx; }
        const unsigned old = xb_add(&bar[XB_XSUB(b.x)], 1u);
        const unsigned gen = old / nloc;
        if (old + 1u == (gen + 1u) * nloc) {
            __builtin_amdgcn_fence(__ATOMIC_RELEASE, "agent");
            asm volatile("s_waitcnt vmcnt(0)" ::: "memory");
            const unsigned og = xb_add(&bar[XB_TOP], 1u);
            const unsigned tg = og / nx;
            if (og + 1u == (tg + 1u) * nx) xb_add(&bar[XB_TOPGEN], 1u);
            else XB_SPIN(xb_ld(&bar[XB_TOPGEN]) == tg, bar);
            __builtin_amdgcn_fence(__ATOMIC_ACQUIRE, "agent");
            xb_add(&bar[XB_XGEN(b.x)], 1u);
            asm volatile("s_waitcnt vmcnt(0)" ::: "memory");
        } else {
            XB_SPIN(xb_ld(&bar[XB_XGEN(b.x)]) == gen, bar);
            __builtin_amdgcn_fence(__ATOMIC_ACQUIRE, "agent");
            asm volatile("s_waitcnt vmcnt(0)" ::: "memory");
        }
    }
    __syncthreads();
}

struct Args {
    const float* in[30];
    float* out;
    unsigned char* ws;
    int ph_lo, ph_hi;
};

struct Frame {
    LAS unsigned char* lds;
    int tid, lane, wave, G;
    const float* const* in;
    float* out;
    unsigned char* ws;
    bf16_t* PROJ; bf16_t* HALO; float* SMALL; bf16_t* XN; bf16_t* PB;
    float *SS1, *SS2, *SS3;
};

constexpr int NWAVES = 8;
constexpr int RING_BYTES = 131072, MISC_OFF = RING_BYTES + 320, LDS_BYTES = 147456;

struct EpiInProj {
    static constexpr bool PERM = true;
    bf16_t* PROJ; bf16_t* HALO; float* SMALL;
    __device__ __forceinline__ void operator()(const f32x4 (&acc)[2][2][4][2], const Unit& u, int wr, int wc, int fr, int fq) const {
        const int row0 = u.pm * 256 + wr * 64 + fr;
        if (u.pn < 44) {
            const int col0 = u.pn * 256 + wc * 32 + 8 * fq;
            const bool conv_tile = (u.pn >= 8 && u.pn < 32);
#pragma unroll
            for (int ai = 0; ai < 2; ++ai)
#pragma unroll
                for (int m = 0; m < 4; ++m) {
                    const int row = row0 + ai * 128 + m * 16;
                    bf16_t* rowp = PROJ + (size_t)row * LDP + col0;
#pragma unroll
                    for (int bj = 0; bj < 2; ++bj) {
                        const f32x4 v0 = acc[ai][bj][m][0], v1 = acc[ai][bj][m][1];
                        u32x4 w; w.x = cvt_pk_bf16(v0[0], v0[1]); w.y = cvt_pk_bf16(v0[2], v0[3]); w.z = cvt_pk_bf16(v1[0], v1[1]); w.w = cvt_pk_bf16(v1[2], v1[3]);
                        *(u32x4*)(rowp + bj * 128) = w;
                        if (m == 3 && conv_tile && fr >= 13) {
                            bf16_t* hp = HALO + ((size_t)(row >> 6) * 3 + (fr - 13)) * NCH + (col0 - C_XS) + bj * 128;
                            *(u32x4*)hp = w;
                        }
                    }
                }
        } else {
            if (wc < 2) {
                const int col0 = wc * 32 + 8 * fq;
#pragma unroll
                for (int ai = 0; ai < 2; ++ai)
#pragma unroll
                    for (int m = 0; m < 4; ++m) {
                        const int row = row0 + ai * 128 + m * 16;
                        float* sp = SMALL + (size_t)row * 64 + col0;
                        *(f32x4*)sp = acc[ai][0][m][0]; *(f32x4*)(sp + 4) = acc[ai][0][m][1];
                    }
            }
        }
    }
};

struct EpiT1 {
    static constexpr bool PERM = true;
    bf16_t* PROJ;
    __device__ __forceinline__ void operator()(const f32x4 (&acc)[2][2][4][2], const Unit& u, int wr, int wc, int fr, int fq) const {
        const int row0 = u.pm * 256 + wr * 64 + fr, col0 = u.pn * 256 + wc * 32 + 8 * fq;
#pragma unroll
        for (int ai = 0; ai < 2; ++ai)
#pragma unroll
            for (int m = 0; m < 4; ++m) {
                const int row = row0 + ai * 128 + m * 16;
#pragma unroll
                for (int bj = 0; bj < 2; ++bj) {
                    const int col = col0 + bj * 128;
                    const u32x4 mgw = *(const u32x4*)(PROJ + (size_t)row * LDP + C_MG + col);
                    float mg[8]; unpack8(mgw, mg);
                    const f32x4 v0 = acc[ai][bj][m][0], v1 = acc[ai][bj][m][1];
                    f32x4 o0, o1;
#pragma unroll
                    for (int i = 0; i < 4; ++i) { o0[i] = v0[i] * sigmoidf_(mg[i]); o1[i] = v1[i] * sigmoidf_(mg[4 + i]); }
                    float* tp = (float*)PROJ + (size_t)row * LDF + col;
                    *(f32x4*)tp = o0; *(f32x4*)(tp + 4) = o1;
                }
            }
    }
};

struct EpiMix {
    static constexpr bool PERM = true;
    bf16_t* PROJ;
    __device__ __forceinline__ void operator()(const f32x4 (&acc)[2][2][4][2], const Unit& u, int wr, int wc, int fr, int fq) const {
        const int row0 = u.pm * 256 + wr * 64 + fr, col0 = u.pn * 256 + wc * 32 + 8 * fq;
#pragma unroll
        for (int ai = 0; ai < 2; ++ai)
#pragma unroll
            for (int m = 0; m < 4; ++m) {
                const int row = row0 + ai * 128 + m * 16;
#pragma unroll
                for (int bj = 0; bj < 2; ++bj) {
                    const int col = col0 + bj * 128;
                    const u32x4 mgw = *(const u32x4*)(PROJ + (size_t)row * LDP + C_MG + 1024 + col);
                    float mg[8]; unpack8(mgw, mg);
                    const float* tp = (const float*)PROJ + (size_t)row * LDF + col;
                    const f32x4 t0 = *(const f32x4*)tp, t1 = *(const f32x4*)(tp + 4);
                    const f32x4 v0 = acc[ai][bj][m][0], v1 = acc[ai][bj][m][1];
                    float o[8];
#pragma unroll
                    for (int i = 0; i < 4; ++i) { o[i] = t0[i] + v0[i] * sigmoidf_(mg[i]); o[4 + i] = t1[i] + v1[i] * sigmoidf_(mg[4 + i]); }
                    *(u32x4*)(PROJ + (size_t)row * LDP + C_Q + col) = pack8(o);
                }
            }
    }
};

template <int MODE> struct EpiResid {
    static constexpr bool PERM = true;
    bf16_t* PROJ; const float* xp; const float* xs; int res_col  , dst_col  , dstb_col; float* SS;
    __device__ __forceinline__ void operator()(const f32x4 (&acc)[2][2][4][2], const Unit& u, int wr, int wc, int fr, int fq) const {
        const int row0 = u.pm * 256 + wr * 64 + fr, col0 = u.pn * 256 + wc * 32 + 8 * fq;
#pragma unroll
        for (int ai = 0; ai < 2; ++ai)
#pragma unroll
            for (int m = 0; m < 4; ++m) {
                const int row = row0 + ai * 128 + m * 16;
                float ss = 0.f;
#pragma unroll
                for (int bj = 0; bj < 2; ++bj) {
                    const int col = col0 + bj * 128;
                    f32x4 r0 = (f32x4){0.f, 0.f, 0.f, 0.f}, r1 = r0;
                    if (MODE == 0) {
                        if (row < MTOT) { const float* rp = (row < MPR ? xp + (size_t)row * D : xs + (size_t)(row - MPR) * D) + col; r0 = *(const f32x4*)rp; r1 = *(const f32x4*)(rp + 4); }
                    } else {
                        const float* rp = (const float*)(PROJ + res_col) + (size_t)row * LDF + col; r0 = *(const f32x4*)rp; r1 = *(const f32x4*)(rp + 4);
                    }
                    const f32x4 x0 = r0 + acc[ai][bj][m][0], x1 = r1 + acc[ai][bj][m][1];
                    float* dp = (float*)(PROJ + dst_col) + (size_t)row * LDF + col;
                    *(f32x4*)dp = x0; *(f32x4*)(dp + 4) = x1;
                    u32x4 w; w.x = cvt_pk_bf16(x0[0], x0[1]); w.y = cvt_pk_bf16(x0[2], x0[3]); w.z = cvt_pk_bf16(x1[0], x1[1]); w.w = cvt_pk_bf16(x1[2], x1[3]);
                    *(u32x4*)(PROJ + (size_t)row * LDP + dstb_col + col) = w;
                    ss += (x0[0] * x0[0] + x0[1] * x0[1]) + (x0[2] * x0[2] + x0[3] * x0[3]) + (x1[0] * x1[0] + x1[1] * x1[1]) + (x1[2] * x1[2] + x1[3] * x1[3]);
                }
                ss += __shfl_xor(ss, 16); ss += __shfl_xor(ss, 32);
                if (fq == 0) atomicAdd(SS + row, ss);
            }
    }
};

struct EpiSwiGLU {
    static constexpr bool PERM = true;
    bf16_t* PROJ; const float* SS;
    __device__ __forceinline__ void operator()(const f32x4 (&acc)[2][2][4][2], const Unit& u, int wr, int wc, int fr, int fq) const {
        const int row0 = u.pm * 256 + wr * 64 + fr, col0 = u.pn * 128 + wc * 32 + 8 * fq;
#pragma unroll
        for (int ai = 0; ai < 2; ++ai)
#pragma unroll
            for (int m = 0; m < 4; ++m) {
                const int row = row0 + ai * 128 + m * 16;
                const float r = rsqrtf(SS[row] * (1.0f / D) + EPS);
                const f32x4 g0 = acc[ai][0][m][0], g1 = acc[ai][0][m][1], u0 = acc[ai][1][m][0], u1 = acc[ai][1][m][1];
                float o[8];
#pragma unroll
                for (int i = 0; i < 4; ++i) { o[i] = siluf_(r * g0[i]) * (r * u0[i]); o[4 + i] = siluf_(r * g1[i]) * (r * u1[i]); }
                *(u32x4*)(PROJ + (size_t)row * LDP + C_XS + col0) = pack8(o);
            }
    }
};

struct EpiPE {
    static constexpr bool PERM = true;
    bf16_t* PROJ;
    __device__ __forceinline__ void operator()(const f32x4 (&acc)[2][2][4][2], const Unit& u, int wr, int wc, int fr, int fq) const {
        const int row0 = u.pm * 256 + wr * 64 + fr, col0 = u.pn * 256 + wc * 32 + 8 * fq;
#pragma unroll
        for (int ai = 0; ai < 2; ++ai)
#pragma unroll
            for (int m = 0; m < 4; ++m) {
                const int row = row0 + ai * 128 + m * 16;
#pragma unroll
                for (int bj = 0; bj < 2; ++bj) {
                    float* tp = (float*)PROJ + (size_t)row * LDF + col0 + bj * 128;
                    *(f32x4*)tp = acc[ai][bj][m][0]; *(f32x4*)(tp + 4) = acc[ai][bj][m][1];
                }
            }
    }
};

struct EpiX3 {
    static constexpr bool PERM = true;
    bf16_t* PROJ; const float* SS2; float* SS3; float* out;
    __device__ __forceinline__ void operator()(const f32x4 (&acc)[2][2][4][2], const Unit& u, int wr, int wc, int fr, int fq) const {
        const int row0 = u.pm * 256 + wr * 64 + fr, col0 = u.pn * 256 + wc * 32 + 8 * fq;
#pragma unroll
        for (int ai = 0; ai < 2; ++ai)
#pragma unroll
            for (int m = 0; m < 4; ++m) {
                const int row = row0 + ai * 128 + m * 16;
                const float r = rsqrtf(SS2[row] * (1.0f / D) + EPS);
                float ss = 0.f;
#pragma unroll
                for (int bj = 0; bj < 2; ++bj) {
                    const int col = col0 + bj * 128;
                    const float* x2p = (const float*)(PROJ + C_MG) + (size_t)row * LDF + col;
                    const float* pep = (const float*)PROJ + (size_t)row * LDF + col;
                    const f32x4 a0 = *(const f32x4*)x2p, a1 = *(const f32x4*)(x2p + 4), p0 = *(const f32x4*)pep, p1 = *(const f32x4*)(pep + 4);
                    const f32x4 v0 = acc[ai][bj][m][0], v1 = acc[ai][bj][m][1];
                    f32x4 x0, x1;
#pragma unroll
                    for (int i = 0; i < 4; ++i) { x0[i] = a0[i] + p0[i] * sigmoidf_(r * v0[i]); x1[i] = a1[i] + p1[i] * sigmoidf_(r * v1[i]); }
                    if (row < MTOT) { float* op = out + (row < MPR ? O_Y + (size_t)row * D : O_YS + (size_t)(row - MPR) * D) + col; *(f32x4*)op = x0; *(f32x4*)(op + 4) = x1; }
                    ss += (x0[0] * x0[0] + x0[1] * x0[1]) + (x0[2] * x0[2] + x0[3] * x0[3]) + (x1[0] * x1[0] + x1[1] * x1[1]) + (x1[2] * x1[2] + x1[3] * x1[3]);
                }
                ss += __shfl_xor(ss, 16); ss += __shfl_xor(ss, 32);
                if (fq == 0) atomicAdd(SS3 + row, ss);
            }
    }
};

struct MapIdent { __device__ __forceinline__ int operator()(int n) const { return n; } };
struct MapWin {
    __device__ __forceinline__ int operator()(int n) const {
        if (n < 5120) return n;
        if (n < 9216) return n + 32;
        if (n < 11264) return n + 48;
        const int j = n - 11264;
        if (j < 32) return 5120 + j;
        if (j < 48) return 9216 + j;
        return -1;
    }
};
struct MapFfn {
    __device__ __forceinline__ int operator()(int n) const { const int j = n >> 8, r = n & 255; return r < 128 ? 128 * j + r : DFF + 128 * j + (r - 128); }
};
template <class Map>
__device__ __forceinline__ void transpose_item(const float* W, int K, int Nsrc, int Ndst, bf16_t* WT, const float* gain, LAS float* scr, int item, int lane, Map map) {
    const int nblk = Ndst / 32, kb = item / nblk, nb = item % nblk, k0 = 64 * kb, n0 = 32 * nb;
    const int sc = map(n0 + (lane & 31));
#pragma unroll 8
    for (int i = 0; i < 32; ++i) { const int kk = 2 * i + (lane >> 5); float v = sc >= 0 ? W[(size_t)(k0 + kk) * Nsrc + sc] : 0.f; if (gain) v *= gain[k0 + kk]; scr[kk * 33 + (lane & 31)] = v; }
    asm volatile("s_waitcnt lgkmcnt(0)" ::: "memory");
    const int c = lane & 7;
#pragma unroll
    for (int j = 0; j < 4; ++j) { const int n = (lane >> 3) + 8 * j; const LAS float* s = scr + (8 * c) * 33 + n;
        u32x4 o; o.x = cvt_pk_bf16(s[0 * 33], s[1 * 33]); o.y = cvt_pk_bf16(s[2 * 33], s[3 * 33]); o.z = cvt_pk_bf16(s[4 * 33], s[5 * 33]); o.w = cvt_pk_bf16(s[6 * 33], s[7 * 33]);
        *(u32x4*)(WT + (size_t)(n0 + n) * K + k0 + 8 * c) = o; }
    asm volatile("s_waitcnt lgkmcnt(0)" ::: "memory");
}

__device__ __forceinline__ void p0_prologue(Frame& F) {
    LAS float* scr = (LAS float*)(F.lds + F.wave * 16384);
    const int gw = blockIdx.x * NWAVES + F.wave, NGW = F.G * NWAVES;
    unsigned char* ws = F.ws;
    constexpr int I_WIN = 16 * (NPROJ / 32), I_WBS = 32 * 32, I_WBG = 16 * 32, I_WOUT = 16 * 32, I_WFI = 16 * (2 * DFF / 32), I_WFO = (DFF / 64) * 32, I_WPG = 16 * 32, I_WPP = 4 * 32;
    constexpr int NITEMS = I_WIN + I_WBS + I_WBG + I_WOUT + I_WFI + I_WFO + I_WPG + I_WPP;
    for (int it = gw; it < NITEMS; it += NGW) {
        int r = it;
        if (r < I_WIN) { transpose_item(F.in[9], D, NIN, NPROJ, (bf16_t*)(ws + WS_WIN), nullptr, scr, r, F.lane, MapWin()); continue; } r -= I_WIN;
        if (r < I_WBS) { transpose_item(F.in[20], 2048, D, D, (bf16_t*)(ws + WS_WBS), nullptr, scr, r, F.lane, MapIdent()); continue; } r -= I_WBS;
        if (r < I_WBG) { transpose_item(F.in[21], D, D, D, (bf16_t*)(ws + WS_WBG), nullptr, scr, r, F.lane, MapIdent()); continue; } r -= I_WBG;
        if (r < I_WOUT) { transpose_item(F.in[22], D, D, D, (bf16_t*)(ws + WS_WOUT), nullptr, scr, r, F.lane, MapIdent()); continue; } r -= I_WOUT;
        if (r < I_WFI) { transpose_item(F.in[24], D, 2 * DFF, 2 * DFF, (bf16_t*)(ws + WS_WFI), F.in[23], scr, r, F.lane, MapFfn()); continue; } r -= I_WFI;
        if (r < I_WFO) { transpose_item(F.in[25], DFF, D, D, (bf16_t*)(ws + WS_WFO), nullptr, scr, r, F.lane, MapIdent()); continue; } r -= I_WFO;
        if (r < I_WPG) { transpose_item(F.in[27], D, D, D, (bf16_t*)(ws + WS_WPG), F.in[26], scr, r, F.lane, MapIdent()); continue; } r -= I_WPG;
        transpose_item(F.in[28], 256, D, D, (bf16_t*)(ws + WS_WPP), nullptr, scr, r, F.lane, MapIdent());
    }
    const float* gmix = F.in[8];
    for (int m = gw; m < MP; m += NGW) {
        u32x2* o8 = (u32x2*)(F.XN + (size_t)m * D) + F.lane;
        u32x2* p8 = (u32x2*)(F.PB + (size_t)m * 256) + F.lane;
        if (m >= MTOT) {
#pragma unroll
            for (int j = 0; j < 4; ++j) o8[64 * j] = (u32x2){0u, 0u};
            p8[0] = (u32x2){0u, 0u};
            continue;
        }
        const float* xrow = m < MPR ? F.in[0] + (size_t)m * D : F.in[1] + (size_t)(m - MPR) * D;
        const f32x4* xr = (const f32x4*)xrow + F.lane;
        f32x4 v[4]; float s = 0.f;
#pragma unroll
        for (int j = 0; j < 4; ++j) { v[j] = xr[64 * j]; s += (v[j][0] * v[j][0] + v[j][1] * v[j][1]) + (v[j][2] * v[j][2] + v[j][3] * v[j][3]); }
        const float rs = rsqrtf(wave_sum(s) * (1.0f / D) + EPS);
#pragma unroll
        for (int j = 0; j < 4; ++j) { const f32x4 gv = ((const f32x4*)gmix)[64 * j + F.lane]; const f32x4 y = v[j] * rs * gv;
            o8[64 * j] = (u32x2){cvt_pk_bf16(y[0], y[1]), cvt_pk_bf16(y[2], y[3])}; }
        const float* prow = m < MPR ? F.in[2] + (size_t)m * 256 : F.in[3] + (size_t)(m - MPR) * 256;
        const f32x4 pv = ((const f32x4*)prow)[F.lane];
        p8[0] = (u32x2){cvt_pk_bf16(pv[0], pv[1]), cvt_pk_bf16(pv[2], pv[3])};
    }
}

__device__ __forceinline__ void p2_conv(Frame& F) {
    const int gt = blockIdx.x * (NWAVES * 64) + F.tid, NT = F.G * NWAVES * 64;
    constexpr int NCG = NCH / 8;
    constexpr int NU_P = (MPR / 64) * NCG, NU_S = NSMP * NCG;
    for (int u = gt; u < NU_P + NU_S; u += NT) {
        const bool smp = u >= NU_P;
        const int uu = smp ? u - NU_P : u;
        const int ch = uu / NCG, cgi = uu % NCG;
        const bool is_ssm = cgi < 384;
        const int cc = is_ssm ? cgi * 8 : (cgi - 384) * 8;
        const int kind = is_ssm ? 0 : 1 + (cgi - 384) / 128;
        const float* cw = is_ssm ? F.in[10] : F.in[16];
        float w[4][8], bias[8];
#pragma unroll
        for (int j = 0; j < 4; ++j) { const f32x4 a = *(const f32x4*)(cw + j * 3072 + cc), b = *(const f32x4*)(cw + j * 3072 + cc + 4);
#pragma unroll
            for (int i = 0; i < 4; ++i) { w[j][i] = a[i]; w[j][4 + i] = b[i]; } }
        if (is_ssm) { const f32x4 a = *(const f32x4*)(F.in[11] + cc), b = *(const f32x4*)(F.in[11] + cc + 4);
#pragma unroll
            for (int i = 0; i < 4; ++i) { bias[i] = a[i]; bias[4 + i] = b[i]; } }
        else {
#pragma unroll
            for (int i = 0; i < 8; ++i) bias[i] = 0.f; }
        float h0[8], h1[8], h2[8];
        const int pcol = C_XS + cgi * 8;
        if (smp) {
            const float* st = (is_ssm ? F.in[5] : F.in[7]) + (size_t)ch * 3 * 3072 + cc;
#pragma unroll
            for (int i = 0; i < 8; ++i) { h0[i] = st[i]; h1[i] = st[3072 + i]; h2[i] = st[2 * 3072 + i]; }
            bf16_t* rp = F.PROJ + (size_t)(MPR + ch) * LDP + pcol;
            float x[8]; unpack8(*(const u32x4*)rp, x);
            float o[8]; float ss = 0.f;
#pragma unroll
            for (int i = 0; i < 8; ++i) { float v = w[0][i] * h0[i] + w[1][i] * h1[i] + w[2][i] * h2[i] + w[3][i] * x[i] + bias[i]; v = siluf_(v); o[i] = v; ss += v * v; }
            if (kind == 1 || kind == 2) {
                ss += __shfl_xor(ss, 1); ss += __shfl_xor(ss, 2); ss += __shfl_xor(ss, 4); ss += __shfl_xor(ss, 8);
                const float rn = rsqrtf(ss + EPS) * (kind == 1 ? 0.08838834764831845f : 1.0f);
#pragma unroll
                for (int i = 0; i < 8; ++i) o[i] *= rn;
            }
            *(u32x4*)rp = pack8(o);
            float* ns = F.out + (is_ssm ? O_SCONVS : O_GCONVS) + (size_t)ch * 3 * 3072 + cc;
#pragma unroll
            for (int i = 0; i < 8; ++i) { ns[i] = h1[i]; ns[3072 + i] = h2[i]; ns[2 * 3072 + i] = x[i]; }
            continue;
        }
        const int rowbase = ch * 64, t0 = rowbase & (SEQ - 1);
        if (t0 == 0) {
#pragma unroll
            for (int i = 0; i < 8; ++i) { h0[i] = 0.f; h1[i] = 0.f; h2[i] = 0.f; }
        } else {
            const bf16_t* hp = F.HALO + (size_t)(ch - 1) * 3 * NCH + cgi * 8;
            unpack8(*(const u32x4*)hp, h0); unpack8(*(const u32x4*)(hp + NCH), h1); unpack8(*(const u32x4*)(hp + 2 * NCH), h2);
        }
        const bool lastc = (t0 == SEQ - 64);
        float* ns = F.out + (is_ssm ? O_SCONVP : O_GCONVP) + (size_t)(rowbase >> 11) * 3 * 3072 + cc;
        bf16_t* rp = F.PROJ + (size_t)rowbase * LDP + pcol;
        for (int rb = 0; rb < 64; rb += 8) {
            u32x4 raw[8];
#pragma unroll
            for (int r = 0; r < 8; ++r) raw[r] = *(const u32x4*)(rp + (size_t)(rb + r) * LDP);
#pragma unroll
            for (int r = 0; r < 8; ++r) {
                float x[8]; unpack8(raw[r], x);
                float o[8]; float ss = 0.f;
#pragma unroll
                for (int i = 0; i < 8; ++i) { float v = w[0][i] * h0[i] + w[1][i] * h1[i] + w[2][i] * h2[i] + w[3][i] * x[i] + bias[i]; v = siluf_(v); o[i] = v; ss += v * v; }
                if (kind == 1 || kind == 2) {
                    ss += __shfl_xor(ss, 1); ss += __shfl_xor(ss, 2); ss += __shfl_xor(ss, 4); ss += __shfl_xor(ss, 8);
                    const float rn = rsqrtf(ss + EPS) * (kind == 1 ? 0.08838834764831845f : 1.0f);
#pragma unroll
                    for (int i = 0; i < 8; ++i) o[i] *= rn;
                }
                *(u32x4*)(rp + (size_t)(rb + r) * LDP) = pack8(o);
                if (lastc && rb == 56 && r >= 5) {
#pragma unroll
                    for (int i = 0; i < 8; ++i) ns[(r - 5) * 3072 + i] = x[i];
                }
#pragma unroll
                for (int i = 0; i < 8; ++i) { h0[i] = h1[i]; h1[i] = h2[i]; h2[i] = x[i]; }
            }
        }
    }
}

__device__ __forceinline__ void ssd_item(Frame& F, int item) {
    const bool smp = item >= NBATCH * 32;
    const int sq = smp ? (item - NBATCH * 32) >> 5 : item >> 5, h = item & 31, g = h >> 3;
    const int row0 = smp ? MPR + sq : sq * SEQ, T = smp ? 1 : SEQ;
    const int tid = F.tid, p = tid >> 3, nq = tid & 7;
    LAS bf16_t* Bs = (LAS bf16_t*)(F.lds);
    LAS bf16_t* Cs = (LAS bf16_t*)(F.lds + 16384);
    LAS bf16_t* Xs = (LAS bf16_t*)(F.lds + 32768);
    LAS float* dts = (LAS float*)(F.lds + 40960);
    LAS float* decs = (LAS float*)(F.lds + 41216);
    LAS float* Ys = (LAS float*)(F.lds + 41472);
    float hst[16];
    if (smp) {
        const float* sp = F.in[4] + ((size_t)(sq * 32 + h) * 64 + p) * 128 + nq * 16;
#pragma unroll
        for (int i = 0; i < 4; ++i) { const f32x4 v = ((const f32x4*)sp)[i]; hst[4 * i] = v[0]; hst[4 * i + 1] = v[1]; hst[4 * i + 2] = v[2]; hst[4 * i + 3] = v[3]; }
    } else {
#pragma unroll
        for (int i = 0; i < 16; ++i) hst[i] = 0.f;
    }
    const float a_h = -__expf(F.in[13][h]), dtb = F.in[12][h], Dh = F.in[14][h];
    for (int tb = 0; tb < T; tb += 64) {
        const int rows = (T - tb) < 64 ? (T - tb) : 64;
#pragma unroll
        for (int i = 0; i < 2; ++i) {
            const int pc = tid + i * 512, r = pc >> 4, c8 = (pc & 15) * 8;
            if (r < rows) {
                const bf16_t* src = F.PROJ + (size_t)(row0 + tb + r) * LDP;
                *(LAS u32x4*)(Bs + r * 128 + c8) = *(const u32x4*)(src + C_B + g * 128 + c8);
                *(LAS u32x4*)(Cs + r * 128 + c8) = *(const u32x4*)(src + C_C + g * 128 + c8);
            }
        }
        { const int r = tid >> 3, c8 = (tid & 7) * 8;
          if (r < rows) *(LAS u32x4*)(Xs + r * 64 + c8) = *(const u32x4*)(F.PROJ + (size_t)(row0 + tb + r) * LDP + C_XS + h * 64 + c8); }
        if (tid < rows) { const float dt = softplusf_(F.SMALL[(size_t)(row0 + tb + tid) * 64 + h] + dtb); dts[tid] = dt; decs[tid] = __expf(dt * a_h); }
        __syncthreads();
        for (int tt = 0; tt < rows; ++tt) {
            const float xv = bf2f(Xs[tt * 64 + p]), dtv = dts[tt], dc = decs[tt], dx = dtv * xv;
            float bv[16], cv[16];
            { float t8[8]; unpack8(*(const LAS u32x4*)(Bs + tt * 128 + nq * 16), t8);
#pragma unroll
              for (int i = 0; i < 8; ++i) bv[i] = t8[i];
              unpack8(*(const LAS u32x4*)(Bs + tt * 128 + nq * 16 + 8), t8);
#pragma unroll
              for (int i = 0; i < 8; ++i) bv[8 + i] = t8[i];
              unpack8(*(const LAS u32x4*)(Cs + tt * 128 + nq * 16), t8);
#pragma unroll
              for (int i = 0; i < 8; ++i) cv[i] = t8[i];
              unpack8(*(const LAS u32x4*)(Cs + tt * 128 + nq * 16 + 8), t8);
#pragma unroll
              for (int i = 0; i < 8; ++i) cv[8 + i] = t8[i]; }
            float yp = 0.f;
#pragma unroll
            for (int i = 0; i < 16; ++i) { hst[i] = dc * hst[i] + dx * bv[i]; yp += cv[i] * hst[i]; }
            yp += __shfl_xor(yp, 1); yp += __shfl_xor(yp, 2); yp += __shfl_xor(yp, 4);
            if (nq == 0) Ys[tt * 64 + p] = yp + Dh * xv;
        }
        __syncthreads();
        { const int r = tid >> 3, c8 = (tid & 7) * 8;
          if (r < rows) { float o[8];
#pragma unroll
              for (int i = 0; i < 8; ++i) o[i] = Ys[r * 64 + c8 + i];
              *(u32x4*)(F.PROJ + (size_t)(row0 + tb + r) * LDP + C_XS + h * 64 + c8) = pack8(o); } }
        __syncthreads();
    }
    float* op = F.out + (smp ? O_SSMS : O_SSMP) + ((size_t)(sq * 32 + h) * 64 + p) * 128 + nq * 16;
#pragma unroll
    for (int i = 0; i < 4; ++i) ((f32x4*)op)[i] = (f32x4){hst[4 * i], hst[4 * i + 1], hst[4 * i + 2], hst[4 * i + 3]};
}

__device__ __forceinline__ void gdn_item(Frame& F, int item) {
    const bool smp = item >= NBATCH * 32;
    const int sq = smp ? (item - NBATCH * 32) >> 5 : item >> 5, h = (item >> 2) & 7, dvq = item & 3;
    const int row0 = smp ? MPR + sq : sq * SEQ, T = smp ? 1 : SEQ;
    const int tid = F.tid, e = tid >> 4, kg = tid & 15;
    LAS bf16_t* Qs = (LAS bf16_t*)(F.lds);
    LAS bf16_t* Ks = (LAS bf16_t*)(F.lds + 16384);
    LAS bf16_t* Vs = (LAS bf16_t*)(F.lds + 32768);
    LAS float* egs = (LAS float*)(F.lds + 36864);
    LAS float* bts = (LAS float*)(F.lds + 37120);
    LAS float* Os = (LAS float*)(F.lds + 37376);
    float S[8];
    const size_t sbase = ((size_t)(sq * 8 + h) * 128 + kg * 8) * 128 + dvq * 32 + e;
    if (smp) {
#pragma unroll
        for (int j = 0; j < 8; ++j) S[j] = F.in[6][sbase + (size_t)j * 128];
    } else {
#pragma unroll
        for (int j = 0; j < 8; ++j) S[j] = 0.f;
    }
    const float na = -__expf(F.in[18][h]), dtb = F.in[17][h];
    for (int tb = 0; tb < T; tb += 64) {
        const int rows = (T - tb) < 64 ? (T - tb) : 64;
#pragma unroll
        for (int i = 0; i < 2; ++i) {
            const int pc = tid + i * 512, r = pc >> 4, c8 = (pc & 15) * 8;
            if (r < rows) {
                const bf16_t* src = F.PROJ + (size_t)(row0 + tb + r) * LDP;
                *(LAS u32x4*)(Qs + r * 128 + c8) = *(const u32x4*)(src + C_Q + h * 128 + c8);
                *(LAS u32x4*)(Ks + r * 128 + c8) = *(const u32x4*)(src + C_K + h * 128 + c8);
            }
        }
        if (tid < 256) { const int r = tid >> 2, c8 = (tid & 3) * 8;
          if (r < rows) *(LAS u32x4*)(Vs + r * 32 + c8) = *(const u32x4*)(F.PROJ + (size_t)(row0 + tb + r) * LDP + C_V + h * 128 + dvq * 32 + c8); }
        if (tid < rows) { const float* sm = F.SMALL + (size_t)(row0 + tb + tid) * 64;
            egs[tid] = __expf(na * softplusf_(sm[40 + h] + dtb)); bts[tid] = sigmoidf_(sm[32 + h]); }
        __syncthreads();
        for (int tt = 0; tt < rows; ++tt) {
            float k8[8], q8[8];
            unpack8(*(const LAS u32x4*)(Ks + tt * 128 + kg * 8), k8);
            unpack8(*(const LAS u32x4*)(Qs + tt * 128 + kg * 8), q8);
            const float eg = egs[tt], bt = bts[tt], v = bf2f(Vs[tt * 32 + e]);
            float ks = 0.f;
#pragma unroll
            for (int j = 0; j < 8; ++j) ks += k8[j] * S[j];
            ks += __shfl_xor(ks, 1); ks += __shfl_xor(ks, 2); ks += __shfl_xor(ks, 4); ks += __shfl_xor(ks, 8);
            const float vn = bt * (v - eg * ks);
            float op = 0.f;
#pragma unroll
            for (int j = 0; j < 8; ++j) { S[j] = eg * S[j] + k8[j] * vn; op += q8[j] * S[j]; }
            op += __shfl_xor(op, 1); op += __shfl_xor(op, 2); op += __shfl_xor(op, 4); op += __shfl_xor(op, 8);
            if (kg == 0) Os[tt * 32 + e] = op;
        }
        __syncthreads();
        if (tid < 256) { const int r = tid >> 2, c8 = (tid & 3) * 8;
          if (r < rows) { float o[8];
#pragma unroll
              for (int i = 0; i < 8; ++i) o[i] = Os[r * 32 + c8 + i];
              *(u32x4*)(F.PROJ + (size_t)(row0 + tb + r) * LDP + C_V + h * 128 + dvq * 32 + c8) = pack8(o); } }
        __syncthreads();
    }
    float* op = F.out + (smp ? O_GDNS : O_GDNP);
#pragma unroll
    for (int j = 0; j < 8; ++j) op[sbase + (size_t)j * 128] = S[j];
}

__device__ __forceinline__ void p3_scan(Frame& F) {
    constexpr int NSSD = NBATCH * 32 + NSMP * 32, NGDN = NBATCH * 32 + NSMP * 32;
    for (int it = blockIdx.x; it < NSSD; it += F.G) ssd_item(F, it);
    for (int it = blockIdx.x; it < NGDN; it += F.G) gdn_item(F, it);
}

__device__ __forceinline__ void p4_norm(Frame& F) {
    const int gw = blockIdx.x * NWAVES + F.wave, NGW = F.G * NWAVES, lane = F.lane;
    const float* gs = F.in[15]; const float* gg = F.in[19];
    for (int m = gw; m < MTOT; m += NGW) {
        bf16_t* row = F.PROJ + (size_t)m * LDP;
#pragma unroll
        for (int g = 0; g < 4; ++g) {
            const int c = g * 512 + lane * 8;
            float y[8], z[8]; unpack8(*(const u32x4*)(row + C_XS + c), y); unpack8(*(const u32x4*)(row + C_Z + c), z);
            float ss = 0.f;
#pragma unroll
            for (int i = 0; i < 8; ++i) { y[i] *= siluf_(z[i]); ss += y[i] * y[i]; }
            const float r = rsqrtf(wave_sum(ss) * (1.0f / 512.0f) + EPS);
            const f32x4 g0 = *(const f32x4*)(gs + c), g1 = *(const f32x4*)(gs + c + 4);
#pragma unroll
            for (int i = 0; i < 4; ++i) { y[i] *= r * g0[i]; y[4 + i] *= r * g1[i]; }
            *(u32x4*)(row + C_XS + c) = pack8(y);
        }
#pragma unroll
        for (int hh = 0; hh < 2; ++hh) {
            const int c = hh * 512 + lane * 8;
            float o[8], gt[8]; unpack8(*(const u32x4*)(row + C_V + c), o); unpack8(*(const u32x4*)(row + C_GATE + c), gt);
            float ss = 0.f;
#pragma unroll
            for (int i = 0; i < 8; ++i) ss += o[i] * o[i];
            ss += __shfl_xor(ss, 1); ss += __shfl_xor(ss, 2); ss += __shfl_xor(ss, 4); ss += __shfl_xor(ss, 8);
            const float r = rsqrtf(ss * (1.0f / 128.0f) + EPS);
            const int e = (lane & 15) * 8;
            const f32x4 g0 = *(const f32x4*)(gg + e), g1 = *(const f32x4*)(gg + e + 4);
#pragma unroll
            for (int i = 0; i < 4; ++i) { o[i] = o[i] * r * g0[i] * siluf_(gt[i]); o[4 + i] = o[4 + i] * r * g1[i] * siluf_(gt[4 + i]); }
            *(u32x4*)(row + C_V + c) = pack8(o);
        }
    }
}

__device__ __forceinline__ void p12_final(Frame& F) {
    const int gw = blockIdx.x * NWAVES + F.wave, NGW = F.G * NWAVES, lane = F.lane;
    const float* gf = F.in[29];
    for (int m = gw; m < MTOT; m += NGW) {
        float* orow = F.out + (m < MPR ? O_Y + (size_t)m * D : O_YS + (size_t)(m - MPR) * D);
        const float r = rsqrtf(F.SS3[m] * (1.0f / D) + EPS);
#pragma unroll
        for (int j = 0; j < 4; ++j) { f32x4* p = (f32x4*)orow + 64 * j + lane; const f32x4 gv = ((const f32x4*)gf)[64 * j + lane]; *p = *p * r * gv; }
    }
}

__global__ void __launch_bounds__(NWAVES * 64, 2) mega_fwd(Args args) {
    extern __shared__ __attribute__((aligned(16))) unsigned char lds_raw[];
    Frame F;
    F.lds = (LAS unsigned char*)lds_raw;
    F.tid = threadIdx.x; F.lane = F.tid & 63; F.wave = __builtin_amdgcn_readfirstlane(F.tid >> 6); F.G = gridDim.x;
    F.in = args.in;
    F.out = args.out; F.ws = args.ws;
    unsigned char* ws = args.ws;
    F.PROJ = (bf16_t*)(ws + WS_PROJ); F.HALO = (bf16_t*)(ws + WS_HALO); F.SMALL = (float*)(ws + WS_SMALL); F.XN = (bf16_t*)(ws + WS_XN); F.PB = (bf16_t*)(ws + WS_PB);
    F.SS1 = (float*)(ws + WS_SS1); F.SS2 = (float*)(ws + WS_SS2); F.SS3 = (float*)(ws + WS_SS3);
    const int lo = args.ph_lo, hi = args.ph_hi;
#if MK_ONE_LAUNCH
    volatile LAS unsigned* MISC = (volatile LAS unsigned*)(F.lds + MISC_OFF);
    if (F.tid < 32) MISC[F.tid] = 0u;
    __syncthreads();
    XcdBarrier bar = xcd_barrier_post((unsigned*)(ws + WS_BAR), MISC + 8);
#define SEAM(k) do { if (lo <= (k) && (k) + 1 < hi) xcd_barrier(bar); } while (0)
#else
#define SEAM(k) do { } while (0)
#endif
#ifndef PHASE_MASK
#define PHASE_MASK 0xffff
#endif
#define IN(k) (((PHASE_MASK >> (k)) & 1) && lo <= (k) && (k) < hi)
    const int bid = (int)blockIdx.x;
    typedef pg8::StaticOrder SO;

    if (IN(0)) { p0_prologue(F); SEAM(0); }
    if (IN(1)) {
        pg8::Gemm g{F.XN, (const bf16_t*)(ws + WS_WIN), MP, NPROJ, D, D, D}; SO S; S.init(MP, NPROJ, F.G, bid);
        EpiInProj E{F.PROJ, F.HALO, F.SMALL};
        pg8::gemm_phase<EpiInProj, SO>(F.lds, g, S, E); SEAM(1);
    }
    if (IN(2)) { p2_conv(F); SEAM(2); }
    if (IN(3)) { p3_scan(F); SEAM(3); }
    if (IN(4)) { p4_norm(F); SEAM(4); }
    if (IN(5)) {
        pg8::Gemm g{F.PROJ + C_XS, (const bf16_t*)(ws + WS_WBS), MP, D, 2048, LDP, 2048}; SO S; S.init(MP, D, F.G, bid);
        EpiT1 E{F.PROJ};
        pg8::gemm_phase<EpiT1, SO>(F.lds, g, S, E); SEAM(5);
    }
    if (IN(6)) {
        pg8::Gemm g{F.PROJ + C_V, (const bf16_t*)(ws + WS_WBG), MP, D, D, LDP, D}; SO S; S.init(MP, D, F.G, bid);
        EpiMix E{F.PROJ};
        pg8::gemm_phase<EpiMix, SO>(F.lds, g, S, E); SEAM(6);
    }
    if (IN(7)) {
        pg8::Gemm g{F.PROJ + C_Q, (const bf16_t*)(ws + WS_WOUT), MP, D, D, LDP, D}; SO S; S.init(MP, D, F.G, bid);
        EpiResid<0> E{F.PROJ, F.in[0], F.in[1], 0, C_Z, C_K, F.SS1};
        pg8::gemm_phase<EpiResid<0>, SO>(F.lds, g, S, E); SEAM(7);
    }
    if (IN(8)) {
        pg8::Gemm g{F.PROJ + C_K, (const bf16_t*)(ws + WS_WFI), MP, 2 * DFF, D, LDP, D}; SO S; S.init(MP, 2 * DFF, F.G, bid);
        EpiSwiGLU E{F.PROJ, F.SS1};
        pg8::gemm_phase<EpiSwiGLU, SO>(F.lds, g, S, E); SEAM(8);
    }
    if (IN(9)) {
        pg8::Gemm g{F.PROJ + C_XS, (const bf16_t*)(ws + WS_WFO), MP, D, DFF, LDP, DFF}; SO S; S.init(MP, D, F.G, bid);
        EpiResid<1> E{F.PROJ, nullptr, nullptr, C_Z, C_MG, C_GATE, F.SS2};
        pg8::gemm_phase<EpiResid<1>, SO>(F.lds, g, S, E); SEAM(9);
    }
    if (IN(10)) {
        pg8::Gemm g{F.PB, (const bf16_t*)(ws + WS_WPP), MP, D, 256, 256, 256}; SO S; S.init(MP, D, F.G, bid);
        EpiPE E{F.PROJ};
        pg8::gemm_phase<EpiPE, SO>(F.lds, g, S, E); SEAM(10);
    }
    if (IN(11)) {
        pg8::Gemm g{F.PROJ + C_GATE, (const bf16_t*)(ws + WS_WPG), MP, D, D, LDP, D}; SO S; S.init(MP, D, F.G, bid);
        EpiX3 E{F.PROJ, F.SS2, F.SS3, F.out};
        pg8::gemm_phase<EpiX3, SO>(F.lds, g, S, E); SEAM(11);
    }
    if (IN(12)) { p12_final(F); }
#undef IN
#undef SEAM
}

constexpr int NPHASES = 13;

extern "C" void kernel_launch(void* const* d_in, const int* in_sizes, int n_in, void* d_out, int out_size, void* d_ws, size_t ws_size, hipStream_t stream) {
    static int grid = 0;
    if (grid == 0) {
        if (n_in != 30 || ws_size < WS_END) { fprintf(stderr, "kernel_launch: bad call: n_in %d ws %zu (need %zu)\n", n_in, ws_size, (size_t)WS_END); grid = -1; return; }
        int dev = 0, cus = 0, per_cu = 0;
        if (hipGetDevice(&dev) != hipSuccess || hipDeviceGetAttribute(&cus, hipDeviceAttributeMultiprocessorCount, dev) != hipSuccess) { grid = -1; return; }
        if (hipFuncSetAttribute((const void*)mega_fwd, hipFuncAttributeMaxDynamicSharedMemorySize, LDS_BYTES) != hipSuccess) { fprintf(stderr, "kernel_launch: hipFuncSetAttribute failed\n"); grid = -1; return; }
        if (hipOccupancyMaxActiveBlocksPerMultiprocessor(&per_cu, (const void*)mega_fwd, NWAVES * 64, LDS_BYTES) != hipSuccess || per_cu < 1) { fprintf(stderr, "kernel_launch: occupancy query says %d\n", per_cu); per_cu = 1; }
        (void)hipGetLastError();
        grid = cus;
    }
    if (grid < 0) return;
    (void)hipMemsetAsync((char*)d_ws + WS_CTL, 0, CTL_BYTES, stream);
    Args a{};
    for (int i = 0; i < 30; ++i) a.in[i] = (const float*)d_in[i];
    a.out = (float*)d_out; a.ws = (unsigned char*)d_ws;
#if MK_ONE_LAUNCH
    a.ph_lo = 0; a.ph_hi = NPHASES;
    void* kargs[] = {&a};
    hipError_t e = hipLaunchCooperativeKernel((const void*)mega_fwd, dim3(grid), dim3(NWAVES * 64), kargs, LDS_BYTES, stream);
    if (e != hipSuccess) fprintf(stderr, "cooperative launch failed: %s (grid %d)\n", hipGetErrorString(e), grid);
#else
    for (int ph = 0; ph < NPHASES; ++ph) {
        a.ph_lo = ph; a.ph_hi = ph + 1;
        hipLaunchKernelGGL(mega_fwd, dim3(grid), dim3(NWAVES * 64), LDS_BYTES, stream, a);
    }
#endif
}
```

```cpp
#include <hip/hip_runtime.h>
#include <hip/hip_cooperative_groups.h>
#include <cstdio>
#include <cstdint>
namespace cg = cooperative_groups;

#ifndef MK_ONE_LAUNCH
#define MK_ONE_LAUNCH 1
#endif

#define LAS __attribute__((address_space(3)))
typedef unsigned short bf16_t;
typedef short bf16x8 __attribute__((ext_vector_type(8)));
typedef float f32x4 __attribute__((ext_vector_type(4)));
typedef float f32x2 __attribute__((ext_vector_type(2)));
typedef unsigned u32x4 __attribute__((ext_vector_type(4)));
typedef unsigned u32x2 __attribute__((ext_vector_type(2)));

constexpr int D = 1024, SEQ = 2048, NBATCH = 8, MPR = NBATCH * SEQ, NSMP = 128, MTOT = MPR + NSMP, MP = 16640;
constexpr int LDP = 11264, LDF = LDP / 2;
constexpr int C_Z = 0, C_XS = 2048, C_B = 4096, C_C = 4608, C_Q = 5120, C_K = 6144, C_V = 7168, C_GATE = 8192, C_MG = 9216;
constexpr int NIN = 11312;
constexpr int NPROJ = 11520;
constexpr int DFF = 2816;
constexpr float EPS = 1e-6f;
constexpr int NCH = 6144;

constexpr size_t O_Y = 0, O_YS = 16777216, O_SSMP = 16908288, O_SCONVP = 19005440, O_GDNP = 19079168, O_GCONVP = 20127744,
                 O_SSMS = 20201472, O_SCONVS = 53755904, O_GDNS = 54935552, O_GCONVS = 71712768;

constexpr size_t MiB = 1u << 20;
constexpr size_t WS_CTL = 0, CTL_BYTES = 1 * MiB;
constexpr size_t WS_BAR = 16384;
constexpr size_t WS_SS1 = 65536, WS_SS2 = WS_SS1 + 69632, WS_SS3 = WS_SS2 + 69632;
constexpr size_t WS_WIN = 1 * MiB, WS_WBS = 25 * MiB, WS_WBG = 29 * MiB, WS_WOUT = 31 * MiB, WS_WFI = 33 * MiB, WS_WFO = 44 * MiB, WS_WPG = 50 * MiB, WS_WPP = 52 * MiB;
constexpr size_t WS_XN = 53 * MiB, WS_PB = 86 * MiB, WS_SMALL = 95 * MiB, WS_HALO = 100 * MiB, WS_PROJ = 110 * MiB;
constexpr size_t WS_END = WS_PROJ + (size_t)MP * LDP * 2;
static_assert(WS_END <= 512 * MiB, "ws map");
static_assert(WS_SS3 + 69632 <= CTL_BYTES, "ctl");

__device__ __forceinline__ unsigned cvt_pk_bf16(float lo, float hi) { unsigned r; asm volatile("v_cvt_pk_bf16_f32 %0, %1, %2" : "=v"(r) : "v"(lo), "v"(hi)); return r; }
__device__ __forceinline__ float bflo(unsigned w) { return __uint_as_float(w << 16); }
__device__ __forceinline__ float bfhi(unsigned w) { return __uint_as_float(w & 0xffff0000u); }
__device__ __forceinline__ float bf2f(bf16_t b) { return __uint_as_float((unsigned)b << 16); }
__device__ __forceinline__ void unpack8(const u32x4 w, float (&f)[8]) { f[0] = bflo(w.x); f[1] = bfhi(w.x); f[2] = bflo(w.y); f[3] = bfhi(w.y); f[4] = bflo(w.z); f[5] = bfhi(w.z); f[6] = bflo(w.w); f[7] = bfhi(w.w); }
__device__ __forceinline__ u32x4 pack8(const float (&f)[8]) { u32x4 w; w.x = cvt_pk_bf16(f[0], f[1]); w.y = cvt_pk_bf16(f[2], f[3]); w.z = cvt_pk_bf16(f[4], f[5]); w.w = cvt_pk_bf16(f[6], f[7]); return w; }
__device__ __forceinline__ float sigmoidf_(float x) { return __builtin_amdgcn_rcpf(1.0f + __builtin_amdgcn_exp2f(-1.4426950408889634f * x)); }
__device__ __forceinline__ float siluf_(float x) { return x * sigmoidf_(x); }
__device__ __forceinline__ float softplusf_(float x) { return x > 20.f ? x : log1pf(__expf(x)); }
__device__ __forceinline__ float wave_sum(float v) {
#pragma unroll
    for (int o = 1; o < 64; o <<= 1) v += __shfl_xor(v, o);
    return v;
}

namespace pg8 {
constexpr int BM = 256, BK = 64, HALF = 128, HTB = HALF * BK * 2, STAGE_BYTES = 8 * HTB, NXCD = 8, WGM = 8;
__host__ __device__ __forceinline__ int lds_byte(int r, int c) { const int st = (r >> 4) * 2 + (c >> 5), rr = r & 15, cc = c & 31, ob = rr * 64 + cc * 2; return st * 1024 + (ob ^ (((ob >> 9) & 1) << 5)); }
__host__ __device__ __forceinline__ void stage_rc(int b, int& R, int& C) { const int st = b / 1024, sb = b % 1024, swz = sb ^ (((sb >> 9) & 1) << 5); R = (st >> 1) * 16 + swz / 64; C = (st & 1) * 32 + (swz % 64) / 2; }
__host__ __device__ __forceinline__ int perm32(int rho) { const int n = rho >> 4, i = rho & 15; return 8 * (i >> 2) + 4 * n + (i & 3); }

struct Unit { int pm, pn; };
struct Gemm { const bf16_t* A; const bf16_t* Bt; int M, N, K, lda, ldb; };

struct StaticOrder {
    int nM, nN, nwg, G, c;
    __host__ __device__ void init(int M, int N, int G_, int c_) { nM = M / BM; nN = N / BM; nwg = nM * nN; G = G_; c = c_; }
    __host__ __device__ bool next(int i, Unit& u) const {
        const long L = (long)i * G + c; if (L >= nwg) return false;
        int wgid = (int)L; { const int q = nwg / NXCD, r = nwg % NXCD, xcd = wgid % NXCD, off = wgid / NXCD; wgid = (xcd < r ? xcd * (q + 1) : r * (q + 1) + (xcd - r) * q) + off; }
        const int nig = WGM * nN, gid = wgid / nig, fm = gid * WGM, gsz = (nM - fm) < WGM ? (nM - fm) : WGM;
        u.pm = fm + ((wgid % nig) % gsz); u.pn = (wgid % nig) / gsz; return true;
    }
    __device__ __forceinline__ void a_ready(const Unit&) const {}
    __device__ __forceinline__ void done(const Unit&) const {}
};

template <class Epi, class Sched, bool ALIGN_EPI = true, bool SP2 = true>
__device__ __forceinline__ void gemm_phase(LAS unsigned char* lds, const Gemm g, const Sched& S, const Epi& E) {
    const int tid = threadIdx.x, wid = __builtin_amdgcn_readfirstlane(tid >> 6), lane = tid & 63, wr = wid >> 2, wc = wid & 3, fr = lane & 15, fq = lane >> 4;
    int nt = g.K / BK; asm volatile("" : "+s"(nt));
    unsigned voffA[2], voffB[2];
#pragma unroll
    for (int i = 0; i < 2; ++i) { int R, C; stage_rc(tid * 16 + i * 8192, R, C); const int Rb = Epi::PERM ? ((R & ~31) + perm32(R & 31)) : R;
        voffA[i] = (unsigned)(R * g.lda + C) * 2u; voffB[i] = (unsigned)(Rb * g.ldb + C) * 2u; }
    const size_t kstep = (size_t)(BK * 2);
    const size_t hstepA = (size_t)HALF * g.lda * 2, hstepB = (size_t)HALF * g.ldb * 2;
    const size_t tstepA = 2 * hstepA, tstepB = 2 * hstepB;
    const unsigned ldsw = (unsigned)wid * 1024u;
    const int aoff = lds_byte(wr * 64 + fr, fq * 8), boff = lds_byte(wc * 32 + fr, fq * 8);
#define PG8_SA(b, h) (((b) * 2 + (h)) * HTB)
#define PG8_SB(b, h) ((4 + (b) * 2 + (h)) * HTB)
#define PG8_STAGE(bufoff, gbase, voff) do { _Pragma("unroll") for (int _i = 0; _i < 2; ++_i) \
        __builtin_amdgcn_global_load_lds((const unsigned*)((const char*)(gbase) + (voff)[_i]), (LAS unsigned*)(lds + (bufoff) + ldsw + _i * 8192), 16, 0, 0); } while (0)
#define PG8_LDA(dst, b, h) do { _Pragma("unroll") for (int m = 0; m < 4; ++m) _Pragma("unroll") for (int k = 0; k < 2; ++k) dst[m][k] = *(const LAS bf16x8*)(lds + PG8_SA(b, h) + aoff + m * 2048 + k * 1024); } while (0)
#define PG8_LDB(dst, b, h) do { _Pragma("unroll") for (int n = 0; n < 2; ++n) _Pragma("unroll") for (int k = 0; k < 2; ++k) dst[n][k] = *(const LAS bf16x8*)(lds + PG8_SB(b, h) + boff + n * 2048 + k * 1024); } while (0)
#define PG8_MMA(ai, bj, At, Bt) do { __builtin_amdgcn_s_setprio(1); _Pragma("unroll") for (int m = 0; m < 4; ++m) _Pragma("unroll") for (int n = 0; n < 2; ++n) _Pragma("unroll") for (int k = 0; k < 2; ++k) \
        acc[ai][bj][m][n] = __builtin_amdgcn_mfma_f32_16x16x32_bf16(Bt[n][k], At[m][k], acc[ai][bj][m][n], 0, 0, 0); __builtin_amdgcn_s_setprio(0); } while (0)
#define PG8_WAIT_V(n) asm volatile("s_waitcnt vmcnt(" #n ")" ::: "memory")
#define PG8_WAIT_L(n) asm volatile("s_waitcnt lgkmcnt(" #n ")" ::: "memory")
#define PG8_BAR __builtin_amdgcn_s_barrier()
#define PG8_SCHED __builtin_amdgcn_sched_barrier(0)
    Unit cur, nxt; int ui = 0;
    if (!S.next(0, cur)) return;
    f32x4 acc[2][2][4][2];
#pragma unroll
    for (int a = 0; a < 2; ++a)
#pragma unroll
        for (int b = 0; b < 2; ++b)
#pragma unroll
            for (int m = 0; m < 4; ++m)
#pragma unroll
                for (int n = 0; n < 2; ++n) acc[a][b][m][n] = (f32x4){0.f, 0.f, 0.f, 0.f};
    bf16x8 At[4][2], B0[2][2], B1[2][2];
    const char* cA = (const char*)g.A + (size_t)cur.pm * tstepA; const char* cB = (const char*)g.Bt + (size_t)cur.pn * tstepB;
    S.a_ready(cur);
    if constexpr (SP2) {
        PG8_STAGE(PG8_SB(0, 0), cB, voffB); PG8_STAGE(PG8_SB(0, 1), cB + hstepB, voffB); PG8_STAGE(PG8_SA(0, 0), cA, voffA); PG8_STAGE(PG8_SA(0, 1), cA + hstepA, voffA);
        if (wr == 1) PG8_BAR;
        PG8_WAIT_V(2); PG8_BAR;
        PG8_STAGE(PG8_SB(1, 0), cB + kstep, voffB); PG8_STAGE(PG8_SA(1, 0), cA + kstep, voffA); PG8_STAGE(PG8_SB(1, 1), cB + hstepB + kstep, voffB);
        PG8_WAIT_V(6); PG8_BAR;
    } else {
        PG8_STAGE(PG8_SB(0, 0), cB, voffB); PG8_STAGE(PG8_SA(0, 0), cA, voffA); PG8_STAGE(PG8_SB(0, 1), cB + hstepB, voffB); PG8_STAGE(PG8_SA(0, 1), cA + hstepA, voffA);
        if (wr == 1) PG8_BAR;
        PG8_WAIT_V(4); PG8_BAR;
        PG8_STAGE(PG8_SB(1, 0), cB + kstep, voffB); PG8_STAGE(PG8_SA(1, 0), cA + kstep, voffA); PG8_STAGE(PG8_SB(1, 1), cB + hstepB + kstep, voffB);
        PG8_WAIT_V(6); PG8_BAR;
    }
    for (;;) {
        const bool has_next = S.next(ui + 1, nxt);
        const char* nA = has_next ? (const char*)g.A + (size_t)nxt.pm * tstepA : cA; const char* nB = has_next ? (const char*)g.Bt + (size_t)nxt.pn * tstepB : cB;
        for (int t = 0; t < nt; t += 2) {
            const bool last = (t == nt - 2);
            const char* a1 = cA + (size_t)(t + 1) * kstep;
            const char* a2 = last ? nA : cA + (size_t)(t + 2) * kstep; const char* b2 = last ? nB : cB + (size_t)(t + 2) * kstep;
            const char* a3 = a2 + kstep; const char* b3 = b2 + kstep;
            if (last && has_next) S.a_ready(nxt);
            if constexpr (SP2) {
            PG8_LDB(B0, 0, 0); PG8_LDB(B1, 0, 1); PG8_SCHED; PG8_LDA(At, 0, 0); PG8_STAGE(PG8_SA(1, 1), a1 + hstepA, voffA);
            PG8_WAIT_V(8); PG8_WAIT_L(0); PG8_BAR; PG8_MMA(0, 0, At, B0); PG8_MMA(0, 1, At, B1); PG8_BAR; PG8_SCHED;
            PG8_LDA(At, 0, 1); PG8_STAGE(PG8_SB(0, 0), b2, voffB); PG8_STAGE(PG8_SB(0, 1), b2 + hstepB, voffB); PG8_STAGE(PG8_SA(0, 0), a2, voffA);
            PG8_WAIT_V(8); PG8_WAIT_L(0); PG8_BAR; PG8_MMA(1, 0, At, B0); PG8_MMA(1, 1, At, B1); PG8_BAR; PG8_SCHED;
            PG8_LDB(B0, 1, 0); PG8_LDB(B1, 1, 1); PG8_SCHED; PG8_LDA(At, 1, 0); PG8_STAGE(PG8_SA(0, 1), a2 + hstepA, voffA);
            PG8_WAIT_V(8); PG8_WAIT_L(0); PG8_BAR; PG8_MMA(0, 0, At, B0); PG8_MMA(0, 1, At, B1); PG8_BAR; PG8_SCHED;
            PG8_LDA(At, 1, 1); PG8_STAGE(PG8_SB(1, 0), b3, voffB); PG8_STAGE(PG8_SB(1, 1), b3 + hstepB, voffB); PG8_STAGE(PG8_SA(1, 0), a3, voffA);
            PG8_WAIT_V(8); PG8_WAIT_L(0); PG8_BAR; PG8_MMA(1, 0, At, B0); PG8_MMA(1, 1, At, B1); PG8_BAR; PG8_SCHED;
            } else {
            PG8_LDB(B0, 0, 0); PG8_SCHED; PG8_LDA(At, 0, 0); PG8_STAGE(PG8_SA(1, 1), a1 + hstepA, voffA);
            PG8_WAIT_L(8); PG8_BAR; PG8_WAIT_L(0); PG8_MMA(0, 0, At, B0); PG8_BAR; PG8_SCHED;
            PG8_LDB(B1, 0, 1); PG8_STAGE(PG8_SB(0, 0), b2, voffB);
            PG8_BAR; PG8_WAIT_L(0); PG8_MMA(0, 1, At, B1); PG8_BAR;
            PG8_LDA(At, 0, 1); PG8_STAGE(PG8_SA(0, 0), a2, voffA);
            PG8_BAR; PG8_WAIT_L(0); PG8_MMA(1, 0, At, B0); PG8_BAR; PG8_SCHED;
            PG8_STAGE(PG8_SB(0, 1), b2 + hstepB, voffB);
            PG8_WAIT_V(6); PG8_BAR; PG8_MMA(1, 1, At, B1); PG8_BAR;
            PG8_LDB(B0, 1, 0); PG8_SCHED; PG8_LDA(At, 1, 0); PG8_STAGE(PG8_SA(0, 1), a2 + hstepA, voffA);
            PG8_WAIT_L(8); PG8_BAR; PG8_WAIT_L(0); PG8_MMA(0, 0, At, B0); PG8_BAR; PG8_SCHED;
            PG8_LDB(B1, 1, 1); PG8_STAGE(PG8_SB(1, 0), b3, voffB);
            PG8_BAR; PG8_WAIT_L(0); PG8_MMA(0, 1, At, B1); PG8_BAR;
            PG8_LDA(At, 1, 1); PG8_STAGE(PG8_SA(1, 0), a3, voffA);
            PG8_BAR; PG8_WAIT_L(0); PG8_MMA(1, 0, At, B0); PG8_BAR; PG8_SCHED;
            PG8_STAGE(PG8_SB(1, 1), b3 + hstepB, voffB);
            PG8_WAIT_V(6); PG8_BAR; PG8_MMA(1, 1, At, B1); PG8_BAR;
            }
        }
        if constexpr (ALIGN_EPI) { if (wr == 0) PG8_BAR; }
        E(acc, cur, wr, wc, fr, fq); S.done(cur);
        if (!has_next) break;
#pragma unroll
        for (int a = 0; a < 2; ++a)
#pragma unroll
            for (int b = 0; b < 2; ++b)
#pragma unroll
                for (int m = 0; m < 4; ++m)
#pragma unroll
                    for (int n = 0; n < 2; ++n) acc[a][b][m][n] = (f32x4){0.f, 0.f, 0.f, 0.f};
        cur = nxt; cA = nA; cB = nB; ++ui;
        if constexpr (ALIGN_EPI) { if (wr == 1) PG8_BAR; }
    }
    PG8_WAIT_V(0);
    if constexpr (!ALIGN_EPI) { if (wr == 0) PG8_BAR; }
    PG8_BAR;
#undef PG8_SA
#undef PG8_SB
#undef PG8_STAGE
#undef PG8_LDA
#undef PG8_LDB
#undef PG8_MMA
#undef PG8_WAIT_V
#undef PG8_WAIT_L
#undef PG8_BAR
#undef PG8_SCHED
}
}
using pg8::Unit;


#define XB_TMO      128
#define XB_XCNT(j)  (256  + 64 * (j))
#define XB_XSUB(j)  (1280 + 64 * (j))
#define XB_XGEN(j)  (2304 + 64 * (j))
#define XB_TOP      3328
#define XB_TOPGEN   3392
#define XCD_BAR_WORDS 3456
#define XB_SPIN_CAP (1u << 22)
__device__ __forceinline__ unsigned xb_ld(unsigned* p)              { return __hip_atomic_load(p, __ATOMIC_RELAXED, __HIP_MEMORY_SCOPE_AGENT); }
__device__ __forceinline__ unsigned xb_add(unsigned* p, unsigned v) { return __hip_atomic_fetch_add(p, v, __ATOMIC_RELAXED, __HIP_MEMORY_SCOPE_AGENT); }
__device__ __forceinline__ unsigned xb_xcc_id() { return (unsigned)__builtin_amdgcn_s_getreg((3 << 11) | 20) & 0xFu; }
#define XB_SPIN(cond, bar) do { unsigned _sp = 0; while (cond) { __builtin_amdgcn_s_sleep(1); \
    if ((++_sp & 255u) == 0u) { if (xb_ld(&(bar)[XB_TMO])) break; if (_sp > XB_SPIN_CAP) { atomicAdd(&(bar)[XB_TMO], 1u); break; } } } } while (0)
struct XcdBarrier { unsigned* bar; unsigned x; volatile LAS unsigned* st; };
__device__ __forceinline__ XcdBarrier xcd_barrier_post(unsigned* bar, volatile LAS unsigned* st) {
    XcdBarrier b; b.bar = bar; b.x = xb_xcc_id(); b.st = st;
    if (threadIdx.x == 0) (void)xb_add(&bar[XB_XCNT(b.x)], 1u);
    return b;
}
__device__ __forceinline__ void xcd_barrier_complete(unsigned* bar, unsigned x, unsigned& nloc, unsigned& nx) {
    const unsigned G = gridDim.x * gridDim.y * gridDim.z;
    unsigned sum, cnt, mine, sp = 0u;
    for (;;) {
        sum = 0u; cnt = 0u; mine = 0u;
#pragma unroll
        for (unsigned j = 0; j < 16; ++j) { const unsigned c = xb_ld(&bar[XB_XCNT(j)]); sum += c; cnt += (c > 0u) ? 1u : 0u; mine = (j == x) ? c : mine; }
        if (sum == G) break;
        __builtin_amdgcn_s_sleep(1);
        if ((++sp & 255u) == 0u) { if (xb_ld(&bar[XB_TMO])) break; if (sp > XB_SPIN_CAP) { atomicAdd(&bar[XB_TMO], 1u); break; } }
    }
    nloc = mine > 0u ? mine : 1u; nx = cnt > 0u ? cnt : 1u;
}
__device__ __forceinline__ void xcd_barrier(const XcdBarrier& b) {
    asm volatile("s_waitcnt vmcnt(0)" ::: "memory");
    __syncthreads();
    if (threadIdx.x == 0) {
        unsigned* bar = b.bar;
        __builtin_amdgcn_s_waitcnt(0);
        unsigned nloc = b.st[0], nx = b.st[1];
        if (nloc == 0u) { xcd_barrier_complete(bar, b.x, nloc, nx); b.st[0] = nloc; b.st[1] = nx; }
        const unsigned old = xb_add(&bar[XB_XSUB(b.x)], 1u);
        const unsigned gen = old / nloc;
        if (old + 1u == (gen + 1u) * nloc) {
            __builtin_amdgcn_fence(__ATOMIC_RELEASE, "agent");
            asm volatile("s_waitcnt vmcnt(0)" ::: "memory");
            const unsigned og = xb_add(&bar[XB_TOP], 1u);
            const unsigned tg = og / nx;
            if (og + 1u == (tg + 1u) * nx) xb_add(&bar[XB_TOPGEN], 1u);
            else XB_SPIN(xb_ld(&bar[XB_TOPGEN]) == tg, bar);
            __builtin_amdgcn_fence(__ATOMIC_ACQUIRE, "agent");
            xb_add(&bar[XB_XGEN(b.x)], 1u);
            asm volatile("s_waitcnt vmcnt(0)" ::: "memory");
        } else {
            XB_SPIN(xb_ld(&bar[XB_XGEN(b.x)]) == gen, bar);
            __builtin_amdgcn_fence(__ATOMIC_ACQUIRE, "agent");
            asm volatile("s_waitcnt vmcnt(0)" ::: "memory");
        }
    }
    __syncthreads();
}

struct Args {
    const float* in[30];
    float* out;
    unsigned char* ws;
    int ph_lo, ph_hi;
};

struct Frame {
    LAS unsigned char* lds;
    int tid, lane, wave, G;
    const float* const* in;
    float* out;
    unsigned char* ws;
    bf16_t* PROJ; bf16_t* HALO; float* SMALL; bf16_t* XN; bf16_t* PB;
    float *SS1, *SS2, *SS3;
};

constexpr int NWAVES = 8;
constexpr int RING_BYTES = 131072, MISC_OFF = RING_BYTES + 320, LDS_BYTES = 147456;

struct EpiInProj {
    static constexpr bool PERM = true;
    bf16_t* PROJ; bf16_t* HALO; float* SMALL;
    __device__ __forceinline__ void operator()(const f32x4 (&acc)[2][2][4][2], const Unit& u, int wr, int wc, int fr, int fq) const {
        const int row0 = u.pm * 256 + wr * 64 + fr;
        if (u.pn < 44) {
            const int col0 = u.pn * 256 + wc * 32 + 8 * fq;
            const bool conv_tile = (u.pn >= 8 && u.pn < 32);
#pragma unroll
            for (int ai = 0; ai < 2; ++ai)
#pragma unroll
                for (int m = 0; m < 4; ++m) {
                    const int row = row0 + ai * 128 + m * 16;
                    bf16_t* rowp = PROJ + (size_t)row * LDP + col0;
#pragma unroll
                    for (int bj = 0; bj < 2; ++bj) {
                        const f32x4 v0 = acc[ai][bj][m][0], v1 = acc[ai][bj][m][1];
                        u32x4 w; w.x = cvt_pk_bf16(v0[0], v0[1]); w.y = cvt_pk_bf16(v0[2], v0[3]); w.z = cvt_pk_bf16(v1[0], v1[1]); w.w = cvt_pk_bf16(v1[2], v1[3]);
                        *(u32x4*)(rowp + bj * 128) = w;
                        if (m == 3 && conv_tile && fr >= 13) {
                            bf16_t* hp = HALO + ((size_t)(row >> 6) * 3 + (fr - 13)) * NCH + (col0 - C_XS) + bj * 128;
                            *(u32x4*)hp = w;
                        }
                    }
                }
        } else {
            if (wc < 2) {
                const int col0 = wc * 32 + 8 * fq;
#pragma unroll
                for (int ai = 0; ai < 2; ++ai)
#pragma unroll
                    for (int m = 0; m < 4; ++m) {
                        const int row = row0 + ai * 128 + m * 16;
                        float* sp = SMALL + (size_t)row * 64 + col0;
                        *(f32x4*)sp = acc[ai][0][m][0]; *(f32x4*)(sp + 4) = acc[ai][0][m][1];
                    }
            }
        }
    }
};

struct EpiT1 {
    static constexpr bool PERM = true;
    bf16_t* PROJ;
    __device__ __forceinline__ void operator()(const f32x4 (&acc)[2][2][4][2], const Unit& u, int wr, int wc, int fr, int fq) const {
        const int row0 = u.pm * 256 + wr * 64 + fr, col0 = u.pn * 256 + wc * 32 + 8 * fq;
#pragma unroll
        for (int ai = 0; ai < 2; ++ai)
#pragma unroll
            for (int m = 0; m < 4; ++m) {
                const int row = row0 + ai * 128 + m * 16;
#pragma unroll
                for (int bj = 0; bj < 2; ++bj) {
                    const int col = col0 + bj * 128;
                    const u32x4 mgw = *(const u32x4*)(PROJ + (size_t)row * LDP + C_MG + col);
                    float mg[8]; unpack8(mgw, mg);
                    const f32x4 v0 = acc[ai][bj][m][0], v1 = acc[ai][bj][m][1];
                    f32x4 o0, o1;
#pragma unroll
                    for (int i = 0; i < 4; ++i) { o0[i] = v0[i] * sigmoidf_(mg[i]); o1[i] = v1[i] * sigmoidf_(mg[4 + i]); }
                    float* tp = (float*)PROJ + (size_t)row * LDF + col;
                    *(f32x4*)tp = o0; *(f32x4*)(tp + 4) = o1;
                }
            }
    }
};

struct EpiMix {
    static constexpr bool PERM = true;
    bf16_t* PROJ;
    __device__ __forceinline__ void operator()(const f32x4 (&acc)[2][2][4][2], const Unit& u, int wr, int wc, int fr, int fq) const {
        const int row0 = u.pm * 256 + wr * 64 + fr, col0 = u.pn * 256 + wc * 32 + 8 * fq;
#pragma unroll
        for (int ai = 0; ai < 2; ++ai)
#pragma unroll
            for (int m = 0; m < 4; ++m) {
                const int row = row0 + ai * 128 + m * 16;
#pragma unroll
                for (int bj = 0; bj < 2; ++bj) {
                    const int col = col0 + bj * 128;
                    const u32x4 mgw = *(const u32x4*)(PROJ + (size_t)row * LDP + C_MG + 1024 + col);
                    float mg[8]; unpack8(mgw, mg);
                    const float* tp = (const float*)PROJ + (size_t)row * LDF + col;
                    const f32x4 t0 = *(const f32x4*)tp, t1 = *(const f32x4*)(tp + 4);
                    const f32x4 v0 = acc[ai][bj][m][0], v1 = acc[ai][bj][m][1];
                    float o[8];
#pragma unroll
                    for (int i = 0; i < 4; ++i) { o[i] = t0[i] + v0[i] * sigmoidf_(mg[i]); o[4 + i] = t1[i] + v1[i] * sigmoidf_(mg[4 + i]); }
                    *(u32x4*)(PROJ + (size_t)row * LDP + C_Q + col) = pack8(o);
                }
            }
    }
};

template <int MODE> struct EpiResid {
    static constexpr bool PERM = true;
    bf16_t* PROJ; const float* xp; const float* xs; int res_col  , dst_col  , dstb_col; float* SS;
    __device__ __forceinline__ void operator()(const f32x4 (&acc)[2][2][4][2], const Unit& u, int wr, int wc, int fr, int fq) const {
        const int row0 = u.pm * 256 + wr * 64 + fr, col0 = u.pn * 256 + wc * 32 + 8 * fq;
#pragma unroll
        for (int ai = 0; ai < 2; ++ai)
#pragma unroll
            for (int m = 0; m < 4; ++m) {
                const int row = row0 + ai * 128 + m * 16;
                float ss = 0.f;
#pragma unroll
                for (int bj = 0; bj < 2; ++bj) {
                    const int col = col0 + bj * 128;
                    f32x4 r0 = (f32x4){0.f, 0.f, 0.f, 0.f}, r1 = r0;
                    if (MODE == 0) {
                        if (row < MTOT) { const float* rp = (row < MPR ? xp + (size_t)row * D : xs + (size_t)(row - MPR) * D) + col; r0 = *(const f32x4*)rp; r1 = *(const f32x4*)(rp + 4); }
                    } else {
                        const float* rp = (const float*)(PROJ + res_col) + (size_t)row * LDF + col; r0 = *(const f32x4*)rp; r1 = *(const f32x4*)(rp + 4);
                    }
                    const f32x4 x0 = r0 + acc[ai][bj][m][0], x1 = r1 + acc[ai][bj][m][1];
                    float* dp = (float*)(PROJ + dst_col) + (size_t)row * LDF + col;
                    *(f32x4*)dp = x0; *(f32x4*)(dp + 4) = x1;
                    u32x4 w; w.x = cvt_pk_bf16(x0[0], x0[1]); w.y = cvt_pk_bf16(x0[2], x0[3]); w.z = cvt_pk_bf16(x1[0], x1[1]); w.w = cvt_pk_bf16(x1[2], x1[3]);
                    *(u32x4*)(PROJ + (size_t)row * LDP + dstb_col + col) = w;
                    ss += (x0[0] * x0[0] + x0[1] * x0[1]) + (x0[2] * x0[2] + x0[3] * x0[3]) + (x1[0] * x1[0] + x1[1] * x1[1]) + (x1[2] * x1[2] + x1[3] * x1[3]);
                }
                ss += __shfl_xor(ss, 16); ss += __shfl_xor(ss, 32);
                if (fq == 0) atomicAdd(SS + row, ss);
            }
    }
};

struct EpiSwiGLU {
    static constexpr bool PERM = true;
    bf16_t* PROJ; const float* SS;
    __device__ __forceinline__ void operator()(const f32x4 (&acc)[2][2][4][2], const Unit& u, int wr, int wc, int fr, int fq) const {
        const int row0 = u.pm * 256 + wr * 64 + fr, col0 = u.pn * 128 + wc * 32 + 8 * fq;
#pragma unroll
        for (int ai = 0; ai < 2; ++ai)
#pragma unroll
            for (int m = 0; m < 4; ++m) {
                const int row = row0 + ai * 128 + m * 16;
                const float r = rsqrtf(SS[row] * (1.0f / D) + EPS);
                const f32x4 g0 = acc[ai][0][m][0], g1 = acc[ai][0][m][1], u0 = acc[ai][1][m][0], u1 = acc[ai][1][m][1];
                float o[8];
#pragma unroll
                for (int i = 0; i < 4; ++i) { o[i] = siluf_(r * g0[i]) * (r * u0[i]); o[4 + i] = siluf_(r * g1[i]) * (r * u1[i]); }
                *(u32x4*)(PROJ + (size_t)row * LDP + C_XS + col0) = pack8(o);
            }
    }
};

struct EpiPE {
    static constexpr bool PERM = true;
    bf16_t* PROJ;
    __device__ __forceinline__ void operator()(const f32x4 (&acc)[2][2][4][2], const Unit& u, int wr, int wc, int fr, int fq) const {
        const int row0 = u.pm * 256 + wr * 64 + fr, col0 = u.pn * 256 + wc * 32 + 8 * fq;
#pragma unroll
        for (int ai = 0; ai < 2; ++ai)
#pragma unroll
            for (int m = 0; m < 4; ++m) {
                const int row = row0 + ai * 128 + m * 16;
#pragma unroll
                for (int bj = 0; bj < 2; ++bj) {
                    float* tp = (float*)PROJ + (size_t)row * LDF + col0 + bj * 128;
                    *(f32x4*)tp = acc[ai][bj][m][0]; *(f32x4*)(tp + 4) = acc[ai][bj][m][1];
                }
            }
    }
};

struct EpiX3 {
    static constexpr bool PERM = true;
    bf16_t* PROJ; const float* SS2; float* SS3; float* out;
    __device__ __forceinline__ void operator()(const f32x4 (&acc)[2][2][4][2], const Unit& u, int wr, int wc, int fr, int fq) const {
        const int row0 = u.pm * 256 + wr * 64 + fr, col0 = u.pn * 256 + wc * 32 + 8 * fq;
#pragma unroll
        for (int ai = 0; ai < 2; ++ai)
#pragma unroll
            for (int m = 0; m < 4; ++m) {
                const int row = row0 + ai * 128 + m * 16;
                const float r = rsqrtf(SS2[row] * (1.0f / D) + EPS);
                float ss = 0.f;
#pragma unroll
                for (int bj = 0; bj < 2; ++bj) {
                    const int col = col0 + bj * 128;
                    const float* x2p = (const float*)(PROJ + C_MG) + (size_t)row * LDF + col;
                    const float* pep = (const float*)PROJ + (size_t)row * LDF + col;
                    const f32x4 a0 = *(const f32x4*)x2p, a1 = *(const f32x4*)(x2p + 4), p0 = *(const f32x4*)pep, p1 = *(const f32x4*)(pep + 4);
                    const f32x4 v0 = acc[ai][bj][m][0], v1 = acc[ai][bj][m][1];
                    f32x4 x0, x1;
#pragma unroll
                    for (int i = 0; i < 4; ++i) { x0[i] = a0[i] + p0[i] * sigmoidf_(r * v0[i]); x1[i] = a1[i] + p1[i] * sigmoidf_(r * v1[i]); }
                    if (row < MTOT) { float* op = out + (row < MPR ? O_Y + (size_t)row * D : O_YS + (size_t)(row - MPR) * D) + col; *(f32x4*)op = x0; *(f32x4*)(op + 4) = x1; }
                    ss += (x0[0] * x0[0] + x0[1] * x0[1]) + (x0[2] * x0[2] + x0[3] * x0[3]) + (x1[0] * x1[0] + x1[1] * x1[1]) + (x1[2] * x1[2] + x1[3] * x1[3]);
                }
                ss += __shfl_xor(ss, 16); ss += __shfl_xor(ss, 32);
                if (fq == 0) atomicAdd(SS3 + row, ss);
            }
    }
};

struct MapIdent { __device__ __forceinline__ int operator()(int n) const { return n; } };
struct MapWin {
    __device__ __forceinline__ int operator()(int n) const {
        if (n < 5120) return n;
        if (n < 9216) return n + 32;
        if (n < 11264) return n + 48;
        const int j = n - 11264;
        if (j < 32) return 5120 + j;
        if (j < 48) return 9216 + j;
        return -1;
    }
};
struct MapFfn {
    __device__ __forceinline__ int operator()(int n) const { const int j = n >> 8, r = n & 255; return r < 128 ? 128 * j + r : DFF + 128 * j + (r - 128); }
};
template <class Map>
__device__ __forceinline__ void transpose_item(const float* W, int K, int Nsrc, int Ndst, bf16_t* WT, const float* gain, LAS float* scr, int item, int lane, Map map) {
    const int nblk = Ndst / 32, kb = item / nblk, nb = item % nblk, k0 = 64 * kb, n0 = 32 * nb;
    const int sc = map(n0 + (lane & 31));
#pragma unroll 8
    for (int i = 0; i < 32; ++i) { const int kk = 2 * i + (lane >> 5); float v = sc >= 0 ? W[(size_t)(k0 + kk) * Nsrc + sc] : 0.f; if (gain) v *= gain[k0 + kk]; scr[kk * 33 + (lane & 31)] = v; }
    asm volatile("s_waitcnt lgkmcnt(0)" ::: "memory");
    const int c = lane & 7;
#pragma unroll
    for (int j = 0; j < 4; ++j) { const int n = (lane >> 3) + 8 * j; const LAS float* s = scr + (8 * c) * 33 + n;
        u32x4 o; o.x = cvt_pk_bf16(s[0 * 33], s[1 * 33]); o.y = cvt_pk_bf16(s[2 * 33], s[3 * 33]); o.z = cvt_pk_bf16(s[4 * 33], s[5 * 33]); o.w = cvt_pk_bf16(s[6 * 33], s[7 * 33]);
        *(u32x4*)(WT + (size_t)(n0 + n) * K + k0 + 8 * c) = o; }
    asm volatile("s_waitcnt lgkmcnt(0)" ::: "memory");
}

__device__ __forceinline__ void p0_prologue(Frame& F) {
    LAS float* scr = (LAS float*)(F.lds + F.wave * 16384);
    const int gw = blockIdx.x * NWAVES + F.wave, NGW = F.G * NWAVES;
    unsigned char* ws = F.ws;
    constexpr int I_WIN = 16 * (NPROJ / 32), I_WBS = 32 * 32, I_WBG = 16 * 32, I_WOUT = 16 * 32, I_WFI = 16 * (2 * DFF / 32), I_WFO = (DFF / 64) * 32, I_WPG = 16 * 32, I_WPP = 4 * 32;
    constexpr int NITEMS = I_WIN + I_WBS + I_WBG + I_WOUT + I_WFI + I_WFO + I_WPG + I_WPP;
    for (int it = gw; it < NITEMS; it += NGW) {
        int r = it;
        if (r < I_WIN) { transpose_item(F.in[9], D, NIN, NPROJ, (bf16_t*)(ws + WS_WIN), nullptr, scr, r, F.lane, MapWin()); continue; } r -= I_WIN;
        if (r < I_WBS) { transpose_item(F.in[20], 2048, D, D, (bf16_t*)(ws + WS_WBS), nullptr, scr, r, F.lane, MapIdent()); continue; } r -= I_WBS;
        if (r < I_WBG) { transpose_item(F.in[21], D, D, D, (bf16_t*)(ws + WS_WBG), nullptr, scr, r, F.lane, MapIdent()); continue; } r -= I_WBG;
        if (r < I_WOUT) { transpose_item(F.in[22], D, D, D, (bf16_t*)(ws + WS_WOUT), nullptr, scr, r, F.lane, MapIdent()); continue; } r -= I_WOUT;
        if (r < I_WFI) { transpose_item(F.in[24], D, 2 * DFF, 2 * DFF, (bf16_t*)(ws + WS_WFI), F.in[23], scr, r, F.lane, MapFfn()); continue; } r -= I_WFI;
        if (r < I_WFO) { transpose_item(F.in[25], DFF, D, D, (bf16_t*)(ws + WS_WFO), nullptr, scr, r, F.lane, MapIdent()); continue; } r -= I_WFO;
        if (r < I_WPG) { transpose_item(F.in[27], D, D, D, (bf16_t*)(ws + WS_WPG), F.in[26], scr, r, F.lane, MapIdent()); continue; } r -= I_WPG;
        transpose_item(F.in[28], 256, D, D, (bf16_t*)(ws + WS_WPP), nullptr, scr, r, F.lane, MapIdent());
    }
    const float* gmix = F.in[8];
    for (int m = gw; m < MP; m += NGW) {
        u32x2* o8 = (u32x2*)(F.XN + (size_t)m * D) + F.lane;
        u32x2* p8 = (u32x2*)(F.PB + (size_t)m * 256) + F.lane;
        if (m >= MTOT) {
#pragma unroll
            for (int j = 0; j < 4; ++j) o8[64 * j] = (u32x2){0u, 0u};
            p8[0] = (u32x2){0u, 0u};
            continue;
        }
        const float* xrow = m < MPR ? F.in[0] + (size_t)m * D : F.in[1] + (size_t)(m - MPR) * D;
        const f32x4* xr = (const f32x4*)xrow + F.lane;
        f32x4 v[4]; float s = 0.f;
#pragma unroll
        for (int j = 0; j < 4; ++j) { v[j] = xr[64 * j]; s += (v[j][0] * v[j][0] + v[j][1] * v[j][1]) + (v[j][2] * v[j][2] + v[j][3] * v[j][3]); }
        const float rs = rsqrtf(wave_sum(s) * (1.0f / D) + EPS);
#pragma unroll
        for (int j = 0; j < 4; ++j) { const f32x4 gv = ((const f32x4*)gmix)[64 * j + F.lane]; const f32x4 y = v[j] * rs * gv;
            o8[64 * j] = (u32x2){cvt_pk_bf16(y[0], y[1]), cvt_pk_bf16(y[2], y[3])}; }
        const float* prow = m < MPR ? F.in[2] + (size_t)m * 256 : F.in[3] + (size_t)(m - MPR) * 256;
        const f32x4 pv = ((const f32x4*)prow)[F.lane];
        p8[0] = (u32x2){cvt_pk_bf16(pv[0], pv[1]), cvt_pk_bf16(pv[2], pv[3])};
    }
}

__device__ __forceinline__ void p2_conv(Frame& F) {
    const int gt = blockIdx.x * (NWAVES * 64) + F.tid, NT = F.G * NWAVES * 64;
    constexpr int NCG = NCH / 8;
    constexpr int NU_P = (MPR / 64) * NCG, NU_S = NSMP * NCG;
    for (int u = gt; u < NU_P + NU_S; u += NT) {
        const bool smp = u >= NU_P;
        const int uu = smp ? u - NU_P : u;
        const int ch = uu / NCG, cgi = uu % NCG;
        const bool is_ssm = cgi < 384;
        const int cc = is_ssm ? cgi * 8 : (cgi - 384) * 8;
        const int kind = is_ssm ? 0 : 1 + (cgi - 384) / 128;
        const float* cw = is_ssm ? F.in[10] : F.in[16];
        float w[4][8], bias[8];
#pragma unroll
        for (int j = 0; j < 4; ++j) { const f32x4 a = *(const f32x4*)(cw + j * 3072 + cc), b = *(const f32x4*)(cw + j * 3072 + cc + 4);
#pragma unroll
            for (int i = 0; i < 4; ++i) { w[j][i] = a[i]; w[j][4 + i] = b[i]; } }
        if (is_ssm) { const f32x4 a = *(const f32x4*)(F.in[11] + cc), b = *(const f32x4*)(F.in[11] + cc + 4);
#pragma unroll
            for (int i = 0; i < 4; ++i) { bias[i] = a[i]; bias[4 + i] = b[i]; } }
        else {
#pragma unroll
            for (int i = 0; i < 8; ++i) bias[i] = 0.f; }
        float h0[8], h1[8], h2[8];
        const int pcol = C_XS + cgi * 8;
        if (smp) {
            const float* st = (is_ssm ? F.in[5] : F.in[7]) + (size_t)ch * 3 * 3072 + cc;
#pragma unroll
            for (int i = 0; i < 8; ++i) { h0[i] = st[i]; h1[i] = st[3072 + i]; h2[i] = st[2 * 3072 + i]; }
            bf16_t* rp = F.PROJ + (size_t)(MPR + ch) * LDP + pcol;
            float x[8]; unpack8(*(const u32x4*)rp, x);
            float o[8]; float ss = 0.f;
#pragma unroll
            for (int i = 0; i < 8; ++i) { float v = w[0][i] * h0[i] + w[1][i] * h1[i] + w[2][i] * h2[i] + w[3][i] * x[i] + bias[i]; v = siluf_(v); o[i] = v; ss += v * v; }
            if (kind == 1 || kind == 2) {
                ss += __shfl_xor(ss, 1); ss += __shfl_xor(ss, 2); ss += __shfl_xor(ss, 4); ss += __shfl_xor(ss, 8);
                const float rn = rsqrtf(ss + EPS) * (kind == 1 ? 0.08838834764831845f : 1.0f);
#pragma unroll
                for (int i = 0; i < 8; ++i) o[i] *= rn;
            }
            *(u32x4*)rp = pack8(o);
            float* ns = F.out + (is_ssm ? O_SCONVS : O_GCONVS) + (size_t)ch * 3 * 3072 + cc;
#pragma unroll
            for (int i = 0; i < 8; ++i) { ns[i] = h1[i]; ns[3072 + i] = h2[i]; ns[2 * 3072 + i] = x[i]; }
            continue;
        }
        const int rowbase = ch * 64, t0 = rowbase & (SEQ - 1);
        if (t0 == 0) {
#pragma unroll
            for (int i = 0; i < 8; ++i) { h0[i] = 0.f; h1[i] = 0.f; h2[i] = 0.f; }
        } else {
            const bf16_t* hp = F.HALO + (size_t)(ch - 1) * 3 * NCH + cgi * 8;
            unpack8(*(const u32x4*)hp, h0); unpack8(*(const u32x4*)(hp + NCH), h1); unpack8(*(const u32x4*)(hp + 2 * NCH), h2);
        }
        const bool lastc = (t0 == SEQ - 64);
        float* ns = F.out + (is_ssm ? O_SCONVP : O_GCONVP) + (size_t)(rowbase >> 11) * 3 * 3072 + cc;
        bf16_t* rp = F.PROJ + (size_t)rowbase * LDP + pcol;
        for (int rb = 0; rb < 64; rb += 8) {
            u32x4 raw[8];
#pragma unroll
            for (int r = 0; r < 8; ++r) raw[r] = *(const u32x4*)(rp + (size_t)(rb + r) * LDP);
#pragma unroll
            for (int r = 0; r < 8; ++r) {
                float x[8]; unpack8(raw[r], x);
                float o[8]; float ss = 0.f;
#pragma unroll
                for (int i = 0; i < 8; ++i) { float v = w[0][i] * h0[i] + w[1][i] * h1[i] + w[2][i] * h2[i] + w[3][i] * x[i] + bias[i]; v = siluf_(v); o[i] = v; ss += v * v; }
                if (kind == 1 || kind == 2) {
                    ss += __shfl_xor(ss, 1); ss += __shfl_xor(ss, 2); ss += __shfl_xor(ss, 4); ss += __shfl_xor(ss, 8);
                    const float rn = rsqrtf(ss + EPS) * (kind == 1 ? 0.08838834764831845f : 1.0f);
#pragma unroll
                    for (int i = 0; i < 8; ++i) o[i] *= rn;
                }
                *(u32x4*)(rp + (size_t)(rb + r) * LDP) = pack8(o);
                if (lastc && rb == 56 && r >= 5) {
#pragma unroll
                    for (int i = 0; i < 8; ++i) ns[(r - 5) * 3072 + i] = x[i];
                }
#pragma unroll
                for (int i = 0; i < 8; ++i) { h0[i] = h1[i]; h1[i] = h2[i]; h2[i] = x[i]; }
            }
        }
    }
}

__device__ __forceinline__ void ssd_item(Frame& F, int item) {
    const bool smp = item >= NBATCH * 32;
    const int sq = smp ? (item - NBATCH * 32) >> 5 : item >> 5, h = item & 31, g = h >> 3;
    const int row0 = smp ? MPR + sq : sq * SEQ, T = smp ? 1 : SEQ;
    const int tid = F.tid, p = tid >> 3, nq = tid & 7;
    LAS bf16_t* Bs = (LAS bf16_t*)(F.lds);
    LAS bf16_t* Cs = (LAS bf16_t*)(F.lds + 16384);
    LAS bf16_t* Xs = (LAS bf16_t*)(F.lds + 32768);
    LAS float* dts = (LAS float*)(F.lds + 40960);
    LAS float* decs = (LAS float*)(F.lds + 41216);
    LAS float* Ys = (LAS float*)(F.lds + 41472);
    float hst[16];
    if (smp) {
        const float* sp = F.in[4] + ((size_t)(sq * 32 + h) * 64 + p) * 128 + nq * 16;
#pragma unroll
        for (int i = 0; i < 4; ++i) { const f32x4 v = ((const f32x4*)sp)[i]; hst[4 * i] = v[0]; hst[4 * i + 1] = v[1]; hst[4 * i + 2] = v[2]; hst[4 * i + 3] = v[3]; }
    } else {
#pragma unroll
        for (int i = 0; i < 16; ++i) hst[i] = 0.f;
    }
    const float a_h = -__expf(F.in[13][h]), dtb = F.in[12][h], Dh = F.in[14][h];
    for (int tb = 0; tb < T; tb += 64) {
        const int rows = (T - tb) < 64 ? (T - tb) : 64;
#pragma unroll
        for (int i = 0; i < 2; ++i) {
            const int pc = tid + i * 512, r = pc >> 4, c8 = (pc & 15) * 8;
            if (r < rows) {
                const bf16_t* src = F.PROJ + (size_t)(row0 + tb + r) * LDP;
                *(LAS u32x4*)(Bs + r * 128 + c8) = *(const u32x4*)(src + C_B + g * 128 + c8);
                *(LAS u32x4*)(Cs + r * 128 + c8) = *(const u32x4*)(src + C_C + g * 128 + c8);
            }
        }
        { const int r = tid >> 3, c8 = (tid & 7) * 8;
          if (r < rows) *(LAS u32x4*)(Xs + r * 64 + c8) = *(const u32x4*)(F.PROJ + (size_t)(row0 + tb + r) * LDP + C_XS + h * 64 + c8); }
        if (tid < rows) { const float dt = softplusf_(F.SMALL[(size_t)(row0 + tb + tid) * 64 + h] + dtb); dts[tid] = dt; decs[tid] = __expf(dt * a_h); }
        __syncthreads();
        for (int tt = 0; tt < rows; ++tt) {
            const float xv = bf2f(Xs[tt * 64 + p]), dtv = dts[tt], dc = decs[tt], dx = dtv * xv;
            float bv[16], cv[16];
            { float t8[8]; unpack8(*(const LAS u32x4*)(Bs + tt * 128 + nq * 16), t8);
#pragma unroll
              for (int i = 0; i < 8; ++i) bv[i] = t8[i];
              unpack8(*(const LAS u32x4*)(Bs + tt * 128 + nq * 16 + 8), t8);
#pragma unroll
              for (int i = 0; i < 8; ++i) bv[8 + i] = t8[i];
              unpack8(*(const LAS u32x4*)(Cs + tt * 128 + nq * 16), t8);
#pragma unroll
              for (int i = 0; i < 8; ++i) cv[i] = t8[i];
              unpack8(*(const LAS u32x4*)(Cs + tt * 128 + nq * 16 + 8), t8);
#pragma unroll
              for (int i = 0; i < 8; ++i) cv[8 + i] = t8[i]; }
            float yp = 0.f;
#pragma unroll
            for (int i = 0; i < 16; ++i) { hst[i] = dc * hst[i] + dx * bv[i]; yp += cv[i] * hst[i]; }
            yp += __shfl_xor(yp, 1); yp += __shfl_xor(yp, 2); yp += __shfl_xor(yp, 4);
            if (nq == 0) Ys[tt * 64 + p] = yp + Dh * xv;
        }
        __syncthreads();
        { const int r = tid >> 3, c8 = (tid & 7) * 8;
          if (r < rows) { float o[8];
#pragma unroll
              for (int i = 0; i < 8; ++i) o[i] = Ys[r * 64 + c8 + i];
              *(u32x4*)(F.PROJ + (size_t)(row0 + tb + r) * LDP + C_XS + h * 64 + c8) = pack8(o); } }
        __syncthreads();
    }
    float* op = F.out + (smp ? O_SSMS : O_SSMP) + ((size_t)(sq * 32 + h) * 64 + p) * 128 + nq * 16;
#pragma unroll
    for (int i = 0; i < 4; ++i) ((f32x4*)op)[i] = (f32x4){hst[4 * i], hst[4 * i + 1], hst[4 * i + 2], hst[4 * i + 3]};
}

__device__ __forceinline__ void gdn_item(Frame& F, int item) {
    const bool smp = item >= NBATCH * 32;
    const int sq = smp ? (item - NBATCH * 32) >> 5 : item >> 5, h = (item >> 2) & 7, dvq = item & 3;
    const int row0 = smp ? MPR + sq : sq * SEQ, T = smp ? 1 : SEQ;
    const int tid = F.tid, e = tid >> 4, kg = tid & 15;
    LAS bf16_t* Qs = (LAS bf16_t*)(F.lds);
    LAS bf16_t* Ks = (LAS bf16_t*)(F.lds + 16384);
    LAS bf16_t* Vs = (LAS bf16_t*)(F.lds + 32768);
    LAS float* egs = (LAS float*)(F.lds + 36864);
    LAS float* bts = (LAS float*)(F.lds + 37120);
    LAS float* Os = (LAS float*)(F.lds + 37376);
    float S[8];
    const size_t sbase = ((size_t)(sq * 8 + h) * 128 + kg * 8) * 128 + dvq * 32 + e;
    if (smp) {
#pragma unroll
        for (int j = 0; j < 8; ++j) S[j] = F.in[6][sbase + (size_t)j * 128];
    } else {
#pragma unroll
        for (int j = 0; j < 8; ++j) S[j] = 0.f;
    }
    const float na = -__expf(F.in[18][h]), dtb = F.in[17][h];
    for (int tb = 0; tb < T; tb += 64) {
        const int rows = (T - tb) < 64 ? (T - tb) : 64;
#pragma unroll
        for (int i = 0; i < 2; ++i) {
            const int pc = tid + i * 512, r = pc >> 4, c8 = (pc & 15) * 8;
            if (r < rows) {
                const bf16_t* src = F.PROJ + (size_t)(row0 + tb + r) * LDP;
                *(LAS u32x4*)(Qs + r * 128 + c8) = *(const u32x4*)(src + C_Q + h * 128 + c8);
                *(LAS u32x4*)(Ks + r * 128 + c8) = *(const u32x4*)(src + C_K + h * 128 + c8);
            }
        }
        if (tid < 256) { const int r = tid >> 2, c8 = (tid & 3) * 8;
          if (r < rows) *(LAS u32x4*)(Vs + r * 32 + c8) = *(const u32x4*)(F.PROJ + (size_t)(row0 + tb + r) * LDP + C_V + h * 128 + dvq * 32 + c8); }
        if (tid < rows) { const float* sm = F.SMALL + (size_t)(row0 + tb + tid) * 64;
            egs[tid] = __expf(na * softplusf_(sm[40 + h] + dtb)); bts[tid] = sigmoidf_(sm[32 + h]); }
        __syncthreads();
        for (int tt = 0; tt < rows; ++tt) {
            float k8[8], q8[8];
            unpack8(*(const LAS u32x4*)(Ks + tt * 128 + kg * 8), k8);
            unpack8(*(const LAS u32x4*)(Qs + tt * 128 + kg * 8), q8);
            const float eg = egs[tt], bt = bts[tt], v = bf2f(Vs[tt * 32 + e]);
            float ks = 0.f;
#pragma unroll
            for (int j = 0; j < 8; ++j) ks += k8[j] * S[j];
            ks += __shfl_xor(ks, 1); ks += __shfl_xor(ks, 2); ks += __shfl_xor(ks, 4); ks += __shfl_xor(ks, 8);
            const float vn = bt * (v - eg * ks);
            float op = 0.f;
#pragma unroll
            for (int j = 0; j < 8; ++j) { S[j] = eg * S[j] + k8[j] * vn; op += q8[j] * S[j]; }
            op += __shfl_xor(op, 1); op += __shfl_xor(op, 2); op += __shfl_xor(op, 4); op += __shfl_xor(op, 8);
            if (kg == 0) Os[tt * 32 + e] = op;
        }
        __syncthreads();
        if (tid < 256) { const int r = tid >> 2, c8 = (tid & 3) * 8;
          if (r < rows) { float o[8];
#pragma unroll
              for (int i = 0; i < 8; ++i) o[i] = Os[r * 32 + c8 + i];
              *(u32x4*)(F.PROJ + (size_t)(row0 + tb + r) * LDP + C_V + h * 128 + dvq * 32 + c8) = pack8(o); } }
        __syncthreads();
    }
    float* op = F.out + (smp ? O_GDNS : O_GDNP);
#pragma unroll
    for (int j = 0; j < 8; ++j) op[sbase + (size_t)j * 128] = S[j];
}


typedef short v4i16 __attribute__((ext_vector_type(4)));
__device__ __forceinline__ bf16x8 row_frag(LAS const unsigned char* base, int pitch, int row0, int k0, int lane) {
    return *(const LAS bf16x8*)(base + (row0 + (lane & 15)) * pitch + (k0 + 8 * (lane >> 4)) * 2);
}
__device__ __forceinline__ bf16x8 tr_frag(LAS const unsigned char* base, int pitch, int k0, int col0, int lane) {
    const int g = lane >> 4, m = lane & 15, q = m >> 2, pp = m & 3;
    LAS const unsigned char* a0 = base + (k0 + 8 * g + q) * pitch + (col0 + 4 * pp) * 2;
    const v4i16 lo = __builtin_amdgcn_ds_read_tr16_b64_v4i16((LAS v4i16*)a0);
    const v4i16 hi = __builtin_amdgcn_ds_read_tr16_b64_v4i16((LAS v4i16*)(a0 + 4 * pitch));
    return (bf16x8){lo[0], lo[1], lo[2], lo[3], hi[0], hi[1], hi[2], hi[3]};
}
#define MFMA16(a, b, c) __builtin_amdgcn_mfma_f32_16x16x32_bf16((a), (b), (c), 0, 0, 0)
__device__ __forceinline__ u32x2 pack4(float a, float b, float c, float d) { return (u32x2){cvt_pk_bf16(a, b), cvt_pk_bf16(c, d)}; }

__device__ __forceinline__ void ssd_chunked(Frame& F, int item) {
    const int b = item >> 5, h = item & 31, g4 = h >> 3;
    const int tid = F.tid, lane = F.lane, w = F.wave, i16 = lane & 15, g = lane >> 4;
    LAS unsigned char* L = F.lds;
    constexpr int PB = 272, PX = 144, PY = 260;
    constexpr int O_BT = 0, O_CT = 17408, O_XT = 34816, O_XD = 44032, O_MT = 53248, O_SL = 62464, O_YT = 79872, O_SC = 96512;
    LAS float* acum = (LAS float*)(L + O_SC); LAS float* dtl = acum + 64; LAS float* scl = acum + 128; LAS float* eac = acum + 192; LAS float* cdecp = acum + 256;
    __syncthreads();
    for (int u = tid; u < 17408 / 16; u += 512) *(LAS u32x4*)(L + O_SL + u * 16) = (u32x4){0u, 0u, 0u, 0u};
    f32x4 sacc[4];
#pragma unroll
    for (int pb = 0; pb < 4; ++pb) sacc[pb] = (f32x4){0.f, 0.f, 0.f, 0.f};
    const float a_h = -__expf(F.in[13][h]), dtb = F.in[12][h], Dh = F.in[14][h];
    const int row00 = b * SEQ;
    u32x4 rb[2], rc[2], rx; float rdt = 0.f;
    const int br0 = tid >> 4, bc8 = (tid & 15) * 8;
    const int xr = tid >> 3, xc8 = (tid & 7) * 8;
#define SSD_LOAD(c) do { const bf16_t* src = F.PROJ + (size_t)(row00 + (c) * 64) * LDP; \
        rb[0] = *(const u32x4*)(src + (size_t)br0 * LDP + C_B + g4 * 128 + bc8); rb[1] = *(const u32x4*)(src + (size_t)(br0 + 32) * LDP + C_B + g4 * 128 + bc8); \
        rc[0] = *(const u32x4*)(src + (size_t)br0 * LDP + C_C + g4 * 128 + bc8); rc[1] = *(const u32x4*)(src + (size_t)(br0 + 32) * LDP + C_C + g4 * 128 + bc8); \
        rx = *(const u32x4*)(src + (size_t)xr * LDP + C_XS + h * 64 + xc8); \
        if (tid < 64) rdt = F.SMALL[(size_t)(row00 + (c) * 64 + tid) * 64 + h]; } while (0)
    SSD_LOAD(0);
    for (int c = 0; c < SEQ / 64; ++c) {
        *(LAS u32x4*)(L + O_BT + br0 * PB + bc8 * 2) = rb[0]; *(LAS u32x4*)(L + O_BT + (br0 + 32) * PB + bc8 * 2) = rb[1];
        *(LAS u32x4*)(L + O_CT + br0 * PB + bc8 * 2) = rc[0]; *(LAS u32x4*)(L + O_CT + (br0 + 32) * PB + bc8 * 2) = rc[1];
        *(LAS u32x4*)(L + O_XT + xr * PX + xc8 * 2) = rx;
        if (tid < 64) {
            const float dt = softplusf_(rdt + dtb);
            float v = dt * a_h;
#pragma unroll
            for (int o = 1; o < 64; o <<= 1) { const float t = __shfl_up(v, o); if (lane >= o) v += t; }
            const float last = __shfl(v, 63);
            acum[lane] = v; dtl[lane] = dt; scl[lane] = dt * __expf(last - v); eac[lane] = __expf(v);
            if (lane == 63) cdecp[0] = __expf(v);
        }
        const u32x4 xkeep = rx;
        __syncthreads();
        if (c + 1 < SEQ / 64) SSD_LOAD(c + 1);
        { float x8[8]; unpack8(xkeep, x8); const float sc = scl[xr];
#pragma unroll
          for (int i = 0; i < 8; ++i) x8[i] *= sc;
          *(LAS u32x4*)(L + O_XD + xr * PX + xc8 * 2) = pack8(x8); }
#pragma unroll
        for (int tt = 0; tt < 2; ++tt) {
            const int t = 2 * w + tt, lb = t >> 2, sb = t & 3;
            const int l = 16 * lb + i16;
            u32x2 mw = (u32x2){0u, 0u};
            if (sb <= lb) {
                f32x4 acc = (f32x4){0.f, 0.f, 0.f, 0.f};
#pragma unroll
                for (int ks = 0; ks < 4; ++ks) acc = MFMA16(row_frag(L + O_BT, PB, 16 * sb, 32 * ks, lane), row_frag(L + O_CT, PB, 16 * lb, 32 * ks, lane), acc);
                const float al = acum[l];
                float mv[4];
#pragma unroll
                for (int r = 0; r < 4; ++r) { const int s = 16 * sb + 4 * g + r; const float e = __expf(al - acum[s]) * dtl[s] * acc[r]; mv[r] = (s <= l) ? e : 0.f; }
                mw = pack4(mv[0], mv[1], mv[2], mv[3]);
            }
            *(LAS u32x2*)(L + O_MT + l * PX + (16 * sb + 4 * g) * 2) = mw;
        }
        f32x4 yacc[2];
        const int lb = w >> 1;
#pragma unroll
        for (int tt = 0; tt < 2; ++tt) {
            const int pb = 2 * (w & 1) + tt;
            f32x4 acc = (f32x4){0.f, 0.f, 0.f, 0.f};
#pragma unroll
            for (int ks = 0; ks < 4; ++ks) acc = MFMA16(row_frag(L + O_CT, PB, 16 * lb, 32 * ks, lane), row_frag(L + O_SL, PB, 16 * pb, 32 * ks, lane), acc);
#pragma unroll
            for (int r = 0; r < 4; ++r) acc[r] *= eac[16 * lb + 4 * g + r];
            yacc[tt] = acc;
        }
        __syncthreads();
#pragma unroll
        for (int tt = 0; tt < 2; ++tt) {
            const int pb = 2 * (w & 1) + tt;
            f32x4 acc = yacc[tt];
            acc = MFMA16(row_frag(L + O_MT, PX, 16 * lb, 0, lane), tr_frag(L + O_XT, PX, 0, 16 * pb, lane), acc);
            if (lb >= 2) acc = MFMA16(row_frag(L + O_MT, PX, 16 * lb, 32, lane), tr_frag(L + O_XT, PX, 32, 16 * pb, lane), acc);
#pragma unroll
            for (int r = 0; r < 4; ++r) { const int l = 16 * lb + 4 * g + r, p = 16 * pb + i16;
                const float xv = bf2f(*(LAS const bf16_t*)(L + O_XT + l * PX + p * 2));
                *(LAS float*)(L + O_YT + l * PY + p * 4) = acc[r] + Dh * xv; }
        }
        { const float cdec = cdecp[0];
#pragma unroll
          for (int pb = 0; pb < 4; ++pb) sacc[pb] *= cdec;
#pragma unroll
          for (int ks = 0; ks < 2; ++ks) {
              const bf16x8 a = tr_frag(L + O_BT, PB, 32 * ks, 16 * w, lane);
#pragma unroll
              for (int pb = 0; pb < 4; ++pb) sacc[pb] = MFMA16(a, tr_frag(L + O_XD, PX, 32 * ks, 16 * pb, lane), sacc[pb]);
          }
#pragma unroll
          for (int pb = 0; pb < 4; ++pb) *(LAS u32x2*)(L + O_SL + (16 * pb + i16) * PB + (16 * w + 4 * g) * 2) = pack4(sacc[pb][0], sacc[pb][1], sacc[pb][2], sacc[pb][3]);
        }
        __syncthreads();
        { float o[8];
#pragma unroll
          for (int i = 0; i < 8; ++i) o[i] = *(LAS const float*)(L + O_YT + xr * PY + (xc8 + i) * 4);
          *(u32x4*)(F.PROJ + (size_t)(row00 + c * 64 + xr) * LDP + C_XS + h * 64 + xc8) = pack8(o); }
    }
#undef SSD_LOAD
#pragma unroll
    for (int pb = 0; pb < 4; ++pb) *(f32x4*)(F.out + O_SSMP + ((size_t)(b * 32 + h) * 64 + 16 * pb + i16) * 128 + 16 * w + 4 * g) = sacc[pb];
}

__device__ __forceinline__ void p3_scan(Frame& F) {
    constexpr int NSSD = NBATCH * 32 + NSMP * 32, NGDN = NBATCH * 32 + NSMP * 32;
    for (int it = blockIdx.x; it < NBATCH * 32; it += F.G) ssd_chunked(F, it);
    __syncthreads();
    for (int it = NBATCH * 32 + blockIdx.x; it < NSSD; it += F.G) ssd_item(F, it);
    for (int it = blockIdx.x; it < NGDN; it += F.G) gdn_item(F, it);
}

__device__ __forceinline__ void p4_norm(Frame& F) {
    const int gw = blockIdx.x * NWAVES + F.wave, NGW = F.G * NWAVES, lane = F.lane;
    const float* gs = F.in[15]; const float* gg = F.in[19];
    for (int m = gw; m < MTOT; m += NGW) {
        bf16_t* row = F.PROJ + (size_t)m * LDP;
#pragma unroll
        for (int g = 0; g < 4; ++g) {
            const int c = g * 512 + lane * 8;
            float y[8], z[8]; unpack8(*(const u32x4*)(row + C_XS + c), y); unpack8(*(const u32x4*)(row + C_Z + c), z);
            float ss = 0.f;
#pragma unroll
            for (int i = 0; i < 8; ++i) { y[i] *= siluf_(z[i]); ss += y[i] * y[i]; }
            const float r = rsqrtf(wave_sum(ss) * (1.0f / 512.0f) + EPS);
            const f32x4 g0 = *(const f32x4*)(gs + c), g1 = *(const f32x4*)(gs + c + 4);
#pragma unroll
            for (int i = 0; i < 4; ++i) { y[i] *= r * g0[i]; y[4 + i] *= r * g1[i]; }
            *(u32x4*)(row + C_XS + c) = pack8(y);
        }
#pragma unroll
        for (int hh = 0; hh < 2; ++hh) {
            const int c = hh * 512 + lane * 8;
            float o[8], gt[8]; unpack8(*(const u32x4*)(row + C_V + c), o); unpack8(*(const u32x4*)(row + C_GATE + c), gt);
            float ss = 0.f;
#pragma unroll
            for (int i = 0; i < 8; ++i) ss += o[i] * o[i];
            ss += __shfl_xor(ss, 1); ss += __shfl_xor(ss, 2); ss += __shfl_xor(ss, 4); ss += __shfl_xor(ss, 8);
            const float r = rsqrtf(ss * (1.0f / 128.0f) + EPS);
            const int e = (lane & 15) * 8;
            const f32x4 g0 = *(const f32x4*)(gg + e), g1 = *(const f32x4*)(gg + e + 4);
#pragma unroll
            for (int i = 0; i < 4; ++i) { o[i] = o[i] * r * g0[i] * siluf_(gt[i]); o[4 + i] = o[4 + i] * r * g1[i] * siluf_(gt[4 + i]); }
            *(u32x4*)(row + C_V + c) = pack8(o);
        }
    }
}

__device__ __forceinline__ void p12_final(Frame& F) {
    const int gw = blockIdx.x * NWAVES + F.wave, NGW = F.G * NWAVES, lane = F.lane;
    const float* gf = F.in[29];
    for (int m = gw; m < MTOT; m += NGW) {
        float* orow = F.out + (m < MPR ? O_Y + (size_t)m * D : O_YS + (size_t)(m - MPR) * D);
        const float r = rsqrtf(F.SS3[m] * (1.0f / D) + EPS);
#pragma unroll
        for (int j = 0; j < 4; ++j) { f32x4* p = (f32x4*)orow + 64 * j + lane; const f32x4 gv = ((const f32x4*)gf)[64 * j + lane]; *p = *p * r * gv; }
    }
}

__global__ void __launch_bounds__(NWAVES * 64, 2) mega_fwd(Args args) {
    extern __shared__ __attribute__((aligned(16))) unsigned char lds_raw[];
    Frame F;
    F.lds = (LAS unsigned char*)lds_raw;
    F.tid = threadIdx.x; F.lane = F.tid & 63; F.wave = __builtin_amdgcn_readfirstlane(F.tid >> 6); F.G = gridDim.x;
    F.in = args.in;
    F.out = args.out; F.ws = args.ws;
    unsigned char* ws = args.ws;
    F.PROJ = (bf16_t*)(ws + WS_PROJ); F.HALO = (bf16_t*)(ws + WS_HALO); F.SMALL = (float*)(ws + WS_SMALL); F.XN = (bf16_t*)(ws + WS_XN); F.PB = (bf16_t*)(ws + WS_PB);
    F.SS1 = (float*)(ws + WS_SS1); F.SS2 = (float*)(ws + WS_SS2); F.SS3 = (float*)(ws + WS_SS3);
    const int lo = args.ph_lo, hi = args.ph_hi;
#if MK_ONE_LAUNCH
    volatile LAS unsigned* MISC = (volatile LAS unsigned*)(F.lds + MISC_OFF);
    if (F.tid < 32) MISC[F.tid] = 0u;
    __syncthreads();
    XcdBarrier bar = xcd_barrier_post((unsigned*)(ws + WS_BAR), MISC + 8);
#define SEAM(k) do { if (lo <= (k) && (k) + 1 < hi) xcd_barrier(bar); } while (0)
#else
#define SEAM(k) do { } while (0)
#endif
#ifndef PHASE_MASK
#define PHASE_MASK 0xffff
#endif
#define IN(k) (((PHASE_MASK >> (k)) & 1) && lo <= (k) && (k) < hi)
    const int bid = (int)blockIdx.x;
    typedef pg8::StaticOrder SO;

    if (IN(0)) { p0_prologue(F); SEAM(0); }
    if (IN(1)) {
        pg8::Gemm g{F.XN, (const bf16_t*)(ws + WS_WIN), MP, NPROJ, D, D, D}; SO S; S.init(MP, NPROJ, F.G, bid);
        EpiInProj E{F.PROJ, F.HALO, F.SMALL};
        pg8::gemm_phase<EpiInProj, SO>(F.lds, g, S, E); SEAM(1);
    }
    if (IN(2)) { p2_conv(F); SEAM(2); }
    if (IN(3)) { p3_scan(F); SEAM(3); }
    if (IN(4)) { p4_norm(F); SEAM(4); }
    if (IN(5)) {
        pg8::Gemm g{F.PROJ + C_XS, (const bf16_t*)(ws + WS_WBS), MP, D, 2048, LDP, 2048}; SO S; S.init(MP, D, F.G, bid);
        EpiT1 E{F.PROJ};
        pg8::gemm_phase<EpiT1, SO>(F.lds, g, S, E); SEAM(5);
    }
    if (IN(6)) {
        pg8::Gemm g{F.PROJ + C_V, (const bf16_t*)(ws + WS_WBG), MP, D, D, LDP, D}; SO S; S.init(MP, D, F.G, bid);
        EpiMix E{F.PROJ};
        pg8::gemm_phase<EpiMix, SO>(F.lds, g, S, E); SEAM(6);
    }
    if (IN(7)) {
        pg8::Gemm g{F.PROJ + C_Q, (const bf16_t*)(ws + WS_WOUT), MP, D, D, LDP, D}; SO S; S.init(MP, D, F.G, bid);
        EpiResid<0> E{F.PROJ, F.in[0], F.in[1], 0, C_Z, C_K, F.SS1};
        pg8::gemm_phase<EpiResid<0>, SO>(F.lds, g, S, E); SEAM(7);
    }
    if (IN(8)) {
        pg8::Gemm g{F.PROJ + C_K, (const bf16_t*)(ws + WS_WFI), MP, 2 * DFF, D, LDP, D}; SO S; S.init(MP, 2 * DFF, F.G, bid);
        EpiSwiGLU E{F.PROJ, F.SS1};
        pg8::gemm_phase<EpiSwiGLU, SO>(F.lds, g, S, E); SEAM(8);
    }
    if (IN(9)) {
        pg8::Gemm g{F.PROJ + C_XS, (const bf16_t*)(ws + WS_WFO), MP, D, DFF, LDP, DFF}; SO S; S.init(MP, D, F.G, bid);
        EpiResid<1> E{F.PROJ, nullptr, nullptr, C_Z, C_MG, C_GATE, F.SS2};
        pg8::gemm_phase<EpiResid<1>, SO>(F.lds, g, S, E); SEAM(9);
    }
    if (IN(10)) {
        pg8::Gemm g{F.PB, (const bf16_t*)(ws + WS_WPP), MP, D, 256, 256, 256}; SO S; S.init(MP, D, F.G, bid);
        EpiPE E{F.PROJ};
        pg8::gemm_phase<EpiPE, SO>(F.lds, g, S, E); SEAM(10);
    }
    if (IN(11)) {
        pg8::Gemm g{F.PROJ + C_GATE, (const bf16_t*)(ws + WS_WPG), MP, D, D, LDP, D}; SO S; S.init(MP, D, F.G, bid);
        EpiX3 E{F.PROJ, F.SS2, F.SS3, F.out};
        pg8::gemm_phase<EpiX3, SO>(F.lds, g, S, E); SEAM(11);
    }
    if (IN(12)) { p12_final(F); }
#undef IN
#undef SEAM
}

constexpr int NPHASES = 13;

extern "C" void kernel_launch(void* const* d_in, const int* in_sizes, int n_in, void* d_out, int out_size, void* d_ws, size_t ws_size, hipStream_t stream) {
    static int grid = 0;
    if (grid == 0) {
        if (n_in != 30 || ws_size < WS_END) { fprintf(stderr, "kernel_launch: bad call: n_in %d ws %zu (need %zu)\n", n_in, ws_size, (size_t)WS_END); grid = -1; return; }
        int dev = 0, cus = 0, per_cu = 0;
        if (hipGetDevice(&dev) != hipSuccess || hipDeviceGetAttribute(&cus, hipDeviceAttributeMultiprocessorCount, dev) != hipSuccess) { grid = -1; return; }
        if (hipFuncSetAttribute((const void*)mega_fwd, hipFuncAttributeMaxDynamicSharedMemorySize, LDS_BYTES) != hipSuccess) { fprintf(stderr, "kernel_launch: hipFuncSetAttribute failed\n"); grid = -1; return; }
        if (hipOccupancyMaxActiveBlocksPerMultiprocessor(&per_cu, (const void*)mega_fwd, NWAVES * 64, LDS_BYTES) != hipSuccess || per_cu < 1) { fprintf(stderr, "kernel_launch: occupancy query says %d\n", per_cu); per_cu = 1; }
        (void)hipGetLastError();
        grid = cus;
    }
    if (grid < 0) return;
    (void)hipMemsetAsync((char*)d_ws + WS_CTL, 0, CTL_BYTES, stream);
    Args a{};
    for (int i = 0; i < 30; ++i) a.in[i] = (const float*)d_in[i];
    a.out = (float*)d_out; a.ws = (unsigned char*)d_ws;
#if MK_ONE_LAUNCH
    a.ph_lo = 0; a.ph_hi = NPHASES;
    void* kargs[] = {&a};
    hipError_t e = hipLaunchCooperativeKernel((const void*)mega_fwd, dim3(grid), dim3(NWAVES * 64), kargs, LDS_BYTES, stream);
    if (e != hipSuccess) fprintf(stderr, "cooperative launch failed: %s (grid %d)\n", hipGetErrorString(e), grid);
#else
    for (int ph = 0; ph < NPHASES; ++ph) {
        a.ph_lo = ph; a.ph_hi = ph + 1;
        hipLaunchKernelGGL(mega_fwd, dim3(grid), dim3(NWAVES * 64), LDS_BYTES, stream, a);
    }
#endif
}
```

```cpp
#include <hip/hip_runtime.h>
#include <hip/hip_cooperative_groups.h>
#include <cstdio>
#include <cstdint>
namespace cg = cooperative_groups;

#ifndef MK_ONE_LAUNCH
#define MK_ONE_LAUNCH 1
#endif

#define LAS __attribute__((address_space(3)))
typedef unsigned short bf16_t;
typedef short bf16x8 __attribute__((ext_vector_type(8)));
typedef float f32x4 __attribute__((ext_vector_type(4)));
typedef float f32x2 __attribute__((ext_vector_type(2)));
typedef unsigned u32x4 __attribute__((ext_vector_type(4)));
typedef unsigned u32x2 __attribute__((ext_vector_type(2)));

constexpr int D = 1024, SEQ = 2048, NBATCH = 8, MPR = NBATCH * SEQ, NSMP = 128, MTOT = MPR + NSMP, MP = 16640;
constexpr int LDP = 11264, LDF = LDP / 2;
constexpr int C_Z = 0, C_XS = 2048, C_B = 4096, C_C = 4608, C_Q = 5120, C_K = 6144, C_V = 7168, C_GATE = 8192, C_MG = 9216;
constexpr int NIN = 11312;
constexpr int NPROJ = 11520;
constexpr int DFF = 2816;
constexpr float EPS = 1e-6f;
constexpr int NCH = 6144;

constexpr size_t O_Y = 0, O_YS = 16777216, O_SSMP = 16908288, O_SCONVP = 19005440, O_GDNP = 19079168, O_GCONVP = 20127744,
                 O_SSMS = 20201472, O_SCONVS = 53755904, O_GDNS = 54935552, O_GCONVS = 71712768;

constexpr size_t MiB = 1u << 20;
constexpr size_t WS_CTL = 0, CTL_BYTES = 1 * MiB;
constexpr size_t WS_BAR = 16384;
constexpr size_t WS_SS1 = 65536, WS_SS2 = WS_SS1 + 69632, WS_SS3 = WS_SS2 + 69632;
constexpr size_t WS_WIN = 1 * MiB, WS_WBS = 25 * MiB, WS_WBG = 29 * MiB, WS_WOUT = 31 * MiB, WS_WFI = 33 * MiB, WS_WFO = 44 * MiB, WS_WPG = 50 * MiB, WS_WPP = 52 * MiB;
constexpr size_t WS_XN = 53 * MiB, WS_PB = 86 * MiB, WS_SMALL = 95 * MiB, WS_HALO = 100 * MiB, WS_PROJ = 110 * MiB;
constexpr size_t WS_END0 = WS_PROJ + (size_t)MP * LDP * 2;
constexpr size_t WS_WT = WS_XN, WS_QKM = WS_WIN, WS_UT = 468 * MiB, WS_GC = 500 * MiB;
constexpr size_t WS_END = WS_GC + 2048 * 64 * 4;
static_assert(WS_END0 <= WS_UT && WS_UT + 32 * MiB <= WS_GC, "ws map 2");
static_assert(WS_END <= 512 * MiB, "ws map");
static_assert(WS_SS3 + 69632 <= CTL_BYTES, "ctl");

typedef __bf16 bf16x2_t __attribute__((ext_vector_type(2)));
__device__ __forceinline__ unsigned cvt_pk_bf16(float lo, float hi) { const f32x2 v = {lo, hi}; const bf16x2_t b = __builtin_convertvector(v, bf16x2_t); return __builtin_bit_cast(unsigned, b); }
__device__ __forceinline__ float bflo(unsigned w) { return __uint_as_float(w << 16); }
__device__ __forceinline__ float bfhi(unsigned w) { return __uint_as_float(w & 0xffff0000u); }
__device__ __forceinline__ float bf2f(bf16_t b) { return __uint_as_float((unsigned)b << 16); }
__device__ __forceinline__ void unpack8(const u32x4 w, float (&f)[8]) { f[0] = bflo(w.x); f[1] = bfhi(w.x); f[2] = bflo(w.y); f[3] = bfhi(w.y); f[4] = bflo(w.z); f[5] = bfhi(w.z); f[6] = bflo(w.w); f[7] = bfhi(w.w); }
__device__ __forceinline__ u32x4 pack8(const float (&f)[8]) { u32x4 w; w.x = cvt_pk_bf16(f[0], f[1]); w.y = cvt_pk_bf16(f[2], f[3]); w.z = cvt_pk_bf16(f[4], f[5]); w.w = cvt_pk_bf16(f[6], f[7]); return w; }
__device__ __forceinline__ float sigmoidf_(float x) { return __builtin_amdgcn_rcpf(1.0f + __builtin_amdgcn_exp2f(-1.4426950408889634f * x)); }
__device__ __forceinline__ float siluf_(float x) { return x * sigmoidf_(x); }
__device__ __forceinline__ float softplusf_(float x) { return x > 20.f ? x : log1pf(__expf(x)); }
__device__ __forceinline__ float wave_sum(float v) {
#pragma unroll
    for (int o = 1; o < 64; o <<= 1) v += __shfl_xor(v, o);
    return v;
}

namespace pg8 {
constexpr int BM = 256, BK = 64, HALF = 128, HTB = HALF * BK * 2, STAGE_BYTES = 8 * HTB, NXCD = 8, WGM = 8;
__host__ __device__ __forceinline__ int lds_byte(int r, int c) { const int st = (r >> 4) * 2 + (c >> 5), rr = r & 15, cc = c & 31, ob = rr * 64 + cc * 2; return st * 1024 + (ob ^ (((ob >> 9) & 1) << 5)); }
__host__ __device__ __forceinline__ void stage_rc(int b, int& R, int& C) { const int st = b / 1024, sb = b % 1024, swz = sb ^ (((sb >> 9) & 1) << 5); R = (st >> 1) * 16 + swz / 64; C = (st & 1) * 32 + (swz % 64) / 2; }
__host__ __device__ __forceinline__ int perm32(int rho) { const int n = rho >> 4, i = rho & 15; return 8 * (i >> 2) + 4 * n + (i & 3); }

struct Unit { int pm, pn; };
struct Gemm { const bf16_t* A; const bf16_t* Bt; int M, N, K, lda, ldb; };

struct StaticOrder {
    int nM, nN, nwg, G, c;
    __host__ __device__ void init(int M, int N, int G_, int c_) { nM = M / BM; nN = N / BM; nwg = nM * nN; G = G_; c = c_; }
    __host__ __device__ bool next(int i, Unit& u) const {
        const long L = (long)i * G + c; if (L >= nwg) return false;
        int wgid = (int)L; { const int q = nwg / NXCD, r = nwg % NXCD, xcd = wgid % NXCD, off = wgid / NXCD; wgid = (xcd < r ? xcd * (q + 1) : r * (q + 1) + (xcd - r) * q) + off; }
        const int nig = WGM * nN, gid = wgid / nig, fm = gid * WGM, gsz = (nM - fm) < WGM ? (nM - fm) : WGM;
        u.pm = fm + ((wgid % nig) % gsz); u.pn = (wgid % nig) / gsz; return true;
    }
    __device__ __forceinline__ void a_ready(const Unit&) const {}
    __device__ __forceinline__ void done(const Unit&) const {}
};

template <class Epi, class Sched, bool ALIGN_EPI = true, bool SP2 = true>
__device__ __forceinline__ void gemm_phase(LAS unsigned char* lds, const Gemm g, const Sched& S, const Epi& E) {
    const int tid = threadIdx.x, wid = __builtin_amdgcn_readfirstlane(tid >> 6), lane = tid & 63, wr = wid >> 2, wc = wid & 3, fr = lane & 15, fq = lane >> 4;
    int nt = g.K / BK; asm volatile("" : "+s"(nt));
    unsigned voffA[2], voffB[2];
#pragma unroll
    for (int i = 0; i < 2; ++i) { int R, C; stage_rc(tid * 16 + i * 8192, R, C); const int Rb = Epi::PERM ? ((R & ~31) + perm32(R & 31)) : R;
        voffA[i] = (unsigned)(R * g.lda + C) * 2u; voffB[i] = (unsigned)(Rb * g.ldb + C) * 2u; }
    const size_t kstep = (size_t)(BK * 2);
    const size_t hstepA = (size_t)HALF * g.lda * 2, hstepB = (size_t)HALF * g.ldb * 2;
    const size_t tstepA = 2 * hstepA, tstepB = 2 * hstepB;
    const unsigned ldsw = (unsigned)wid * 1024u;
    const int aoff = lds_byte(wr * 64 + fr, fq * 8), boff = lds_byte(wc * 32 + fr, fq * 8);
#define PG8_SA(b, h) (((b) * 2 + (h)) * HTB)
#define PG8_SB(b, h) ((4 + (b) * 2 + (h)) * HTB)
#define PG8_STAGE(bufoff, gbase, voff) do { _Pragma("unroll") for (int _i = 0; _i < 2; ++_i) \
        __builtin_amdgcn_global_load_lds((const unsigned*)((const char*)(gbase) + (voff)[_i]), (LAS unsigned*)(lds + (bufoff) + ldsw + _i * 8192), 16, 0, 0); } while (0)
#define PG8_LDA(dst, b, h) do { _Pragma("unroll") for (int m = 0; m < 4; ++m) _Pragma("unroll") for (int k = 0; k < 2; ++k) dst[m][k] = *(const LAS bf16x8*)(lds + PG8_SA(b, h) + aoff + m * 2048 + k * 1024); } while (0)
#define PG8_LDB(dst, b, h) do { _Pragma("unroll") for (int n = 0; n < 2; ++n) _Pragma("unroll") for (int k = 0; k < 2; ++k) dst[n][k] = *(const LAS bf16x8*)(lds + PG8_SB(b, h) + boff + n * 2048 + k * 1024); } while (0)
#define PG8_MMA(ai, bj, At, Bt) do { __builtin_amdgcn_s_setprio(1); _Pragma("unroll") for (int m = 0; m < 4; ++m) _Pragma("unroll") for (int n = 0; n < 2; ++n) _Pragma("unroll") for (int k = 0; k < 2; ++k) \
        acc[ai][bj][m][n] = __builtin_amdgcn_mfma_f32_16x16x32_bf16(Bt[n][k], At[m][k], acc[ai][bj][m][n], 0, 0, 0); __builtin_amdgcn_s_setprio(0); } while (0)
#define PG8_WAIT_V(n) asm volatile("s_waitcnt vmcnt(" #n ")" ::: "memory")
#define PG8_WAIT_L(n) asm volatile("s_waitcnt lgkmcnt(" #n ")" ::: "memory")
#define PG8_BAR __builtin_amdgcn_s_barrier()
#define PG8_SCHED __builtin_amdgcn_sched_barrier(0)
    Unit cur, nxt; int ui = 0;
    if (!S.next(0, cur)) return;
    f32x4 acc[2][2][4][2];
#pragma unroll
    for (int a = 0; a < 2; ++a)
#pragma unroll
        for (int b = 0; b < 2; ++b)
#pragma unroll
            for (int m = 0; m < 4; ++m)
#pragma unroll
                for (int n = 0; n < 2; ++n) acc[a][b][m][n] = (f32x4){0.f, 0.f, 0.f, 0.f};
    bf16x8 At[4][2], B0[2][2], B1[2][2];
    const char* cA = (const char*)g.A + (size_t)cur.pm * tstepA; const char* cB = (const char*)g.Bt + (size_t)cur.pn * tstepB;
    S.a_ready(cur);
    if constexpr (SP2) {
        PG8_STAGE(PG8_SB(0, 0), cB, voffB); PG8_STAGE(PG8_SB(0, 1), cB + hstepB, voffB); PG8_STAGE(PG8_SA(0, 0), cA, voffA); PG8_STAGE(PG8_SA(0, 1), cA + hstepA, voffA);
        if (wr == 1) PG8_BAR;
        PG8_WAIT_V(2); PG8_BAR;
        PG8_STAGE(PG8_SB(1, 0), cB + kstep, voffB); PG8_STAGE(PG8_SA(1, 0), cA + kstep, voffA); PG8_STAGE(PG8_SB(1, 1), cB + hstepB + kstep, voffB);
        PG8_WAIT_V(6); PG8_BAR;
    } else {
        PG8_STAGE(PG8_SB(0, 0), cB, voffB); PG8_STAGE(PG8_SA(0, 0), cA, voffA); PG8_STAGE(PG8_SB(0, 1), cB + hstepB, voffB); PG8_STAGE(PG8_SA(0, 1), cA + hstepA, voffA);
        if (wr == 1) PG8_BAR;
        PG8_WAIT_V(4); PG8_BAR;
        PG8_STAGE(PG8_SB(1, 0), cB + kstep, voffB); PG8_STAGE(PG8_SA(1, 0), cA + kstep, voffA); PG8_STAGE(PG8_SB(1, 1), cB + hstepB + kstep, voffB);
        PG8_WAIT_V(6); PG8_BAR;
    }
    for (;;) {
        const bool has_next = S.next(ui + 1, nxt);
        const char* nA = has_next ? (const char*)g.A + (size_t)nxt.pm * tstepA : cA; const char* nB = has_next ? (const char*)g.Bt + (size_t)nxt.pn * tstepB : cB;
        for (int t = 0; t < nt; t += 2) {
            const bool last = (t == nt - 2);
            const char* a1 = cA + (size_t)(t + 1) * kstep;
            const char* a2 = last ? nA : cA + (size_t)(t + 2) * kstep; const char* b2 = last ? nB : cB + (size_t)(t + 2) * kstep;
            const char* a3 = a2 + kstep; const char* b3 = b2 + kstep;
            if (last && has_next) S.a_ready(nxt);
            if constexpr (SP2) {
            PG8_LDB(B0, 0, 0); PG8_LDB(B1, 0, 1); PG8_SCHED; PG8_LDA(At, 0, 0); PG8_STAGE(PG8_SA(1, 1), a1 + hstepA, voffA);
            PG8_WAIT_V(8); PG8_WAIT_L(0); PG8_BAR; PG8_MMA(0, 0, At, B0); PG8_MMA(0, 1, At, B1); PG8_BAR; PG8_SCHED;
            PG8_LDA(At, 0, 1); PG8_STAGE(PG8_SB(0, 0), b2, voffB); PG8_STAGE(PG8_SB(0, 1), b2 + hstepB, voffB); PG8_STAGE(PG8_SA(0, 0), a2, voffA);
            PG8_WAIT_V(8); PG8_WAIT_L(0); PG8_BAR; PG8_MMA(1, 0, At, B0); PG8_MMA(1, 1, At, B1); PG8_BAR; PG8_SCHED;
            PG8_LDB(B0, 1, 0); PG8_LDB(B1, 1, 1); PG8_SCHED; PG8_LDA(At, 1, 0); PG8_STAGE(PG8_SA(0, 1), a2 + hstepA, voffA);
            PG8_WAIT_V(8); PG8_WAIT_L(0); PG8_BAR; PG8_MMA(0, 0, At, B0); PG8_MMA(0, 1, At, B1); PG8_BAR; PG8_SCHED;
            PG8_LDA(At, 1, 1); PG8_STAGE(PG8_SB(1, 0), b3, voffB); PG8_STAGE(PG8_SB(1, 1), b3 + hstepB, voffB); PG8_STAGE(PG8_SA(1, 0), a3, voffA);
            PG8_WAIT_V(8); PG8_WAIT_L(0); PG8_BAR; PG8_MMA(1, 0, At, B0); PG8_MMA(1, 1, At, B1); PG8_BAR; PG8_SCHED;
            } else {
            PG8_LDB(B0, 0, 0); PG8_SCHED; PG8_LDA(At, 0, 0); PG8_STAGE(PG8_SA(1, 1), a1 + hstepA, voffA);
            PG8_WAIT_L(8); PG8_BAR; PG8_WAIT_L(0); PG8_MMA(0, 0, At, B0); PG8_BAR; PG8_SCHED;
            PG8_LDB(B1, 0, 1); PG8_STAGE(PG8_SB(0, 0), b2, voffB);
            PG8_BAR; PG8_WAIT_L(0); PG8_MMA(0, 1, At, B1); PG8_BAR;
            PG8_LDA(At, 0, 1); PG8_STAGE(PG8_SA(0, 0), a2, voffA);
            PG8_BAR; PG8_WAIT_L(0); PG8_MMA(1, 0, At, B0); PG8_BAR; PG8_SCHED;
            PG8_STAGE(PG8_SB(0, 1), b2 + hstepB, voffB);
            PG8_WAIT_V(6); PG8_BAR; PG8_MMA(1, 1, At, B1); PG8_BAR;
            PG8_LDB(B0, 1, 0); PG8_SCHED; PG8_LDA(At, 1, 0); PG8_STAGE(PG8_SA(0, 1), a2 + hstepA, voffA);
            PG8_WAIT_L(8); PG8_BAR; PG8_WAIT_L(0); PG8_MMA(0, 0, At, B0); PG8_BAR; PG8_SCHED;
            PG8_LDB(B1, 1, 1); PG8_STAGE(PG8_SB(1, 0), b3, voffB);
            PG8_BAR; PG8_WAIT_L(0); PG8_MMA(0, 1, At, B1); PG8_BAR;
            PG8_LDA(At, 1, 1); PG8_STAGE(PG8_SA(1, 0), a3, voffA);
            PG8_BAR; PG8_WAIT_L(0); PG8_MMA(1, 0, At, B0); PG8_BAR; PG8_SCHED;
            PG8_STAGE(PG8_SB(1, 1), b3 + hstepB, voffB);
            PG8_WAIT_V(6); PG8_BAR; PG8_MMA(1, 1, At, B1); PG8_BAR;
            }
        }
        if constexpr (ALIGN_EPI) { if (wr == 0) PG8_BAR; }
        E(acc, cur, wr, wc, fr, fq); S.done(cur);
        if (!has_next) break;
#pragma unroll
        for (int a = 0; a < 2; ++a)
#pragma unroll
            for (int b = 0; b < 2; ++b)
#pragma unroll
                for (int m = 0; m < 4; ++m)
#pragma unroll
                    for (int n = 0; n < 2; ++n) acc[a][b][m][n] = (f32x4){0.f, 0.f, 0.f, 0.f};
        cur = nxt; cA = nA; cB = nB; ++ui;
        if constexpr (ALIGN_EPI) { if (wr == 1) PG8_BAR; }
    }
    PG8_WAIT_V(0);
    if constexpr (!ALIGN_EPI) { if (wr == 0) PG8_BAR; }
    PG8_BAR;
#undef PG8_SA
#undef PG8_SB
#undef PG8_STAGE
#undef PG8_LDA
#undef PG8_LDB
#undef PG8_MMA
#undef PG8_WAIT_V
#undef PG8_WAIT_L
#undef PG8_BAR
#undef PG8_SCHED
}
}
using pg8::Unit;


#define XB_TMO      128
#define XB_XCNT(j)  (256  + 64 * (j))
#define XB_XSUB(j)  (1280 + 64 * (j))
#define XB_XGEN(j)  (2304 + 64 * (j))
#define XB_TOP      3328
#define XB_TOPGEN   3392
#define XCD_BAR_WORDS 3456
#define XB_SPIN_CAP (1u << 22)
__device__ __forceinline__ unsigned xb_ld(unsigned* p)              { return __hip_atomic_load(p, __ATOMIC_RELAXED, __HIP_MEMORY_SCOPE_AGENT); }
__device__ __forceinline__ unsigned xb_add(unsigned* p, unsigned v) { return __hip_atomic_fetch_add(p, v, __ATOMIC_RELAXED, __HIP_MEMORY_SCOPE_AGENT); }
__device__ __forceinline__ unsigned xb_xcc_id() { return (unsigned)__builtin_amdgcn_s_getreg((3 << 11) | 20) & 0xFu; }
#define XB_SPIN(cond, bar) do { unsigned _sp = 0; while (cond) { __builtin_amdgcn_s_sleep(1); \
    if ((++_sp & 255u) == 0u) { if (xb_ld(&(bar)[XB_TMO])) break; if (_sp > XB_SPIN_CAP) { atomicAdd(&(bar)[XB_TMO], 1u); break; } } } } while (0)
struct XcdBarrier { unsigned* bar; unsigned x; volatile LAS unsigned* st; };
__device__ __forceinline__ XcdBarrier xcd_barrier_post(unsigned* bar, volatile LAS unsigned* st) {
    XcdBarrier b; b.bar = bar; b.x = xb_xcc_id(); b.st = st;
    if (threadIdx.x == 0) (void)xb_add(&bar[XB_XCNT(b.x)], 1u);
    return b;
}
__device__ __forceinline__ void xcd_barrier_complete(unsigned* bar, unsigned x, unsigned& nloc, unsigned& nx) {
    const unsigned G = gridDim.x * gridDim.y * gridDim.z;
    unsigned sum, cnt, mine, sp = 0u;
    for (;;) {
        sum = 0u; cnt = 0u; mine = 0u;
#pragma unroll
        for (unsigned j = 0; j < 16; ++j) { const unsigned c = xb_ld(&bar[XB_XCNT(j)]); sum += c; cnt += (c > 0u) ? 1u : 0u; mine = (j == x) ? c : mine; }
        if (sum == G) break;
        __builtin_amdgcn_s_sleep(1);
        if ((++sp & 255u) == 0u) { if (xb_ld(&bar[XB_TMO])) break; if (sp > XB_SPIN_CAP) { atomicAdd(&bar[XB_TMO], 1u); break; } }
    }
    nloc = mine > 0u ? mine : 1u; nx = cnt > 0u ? cnt : 1u;
}
__device__ __forceinline__ void xcd_barrier(const XcdBarrier& b) {
    asm volatile("s_waitcnt vmcnt(0)" ::: "memory");
    __syncthreads();
    if (threadIdx.x == 0) {
        unsigned* bar = b.bar;
        __builtin_amdgcn_s_waitcnt(0);
        unsigned nloc = b.st[0], nx = b.st[1];
        if (nloc == 0u) { xcd_barrier_complete(bar, b.x, nloc, nx); b.st[0] = nloc; b.st[1] = nx; }
        const unsigned old = xb_add(&bar[XB_XSUB(b.x)], 1u);
        const unsigned gen = old / nloc;
        if (old + 1u == (gen + 1u) * nloc) {
            __builtin_amdgcn_fence(__ATOMIC_RELEASE, "agent");
            asm volatile("s_waitcnt vmcnt(0)" ::: "memory");
            const unsigned og = xb_add(&bar[XB_TOP], 1u);
            const unsigned tg = og / nx;
            if (og + 1u == (tg + 1u) * nx) xb_add(&bar[XB_TOPGEN], 1u);
            else XB_SPIN(xb_ld(&bar[XB_TOPGEN]) == tg, bar);
            __builtin_amdgcn_fence(__ATOMIC_ACQUIRE, "agent");
            xb_add(&bar[XB_XGEN(b.x)], 1u);
            asm volatile("s_waitcnt vmcnt(0)" ::: "memory");
        } else {
            XB_SPIN(xb_ld(&bar[XB_XGEN(b.x)]) == gen, bar);
            __builtin_amdgcn_fence(__ATOMIC_ACQUIRE, "agent");
            asm volatile("s_waitcnt vmcnt(0)" ::: "memory");
        }
    }
    __syncthreads();
}

struct Args {
    const float* in[30];
    float* out;
    unsigned char* ws;
    int ph_lo, ph_hi;
};

struct Frame {
    LAS unsigned char* lds;
    int tid, lane, wave, G;
    const float* const* in;
    float* out;
    unsigned char* ws;
    bf16_t* PROJ; bf16_t* HALO; float* SMALL; bf16_t* XN; bf16_t* PB;
    float *SS1, *SS2, *SS3;
};

constexpr int NWAVES = 8;
constexpr int RING_BYTES = 131072, MISC_OFF = RING_BYTES + 320, LDS_BYTES = 147456;

struct EpiInProj {
    static constexpr bool PERM = true;
    bf16_t* PROJ; bf16_t* HALO; float* SMALL;
    __device__ __forceinline__ void operator()(const f32x4 (&acc)[2][2][4][2], const Unit& u, int wr, int wc, int fr, int fq) const {
        const int row0 = u.pm * 256 + wr * 64 + fr;
        if (u.pn < 44) {
            const int col0 = u.pn * 256 + wc * 32 + 8 * fq;
            const bool conv_tile = (u.pn >= 8 && u.pn < 32);
#pragma unroll
            for (int ai = 0; ai < 2; ++ai)
#pragma unroll
                for (int m = 0; m < 4; ++m) {
                    const int row = row0 + ai * 128 + m * 16;
                    bf16_t* rowp = PROJ + (size_t)row * LDP + col0;
#pragma unroll
                    for (int bj = 0; bj < 2; ++bj) {
                        const f32x4 v0 = acc[ai][bj][m][0], v1 = acc[ai][bj][m][1];
                        u32x4 w; w.x = cvt_pk_bf16(v0[0], v0[1]); w.y = cvt_pk_bf16(v0[2], v0[3]); w.z = cvt_pk_bf16(v1[0], v1[1]); w.w = cvt_pk_bf16(v1[2], v1[3]);
                        *(u32x4*)(rowp + bj * 128) = w;
                        if (m == 3 && conv_tile && fr >= 13) {
                            bf16_t* hp = HALO + ((size_t)(row >> 6) * 3 + (fr - 13)) * NCH + (col0 - C_XS) + bj * 128;
                            *(u32x4*)hp = w;
                        }
                    }
                }
        } else {
            if (wc < 2) {
                const int col0 = wc * 32 + 8 * fq;
#pragma unroll
                for (int ai = 0; ai < 2; ++ai)
#pragma unroll
                    for (int m = 0; m < 4; ++m) {
                        const int row = row0 + ai * 128 + m * 16;
                        float* sp = SMALL + (size_t)row * 64 + col0;
                        *(f32x4*)sp = acc[ai][0][m][0]; *(f32x4*)(sp + 4) = acc[ai][0][m][1];
                    }
            }
        }
    }
};

struct EpiT1 {
    static constexpr bool PERM = true;
    bf16_t* PROJ;
    __device__ __forceinline__ void operator()(const f32x4 (&acc)[2][2][4][2], const Unit& u, int wr, int wc, int fr, int fq) const {
        const int row0 = u.pm * 256 + wr * 64 + fr, col0 = u.pn * 256 + wc * 32 + 8 * fq;
#pragma unroll
        for (int ai = 0; ai < 2; ++ai)
#pragma unroll
            for (int m = 0; m < 4; ++m) {
                const int row = row0 + ai * 128 + m * 16;
#pragma unroll
                for (int bj = 0; bj < 2; ++bj) {
                    const int col = col0 + bj * 128;
                    const u32x4 mgw = *(const u32x4*)(PROJ + (size_t)row * LDP + C_MG + col);
                    float mg[8]; unpack8(mgw, mg);
                    const f32x4 v0 = acc[ai][bj][m][0], v1 = acc[ai][bj][m][1];
                    f32x4 o0, o1;
#pragma unroll
                    for (int i = 0; i < 4; ++i) { o0[i] = v0[i] * sigmoidf_(mg[i]); o1[i] = v1[i] * sigmoidf_(mg[4 + i]); }
                    float* tp = (float*)PROJ + (size_t)row * LDF + col;
                    *(f32x4*)tp = o0; *(f32x4*)(tp + 4) = o1;
                }
            }
    }
};

struct EpiMix {
    static constexpr bool PERM = true;
    bf16_t* PROJ;
    __device__ __forceinline__ void operator()(const f32x4 (&acc)[2][2][4][2], const Unit& u, int wr, int wc, int fr, int fq) const {
        const int row0 = u.pm * 256 + wr * 64 + fr, col0 = u.pn * 256 + wc * 32 + 8 * fq;
#pragma unroll
        for (int ai = 0; ai < 2; ++ai)
#pragma unroll
            for (int m = 0; m < 4; ++m) {
                const int row = row0 + ai * 128 + m * 16;
#pragma unroll
                for (int bj = 0; bj < 2; ++bj) {
                    const int col = col0 + bj * 128;
                    const u32x4 mgw = *(const u32x4*)(PROJ + (size_t)row * LDP + C_MG + 1024 + col);
                    float mg[8]; unpack8(mgw, mg);
                    const float* tp = (const float*)PROJ + (size_t)row * LDF + col;
                    const f32x4 t0 = *(const f32x4*)tp, t1 = *(const f32x4*)(tp + 4);
                    const f32x4 v0 = acc[ai][bj][m][0], v1 = acc[ai][bj][m][1];
                    float o[8];
#pragma unroll
                    for (int i = 0; i < 4; ++i) { o[i] = t0[i] + v0[i] * sigmoidf_(mg[i]); o[4 + i] = t1[i] + v1[i] * sigmoidf_(mg[4 + i]); }
                    *(u32x4*)(PROJ + (size_t)row * LDP + C_Q + col) = pack8(o);
                }
            }
    }
};

template <int MODE> struct EpiResid {
    static constexpr bool PERM = true;
    bf16_t* PROJ; const float* xp; const float* xs; int res_col  , dst_col  , dstb_col; float* SS;
    __device__ __forceinline__ void operator()(const f32x4 (&acc)[2][2][4][2], const Unit& u, int wr, int wc, int fr, int fq) const {
        const int row0 = u.pm * 256 + wr * 64 + fr, col0 = u.pn * 256 + wc * 32 + 8 * fq;
#pragma unroll
        for (int ai = 0; ai < 2; ++ai)
#pragma unroll
            for (int m = 0; m < 4; ++m) {
                const int row = row0 + ai * 128 + m * 16;
                float ss = 0.f;
#pragma unroll
                for (int bj = 0; bj < 2; ++bj) {
                    const int col = col0 + bj * 128;
                    f32x4 r0 = (f32x4){0.f, 0.f, 0.f, 0.f}, r1 = r0;
                    if (MODE == 0) {
                        if (row < MTOT) { const float* rp = (row < MPR ? xp + (size_t)row * D : xs + (size_t)(row - MPR) * D) + col; r0 = *(const f32x4*)rp; r1 = *(const f32x4*)(rp + 4); }
                    } else {
                        const float* rp = (const float*)(PROJ + res_col) + (size_t)row * LDF + col; r0 = *(const f32x4*)rp; r1 = *(const f32x4*)(rp + 4);
                    }
                    const f32x4 x0 = r0 + acc[ai][bj][m][0], x1 = r1 + acc[ai][bj][m][1];
                    float* dp = (float*)(PROJ + dst_col) + (size_t)row * LDF + col;
                    *(f32x4*)dp = x0; *(f32x4*)(dp + 4) = x1;
                    u32x4 w; w.x = cvt_pk_bf16(x0[0], x0[1]); w.y = cvt_pk_bf16(x0[2], x0[3]); w.z = cvt_pk_bf16(x1[0], x1[1]); w.w = cvt_pk_bf16(x1[2], x1[3]);
                    *(u32x4*)(PROJ + (size_t)row * LDP + dstb_col + col) = w;
                    ss += (x0[0] * x0[0] + x0[1] * x0[1]) + (x0[2] * x0[2] + x0[3] * x0[3]) + (x1[0] * x1[0] + x1[1] * x1[1]) + (x1[2] * x1[2] + x1[3] * x1[3]);
                }
                ss += __shfl_xor(ss, 16); ss += __shfl_xor(ss, 32);
                if (fq == 0) atomicAdd(SS + row, ss);
            }
    }
};

struct EpiSwiGLU {
    static constexpr bool PERM = true;
    bf16_t* PROJ; const float* SS;
    __device__ __forceinline__ void operator()(const f32x4 (&acc)[2][2][4][2], const Unit& u, int wr, int wc, int fr, int fq) const {
        const int row0 = u.pm * 256 + wr * 64 + fr, col0 = u.pn * 128 + wc * 32 + 8 * fq;
#pragma unroll
        for (int ai = 0; ai < 2; ++ai)
#pragma unroll
            for (int m = 0; m < 4; ++m) {
                const int row = row0 + ai * 128 + m * 16;
                const float r = rsqrtf(SS[row] * (1.0f / D) + EPS);
                const f32x4 g0 = acc[ai][0][m][0], g1 = acc[ai][0][m][1], u0 = acc[ai][1][m][0], u1 = acc[ai][1][m][1];
                float o[8];
#pragma unroll
                for (int i = 0; i < 4; ++i) { o[i] = siluf_(r * g0[i]) * (r * u0[i]); o[4 + i] = siluf_(r * g1[i]) * (r * u1[i]); }
                *(u32x4*)(PROJ + (size_t)row * LDP + C_XS + col0) = pack8(o);
            }
    }
};

struct EpiPE {
    static constexpr bool PERM = true;
    bf16_t* PROJ;
    __device__ __forceinline__ void operator()(const f32x4 (&acc)[2][2][4][2], const Unit& u, int wr, int wc, int fr, int fq) const {
        const int row0 = u.pm * 256 + wr * 64 + fr, col0 = u.pn * 256 + wc * 32 + 8 * fq;
#pragma unroll
        for (int ai = 0; ai < 2; ++ai)
#pragma unroll
            for (int m = 0; m < 4; ++m) {
                const int row = row0 + ai * 128 + m * 16;
#pragma unroll
                for (int bj = 0; bj < 2; ++bj) {
                    float* tp = (float*)PROJ + (size_t)row * LDF + col0 + bj * 128;
                    *(f32x4*)tp = acc[ai][bj][m][0]; *(f32x4*)(tp + 4) = acc[ai][bj][m][1];
                }
            }
    }
};

struct EpiX3 {
    static constexpr bool PERM = true;
    bf16_t* PROJ; const float* SS2; float* SS3; float* out;
    __device__ __forceinline__ void operator()(const f32x4 (&acc)[2][2][4][2], const Unit& u, int wr, int wc, int fr, int fq) const {
        const int row0 = u.pm * 256 + wr * 64 + fr, col0 = u.pn * 256 + wc * 32 + 8 * fq;
#pragma unroll
        for (int ai = 0; ai < 2; ++ai)
#pragma unroll
            for (int m = 0; m < 4; ++m) {
                const int row = row0 + ai * 128 + m * 16;
                const float r = rsqrtf(SS2[row] * (1.0f / D) + EPS);
                float ss = 0.f;
#pragma unroll
                for (int bj = 0; bj < 2; ++bj) {
                    const int col = col0 + bj * 128;
                    const float* x2p = (const float*)(PROJ + C_MG) + (size_t)row * LDF + col;
                    const float* pep = (const float*)PROJ + (size_t)row * LDF + col;
                    const f32x4 a0 = *(const f32x4*)x2p, a1 = *(const f32x4*)(x2p + 4), p0 = *(const f32x4*)pep, p1 = *(const f32x4*)(pep + 4);
                    const f32x4 v0 = acc[ai][bj][m][0], v1 = acc[ai][bj][m][1];
                    f32x4 x0, x1;
#pragma unroll
                    for (int i = 0; i < 4; ++i) { x0[i] = a0[i] + p0[i] * sigmoidf_(r * v0[i]); x1[i] = a1[i] + p1[i] * sigmoidf_(r * v1[i]); }
                    if (row < MTOT) { float* op = out + (row < MPR ? O_Y + (size_t)row * D : O_YS + (size_t)(row - MPR) * D) + col; *(f32x4*)op = x0; *(f32x4*)(op + 4) = x1; }
                    ss += (x0[0] * x0[0] + x0[1] * x0[1]) + (x0[2] * x0[2] + x0[3] * x0[3]) + (x1[0] * x1[0] + x1[1] * x1[1]) + (x1[2] * x1[2] + x1[3] * x1[3]);
                }
                ss += __shfl_xor(ss, 16); ss += __shfl_xor(ss, 32);
                if (fq == 0) atomicAdd(SS3 + row, ss);
            }
    }
};

struct MapIdent { __device__ __forceinline__ int operator()(int n) const { return n; } };
struct MapWin {
    __device__ __forceinline__ int operator()(int n) const {
        if (n < 5120) return n;
        if (n < 9216) return n + 32;
        if (n < 11264) return n + 48;
        const int j = n - 11264;
        if (j < 32) return 5120 + j;
        if (j < 48) return 9216 + j;
        return -1;
    }
};
struct MapFfn {
    __device__ __forceinline__ int operator()(int n) const { const int j = n >> 8, r = n & 255; return r < 128 ? 128 * j + r : DFF + 128 * j + (r - 128); }
};
template <class Map>
__device__ __forceinline__ void transpose_item(const float* W, int K, int Nsrc, int Ndst, bf16_t* WT, const float* gain, LAS float* scr, int item, int lane, Map map) {
    const int nblk = Ndst / 32, kb = item / nblk, nb = item % nblk, k0 = 64 * kb, n0 = 32 * nb;
    const int sc = map(n0 + (lane & 31));
#pragma unroll 8
    for (int i = 0; i < 32; ++i) { const int kk = 2 * i + (lane >> 5); float v = sc >= 0 ? W[(size_t)(k0 + kk) * Nsrc + sc] : 0.f; if (gain) v *= gain[k0 + kk]; scr[kk * 33 + (lane & 31)] = v; }
    asm volatile("s_waitcnt lgkmcnt(0)" ::: "memory");
    const int c = lane & 7;
#pragma unroll
    for (int j = 0; j < 4; ++j) { const int n = (lane >> 3) + 8 * j; const LAS float* s = scr + (8 * c) * 33 + n;
        u32x4 o; o.x = cvt_pk_bf16(s[0 * 33], s[1 * 33]); o.y = cvt_pk_bf16(s[2 * 33], s[3 * 33]); o.z = cvt_pk_bf16(s[4 * 33], s[5 * 33]); o.w = cvt_pk_bf16(s[6 * 33], s[7 * 33]);
        *(u32x4*)(WT + (size_t)(n0 + n) * K + k0 + 8 * c) = o; }
    asm volatile("s_waitcnt lgkmcnt(0)" ::: "memory");
}

__device__ __forceinline__ void p0_prologue(Frame& F) {
    LAS float* scr = (LAS float*)(F.lds + F.wave * 16384);
    const int gw = blockIdx.x * NWAVES + F.wave, NGW = F.G * NWAVES;
    unsigned char* ws = F.ws;
    constexpr int I_WIN = 16 * (NPROJ / 32), I_WBS = 32 * 32, I_WBG = 16 * 32, I_WOUT = 16 * 32, I_WFI = 16 * (2 * DFF / 32), I_WFO = (DFF / 64) * 32, I_WPG = 16 * 32, I_WPP = 4 * 32;
    constexpr int NITEMS = I_WIN + I_WBS + I_WBG + I_WOUT + I_WFI + I_WFO + I_WPG + I_WPP;
    for (int it = gw; it < NITEMS; it += NGW) {
        int r = it;
        if (r < I_WIN) { transpose_item(F.in[9], D, NIN, NPROJ, (bf16_t*)(ws + WS_WIN), nullptr, scr, r, F.lane, MapWin()); continue; } r -= I_WIN;
        if (r < I_WBS) { transpose_item(F.in[20], 2048, D, D, (bf16_t*)(ws + WS_WBS), nullptr, scr, r, F.lane, MapIdent()); continue; } r -= I_WBS;
        if (r < I_WBG) { transpose_item(F.in[21], D, D, D, (bf16_t*)(ws + WS_WBG), nullptr, scr, r, F.lane, MapIdent()); continue; } r -= I_WBG;
        if (r < I_WOUT) { transpose_item(F.in[22], D, D, D, (bf16_t*)(ws + WS_WOUT), nullptr, scr, r, F.lane, MapIdent()); continue; } r -= I_WOUT;
        if (r < I_WFI) { transpose_item(F.in[24], D, 2 * DFF, 2 * DFF, (bf16_t*)(ws + WS_WFI), F.in[23], scr, r, F.lane, MapFfn()); continue; } r -= I_WFI;
        if (r < I_WFO) { transpose_item(F.in[25], DFF, D, D, (bf16_t*)(ws + WS_WFO), nullptr, scr, r, F.lane, MapIdent()); continue; } r -= I_WFO;
        if (r < I_WPG) { transpose_item(F.in[27], D, D, D, (bf16_t*)(ws + WS_WPG), F.in[26], scr, r, F.lane, MapIdent()); continue; } r -= I_WPG;
        transpose_item(F.in[28], 256, D, D, (bf16_t*)(ws + WS_WPP), nullptr, scr, r, F.lane, MapIdent());
    }
    const float* gmix = F.in[8];
    for (int m = gw; m < MP; m += NGW) {
        u32x2* o8 = (u32x2*)(F.XN + (size_t)m * D) + F.lane;
        u32x2* p8 = (u32x2*)(F.PB + (size_t)m * 256) + F.lane;
        if (m >= MTOT) {
#pragma unroll
            for (int j = 0; j < 4; ++j) o8[64 * j] = (u32x2){0u, 0u};
            p8[0] = (u32x2){0u, 0u};
            continue;
        }
        const float* xrow = m < MPR ? F.in[0] + (size_t)m * D : F.in[1] + (size_t)(m - MPR) * D;
        const f32x4* xr = (const f32x4*)xrow + F.lane;
        f32x4 v[4]; float s = 0.f;
#pragma unroll
        for (int j = 0; j < 4; ++j) { v[j] = xr[64 * j]; s += (v[j][0] * v[j][0] + v[j][1] * v[j][1]) + (v[j][2] * v[j][2] + v[j][3] * v[j][3]); }
        const float rs = rsqrtf(wave_sum(s) * (1.0f / D) + EPS);
#pragma unroll
        for (int j = 0; j < 4; ++j) { const f32x4 gv = ((const f32x4*)gmix)[64 * j + F.lane]; const f32x4 y = v[j] * rs * gv;
            o8[64 * j] = (u32x2){cvt_pk_bf16(y[0], y[1]), cvt_pk_bf16(y[2], y[3])}; }
        const float* prow = m < MPR ? F.in[2] + (size_t)m * 256 : F.in[3] + (size_t)(m - MPR) * 256;
        const f32x4 pv = ((const f32x4*)prow)[F.lane];
        p8[0] = (u32x2){cvt_pk_bf16(pv[0], pv[1]), cvt_pk_bf16(pv[2], pv[3])};
    }
}

__device__ __forceinline__ void p2_conv(Frame& F) {
    const int gt = blockIdx.x * (NWAVES * 64) + F.tid, NT = F.G * NWAVES * 64;
    constexpr int NCG = NCH / 8;
    constexpr int NU_P = (MPR / 64) * NCG, NU_S = NSMP * NCG;
    for (int u = gt; u < NU_P + NU_S; u += NT) {
        const bool smp = u >= NU_P;
        const int uu = smp ? u - NU_P : u;
        const int ch = uu / NCG, cgi = uu % NCG;
        const bool is_ssm = cgi < 384;
        const int cc = is_ssm ? cgi * 8 : (cgi - 384) * 8;
        const int kind = is_ssm ? 0 : 1 + (cgi - 384) / 128;
        const float* cw = is_ssm ? F.in[10] : F.in[16];
        float w[4][8], bias[8];
#pragma unroll
        for (int j = 0; j < 4; ++j) { const f32x4 a = *(const f32x4*)(cw + j * 3072 + cc), b = *(const f32x4*)(cw + j * 3072 + cc + 4);
#pragma unroll
            for (int i = 0; i < 4; ++i) { w[j][i] = a[i]; w[j][4 + i] = b[i]; } }
        if (is_ssm) { const f32x4 a = *(const f32x4*)(F.in[11] + cc), b = *(const f32x4*)(F.in[11] + cc + 4);
#pragma unroll
            for (int i = 0; i < 4; ++i) { bias[i] = a[i]; bias[4 + i] = b[i]; } }
        else {
#pragma unroll
            for (int i = 0; i < 8; ++i) bias[i] = 0.f; }
        float h0[8], h1[8], h2[8];
        const int pcol = C_XS + cgi * 8;
        if (smp) {
            const float* st = (is_ssm ? F.in[5] : F.in[7]) + (size_t)ch * 3 * 3072 + cc;
#pragma unroll
            for (int i = 0; i < 8; ++i) { h0[i] = st[i]; h1[i] = st[3072 + i]; h2[i] = st[2 * 3072 + i]; }
            bf16_t* rp = F.PROJ + (size_t)(MPR + ch) * LDP + pcol;
            float x[8]; unpack8(*(const u32x4*)rp, x);
            float o[8]; float ss = 0.f;
#pragma unroll
            for (int i = 0; i < 8; ++i) { float v = w[0][i] * h0[i] + w[1][i] * h1[i] + w[2][i] * h2[i] + w[3][i] * x[i] + bias[i]; v = siluf_(v); o[i] = v; ss += v * v; }
            if (kind == 1 || kind == 2) {
                ss += __shfl_xor(ss, 1); ss += __shfl_xor(ss, 2); ss += __shfl_xor(ss, 4); ss += __shfl_xor(ss, 8);
                const float rn = rsqrtf(ss + EPS) * (kind == 1 ? 0.08838834764831845f : 1.0f);
#pragma unroll
                for (int i = 0; i < 8; ++i) o[i] *= rn;
            }
            *(u32x4*)rp = pack8(o);
            float* ns = F.out + (is_ssm ? O_SCONVS : O_GCONVS) + (size_t)ch * 3 * 3072 + cc;
#pragma unroll
            for (int i = 0; i < 8; ++i) { ns[i] = h1[i]; ns[3072 + i] = h2[i]; ns[2 * 3072 + i] = x[i]; }
            continue;
        }
        const int rowbase = ch * 64, t0 = rowbase & (SEQ - 1);
        if (t0 == 0) {
#pragma unroll
            for (int i = 0; i < 8; ++i) { h0[i] = 0.f; h1[i] = 0.f; h2[i] = 0.f; }
        } else {
            const bf16_t* hp = F.HALO + (size_t)(ch - 1) * 3 * NCH + cgi * 8;
            unpack8(*(const u32x4*)hp, h0); unpack8(*(const u32x4*)(hp + NCH), h1); unpack8(*(const u32x4*)(hp + 2 * NCH), h2);
        }
        const bool lastc = (t0 == SEQ - 64);
        float* ns = F.out + (is_ssm ? O_SCONVP : O_GCONVP) + (size_t)(rowbase >> 11) * 3 * 3072 + cc;
        bf16_t* rp = F.PROJ + (size_t)rowbase * LDP + pcol;
        for (int rb = 0; rb < 64; rb += 8) {
            u32x4 raw[8];
#pragma unroll
            for (int r = 0; r < 8; ++r) raw[r] = *(const u32x4*)(rp + (size_t)(rb + r) * LDP);
#pragma unroll
            for (int r = 0; r < 8; ++r) {
                float x[8]; unpack8(raw[r], x);
                float o[8]; float ss = 0.f;
#pragma unroll
                for (int i = 0; i < 8; ++i) { float v = w[0][i] * h0[i] + w[1][i] * h1[i] + w[2][i] * h2[i] + w[3][i] * x[i] + bias[i]; v = siluf_(v); o[i] = v; ss += v * v; }
                if (kind == 1 || kind == 2) {
                    ss += __shfl_xor(ss, 1); ss += __shfl_xor(ss, 2); ss += __shfl_xor(ss, 4); ss += __shfl_xor(ss, 8);
                    const float rn = rsqrtf(ss + EPS) * (kind == 1 ? 0.08838834764831845f : 1.0f);
#pragma unroll
                    for (int i = 0; i < 8; ++i) o[i] *= rn;
                }
                *(u32x4*)(rp + (size_t)(rb + r) * LDP) = pack8(o);
                if (lastc && rb == 56 && r >= 5) {
#pragma unroll
                    for (int i = 0; i < 8; ++i) ns[(r - 5) * 3072 + i] = x[i];
                }
#pragma unroll
                for (int i = 0; i < 8; ++i) { h0[i] = h1[i]; h1[i] = h2[i]; h2[i] = x[i]; }
            }
        }
    }
}

__device__ __forceinline__ void ssd_item(Frame& F, int item) {
    const bool smp = item >= NBATCH * 32;
    const int sq = smp ? (item - NBATCH * 32) >> 5 : item >> 5, h = item & 31, g = h >> 3;
    const int row0 = smp ? MPR + sq : sq * SEQ, T = smp ? 1 : SEQ;
    const int tid = F.tid, p = tid >> 3, nq = tid & 7;
    LAS bf16_t* Bs = (LAS bf16_t*)(F.lds);
    LAS bf16_t* Cs = (LAS bf16_t*)(F.lds + 16384);
    LAS bf16_t* Xs = (LAS bf16_t*)(F.lds + 32768);
    LAS float* dts = (LAS float*)(F.lds + 40960);
    LAS float* decs = (LAS float*)(F.lds + 41216);
    LAS float* Ys = (LAS float*)(F.lds + 41472);
    float hst[16];
    if (smp) {
        const float* sp = F.in[4] + ((size_t)(sq * 32 + h) * 64 + p) * 128 + nq * 16;
#pragma unroll
        for (int i = 0; i < 4; ++i) { const f32x4 v = ((const f32x4*)sp)[i]; hst[4 * i] = v[0]; hst[4 * i + 1] = v[1]; hst[4 * i + 2] = v[2]; hst[4 * i + 3] = v[3]; }
    } else {
#pragma unroll
        for (int i = 0; i < 16; ++i) hst[i] = 0.f;
    }
    const float a_h = -__expf(F.in[13][h]), dtb = F.in[12][h], Dh = F.in[14][h];
    for (int tb = 0; tb < T; tb += 64) {
        const int rows = (T - tb) < 64 ? (T - tb) : 64;
#pragma unroll
        for (int i = 0; i < 2; ++i) {
            const int pc = tid + i * 512, r = pc >> 4, c8 = (pc & 15) * 8;
            if (r < rows) {
                const bf16_t* src = F.PROJ + (size_t)(row0 + tb + r) * LDP;
                *(LAS u32x4*)(Bs + r * 128 + c8) = *(const u32x4*)(src + C_B + g * 128 + c8);
                *(LAS u32x4*)(Cs + r * 128 + c8) = *(const u32x4*)(src + C_C + g * 128 + c8);
            }
        }
        { const int r = tid >> 3, c8 = (tid & 7) * 8;
          if (r < rows) *(LAS u32x4*)(Xs + r * 64 + c8) = *(const u32x4*)(F.PROJ + (size_t)(row0 + tb + r) * LDP + C_XS + h * 64 + c8); }
        if (tid < rows) { const float dt = softplusf_(F.SMALL[(size_t)(row0 + tb + tid) * 64 + h] + dtb); dts[tid] = dt; decs[tid] = __expf(dt * a_h); }
        __syncthreads();
        for (int tt = 0; tt < rows; ++tt) {
            const float xv = bf2f(Xs[tt * 64 + p]), dtv = dts[tt], dc = decs[tt], dx = dtv * xv;
            float bv[16], cv[16];
            { float t8[8]; unpack8(*(const LAS u32x4*)(Bs + tt * 128 + nq * 16), t8);
#pragma unroll
              for (int i = 0; i < 8; ++i) bv[i] = t8[i];
              unpack8(*(const LAS u32x4*)(Bs + tt * 128 + nq * 16 + 8), t8);
#pragma unroll
              for (int i = 0; i < 8; ++i) bv[8 + i] = t8[i];
              unpack8(*(const LAS u32x4*)(Cs + tt * 128 + nq * 16), t8);
#pragma unroll
              for (int i = 0; i < 8; ++i) cv[i] = t8[i];
              unpack8(*(const LAS u32x4*)(Cs + tt * 128 + nq * 16 + 8), t8);
#pragma unroll
              for (int i = 0; i < 8; ++i) cv[8 + i] = t8[i]; }
            float yp = 0.f;
#pragma unroll
            for (int i = 0; i < 16; ++i) { hst[i] = dc * hst[i] + dx * bv[i]; yp += cv[i] * hst[i]; }
            yp += __shfl_xor(yp, 1); yp += __shfl_xor(yp, 2); yp += __shfl_xor(yp, 4);
            if (nq == 0) Ys[tt * 64 + p] = yp + Dh * xv;
        }
        __syncthreads();
        { const int r = tid >> 3, c8 = (tid & 7) * 8;
          if (r < rows) { float o[8];
#pragma unroll
              for (int i = 0; i < 8; ++i) o[i] = Ys[r * 64 + c8 + i];
              *(u32x4*)(F.PROJ + (size_t)(row0 + tb + r) * LDP + C_XS + h * 64 + c8) = pack8(o); } }
        __syncthreads();
    }
    float* op = F.out + (smp ? O_SSMS : O_SSMP) + ((size_t)(sq * 32 + h) * 64 + p) * 128 + nq * 16;
#pragma unroll
    for (int i = 0; i < 4; ++i) ((f32x4*)op)[i] = (f32x4){hst[4 * i], hst[4 * i + 1], hst[4 * i + 2], hst[4 * i + 3]};
}

__device__ __forceinline__ void gdn_item(Frame& F, int item) {
    const bool smp = item >= NBATCH * 32;
    const int sq = smp ? (item - NBATCH * 32) >> 5 : item >> 5, h = (item >> 2) & 7, dvq = item & 3;
    const int row0 = smp ? MPR + sq : sq * SEQ, T = smp ? 1 : SEQ;
    const int tid = F.tid, e = tid >> 4, kg = tid & 15;
    LAS bf16_t* Qs = (LAS bf16_t*)(F.lds);
    LAS bf16_t* Ks = (LAS bf16_t*)(F.lds + 16384);
    LAS bf16_t* Vs = (LAS bf16_t*)(F.lds + 32768);
    LAS float* egs = (LAS float*)(F.lds + 36864);
    LAS float* bts = (LAS float*)(F.lds + 37120);
    LAS float* Os = (LAS float*)(F.lds + 37376);
    float S[8];
    const size_t sbase = ((size_t)(sq * 8 + h) * 128 + kg * 8) * 128 + dvq * 32 + e;
    if (smp) {
#pragma unroll
        for (int j = 0; j < 8; ++j) S[j] = F.in[6][sbase + (size_t)j * 128];
    } else {
#pragma unroll
        for (int j = 0; j < 8; ++j) S[j] = 0.f;
    }
    const float na = -__expf(F.in[18][h]), dtb = F.in[17][h];
    for (int tb = 0; tb < T; tb += 64) {
        const int rows = (T - tb) < 64 ? (T - tb) : 64;
#pragma unroll
        for (int i = 0; i < 2; ++i) {
            const int pc = tid + i * 512, r = pc >> 4, c8 = (pc & 15) * 8;
            if (r < rows) {
                const bf16_t* src = F.PROJ + (size_t)(row0 + tb + r) * LDP;
                *(LAS u32x4*)(Qs + r * 128 + c8) = *(const u32x4*)(src + C_Q + h * 128 + c8);
                *(LAS u32x4*)(Ks + r * 128 + c8) = *(const u32x4*)(src + C_K + h * 128 + c8);
            }
        }
        if (tid < 256) { const int r = tid >> 2, c8 = (tid & 3) * 8;
          if (r < rows) *(LAS u32x4*)(Vs + r * 32 + c8) = *(const u32x4*)(F.PROJ + (size_t)(row0 + tb + r) * LDP + C_V + h * 128 + dvq * 32 + c8); }
        if (tid < rows) { const float* sm = F.SMALL + (size_t)(row0 + tb + tid) * 64;
            egs[tid] = __expf(na * softplusf_(sm[40 + h] + dtb)); bts[tid] = sigmoidf_(sm[32 + h]); }
        __syncthreads();
        for (int tt = 0; tt < rows; ++tt) {
            float k8[8], q8[8];
            unpack8(*(const LAS u32x4*)(Ks + tt * 128 + kg * 8), k8);
            unpack8(*(const LAS u32x4*)(Qs + tt * 128 + kg * 8), q8);
            const float eg = egs[tt], bt = bts[tt], v = bf2f(Vs[tt * 32 + e]);
            float ks = 0.f;
#pragma unroll
            for (int j = 0; j < 8; ++j) ks += k8[j] * S[j];
            ks += __shfl_xor(ks, 1); ks += __shfl_xor(ks, 2); ks += __shfl_xor(ks, 4); ks += __shfl_xor(ks, 8);
            const float vn = bt * (v - eg * ks);
            float op = 0.f;
#pragma unroll
            for (int j = 0; j < 8; ++j) { S[j] = eg * S[j] + k8[j] * vn; op += q8[j] * S[j]; }
            op += __shfl_xor(op, 1); op += __shfl_xor(op, 2); op += __shfl_xor(op, 4); op += __shfl_xor(op, 8);
            if (kg == 0) Os[tt * 32 + e] = op;
        }
        __syncthreads();
        if (tid < 256) { const int r = tid >> 2, c8 = (tid & 3) * 8;
          if (r < rows) { float o[8];
#pragma unroll
              for (int i = 0; i < 8; ++i) o[i] = Os[r * 32 + c8 + i];
              *(u32x4*)(F.PROJ + (size_t)(row0 + tb + r) * LDP + C_V + h * 128 + dvq * 32 + c8) = pack8(o); } }
        __syncthreads();
    }
    float* op = F.out + (smp ? O_GDNS : O_GDNP);
#pragma unroll
    for (int j = 0; j < 8; ++j) op[sbase + (size_t)j * 128] = S[j];
}


typedef short v4i16 __attribute__((ext_vector_type(4)));
__device__ __forceinline__ bf16x8 row_frag(LAS const unsigned char* base, int pitch, int row0, int k0, int lane) {
    return *(const LAS bf16x8*)(base + (row0 + (lane & 15)) * pitch + (k0 + 8 * (lane >> 4)) * 2);
}
__device__ __forceinline__ bf16x8 tr_frag(LAS const unsigned char* base, int pitch, int k0, int col0, int lane) {
    const int g = lane >> 4, m = lane & 15, q = m >> 2, pp = m & 3;
    LAS const unsigned char* a0 = base + (k0 + 8 * g + q) * pitch + (col0 + 4 * pp) * 2;
    const v4i16 lo = __builtin_amdgcn_ds_read_tr16_b64_v4i16((LAS v4i16*)a0);
    const v4i16 hi = __builtin_amdgcn_ds_read_tr16_b64_v4i16((LAS v4i16*)(a0 + 4 * pitch));
    return (bf16x8){lo[0], lo[1], lo[2], lo[3], hi[0], hi[1], hi[2], hi[3]};
}
#define MFMA16(a, b, c) __builtin_amdgcn_mfma_f32_16x16x32_bf16((a), (b), (c), 0, 0, 0)
__device__ __forceinline__ u32x2 pack4(float a, float b, float c, float d) { return (u32x2){cvt_pk_bf16(a, b), cvt_pk_bf16(c, d)}; }

__device__ __forceinline__ void ssd_chunked(Frame& F, int item) {
    const int b = item >> 5, h = item & 31, g4 = h >> 3;
    const int tid = F.tid, lane = F.lane, w = F.wave, i16 = lane & 15, g = lane >> 4;
    LAS unsigned char* L = F.lds;
    constexpr int PB = 272, PX = 144, PY = 260;
    constexpr int O_BT = 0, O_CT = 17408, O_XT = 34816, O_XD = 44032, O_MT = 53248, O_SL = 62464, O_YT = 79872, O_SC = 96512;
    LAS float* acum = (LAS float*)(L + O_SC); LAS float* dtl = acum + 64; LAS float* scl = acum + 128; LAS float* eac = acum + 192; LAS float* cdecp = acum + 256;
    __syncthreads();
    for (int u = tid; u < 17408 / 16; u += 512) *(LAS u32x4*)(L + O_SL + u * 16) = (u32x4){0u, 0u, 0u, 0u};
    f32x4 sacc[4];
#pragma unroll
    for (int pb = 0; pb < 4; ++pb) sacc[pb] = (f32x4){0.f, 0.f, 0.f, 0.f};
    const float a_h = -__expf(F.in[13][h]), dtb = F.in[12][h], Dh = F.in[14][h];
    const int row00 = b * SEQ;
    u32x4 rb[2], rc[2], rx; float rdt = 0.f;
    const int br0 = tid >> 4, bc8 = (tid & 15) * 8;
    const int xr = tid >> 3, xc8 = (tid & 7) * 8;
#define SSD_LOAD(c) do { const bf16_t* src = F.PROJ + (size_t)(row00 + (c) * 64) * LDP; \
        rb[0] = *(const u32x4*)(src + (size_t)br0 * LDP + C_B + g4 * 128 + bc8); rb[1] = *(const u32x4*)(src + (size_t)(br0 + 32) * LDP + C_B + g4 * 128 + bc8); \
        rc[0] = *(const u32x4*)(src + (size_t)br0 * LDP + C_C + g4 * 128 + bc8); rc[1] = *(const u32x4*)(src + (size_t)(br0 + 32) * LDP + C_C + g4 * 128 + bc8); \
        rx = *(const u32x4*)(src + (size_t)xr * LDP + C_XS + h * 64 + xc8); \
        if (tid < 64) rdt = F.SMALL[(size_t)(row00 + (c) * 64 + tid) * 64 + h]; } while (0)
    SSD_LOAD(0);
    for (int c = 0; c < SEQ / 64; ++c) {
        *(LAS u32x4*)(L + O_BT + br0 * PB + bc8 * 2) = rb[0]; *(LAS u32x4*)(L + O_BT + (br0 + 32) * PB + bc8 * 2) = rb[1];
        *(LAS u32x4*)(L + O_CT + br0 * PB + bc8 * 2) = rc[0]; *(LAS u32x4*)(L + O_CT + (br0 + 32) * PB + bc8 * 2) = rc[1];
        *(LAS u32x4*)(L + O_XT + xr * PX + xc8 * 2) = rx;
        if (tid < 64) {
            const float dt = softplusf_(rdt + dtb);
            float v = dt * a_h;
#pragma unroll
            for (int o = 1; o < 64; o <<= 1) { const float t = __shfl_up(v, o); if (lane >= o) v += t; }
            const float last = __shfl(v, 63);
            acum[lane] = v; dtl[lane] = dt; scl[lane] = dt * __expf(last - v); eac[lane] = __expf(v);
            if (lane == 63) cdecp[0] = __expf(v);
        }
        const u32x4 xkeep = rx;
        __syncthreads();
        if (c + 1 < SEQ / 64) SSD_LOAD(c + 1);
        { float x8[8]; unpack8(xkeep, x8); const float sc = scl[xr];
#pragma unroll
          for (int i = 0; i < 8; ++i) x8[i] *= sc;
          *(LAS u32x4*)(L + O_XD + xr * PX + xc8 * 2) = pack8(x8); }
#pragma unroll
        for (int tt = 0; tt < 2; ++tt) {
            const int t = 2 * w + tt, lb = t >> 2, sb = t & 3;
            const int l = 16 * lb + i16;
            u32x2 mw = (u32x2){0u, 0u};
            if (sb <= lb) {
                f32x4 acc = (f32x4){0.f, 0.f, 0.f, 0.f};
#pragma unroll
                for (int ks = 0; ks < 4; ++ks) acc = MFMA16(row_frag(L + O_BT, PB, 16 * sb, 32 * ks, lane), row_frag(L + O_CT, PB, 16 * lb, 32 * ks, lane), acc);
                const float al = acum[l];
                float mv[4];
#pragma unroll
                for (int r = 0; r < 4; ++r) { const int s = 16 * sb + 4 * g + r; const float e = __expf(al - acum[s]) * dtl[s] * acc[r]; mv[r] = (s <= l) ? e : 0.f; }
                mw = pack4(mv[0], mv[1], mv[2], mv[3]);
            }
            *(LAS u32x2*)(L + O_MT + l * PX + (16 * sb + 4 * g) * 2) = mw;
        }
        f32x4 yacc[2];
        const int lb = w >> 1;
#pragma unroll
        for (int tt = 0; tt < 2; ++tt) {
            const int pb = 2 * (w & 1) + tt;
            f32x4 acc = (f32x4){0.f, 0.f, 0.f, 0.f};
#pragma unroll
            for (int ks = 0; ks < 4; ++ks) acc = MFMA16(row_frag(L + O_CT, PB, 16 * lb, 32 * ks, lane), row_frag(L + O_SL, PB, 16 * pb, 32 * ks, lane), acc);
#pragma unroll
            for (int r = 0; r < 4; ++r) acc[r] *= eac[16 * lb + 4 * g + r];
            yacc[tt] = acc;
        }
        __syncthreads();
#pragma unroll
        for (int tt = 0; tt < 2; ++tt) {
            const int pb = 2 * (w & 1) + tt;
            f32x4 acc = yacc[tt];
            acc = MFMA16(row_frag(L + O_MT, PX, 16 * lb, 0, lane), tr_frag(L + O_XT, PX, 0, 16 * pb, lane), acc);
            if (lb >= 2) acc = MFMA16(row_frag(L + O_MT, PX, 16 * lb, 32, lane), tr_frag(L + O_XT, PX, 32, 16 * pb, lane), acc);
#pragma unroll
            for (int r = 0; r < 4; ++r) { const int l = 16 * lb + 4 * g + r, p = 16 * pb + i16;
                const float xv = bf2f(*(LAS const bf16_t*)(L + O_XT + l * PX + p * 2));
                *(LAS float*)(L + O_YT + l * PY + p * 4) = acc[r] + Dh * xv; }
        }
        { const float cdec = cdecp[0];
#pragma unroll
          for (int pb = 0; pb < 4; ++pb) sacc[pb] *= cdec;
#pragma unroll
          for (int ks = 0; ks < 2; ++ks) {
              const bf16x8 a = tr_frag(L + O_BT, PB, 32 * ks, 16 * w, lane);
#pragma unroll
              for (int pb = 0; pb < 4; ++pb) sacc[pb] = MFMA16(a, tr_frag(L + O_XD, PX, 32 * ks, 16 * pb, lane), sacc[pb]);
          }
#pragma unroll
          for (int pb = 0; pb < 4; ++pb) *(LAS u32x2*)(L + O_SL + (16 * pb + i16) * PB + (16 * w + 4 * g) * 2) = pack4(sacc[pb][0], sacc[pb][1], sacc[pb][2], sacc[pb][3]);
        }
        __syncthreads();
        { float o[8];
#pragma unroll
          for (int i = 0; i < 8; ++i) o[i] = *(LAS const float*)(L + O_YT + xr * PY + (xc8 + i) * 4);
          *(u32x4*)(F.PROJ + (size_t)(row00 + c * 64 + xr) * LDP + C_XS + h * 64 + xc8) = pack8(o); }
    }
#undef SSD_LOAD
#pragma unroll
    for (int pb = 0; pb < 4; ++pb) *(f32x4*)(F.out + O_SSMP + ((size_t)(b * 32 + h) * 64 + 16 * pb + i16) * 128 + 16 * w + 4 * g) = sacc[pb];
}


__device__ __forceinline__ void gdn_prep(Frame& F, int it, int hb) {
    const int c = it & 31, bh = it >> 5, h = bh & 7, b = bh >> 3;
    const int ht = F.tid & 255, lane = F.lane, hw = F.wave & 3, i16 = lane & 15, g = lane >> 4;
    LAS unsigned char* L = F.lds + hb * 65536;
    constexpr int PB = 272;
    constexpr int O_KT = 0, O_QT = 17408, O_VT = 34816, O_SC = 52224;
    LAS float* gc = (LAS float*)(L + O_SC); LAS float* bt = gc + 64; LAS float* egc = gc + 128;
    const int row0 = b * SEQ + c * 64;
    __syncthreads();
    {
        u32x4 rk[4], rq[4], rv[4];
#pragma unroll
        for (int j = 0; j < 4; ++j) { const int pc = ht + j * 256, r = pc >> 4, c8 = (pc & 15) * 8; const bf16_t* src = F.PROJ + (size_t)(row0 + r) * LDP + h * 128 + c8;
            rk[j] = *(const u32x4*)(src + C_K); rq[j] = *(const u32x4*)(src + C_Q); rv[j] = *(const u32x4*)(src + C_V); }
        if (ht < 64) {
            const float* sm = F.SMALL + (size_t)(row0 + lane) * 64;
            const float na = -__expf(F.in[18][h]), dtb = F.in[17][h];
            float v = na * softplusf_(sm[40 + h] + dtb);
            const float be = sigmoidf_(sm[32 + h]);
#pragma unroll
            for (int o = 1; o < 64; o <<= 1) { const float t = __shfl_up(v, o); if (lane >= o) v += t; }
            gc[lane] = v; bt[lane] = be; egc[lane] = __expf(v);
            ((float*)(F.ws + WS_GC))[(size_t)it * 64 + lane] = v;
        }
#pragma unroll
        for (int j = 0; j < 4; ++j) { const int pc = ht + j * 256, r = pc >> 4, c8 = (pc & 15) * 8;
            *(LAS u32x4*)(L + O_KT + r * PB + c8 * 2) = rk[j]; *(LAS u32x4*)(L + O_QT + r * PB + c8 * 2) = rq[j]; *(LAS u32x4*)(L + O_VT + r * PB + c8 * 2) = rv[j]; }
    }
    __syncthreads();
    f32x4 kk[4];
    const int lb = hw;
    bf16_t* qkm = (bf16_t*)(F.ws + WS_QKM) + (size_t)it * 4096;
#pragma unroll
    for (int sb = 0; sb < 4; ++sb) {
        kk[sb] = (f32x4){0.f, 0.f, 0.f, 0.f};
        const int l = 16 * lb + i16;
        u32x2 qw = (u32x2){0u, 0u};
        if (sb <= lb) {
            f32x4 qa = (f32x4){0.f, 0.f, 0.f, 0.f};
#pragma unroll
            for (int ks = 0; ks < 4; ++ks) {
                const bf16x8 ks_ = row_frag(L + O_KT, PB, 16 * sb, 32 * ks, lane);
                kk[sb] = MFMA16(row_frag(L + O_KT, PB, 16 * lb, 32 * ks, lane), ks_, kk[sb]);
                qa = MFMA16(ks_, row_frag(L + O_QT, PB, 16 * lb, 32 * ks, lane), qa);
            }
            const float gl = gc[l];
            float qv[4];
#pragma unroll
            for (int r = 0; r < 4; ++r) { const int s_ = 16 * sb + 4 * g + r; const float e = __expf(gl - gc[s_]) * qa[r]; qv[r] = (s_ <= l) ? e : 0.f; }
            qw = pack4(qv[0], qv[1], qv[2], qv[3]);
        }
        *(u32x2*)(qkm + l * 64 + 16 * sb + 4 * g) = qw;
    }
    __syncthreads();
#pragma unroll
    for (int sb = 0; sb < 4; ++sb) {
        if (sb <= lb) {
#pragma unroll
            for (int r = 0; r < 4; ++r) { const int l = 16 * lb + 4 * g + r, s_ = 16 * sb + i16;
                const float a = (s_ < l) ? bt[l] * kk[sb][r] * __expf(gc[l] - gc[s_]) : 0.f;
                *(LAS float*)(L + O_QT + l * PB + s_ * 4) = a; }
        }
    }
    __syncthreads();
    float x[64];
    {
        const bool isv = ht < 128;
        LAS const unsigned char* colp = L + (isv ? O_VT : O_KT) + (ht & 127) * 2;
#pragma unroll
        for (int l = 0; l < 64; ++l) { const float v = bf2f(*(LAS const bf16_t*)(colp + l * PB)); x[l] = v * bt[l] * (isv ? 1.0f : egc[l]); }
    }
#pragma unroll
    for (int l = 1; l < 64; ++l) {
        float acc0 = x[l], acc1 = 0.f;
#pragma unroll
        for (int s4 = 0; s4 < (l + 3) / 4; ++s4) {
            const f32x4 a = *(LAS const f32x4*)(L + O_QT + l * PB + s4 * 16);
#pragma unroll
            for (int j = 0; j < 4; ++j) if (4 * s4 + j < l) { if (j & 1) asm("v_fma_f32 %0, -%1, %2, %0" : "+v"(acc1) : "v"(a[j]), "v"(x[4 * s4 + j])); else asm("v_fma_f32 %0, -%1, %2, %0" : "+v"(acc0) : "v"(a[j]), "v"(x[4 * s4 + j])); }
        }
        x[l] = acc0 + acc1;
        asm volatile("" ::: "memory");
    }
    {
        const bool isv = ht < 128;
        bf16_t* dst = (bf16_t*)(F.ws + (isv ? WS_UT : WS_WT)) + (size_t)it * 8192 + (ht & 127) * 64;
        const float sg = isv ? 1.0f : -1.0f;
#pragma unroll
        for (int q8 = 0; q8 < 8; ++q8) { float o[8];
#pragma unroll
            for (int i = 0; i < 8; ++i) o[i] = sg * x[8 * q8 + i];
            *(u32x4*)(dst + 8 * q8) = pack8(o); }
    }
}

__device__ __forceinline__ void gdn_scan(Frame& F, int item) {
    const int dvq = item & 3, bh = item >> 2, h = bh & 7, b = bh >> 3;
    const int tid = F.tid, lane = F.lane, w = F.wave, i16 = lane & 15, g = lane >> 4;
    LAS unsigned char* L = F.lds;
    constexpr int PB = 272, PX = 144, PO = 132;
    constexpr int O_WT = 0, O_QG = 18432, O_KG = 35840, O_QK = 53248, O_UT = 62464, O_ST = 67072, O_VN = 75776, O_OT = 80384, O_GL = 88832;
    __syncthreads();
    for (int u = tid; u < 8704 / 16; u += 512) *(LAS u32x4*)(L + O_ST + u * 16) = (u32x4){0u, 0u, 0u, 0u};
    f32x4 sacc[2];
    sacc[0] = (f32x4){0.f, 0.f, 0.f, 0.f}; sacc[1] = sacc[0];
    const int lb = w >> 1, eb = w & 1;
    const int r0 = tid >> 4, c8a = (tid & 15) * 8;
    const int xr = tid >> 3, xc8 = (tid & 7) * 8;
    const float* GC = (const float*)(F.ws + WS_GC);
    u32x4 rw[2], rq[2], rk[2], rqk, ru; float gq0 = 0.f, gq1 = 0.f, glast = 0.f;
#define GDN_LOAD(c) do { const size_t it_ = (size_t)bh * 32 + (c); \
        const bf16_t* wt = (const bf16_t*)(F.ws + WS_WT) + it_ * 8192; rw[0] = *(const u32x4*)(wt + xr * 64 + xc8); rw[1] = *(const u32x4*)(wt + (xr + 64) * 64 + xc8); \
        const bf16_t* src = F.PROJ + (size_t)(b * SEQ + (c) * 64) * LDP + h * 128 + c8a; \
        rq[0] = *(const u32x4*)(src + (size_t)r0 * LDP + C_Q); rq[1] = *(const u32x4*)(src + (size_t)(r0 + 32) * LDP + C_Q); \
        rk[0] = *(const u32x4*)(src + (size_t)r0 * LDP + C_K); rk[1] = *(const u32x4*)(src + (size_t)(r0 + 32) * LDP + C_K); \
        rqk = *(const u32x4*)((const bf16_t*)(F.ws + WS_QKM) + it_ * 4096 + xr * 64 + xc8); \
        if (tid < 256) ru = *(const u32x4*)((const bf16_t*)(F.ws + WS_UT) + it_ * 8192 + (dvq * 32 + xr) * 64 + xc8); \
        gq0 = GC[it_ * 64 + r0]; gq1 = GC[it_ * 64 + r0 + 32]; glast = GC[it_ * 64 + 63]; } while (0)
    GDN_LOAD(0);
    for (int c = 0; c < SEQ / 64; ++c) {
        *(LAS u32x4*)(L + O_WT + xr * PX + xc8 * 2) = rw[0]; *(LAS u32x4*)(L + O_WT + (xr + 64) * PX + xc8 * 2) = rw[1];
        *(LAS u32x4*)(L + O_QK + xr * PX + xc8 * 2) = rqk;
        if (tid < 256) *(LAS u32x4*)(L + O_UT + xr * PX + xc8 * 2) = ru;
        {
            float t8[8];
            const float eq0 = __expf(gq0), eq1 = __expf(gq1), ek0 = __expf(glast - gq0), ek1 = __expf(glast - gq1);
            unpack8(rq[0], t8);
#pragma unroll
            for (int i = 0; i < 8; ++i) t8[i] *= eq0;
            *(LAS u32x4*)(L + O_QG + r0 * PB + c8a * 2) = pack8(t8);
            unpack8(rq[1], t8);
#pragma unroll
            for (int i = 0; i < 8; ++i) t8[i] *= eq1;
            *(LAS u32x4*)(L + O_QG + (r0 + 32) * PB + c8a * 2) = pack8(t8);
            unpack8(rk[0], t8);
#pragma unroll
            for (int i = 0; i < 8; ++i) t8[i] *= ek0;
            *(LAS u32x4*)(L + O_KG + r0 * PB + c8a * 2) = pack8(t8);
            unpack8(rk[1], t8);
#pragma unroll
            for (int i = 0; i < 8; ++i) t8[i] *= ek1;
            *(LAS u32x4*)(L + O_KG + (r0 + 32) * PB + c8a * 2) = pack8(t8);
        }
        const float gl = __expf(glast);
        __syncthreads();
        if (c + 1 < SEQ / 64) GDN_LOAD(c + 1);
        f32x4 vacc, oacc = (f32x4){0.f, 0.f, 0.f, 0.f};
        { const u32x2 uw = *(LAS const u32x2*)(L + O_UT + (16 * eb + i16) * PX + (16 * lb + 4 * g) * 2);
          vacc = (f32x4){bflo(uw.x), bfhi(uw.x), bflo(uw.y), bfhi(uw.y)}; }
#pragma unroll
        for (int ks = 0; ks < 4; ++ks) {
            const bf16x8 bS = row_frag(L + O_ST, PB, 16 * eb, 32 * ks, lane);
            vacc = MFMA16(tr_frag(L + O_WT, PX, 32 * ks, 16 * lb, lane), bS, vacc);
            oacc = MFMA16(row_frag(L + O_QG, PB, 16 * lb, 32 * ks, lane), bS, oacc);
        }
        *(LAS u32x2*)(L + O_VN + (16 * eb + i16) * PX + (16 * lb + 4 * g) * 2) = pack4(vacc[0], vacc[1], vacc[2], vacc[3]);
        __syncthreads();
        {
            const bf16x8 bV0 = row_frag(L + O_VN, PX, 16 * eb, 0, lane), bV1 = row_frag(L + O_VN, PX, 16 * eb, 32, lane);
            oacc = MFMA16(row_frag(L + O_QK, PX, 16 * lb, 0, lane), bV0, oacc);
            if (lb >= 2) oacc = MFMA16(row_frag(L + O_QK, PX, 16 * lb, 32, lane), bV1, oacc);
#pragma unroll
            for (int r = 0; r < 4; ++r) *(LAS float*)(L + O_OT + (16 * lb + 4 * g + r) * PO + (16 * eb + i16) * 4) = oacc[r];
#pragma unroll
            for (int t2 = 0; t2 < 2; ++t2) {
                const int db = 2 * lb + t2;
                f32x4 sa = sacc[t2] * gl;
                sa = MFMA16(tr_frag(L + O_KG, PB, 0, 16 * db, lane), bV0, sa);
                sa = MFMA16(tr_frag(L + O_KG, PB, 32, 16 * db, lane), bV1, sa);
                sacc[t2] = sa;
                *(LAS u32x2*)(L + O_ST + (16 * eb + i16) * PB + (16 * db + 4 * g) * 2) = pack4(sa[0], sa[1], sa[2], sa[3]);
            }
        }
        __syncthreads();
        if (tid < 256) { const int r = tid >> 2, c8 = (tid & 3) * 8; float o[8];
#pragma unroll
            for (int i = 0; i < 8; ++i) o[i] = *(LAS const float*)(L + O_OT + r * PO + (c8 + i) * 4);
            *(u32x4*)(F.PROJ + (size_t)(b * SEQ + c * 64 + r) * LDP + C_V + h * 128 + dvq * 32 + c8) = pack8(o); }
    }
#undef GDN_LOAD
#pragma unroll
    for (int t2 = 0; t2 < 2; ++t2)
#pragma unroll
        for (int r = 0; r < 4; ++r) F.out[O_GDNP + ((size_t)bh * 128 + 16 * (2 * lb + t2) + 4 * g + r) * 128 + dvq * 32 + 16 * eb + i16] = sacc[t2][r];
}

__device__ __forceinline__ void p3_scan(Frame& F) {
    constexpr int NSSD = NBATCH * 32 + NSMP * 32;
#ifndef NO_SSDC
    for (int it = blockIdx.x; it < NBATCH * 32; it += F.G) ssd_chunked(F, it);
#endif
#ifndef NO_PREP
    for (int pr = blockIdx.x; pr < 1024; pr += F.G) gdn_prep(F, 2 * pr + (F.tid >> 8), F.tid >> 8);
#endif
    __syncthreads();
#ifndef NO_SSDI
    for (int it = NBATCH * 32 + blockIdx.x; it < NSSD; it += F.G) ssd_item(F, it);
#endif
}
__device__ __forceinline__ void p3b_scan(Frame& F) {
    constexpr int NGDN = NBATCH * 32 + NSMP * 32;
    for (int it = blockIdx.x; it < NBATCH * 32; it += F.G) gdn_scan(F, it);
    __syncthreads();
    for (int it = NBATCH * 32 + blockIdx.x; it < NGDN; it += F.G) gdn_item(F, it);
}

__device__ __forceinline__ void p4_norm(Frame& F) {
    const int gw = blockIdx.x * NWAVES + F.wave, NGW = F.G * NWAVES, lane = F.lane;
    const float* gs = F.in[15]; const float* gg = F.in[19];
    for (int m = gw; m < MTOT; m += NGW) {
        bf16_t* row = F.PROJ + (size_t)m * LDP;
#pragma unroll
        for (int g = 0; g < 4; ++g) {
            const int c = g * 512 + lane * 8;
            float y[8], z[8]; unpack8(*(const u32x4*)(row + C_XS + c), y); unpack8(*(const u32x4*)(row + C_Z + c), z);
            float ss = 0.f;
#pragma unroll
            for (int i = 0; i < 8; ++i) { y[i] *= siluf_(z[i]); ss += y[i] * y[i]; }
            const float r = rsqrtf(wave_sum(ss) * (1.0f / 512.0f) + EPS);
            const f32x4 g0 = *(const f32x4*)(gs + c), g1 = *(const f32x4*)(gs + c + 4);
#pragma unroll
            for (int i = 0; i < 4; ++i) { y[i] *= r * g0[i]; y[4 + i] *= r * g1[i]; }
            *(u32x4*)(row + C_XS + c) = pack8(y);
        }
#pragma unroll
        for (int hh = 0; hh < 2; ++hh) {
            const int c = hh * 512 + lane * 8;
            float o[8], gt[8]; unpack8(*(const u32x4*)(row + C_V + c), o); unpack8(*(const u32x4*)(row + C_GATE + c), gt);
            float ss = 0.f;
#pragma unroll
            for (int i = 0; i < 8; ++i) ss += o[i] * o[i];
            ss += __shfl_xor(ss, 1); ss += __shfl_xor(ss, 2); ss += __shfl_xor(ss, 4); ss += __shfl_xor(ss, 8);
            const float r = rsqrtf(ss * (1.0f / 128.0f) + EPS);
            const int e = (lane & 15) * 8;
            const f32x4 g0 = *(const f32x4*)(gg + e), g1 = *(const f32x4*)(gg + e + 4);
#pragma unroll
            for (int i = 0; i < 4; ++i) { o[i] = o[i] * r * g0[i] * siluf_(gt[i]); o[4 + i] = o[4 + i] * r * g1[i] * siluf_(gt[4 + i]); }
            *(u32x4*)(row + C_V + c) = pack8(o);
        }
    }
}

__device__ __forceinline__ void p12_final(Frame& F) {
    const int gw = blockIdx.x * NWAVES + F.wave, NGW = F.G * NWAVES, lane = F.lane;
    const float* gf = F.in[29];
    for (int m = gw; m < MTOT; m += NGW) {
        float* orow = F.out + (m < MPR ? O_Y + (size_t)m * D : O_YS + (size_t)(m - MPR) * D);
        const float r = rsqrtf(F.SS3[m] * (1.0f / D) + EPS);
#pragma unroll
        for (int j = 0; j < 4; ++j) { f32x4* p = (f32x4*)orow + 64 * j + lane; const f32x4 gv = ((const f32x4*)gf)[64 * j + lane]; *p = *p * r * gv; }
    }
}

__global__ void __launch_bounds__(NWAVES * 64, 2) mega_fwd(Args args) {
    extern __shared__ __attribute__((aligned(16))) unsigned char lds_raw[];
    Frame F;
    F.lds = (LAS unsigned char*)lds_raw;
    F.tid = threadIdx.x; F.lane = F.tid & 63; F.wave = __builtin_amdgcn_readfirstlane(F.tid >> 6); F.G = gridDim.x;
    F.in = args.in;
    F.out = args.out; F.ws = args.ws;
    unsigned char* ws = args.ws;
    F.PROJ = (bf16_t*)(ws + WS_PROJ); F.HALO = (bf16_t*)(ws + WS_HALO); F.SMALL = (float*)(ws + WS_SMALL); F.XN = (bf16_t*)(ws + WS_XN); F.PB = (bf16_t*)(ws + WS_PB);
    F.SS1 = (float*)(ws + WS_SS1); F.SS2 = (float*)(ws + WS_SS2); F.SS3 = (float*)(ws + WS_SS3);
    const int lo = args.ph_lo, hi = args.ph_hi;
#if MK_ONE_LAUNCH
    volatile LAS unsigned* MISC = (volatile LAS unsigned*)(F.lds + MISC_OFF);
    if (F.tid < 32) MISC[F.tid] = 0u;
    __syncthreads();
    XcdBarrier bar = xcd_barrier_post((unsigned*)(ws + WS_BAR), MISC + 8);
#define SEAM(k) do { if (lo <= (k) && (k) + 1 < hi) xcd_barrier(bar); } while (0)
#else
#define SEAM(k) do { } while (0)
#endif
#ifndef PHASE_MASK
#define PHASE_MASK 0xffff
#endif
#define IN(k) (((PHASE_MASK >> (k)) & 1) && lo <= (k) && (k) < hi)
    const int bid = (int)blockIdx.x;
    typedef pg8::StaticOrder SO;

    if (IN(0)) { p0_prologue(F); SEAM(0); }
    if (IN(1)) {
        pg8::Gemm g{F.XN, (const bf16_t*)(ws + WS_WIN), MP, NPROJ, D, D, D}; SO S; S.init(MP, NPROJ, F.G, bid);
        EpiInProj E{F.PROJ, F.HALO, F.SMALL};
        pg8::gemm_phase<EpiInProj, SO>(F.lds, g, S, E); SEAM(1);
    }
    if (IN(2)) { p2_conv(F); SEAM(2); }
    if (IN(3)) { p3_scan(F); SEAM(3); }
    if (IN(4)) { p3b_scan(F); SEAM(4); }
    if (IN(5)) { p4_norm(F); SEAM(5); }
    if (IN(6)) {
        pg8::Gemm g{F.PROJ + C_XS, (const bf16_t*)(ws + WS_WBS), MP, D, 2048, LDP, 2048}; SO S; S.init(MP, D, F.G, bid);
        EpiT1 E{F.PROJ};
        pg8::gemm_phase<EpiT1, SO>(F.lds, g, S, E); SEAM(6);
    }
    if (IN(7)) {
        pg8::Gemm g{F.PROJ + C_V, (const bf16_t*)(ws + WS_WBG), MP, D, D, LDP, D}; SO S; S.init(MP, D, F.G, bid);
        EpiMix E{F.PROJ};
        pg8::gemm_phase<EpiMix, SO>(F.lds, g, S, E); SEAM(7);
    }
    if (IN(8)) {
        pg8::Gemm g{F.PROJ + C_Q, (const bf16_t*)(ws + WS_WOUT), MP, D, D, LDP, D}; SO S; S.init(MP, D, F.G, bid);
        EpiResid<0> E{F.PROJ, F.in[0], F.in[1], 0, C_Z, C_K, F.SS1};
        pg8::gemm_phase<EpiResid<0>, SO>(F.lds, g, S, E); SEAM(8);
    }
    if (IN(9)) {
        pg8::Gemm g{F.PROJ + C_K, (const bf16_t*)(ws + WS_WFI), MP, 2 * DFF, D, LDP, D}; SO S; S.init(MP, 2 * DFF, F.G, bid);
        EpiSwiGLU E{F.PROJ, F.SS1};
        pg8::gemm_phase<EpiSwiGLU, SO>(F.lds, g, S, E); SEAM(9);
    }
    if (IN(10)) {
        pg8::Gemm g{F.PROJ + C_XS, (const bf16_t*)(ws + WS_WFO), MP, D, DFF, LDP, DFF}; SO S; S.init(MP, D, F.G, bid);
        EpiResid<1> E{F.PROJ, nullptr, nullptr, C_Z, C_MG, C_GATE, F.SS2};
        pg8::gemm_phase<EpiResid<1>, SO>(F.lds, g, S, E); SEAM(10);
    }
    if (IN(11)) {
        pg8::Gemm g{F.PB, (const bf16_t*)(ws + WS_WPP), MP, D, 256, 256, 256}; SO S; S.init(MP, D, F.G, bid);
        EpiPE E{F.PROJ};
        pg8::gemm_phase<EpiPE, SO>(F.lds, g, S, E); SEAM(11);
    }
    if (IN(12)) {
        pg8::Gemm g{F.PROJ + C_GATE, (const bf16_t*)(ws + WS_WPG), MP, D, D, LDP, D}; SO S; S.init(MP, D, F.G, bid);
        EpiX3 E{F.PROJ, F.SS2, F.SS3, F.out};
        pg8::gemm_phase<EpiX3, SO>(F.lds, g, S, E); SEAM(12);
    }
    if (IN(13)) { p12_final(F); }
#undef IN
#undef SEAM
}

constexpr int NPHASES = 14;

extern "C" void kernel_launch(void* const* d_in, const int* in_sizes, int n_in, void* d_out, int out_size, void* d_ws, size_t ws_size, hipStream_t stream) {
    static int grid = 0;
    if (grid == 0) {
        if (n_in != 30 || ws_size < WS_END) { fprintf(stderr, "kernel_launch: bad call: n_in %d ws %zu (need %zu)\n", n_in, ws_size, (size_t)WS_END); grid = -1; return; }
        int dev = 0, cus = 0, per_cu = 0;
        if (hipGetDevice(&dev) != hipSuccess || hipDeviceGetAttribute(&cus, hipDeviceAttributeMultiprocessorCount, dev) != hipSuccess) { grid = -1; return; }
        if (hipFuncSetAttribute((const void*)mega_fwd, hipFuncAttributeMaxDynamicSharedMemorySize, LDS_BYTES) != hipSuccess) { fprintf(stderr, "kernel_launch: hipFuncSetAttribute failed\n"); grid = -1; return; }
        if (hipOccupancyMaxActiveBlocksPerMultiprocessor(&per_cu, (const void*)mega_fwd, NWAVES * 64, LDS_BYTES) != hipSuccess || per_cu < 1) { fprintf(stderr, "kernel_launch: occupancy query says %d\n", per_cu); per_cu = 1; }
        (void)hipGetLastError();
        grid = cus;
    }
    if (grid < 0) return;
    (void)hipMemsetAsync((char*)d_ws + WS_CTL, 0, CTL_BYTES, stream);
    Args a{};
    for (int i = 0; i < 30; ++i) a.in[i] = (const float*)d_in[i];
    a.out = (float*)d_out; a.ws = (unsigned char*)d_ws;
#if MK_ONE_LAUNCH
    a.ph_lo = 0; a.ph_hi = NPHASES;
    void* kargs[] = {&a};
    hipError_t e = hipLaunchCooperativeKernel((const void*)mega_fwd, dim3(grid), dim3(NWAVES * 64), kargs, LDS_BYTES, stream);
    if (e != hipSuccess) fprintf(stderr, "cooperative launch failed: %s (grid %d)\n", hipGetErrorString(e), grid);
#else
    for (int ph = 0; ph < NPHASES; ++ph) {
        a.ph_lo = ph; a.ph_hi = ph + 1;
        hipLaunchKernelGGL(mega_fwd, dim3(grid), dim3(NWAVES * 64), LDS_BYTES, stream, a);
    }
#endif
}
```

```cpp
#include <hip/hip_runtime.h>
#include <hip/hip_cooperative_groups.h>
#include <cstdio>
#include <cstdint>
namespace cg = cooperative_groups;

#ifndef MK_ONE_LAUNCH
#define MK_ONE_LAUNCH 1
#endif

#define LAS __attribute__((address_space(3)))
typedef unsigned short bf16_t;
typedef short bf16x8 __attribute__((ext_vector_type(8)));
typedef float f32x4 __attribute__((ext_vector_type(4)));
typedef float f32x2 __attribute__((ext_vector_type(2)));
typedef unsigned u32x4 __attribute__((ext_vector_type(4)));
typedef unsigned u32x2 __attribute__((ext_vector_type(2)));

constexpr int D = 1024, SEQ = 2048, NBATCH = 8, MPR = NBATCH * SEQ, NSMP = 128, MTOT = MPR + NSMP, MP = 16640;
constexpr int LDP = 11264, LDF = LDP / 2;
constexpr int C_Z = 0, C_XS = 2048, C_B = 4096, C_C = 4608, C_Q = 5120, C_K = 6144, C_V = 7168, C_GATE = 8192, C_MG = 9216;
constexpr int NIN = 11312;
constexpr int NPROJ = 11520;
constexpr int DFF = 2816;
constexpr float EPS = 1e-6f;
constexpr int NCH = 6144;

constexpr size_t O_Y = 0, O_YS = 16777216, O_SSMP = 16908288, O_SCONVP = 19005440, O_GDNP = 19079168, O_GCONVP = 20127744,
                 O_SSMS = 20201472, O_SCONVS = 53755904, O_GDNS = 54935552, O_GCONVS = 71712768;

constexpr size_t MiB = 1u << 20;
constexpr size_t WS_CTL = 0, CTL_BYTES = 1 * MiB;
constexpr size_t WS_BAR = 16384;
constexpr size_t WS_SS1 = 65536, WS_SS2 = WS_SS1 + 69632, WS_SS3 = WS_SS2 + 69632;
constexpr size_t WS_WIN = 1 * MiB, WS_WBS = 25 * MiB, WS_WBG = 29 * MiB, WS_WOUT = 31 * MiB, WS_WFI = 33 * MiB, WS_WFO = 44 * MiB, WS_WPG = 50 * MiB, WS_WPP = 52 * MiB;
constexpr size_t WS_XN = 53 * MiB, WS_PB = 86 * MiB, WS_SMALL = 95 * MiB, WS_HALO = 100 * MiB, WS_PROJ = 110 * MiB;
constexpr size_t WS_END0 = WS_PROJ + (size_t)MP * LDP * 2;
constexpr size_t WS_WT = WS_XN, WS_QKM = WS_WIN, WS_UT = 468 * MiB, WS_GC = 500 * MiB;
constexpr size_t WS_END = WS_GC + 2048 * 64 * 4;
static_assert(WS_END0 <= WS_UT && WS_UT + 32 * MiB <= WS_GC, "ws map 2");
static_assert(WS_END <= 512 * MiB, "ws map");
static_assert(WS_SS3 + 69632 <= CTL_BYTES, "ctl");

typedef __bf16 bf16x2_t __attribute__((ext_vector_type(2)));
__device__ __forceinline__ unsigned cvt_pk_bf16(float lo, float hi) { const f32x2 v = {lo, hi}; const bf16x2_t b = __builtin_convertvector(v, bf16x2_t); return __builtin_bit_cast(unsigned, b); }
__device__ __forceinline__ float bflo(unsigned w) { return __uint_as_float(w << 16); }
__device__ __forceinline__ float bfhi(unsigned w) { return __uint_as_float(w & 0xffff0000u); }
__device__ __forceinline__ float bf2f(bf16_t b) { return __uint_as_float((unsigned)b << 16); }
__device__ __forceinline__ void unpack8(const u32x4 w, float (&f)[8]) { f[0] = bflo(w.x); f[1] = bfhi(w.x); f[2] = bflo(w.y); f[3] = bfhi(w.y); f[4] = bflo(w.z); f[5] = bfhi(w.z); f[6] = bflo(w.w); f[7] = bfhi(w.w); }
__device__ __forceinline__ u32x4 pack8(const float (&f)[8]) { u32x4 w; w.x = cvt_pk_bf16(f[0], f[1]); w.y = cvt_pk_bf16(f[2], f[3]); w.z = cvt_pk_bf16(f[4], f[5]); w.w = cvt_pk_bf16(f[6], f[7]); return w; }
__device__ __forceinline__ float sigmoidf_(float x) { return __builtin_amdgcn_rcpf(1.0f + __builtin_amdgcn_exp2f(-1.4426950408889634f * x)); }
__device__ __forceinline__ float siluf_(float x) { return x * sigmoidf_(x); }
__device__ __forceinline__ float softplusf_(float x) { return x > 20.f ? x : log1pf(__expf(x)); }
__device__ __forceinline__ float wave_sum(float v) {
#pragma unroll
    for (int o = 1; o < 64; o <<= 1) v += __shfl_xor(v, o);
    return v;
}

namespace pg8 {
constexpr int BM = 256, BK = 64, HALF = 128, HTB = HALF * BK * 2, STAGE_BYTES = 8 * HTB, NXCD = 8, WGM = 8;
__host__ __device__ __forceinline__ int lds_byte(int r, int c) { const int st = (r >> 4) * 2 + (c >> 5), rr = r & 15, cc = c & 31, ob = rr * 64 + cc * 2; return st * 1024 + (ob ^ (((ob >> 9) & 1) << 5)); }
__host__ __device__ __forceinline__ void stage_rc(int b, int& R, int& C) { const int st = b / 1024, sb = b % 1024, swz = sb ^ (((sb >> 9) & 1) << 5); R = (st >> 1) * 16 + swz / 64; C = (st & 1) * 32 + (swz % 64) / 2; }
__host__ __device__ __forceinline__ int perm32(int rho) { const int n = rho >> 4, i = rho & 15; return 8 * (i >> 2) + 4 * n + (i & 3); }

struct Unit { int pm, pn; };
struct Gemm { const bf16_t* A; const bf16_t* Bt; int M, N, K, lda, ldb; };

struct StaticOrder {
    int nM, nN, nwg, G, c;
    __host__ __device__ void init(int M, int N, int G_, int c_) { nM = M / BM; nN = N / BM; nwg = nM * nN; G = G_; c = c_; }
    __host__ __device__ bool next(int i, Unit& u) const {
        const long L = (long)i * G + c; if (L >= nwg) return false;
        int wgid = (int)L; { const int q = nwg / NXCD, r = nwg % NXCD, xcd = wgid % NXCD, off = wgid / NXCD; wgid = (xcd < r ? xcd * (q + 1) : r * (q + 1) + (xcd - r) * q) + off; }
        const int nig = WGM * nN, gid = wgid / nig, fm = gid * WGM, gsz = (nM - fm) < WGM ? (nM - fm) : WGM;
        u.pm = fm + ((wgid % nig) % gsz); u.pn = (wgid % nig) / gsz; return true;
    }
    __device__ __forceinline__ void a_ready(const Unit&) const {}
    __device__ __forceinline__ void done(const Unit&) const {}
};

template <class Epi, class Sched, bool ALIGN_EPI = true, bool SP2 = true>
__device__ __forceinline__ void gemm_phase(LAS unsigned char* lds, const Gemm g, const Sched& S, const Epi& E) {
    const int tid = threadIdx.x, wid = __builtin_amdgcn_readfirstlane(tid >> 6), lane = tid & 63, wr = wid >> 2, wc = wid & 3, fr = lane & 15, fq = lane >> 4;
    int nt = g.K / BK; asm volatile("" : "+s"(nt));
    unsigned voffA[2], voffB[2];
#pragma unroll
    for (int i = 0; i < 2; ++i) { int R, C; stage_rc(tid * 16 + i * 8192, R, C); const int Rb = Epi::PERM ? ((R & ~31) + perm32(R & 31)) : R;
        voffA[i] = (unsigned)(R * g.lda + C) * 2u; voffB[i] = (unsigned)(Rb * g.ldb + C) * 2u; }
    const size_t kstep = (size_t)(BK * 2);
    const size_t hstepA = (size_t)HALF * g.lda * 2, hstepB = (size_t)HALF * g.ldb * 2;
    const size_t tstepA = 2 * hstepA, tstepB = 2 * hstepB;
    const unsigned ldsw = (unsigned)wid * 1024u;
    const int aoff = lds_byte(wr * 64 + fr, fq * 8), boff = lds_byte(wc * 32 + fr, fq * 8);
#define PG8_SA(b, h) (((b) * 2 + (h)) * HTB)
#define PG8_SB(b, h) ((4 + (b) * 2 + (h)) * HTB)
#define PG8_STAGE(bufoff, gbase, voff) do { _Pragma("unroll") for (int _i = 0; _i < 2; ++_i) \
        __builtin_amdgcn_global_load_lds((const unsigned*)((const char*)(gbase) + (voff)[_i]), (LAS unsigned*)(lds + (bufoff) + ldsw + _i * 8192), 16, 0, 0); } while (0)
#define PG8_LDA(dst, b, h) do { _Pragma("unroll") for (int m = 0; m < 4; ++m) _Pragma("unroll") for (int k = 0; k < 2; ++k) dst[m][k] = *(const LAS bf16x8*)(lds + PG8_SA(b, h) + aoff + m * 2048 + k * 1024); } while (0)
#define PG8_LDB(dst, b, h) do { _Pragma("unroll") for (int n = 0; n < 2; ++n) _Pragma("unroll") for (int k = 0; k < 2; ++k) dst[n][k] = *(const LAS bf16x8*)(lds + PG8_SB(b, h) + boff + n * 2048 + k * 1024); } while (0)
#define PG8_MMA(ai, bj, At, Bt) do { __builtin_amdgcn_s_setprio(1); _Pragma("unroll") for (int m = 0; m < 4; ++m) _Pragma("unroll") for (int n = 0; n < 2; ++n) _Pragma("unroll") for (int k = 0; k < 2; ++k) \
        acc[ai][bj][m][n] = __builtin_amdgcn_mfma_f32_16x16x32_bf16(Bt[n][k], At[m][k], acc[ai][bj][m][n], 0, 0, 0); __builtin_amdgcn_s_setprio(0); } while (0)
#define PG8_WAIT_V(n) asm volatile("s_waitcnt vmcnt(" #n ")" ::: "memory")
#define PG8_WAIT_L(n) asm volatile("s_waitcnt lgkmcnt(" #n ")" ::: "memory")
#define PG8_BAR __builtin_amdgcn_s_barrier()
#define PG8_SCHED __builtin_amdgcn_sched_barrier(0)
    Unit cur, nxt; int ui = 0;
    if (!S.next(0, cur)) return;
    f32x4 acc[2][2][4][2];
#pragma unroll
    for (int a = 0; a < 2; ++a)
#pragma unroll
        for (int b = 0; b < 2; ++b)
#pragma unroll
            for (int m = 0; m < 4; ++m)
#pragma unroll
                for (int n = 0; n < 2; ++n) acc[a][b][m][n] = (f32x4){0.f, 0.f, 0.f, 0.f};
    bf16x8 At[4][2], B0[2][2], B1[2][2];
    const char* cA = (const char*)g.A + (size_t)cur.pm * tstepA; const char* cB = (const char*)g.Bt + (size_t)cur.pn * tstepB;
    S.a_ready(cur);
    if constexpr (SP2) {
        PG8_STAGE(PG8_SB(0, 0), cB, voffB); PG8_STAGE(PG8_SB(0, 1), cB + hstepB, voffB); PG8_STAGE(PG8_SA(0, 0), cA, voffA); PG8_STAGE(PG8_SA(0, 1), cA + hstepA, voffA);
        if (wr == 1) PG8_BAR;
        PG8_WAIT_V(2); PG8_BAR;
        PG8_STAGE(PG8_SB(1, 0), cB + kstep, voffB); PG8_STAGE(PG8_SA(1, 0), cA + kstep, voffA); PG8_STAGE(PG8_SB(1, 1), cB + hstepB + kstep, voffB);
        PG8_WAIT_V(6); PG8_BAR;
    } else {
        PG8_STAGE(PG8_SB(0, 0), cB, voffB); PG8_STAGE(PG8_SA(0, 0), cA, voffA); PG8_STAGE(PG8_SB(0, 1), cB + hstepB, voffB); PG8_STAGE(PG8_SA(0, 1), cA + hstepA, voffA);
        if (wr == 1) PG8_BAR;
        PG8_WAIT_V(4); PG8_BAR;
        PG8_STAGE(PG8_SB(1, 0), cB + kstep, voffB); PG8_STAGE(PG8_SA(1, 0), cA + kstep, voffA); PG8_STAGE(PG8_SB(1, 1), cB + hstepB + kstep, voffB);
        PG8_WAIT_V(6); PG8_BAR;
    }
    for (;;) {
        const bool has_next = S.next(ui + 1, nxt);
        const char* nA = has_next ? (const char*)g.A + (size_t)nxt.pm * tstepA : cA; const char* nB = has_next ? (const char*)g.Bt + (size_t)nxt.pn * tstepB : cB;
        for (int t = 0; t < nt; t += 2) {
            const bool last = (t == nt - 2);
            const char* a1 = cA + (size_t)(t + 1) * kstep;
            const char* a2 = last ? nA : cA + (size_t)(t + 2) * kstep; const char* b2 = last ? nB : cB + (size_t)(t + 2) * kstep;
            const char* a3 = a2 + kstep; const char* b3 = b2 + kstep;
            if (last && has_next) S.a_ready(nxt);
            if constexpr (SP2) {
            PG8_LDB(B0, 0, 0); PG8_LDB(B1, 0, 1); PG8_SCHED; PG8_LDA(At, 0, 0); PG8_STAGE(PG8_SA(1, 1), a1 + hstepA, voffA);
            PG8_WAIT_V(8); PG8_WAIT_L(0); PG8_BAR; PG8_MMA(0, 0, At, B0); PG8_MMA(0, 1, At, B1); PG8_BAR; PG8_SCHED;
            PG8_LDA(At, 0, 1); PG8_STAGE(PG8_SB(0, 0), b2, voffB); PG8_STAGE(PG8_SB(0, 1), b2 + hstepB, voffB); PG8_STAGE(PG8_SA(0, 0), a2, voffA);
            PG8_WAIT_V(8); PG8_WAIT_L(0); PG8_BAR; PG8_MMA(1, 0, At, B0); PG8_MMA(1, 1, At, B1); PG8_BAR; PG8_SCHED;
            PG8_LDB(B0, 1, 0); PG8_LDB(B1, 1, 1); PG8_SCHED; PG8_LDA(At, 1, 0); PG8_STAGE(PG8_SA(0, 1), a2 + hstepA, voffA);
            PG8_WAIT_V(8); PG8_WAIT_L(0); PG8_BAR; PG8_MMA(0, 0, At, B0); PG8_MMA(0, 1, At, B1); PG8_BAR; PG8_SCHED;
            PG8_LDA(At, 1, 1); PG8_STAGE(PG8_SB(1, 0), b3, voffB); PG8_STAGE(PG8_SB(1, 1), b3 + hstepB, voffB); PG8_STAGE(PG8_SA(1, 0), a3, voffA);
            PG8_WAIT_V(8); PG8_WAIT_L(0); PG8_BAR; PG8_MMA(1, 0, At, B0); PG8_MMA(1, 1, At, B1); PG8_BAR; PG8_SCHED;
            } else {
            PG8_LDB(B0, 0, 0); PG8_SCHED; PG8_LDA(At, 0, 0); PG8_STAGE(PG8_SA(1, 1), a1 + hstepA, voffA);
            PG8_WAIT_L(8); PG8_BAR; PG8_WAIT_L(0); PG8_MMA(0, 0, At, B0); PG8_BAR; PG8_SCHED;
            PG8_LDB(B1, 0, 1); PG8_STAGE(PG8_SB(0, 0), b2, voffB);
            PG8_BAR; PG8_WAIT_L(0); PG8_MMA(0, 1, At, B1); PG8_BAR;
            PG8_LDA(At, 0, 1); PG8_STAGE(PG8_SA(0, 0), a2, voffA);
            PG8_BAR; PG8_WAIT_L(0); PG8_MMA(1, 0, At, B0); PG8_BAR; PG8_SCHED;
            PG8_STAGE(PG8_SB(0, 1), b2 + hstepB, voffB);
            PG8_WAIT_V(6); PG8_BAR; PG8_MMA(1, 1, At, B1); PG8_BAR;
            PG8_LDB(B0, 1, 0); PG8_SCHED; PG8_LDA(At, 1, 0); PG8_STAGE(PG8_SA(0, 1), a2 + hstepA, voffA);
            PG8_WAIT_L(8); PG8_BAR; PG8_WAIT_L(0); PG8_MMA(0, 0, At, B0); PG8_BAR; PG8_SCHED;
            PG8_LDB(B1, 1, 1); PG8_STAGE(PG8_SB(1, 0), b3, voffB);
            PG8_BAR; PG8_WAIT_L(0); PG8_MMA(0, 1, At, B1); PG8_BAR;
            PG8_LDA(At, 1, 1); PG8_STAGE(PG8_SA(1, 0), a3, voffA);
            PG8_BAR; PG8_WAIT_L(0); PG8_MMA(1, 0, At, B0); PG8_BAR; PG8_SCHED;
            PG8_STAGE(PG8_SB(1, 1), b3 + hstepB, voffB);
            PG8_WAIT_V(6); PG8_BAR; PG8_MMA(1, 1, At, B1); PG8_BAR;
            }
        }
        if constexpr (ALIGN_EPI) { if (wr == 0) PG8_BAR; }
        E(acc, cur, wr, wc, fr, fq); S.done(cur);
        if (!has_next) break;
#pragma unroll
        for (int a = 0; a < 2; ++a)
#pragma unroll
            for (int b = 0; b < 2; ++b)
#pragma unroll
                for (int m = 0; m < 4; ++m)
#pragma unroll
                    for (int n = 0; n < 2; ++n) acc[a][b][m][n] = (f32x4){0.f, 0.f, 0.f, 0.f};
        cur = nxt; cA = nA; cB = nB; ++ui;
        if constexpr (ALIGN_EPI) { if (wr == 1) PG8_BAR; }
    }
    PG8_WAIT_V(0);
    if constexpr (!ALIGN_EPI) { if (wr == 0) PG8_BAR; }
    PG8_BAR;
#undef PG8_SA
#undef PG8_SB
#undef PG8_STAGE
#undef PG8_LDA
#undef PG8_LDB
#undef PG8_MMA
#undef PG8_WAIT_V
#undef PG8_WAIT_L
#undef PG8_BAR
#undef PG8_SCHED
}
}
using pg8::Unit;


#define XB_TMO      128
#define XB_XCNT(j)  (256  + 64 * (j))
#define XB_XSUB(j)  (1280 + 64 * (j))
#define XB_XGEN(j)  (2304 + 64 * (j))
#define XB_TOP      3328
#define XB_TOPGEN   3392
#define XCD_BAR_WORDS 3456
#define XB_SPIN_CAP (1u << 22)
__device__ __forceinline__ unsigned xb_ld(unsigned* p)              { return __hip_atomic_load(p, __ATOMIC_RELAXED, __HIP_MEMORY_SCOPE_AGENT); }
__device__ __forceinline__ unsigned xb_add(unsigned* p, unsigned v) { return __hip_atomic_fetch_add(p, v, __ATOMIC_RELAXED, __HIP_MEMORY_SCOPE_AGENT); }
__device__ __forceinline__ unsigned xb_xcc_id() { return (unsigned)__builtin_amdgcn_s_getreg((3 << 11) | 20) & 0xFu; }
#define XB_SPIN(cond, bar) do { unsigned _sp = 0; while (cond) { __builtin_amdgcn_s_sleep(1); \
    if ((++_sp & 255u) == 0u) { if (xb_ld(&(bar)[XB_TMO])) break; if (_sp > XB_SPIN_CAP) { atomicAdd(&(bar)[XB_TMO], 1u); break; } } } } while (0)
struct XcdBarrier { unsigned* bar; unsigned x; volatile LAS unsigned* st; };
__device__ __forceinline__ XcdBarrier xcd_barrier_post(unsigned* bar, volatile LAS unsigned* st) {
    XcdBarrier b; b.bar = bar; b.x = xb_xcc_id(); b.st = st;
    if (threadIdx.x == 0) (void)xb_add(&bar[XB_XCNT(b.x)], 1u);
    return b;
}
__device__ __forceinline__ void xcd_barrier_complete(unsigned* bar, unsigned x, unsigned& nloc, unsigned& nx) {
    const unsigned G = gridDim.x * gridDim.y * gridDim.z;
    unsigned sum, cnt, mine, sp = 0u;
    for (;;) {
        sum = 0u; cnt = 0u; mine = 0u;
#pragma unroll
        for (unsigned j = 0; j < 16; ++j) { const unsigned c = xb_ld(&bar[XB_XCNT(j)]); sum += c; cnt += (c > 0u) ? 1u : 0u; mine = (j == x) ? c : mine; }
        if (sum == G) break;
        __builtin_amdgcn_s_sleep(1);
        if ((++sp & 255u) == 0u) { if (xb_ld(&bar[XB_TMO])) break; if (sp > XB_SPIN_CAP) { atomicAdd(&bar[XB_TMO], 1u); break; } }
    }
    nloc = mine > 0u ? mine : 1u; nx = cnt > 0u ? cnt : 1u;
}
__device__ __forceinline__ void xcd_barrier(const XcdBarrier& b) {
    asm volatile("s_waitcnt vmcnt(0)" ::: "memory");
    __syncthreads();
    if (threadIdx.x == 0) {
        unsigned* bar = b.bar;
        __builtin_amdgcn_s_waitcnt(0);
        unsigned nloc = b.st[0], nx = b.st[1];
        if (nloc == 0u) { xcd_barrier_complete(bar, b.x, nloc, nx); b.st[0] = nloc; b.st[1] = nx; }
        const unsigned old = xb_add(&bar[XB_XSUB(b.x)], 1u);
        const unsigned gen = old / nloc;
        if (old + 1u == (gen + 1u) * nloc) {
            __builtin_amdgcn_fence(__ATOMIC_RELEASE, "agent");
            asm volatile("s_waitcnt vmcnt(0)" ::: "memory");
            const unsigned og = xb_add(&bar[XB_TOP], 1u);
            const unsigned tg = og / nx;
            if (og + 1u == (tg + 1u) * nx) xb_add(&bar[XB_TOPGEN], 1u);
            else XB_SPIN(xb_ld(&bar[XB_TOPGEN]) == tg, bar);
            __builtin_amdgcn_fence(__ATOMIC_ACQUIRE, "agent");
            xb_add(&bar[XB_XGEN(b.x)], 1u);
            asm volatile("s_waitcnt vmcnt(0)" ::: "memory");
        } else {
            XB_SPIN(xb_ld(&bar[XB_XGEN(b.x)]) == gen, bar);
            __builtin_amdgcn_fence(__ATOMIC_ACQUIRE, "agent");
            asm volatile("s_waitcnt vmcnt(0)" ::: "memory");
        }
    }
    __syncthreads();
}

struct Args {
    const float* in[30];
    float* out;
    unsigned char* ws;
    int ph_lo, ph_hi;
};

struct Frame {
    LAS unsigned char* lds;
    int tid, lane, wave, G;
    const float* const* in;
    float* out;
    unsigned char* ws;
    bf16_t* PROJ; bf16_t* HALO; float* SMALL; bf16_t* XN; bf16_t* PB;
    float *SS1, *SS2, *SS3;
};

constexpr int NWAVES = 8;
constexpr int RING_BYTES = 131072, MISC_OFF = RING_BYTES + 320, LDS_BYTES = 147456;

struct EpiInProj {
    static constexpr bool PERM = true;
    bf16_t* PROJ; bf16_t* HALO; float* SMALL;
    __device__ __forceinline__ void operator()(const f32x4 (&acc)[2][2][4][2], const Unit& u, int wr, int wc, int fr, int fq) const {
        const int row0 = u.pm * 256 + wr * 64 + fr;
        if (u.pn < 44) {
            const int col0 = u.pn * 256 + wc * 32 + 8 * fq;
            const bool conv_tile = (u.pn >= 8 && u.pn < 32);
#pragma unroll
            for (int ai = 0; ai < 2; ++ai)
#pragma unroll
                for (int m = 0; m < 4; ++m) {
                    const int row = row0 + ai * 128 + m * 16;
                    bf16_t* rowp = PROJ + (size_t)row * LDP + col0;
#pragma unroll
                    for (int bj = 0; bj < 2; ++bj) {
                        const f32x4 v0 = acc[ai][bj][m][0], v1 = acc[ai][bj][m][1];
                        u32x4 w; w.x = cvt_pk_bf16(v0[0], v0[1]); w.y = cvt_pk_bf16(v0[2], v0[3]); w.z = cvt_pk_bf16(v1[0], v1[1]); w.w = cvt_pk_bf16(v1[2], v1[3]);
                        *(u32x4*)(rowp + bj * 128) = w;
                        if (m == 3 && conv_tile && fr >= 13) {
                            bf16_t* hp = HALO + ((size_t)(row >> 6) * 3 + (fr - 13)) * NCH + (col0 - C_XS) + bj * 128;
                            *(u32x4*)hp = w;
                        }
                    }
                }
        } else {
            if (wc < 2) {
                const int col0 = wc * 32 + 8 * fq;
#pragma unroll
                for (int ai = 0; ai < 2; ++ai)
#pragma unroll
                    for (int m = 0; m < 4; ++m) {
                        const int row = row0 + ai * 128 + m * 16;
                        float* sp = SMALL + (size_t)row * 64 + col0;
                        *(f32x4*)sp = acc[ai][0][m][0]; *(f32x4*)(sp + 4) = acc[ai][0][m][1];
                    }
            }
        }
    }
};

struct EpiT1 {
    static constexpr bool PERM = true;
    bf16_t* PROJ;
    __device__ __forceinline__ void operator()(const f32x4 (&acc)[2][2][4][2], const Unit& u, int wr, int wc, int fr, int fq) const {
        const int row0 = u.pm * 256 + wr * 64 + fr, col0 = u.pn * 256 + wc * 32 + 8 * fq;
#pragma unroll
        for (int ai = 0; ai < 2; ++ai)
#pragma unroll
            for (int m = 0; m < 4; ++m) {
                const int row = row0 + ai * 128 + m * 16;
#pragma unroll
                for (int bj = 0; bj < 2; ++bj) {
                    const int col = col0 + bj * 128;
                    const u32x4 mgw = *(const u32x4*)(PROJ + (size_t)row * LDP + C_MG + col);
                    float mg[8]; unpack8(mgw, mg);
                    const f32x4 v0 = acc[ai][bj][m][0], v1 = acc[ai][bj][m][1];
                    f32x4 o0, o1;
#pragma unroll
                    for (int i = 0; i < 4; ++i) { o0[i] = v0[i] * sigmoidf_(mg[i]); o1[i] = v1[i] * sigmoidf_(mg[4 + i]); }
                    float* tp = (float*)PROJ + (size_t)row * LDF + col;
                    *(f32x4*)tp = o0; *(f32x4*)(tp + 4) = o1;
                }
            }
    }
};

struct EpiMix {
    static constexpr bool PERM = true;
    bf16_t* PROJ;
    __device__ __forceinline__ void operator()(const f32x4 (&acc)[2][2][4][2], const Unit& u, int wr, int wc, int fr, int fq) const {
        const int row0 = u.pm * 256 + wr * 64 + fr, col0 = u.pn * 256 + wc * 32 + 8 * fq;
#pragma unroll
        for (int ai = 0; ai < 2; ++ai)
#pragma unroll
            for (int m = 0; m < 4; ++m) {
                const int row = row0 + ai * 128 + m * 16;
#pragma unroll
                for (int bj = 0; bj < 2; ++bj) {
                    const int col = col0 + bj * 128;
                    const u32x4 mgw = *(const u32x4*)(PROJ + (size_t)row * LDP + C_MG + 1024 + col);
                    float mg[8]; unpack8(mgw, mg);
                    const float* tp = (const float*)PROJ + (size_t)row * LDF + col;
                    const f32x4 t0 = *(const f32x4*)tp, t1 = *(const f32x4*)(tp + 4);
                    const f32x4 v0 = acc[ai][bj][m][0], v1 = acc[ai][bj][m][1];
                    float o[8];
#pragma unroll
                    for (int i = 0; i < 4; ++i) { o[i] = t0[i] + v0[i] * sigmoidf_(mg[i]); o[4 + i] = t1[i] + v1[i] * sigmoidf_(mg[4 + i]); }
                    *(u32x4*)(PROJ + (size_t)row * LDP + C_Q + col) = pack8(o);
                }
            }
    }
};

template <int MODE> struct EpiResid {
    static constexpr bool PERM = true;
    bf16_t* PROJ; const float* xp; const float* xs; int res_col  , dst_col  , dstb_col; float* SS;
    __device__ __forceinline__ void operator()(const f32x4 (&acc)[2][2][4][2], const Unit& u, int wr, int wc, int fr, int fq) const {
        const int row0 = u.pm * 256 + wr * 64 + fr, col0 = u.pn * 256 + wc * 32 + 8 * fq;
#pragma unroll
        for (int ai = 0; ai < 2; ++ai)
#pragma unroll
            for (int m = 0; m < 4; ++m) {
                const int row = row0 + ai * 128 + m * 16;
                float ss = 0.f;
#pragma unroll
                for (int bj = 0; bj < 2; ++bj) {
                    const int col = col0 + bj * 128;
                    f32x4 r0 = (f32x4){0.f, 0.f, 0.f, 0.f}, r1 = r0;
                    if (MODE == 0) {
                        if (row < MTOT) { const float* rp = (row < MPR ? xp + (size_t)row * D : xs + (size_t)(row - MPR) * D) + col; r0 = *(const f32x4*)rp; r1 = *(const f32x4*)(rp + 4); }
                    } else {
                        const float* rp = (const float*)(PROJ + res_col) + (size_t)row * LDF + col; r0 = *(const f32x4*)rp; r1 = *(const f32x4*)(rp + 4);
                    }
                    const f32x4 x0 = r0 + acc[ai][bj][m][0], x1 = r1 + acc[ai][bj][m][1];
                    float* dp = (float*)(PROJ + dst_col) + (size_t)row * LDF + col;
                    *(f32x4*)dp = x0; *(f32x4*)(dp + 4) = x1;
                    u32x4 w; w.x = cvt_pk_bf16(x0[0], x0[1]); w.y = cvt_pk_bf16(x0[2], x0[3]); w.z = cvt_pk_bf16(x1[0], x1[1]); w.w = cvt_pk_bf16(x1[2], x1[3]);
                    *(u32x4*)(PROJ + (size_t)row * LDP + dstb_col + col) = w;
                    ss += (x0[0] * x0[0] + x0[1] * x0[1]) + (x0[2] * x0[2] + x0[3] * x0[3]) + (x1[0] * x1[0] + x1[1] * x1[1]) + (x1[2] * x1[2] + x1[3] * x1[3]);
                }
                ss += __shfl_xor(ss, 16); ss += __shfl_xor(ss, 32);
                if (fq == 0) atomicAdd(SS + row, ss);
            }
    }
};

struct EpiSwiGLU {
    static constexpr bool PERM = true;
    bf16_t* PROJ; const float* SS;
    __device__ __forceinline__ void operator()(const f32x4 (&acc)[2][2][4][2], const Unit& u, int wr, int wc, int fr, int fq) const {
        const int row0 = u.pm * 256 + wr * 64 + fr, col0 = u.pn * 128 + wc * 32 + 8 * fq;
#pragma unroll
        for (int ai = 0; ai < 2; ++ai)
#pragma unroll
            for (int m = 0; m < 4; ++m) {
                const int row = row0 + ai * 128 + m * 16;
                const float r = rsqrtf(SS[row] * (1.0f / D) + EPS);
                const f32x4 g0 = acc[ai][0][m][0], g1 = acc[ai][0][m][1], u0 = acc[ai][1][m][0], u1 = acc[ai][1][m][1];
                float o[8];
#pragma unroll
                for (int i = 0; i < 4; ++i) { o[i] = siluf_(r * g0[i]) * (r * u0[i]); o[4 + i] = siluf_(r * g1[i]) * (r * u1[i]); }
                *(u32x4*)(PROJ + (size_t)row * LDP + C_XS + col0) = pack8(o);
            }
    }
};

struct EpiPE {
    static constexpr bool PERM = true;
    bf16_t* PROJ;
    __device__ __forceinline__ void operator()(const f32x4 (&acc)[2][2][4][2], const Unit& u, int wr, int wc, int fr, int fq) const {
        const int row0 = u.pm * 256 + wr * 64 + fr, col0 = u.pn * 256 + wc * 32 + 8 * fq;
#pragma unroll
        for (int ai = 0; ai < 2; ++ai)
#pragma unroll
            for (int m = 0; m < 4; ++m) {
                const int row = row0 + ai * 128 + m * 16;
#pragma unroll
                for (int bj = 0; bj < 2; ++bj) {
                    float* tp = (float*)PROJ + (size_t)row * LDF + col0 + bj * 128;
                    *(f32x4*)tp = acc[ai][bj][m][0]; *(f32x4*)(tp + 4) = acc[ai][bj][m][1];
                }
            }
    }
};

struct EpiX3 {
    static constexpr bool PERM = true;
    bf16_t* PROJ; const float* SS2; float* SS3; float* out;
    __device__ __forceinline__ void operator()(const f32x4 (&acc)[2][2][4][2], const Unit& u, int wr, int wc, int fr, int fq) const {
        const int row0 = u.pm * 256 + wr * 64 + fr, col0 = u.pn * 256 + wc * 32 + 8 * fq;
#pragma unroll
        for (int ai = 0; ai < 2; ++ai)
#pragma unroll
            for (int m = 0; m < 4; ++m) {
                const int row = row0 + ai * 128 + m * 16;
                const float r = rsqrtf(SS2[row] * (1.0f / D) + EPS);
                float ss = 0.f;
#pragma unroll
                for (int bj = 0; bj < 2; ++bj) {
                    const int col = col0 + bj * 128;
                    const float* x2p = (const float*)(PROJ + C_MG) + (size_t)row * LDF + col;
                    const float* pep = (const float*)PROJ + (size_t)row * LDF + col;
                    const f32x4 a0 = *(const f32x4*)x2p, a1 = *(const f32x4*)(x2p + 4), p0 = *(const f32x4*)pep, p1 = *(const f32x4*)(pep + 4);
                    const f32x4 v0 = acc[ai][bj][m][0], v1 = acc[ai][bj][m][1];
                    f32x4 x0, x1;
#pragma unroll
                    for (int i = 0; i < 4; ++i) { x0[i] = a0[i] + p0[i] * sigmoidf_(r * v0[i]); x1[i] = a1[i] + p1[i] * sigmoidf_(r * v1[i]); }
                    if (row < MTOT) { float* op = out + (row < MPR ? O_Y + (size_t)row * D : O_YS + (size_t)(row - MPR) * D) + col; *(f32x4*)op = x0; *(f32x4*)(op + 4) = x1; }
                    ss += (x0[0] * x0[0] + x0[1] * x0[1]) + (x0[2] * x0[2] + x0[3] * x0[3]) + (x1[0] * x1[0] + x1[1] * x1[1]) + (x1[2] * x1[2] + x1[3] * x1[3]);
                }
                ss += __shfl_xor(ss, 16); ss += __shfl_xor(ss, 32);
                if (fq == 0) atomicAdd(SS3 + row, ss);
            }
    }
};

struct MapIdent { __device__ __forceinline__ int operator()(int n) const { return n; } };
struct MapWin {
    __device__ __forceinline__ int operator()(int n) const {
        if (n < 5120) return n;
        if (n < 9216) return n + 32;
        if (n < 11264) return n + 48;
        const int j = n - 11264;
        if (j < 32) return 5120 + j;
        if (j < 48) return 9216 + j;
        return -1;
    }
};
struct MapFfn {
    __device__ __forceinline__ int operator()(int n) const { const int j = n >> 8, r = n & 255; return r < 128 ? 128 * j + r : DFF + 128 * j + (r - 128); }
};
template <class Map>
__device__ __forceinline__ void transpose_item(const float* W, int K, int Nsrc, int Ndst, bf16_t* WT, const float* gain, LAS float* scr, int item, int lane, Map map) {
    const int nblk = Ndst / 32, kb = item / nblk, nb = item % nblk, k0 = 64 * kb, n0 = 32 * nb;
    const int sc = map(n0 + (lane & 31));
    float tv[32];
#pragma unroll
    for (int i = 0; i < 32; ++i) { const int kk = 2 * i + (lane >> 5); tv[i] = sc >= 0 ? W[(size_t)(k0 + kk) * Nsrc + sc] : 0.f; }
#pragma unroll
    for (int i = 0; i < 32; ++i) { const int kk = 2 * i + (lane >> 5); float v = tv[i]; if (gain) v *= gain[k0 + kk]; scr[kk * 33 + (lane & 31)] = v; }
    asm volatile("s_waitcnt lgkmcnt(0)" ::: "memory");
    const int c = lane & 7;
#pragma unroll
    for (int j = 0; j < 4; ++j) { const int n = (lane >> 3) + 8 * j; const LAS float* s = scr + (8 * c) * 33 + n;
        u32x4 o; o.x = cvt_pk_bf16(s[0 * 33], s[1 * 33]); o.y = cvt_pk_bf16(s[2 * 33], s[3 * 33]); o.z = cvt_pk_bf16(s[4 * 33], s[5 * 33]); o.w = cvt_pk_bf16(s[6 * 33], s[7 * 33]);
        *(u32x4*)(WT + (size_t)(n0 + n) * K + k0 + 8 * c) = o; }
    asm volatile("s_waitcnt lgkmcnt(0)" ::: "memory");
}

__device__ __forceinline__ void p0_prologue(Frame& F) {
    LAS float* scr = (LAS float*)(F.lds + F.wave * 16384);
    const int gw = blockIdx.x * NWAVES + F.wave, NGW = F.G * NWAVES;
    unsigned char* ws = F.ws;
    constexpr int I_WIN = 16 * (NPROJ / 32), I_WBS = 32 * 32, I_WBG = 16 * 32, I_WOUT = 16 * 32, I_WFI = 16 * (2 * DFF / 32), I_WFO = (DFF / 64) * 32, I_WPG = 16 * 32, I_WPP = 4 * 32;
    constexpr int NITEMS = I_WIN + I_WBS + I_WBG + I_WOUT + I_WFI + I_WFO + I_WPG + I_WPP;
    for (int it = gw; it < NITEMS; it += NGW) {
        int r = it;
        if (r < I_WIN) { transpose_item(F.in[9], D, NIN, NPROJ, (bf16_t*)(ws + WS_WIN), nullptr, scr, r, F.lane, MapWin()); continue; } r -= I_WIN;
        if (r < I_WBS) { transpose_item(F.in[20], 2048, D, D, (bf16_t*)(ws + WS_WBS), nullptr, scr, r, F.lane, MapIdent()); continue; } r -= I_WBS;
        if (r < I_WBG) { transpose_item(F.in[21], D, D, D, (bf16_t*)(ws + WS_WBG), nullptr, scr, r, F.lane, MapIdent()); continue; } r -= I_WBG;
        if (r < I_WOUT) { transpose_item(F.in[22], D, D, D, (bf16_t*)(ws + WS_WOUT), nullptr, scr, r, F.lane, MapIdent()); continue; } r -= I_WOUT;
        if (r < I_WFI) { transpose_item(F.in[24], D, 2 * DFF, 2 * DFF, (bf16_t*)(ws + WS_WFI), F.in[23], scr, r, F.lane, MapFfn()); continue; } r -= I_WFI;
        if (r < I_WFO) { transpose_item(F.in[25], DFF, D, D, (bf16_t*)(ws + WS_WFO), nullptr, scr, r, F.lane, MapIdent()); continue; } r -= I_WFO;
        if (r < I_WPG) { transpose_item(F.in[27], D, D, D, (bf16_t*)(ws + WS_WPG), F.in[26], scr, r, F.lane, MapIdent()); continue; } r -= I_WPG;
        transpose_item(F.in[28], 256, D, D, (bf16_t*)(ws + WS_WPP), nullptr, scr, r, F.lane, MapIdent());
    }
    const float* gmix = F.in[8];
    for (int m = gw; m < MP; m += NGW) {
        u32x2* o8 = (u32x2*)(F.XN + (size_t)m * D) + F.lane;
        u32x2* p8 = (u32x2*)(F.PB + (size_t)m * 256) + F.lane;
        if (m >= MTOT) {
#pragma unroll
            for (int j = 0; j < 4; ++j) o8[64 * j] = (u32x2){0u, 0u};
            p8[0] = (u32x2){0u, 0u};
            continue;
        }
        const float* xrow = m < MPR ? F.in[0] + (size_t)m * D : F.in[1] + (size_t)(m - MPR) * D;
        const f32x4* xr = (const f32x4*)xrow + F.lane;
        f32x4 v[4]; float s = 0.f;
#pragma unroll
        for (int j = 0; j < 4; ++j) { v[j] = xr[64 * j]; s += (v[j][0] * v[j][0] + v[j][1] * v[j][1]) + (v[j][2] * v[j][2] + v[j][3] * v[j][3]); }
        const float rs = rsqrtf(wave_sum(s) * (1.0f / D) + EPS);
#pragma unroll
        for (int j = 0; j < 4; ++j) { const f32x4 gv = ((const f32x4*)gmix)[64 * j + F.lane]; const f32x4 y = v[j] * rs * gv;
            o8[64 * j] = (u32x2){cvt_pk_bf16(y[0], y[1]), cvt_pk_bf16(y[2], y[3])}; }
        const float* prow = m < MPR ? F.in[2] + (size_t)m * 256 : F.in[3] + (size_t)(m - MPR) * 256;
        const f32x4 pv = ((const f32x4*)prow)[F.lane];
        p8[0] = (u32x2){cvt_pk_bf16(pv[0], pv[1]), cvt_pk_bf16(pv[2], pv[3])};
    }
}

__device__ __forceinline__ void p2_conv(Frame& F) {
    const int gt = blockIdx.x * (NWAVES * 64) + F.tid, NT = F.G * NWAVES * 64;
    constexpr int NCG = NCH / 8;
    constexpr int NU_P = (MPR / 64) * NCG, NU_S = NSMP * NCG;
    for (int u = gt; u < NU_P + NU_S; u += NT) {
        const bool smp = u >= NU_P;
        const int uu = smp ? u - NU_P : u;
        const int ch = uu / NCG, cgi = uu % NCG;
        const bool is_ssm = cgi < 384;
        const int cc = is_ssm ? cgi * 8 : (cgi - 384) * 8;
        const int kind = is_ssm ? 0 : 1 + (cgi - 384) / 128;
        const float* cw = is_ssm ? F.in[10] : F.in[16];
        float w[4][8], bias[8];
#pragma unroll
        for (int j = 0; j < 4; ++j) { const f32x4 a = *(const f32x4*)(cw + j * 3072 + cc), b = *(const f32x4*)(cw + j * 3072 + cc + 4);
#pragma unroll
            for (int i = 0; i < 4; ++i) { w[j][i] = a[i]; w[j][4 + i] = b[i]; } }
        if (is_ssm) { const f32x4 a = *(const f32x4*)(F.in[11] + cc), b = *(const f32x4*)(F.in[11] + cc + 4);
#pragma unroll
            for (int i = 0; i < 4; ++i) { bias[i] = a[i]; bias[4 + i] = b[i]; } }
        else {
#pragma unroll
            for (int i = 0; i < 8; ++i) bias[i] = 0.f; }
        float h0[8], h1[8], h2[8];
        const int pcol = C_XS + cgi * 8;
        if (smp) {
            const float* st = (is_ssm ? F.in[5] : F.in[7]) + (size_t)ch * 3 * 3072 + cc;
#pragma unroll
            for (int i = 0; i < 8; ++i) { h0[i] = st[i]; h1[i] = st[3072 + i]; h2[i] = st[2 * 3072 + i]; }
            bf16_t* rp = F.PROJ + (size_t)(MPR + ch) * LDP + pcol;
            float x[8]; unpack8(*(const u32x4*)rp, x);
            float o[8]; float ss = 0.f;
#pragma unroll
            for (int i = 0; i < 8; ++i) { float v = w[0][i] * h0[i] + w[1][i] * h1[i] + w[2][i] * h2[i] + w[3][i] * x[i] + bias[i]; v = siluf_(v); o[i] = v; ss += v * v; }
            if (kind == 1 || kind == 2) {
                ss += __shfl_xor(ss, 1); ss += __shfl_xor(ss, 2); ss += __shfl_xor(ss, 4); ss += __shfl_xor(ss, 8);
                const float rn = rsqrtf(ss + EPS) * (kind == 1 ? 0.08838834764831845f : 1.0f);
#pragma unroll
                for (int i = 0; i < 8; ++i) o[i] *= rn;
            }
            *(u32x4*)rp = pack8(o);
            float* ns = F.out + (is_ssm ? O_SCONVS : O_GCONVS) + (size_t)ch * 3 * 3072 + cc;
#pragma unroll
            for (int i = 0; i < 8; ++i) { ns[i] = h1[i]; ns[3072 + i] = h2[i]; ns[2 * 3072 + i] = x[i]; }
            continue;
        }
        const int rowbase = ch * 64, t0 = rowbase & (SEQ - 1);
        if (t0 == 0) {
#pragma unroll
            for (int i = 0; i < 8; ++i) { h0[i] = 0.f; h1[i] = 0.f; h2[i] = 0.f; }
        } else {
            const bf16_t* hp = F.HALO + (size_t)(ch - 1) * 3 * NCH + cgi * 8;
            unpack8(*(const u32x4*)hp, h0); unpack8(*(const u32x4*)(hp + NCH), h1); unpack8(*(const u32x4*)(hp + 2 * NCH), h2);
        }
        const bool lastc = (t0 == SEQ - 64);
        float* ns = F.out + (is_ssm ? O_SCONVP : O_GCONVP) + (size_t)(rowbase >> 11) * 3 * 3072 + cc;
        bf16_t* rp = F.PROJ + (size_t)rowbase * LDP + pcol;
        for (int rb = 0; rb < 64; rb += 8) {
            u32x4 raw[8];
#pragma unroll
            for (int r = 0; r < 8; ++r) raw[r] = *(const u32x4*)(rp + (size_t)(rb + r) * LDP);
#pragma unroll
            for (int r = 0; r < 8; ++r) {
                float x[8]; unpack8(raw[r], x);
                float o[8]; float ss = 0.f;
#pragma unroll
                for (int i = 0; i < 8; ++i) { float v = w[0][i] * h0[i] + w[1][i] * h1[i] + w[2][i] * h2[i] + w[3][i] * x[i] + bias[i]; v = siluf_(v); o[i] = v; ss += v * v; }
                if (kind == 1 || kind == 2) {
                    ss += __shfl_xor(ss, 1); ss += __shfl_xor(ss, 2); ss += __shfl_xor(ss, 4); ss += __shfl_xor(ss, 8);
                    const float rn = rsqrtf(ss + EPS) * (kind == 1 ? 0.08838834764831845f : 1.0f);
#pragma unroll
                    for (int i = 0; i < 8; ++i) o[i] *= rn;
                }
                *(u32x4*)(rp + (size_t)(rb + r) * LDP) = pack8(o);
                if (lastc && rb == 56 && r >= 5) {
#pragma unroll
                    for (int i = 0; i < 8; ++i) ns[(r - 5) * 3072 + i] = x[i];
                }
#pragma unroll
                for (int i = 0; i < 8; ++i) { h0[i] = h1[i]; h1[i] = h2[i]; h2[i] = x[i]; }
            }
        }
    }
}

__device__ __forceinline__ void ssd_item(Frame& F, int item) {
    const bool smp = item >= NBATCH * 32;
    const int sq = smp ? (item - NBATCH * 32) >> 5 : item >> 5, h = item & 31, g = h >> 3;
    const int row0 = smp ? MPR + sq : sq * SEQ, T = smp ? 1 : SEQ;
    const int tid = F.tid, p = tid >> 3, nq = tid & 7;
    LAS bf16_t* Bs = (LAS bf16_t*)(F.lds);
    LAS bf16_t* Cs = (LAS bf16_t*)(F.lds + 16384);
    LAS bf16_t* Xs = (LAS bf16_t*)(F.lds + 32768);
    LAS float* dts = (LAS float*)(F.lds + 40960);
    LAS float* decs = (LAS float*)(F.lds + 41216);
    LAS float* Ys = (LAS float*)(F.lds + 41472);
    float hst[16];
    if (smp) {
        const float* sp = F.in[4] + ((size_t)(sq * 32 + h) * 64 + p) * 128 + nq * 16;
#pragma unroll
        for (int i = 0; i < 4; ++i) { const f32x4 v = ((const f32x4*)sp)[i]; hst[4 * i] = v[0]; hst[4 * i + 1] = v[1]; hst[4 * i + 2] = v[2]; hst[4 * i + 3] = v[3]; }
    } else {
#pragma unroll
        for (int i = 0; i < 16; ++i) hst[i] = 0.f;
    }
    const float a_h = -__expf(F.in[13][h]), dtb = F.in[12][h], Dh = F.in[14][h];
    for (int tb = 0; tb < T; tb += 64) {
        const int rows = (T - tb) < 64 ? (T - tb) : 64;
#pragma unroll
        for (int i = 0; i < 2; ++i) {
            const int pc = tid + i * 512, r = pc >> 4, c8 = (pc & 15) * 8;
            if (r < rows) {
                const bf16_t* src = F.PROJ + (size_t)(row0 + tb + r) * LDP;
                *(LAS u32x4*)(Bs + r * 128 + c8) = *(const u32x4*)(src + C_B + g * 128 + c8);
                *(LAS u32x4*)(Cs + r * 128 + c8) = *(const u32x4*)(src + C_C + g * 128 + c8);
            }
        }
        { const int r = tid >> 3, c8 = (tid & 7) * 8;
          if (r < rows) *(LAS u32x4*)(Xs + r * 64 + c8) = *(const u32x4*)(F.PROJ + (size_t)(row0 + tb + r) * LDP + C_XS + h * 64 + c8); }
        if (tid < rows) { const float dt = softplusf_(F.SMALL[(size_t)(row0 + tb + tid) * 64 + h] + dtb); dts[tid] = dt; decs[tid] = __expf(dt * a_h); }
        __syncthreads();
        for (int tt = 0; tt < rows; ++tt) {
            const float xv = bf2f(Xs[tt * 64 + p]), dtv = dts[tt], dc = decs[tt], dx = dtv * xv;
            float bv[16], cv[16];
            { float t8[8]; unpack8(*(const LAS u32x4*)(Bs + tt * 128 + nq * 16), t8);
#pragma unroll
              for (int i = 0; i < 8; ++i) bv[i] = t8[i];
              unpack8(*(const LAS u32x4*)(Bs + tt * 128 + nq * 16 + 8), t8);
#pragma unroll
              for (int i = 0; i < 8; ++i) bv[8 + i] = t8[i];
              unpack8(*(const LAS u32x4*)(Cs + tt * 128 + nq * 16), t8);
#pragma unroll
              for (int i = 0; i < 8; ++i) cv[i] = t8[i];
              unpack8(*(const LAS u32x4*)(Cs + tt * 128 + nq * 16 + 8), t8);
#pragma unroll
              for (int i = 0; i < 8; ++i) cv[8 + i] = t8[i]; }
            float yp = 0.f;
#pragma unroll
            for (int i = 0; i < 16; ++i) { hst[i] = dc * hst[i] + dx * bv[i]; yp += cv[i] * hst[i]; }
            yp += __shfl_xor(yp, 1); yp += __shfl_xor(yp, 2); yp += __shfl_xor(yp, 4);
            if (nq == 0) Ys[tt * 64 + p] = yp + Dh * xv;
        }
        __syncthreads();
        { const int r = tid >> 3, c8 = (tid & 7) * 8;
          if (r < rows) { float o[8];
#pragma unroll
              for (int i = 0; i < 8; ++i) o[i] = Ys[r * 64 + c8 + i];
              *(u32x4*)(F.PROJ + (size_t)(row0 + tb + r) * LDP + C_XS + h * 64 + c8) = pack8(o); } }
        __syncthreads();
    }
    float* op = F.out + (smp ? O_SSMS : O_SSMP) + ((size_t)(sq * 32 + h) * 64 + p) * 128 + nq * 16;
#pragma unroll
    for (int i = 0; i < 4; ++i) ((f32x4*)op)[i] = (f32x4){hst[4 * i], hst[4 * i + 1], hst[4 * i + 2], hst[4 * i + 3]};
}

__device__ __forceinline__ void gdn_item(Frame& F, int item) {
    const bool smp = item >= NBATCH * 32;
    const int sq = smp ? (item - NBATCH * 32) >> 5 : item >> 5, h = (item >> 2) & 7, dvq = item & 3;
    const int row0 = smp ? MPR + sq : sq * SEQ, T = smp ? 1 : SEQ;
    const int tid = F.tid, e = tid >> 4, kg = tid & 15;
    LAS bf16_t* Qs = (LAS bf16_t*)(F.lds);
    LAS bf16_t* Ks = (LAS bf16_t*)(F.lds + 16384);
    LAS bf16_t* Vs = (LAS bf16_t*)(F.lds + 32768);
    LAS float* egs = (LAS float*)(F.lds + 36864);
    LAS float* bts = (LAS float*)(F.lds + 37120);
    LAS float* Os = (LAS float*)(F.lds + 37376);
    float S[8];
    const size_t sbase = ((size_t)(sq * 8 + h) * 128 + kg * 8) * 128 + dvq * 32 + e;
    if (smp) {
#pragma unroll
        for (int j = 0; j < 8; ++j) S[j] = F.in[6][sbase + (size_t)j * 128];
    } else {
#pragma unroll
        for (int j = 0; j < 8; ++j) S[j] = 0.f;
    }
    const float na = -__expf(F.in[18][h]), dtb = F.in[17][h];
    for (int tb = 0; tb < T; tb += 64) {
        const int rows = (T - tb) < 64 ? (T - tb) : 64;
#pragma unroll
        for (int i = 0; i < 2; ++i) {
            const int pc = tid + i * 512, r = pc >> 4, c8 = (pc & 15) * 8;
            if (r < rows) {
                const bf16_t* src = F.PROJ + (size_t)(row0 + tb + r) * LDP;
                *(LAS u32x4*)(Qs + r * 128 + c8) = *(const u32x4*)(src + C_Q + h * 128 + c8);
                *(LAS u32x4*)(Ks + r * 128 + c8) = *(const u32x4*)(src + C_K + h * 128 + c8);
            }
        }
        if (tid < 256) { const int r = tid >> 2, c8 = (tid & 3) * 8;
          if (r < rows) *(LAS u32x4*)(Vs + r * 32 + c8) = *(const u32x4*)(F.PROJ + (size_t)(row0 + tb + r) * LDP + C_V + h * 128 + dvq * 32 + c8); }
        if (tid < rows) { const float* sm = F.SMALL + (size_t)(row0 + tb + tid) * 64;
            egs[tid] = __expf(na * softplusf_(sm[40 + h] + dtb)); bts[tid] = sigmoidf_(sm[32 + h]); }
        __syncthreads();
        for (int tt = 0; tt < rows; ++tt) {
            float k8[8], q8[8];
            unpack8(*(const LAS u32x4*)(Ks + tt * 128 + kg * 8), k8);
            unpack8(*(const LAS u32x4*)(Qs + tt * 128 + kg * 8), q8);
            const float eg = egs[tt], bt = bts[tt], v = bf2f(Vs[tt * 32 + e]);
            float ks = 0.f;
#pragma unroll
            for (int j = 0; j < 8; ++j) ks += k8[j] * S[j];
            ks += __shfl_xor(ks, 1); ks += __shfl_xor(ks, 2); ks += __shfl_xor(ks, 4); ks += __shfl_xor(ks, 8);
            const float vn = bt * (v - eg * ks);
            float op = 0.f;
#pragma unroll
            for (int j = 0; j < 8; ++j) { S[j] = eg * S[j] + k8[j] * vn; op += q8[j] * S[j]; }
            op += __shfl_xor(op, 1); op += __shfl_xor(op, 2); op += __shfl_xor(op, 4); op += __shfl_xor(op, 8);
            if (kg == 0) Os[tt * 32 + e] = op;
        }
        __syncthreads();
        if (tid < 256) { const int r = tid >> 2, c8 = (tid & 3) * 8;
          if (r < rows) { float o[8];
#pragma unroll
              for (int i = 0; i < 8; ++i) o[i] = Os[r * 32 + c8 + i];
              *(u32x4*)(F.PROJ + (size_t)(row0 + tb + r) * LDP + C_V + h * 128 + dvq * 32 + c8) = pack8(o); } }
        __syncthreads();
    }
    float* op = F.out + (smp ? O_GDNS : O_GDNP);
#pragma unroll
    for (int j = 0; j < 8; ++j) op[sbase + (size_t)j * 128] = S[j];
}


typedef short v4i16 __attribute__((ext_vector_type(4)));
__device__ __forceinline__ bf16x8 row_frag(LAS const unsigned char* base, int pitch, int row0, int k0, int lane) {
    return *(const LAS bf16x8*)(base + (row0 + (lane & 15)) * pitch + (k0 + 8 * (lane >> 4)) * 2);
}
__device__ __forceinline__ bf16x8 tr_frag(LAS const unsigned char* base, int pitch, int k0, int col0, int lane) {
    const int g = lane >> 4, m = lane & 15, q = m >> 2, pp = m & 3;
    LAS const unsigned char* a0 = base + (k0 + 8 * g + q) * pitch + (col0 + 4 * pp) * 2;
    const v4i16 lo = __builtin_amdgcn_ds_read_tr16_b64_v4i16((LAS v4i16*)a0);
    const v4i16 hi = __builtin_amdgcn_ds_read_tr16_b64_v4i16((LAS v4i16*)(a0 + 4 * pitch));
    return (bf16x8){lo[0], lo[1], lo[2], lo[3], hi[0], hi[1], hi[2], hi[3]};
}
#define LDS_BARRIER() do { asm volatile("s_waitcnt lgkmcnt(0)" ::: "memory"); __builtin_amdgcn_s_barrier(); asm volatile("" ::: "memory"); } while (0)
#define MFMA16(a, b, c) __builtin_amdgcn_mfma_f32_16x16x32_bf16((a), (b), (c), 0, 0, 0)
__device__ __forceinline__ u32x2 pack4(float a, float b, float c, float d) { return (u32x2){cvt_pk_bf16(a, b), cvt_pk_bf16(c, d)}; }

__device__ __forceinline__ void ssd_chunked(Frame& F, int item) {
    const int b = item >> 5, h = item & 31, g4 = h >> 3;
    const int tid = F.tid, lane = F.lane, w = F.wave, i16 = lane & 15, g = lane >> 4;
    LAS unsigned char* L = F.lds;
    constexpr int PB = 272, PX = 144, PY = 260;
    constexpr int O_BT = 0, O_CT = 17408, O_XT = 34816, O_XD = 44032, O_MT = 53248, O_SL = 62464, O_YT = 79872, O_SC = 96512;
    LAS float* acum = (LAS float*)(L + O_SC); LAS float* dtl = acum + 64; LAS float* scl = acum + 128; LAS float* eac = acum + 192; LAS float* cdecp = acum + 256;
    __syncthreads();
    for (int u = tid; u < 17408 / 16; u += 512) *(LAS u32x4*)(L + O_SL + u * 16) = (u32x4){0u, 0u, 0u, 0u};
    f32x4 sacc[4];
#pragma unroll
    for (int pb = 0; pb < 4; ++pb) sacc[pb] = (f32x4){0.f, 0.f, 0.f, 0.f};
    const float a_h = -__expf(F.in[13][h]), dtb = F.in[12][h], Dh = F.in[14][h];
    const int row00 = b * SEQ;
    u32x4 rb[2], rc[2], rx; float rdt = 0.f;
    const int br0 = tid >> 4, bc8 = (tid & 15) * 8;
    const int xr = tid >> 3, xc8 = (tid & 7) * 8;
#define SSD_LOAD(c) do { const bf16_t* src = F.PROJ + (size_t)(row00 + (c) * 64) * LDP; \
        rb[0] = *(const u32x4*)(src + (size_t)br0 * LDP + C_B + g4 * 128 + bc8); rb[1] = *(const u32x4*)(src + (size_t)(br0 + 32) * LDP + C_B + g4 * 128 + bc8); \
        rc[0] = *(const u32x4*)(src + (size_t)br0 * LDP + C_C + g4 * 128 + bc8); rc[1] = *(const u32x4*)(src + (size_t)(br0 + 32) * LDP + C_C + g4 * 128 + bc8); \
        rx = *(const u32x4*)(src + (size_t)xr * LDP + C_XS + h * 64 + xc8); \
        if (tid < 64) rdt = F.SMALL[(size_t)(row00 + (c) * 64 + tid) * 64 + h]; } while (0)
    SSD_LOAD(0);
    for (int c = 0; c < SEQ / 64; ++c) {
        *(LAS u32x4*)(L + O_BT + br0 * PB + bc8 * 2) = rb[0]; *(LAS u32x4*)(L + O_BT + (br0 + 32) * PB + bc8 * 2) = rb[1];
        *(LAS u32x4*)(L + O_CT + br0 * PB + bc8 * 2) = rc[0]; *(LAS u32x4*)(L + O_CT + (br0 + 32) * PB + bc8 * 2) = rc[1];
        *(LAS u32x4*)(L + O_XT + xr * PX + xc8 * 2) = rx;
        if (tid < 64) {
            const float dt = softplusf_(rdt + dtb);
            float v = dt * a_h;
#pragma unroll
            for (int o = 1; o < 64; o <<= 1) { const float t = __shfl_up(v, o); if (lane >= o) v += t; }
            const float last = __shfl(v, 63);
            acum[lane] = v; dtl[lane] = dt; scl[lane] = dt * __expf(last - v); eac[lane] = __expf(v);
            if (lane == 63) cdecp[0] = __expf(v);
        }
        const u32x4 xkeep = rx;
        LDS_BARRIER();
        if (c + 1 < SEQ / 64) SSD_LOAD(c + 1);
        { float x8[8]; unpack8(xkeep, x8); const float sc = scl[xr];
#pragma unroll
          for (int i = 0; i < 8; ++i) x8[i] *= sc;
          *(LAS u32x4*)(L + O_XD + xr * PX + xc8 * 2) = pack8(x8); }
#pragma unroll
        for (int tt = 0; tt < 2; ++tt) {
            const int t = 2 * w + tt, lb = t >> 2, sb = t & 3;
            const int l = 16 * lb + i16;
            u32x2 mw = (u32x2){0u, 0u};
            if (sb <= lb) {
                f32x4 acc = (f32x4){0.f, 0.f, 0.f, 0.f};
#pragma unroll
                for (int ks = 0; ks < 4; ++ks) acc = MFMA16(row_frag(L + O_BT, PB, 16 * sb, 32 * ks, lane), row_frag(L + O_CT, PB, 16 * lb, 32 * ks, lane), acc);
                const float al = acum[l];
                float mv[4];
#pragma unroll
                for (int r = 0; r < 4; ++r) { const int s = 16 * sb + 4 * g + r; const float e = __expf(al - acum[s]) * dtl[s] * acc[r]; mv[r] = (s <= l) ? e : 0.f; }
                mw = pack4(mv[0], mv[1], mv[2], mv[3]);
            }
            *(LAS u32x2*)(L + O_MT + l * PX + (16 * sb + 4 * g) * 2) = mw;
        }
        f32x4 yacc[2];
        const int lb = w >> 1;
#pragma unroll
        for (int tt = 0; tt < 2; ++tt) {
            const int pb = 2 * (w & 1) + tt;
            f32x4 acc = (f32x4){0.f, 0.f, 0.f, 0.f};
#pragma unroll
            for (int ks = 0; ks < 4; ++ks) acc = MFMA16(row_frag(L + O_CT, PB, 16 * lb, 32 * ks, lane), row_frag(L + O_SL, PB, 16 * pb, 32 * ks, lane), acc);
#pragma unroll
            for (int r = 0; r < 4; ++r) acc[r] *= eac[16 * lb + 4 * g + r];
            yacc[tt] = acc;
        }
        LDS_BARRIER();
#pragma unroll
        for (int tt = 0; tt < 2; ++tt) {
            const int pb = 2 * (w & 1) + tt;
            f32x4 acc = yacc[tt];
            acc = MFMA16(row_frag(L + O_MT, PX, 16 * lb, 0, lane), tr_frag(L + O_XT, PX, 0, 16 * pb, lane), acc);
            if (lb >= 2) acc = MFMA16(row_frag(L + O_MT, PX, 16 * lb, 32, lane), tr_frag(L + O_XT, PX, 32, 16 * pb, lane), acc);
#pragma unroll
            for (int r = 0; r < 4; ++r) { const int l = 16 * lb + 4 * g + r, p = 16 * pb + i16;
                const float xv = bf2f(*(LAS const bf16_t*)(L + O_XT + l * PX + p * 2));
                *(LAS float*)(L + O_YT + l * PY + p * 4) = acc[r] + Dh * xv; }
        }
        { const float cdec = cdecp[0];
#pragma unroll
          for (int pb = 0; pb < 4; ++pb) sacc[pb] *= cdec;
#pragma unroll
          for (int ks = 0; ks < 2; ++ks) {
              const bf16x8 a = tr_frag(L + O_BT, PB, 32 * ks, 16 * w, lane);
#pragma unroll
              for (int pb = 0; pb < 4; ++pb) sacc[pb] = MFMA16(a, tr_frag(L + O_XD, PX, 32 * ks, 16 * pb, lane), sacc[pb]);
          }
#pragma unroll
          for (int pb = 0; pb < 4; ++pb) *(LAS u32x2*)(L + O_SL + (16 * pb + i16) * PB + (16 * w + 4 * g) * 2) = pack4(sacc[pb][0], sacc[pb][1], sacc[pb][2], sacc[pb][3]);
        }
        LDS_BARRIER();
        { float o[8];
#pragma unroll
          for (int i = 0; i < 8; ++i) o[i] = *(LAS const float*)(L + O_YT + xr * PY + (xc8 + i) * 4);
          *(u32x4*)(F.PROJ + (size_t)(row00 + c * 64 + xr) * LDP + C_XS + h * 64 + xc8) = pack8(o); }
    }
#undef SSD_LOAD
#pragma unroll
    for (int pb = 0; pb < 4; ++pb) *(f32x4*)(F.out + O_SSMP + ((size_t)(b * 32 + h) * 64 + 16 * pb + i16) * 128 + 16 * w + 4 * g) = sacc[pb];
}


__device__ __forceinline__ void gdn_prep(Frame& F, int it, int hb) {
    const int c = it & 31, bh = it >> 5, h = bh & 7, b = bh >> 3;
    const int ht = F.tid & 255, lane = F.lane, hw = F.wave & 3, i16 = lane & 15, g = lane >> 4;
    LAS unsigned char* L = F.lds + hb * 65536;
    constexpr int PB = 272;
    constexpr int O_KT = 0, O_QT = 17408, O_VT = 34816, O_SC = 52224;
    LAS float* gc = (LAS float*)(L + O_SC); LAS float* bt = gc + 64; LAS float* egc = gc + 128;
    const int row0 = b * SEQ + c * 64;
    __syncthreads();
    {
        u32x4 rk[4], rq[4], rv[4];
#pragma unroll
        for (int j = 0; j < 4; ++j) { const int pc = ht + j * 256, r = pc >> 4, c8 = (pc & 15) * 8; const bf16_t* src = F.PROJ + (size_t)(row0 + r) * LDP + h * 128 + c8;
            rk[j] = *(const u32x4*)(src + C_K); rq[j] = *(const u32x4*)(src + C_Q); rv[j] = *(const u32x4*)(src + C_V); }
        if (ht < 64) {
            const float* sm = F.SMALL + (size_t)(row0 + lane) * 64;
            const float na = -__expf(F.in[18][h]), dtb = F.in[17][h];
            float v = na * softplusf_(sm[40 + h] + dtb);
            const float be = sigmoidf_(sm[32 + h]);
#pragma unroll
            for (int o = 1; o < 64; o <<= 1) { const float t = __shfl_up(v, o); if (lane >= o) v += t; }
            gc[lane] = v; bt[lane] = be; egc[lane] = __expf(v);
            ((float*)(F.ws + WS_GC))[(size_t)it * 64 + lane] = v;
        }
#pragma unroll
        for (int j = 0; j < 4; ++j) { const int pc = ht + j * 256, r = pc >> 4, c8 = (pc & 15) * 8;
            *(LAS u32x4*)(L + O_KT + r * PB + c8 * 2) = rk[j]; *(LAS u32x4*)(L + O_QT + r * PB + c8 * 2) = rq[j]; *(LAS u32x4*)(L + O_VT + r * PB + c8 * 2) = rv[j]; }
    }
    __syncthreads();
    f32x4 kk[4];
    const int lb = hw;
    bf16_t* qkm = (bf16_t*)(F.ws + WS_QKM) + (size_t)it * 4096;
#pragma unroll
    for (int sb = 0; sb < 4; ++sb) {
        kk[sb] = (f32x4){0.f, 0.f, 0.f, 0.f};
        const int l = 16 * lb + i16;
        u32x2 qw = (u32x2){0u, 0u};
        if (sb <= lb) {
            f32x4 qa = (f32x4){0.f, 0.f, 0.f, 0.f};
#pragma unroll
            for (int ks = 0; ks < 4; ++ks) {
                const bf16x8 ks_ = row_frag(L + O_KT, PB, 16 * sb, 32 * ks, lane);
                kk[sb] = MFMA16(row_frag(L + O_KT, PB, 16 * lb, 32 * ks, lane), ks_, kk[sb]);
                qa = MFMA16(ks_, row_frag(L + O_QT, PB, 16 * lb, 32 * ks, lane), qa);
            }
            const float gl = gc[l];
            float qv[4];
#pragma unroll
            for (int r = 0; r < 4; ++r) { const int s_ = 16 * sb + 4 * g + r; const float e = __expf(gl - gc[s_]) * qa[r]; qv[r] = (s_ <= l) ? e : 0.f; }
            qw = pack4(qv[0], qv[1], qv[2], qv[3]);
        }
        *(u32x2*)(qkm + l * 64 + 16 * sb + 4 * g) = qw;
    }
    __syncthreads();
#pragma unroll
    for (int sb = 0; sb < 4; ++sb) {
        if (sb <= lb) {
#pragma unroll
            for (int r = 0; r < 4; ++r) { const int l = 16 * lb + 4 * g + r, s_ = 16 * sb + i16;
                const float a = (s_ < l) ? bt[l] * kk[sb][r] * __expf(gc[l] - gc[s_]) : 0.f;
                *(LAS float*)(L + O_QT + l * PB + s_ * 4) = a; }
        }
    }
    __syncthreads();
    float x[64];
    {
        const bool isv = ht < 128;
        LAS const unsigned char* colp = L + (isv ? O_VT : O_KT) + (ht & 127) * 2;
#pragma unroll
        for (int l = 0; l < 64; ++l) { const float v = bf2f(*(LAS const bf16_t*)(colp + l * PB)); x[l] = v * bt[l] * (isv ? 1.0f : egc[l]); }
    }
#pragma unroll
    for (int l = 1; l < 64; ++l) {
        float acc0 = x[l], acc1 = 0.f;
#pragma unroll
        for (int s4 = 0; s4 < (l + 3) / 4; ++s4) {
            const f32x4 a = *(LAS const f32x4*)(L + O_QT + l * PB + s4 * 16);
#pragma unroll
            for (int j = 0; j < 4; ++j) if (4 * s4 + j < l) { if (j & 1) asm("v_fma_f32 %0, -%1, %2, %0" : "+v"(acc1) : "v"(a[j]), "v"(x[4 * s4 + j])); else asm("v_fma_f32 %0, -%1, %2, %0" : "+v"(acc0) : "v"(a[j]), "v"(x[4 * s4 + j])); }
        }
        x[l] = acc0 + acc1;
        asm volatile("" ::: "memory");
    }
    {
        const bool isv = ht < 128;
        bf16_t* dst = (bf16_t*)(F.ws + (isv ? WS_UT : WS_WT)) + (size_t)it * 8192 + (ht & 127) * 64;
        const float sg = isv ? 1.0f : -1.0f;
#pragma unroll
        for (int q8 = 0; q8 < 8; ++q8) { float o[8];
#pragma unroll
            for (int i = 0; i < 8; ++i) o[i] = sg * x[8 * q8 + i];
            *(u32x4*)(dst + 8 * q8) = pack8(o); }
    }
}

__device__ __forceinline__ void gdn_scan(Frame& F, int item) {
    const int dvq = item & 3, bh = item >> 2, h = bh & 7, b = bh >> 3;
    const int tid = F.tid, lane = F.lane, w = F.wave, i16 = lane & 15, g = lane >> 4;
    LAS unsigned char* L = F.lds;
    constexpr int PB = 272, PX = 144, PO = 132;
    constexpr int O_WT = 0, O_QG = 18432, O_KG = 35840, O_QK = 53248, O_UT = 62464, O_ST = 67072, O_VN = 75776, O_OT = 80384, O_GL = 88832;
    __syncthreads();
    for (int u = tid; u < 8704 / 16; u += 512) *(LAS u32x4*)(L + O_ST + u * 16) = (u32x4){0u, 0u, 0u, 0u};
    f32x4 sacc[2];
    sacc[0] = (f32x4){0.f, 0.f, 0.f, 0.f}; sacc[1] = sacc[0];
    const int lb = w >> 1, eb = w & 1;
    const int r0 = tid >> 4, c8a = (tid & 15) * 8;
    const int xr = tid >> 3, xc8 = (tid & 7) * 8;
    const float* GC = (const float*)(F.ws + WS_GC);
    u32x4 rw[2], rq[2], rk[2], rqk, ru; float gq0 = 0.f, gq1 = 0.f, glast = 0.f;
#define GDN_LOAD(c) do { const size_t it_ = (size_t)bh * 32 + (c); \
        const bf16_t* wt = (const bf16_t*)(F.ws + WS_WT) + it_ * 8192; rw[0] = *(const u32x4*)(wt + xr * 64 + xc8); rw[1] = *(const u32x4*)(wt + (xr + 64) * 64 + xc8); \
        const bf16_t* src = F.PROJ + (size_t)(b * SEQ + (c) * 64) * LDP + h * 128 + c8a; \
        rq[0] = *(const u32x4*)(src + (size_t)r0 * LDP + C_Q); rq[1] = *(const u32x4*)(src + (size_t)(r0 + 32) * LDP + C_Q); \
        rk[0] = *(const u32x4*)(src + (size_t)r0 * LDP + C_K); rk[1] = *(const u32x4*)(src + (size_t)(r0 + 32) * LDP + C_K); \
        rqk = *(const u32x4*)((const bf16_t*)(F.ws + WS_QKM) + it_ * 4096 + xr * 64 + xc8); \
        if (tid < 256) ru = *(const u32x4*)((const bf16_t*)(F.ws + WS_UT) + it_ * 8192 + (dvq * 32 + xr) * 64 + xc8); \
        gq0 = GC[it_ * 64 + r0]; gq1 = GC[it_ * 64 + r0 + 32]; glast = GC[it_ * 64 + 63]; } while (0)
    GDN_LOAD(0);
    for (int c = 0; c < SEQ / 64; ++c) {
        *(LAS u32x4*)(L + O_WT + xr * PX + xc8 * 2) = rw[0]; *(LAS u32x4*)(L + O_WT + (xr + 64) * PX + xc8 * 2) = rw[1];
        *(LAS u32x4*)(L + O_QK + xr * PX + xc8 * 2) = rqk;
        if (tid < 256) *(LAS u32x4*)(L + O_UT + xr * PX + xc8 * 2) = ru;
        {
            float t8[8];
            const float eq0 = __expf(gq0), eq1 = __expf(gq1), ek0 = __expf(glast - gq0), ek1 = __expf(glast - gq1);
            unpack8(rq[0], t8);
#pragma unroll
            for (int i = 0; i < 8; ++i) t8[i] *= eq0;
            *(LAS u32x4*)(L + O_QG + r0 * PB + c8a * 2) = pack8(t8);
            unpack8(rq[1], t8);
#pragma unroll
            for (int i = 0; i < 8; ++i) t8[i] *= eq1;
            *(LAS u32x4*)(L + O_QG + (r0 + 32) * PB + c8a * 2) = pack8(t8);
            unpack8(rk[0], t8);
#pragma unroll
            for (int i = 0; i < 8; ++i) t8[i] *= ek0;
            *(LAS u32x4*)(L + O_KG + r0 * PB + c8a * 2) = pack8(t8);
            unpack8(rk[1], t8);
#pragma unroll
            for (int i = 0; i < 8; ++i) t8[i] *= ek1;
            *(LAS u32x4*)(L + O_KG + (r0 + 32) * PB + c8a * 2) = pack8(t8);
        }
        const float gl = __expf(glast);
        LDS_BARRIER();
        if (c + 1 < SEQ / 64) GDN_LOAD(c + 1);
        f32x4 vacc, oacc = (f32x4){0.f, 0.f, 0.f, 0.f};
        { const u32x2 uw = *(LAS const u32x2*)(L + O_UT + (16 * eb + i16) * PX + (16 * lb + 4 * g) * 2);
          vacc = (f32x4){bflo(uw.x), bfhi(uw.x), bflo(uw.y), bfhi(uw.y)}; }
#pragma unroll
        for (int ks = 0; ks < 4; ++ks) {
            const bf16x8 bS = row_frag(L + O_ST, PB, 16 * eb, 32 * ks, lane);
            vacc = MFMA16(tr_frag(L + O_WT, PX, 32 * ks, 16 * lb, lane), bS, vacc);
            oacc = MFMA16(row_frag(L + O_QG, PB, 16 * lb, 32 * ks, lane), bS, oacc);
        }
        *(LAS u32x2*)(L + O_VN + (16 * eb + i16) * PX + (16 * lb + 4 * g) * 2) = pack4(vacc[0], vacc[1], vacc[2], vacc[3]);
        LDS_BARRIER();
        {
            const bf16x8 bV0 = row_frag(L + O_VN, PX, 16 * eb, 0, lane), bV1 = row_frag(L + O_VN, PX, 16 * eb, 32, lane);
            oacc = MFMA16(row_frag(L + O_QK, PX, 16 * lb, 0, lane), bV0, oacc);
            if (lb >= 2) oacc = MFMA16(row_frag(L + O_QK, PX, 16 * lb, 32, lane), bV1, oacc);
#pragma unroll
            for (int r = 0; r < 4; ++r) *(LAS float*)(L + O_OT + (16 * lb + 4 * g + r) * PO + (16 * eb + i16) * 4) = oacc[r];
#pragma unroll
            for (int t2 = 0; t2 < 2; ++t2) {
                const int db = 2 * lb + t2;
                f32x4 sa = sacc[t2] * gl;
                sa = MFMA16(tr_frag(L + O_KG, PB, 0, 16 * db, lane), bV0, sa);
                sa = MFMA16(tr_frag(L + O_KG, PB, 32, 16 * db, lane), bV1, sa);
                sacc[t2] = sa;
                *(LAS u32x2*)(L + O_ST + (16 * eb + i16) * PB + (16 * db + 4 * g) * 2) = pack4(sa[0], sa[1], sa[2], sa[3]);
            }
        }
        LDS_BARRIER();
        if (tid < 256) { const int r = tid >> 2, c8 = (tid & 3) * 8; float o[8];
#pragma unroll
            for (int i = 0; i < 8; ++i) o[i] = *(LAS const float*)(L + O_OT + r * PO + (c8 + i) * 4);
            *(u32x4*)(F.PROJ + (size_t)(b * SEQ + c * 64 + r) * LDP + C_V + h * 128 + dvq * 32 + c8) = pack8(o); }
    }
#undef GDN_LOAD
#pragma unroll
    for (int t2 = 0; t2 < 2; ++t2)
#pragma unroll
        for (int r = 0; r < 4; ++r) F.out[O_GDNP + ((size_t)bh * 128 + 16 * (2 * lb + t2) + 4 * g + r) * 128 + dvq * 32 + 16 * eb + i16] = sacc[t2][r];
}


template <class EpiQ>
__device__ __forceinline__ void small_gemm(Frame& F, const bf16_t* A, int lda, const bf16_t* Bt, int ldb, int K, int N, const EpiQ& q) {
    const int lane = F.lane, w = F.wave, i16 = lane & 15, g = lane >> 4, kp = w & 3, tw = w >> 2;
    LAS float* part = (LAS float*)F.lds;
    const int ntl = 8 * (N / 16), nsteps = K / 128;
    for (int t2 = blockIdx.x; 2 * t2 < ntl; t2 += F.G) {
        const int t = 2 * t2 + tw, rg = t / (N / 16), nb = t % (N / 16);
        const bf16_t* ap = A + (size_t)(16 * rg + i16) * lda + kp * (K / 4) + 8 * g;
        const bf16_t* bp = Bt + (size_t)(16 * nb + i16) * ldb + kp * (K / 4) + 8 * g;
        f32x4 acc = (f32x4){0.f, 0.f, 0.f, 0.f};
        int ks = 0;
        for (; ks + 4 <= nsteps; ks += 4) {
            bf16x8 av[4], bv[4];
#pragma unroll
            for (int j = 0; j < 4; ++j) { av[j] = *(const bf16x8*)(ap + (ks + j) * 32); bv[j] = *(const bf16x8*)(bp + (ks + j) * 32); }
#pragma unroll
            for (int j = 0; j < 4; ++j) acc = MFMA16(bv[j], av[j], acc);
        }
        for (; ks < nsteps; ++ks) acc = MFMA16(*(const bf16x8*)(bp + ks * 32), *(const bf16x8*)(ap + ks * 32), acc);
        __syncthreads();
        *(LAS f32x4*)(part + (w * 64 + lane) * 4) = acc;
        __syncthreads();
        if (kp == 0) {
            const f32x4 p1 = *(LAS const f32x4*)(part + ((w + 1) * 64 + lane) * 4), p2 = *(LAS const f32x4*)(part + ((w + 2) * 64 + lane) * 4), p3 = *(LAS const f32x4*)(part + ((w + 3) * 64 + lane) * 4);
            acc = (acc + p1) + (p2 + p3);
            q(MPR + 16 * rg + i16, 16 * nb + 4 * g, acc);
        }
    }
}
struct QT1 { bf16_t* PROJ;
    __device__ __forceinline__ void operator()(int row, int col, f32x4 v) const {
        const u32x2 mw = *(const u32x2*)(PROJ + (size_t)row * LDP + C_MG + col);
        f32x4 o; o[0] = v[0] * sigmoidf_(bflo(mw.x)); o[1] = v[1] * sigmoidf_(bfhi(mw.x)); o[2] = v[2] * sigmoidf_(bflo(mw.y)); o[3] = v[3] * sigmoidf_(bfhi(mw.y));
        *(f32x4*)((float*)PROJ + (size_t)row * LDF + col) = o; } };
struct QMix { bf16_t* PROJ;
    __device__ __forceinline__ void operator()(int row, int col, f32x4 v) const {
        const u32x2 mw = *(const u32x2*)(PROJ + (size_t)row * LDP + C_MG + 1024 + col);
        const f32x4 t = *(const f32x4*)((const float*)PROJ + (size_t)row * LDF + col);
        *(u32x2*)(PROJ + (size_t)row * LDP + C_Q + col) = pack4(t[0] + v[0] * sigmoidf_(bflo(mw.x)), t[1] + v[1] * sigmoidf_(bfhi(mw.x)), t[2] + v[2] * sigmoidf_(bflo(mw.y)), t[3] + v[3] * sigmoidf_(bfhi(mw.y))); } };
template <int MODE> struct QResid { bf16_t* PROJ; const float* xs; int res_col, dst_col, dstb_col; float* SS;
    __device__ __forceinline__ void operator()(int row, int col, f32x4 v) const {
        const f32x4 r = MODE == 0 ? *(const f32x4*)(xs + (size_t)(row - MPR) * D + col) : *(const f32x4*)((const float*)(PROJ + res_col) + (size_t)row * LDF + col);
        const f32x4 x = r + v;
        *(f32x4*)((float*)(PROJ + dst_col) + (size_t)row * LDF + col) = x;
        *(u32x2*)(PROJ + (size_t)row * LDP + dstb_col + col) = pack4(x[0], x[1], x[2], x[3]);
        float ss = (x[0] * x[0] + x[1] * x[1]) + (x[2] * x[2] + x[3] * x[3]);
        ss += __shfl_xor(ss, 16); ss += __shfl_xor(ss, 32);
        if ((threadIdx.x & 48) == 0) atomicAdd(SS + row, ss); } };
struct QPE { bf16_t* PROJ;
    __device__ __forceinline__ void operator()(int row, int col, f32x4 v) const { *(f32x4*)((float*)PROJ + (size_t)row * LDF + col) = v; } };
struct QX3 { bf16_t* PROJ; const float* SS2; float* SS3; float* out;
    __device__ __forceinline__ void operator()(int row, int col, f32x4 v) const {
        const float r = rsqrtf(SS2[row] * (1.0f / D) + EPS);
        const f32x4 a = *(const f32x4*)((const float*)(PROJ + C_MG) + (size_t)row * LDF + col), p = *(const f32x4*)((const float*)PROJ + (size_t)row * LDF + col);
        f32x4 x;
#pragma unroll
        for (int i = 0; i < 4; ++i) x[i] = a[i] + p[i] * sigmoidf_(r * v[i]);
        *(f32x4*)(out + O_YS + (size_t)(row - MPR) * D + col) = x;
        float ss = (x[0] * x[0] + x[1] * x[1]) + (x[2] * x[2] + x[3] * x[3]);
        ss += __shfl_xor(ss, 16); ss += __shfl_xor(ss, 32);
        if ((threadIdx.x & 48) == 0) atomicAdd(SS3 + row, ss); } };

__device__ __forceinline__ void p3_scan(Frame& F) {
    constexpr int NSSD = NBATCH * 32 + NSMP * 32;
#ifndef NO_SSDC
    if (F.G == 256) {
        const int xcd = blockIdx.x & 7, idx = blockIdx.x >> 3, grp = xcd * 4 + (idx >> 3);
        ssd_chunked(F, (grp >> 2) * 32 + (grp & 3) * 8 + (idx & 7));
    } else
    for (int it = blockIdx.x; it < NBATCH * 32; it += F.G) ssd_chunked(F, it);
#endif
#ifndef NO_PREP
#ifndef REP_PREP
#define REP_PREP 1
#endif
    for (int rp = 0; rp < REP_PREP; ++rp)
    for (int pr = blockIdx.x; pr < 1024; pr += F.G) gdn_prep(F, 2 * pr + (F.tid >> 8), F.tid >> 8);
#endif
    __syncthreads();
#ifndef NO_SSDI
    for (int it = NBATCH * 32 + blockIdx.x; it < NSSD; it += F.G) ssd_item(F, it);
#endif
}
__device__ __forceinline__ void p3b_scan(Frame& F) {
    constexpr int NGDN = NBATCH * 32 + NSMP * 32;
#ifndef REP_SCAN
#define REP_SCAN 1
#endif
    for (int rp = 0; rp < REP_SCAN; ++rp)
    if (F.G == 256) {
        const int xcd = blockIdx.x & 7, idx = blockIdx.x >> 3;
        gdn_scan(F, (xcd * 8 + (idx >> 2)) * 4 + (idx & 3));
    } else
    for (int it = blockIdx.x; it < NBATCH * 32; it += F.G) gdn_scan(F, it);
    __syncthreads();
    for (int it = NBATCH * 32 + blockIdx.x; it < NGDN; it += F.G) gdn_item(F, it);
}

__device__ __forceinline__ void p4_norm(Frame& F) {
    const int gw = blockIdx.x * NWAVES + F.wave, NGW = F.G * NWAVES, lane = F.lane;
    const float* gs = F.in[15]; const float* gg = F.in[19];
    for (int m = gw; m < MTOT; m += NGW) {
        bf16_t* row = F.PROJ + (size_t)m * LDP;
#pragma unroll
        for (int g = 0; g < 4; ++g) {
            const int c = g * 512 + lane * 8;
            float y[8], z[8]; unpack8(*(const u32x4*)(row + C_XS + c), y); unpack8(*(const u32x4*)(row + C_Z + c), z);
            float ss = 0.f;
#pragma unroll
            for (int i = 0; i < 8; ++i) { y[i] *= siluf_(z[i]); ss += y[i] * y[i]; }
            const float r = rsqrtf(wave_sum(ss) * (1.0f / 512.0f) + EPS);
            const f32x4 g0 = *(const f32x4*)(gs + c), g1 = *(const f32x4*)(gs + c + 4);
#pragma unroll
            for (int i = 0; i < 4; ++i) { y[i] *= r * g0[i]; y[4 + i] *= r * g1[i]; }
            *(u32x4*)(row + C_XS + c) = pack8(y);
        }
#pragma unroll
        for (int hh = 0; hh < 2; ++hh) {
            const int c = hh * 512 + lane * 8;
            float o[8], gt[8]; unpack8(*(const u32x4*)(row + C_V + c), o); unpack8(*(const u32x4*)(row + C_GATE + c), gt);
            float ss = 0.f;
#pragma unroll
            for (int i = 0; i < 8; ++i) ss += o[i] * o[i];
            ss += __shfl_xor(ss, 1); ss += __shfl_xor(ss, 2); ss += __shfl_xor(ss, 4); ss += __shfl_xor(ss, 8);
            const float r = rsqrtf(ss * (1.0f / 128.0f) + EPS);
            const int e = (lane & 15) * 8;
            const f32x4 g0 = *(const f32x4*)(gg + e), g1 = *(const f32x4*)(gg + e + 4);
#pragma unroll
            for (int i = 0; i < 4; ++i) { o[i] = o[i] * r * g0[i] * siluf_(gt[i]); o[4 + i] = o[4 + i] * r * g1[i] * siluf_(gt[4 + i]); }
            *(u32x4*)(row + C_V + c) = pack8(o);
        }
    }
}

__device__ __forceinline__ void p12_final(Frame& F) {
    const int gw = blockIdx.x * NWAVES + F.wave, NGW = F.G * NWAVES, lane = F.lane;
    const float* gf = F.in[29];
    for (int m = gw; m < MTOT; m += NGW) {
        float* orow = F.out + (m < MPR ? O_Y + (size_t)m * D : O_YS + (size_t)(m - MPR) * D);
        const float r = rsqrtf(F.SS3[m] * (1.0f / D) + EPS);
#pragma unroll
        for (int j = 0; j < 4; ++j) { f32x4* p = (f32x4*)orow + 64 * j + lane; const f32x4 gv = ((const f32x4*)gf)[64 * j + lane]; *p = *p * r * gv; }
    }
}

__global__ void __launch_bounds__(NWAVES * 64, 2) mega_fwd(Args args) {
    extern __shared__ __attribute__((aligned(16))) unsigned char lds_raw[];
    Frame F;
    F.lds = (LAS unsigned char*)lds_raw;
    F.tid = threadIdx.x; F.lane = F.tid & 63; F.wave = __builtin_amdgcn_readfirstlane(F.tid >> 6); F.G = gridDim.x;
    F.in = args.in;
    F.out = args.out; F.ws = args.ws;
    unsigned char* ws = args.ws;
    F.PROJ = (bf16_t*)(ws + WS_PROJ); F.HALO = (bf16_t*)(ws + WS_HALO); F.SMALL = (float*)(ws + WS_SMALL); F.XN = (bf16_t*)(ws + WS_XN); F.PB = (bf16_t*)(ws + WS_PB);
    F.SS1 = (float*)(ws + WS_SS1); F.SS2 = (float*)(ws + WS_SS2); F.SS3 = (float*)(ws + WS_SS3);
    const int lo = args.ph_lo, hi = args.ph_hi;
#if MK_ONE_LAUNCH
    volatile LAS unsigned* MISC = (volatile LAS unsigned*)(F.lds + MISC_OFF);
    if (F.tid < 32) MISC[F.tid] = 0u;
    __syncthreads();
    XcdBarrier bar = xcd_barrier_post((unsigned*)(ws + WS_BAR), MISC + 8);
#define SEAM(k) do { if (lo <= (k) && (k) + 1 < hi) xcd_barrier(bar); } while (0)
#else
#define SEAM(k) do { } while (0)
#endif
#ifndef PHASE_MASK
#define PHASE_MASK 0xffff
#endif
#define IN(k) (((PHASE_MASK >> (k)) & 1) && lo <= (k) && (k) < hi)
#ifndef REP_PHASE
#define REP_PHASE -1
#endif
#define NREP(k) ((REP_PHASE == (k)) ? 2 : 1)
    const int bid = (int)blockIdx.x;
    typedef pg8::StaticOrder SO;

    if (IN(0)) { for (int rp = 0; rp < NREP(0); ++rp) { p0_prologue(F); if (rp + 1 < NREP(0)) xcd_barrier(bar); } SEAM(0); }
    if (IN(1)) {
        pg8::Gemm g{F.XN, (const bf16_t*)(ws + WS_WIN), MP, NPROJ, D, D, D}; SO S; S.init(MP, NPROJ, F.G, bid);
        EpiInProj E{F.PROJ, F.HALO, F.SMALL};
        for (int rp = 0; rp < NREP(1); ++rp) { pg8::gemm_phase<EpiInProj, SO>(F.lds, g, S, E); if (rp + 1 < NREP(1)) xcd_barrier(bar); } SEAM(1);
    }
    if (IN(2)) { p2_conv(F); SEAM(2); }
    if (IN(3)) { p3_scan(F); SEAM(3); }
    if (IN(4)) { p3b_scan(F); SEAM(4); }
    if (IN(5)) { p4_norm(F); SEAM(5); }
    if (IN(6)) {
        pg8::Gemm g{F.PROJ + C_XS, (const bf16_t*)(ws + WS_WBS), MPR, D, 2048, LDP, 2048}; SO S; S.init(MPR, D, F.G, bid);
        EpiT1 E{F.PROJ};
        for (int rp = 0; rp < NREP(6); ++rp) { pg8::gemm_phase<EpiT1, SO>(F.lds, g, S, E); if (rp + 1 < NREP(6)) xcd_barrier(bar); }
        small_gemm(F, F.PROJ + (size_t)MPR * LDP + C_XS, LDP, (const bf16_t*)(ws + WS_WBS), 2048, 2048, D, QT1{F.PROJ}); SEAM(6);
    }
    if (IN(7)) {
        pg8::Gemm g{F.PROJ + C_V, (const bf16_t*)(ws + WS_WBG), MPR, D, D, LDP, D}; SO S; S.init(MPR, D, F.G, bid);
        EpiMix E{F.PROJ};
        pg8::gemm_phase<EpiMix, SO>(F.lds, g, S, E);
        small_gemm(F, F.PROJ + (size_t)MPR * LDP + C_V, LDP, (const bf16_t*)(ws + WS_WBG), D, D, D, QMix{F.PROJ}); SEAM(7);
    }
    if (IN(8)) {
        pg8::Gemm g{F.PROJ + C_Q, (const bf16_t*)(ws + WS_WOUT), MPR, D, D, LDP, D}; SO S; S.init(MPR, D, F.G, bid);
        EpiResid<0> E{F.PROJ, F.in[0], F.in[1], 0, C_Z, C_K, F.SS1};
        pg8::gemm_phase<EpiResid<0>, SO>(F.lds, g, S, E);
        small_gemm(F, F.PROJ + (size_t)MPR * LDP + C_Q, LDP, (const bf16_t*)(ws + WS_WOUT), D, D, D, QResid<0>{F.PROJ, F.in[1], 0, C_Z, C_K, F.SS1}); SEAM(8);
    }
    if (IN(9)) {
        pg8::Gemm g{F.PROJ + C_K, (const bf16_t*)(ws + WS_WFI), MP, 2 * DFF, D, LDP, D}; SO S; S.init(MP, 2 * DFF, F.G, bid);
        EpiSwiGLU E{F.PROJ, F.SS1};
        for (int rp = 0; rp < NREP(9); ++rp) { pg8::gemm_phase<EpiSwiGLU, SO>(F.lds, g, S, E); if (rp + 1 < NREP(9)) xcd_barrier(bar); } SEAM(9);
    }
    if (IN(10)) {
        pg8::Gemm g{F.PROJ + C_XS, (const bf16_t*)(ws + WS_WFO), MPR, D, DFF, LDP, DFF}; SO S; S.init(MPR, D, F.G, bid);
        EpiResid<1> E{F.PROJ, nullptr, nullptr, C_Z, C_MG, C_GATE, F.SS2};
        pg8::gemm_phase<EpiResid<1>, SO>(F.lds, g, S, E);
        small_gemm(F, F.PROJ + (size_t)MPR * LDP + C_XS, LDP, (const bf16_t*)(ws + WS_WFO), DFF, DFF, D, QResid<1>{F.PROJ, nullptr, C_Z, C_MG, C_GATE, F.SS2}); SEAM(10);
    }
    if (IN(11)) {
        pg8::Gemm g{F.PB, (const bf16_t*)(ws + WS_WPP), MPR, D, 256, 256, 256}; SO S; S.init(MPR, D, F.G, bid);
        EpiPE E{F.PROJ};
        pg8::gemm_phase<EpiPE, SO>(F.lds, g, S, E);
        small_gemm(F, F.PB + (size_t)MPR * 256, 256, (const bf16_t*)(ws + WS_WPP), 256, 256, D, QPE{F.PROJ}); SEAM(11);
    }
    if (IN(12)) {
        pg8::Gemm g{F.PROJ + C_GATE, (const bf16_t*)(ws + WS_WPG), MPR, D, D, LDP, D}; SO S; S.init(MPR, D, F.G, bid);
        EpiX3 E{F.PROJ, F.SS2, F.SS3, F.out};
        pg8::gemm_phase<EpiX3, SO>(F.lds, g, S, E);
        small_gemm(F, F.PROJ + (size_t)MPR * LDP + C_GATE, LDP, (const bf16_t*)(ws + WS_WPG), D, D, D, QX3{F.PROJ, F.SS2, F.SS3, F.out}); SEAM(12);
    }
    if (IN(13)) { p12_final(F); }
#undef IN
#undef SEAM
}

constexpr int NPHASES = 14;

extern "C" void kernel_launch(void* const* d_in, const int* in_sizes, int n_in, void* d_out, int out_size, void* d_ws, size_t ws_size, hipStream_t stream) {
    static int grid = 0;
    if (grid == 0) {
        if (n_in != 30 || ws_size < WS_END) { fprintf(stderr, "kernel_launch: bad call: n_in %d ws %zu (need %zu)\n", n_in, ws_size, (size_t)WS_END); grid = -1; return; }
        int dev = 0, cus = 0, per_cu = 0;
        if (hipGetDevice(&dev) != hipSuccess || hipDeviceGetAttribute(&cus, hipDeviceAttributeMultiprocessorCount, dev) != hipSuccess) { grid = -1; return; }
        if (hipFuncSetAttribute((const void*)mega_fwd, hipFuncAttributeMaxDynamicSharedMemorySize, LDS_BYTES) != hipSuccess) { fprintf(stderr, "kernel_launch: hipFuncSetAttribute failed\n"); grid = -1; return; }
        if (hipOccupancyMaxActiveBlocksPerMultiprocessor(&per_cu, (const void*)mega_fwd, NWAVES * 64, LDS_BYTES) != hipSuccess || per_cu < 1) { fprintf(stderr, "kernel_launch: occupancy query says %d\n", per_cu); per_cu = 1; }
        (void)hipGetLastError();
        grid = cus;
    }
    if (grid < 0) return;
    (void)hipMemsetAsync((char*)d_ws + WS_CTL, 0, CTL_BYTES, stream);
    Args a{};
    for (int i = 0; i < 30; ++i) a.in[i] = (const float*)d_in[i];
    a.out = (float*)d_out; a.ws = (unsigned char*)d_ws;
#if MK_ONE_LAUNCH
    a.ph_lo = 0; a.ph_hi = NPHASES;
    void* kargs[] = {&a};
    hipError_t e = hipLaunchCooperativeKernel((const void*)mega_fwd, dim3(grid), dim3(NWAVES * 64), kargs, LDS_BYTES, stream);
    if (e != hipSuccess) fprintf(stderr, "cooperative launch failed: %s (grid %d)\n", hipGetErrorString(e), grid);
#else
    for (int ph = 0; ph < NPHASES; ++ph) {
        a.ph_lo = ph; a.ph_hi = ph + 1;
        hipLaunchKernelGGL(mega_fwd, dim3(grid), dim3(NWAVES * 64), LDS_BYTES, stream, a);
    }
#endif
}
```

```cpp
#include <hip/hip_runtime.h>
#include <hip/hip_cooperative_groups.h>
#include <cstdio>
#include <cstdint>
namespace cg = cooperative_groups;

#define PROBE_SCALE 1e-6f
#ifndef MK_ONE_LAUNCH
#define MK_ONE_LAUNCH 1
#endif

#define LAS __attribute__((address_space(3)))
typedef unsigned short bf16_t;
typedef short bf16x8 __attribute__((ext_vector_type(8)));
typedef float f32x4 __attribute__((ext_vector_type(4)));
typedef float f32x2 __attribute__((ext_vector_type(2)));
typedef unsigned u32x4 __attribute__((ext_vector_type(4)));
typedef unsigned u32x2 __attribute__((ext_vector_type(2)));

constexpr int D = 1024, SEQ = 2048, NBATCH = 8, MPR = NBATCH * SEQ, NSMP = 128, MTOT = MPR + NSMP, MP = 16640;
constexpr int LDP = 11264, LDF = LDP / 2;
constexpr int C_Z = 0, C_XS = 2048, C_B = 4096, C_C = 4608, C_Q = 5120, C_K = 6144, C_V = 7168, C_GATE = 8192, C_MG = 9216;
constexpr int NIN = 11312;
constexpr int NPROJ = 11520;
constexpr int DFF = 2816;
constexpr float EPS = 1e-6f;
constexpr int CONV_FUSE_LO = 8, CONV_FUSE_HI = 32;
constexpr int NCH = 6144;

constexpr size_t O_Y = 0, O_YS = 16777216, O_SSMP = 16908288, O_SCONVP = 19005440, O_GDNP = 19079168, O_GCONVP = 20127744,
                 O_SSMS = 20201472, O_SCONVS = 53755904, O_GDNS = 54935552, O_GCONVS = 71712768;

constexpr int RT_OFF = 132096;
constexpr size_t MiB = 1u << 20;
constexpr size_t WS_CTL = 502 * MiB, CTL_BYTES = 1 * MiB;
constexpr size_t WS_BAR = WS_CTL + 16384;
constexpr size_t WS_XCNT = WS_CTL + 32768, WS_XCNT2 = WS_CTL + 49152;
constexpr size_t WS_SS1 = WS_CTL + 65536, WS_SS2 = WS_SS1 + 69632, WS_SS3 = WS_SS2 + 69632;
constexpr size_t WS_WIN = 1 * MiB, WS_WBS = 25 * MiB, WS_WBG = 29 * MiB, WS_WOUT = 31 * MiB, WS_WFI = 33 * MiB, WS_WFO = 44 * MiB, WS_WPG = 50 * MiB, WS_WPP = 52 * MiB;
constexpr size_t WS_XN = 53 * MiB, WS_PB = 86 * MiB, WS_SMALL = 95 * MiB, WS_HALO = 100 * MiB, WS_PROJ = 110 * MiB;
constexpr size_t WS_END0 = WS_PROJ + (size_t)MP * LDP * 2;
constexpr size_t WS_WT = WS_XN, WS_QKM = WS_WIN, WS_UT = 468 * MiB, WS_GC = 500 * MiB;
constexpr size_t WS_SSY = 501 * MiB, WS_SSO = WS_SSY + 512 * 1024, SS2_BYTES = 1024 * 1024;
constexpr size_t WS_END = WS_CTL + CTL_BYTES;
static_assert(WS_SSY + SS2_BYTES == WS_CTL, "one memset region");
static_assert(WS_END0 <= WS_UT && WS_UT + 32 * MiB <= WS_GC, "ws map 2");
static_assert(WS_END <= 512 * MiB, "ws map");
static_assert(WS_SS3 + 69632 <= WS_CTL + CTL_BYTES, "ctl");

typedef __bf16 bf16x2_t __attribute__((ext_vector_type(2)));
__device__ __forceinline__ unsigned cvt_pk_bf16(float lo, float hi) { const f32x2 v = {lo, hi}; const bf16x2_t b = __builtin_convertvector(v, bf16x2_t); return __builtin_bit_cast(unsigned, b); }
__device__ __forceinline__ float bflo(unsigned w) { return __uint_as_float(w << 16); }
__device__ __forceinline__ float bfhi(unsigned w) { return __uint_as_float(w & 0xffff0000u); }
__device__ __forceinline__ float bf2f(bf16_t b) { return __uint_as_float((unsigned)b << 16); }
__device__ __forceinline__ void unpack8(const u32x4 w, float (&f)[8]) { f[0] = bflo(w.x); f[1] = bfhi(w.x); f[2] = bflo(w.y); f[3] = bfhi(w.y); f[4] = bflo(w.z); f[5] = bfhi(w.z); f[6] = bflo(w.w); f[7] = bfhi(w.w); }
__device__ __forceinline__ u32x4 pack8(const float (&f)[8]) { u32x4 w; w.x = cvt_pk_bf16(f[0], f[1]); w.y = cvt_pk_bf16(f[2], f[3]); w.z = cvt_pk_bf16(f[4], f[5]); w.w = cvt_pk_bf16(f[6], f[7]); return w; }
__device__ __forceinline__ float sigmoidf_(float x) { return __builtin_amdgcn_rcpf(1.0f + __builtin_amdgcn_exp2f(-1.4426950408889634f * x)); }
__device__ __forceinline__ float siluf_(float x) { return x * sigmoidf_(x); }
__device__ __forceinline__ float softplusf_(float x) { return x > 20.f ? x : log1pf(__expf(x)); }
template <int CTRL> __device__ __forceinline__ float dpp_mov(float v) { return __builtin_bit_cast(float, __builtin_amdgcn_update_dpp(0, __builtin_bit_cast(int, v), CTRL, 0xF, 0xF, true)); }
template <int J> __device__ __forceinline__ float dpp_prev(float x, float pv) {
    int t = __builtin_amdgcn_update_dpp(0, __builtin_bit_cast(int, pv), 0x120 + J, 0xF, 0xF, true);
    t = __builtin_amdgcn_update_dpp(t, __builtin_bit_cast(int, x), 0x110 + J, 0xF, 0xF, false);
    return __builtin_bit_cast(float, t);
}
__device__ __forceinline__ float row16_sum(float v) {
    v += dpp_mov<0xB1>(v);
    v += dpp_mov<0x4E>(v);
    v += dpp_mov<0x124>(v);
    v += dpp_mov<0x128>(v);
    return v;
}
__device__ __forceinline__ float wave_sum(float v) {
#pragma unroll
    for (int o = 1; o < 64; o <<= 1) v += __shfl_xor(v, o);
    return v;
}

namespace pg8 {
constexpr int BM = 256, BK = 64, HALF = 128, HTB = HALF * BK * 2, STAGE_BYTES = 8 * HTB, NXCD = 8, WGM = 8;
__host__ __device__ __forceinline__ int lds_byte(int r, int c) { const int st = (r >> 4) * 2 + (c >> 5), rr = r & 15, cc = c & 31, ob = rr * 64 + cc * 2; return st * 1024 + (ob ^ (((ob >> 9) & 1) << 5)); }
__host__ __device__ __forceinline__ void stage_rc(int b, int& R, int& C) { const int st = b / 1024, sb = b % 1024, swz = sb ^ (((sb >> 9) & 1) << 5); R = (st >> 1) * 16 + swz / 64; C = (st & 1) * 32 + (swz % 64) / 2; }
__host__ __device__ __forceinline__ int perm32(int rho) { const int n = rho >> 4, i = rho & 15; return 8 * (i >> 2) + 4 * n + (i & 3); }

struct Unit { int pm, pn; };
struct Gemm { const bf16_t* A; const bf16_t* Bt; int M, N, K, lda, ldb; };

struct StaticOrder {
    int nM, nN, nwg, G, c;
    __host__ __device__ __forceinline__ void init(int M, int N, int G_, int c_) { nM = M / BM; nN = N / BM; nwg = nM * nN; G = G_; c = c_; }
    __host__ __device__ __forceinline__ bool next(int i, Unit& u) const {
        const long L = (long)i * G + c; if (L >= nwg) return false;
        int wgid = (int)L; { const int q = nwg / NXCD, r = nwg % NXCD, xcd = wgid % NXCD, off = wgid / NXCD; wgid = (xcd < r ? xcd * (q + 1) : r * (q + 1) + (xcd - r) * q) + off; }
        const int nig = WGM * nN, gid = wgid / nig, fm = gid * WGM, gsz = (nM - fm) < WGM ? (nM - fm) : WGM;
        u.pm = fm + ((wgid % nig) % gsz); u.pn = (wgid % nig) / gsz; return true;
    }
    __device__ __forceinline__ void a_ready(const Unit&) const {}
    __device__ __forceinline__ void done(const Unit&) const {}
};

template <class Epi, class Sched, bool ALIGN_EPI = true, bool SP2 = true>
__device__ __forceinline__ void gemm_phase(LAS unsigned char* lds, const Gemm g, const Sched& S, const Epi& E) {
    const int tid = threadIdx.x, wid = __builtin_amdgcn_readfirstlane(tid >> 6), lane = tid & 63, wr = wid >> 2, wc = wid & 3, fr = lane & 15, fq = lane >> 4;
    int nt = g.K / BK / Epi::NSEG; asm volatile("" : "+s"(nt));
    unsigned voffA, voffB;
    { int R, C; stage_rc(tid * 16, R, C); const int Rb = Epi::PERM ? ((R & ~31) + perm32(R & 31)) : R;
      voffA = (unsigned)(R * g.lda + C) * 2u; voffB = (unsigned)(Rb * g.ldb + C) * 2u; }
    const size_t s64A = (size_t)64 * g.lda * 2, s64B = (size_t)64 * g.ldb * 2;
    const size_t kstep = (size_t)(BK * 2);
    const size_t hstepA = (size_t)HALF * g.lda * 2, hstepB = (size_t)HALF * g.ldb * 2;
    const size_t tstepA = 2 * hstepA, tstepB = 2 * hstepB;
    const unsigned ldsw = (unsigned)wid * 1024u;
    const int aoff = lds_byte(wr * 64 + fr, fq * 8), boff = lds_byte(wc * 32 + fr, fq * 8);
#define PG8_SA(b, h) (((b) * 2 + (h)) * HTB)
#define PG8_SB(b, h) ((4 + (b) * 2 + (h)) * HTB)
#define PG8_STAGE(bufoff, gbase, voff) do { _Pragma("unroll") for (int _i = 0; _i < 2; ++_i) \
        __builtin_amdgcn_global_load_lds((const unsigned*)((const char*)(gbase) + (size_t)_i * (voff##_s64) + (voff)), (LAS unsigned*)(lds + (bufoff) + ldsw + _i * 8192), 16, 0, 0); } while (0)
#define voffA_s64 s64A
#define voffB_s64 s64B
#define PG8_LDA(dst, b, h) do { _Pragma("unroll") for (int m = 0; m < 4; ++m) _Pragma("unroll") for (int k = 0; k < 2; ++k) dst[m][k] = *(const LAS bf16x8*)(lds + PG8_SA(b, h) + aoff + m * 2048 + k * 1024); } while (0)
#define PG8_LDB(dst, b, h) do { _Pragma("unroll") for (int n = 0; n < 2; ++n) _Pragma("unroll") for (int k = 0; k < 2; ++k) dst[n][k] = *(const LAS bf16x8*)(lds + PG8_SB(b, h) + boff + n * 2048 + k * 1024); } while (0)
#define PG8_MMA(ai, bj, At, Bt) do { __builtin_amdgcn_s_setprio(1); _Pragma("unroll") for (int m = 0; m < 4; ++m) _Pragma("unroll") for (int n = 0; n < 2; ++n) _Pragma("unroll") for (int k = 0; k < 2; ++k) \
        acc[ai][bj][m][n] = __builtin_amdgcn_mfma_f32_16x16x32_bf16(Bt[n][k], At[m][k], acc[ai][bj][m][n], 0, 0, 0); __builtin_amdgcn_s_setprio(0); } while (0)
#define PG8_WAIT_V(n) asm volatile("s_waitcnt vmcnt(" #n ")" ::: "memory")
#define PG8_WAIT_L(n) asm volatile("s_waitcnt lgkmcnt(" #n ")" ::: "memory")
#define PG8_BAR __builtin_amdgcn_s_barrier()
#define PG8_SCHED __builtin_amdgcn_sched_barrier(0)
    Unit cur, nxt; int ui = 0;
    if (!S.next(0, cur)) return;
    f32x4 acc[2][2][4][2];
#pragma unroll
    for (int a = 0; a < 2; ++a)
#pragma unroll
        for (int b = 0; b < 2; ++b)
#pragma unroll
            for (int m = 0; m < 4; ++m)
#pragma unroll
                for (int n = 0; n < 2; ++n) acc[a][b][m][n] = (f32x4){0.f, 0.f, 0.f, 0.f};
    bf16x8 At[4][2], B0[2][2], B1[2][2];
    const char* cA = (const char*)g.A + (size_t)cur.pm * tstepA; const char* cB = (const char*)g.Bt + (size_t)cur.pn * tstepB;
    S.a_ready(cur);
    if constexpr (SP2) {
        PG8_STAGE(PG8_SB(0, 0), cB, voffB); PG8_STAGE(PG8_SB(0, 1), cB + hstepB, voffB); PG8_STAGE(PG8_SA(0, 0), cA, voffA); PG8_STAGE(PG8_SA(0, 1), cA + hstepA, voffA);
        if (wr == 1) PG8_BAR;
        PG8_WAIT_V(2); PG8_BAR;
        PG8_STAGE(PG8_SB(1, 0), cB + kstep, voffB); PG8_STAGE(PG8_SA(1, 0), cA + kstep, voffA); PG8_STAGE(PG8_SB(1, 1), cB + hstepB + kstep, voffB);
        PG8_WAIT_V(6); PG8_BAR;
    } else {
        PG8_STAGE(PG8_SB(0, 0), cB, voffB); PG8_STAGE(PG8_SA(0, 0), cA, voffA); PG8_STAGE(PG8_SB(0, 1), cB + hstepB, voffB); PG8_STAGE(PG8_SA(0, 1), cA + hstepA, voffA);
        if (wr == 1) PG8_BAR;
        PG8_WAIT_V(4); PG8_BAR;
        PG8_STAGE(PG8_SB(1, 0), cB + kstep, voffB); PG8_STAGE(PG8_SA(1, 0), cA + kstep, voffA); PG8_STAGE(PG8_SB(1, 1), cB + hstepB + kstep, voffB);
        PG8_WAIT_V(6); PG8_BAR;
    }
    for (;;) {
        const bool has_next = S.next(ui + 1, nxt);
        const char* uA = has_next ? (const char*)g.A + (size_t)nxt.pm * tstepA : cA; const char* uB = has_next ? (const char*)g.Bt + (size_t)nxt.pn * tstepB : cB;
        const char* sA = cA; const char* sB = cB;
#pragma unroll
        for (int part = 0; part < Epi::NPART; ++part) {
        const int seg0 = part == 0 ? 0 : Epi::SPLIT, seg1 = part == Epi::NPART - 1 ? Epi::NSEG : Epi::SPLIT;
#pragma nounroll
        for (int seg = seg0; seg < seg1; ++seg) {
        const bool lastseg = (seg == Epi::NSEG - 1);
        int ntc = nt; if constexpr (Epi::NSEG == 12) ntc = seg < 4 ? 8 : 2;
        const char* nA = lastseg ? uA : sA + (size_t)ntc * kstep; const char* nB = lastseg ? uB : sB + (size_t)ntc * kstep;
        for (int t = 0; t < ntc; t += 2) {
            const bool last = (t == ntc - 2);
            const char* a1 = sA + (size_t)(t + 1) * kstep;
            const char* a2 = last ? nA : sA + (size_t)(t + 2) * kstep; const char* b2 = last ? nB : sB + (size_t)(t + 2) * kstep;
            const char* a3 = a2 + kstep; const char* b3 = b2 + kstep;
            if (last && lastseg && has_next) S.a_ready(nxt);
            if constexpr (SP2) {
            PG8_LDB(B0, 0, 0); PG8_LDB(B1, 0, 1); PG8_SCHED; PG8_LDA(At, 0, 0); PG8_STAGE(PG8_SA(1, 1), a1 + hstepA, voffA);
            PG8_WAIT_V(8); PG8_WAIT_L(0); PG8_BAR; PG8_MMA(0, 0, At, B0); PG8_MMA(0, 1, At, B1); PG8_BAR; PG8_SCHED;
            PG8_LDA(At, 0, 1); PG8_STAGE(PG8_SB(0, 0), b2, voffB); PG8_STAGE(PG8_SB(0, 1), b2 + hstepB, voffB); PG8_STAGE(PG8_SA(0, 0), a2, voffA);
            PG8_WAIT_V(8); PG8_WAIT_L(0); PG8_BAR; PG8_MMA(1, 0, At, B0); PG8_MMA(1, 1, At, B1); PG8_BAR; PG8_SCHED;
            PG8_LDB(B0, 1, 0); PG8_LDB(B1, 1, 1); PG8_SCHED; PG8_LDA(At, 1, 0); PG8_STAGE(PG8_SA(0, 1), a2 + hstepA, voffA);
            PG8_WAIT_V(8); PG8_WAIT_L(0); PG8_BAR; PG8_MMA(0, 0, At, B0); PG8_MMA(0, 1, At, B1); PG8_BAR; PG8_SCHED;
            PG8_LDA(At, 1, 1); PG8_STAGE(PG8_SB(1, 0), b3, voffB); PG8_STAGE(PG8_SB(1, 1), b3 + hstepB, voffB); PG8_STAGE(PG8_SA(1, 0), a3, voffA);
            PG8_WAIT_V(8); PG8_WAIT_L(0); PG8_BAR; PG8_MMA(1, 0, At, B0); PG8_MMA(1, 1, At, B1); PG8_BAR; PG8_SCHED;
            } else {
            PG8_LDB(B0, 0, 0); PG8_SCHED; PG8_LDA(At, 0, 0); PG8_STAGE(PG8_SA(1, 1), a1 + hstepA, voffA);
            PG8_WAIT_L(8); PG8_BAR; PG8_WAIT_L(0); PG8_MMA(0, 0, At, B0); PG8_BAR; PG8_SCHED;
            PG8_LDB(B1, 0, 1); PG8_STAGE(PG8_SB(0, 0), b2, voffB);
            PG8_BAR; PG8_WAIT_L(0); PG8_MMA(0, 1, At, B1); PG8_BAR;
            PG8_LDA(At, 0, 1); PG8_STAGE(PG8_SA(0, 0), a2, voffA);
            PG8_BAR; PG8_WAIT_L(0); PG8_MMA(1, 0, At, B0); PG8_BAR; PG8_SCHED;
            PG8_STAGE(PG8_SB(0, 1), b2 + hstepB, voffB);
            PG8_WAIT_V(6); PG8_BAR; PG8_MMA(1, 1, At, B1); PG8_BAR;
            PG8_LDB(B0, 1, 0); PG8_SCHED; PG8_LDA(At, 1, 0); PG8_STAGE(PG8_SA(0, 1), a2 + hstepA, voffA);
            PG8_WAIT_L(8); PG8_BAR; PG8_WAIT_L(0); PG8_MMA(0, 0, At, B0); PG8_BAR; PG8_SCHED;
            PG8_LDB(B1, 1, 1); PG8_STAGE(PG8_SB(1, 0), b3, voffB);
            PG8_BAR; PG8_WAIT_L(0); PG8_MMA(0, 1, At, B1); PG8_BAR;
            PG8_LDA(At, 1, 1); PG8_STAGE(PG8_SA(1, 0), a3, voffA);
            PG8_BAR; PG8_WAIT_L(0); PG8_MMA(1, 0, At, B0); PG8_BAR; PG8_SCHED;
            PG8_STAGE(PG8_SB(1, 1), b3 + hstepB, voffB);
            PG8_WAIT_V(6); PG8_BAR; PG8_MMA(1, 1, At, B1); PG8_BAR;
            }
        }
        if constexpr (Epi::NSEG > 1) { if (!lastseg) { if (seg != seg1 - 1) E.khook(acc, seg, cur, wr, wc, fr, fq, (LAS const float*)(lds + RT_OFF)); sA = nA; sB = nB; } }
        }
        if constexpr (Epi::NPART > 1) { if (part + 1 < Epi::NPART) { __builtin_amdgcn_sched_barrier(0); E.parthook(acc, cur, wr, wc, fr, fq, (LAS const float*)(lds + RT_OFF)); __builtin_amdgcn_sched_barrier(0); } }
        }
        if constexpr (ALIGN_EPI) { if (wr == 0) PG8_BAR; }
        E(acc, cur, wr, wc, fr, fq); S.done(cur);
        if (!has_next) break;
#pragma unroll
        for (int a = 0; a < 2; ++a)
#pragma unroll
            for (int b = 0; b < 2; ++b)
#pragma unroll
                for (int m = 0; m < 4; ++m)
#pragma unroll
                    for (int n = 0; n < 2; ++n) acc[a][b][m][n] = (f32x4){0.f, 0.f, 0.f, 0.f};
        cur = nxt; cA = uA; cB = uB; ++ui;
        if constexpr (ALIGN_EPI) { if (wr == 1) PG8_BAR; }
    }
    PG8_WAIT_V(0);
    if constexpr (!ALIGN_EPI) { if (wr == 0) PG8_BAR; }
    PG8_BAR;
#undef PG8_SA
#undef PG8_SB
#undef PG8_STAGE
#undef voffA_s64
#undef voffB_s64
#undef PG8_LDA
#undef PG8_LDB
#undef PG8_MMA
#undef PG8_WAIT_V
#undef PG8_WAIT_L
#undef PG8_BAR
#undef PG8_SCHED
}
}
using pg8::Unit;


#define XB_TMO      128
#define XB_XCNT(j)  (256  + 64 * (j))
#define XB_XSUB(j)  (1280 + 64 * (j))
#define XB_XGEN(j)  (2304 + 64 * (j))
#define XB_TOP      3328
#define XB_TOPGEN   3392
#define XCD_BAR_WORDS 3456
#define XB_SPIN_CAP (1u << 22)
__device__ __forceinline__ unsigned xb_ld(unsigned* p)              { return __hip_atomic_load(p, __ATOMIC_RELAXED, __HIP_MEMORY_SCOPE_AGENT); }
__device__ __forceinline__ unsigned xb_add(unsigned* p, unsigned v) { return __hip_atomic_fetch_add(p, v, __ATOMIC_RELAXED, __HIP_MEMORY_SCOPE_AGENT); }
__device__ __forceinline__ unsigned xb_xcc_id() { return (unsigned)__builtin_amdgcn_s_getreg((3 << 11) | 20) & 0xFu; }
#define XB_SPIN(cond, bar) do { unsigned _sp = 0; while (cond) { __builtin_amdgcn_s_sleep(1); \
    if ((++_sp & 255u) == 0u) { if (xb_ld(&(bar)[XB_TMO])) break; if (_sp > XB_SPIN_CAP) { atomicAdd(&(bar)[XB_TMO], 1u); break; } } } } while (0)
struct XcdBarrier { unsigned* bar; unsigned x; volatile LAS unsigned* st; };
__device__ __forceinline__ XcdBarrier xcd_barrier_post(unsigned* bar, volatile LAS unsigned* st) {
    XcdBarrier b; b.bar = bar; b.x = xb_xcc_id(); b.st = st;
    if (threadIdx.x == 0) (void)xb_add(&bar[XB_XCNT(b.x)], 1u);
    return b;
}
__device__ __forceinline__ void xcd_barrier_complete(unsigned* bar, unsigned x, unsigned& nloc, unsigned& nx) {
    const unsigned G = gridDim.x * gridDim.y * gridDim.z;
    unsigned sum, cnt, mine, sp = 0u;
    for (;;) {
        sum = 0u; cnt = 0u; mine = 0u;
#pragma unroll
        for (unsigned j = 0; j < 16; ++j) { const unsigned c = xb_ld(&bar[XB_XCNT(j)]); sum += c; cnt += (c > 0u) ? 1u : 0u; mine = (j == x) ? c : mine; }
        if (sum == G) break;
        __builtin_amdgcn_s_sleep(1);
        if ((++sp & 255u) == 0u) { if (xb_ld(&bar[XB_TMO])) break; if (sp > XB_SPIN_CAP) { atomicAdd(&bar[XB_TMO], 1u); break; } }
    }
    nloc = mine > 0u ? mine : 1u; nx = cnt > 0u ? cnt : 1u;
}
__device__ __forceinline__ void xcd_barrier(const XcdBarrier& b) {
    asm volatile("s_waitcnt vmcnt(0)" ::: "memory");
    __syncthreads();
    if (threadIdx.x == 0) {
        unsigned* bar = b.bar;
        __builtin_amdgcn_s_waitcnt(0);
        unsigned nloc = b.st[0], nx = b.st[1];
        if (nloc == 0u) { xcd_barrier_complete(bar, b.x, nloc, nx); b.st[0] = nloc; b.st[1] = nx; }
        const unsigned old = xb_add(&bar[XB_XSUB(b.x)], 1u);
        const unsigned gen = old / nloc;
        if (old + 1u == (gen + 1u) * nloc) {
            __builtin_amdgcn_fence(__ATOMIC_RELEASE, "agent");
            asm volatile("s_waitcnt vmcnt(0)" ::: "memory");
            const unsigned og = xb_add(&bar[XB_TOP], 1u);
            const unsigned tg = og / nx;
            if (og + 1u == (tg + 1u) * nx) xb_add(&bar[XB_TOPGEN], 1u);
            else XB_SPIN(xb_ld(&bar[XB_TOPGEN]) == tg, bar);
            __builtin_amdgcn_fence(__ATOMIC_ACQUIRE, "agent");
            xb_add(&bar[XB_XGEN(b.x)], 1u);
            asm volatile("s_waitcnt vmcnt(0)" ::: "memory");
        } else {
            XB_SPIN(xb_ld(&bar[XB_XGEN(b.x)]) == gen, bar);
            __builtin_amdgcn_fence(__ATOMIC_ACQUIRE, "agent");
            asm volatile("s_waitcnt vmcnt(0)" ::: "memory");
        }
    }
    __syncthreads();
}

struct Args {
    const float* in[30];
    float* out;
    unsigned char* ws;
    int ph_lo, ph_hi;
};

struct Frame {
    LAS unsigned char* lds;
    int tid, lane, wave, G;
    const float* const* in;
    float* out;
    unsigned char* ws;
    __device__ __forceinline__ bf16_t* PROJ() const { return (bf16_t*)(ws + WS_PROJ); }
    __device__ __forceinline__ bf16_t* HALO() const { return (bf16_t*)(ws + WS_HALO); }
    __device__ __forceinline__ float* SMALL() const { return (float*)(ws + WS_SMALL); }
    __device__ __forceinline__ bf16_t* XN() const { return (bf16_t*)(ws + WS_XN); }
    __device__ __forceinline__ bf16_t* PB() const { return (bf16_t*)(ws + WS_PB); }
    __device__ __forceinline__ float* SS1() const { return (float*)(ws + WS_SS1); }
    __device__ __forceinline__ float* SS2() const { return (float*)(ws + WS_SS2); }
    __device__ __forceinline__ float* SS3() const { return (float*)(ws + WS_SS3); }
};

constexpr int NWAVES = 8;
constexpr int RING_BYTES = 131072, LDS_BYTES = 162816, MISC_OFF = LDS_BYTES - 1024;

struct EpiInProj {
    static constexpr bool PERM = true; static constexpr int NSEG = 1; static constexpr int NPART = 1, SPLIT = 0;
    bf16_t* PROJ; bf16_t* HALO; float* SMALL; const float* cws; const float* cbs; const float* cwg; LAS float* nt_;
    __device__ __forceinline__ void operator()(const f32x4 (&acc)[2][2][4][2], const Unit& u, int wr, int wc, int fr, int fq) const {
        const int row0 = u.pm * 256 + wr * 64 + fr;
        if (u.pn >= CONV_FUSE_LO && u.pn < CONV_FUSE_HI && u.pm < MPR / 256) {
            f32x4 (&av)[2][2][4][2] = const_cast<f32x4 (&)[2][2][4][2]>(acc);
            const bool is_ssm = u.pn < 20, nrm = u.pn >= 20 && u.pn < 28;
            const int col0 = u.pn * 256 + wc * 32 + 8 * fq, cc0 = col0 - C_XS, wc0 = is_ssm ? cc0 : cc0 - 3072;
            const float* cw = is_ssm ? cws : cwg;
#pragma unroll
            for (int bj = 0; bj < 2; ++bj) {
                float w0[8], w1[8], w2[8], w3[8], bs[8];
                { const float* wp = cw + wc0 + bj * 128;
#pragma unroll
                  for (int h = 0; h < 2; ++h) { const f32x4 a0 = *(const f32x4*)(wp + 4 * h), a1 = *(const f32x4*)(wp + 3072 + 4 * h), a2 = *(const f32x4*)(wp + 2 * 3072 + 4 * h), a3 = *(const f32x4*)(wp + 3 * 3072 + 4 * h);
                      f32x4 bb = (f32x4){0.f, 0.f, 0.f, 0.f}; if (is_ssm) bb = *(const f32x4*)(cbs + wc0 + bj * 128 + 4 * h);
#pragma unroll
                      for (int i = 0; i < 4; ++i) { w0[4 * h + i] = a0[i]; w1[4 * h + i] = a1[i]; w2[4 * h + i] = a2[i]; w3[4 * h + i] = a3[i]; bs[4 * h + i] = bb[i]; } } }
#pragma unroll
                for (int ai = 0; ai < 2; ++ai)
#pragma unroll
                    for (int mm = 0; mm < 4; ++mm) {
                        const int m = 3 - mm, mp = m > 0 ? m - 1 : 0;
                        const int row = row0 + ai * 128 + m * 16;
                        if (m == 3) {
                            const f32x4 v0 = av[ai][bj][3][0], v1 = av[ai][bj][3][1];
                            u32x4 w; w.x = cvt_pk_bf16(v0[0], v0[1]); w.y = cvt_pk_bf16(v0[2], v0[3]); w.z = cvt_pk_bf16(v1[0], v1[1]); w.w = cvt_pk_bf16(v1[2], v1[3]);
                            if (fr >= 13) *(u32x4*)(HALO + ((size_t)(row >> 6) * 3 + (fr - 13)) * NCH + cc0 + bj * 128) = w;
                        }
                        float o[8], ss = 0.f;
#pragma unroll
                        for (int e = 0; e < 8; ++e) {
                            const float x = av[ai][bj][m][e >> 2][e & 3], pv = av[ai][bj][mp][e >> 2][e & 3];
                            const float t1 = dpp_prev<1>(x, pv), t2 = dpp_prev<2>(x, pv), t3 = dpp_prev<3>(x, pv);
                            float v = w3[e] * x + bs[e]; v += w2[e] * t1; v += w1[e] * t2; v += w0[e] * t3;
                            v = siluf_(v); ss += v * v;
                            o[e] = (m == 0 && fr < 3) ? x : v;
                        }
                        if (nrm) {
                            av[ai][bj][m][0] = (f32x4){o[0], o[1], o[2], o[3]}; av[ai][bj][m][1] = (f32x4){o[4], o[5], o[6], o[7]};
                            ss += __shfl_xor(ss, 16); ss += __shfl_xor(ss, 32);
                            if (fq == 0) nt_[((ai * 128 + wr * 64 + m * 16 + fr) * 2 + bj) * 4 + wc] = ss;
                        } else __builtin_nontemporal_store(pack8(o), (u32x4*)(PROJ + (size_t)row * LDP + col0 + bj * 128));
                    }
            }
            if (nrm) {
                asm volatile("s_waitcnt lgkmcnt(0)" ::: "memory"); __builtin_amdgcn_s_barrier(); asm volatile("" ::: "memory");
                const float qs = u.pn < 24 ? 0.08838834764831845f : 1.0f;
#pragma unroll
                for (int ai = 0; ai < 2; ++ai)
#pragma unroll
                    for (int m = 0; m < 4; ++m) {
                        const int rl = ai * 128 + wr * 64 + m * 16 + fr;
#pragma unroll
                        for (int bj = 0; bj < 2; ++bj) {
                            const f32x4 pq = *(LAS const f32x4*)(nt_ + (rl * 2 + bj) * 4);
                            float rn = rsqrtf((pq[0] + pq[1]) + (pq[2] + pq[3]) + EPS) * qs;
                            if (m == 0 && fr < 3) rn = 1.0f;
                            const f32x4 v0 = av[ai][bj][m][0] * rn, v1 = av[ai][bj][m][1] * rn;
                            u32x4 w; w.x = cvt_pk_bf16(v0[0], v0[1]); w.y = cvt_pk_bf16(v0[2], v0[3]); w.z = cvt_pk_bf16(v1[0], v1[1]); w.w = cvt_pk_bf16(v1[2], v1[3]);
                            __builtin_nontemporal_store(w, (u32x4*)(PROJ + (size_t)(u.pm * 256 + rl) * LDP + col0 + bj * 128));
                        }
                    }
            }
        } else if (u.pn < 44) {
            const int col0 = u.pn * 256 + wc * 32 + 8 * fq;
            const bool conv_tile = (u.pn >= 8 && u.pn < 32);
#pragma unroll
            for (int ai = 0; ai < 2; ++ai)
#pragma unroll
                for (int m = 0; m < 4; ++m) {
                    const int row = row0 + ai * 128 + m * 16;
                    bf16_t* rowp = PROJ + (size_t)row * LDP + col0;
#pragma unroll
                    for (int bj = 0; bj < 2; ++bj) {
                        const f32x4 v0 = acc[ai][bj][m][0], v1 = acc[ai][bj][m][1];
                        u32x4 w; w.x = cvt_pk_bf16(v0[0], v0[1]); w.y = cvt_pk_bf16(v0[2], v0[3]); w.z = cvt_pk_bf16(v1[0], v1[1]); w.w = cvt_pk_bf16(v1[2], v1[3]);
                        __builtin_nontemporal_store(w, (u32x4*)(rowp + bj * 128));
                        if (m == 3 && conv_tile && fr >= 13) {
                            bf16_t* hp = HALO + ((size_t)(row >> 6) * 3 + (fr - 13)) * NCH + (col0 - C_XS) + bj * 128;
                            *(u32x4*)hp = w;
                        }
                    }
                }
        } else {
            if (wc < 2) {
                const int col0 = wc * 32 + 8 * fq;
#pragma unroll
                for (int ai = 0; ai < 2; ++ai)
#pragma unroll
                    for (int m = 0; m < 4; ++m) {
                        const int row = row0 + ai * 128 + m * 16;
                        float* sp = SMALL + (size_t)row * 64 + col0;
                        *(f32x4*)sp = acc[ai][0][m][0]; *(f32x4*)(sp + 4) = acc[ai][0][m][1];
                    }
            }
        }
    }
};

struct EpiT1 {
    static constexpr bool PERM = true; static constexpr int NSEG = 4; static constexpr int NPART = 1, SPLIT = 0;
    bf16_t* PROJ; LAS const float* rl;
    __device__ __forceinline__ void khook(f32x4 (&acc)[2][2][4][2], int b, int wr, int fr, LAS const float* rt) const {
#pragma unroll
        for (int ai = 0; ai < 2; ++ai)
#pragma unroll
            for (int m = 0; m < 4; ++m) { const float rr = rt[b * 256 + ai * 128 + wr * 64 + m * 16 + fr];
#pragma unroll
                for (int bj = 0; bj < 2; ++bj) { acc[ai][bj][m][0] *= rr; acc[ai][bj][m][1] *= rr; } }
    }
    __device__ __forceinline__ void operator()(const f32x4 (&acc)[2][2][4][2], const Unit& u, int wr, int wc, int fr, int fq) const {
        const int row0 = u.pm * 256 + wr * 64 + fr, col0 = u.pn * 256 + wc * 32 + 8 * fq;
#pragma unroll
        for (int ai = 0; ai < 2; ++ai)
#pragma unroll
            for (int m = 0; m < 4; ++m) {
                const int row = row0 + ai * 128 + m * 16;
                const float rlast = rl[ai * 128 + wr * 64 + m * 16 + fr];
#pragma unroll
                for (int bj = 0; bj < 2; ++bj) {
                    const int col = col0 + bj * 128;
                    const u32x4 mgw = *(const u32x4*)(PROJ + (size_t)row * LDP + C_MG + col);
                    float mg[8]; unpack8(mgw, mg);
                    const f32x4 v0 = acc[ai][bj][m][0], v1 = acc[ai][bj][m][1];
                    float o[8];
#pragma unroll
                    for (int i = 0; i < 4; ++i) { o[i] = v0[i] * rlast * sigmoidf_(mg[i]); o[4 + i] = v1[i] * rlast * sigmoidf_(mg[4 + i]); }
                    *(u32x4*)(PROJ + (size_t)row * LDP + C_Z + col) = pack8(o);
                }
            }
    }
};

struct EpiMix {
    static constexpr bool PERM = true; static constexpr int NSEG = 8; static constexpr int NPART = 1, SPLIT = 0;
    bf16_t* PROJ; LAS const float* rl;
    __device__ __forceinline__ void khook(f32x4 (&acc)[2][2][4][2], int b, int wr, int fr, LAS const float* rt) const {
#pragma unroll
        for (int ai = 0; ai < 2; ++ai)
#pragma unroll
            for (int m = 0; m < 4; ++m) { const float rr = rt[b * 256 + ai * 128 + wr * 64 + m * 16 + fr];
#pragma unroll
                for (int bj = 0; bj < 2; ++bj) { acc[ai][bj][m][0] *= rr; acc[ai][bj][m][1] *= rr; } }
    }
    __device__ __forceinline__ void operator()(const f32x4 (&acc)[2][2][4][2], const Unit& u, int wr, int wc, int fr, int fq) const {
        const int row0 = u.pm * 256 + wr * 64 + fr, col0 = u.pn * 256 + wc * 32 + 8 * fq;
#pragma unroll
        for (int ai = 0; ai < 2; ++ai)
#pragma unroll
            for (int m = 0; m < 4; ++m) {
                const int row = row0 + ai * 128 + m * 16;
                const float rlast = rl[ai * 128 + wr * 64 + m * 16 + fr];
#pragma unroll
                for (int bj = 0; bj < 2; ++bj) {
                    const int col = col0 + bj * 128;
                    const u32x4 mgw = *(const u32x4*)(PROJ + (size_t)row * LDP + C_MG + 1024 + col);
                    float mg[8]; unpack8(mgw, mg);
                    float t1v[8]; unpack8(*(const u32x4*)(PROJ + (size_t)row * LDP + C_Z + col), t1v);
                    const f32x4 v0 = acc[ai][bj][m][0], v1 = acc[ai][bj][m][1];
                    float o[8];
#pragma unroll
                    for (int i = 0; i < 4; ++i) { o[i] = t1v[i] + v0[i] * rlast * sigmoidf_(mg[i]); o[4 + i] = t1v[4 + i] + v1[i] * rlast * sigmoidf_(mg[4 + i]); }
                    *(u32x4*)(PROJ + (size_t)row * LDP + C_Q + col) = pack8(o);
                }
            }
    }
};

struct EpiMixCat {
    static constexpr bool PERM = true; static constexpr int NSEG = 12; static constexpr int NPART = 2, SPLIT = 4;
    bf16_t* PROJ; LAS const float* rl;
    __device__ __forceinline__ void khook(f32x4 (&acc)[2][2][4][2], int seg, const Unit&, int wr, int, int fr, int, LAS const float* rt) const {
#pragma unroll
        for (int ai = 0; ai < 2; ++ai)
#pragma unroll
            for (int m = 0; m < 4; ++m) { const float rr = rt[seg * 256 + ai * 128 + wr * 64 + m * 16 + fr];
#pragma unroll
                for (int bj = 0; bj < 2; ++bj) { acc[ai][bj][m][0] *= rr; acc[ai][bj][m][1] *= rr; } }
    }
    __device__ __forceinline__ void parthook(f32x4 (&acc)[2][2][4][2], const Unit& u, int wr, int wc, int fr, int fq, LAS const float* rt) const {
        const int row0 = u.pm * 256 + wr * 64 + fr, col0 = u.pn * 256 + wc * 32 + 8 * fq;
#pragma unroll
        for (int ai = 0; ai < 2; ++ai) {
            int rowa = row0 + ai * 128; asm volatile("" : "+v"(rowa));
            u32x4 w1[4][2], w2[4][2];
#pragma unroll
            for (int m = 0; m < 4; ++m)
#pragma unroll
                for (int bj = 0; bj < 2; ++bj) {
                    const unsigned goff = (unsigned)(rowa + m * 16) * (unsigned)(LDP * 2) + (unsigned)(C_MG + col0 + bj * 128) * 2u;
                    w1[m][bj] = *(const u32x4*)((const char*)PROJ + goff); w2[m][bj] = *(const u32x4*)((const char*)PROJ + goff + 2048);
                }
            __builtin_amdgcn_sched_barrier(0);
#pragma unroll
            for (int m = 0; m < 4; ++m) {
                const float rr = rt[3 * 256 + ai * 128 + wr * 64 + m * 16 + fr];
#pragma unroll
                for (int bj = 0; bj < 2; ++bj) {
#pragma unroll
                    for (int q = 0; q < 4; ++q) {
                        const float flo = rr * (1.0f + __builtin_amdgcn_exp2f(-1.4426950408889634f * bflo(w2[m][bj][q]))) * __builtin_amdgcn_rcpf(1.0f + __builtin_amdgcn_exp2f(-1.4426950408889634f * bflo(w1[m][bj][q])));
                        const float fhi = rr * (1.0f + __builtin_amdgcn_exp2f(-1.4426950408889634f * bfhi(w2[m][bj][q]))) * __builtin_amdgcn_rcpf(1.0f + __builtin_amdgcn_exp2f(-1.4426950408889634f * bfhi(w1[m][bj][q])));
                        acc[ai][bj][m][q >> 1][2 * (q & 1)] *= flo; acc[ai][bj][m][q >> 1][2 * (q & 1) + 1] *= fhi;
                    }
                }
            }
            __builtin_amdgcn_sched_barrier(0);
        }
    }
    __device__ __forceinline__ void operator()(const f32x4 (&acc)[2][2][4][2], const Unit& u, int wr, int wc, int fr, int fq) const {
        const int row0 = u.pm * 256 + wr * 64 + fr, col0 = u.pn * 256 + wc * 32 + 8 * fq;
#pragma unroll
        for (int ai = 0; ai < 2; ++ai)
#pragma unroll
            for (int m = 0; m < 4; ++m) {
                const int row = row0 + ai * 128 + m * 16;
                const float rlast = rl[ai * 128 + wr * 64 + m * 16 + fr];
#pragma unroll
                for (int bj = 0; bj < 2; ++bj) {
                    const int col = col0 + bj * 128;
                    float mg[8]; unpack8(*(const u32x4*)(PROJ + (size_t)row * LDP + C_MG + 1024 + col), mg);
                    const f32x4 v0 = acc[ai][bj][m][0], v1 = acc[ai][bj][m][1];
                    float o[8];
#pragma unroll
                    for (int i = 0; i < 4; ++i) { o[i] = v0[i] * rlast * sigmoidf_(mg[i]); o[4 + i] = v1[i] * rlast * sigmoidf_(mg[4 + i]); }
                    *(u32x4*)(PROJ + (size_t)row * LDP + C_Q + col) = pack8(o);
                }
            }
    }
};

template <int MODE> struct EpiResid {
    static constexpr bool PERM = true; static constexpr int NSEG = 1; static constexpr int NPART = 1, SPLIT = 0;
    bf16_t* PROJ; const float* xp; const float* xs; int res_col, dstb_col; float* SS;
    __device__ __forceinline__ void operator()(const f32x4 (&acc)[2][2][4][2], const Unit& u, int wr, int wc, int fr, int fq) const {
        const int row0 = u.pm * 256 + wr * 64 + fr, col0 = u.pn * 256 + wc * 32 + 8 * fq;
#pragma unroll
        for (int ai = 0; ai < 2; ++ai)
#pragma unroll
            for (int m = 0; m < 4; ++m) {
                const int row = row0 + ai * 128 + m * 16;
                float ss = 0.f;
#pragma unroll
                for (int bj = 0; bj < 2; ++bj) {
                    const int col = col0 + bj * 128;
                    f32x4 r0 = (f32x4){0.f, 0.f, 0.f, 0.f}, r1 = r0;
                    if (MODE == 0) {
                        if (row < MTOT) { const float* rp = (row < MPR ? xp + (size_t)row * D : xs + (size_t)(row - MPR) * D) + col; r0 = *(const f32x4*)rp; r1 = *(const f32x4*)(rp + 4); }
                    } else {
                        float rv[8]; unpack8(*(const u32x4*)(PROJ + (size_t)row * LDP + res_col + col), rv);
                        r0 = (f32x4){rv[0], rv[1], rv[2], rv[3]}; r1 = (f32x4){rv[4], rv[5], rv[6], rv[7]};
                    }
                    const f32x4 x0 = r0 + acc[ai][bj][m][0], x1 = r1 + acc[ai][bj][m][1];
                    u32x4 w; w.x = cvt_pk_bf16(x0[0], x0[1]); w.y = cvt_pk_bf16(x0[2], x0[3]); w.z = cvt_pk_bf16(x1[0], x1[1]); w.w = cvt_pk_bf16(x1[2], x1[3]);
                    *(u32x4*)(PROJ + (size_t)row * LDP + dstb_col + col) = w;
                    ss += (x0[0] * x0[0] + x0[1] * x0[1]) + (x0[2] * x0[2] + x0[3] * x0[3]) + (x1[0] * x1[0] + x1[1] * x1[1]) + (x1[2] * x1[2] + x1[3] * x1[3]);
                }
                ss += __shfl_xor(ss, 16); ss += __shfl_xor(ss, 32);
                if (fq == 0) atomicAdd(SS + row, ss);
            }
    }
};

struct EpiSwiGLU {
    static constexpr bool PERM = true; static constexpr int NSEG = 1; static constexpr int NPART = 1, SPLIT = 0;
    bf16_t* PROJ; const float* SS;
    __device__ __forceinline__ void operator()(const f32x4 (&acc)[2][2][4][2], const Unit& u, int wr, int wc, int fr, int fq) const {
        const int row0 = u.pm * 256 + wr * 64 + fr, col0 = u.pn * 128 + wc * 32 + 8 * fq;
#pragma unroll
        for (int ai = 0; ai < 2; ++ai)
#pragma unroll
            for (int m = 0; m < 4; ++m) {
                const int row = row0 + ai * 128 + m * 16;
                const float r = rsqrtf(SS[row] * (1.0f / D) + EPS);
                const f32x4 g0 = acc[ai][0][m][0], g1 = acc[ai][0][m][1], u0 = acc[ai][1][m][0], u1 = acc[ai][1][m][1];
                float o[8];
#pragma unroll
                for (int i = 0; i < 4; ++i) { o[i] = siluf_(r * g0[i]) * (r * u0[i]); o[4 + i] = siluf_(r * g1[i]) * (r * u1[i]); }
                __builtin_nontemporal_store(pack8(o), (u32x4*)(PROJ + (size_t)row * LDP + C_XS + col0));
            }
    }
};

struct EpiPE {
    static constexpr bool PERM = true; static constexpr int NSEG = 1; static constexpr int NPART = 1, SPLIT = 0;
    bf16_t* PROJ;
    __device__ __forceinline__ void operator()(const f32x4 (&acc)[2][2][4][2], const Unit& u, int wr, int wc, int fr, int fq) const {
        const int row0 = u.pm * 256 + wr * 64 + fr, col0 = u.pn * 256 + wc * 32 + 8 * fq;
#pragma unroll
        for (int ai = 0; ai < 2; ++ai)
#pragma unroll
            for (int m = 0; m < 4; ++m) {
                const int row = row0 + ai * 128 + m * 16;
#pragma unroll
                for (int bj = 0; bj < 2; ++bj) {
                    const f32x4 v0 = acc[ai][bj][m][0], v1 = acc[ai][bj][m][1];
                    u32x4 w; w.x = cvt_pk_bf16(v0[0], v0[1]); w.y = cvt_pk_bf16(v0[2], v0[3]); w.z = cvt_pk_bf16(v1[0], v1[1]); w.w = cvt_pk_bf16(v1[2], v1[3]);
                    *(u32x4*)(PROJ + (size_t)row * LDP + C_Z + col0 + bj * 128) = w;
                }
            }
    }
};

struct EpiX3 {
    static constexpr bool PERM = true; static constexpr int NSEG = 1; static constexpr int NPART = 1, SPLIT = 0;
    bf16_t* PROJ; const float* SS2; float* SS3; float* out; unsigned* cnt; unsigned* bar; const float* gf; LAS float* rt;
    __device__ __forceinline__ void operator()(const f32x4 (&acc_)[2][2][4][2], const Unit& u, int wr, int wc, int fr, int fq) const {
        f32x4 (&acc)[2][2][4][2] = const_cast<f32x4 (&)[2][2][4][2]>(acc_);
        const int row0 = u.pm * 256 + wr * 64 + fr, col0 = u.pn * 256 + wc * 32 + 8 * fq;
#pragma unroll
        for (int ai = 0; ai < 2; ++ai)
#pragma unroll
            for (int m = 0; m < 4; ++m) {
                const int row = row0 + ai * 128 + m * 16;
                const float r = rsqrtf(SS2[row] * (1.0f / D) + EPS);
                float ss = 0.f;
#pragma unroll
                for (int bj = 0; bj < 2; ++bj) {
                    const int col = col0 + bj * 128;
                    float xa[8], pa[8]; unpack8(*(const u32x4*)(PROJ + (size_t)row * LDP + C_GATE + col), xa); unpack8(*(const u32x4*)(PROJ + (size_t)row * LDP + C_Z + col), pa);
                    const f32x4 a0 = (f32x4){xa[0], xa[1], xa[2], xa[3]}, a1 = (f32x4){xa[4], xa[5], xa[6], xa[7]}, p0 = (f32x4){pa[0], pa[1], pa[2], pa[3]}, p1 = (f32x4){pa[4], pa[5], pa[6], pa[7]};
                    const f32x4 v0 = acc[ai][bj][m][0], v1 = acc[ai][bj][m][1];
                    f32x4 x0, x1;
#pragma unroll
                    for (int i = 0; i < 4; ++i) { x0[i] = a0[i] + p0[i] * sigmoidf_(r * v0[i]); x1[i] = a1[i] + p1[i] * sigmoidf_(r * v1[i]); }
                    acc[ai][bj][m][0] = x0; acc[ai][bj][m][1] = x1;
                    ss += (x0[0] * x0[0] + x0[1] * x0[1]) + (x0[2] * x0[2] + x0[3] * x0[3]) + (x1[0] * x1[0] + x1[1] * x1[1]) + (x1[2] * x1[2] + x1[3] * x1[3]);
                }
                ss += __shfl_xor(ss, 16); ss += __shfl_xor(ss, 32);
                if (fq == 0) atomicAdd(SS3 + row, ss);
            }
        asm volatile("s_waitcnt vmcnt(0)" ::: "memory");
        unsigned* c = cnt + 64 * u.pm;
        if ((threadIdx.x & 63) == 0) (void)xb_add(c, 1u);
        if (threadIdx.x < 64) { unsigned sp = 0u; while ((unsigned)__builtin_amdgcn_readfirstlane(xb_ld(c)) < 32u) { __builtin_amdgcn_s_sleep(1);
            if ((++sp & 255u) == 0u) { if (xb_ld(&bar[XB_TMO])) break; if (sp > XB_SPIN_CAP) { atomicAdd(&bar[XB_TMO], 1u); break; } } } }
        asm volatile("s_waitcnt vmcnt(0) lgkmcnt(0)" ::: "memory"); __builtin_amdgcn_s_barrier(); asm volatile("" ::: "memory");
        if (threadIdx.x < 256) rt[threadIdx.x] = rsqrtf(__uint_as_float(xb_ld((unsigned*)(SS3 + u.pm * 256 + threadIdx.x))) * (1.0f / D) + EPS);
        asm volatile("s_waitcnt vmcnt(0) lgkmcnt(0)" ::: "memory"); __builtin_amdgcn_s_barrier(); asm volatile("" ::: "memory");
        f32x4 gq[2][2];
#pragma unroll
        for (int bj = 0; bj < 2; ++bj) { gq[bj][0] = *(const f32x4*)(gf + col0 + bj * 128); gq[bj][1] = *(const f32x4*)(gf + col0 + bj * 128 + 4); }
#pragma unroll
        for (int ai = 0; ai < 2; ++ai)
#pragma unroll
            for (int m = 0; m < 4; ++m) {
                const int rl = ai * 128 + wr * 64 + m * 16 + fr;
                const float r3 = rt[rl];
                float* orow = out + O_Y + (size_t)(u.pm * 256 + rl) * D + col0;
#pragma unroll
                for (int bj = 0; bj < 2; ++bj) {
                    *(f32x4*)(orow + bj * 128) = acc[ai][bj][m][0] * r3 * gq[bj][0];
                    *(f32x4*)(orow + bj * 128 + 4) = acc[ai][bj][m][1] * r3 * gq[bj][1];
                }
            }
    }
};

struct MapIdent { __device__ __forceinline__ int operator()(int n) const { return n; } };
struct MapWin {
    __device__ __forceinline__ int operator()(int n) const {
        if (n < 5120) return n;
        if (n < 9216) return n + 32;
        if (n < 11264) return n + 48;
        const int j = n - 11264;
        if (j < 32) return 5120 + j;
        if (j < 48) return 9216 + j;
        return -1;
    }
};
struct MapFfn {
    __device__ __forceinline__ int operator()(int n) const { const int j = n >> 8, r = n & 255; return r < 128 ? 128 * j + r : DFF + 128 * j + (r - 128); }
};
template <class Map>
__device__ __forceinline__ void transpose_item(const float* W, int K, int Nsrc, int Ndst, bf16_t* WT, const float* gain, LAS float* scr, int item, int lane, Map map) {
    const int nblk = Ndst / 32, kb = item / nblk, nb = item % nblk, k0 = 64 * kb, n0 = 32 * nb;
    const int sc = map(n0 + (lane & 31));
    float tv[32];
#pragma unroll
    for (int i = 0; i < 32; ++i) { const int kk = 2 * i + (lane >> 5); tv[i] = sc >= 0 ? W[(size_t)(k0 + kk) * Nsrc + sc] : 0.f; }
#pragma unroll
    for (int i = 0; i < 32; ++i) { const int kk = 2 * i + (lane >> 5); float v = tv[i]; if (gain) v *= gain[k0 + kk]; scr[kk * 33 + (lane & 31)] = v; }
    asm volatile("s_waitcnt lgkmcnt(0)" ::: "memory");
    const int c = lane & 7;
#pragma unroll
    for (int j = 0; j < 4; ++j) { const int n = (lane >> 3) + 8 * j; const LAS float* s = scr + (8 * c) * 33 + n;
        u32x4 o; o.x = cvt_pk_bf16(s[0 * 33], s[1 * 33]); o.y = cvt_pk_bf16(s[2 * 33], s[3 * 33]); o.z = cvt_pk_bf16(s[4 * 33], s[5 * 33]); o.w = cvt_pk_bf16(s[6 * 33], s[7 * 33]);
        *(u32x4*)(WT + (size_t)(n0 + n) * K + k0 + 8 * c) = o; }
    asm volatile("s_waitcnt lgkmcnt(0)" ::: "memory");
}

struct TItem { const float* W; const float* gain; bf16_t* WT; int K, Nsrc, k0, n0, sc, ldk, koff; };
__device__ __forceinline__ TItem p0_decode(const Frame& F, int it, int lane) {
    constexpr int I_WIN = 16 * (NPROJ / 32), I_WBS = 32 * 32, I_WBG = 16 * 32, I_WOUT = 16 * 32, I_WFI = 16 * (2 * DFF / 32), I_WFO = (DFF / 64) * 32, I_WPG = 16 * 32;
    unsigned char* ws = F.ws;
    TItem t; int r = it, Ndst, mapid = 0; t.ldk = 0; t.koff = 0;
    if (r < I_WIN) { t.W = F.in[9]; t.gain = nullptr; t.WT = (bf16_t*)(ws + WS_WIN); t.K = D; t.Nsrc = NIN; Ndst = NPROJ; mapid = 1; }
    else if ((r -= I_WIN) < I_WBS) { t.W = F.in[20]; t.gain = F.in[15];     t.WT = (bf16_t*)(ws + WS_WBS); t.K = 2048; t.Nsrc = D; Ndst = D; t.ldk = 3072; t.koff = 0; }
    else if ((r -= I_WBS) < I_WBG) { t.W = F.in[21]; t.gain = nullptr; t.WT = (bf16_t*)(ws + WS_WBS); t.K = D; t.Nsrc = D; Ndst = D; t.ldk = 3072; t.koff = 2048; }
    else if ((r -= I_WBG) < I_WOUT) { t.W = F.in[22]; t.gain = nullptr; t.WT = (bf16_t*)(ws + WS_WOUT); t.K = D; t.Nsrc = D; Ndst = D; }
    else if ((r -= I_WOUT) < I_WFI) { t.W = F.in[24]; t.gain = F.in[23]; t.WT = (bf16_t*)(ws + WS_WFI); t.K = D; t.Nsrc = 2 * DFF; Ndst = 2 * DFF; mapid = 2; }
    else if ((r -= I_WFI) < I_WFO) { t.W = F.in[25]; t.gain = nullptr; t.WT = (bf16_t*)(ws + WS_WFO); t.K = DFF; t.Nsrc = D; Ndst = D; }
    else if ((r -= I_WFO) < I_WPG) { t.W = F.in[27]; t.gain = F.in[26]; t.WT = (bf16_t*)(ws + WS_WPG); t.K = D; t.Nsrc = D; Ndst = D; }
    else { r -= I_WPG; t.W = F.in[28]; t.gain = nullptr; t.WT = (bf16_t*)(ws + WS_WPP); t.K = 256; t.Nsrc = D; Ndst = D; }
    if (t.ldk == 0) t.ldk = t.K;
    const int nblk = Ndst / 32; t.k0 = 64 * (r / nblk); t.n0 = 32 * (r % nblk);
    const int n = t.n0 + 4 * (lane & 7);
    t.sc = mapid == 1 ? MapWin()(n) : mapid == 2 ? MapFfn()(n) : n;
    return t;
}
__device__ __forceinline__ void p0_load(const TItem& t, int lane, f32x4 (&tv)[8]) {
#pragma unroll
    for (int i = 0; i < 8; ++i) { const int kk = 8 * i + (lane >> 3); tv[i] = t.sc >= 0 ? *(const f32x4*)(t.W + (size_t)(t.k0 + kk) * t.Nsrc + t.sc) : (f32x4){0.f, 0.f, 0.f, 0.f}; }
}
__device__ __forceinline__ void p0_finish(const TItem& t, int lane, const f32x4 (&tv)[8], LAS float* scr) {
#pragma unroll
    for (int i = 0; i < 8; ++i) { const int kk = 8 * i + (lane >> 3); f32x4 v = tv[i]; if (t.gain) v = v * t.gain[t.k0 + kk];
#pragma unroll
        for (int e = 0; e < 4; ++e) scr[kk * 33 + 4 * (lane & 7) + e] = v[e]; }
    asm volatile("s_waitcnt lgkmcnt(0)" ::: "memory");
    const int c = lane & 7;
#pragma unroll
    for (int j = 0; j < 4; ++j) { const int n = (lane >> 3) + 8 * j; const LAS float* sp = scr + (8 * c) * 33 + n;
        u32x4 o; o.x = cvt_pk_bf16(sp[0 * 33], sp[1 * 33]); o.y = cvt_pk_bf16(sp[2 * 33], sp[3 * 33]); o.z = cvt_pk_bf16(sp[4 * 33], sp[5 * 33]); o.w = cvt_pk_bf16(sp[6 * 33], sp[7 * 33]);
        *(u32x4*)(t.WT + (size_t)(t.n0 + n) * t.ldk + t.koff + t.k0 + 8 * c) = o; }
    asm volatile("s_waitcnt lgkmcnt(0)" ::: "memory");
}
__device__ __forceinline__ void p0_prologue(Frame& F, int mode, int gw, int NGW) {
    LAS float* scr = (LAS float*)(F.lds + F.wave * 16384);
    const int lane = F.lane;
    constexpr int I_WIN = 16 * (NPROJ / 32);
    constexpr int NITEMS = I_WIN + 32 * 32 + 16 * 32 + 16 * 32 + 16 * (2 * DFF / 32) + (DFF / 64) * 32 + 16 * 32 + 4 * 32;
    const int it_lo = mode == 0 ? 0 : I_WIN, it_hi = mode == 0 ? I_WIN : NITEMS;
    if (it_lo + gw < it_hi) {
        TItem cur = p0_decode(F, it_lo + gw, lane); f32x4 tv[8]; p0_load(cur, lane, tv);
        for (int it = it_lo + gw; it < it_hi; it += NGW) {
            const bool more = it + NGW < it_hi;
            TItem nxt = cur; f32x4 tn[8];
            if (more) { nxt = p0_decode(F, it + NGW, lane); p0_load(nxt, lane, tn); }
            p0_finish(cur, lane, tv, scr);
            if (more) { cur = nxt;
#pragma unroll
                for (int i = 0; i < 8; ++i) tv[i] = tn[i]; }
        }
    }
    if (mode == 0) {
        const float* gmix = F.in[8];
        for (int m0 = gw; m0 < MP; m0 += 4 * NGW) {
            f32x4 v[4][4];
#pragma unroll
            for (int q = 0; q < 4; ++q) { const int m = m0 + q * NGW;
                if (m < MTOT) {
                    const float* xrow = m < MPR ? F.in[0] + (size_t)m * D : F.in[1] + (size_t)(m - MPR) * D;
#pragma unroll
                    for (int j = 0; j < 4; ++j) v[q][j] = ((const f32x4*)xrow)[64 * j + lane];
                } else {
#pragma unroll
                    for (int j = 0; j < 4; ++j) v[q][j] = (f32x4){0.f, 0.f, 0.f, 0.f};
                } }
#pragma unroll
            for (int q = 0; q < 4; ++q) { const int m = m0 + q * NGW;
                if (m < MP) {
                    u32x2* o8 = (u32x2*)(F.XN() + (size_t)m * D) + lane;
                    float sq = 0.f;
#pragma unroll
                    for (int j = 0; j < 4; ++j) sq += (v[q][j][0] * v[q][j][0] + v[q][j][1] * v[q][j][1]) + (v[q][j][2] * v[q][j][2] + v[q][j][3] * v[q][j][3]);
                    const float rs = rsqrtf(wave_sum(sq) * (1.0f / D) + EPS);
#pragma unroll
                    for (int j = 0; j < 4; ++j) { const f32x4 gv = ((const f32x4*)gmix)[64 * j + lane]; const f32x4 y = v[q][j] * rs * gv;
                        o8[64 * j] = (u32x2){cvt_pk_bf16(y[0], y[1]), cvt_pk_bf16(y[2], y[3])}; }
                } }
        }
    } else {
        for (int m0 = gw; m0 < MP; m0 += 8 * NGW) {
            f32x4 pv[8];
#pragma unroll
            for (int q = 0; q < 8; ++q) { const int m = m0 + q * NGW;
                pv[q] = m < MTOT ? ((const f32x4*)(m < MPR ? F.in[2] + (size_t)m * 256 : F.in[3] + (size_t)(m - MPR) * 256))[lane] : (f32x4){0.f, 0.f, 0.f, 0.f}; }
#pragma unroll
            for (int q = 0; q < 8; ++q) { const int m = m0 + q * NGW;
                if (m < MP) ((u32x2*)(F.PB() + (size_t)m * 256))[lane] = (u32x2){cvt_pk_bf16(pv[q][0], pv[q][1]), cvt_pk_bf16(pv[q][2], pv[q][3])}; }
        }
    }
}

__device__ __forceinline__ void p2_conv(Frame& F) {
    const int gt = blockIdx.x * (NWAVES * 64) + F.tid, NT = F.G * NWAVES * 64;
    constexpr int NCG = NCH / 8;
    constexpr int NU_F = (MPR / 64) * NCG, NU_S = NSMP * NCG;
    for (int u = gt; u < NU_F + NU_S; u += NT) {
        const bool smp = u >= NU_F;
        const int uu = smp ? u - NU_F : u;
        const int ch = uu / NCG, cgi = uu % NCG;
        const bool is_ssm = cgi < 384;
        const int cc = is_ssm ? cgi * 8 : (cgi - 384) * 8;
        const int kind = is_ssm ? 0 : 1 + (cgi - 384) / 128;
        const float* cw = is_ssm ? F.in[10] : F.in[16];
        float w[4][8], bias[8];
#pragma unroll
        for (int j = 0; j < 4; ++j) { const f32x4 a = *(const f32x4*)(cw + j * 3072 + cc), b = *(const f32x4*)(cw + j * 3072 + cc + 4);
#pragma unroll
            for (int i = 0; i < 4; ++i) { w[j][i] = a[i]; w[j][4 + i] = b[i]; } }
        if (is_ssm) { const f32x4 a = *(const f32x4*)(F.in[11] + cc), b = *(const f32x4*)(F.in[11] + cc + 4);
#pragma unroll
            for (int i = 0; i < 4; ++i) { bias[i] = a[i]; bias[4 + i] = b[i]; } }
        else {
#pragma unroll
            for (int i = 0; i < 8; ++i) bias[i] = 0.f; }
        float h0[8], h1[8], h2[8];
        const int pcol = C_XS + cgi * 8;
        if (smp) {
            const float* st = (is_ssm ? F.in[5] : F.in[7]) + (size_t)ch * 3 * 3072 + cc;
#pragma unroll
            for (int i = 0; i < 8; ++i) { h0[i] = st[i]; h1[i] = st[3072 + i]; h2[i] = st[2 * 3072 + i]; }
            bf16_t* rp = F.PROJ() + (size_t)(MPR + ch) * LDP + pcol;
            float x[8]; unpack8(*(const u32x4*)rp, x);
            float o[8]; float ss = 0.f;
#pragma unroll
            for (int i = 0; i < 8; ++i) { float v = w[0][i] * h0[i] + w[1][i] * h1[i] + w[2][i] * h2[i] + w[3][i] * x[i] + bias[i]; v = siluf_(v); o[i] = v; ss += v * v; }
            if (kind == 1 || kind == 2) {
                ss = row16_sum(ss);
                const float rn = rsqrtf(ss + EPS) * (kind == 1 ? 0.08838834764831845f : 1.0f);
#pragma unroll
                for (int i = 0; i < 8; ++i) o[i] *= rn;
            }
            *(u32x4*)rp = pack8(o);
            float* ns = F.out + (is_ssm ? O_SCONVS : O_GCONVS) + (size_t)ch * 3 * 3072 + cc;
#pragma unroll
            for (int i = 0; i < 8; ++i) { ns[i] = h1[i]; ns[3072 + i] = h2[i]; ns[2 * 3072 + i] = x[i]; }
            continue;
        }
        const int rowbase = ch * 64, t0 = rowbase & (SEQ - 1);
        if (t0 == 0) {
#pragma unroll
            for (int i = 0; i < 8; ++i) { h0[i] = 0.f; h1[i] = 0.f; h2[i] = 0.f; }
        } else {
            const bf16_t* hp = F.HALO() + (size_t)(ch - 1) * 3 * NCH + cgi * 8;
            unpack8(*(const u32x4*)hp, h0); unpack8(*(const u32x4*)(hp + NCH), h1); unpack8(*(const u32x4*)(hp + 2 * NCH), h2);
        }
        const bool lastc = (t0 == SEQ - 64);
        float* ns = F.out + (is_ssm ? O_SCONVP : O_GCONVP) + (size_t)(rowbase >> 11) * 3 * 3072 + cc;
        bf16_t* rp = F.PROJ() + (size_t)rowbase * LDP + pcol;
        u32x4 raw[3];
#pragma unroll
        for (int r = 0; r < 3; ++r) raw[r] = *(const u32x4*)(rp + (size_t)r * LDP);
#pragma unroll
        for (int r = 0; r < 3; ++r) {
            float x[8]; unpack8(raw[r], x);
            float o[8]; float ss = 0.f;
#pragma unroll
            for (int i = 0; i < 8; ++i) { float v = w[0][i] * h0[i] + w[1][i] * h1[i] + w[2][i] * h2[i] + w[3][i] * x[i] + bias[i]; v = siluf_(v); o[i] = v; ss += v * v; }
            if (kind == 1 || kind == 2) {
                ss = row16_sum(ss);
                const float rn = rsqrtf(ss + EPS) * (kind == 1 ? 0.08838834764831845f : 1.0f);
#pragma unroll
                for (int i = 0; i < 8; ++i) o[i] *= rn;
            }
            *(u32x4*)(rp + (size_t)r * LDP) = pack8(o);
#pragma unroll
            for (int i = 0; i < 8; ++i) { h0[i] = h1[i]; h1[i] = h2[i]; h2[i] = x[i]; }
        }
        if (lastc) {
            const bf16_t* hp = F.HALO() + (size_t)ch * 3 * NCH + cgi * 8;
#pragma unroll
            for (int r = 0; r < 3; ++r) { float x[8]; unpack8(*(const u32x4*)(hp + (size_t)r * NCH), x);
#pragma unroll
                for (int i = 0; i < 8; ++i) ns[r * 3072 + i] = x[i]; }
        }
    }
}

__device__ __forceinline__ void ssd_item(Frame& F, int item) {
    const bool smp = item >= NBATCH * 32;
    const int sq = smp ? (item - NBATCH * 32) >> 5 : item >> 5, h = item & 31, g = h >> 3;
    const int row0 = smp ? MPR + sq : sq * SEQ, T = smp ? 1 : SEQ;
    const int tid = F.tid, p = tid >> 3, nq = tid & 7;
    LAS bf16_t* Bs = (LAS bf16_t*)(F.lds);
    LAS bf16_t* Cs = (LAS bf16_t*)(F.lds + 16384);
    LAS bf16_t* Xs = (LAS bf16_t*)(F.lds + 32768);
    LAS float* dts = (LAS float*)(F.lds + 40960);
    LAS float* decs = (LAS float*)(F.lds + 41216);
    LAS float* Ys = (LAS float*)(F.lds + 41472);
    float hst[16];
    if (smp) {
        const float* sp = F.in[4] + ((size_t)(sq * 32 + h) * 64 + p) * 128 + nq * 16;
#pragma unroll
        for (int i = 0; i < 4; ++i) { const f32x4 v = ((const f32x4*)sp)[i]; hst[4 * i] = v[0]; hst[4 * i + 1] = v[1]; hst[4 * i + 2] = v[2]; hst[4 * i + 3] = v[3]; }
    } else {
#pragma unroll
        for (int i = 0; i < 16; ++i) hst[i] = 0.f;
    }
    const float a_h = -__expf(F.in[13][h]), dtb = F.in[12][h], Dh = F.in[14][h];
    for (int tb = 0; tb < T; tb += 64) {
        const int rows = (T - tb) < 64 ? (T - tb) : 64;
#pragma unroll
        for (int i = 0; i < 2; ++i) {
            const int pc = tid + i * 512, r = pc >> 4, c8 = (pc & 15) * 8;
            if (r < rows) {
                const bf16_t* src = F.PROJ() + (size_t)(row0 + tb + r) * LDP;
                *(LAS u32x4*)(Bs + r * 128 + c8) = *(const u32x4*)(src + C_B + g * 128 + c8);
                *(LAS u32x4*)(Cs + r * 128 + c8) = *(const u32x4*)(src + C_C + g * 128 + c8);
            }
        }
        { const int r = tid >> 3, c8 = (tid & 7) * 8;
          if (r < rows) *(LAS u32x4*)(Xs + r * 64 + c8) = *(const u32x4*)(F.PROJ() + (size_t)(row0 + tb + r) * LDP + C_XS + h * 64 + c8); }
        if (tid < rows) { const float dt = softplusf_(F.SMALL()[(size_t)(row0 + tb + tid) * 64 + h] + dtb); dts[tid] = dt; decs[tid] = __expf(dt * a_h); }
        __syncthreads();
        for (int tt = 0; tt < rows; ++tt) {
            const float xv = bf2f(Xs[tt * 64 + p]), dtv = dts[tt], dc = decs[tt], dx = dtv * xv;
            float bv[16], cv[16];
            { float t8[8]; unpack8(*(const LAS u32x4*)(Bs + tt * 128 + nq * 16), t8);
#pragma unroll
              for (int i = 0; i < 8; ++i) bv[i] = t8[i];
              unpack8(*(const LAS u32x4*)(Bs + tt * 128 + nq * 16 + 8), t8);
#pragma unroll
              for (int i = 0; i < 8; ++i) bv[8 + i] = t8[i];
              unpack8(*(const LAS u32x4*)(Cs + tt * 128 + nq * 16), t8);
#pragma unroll
              for (int i = 0; i < 8; ++i) cv[i] = t8[i];
              unpack8(*(const LAS u32x4*)(Cs + tt * 128 + nq * 16 + 8), t8);
#pragma unroll
              for (int i = 0; i < 8; ++i) cv[8 + i] = t8[i]; }
            float yp = 0.f;
#pragma unroll
            for (int i = 0; i < 16; ++i) { hst[i] = dc * hst[i] + dx * bv[i]; yp += cv[i] * hst[i]; }
            yp += __shfl_xor(yp, 1); yp += __shfl_xor(yp, 2); yp += __shfl_xor(yp, 4);
            if (nq == 0) Ys[tt * 64 + p] = yp + Dh * xv;
        }
        __syncthreads();
        { const int r = tid >> 3, c8 = (tid & 7) * 8;
          if (r < rows) { float o[8];
#pragma unroll
              for (int i = 0; i < 8; ++i) o[i] = Ys[r * 64 + c8 + i];
              *(u32x4*)(F.PROJ() + (size_t)(row0 + tb + r) * LDP + C_XS + h * 64 + c8) = pack8(o); } }
        __syncthreads();
    }
    float* op = F.out + (smp ? O_SSMS : O_SSMP) + ((size_t)(sq * 32 + h) * 64 + p) * 128 + nq * 16;
#pragma unroll
    for (int i = 0; i < 4; ++i) ((f32x4*)op)[i] = (f32x4){hst[4 * i], hst[4 * i + 1], hst[4 * i + 2], hst[4 * i + 3]};
}

__device__ __forceinline__ void gdn_item(Frame& F, int item) {
    const bool smp = item >= NBATCH * 32;
    const int sq = smp ? (item - NBATCH * 32) >> 5 : item >> 5, h = (item >> 2) & 7, dvq = item & 3;
    const int row0 = smp ? MPR + sq : sq * SEQ, T = smp ? 1 : SEQ;
    const int tid = F.tid, e = tid >> 4, kg = tid & 15;
    LAS bf16_t* Qs = (LAS bf16_t*)(F.lds);
    LAS bf16_t* Ks = (LAS bf16_t*)(F.lds + 16384);
    LAS bf16_t* Vs = (LAS bf16_t*)(F.lds + 32768);
    LAS float* egs = (LAS float*)(F.lds + 36864);
    LAS float* bts = (LAS float*)(F.lds + 37120);
    LAS float* Os = (LAS float*)(F.lds + 37376);
    float S[8];
    const size_t sbase = ((size_t)(sq * 8 + h) * 128 + kg * 8) * 128 + dvq * 32 + e;
    if (smp) {
#pragma unroll
        for (int j = 0; j < 8; ++j) S[j] = F.in[6][sbase + (size_t)j * 128];
    } else {
#pragma unroll
        for (int j = 0; j < 8; ++j) S[j] = 0.f;
    }
    const float na = -__expf(F.in[18][h]), dtb = F.in[17][h];
    for (int tb = 0; tb < T; tb += 64) {
        const int rows = (T - tb) < 64 ? (T - tb) : 64;
#pragma unroll
        for (int i = 0; i < 2; ++i) {
            const int pc = tid + i * 512, r = pc >> 4, c8 = (pc & 15) * 8;
            if (r < rows) {
                const bf16_t* src = F.PROJ() + (size_t)(row0 + tb + r) * LDP;
                *(LAS u32x4*)(Qs + r * 128 + c8) = *(const u32x4*)(src + C_Q + h * 128 + c8);
                *(LAS u32x4*)(Ks + r * 128 + c8) = *(const u32x4*)(src + C_K + h * 128 + c8);
            }
        }
        if (tid < 256) { const int r = tid >> 2, c8 = (tid & 3) * 8;
          if (r < rows) *(LAS u32x4*)(Vs + r * 32 + c8) = *(const u32x4*)(F.PROJ() + (size_t)(row0 + tb + r) * LDP + C_V + h * 128 + dvq * 32 + c8); }
        if (tid < rows) { const float* sm = F.SMALL() + (size_t)(row0 + tb + tid) * 64;
            egs[tid] = __expf(na * softplusf_(sm[40 + h] + dtb)); bts[tid] = sigmoidf_(sm[32 + h]); }
        __syncthreads();
        for (int tt = 0; tt < rows; ++tt) {
            float k8[8], q8[8];
            unpack8(*(const LAS u32x4*)(Ks + tt * 128 + kg * 8), k8);
            unpack8(*(const LAS u32x4*)(Qs + tt * 128 + kg * 8), q8);
            const float eg = egs[tt], bt = bts[tt], v = bf2f(Vs[tt * 32 + e]);
            float ks = 0.f;
#pragma unroll
            for (int j = 0; j < 8; ++j) ks += k8[j] * S[j];
            ks += __shfl_xor(ks, 1); ks += __shfl_xor(ks, 2); ks += __shfl_xor(ks, 4); ks += __shfl_xor(ks, 8);
            const float vn = bt * (v - eg * ks);
            float op = 0.f;
#pragma unroll
            for (int j = 0; j < 8; ++j) { S[j] = eg * S[j] + k8[j] * vn; op += q8[j] * S[j]; }
            op += __shfl_xor(op, 1); op += __shfl_xor(op, 2); op += __shfl_xor(op, 4); op += __shfl_xor(op, 8);
            if (kg == 0) Os[tt * 32 + e] = op;
        }
        __syncthreads();
        if (tid < 256) { const int r = tid >> 2, c8 = (tid & 3) * 8;
          if (r < rows) { float o[8];
#pragma unroll
              for (int i = 0; i < 8; ++i) o[i] = Os[r * 32 + c8 + i];
              *(u32x4*)(F.PROJ() + (size_t)(row0 + tb + r) * LDP + C_B + h * 128 + dvq * 32 + c8) = pack8(o); } }
        __syncthreads();
    }
    float* op = F.out + (smp ? O_GDNS : O_GDNP);
#pragma unroll
    for (int j = 0; j < 8; ++j) op[sbase + (size_t)j * 128] = S[j];
}


typedef short v4i16 __attribute__((ext_vector_type(4)));
__device__ __forceinline__ bf16x8 row_frag(LAS const unsigned char* base, int pitch, int row0, int k0, int lane) {
    return *(const LAS bf16x8*)(base + (row0 + (lane & 15)) * pitch + (k0 + 8 * (lane >> 4)) * 2);
}
__device__ __forceinline__ bf16x8 tr_frag(LAS const unsigned char* base, int pitch, int k0, int col0, int lane) {
    const int g = lane >> 4, m = lane & 15, q = m >> 2, pp = m & 3;
    LAS const unsigned char* a0 = base + (k0 + 8 * g + q) * pitch + (col0 + 4 * pp) * 2;
    const v4i16 lo = __builtin_amdgcn_ds_read_tr16_b64_v4i16((LAS v4i16*)a0);
    const v4i16 hi = __builtin_amdgcn_ds_read_tr16_b64_v4i16((LAS v4i16*)(a0 + 4 * pitch));
    return (bf16x8){lo[0], lo[1], lo[2], lo[3], hi[0], hi[1], hi[2], hi[3]};
}
#define LDS_BARRIER() do { asm volatile("s_waitcnt lgkmcnt(0)" ::: "memory"); __builtin_amdgcn_s_barrier(); asm volatile("" ::: "memory"); } while (0)
#define MFMA16(a, b, c) __builtin_amdgcn_mfma_f32_16x16x32_bf16((a), (b), (c), 0, 0, 0)
__device__ __forceinline__ u32x2 pack4(float a, float b, float c, float d) { return (u32x2){cvt_pk_bf16(a, b), cvt_pk_bf16(c, d)}; }

struct SsdSmpIn { f32x4 st[4]; u32x2 b[4], c[4]; float x, dtraw; };
__device__ __forceinline__ void ssd_smp_load(const Frame& F, int it, int p, int nq, SsdSmpIn& r) {
    const int sq = it >> 5, h = it & 31, g4 = h >> 3;
    const float* sp = F.in[4] + ((size_t)(sq * 32 + h) * 64 + p) * 128 + nq * 4;
#pragma unroll
    for (int j = 0; j < 4; ++j) r.st[j] = *(const f32x4*)(sp + 32 * j);
    const bf16_t* row = F.PROJ() + (size_t)(MPR + sq) * LDP;
#pragma unroll
    for (int j = 0; j < 4; ++j) { r.b[j] = *(const u32x2*)(row + C_B + g4 * 128 + 32 * j + 4 * nq); r.c[j] = *(const u32x2*)(row + C_C + g4 * 128 + 32 * j + 4 * nq); }
    r.x = bf2f(row[C_XS + h * 64 + p]);
    r.dtraw = F.SMALL()[(size_t)(MPR + sq) * 64 + h];
}
__device__ __forceinline__ void ssd_smp_run(const Frame& F, int it, int p, int nq, const SsdSmpIn& r) {
    const int sq = it >> 5, h = it & 31;
    const float a_h = -__expf(F.in[13][h]), dt = softplusf_(r.dtraw + F.in[12][h]), dc = __expf(dt * a_h), dx = dt * r.x;
    float yp = 0.f; f32x4 o[4];
#pragma unroll
    for (int j = 0; j < 4; ++j) {
        const float bv[4] = {bflo(r.b[j].x), bfhi(r.b[j].x), bflo(r.b[j].y), bfhi(r.b[j].y)}, cv[4] = {bflo(r.c[j].x), bfhi(r.c[j].x), bflo(r.c[j].y), bfhi(r.c[j].y)};
#pragma unroll
        for (int i = 0; i < 4; ++i) { const float hv = dc * r.st[j][i] + dx * bv[i]; o[j][i] = hv; yp += cv[i] * hv; }
    }
    yp += __shfl_xor(yp, 1); yp += __shfl_xor(yp, 2); yp += __shfl_xor(yp, 4);
    float* op = F.out + O_SSMS + ((size_t)(sq * 32 + h) * 64 + p) * 128 + nq * 4;
#pragma unroll
    for (int j = 0; j < 4; ++j) *(f32x4*)(op + 32 * j) = o[j];
    if (nq == 0) { const unsigned w = cvt_pk_bf16(yp + F.in[14][h] * r.x, 0.f); F.PROJ()[(size_t)(MPR + sq) * LDP + C_XS + h * 64 + p] = (bf16_t)(w & 0xffffu); }
}
__device__ __forceinline__ void ssd_sample_stream_regs(const Frame& F, int first) {
    const int p = F.tid >> 3, nq = F.tid & 7;
    constexpr int NIT = NSMP * 32;
    SsdSmpIn r[4];
#pragma unroll
    for (int j = 0; j < 4; ++j) if (first + j * F.G < NIT) ssd_smp_load(F, first + j * F.G, p, nq, r[j]);
    for (int it0 = first; it0 < NIT; it0 += 4 * F.G) {
#pragma unroll
        for (int j = 0; j < 4; ++j) {
            const int it = it0 + j * F.G;
            if (it < NIT) { ssd_smp_run(F, it, p, nq, r[j]); if (it + 4 * F.G < NIT) ssd_smp_load(F, it + 4 * F.G, p, nq, r[j]); }
        }
    }
}
__device__ __forceinline__ void ssd_sample_stream(const Frame& F, int first) {
    constexpr int NIT = NSMP * 32, SLOT = 36864;
    static_assert(4 * SLOT + 512 <= MISC_OFF, "ssd sample ring");
    const int w = F.wave, lane = F.lane;
    LAS unsigned char* L = F.lds;
    const int n = first < NIT ? (NIT - 1 - first) / F.G + 1 : 0;
    LAS float* hp = (LAS float*)(L + 4 * SLOT);
    __syncthreads();
    if (F.tid < 32) { hp[F.tid] = -__expf(F.in[13][F.tid]); hp[32 + F.tid] = F.in[12][F.tid]; hp[64 + F.tid] = F.in[14][F.tid]; }
    __syncthreads();
    if (w < 4) {
#define SSL_ISSUE(k_) do { const int it_ = first + (k_) * F.G, sq_ = it_ >> 5, h_ = it_ & 31; \
            const char* sp_ = (const char*)(F.in[4] + (size_t)it_ * 8192) + (size_t)((w * 8) * 64 + lane) * 16; \
            LAS unsigned char* sl_ = L + ((k_) & 3) * SLOT + w * 8192; \
            _Pragma("unroll") for (int j_ = 0; j_ < 8; ++j_) __builtin_amdgcn_global_load_lds((const unsigned*)(sp_ + j_ * 1024), (LAS unsigned*)(sl_ + j_ * 1024), 16, 0, 0); \
            const bf16_t* row_ = F.PROJ() + (size_t)(MPR + sq_) * LDP; \
            const char* op_ = w == 0 ? (const char*)(row_ + C_B + (h_ >> 3) * 128 + (lane & 15) * 8) : w == 1 ? (const char*)(row_ + C_C + (h_ >> 3) * 128 + (lane & 15) * 8) \
                            : w == 2 ? (const char*)(row_ + C_XS + h_ * 64 + (lane & 7) * 8) : (const char*)(F.SMALL() + (size_t)(MPR + sq_) * 64 + (h_ & ~3)); \
            __builtin_amdgcn_global_load_lds((const unsigned*)op_, (LAS unsigned*)(L + ((k_) & 3) * SLOT + 32768 + w * 1024), 16, 0, 0); } while (0)
        if (n > 0) SSL_ISSUE(0);
        if (n > 1) SSL_ISSUE(1);
        if (n > 2) SSL_ISSUE(2);
        for (int k = 0; k < n; ++k) {
            const int younger = n - 1 - k;
            if (younger >= 2) asm volatile("s_waitcnt vmcnt(18)" ::: "memory"); else if (younger == 1) asm volatile("s_waitcnt vmcnt(9)" ::: "memory"); else asm volatile("s_waitcnt vmcnt(0)" ::: "memory");
            __builtin_amdgcn_s_barrier(); asm volatile("" ::: "memory");
            if (k + 3 < n) SSL_ISSUE(k + 3);
        }
#undef SSL_ISSUE
    } else {
        const int cw = w - 4, nb = lane & 31, hi = lane >> 5;
        for (int k = 0; k < n; ++k) {
            asm volatile("s_waitcnt lgkmcnt(0)" ::: "memory"); __builtin_amdgcn_s_barrier(); asm volatile("" ::: "memory");
            const int it = first + k * F.G, sq = it >> 5, h = it & 31;
            LAS const unsigned char* sl = L + (k & 3) * SLOT;
            const float a_h = hp[h], dtb = hp[32 + h], Dh = hp[64 + h];
            const float dt = softplusf_(*(LAS const float*)(sl + 32768 + 3 * 1024 + (h & 3) * 4) + dtb), dc = __expf(dt * a_h);
            const u32x2 bw = *(LAS const u32x2*)(sl + 32768 + nb * 8), cwd = *(LAS const u32x2*)(sl + 32768 + 1024 + nb * 8);
            const f32x4 bv = (f32x4){bflo(bw.x), bfhi(bw.x), bflo(bw.y), bfhi(bw.y)}, cv = (f32x4){bflo(cwd.x), bfhi(cwd.x), bflo(cwd.y), bfhi(cwd.y)};
            float* op = F.out + O_SSMS + (size_t)it * 8192;
            bf16_t* yrow = F.PROJ() + (size_t)(MPR + sq) * LDP + C_XS + h * 64;
#pragma unroll
            for (int j = 0; j < 8; ++j) {
                const int piece = (cw * 8 + j) * 64 + lane, pr = (cw * 8 + j) * 2 + hi;
                const f32x4 hv = *(LAS const f32x4*)(sl + piece * 16);
                const float xv = bf2f(*(LAS const bf16_t*)(sl + 32768 + 2048 + pr * 2));
                const f32x4 o = hv * dc + bv * (dt * xv);
                *(f32x4*)(op + piece * 4) = o;
                float yp = (cv[0] * o[0] + cv[1] * o[1]) + (cv[2] * o[2] + cv[3] * o[3]);
                yp += __shfl_xor(yp, 1); yp += __shfl_xor(yp, 2); yp += __shfl_xor(yp, 4); yp += __shfl_xor(yp, 8); yp += __shfl_xor(yp, 16);
                if (nb == 0) { const unsigned wv = cvt_pk_bf16(yp + Dh * xv, 0.f); yrow[pr] = (bf16_t)(wv & 0xffffu); }
            }
        }
    }
}
struct GdnSmpIn { float S[8]; u32x4 k8, q8; float v, araw, braw; };
__device__ __forceinline__ void gdn_smp_load(const Frame& F, int it, int e, int kg, GdnSmpIn& r) {
    const int sq = it >> 5, h = (it >> 2) & 7, dvq = it & 3;
    const float* sp = F.in[6] + ((size_t)(sq * 8 + h) * 128 + kg * 8) * 128 + dvq * 32 + e;
#pragma unroll
    for (int j = 0; j < 8; ++j) r.S[j] = sp[(size_t)j * 128];
    const bf16_t* row = F.PROJ() + (size_t)(MPR + sq) * LDP;
    r.k8 = *(const u32x4*)(row + C_K + h * 128 + kg * 8); r.q8 = *(const u32x4*)(row + C_Q + h * 128 + kg * 8);
    r.v = bf2f(row[C_V + h * 128 + dvq * 32 + e]);
    const float* sm = F.SMALL() + (size_t)(MPR + sq) * 64;
    r.araw = sm[40 + h]; r.braw = sm[32 + h];
}
__device__ __forceinline__ void gdn_smp_run(const Frame& F, int it, int e, int kg, const GdnSmpIn& r) {
    const int sq = it >> 5, h = (it >> 2) & 7, dvq = it & 3;
    const float eg = __expf(-__expf(F.in[18][h]) * softplusf_(r.araw + F.in[17][h])), bt = sigmoidf_(r.braw);
    float k8[8], q8[8]; unpack8(r.k8, k8); unpack8(r.q8, q8);
    float ks = 0.f;
#pragma unroll
    for (int j = 0; j < 8; ++j) ks += k8[j] * r.S[j];
    ks += __shfl_xor(ks, 1); ks += __shfl_xor(ks, 2); ks += __shfl_xor(ks, 4); ks += __shfl_xor(ks, 8);
    const float vn = bt * (r.v - eg * ks);
    float op = 0.f, Sn[8];
#pragma unroll
    for (int j = 0; j < 8; ++j) { Sn[j] = eg * r.S[j] + k8[j] * vn; op += q8[j] * Sn[j]; }
    op += __shfl_xor(op, 1); op += __shfl_xor(op, 2); op += __shfl_xor(op, 4); op += __shfl_xor(op, 8);
    float* dp = F.out + O_GDNS + ((size_t)(sq * 8 + h) * 128 + kg * 8) * 128 + dvq * 32 + e;
#pragma unroll
    for (int j = 0; j < 8; ++j) dp[(size_t)j * 128] = Sn[j];
    if (kg == 0) { const unsigned w = cvt_pk_bf16(op, 0.f); F.PROJ()[(size_t)(MPR + sq) * LDP + C_V + h * 128 + dvq * 32 + e] = (bf16_t)(w & 0xffffu); }
}
__device__ __forceinline__ void gdn_sample_stream(const Frame& F, int first) {
    const int e = F.tid >> 4, kg = F.tid & 15;
    constexpr int NIT = NSMP * 32;
    for (int it0 = first; it0 < NIT; it0 += 4 * F.G) {
        GdnSmpIn r[4];
#pragma unroll
        for (int j = 0; j < 4; ++j) if (it0 + j * F.G < NIT) gdn_smp_load(F, it0 + j * F.G, e, kg, r[j]);
#pragma unroll
        for (int j = 0; j < 4; ++j) if (it0 + j * F.G < NIT) gdn_smp_run(F, it0 + j * F.G, e, kg, r[j]);
    }
}


__device__ __forceinline__ void ssd_chunked(Frame& F, int item, int& sit) {
    (void)sit;
    const int b = item >> 5, h = item & 31, g4 = h >> 3;
    const int tid = F.tid, lane = F.lane, w = F.wave, i16 = lane & 15, g = lane >> 4;
    LAS unsigned char* L = F.lds;
    constexpr int PB = 272, PX = 144, PY = 260;
    constexpr int SET = 45120, O_BT = 0, O_CT = 17408, O_XT = 34816, O_SC = 44032;
    constexpr int O_XD = 2 * SET, O_MT = O_XD + 9216, O_SL = O_MT + 9216, O_YT = O_SL + 17408;
    static_assert(O_YT + 64 * PY <= MISC_OFF, "ssd LDS map");
    LAS float* acumA = (LAS float*)(L + O_SC); LAS float* dtlA = acumA + 64; LAS float* sclA = acumA + 128; LAS float* eacA = acumA + 192; LAS float* cdecpA = acumA + 256;
    LAS float* acumB = (LAS float*)(L + SET + O_SC); LAS float* dtlB = acumB + 64; LAS float* sclB = acumB + 128; LAS float* eacB = acumB + 192; LAS float* cdecpB = acumB + 256;
    __syncthreads();
    for (int u = tid; u < 17408 / 16; u += 512) *(LAS u32x4*)(L + O_SL + u * 16) = (u32x4){0u, 0u, 0u, 0u};
    f32x4 sacc[4];
#pragma unroll
    for (int pb = 0; pb < 4; ++pb) sacc[pb] = (f32x4){0.f, 0.f, 0.f, 0.f};
    const float a_h = -__expf(F.in[13][h]), dtb = F.in[12][h], Dh = F.in[14][h];
    const int row00 = b * SEQ;
    u32x4 rbA[2], rcA[2], rxA, rzA, rbB[2], rcB[2], rxB, rzB, zsA, zsB; float rdtA = 0.f, rdtB = 0.f;
    zsA = (u32x4){0u, 0u, 0u, 0u}; zsB = zsA;
    float* SSY = (float*)(F.ws + WS_SSY);
    const int br0 = tid >> 4, bc8 = (tid & 15) * 8;
    const int xr = tid >> 3, xc8 = (tid & 7) * 8;
#define SSD_LOADA(c) do { const bf16_t* src = F.PROJ() + (size_t)(row00 + (c) * 64) * LDP; \
        rbA[0] = *(const u32x4*)(src + (size_t)br0 * LDP + C_B + g4 * 128 + bc8); rbA[1] = *(const u32x4*)(src + (size_t)(br0 + 32) * LDP + C_B + g4 * 128 + bc8); \
        rcA[0] = *(const u32x4*)(src + (size_t)br0 * LDP + C_C + g4 * 128 + bc8); rcA[1] = *(const u32x4*)(src + (size_t)(br0 + 32) * LDP + C_C + g4 * 128 + bc8); \
        rxA = *(const u32x4*)(src + (size_t)xr * LDP + C_XS + h * 64 + xc8); \
        rzA = *(const u32x4*)(src + (size_t)xr * LDP + C_Z + h * 64 + xc8); \
        if (tid < 64) rdtA = F.SMALL()[(size_t)(row00 + (c) * 64 + tid) * 64 + h]; } while (0)
#define SSD_LOADB(c) do { const bf16_t* src = F.PROJ() + (size_t)(row00 + (c) * 64) * LDP; \
        rbB[0] = *(const u32x4*)(src + (size_t)br0 * LDP + C_B + g4 * 128 + bc8); rbB[1] = *(const u32x4*)(src + (size_t)(br0 + 32) * LDP + C_B + g4 * 128 + bc8); \
        rcB[0] = *(const u32x4*)(src + (size_t)br0 * LDP + C_C + g4 * 128 + bc8); rcB[1] = *(const u32x4*)(src + (size_t)(br0 + 32) * LDP + C_C + g4 * 128 + bc8); \
        rxB = *(const u32x4*)(src + (size_t)xr * LDP + C_XS + h * 64 + xc8); \
        rzB = *(const u32x4*)(src + (size_t)xr * LDP + C_Z + h * 64 + xc8); \
        if (tid < 64) rdtB = F.SMALL()[(size_t)(row00 + (c) * 64 + tid) * 64 + h]; } while (0)
#define SSD_STAGE(Q, QS) do { \
        *(LAS u32x4*)(L + QS * SET + O_BT + br0 * PB + bc8 * 2) = rb##Q[0]; *(LAS u32x4*)(L + QS * SET + O_BT + (br0 + 32) * PB + bc8 * 2) = rb##Q[1]; \
        *(LAS u32x4*)(L + QS * SET + O_CT + br0 * PB + bc8 * 2) = rc##Q[0]; *(LAS u32x4*)(L + QS * SET + O_CT + (br0 + 32) * PB + bc8 * 2) = rc##Q[1]; \
        *(LAS u32x4*)(L + QS * SET + O_XT + xr * PX + xc8 * 2) = rx##Q; zs##Q = rz##Q; \
        if (tid < 64) { \
            const float dt_ = softplusf_(rdt##Q + dtb); float v_ = dt_ * a_h; \
            _Pragma("unroll") for (int o_ = 1; o_ < 64; o_ <<= 1) { const float t_ = __shfl_up(v_, o_); if (lane >= o_) v_ += t_; } \
            const float last_ = __shfl(v_, 63); \
            acum##Q[lane] = v_; dtl##Q[lane] = dt_; scl##Q[lane] = dt_ * __expf(last_ - v_); eac##Q[lane] = __expf(v_); \
            if (lane == 63) cdecp##Q[0] = __expf(v_); } } while (0)
    SSD_LOADA(0); SSD_LOADB(1);
    SSD_STAGE(A, 0);
    SSD_LOADA(2);
    for (int c2 = 0; c2 < SEQ / 128; ++c2) {
        { const int c = 2 * c2;
        LDS_BARRIER();
        if (c > 0) {
            float o[8], z8[8]; unpack8(zsB, z8); float ss = 0.f;
#pragma unroll
            for (int i = 0; i < 8; ++i) { o[i] = *(LAS const float*)(L + O_YT + xr * PY + (xc8 + i) * 4) * siluf_(z8[i]); ss += o[i] * o[i]; }
            *(u32x4*)(F.PROJ() + (size_t)(row00 + (c - 1) * 64 + xr) * LDP + C_XS + h * 64 + xc8) = pack8(o);
            ss += __shfl_xor(ss, 1); ss += __shfl_xor(ss, 2); ss += __shfl_xor(ss, 4);
            if ((tid & 7) == 0) atomicAdd(SSY + (size_t)(row00 + (c - 1) * 64 + xr) * 4 + g4, ss);
        }
        if (c + 1 < SEQ / 64) {
            SSD_STAGE(B, 1);
            if (c + 3 < SEQ / 64) SSD_LOADB(c + 3);
        }
        { float x8[8]; unpack8(*(LAS const u32x4*)(L + 0 * SET + O_XT + xr * PX + xc8 * 2), x8); const float sc = sclA[xr];
#pragma unroll
          for (int i = 0; i < 8; ++i) x8[i] *= sc;
          *(LAS u32x4*)(L + O_XD + xr * PX + xc8 * 2) = pack8(x8); }
#pragma unroll
        for (int tt = 0; tt < 2; ++tt) {
            const int t = 2 * w + tt, lb = t >> 2, sb = t & 3;
            const int l = 16 * lb + i16;
            u32x2 mw = (u32x2){0u, 0u};
            if (sb <= lb) {
                f32x4 acc = (f32x4){0.f, 0.f, 0.f, 0.f};
#pragma unroll
                for (int ks = 0; ks < 4; ++ks) acc = MFMA16(row_frag(L + 0 * SET + O_BT, PB, 16 * sb, 32 * ks, lane), row_frag(L + 0 * SET + O_CT, PB, 16 * lb, 32 * ks, lane), acc);
                const float al = acumA[l];
                float mv[4];
#pragma unroll
                for (int r = 0; r < 4; ++r) { const int s = 16 * sb + 4 * g + r; const float e = __expf(al - acumA[s]) * dtlA[s] * acc[r]; mv[r] = (s <= l) ? e : 0.f; }
                mw = pack4(mv[0], mv[1], mv[2], mv[3]);
            }
            *(LAS u32x2*)(L + O_MT + l * PX + (16 * sb + 4 * g) * 2) = mw;
        }
        f32x4 yacc[2];
        const int lb = w >> 1;
#pragma unroll
        for (int tt = 0; tt < 2; ++tt) {
            const int pb = 2 * (w & 1) + tt;
            f32x4 acc = (f32x4){0.f, 0.f, 0.f, 0.f};
#pragma unroll
            for (int ks = 0; ks < 4; ++ks) acc = MFMA16(row_frag(L + 0 * SET + O_CT, PB, 16 * lb, 32 * ks, lane), row_frag(L + O_SL, PB, 16 * pb, 32 * ks, lane), acc);
#pragma unroll
            for (int r = 0; r < 4; ++r) acc[r] *= eacA[16 * lb + 4 * g + r];
            yacc[tt] = acc;
        }
        LDS_BARRIER();
#pragma unroll
        for (int tt = 0; tt < 2; ++tt) {
            const int pb = 2 * (w & 1) + tt;
            f32x4 acc = yacc[tt];
            acc = MFMA16(row_frag(L + O_MT, PX, 16 * lb, 0, lane), tr_frag(L + 0 * SET + O_XT, PX, 0, 16 * pb, lane), acc);
            if (lb >= 2) acc = MFMA16(row_frag(L + O_MT, PX, 16 * lb, 32, lane), tr_frag(L + 0 * SET + O_XT, PX, 32, 16 * pb, lane), acc);
#pragma unroll
            for (int r = 0; r < 4; ++r) { const int l = 16 * lb + 4 * g + r, p = 16 * pb + i16;
                const float xv = bf2f(*(LAS const bf16_t*)(L + 0 * SET + O_XT + l * PX + p * 2));
                *(LAS float*)(L + O_YT + l * PY + p * 4) = acc[r] + Dh * xv; }
        }
        { const float cdec = cdecpA[0];
#pragma unroll
          for (int pb = 0; pb < 4; ++pb) sacc[pb] *= cdec;
#pragma unroll
          for (int ks = 0; ks < 2; ++ks) {
              const bf16x8 a = tr_frag(L + 0 * SET + O_BT, PB, 32 * ks, 16 * w, lane);
#pragma unroll
              for (int pb = 0; pb < 4; ++pb) sacc[pb] = MFMA16(a, tr_frag(L + O_XD, PX, 32 * ks, 16 * pb, lane), sacc[pb]);
          }
#pragma unroll
          for (int pb = 0; pb < 4; ++pb) *(LAS u32x2*)(L + O_SL + (16 * pb + i16) * PB + (16 * w + 4 * g) * 2) = pack4(sacc[pb][0], sacc[pb][1], sacc[pb][2], sacc[pb][3]);
        }
        }
        { const int c = 2 * c2 + 1;
        LDS_BARRIER();
        if (c > 0) {
            float o[8], z8[8]; unpack8(zsA, z8); float ss = 0.f;
#pragma unroll
            for (int i = 0; i < 8; ++i) { o[i] = *(LAS const float*)(L + O_YT + xr * PY + (xc8 + i) * 4) * siluf_(z8[i]); ss += o[i] * o[i]; }
            *(u32x4*)(F.PROJ() + (size_t)(row00 + (c - 1) * 64 + xr) * LDP + C_XS + h * 64 + xc8) = pack8(o);
            ss += __shfl_xor(ss, 1); ss += __shfl_xor(ss, 2); ss += __shfl_xor(ss, 4);
            if ((tid & 7) == 0) atomicAdd(SSY + (size_t)(row00 + (c - 1) * 64 + xr) * 4 + g4, ss);
        }
        if (c + 1 < SEQ / 64) {
            SSD_STAGE(A, 0);
            if (c + 3 < SEQ / 64) SSD_LOADA(c + 3);
        }
        { float x8[8]; unpack8(*(LAS const u32x4*)(L + 1 * SET + O_XT + xr * PX + xc8 * 2), x8); const float sc = sclB[xr];
#pragma unroll
          for (int i = 0; i < 8; ++i) x8[i] *= sc;
          *(LAS u32x4*)(L + O_XD + xr * PX + xc8 * 2) = pack8(x8); }
#pragma unroll
        for (int tt = 0; tt < 2; ++tt) {
            const int t = 2 * w + tt, lb = t >> 2, sb = t & 3;
            const int l = 16 * lb + i16;
            u32x2 mw = (u32x2){0u, 0u};
            if (sb <= lb) {
                f32x4 acc = (f32x4){0.f, 0.f, 0.f, 0.f};
#pragma unroll
                for (int ks = 0; ks < 4; ++ks) acc = MFMA16(row_frag(L + 1 * SET + O_BT, PB, 16 * sb, 32 * ks, lane), row_frag(L + 1 * SET + O_CT, PB, 16 * lb, 32 * ks, lane), acc);
                const float al = acumB[l];
                float mv[4];
#pragma unroll
                for (int r = 0; r < 4; ++r) { const int s = 16 * sb + 4 * g + r; const float e = __expf(al - acumB[s]) * dtlB[s] * acc[r]; mv[r] = (s <= l) ? e : 0.f; }
                mw = pack4(mv[0], mv[1], mv[2], mv[3]);
            }
            *(LAS u32x2*)(L + O_MT + l * PX + (16 * sb + 4 * g) * 2) = mw;
        }
        f32x4 yacc[2];
        const int lb = w >> 1;
#pragma unroll
        for (int tt = 0; tt < 2; ++tt) {
            const int pb = 2 * (w & 1) + tt;
            f32x4 acc = (f32x4){0.f, 0.f, 0.f, 0.f};
#pragma unroll
            for (int ks = 0; ks < 4; ++ks) acc = MFMA16(row_frag(L + 1 * SET + O_CT, PB, 16 * lb, 32 * ks, lane), row_frag(L + O_SL, PB, 16 * pb, 32 * ks, lane), acc);
#pragma unroll
            for (int r = 0; r < 4; ++r) acc[r] *= eacB[16 * lb + 4 * g + r];
            yacc[tt] = acc;
        }
        LDS_BARRIER();
#pragma unroll
        for (int tt = 0; tt < 2; ++tt) {
            const int pb = 2 * (w & 1) + tt;
            f32x4 acc = yacc[tt];
            acc = MFMA16(row_frag(L + O_MT, PX, 16 * lb, 0, lane), tr_frag(L + 1 * SET + O_XT, PX, 0, 16 * pb, lane), acc);
            if (lb >= 2) acc = MFMA16(row_frag(L + O_MT, PX, 16 * lb, 32, lane), tr_frag(L + 1 * SET + O_XT, PX, 32, 16 * pb, lane), acc);
#pragma unroll
            for (int r = 0; r < 4; ++r) { const int l = 16 * lb + 4 * g + r, p = 16 * pb + i16;
                const float xv = bf2f(*(LAS const bf16_t*)(L + 1 * SET + O_XT + l * PX + p * 2));
                *(LAS float*)(L + O_YT + l * PY + p * 4) = acc[r] + Dh * xv; }
        }
        { const float cdec = cdecpB[0];
#pragma unroll
          for (int pb = 0; pb < 4; ++pb) sacc[pb] *= cdec;
#pragma unroll
          for (int ks = 0; ks < 2; ++ks) {
              const bf16x8 a = tr_frag(L + 1 * SET + O_BT, PB, 32 * ks, 16 * w, lane);
#pragma unroll
              for (int pb = 0; pb < 4; ++pb) sacc[pb] = MFMA16(a, tr_frag(L + O_XD, PX, 32 * ks, 16 * pb, lane), sacc[pb]);
          }
#pragma unroll
          for (int pb = 0; pb < 4; ++pb) *(LAS u32x2*)(L + O_SL + (16 * pb + i16) * PB + (16 * w + 4 * g) * 2) = pack4(sacc[pb][0], sacc[pb][1], sacc[pb][2], sacc[pb][3]);
        }
        }
    }
    LDS_BARRIER();
    {
        float o[8], z8[8]; unpack8(zsB, z8); float ss = 0.f;
#pragma unroll
        for (int i = 0; i < 8; ++i) { o[i] = *(LAS const float*)(L + O_YT + xr * PY + (xc8 + i) * 4) * siluf_(z8[i]); ss += o[i] * o[i]; }
        *(u32x4*)(F.PROJ() + (size_t)(row00 + (SEQ / 64 - 1) * 64 + xr) * LDP + C_XS + h * 64 + xc8) = pack8(o);
        ss += __shfl_xor(ss, 1); ss += __shfl_xor(ss, 2); ss += __shfl_xor(ss, 4);
        if ((tid & 7) == 0) atomicAdd(SSY + (size_t)(row00 + (SEQ / 64 - 1) * 64 + xr) * 4 + g4, ss);
    }
#undef SSD_LOADA
#undef SSD_LOADB
#undef SSD_STAGE
#pragma unroll
    for (int pb = 0; pb < 4; ++pb) *(f32x4*)(F.out + O_SSMP + ((size_t)(b * 32 + h) * 64 + 16 * pb + i16) * 128 + 16 * w + 4 * g) = sacc[pb];
}


__device__ __forceinline__ void gdn_prep(Frame& F, int it, int hb) {
    const int c = it & 31, bh = it >> 5, h = bh & 7, b = bh >> 3;
    const int ht = F.tid & 255, lane = F.lane, hw = F.wave & 3, i16 = lane & 15, g = lane >> 4;
    LAS unsigned char* L = F.lds + hb * 65536;
    constexpr int PB = 272;
    constexpr int O_KT = 0, O_QT = 17408, O_VT = 34816, O_SC = 52224;
    LAS float* gc = (LAS float*)(L + O_SC); LAS float* bt = gc + 64; LAS float* egc = gc + 128;
    const int row0 = b * SEQ + c * 64;
    __syncthreads();
    {
        u32x4 rk[4], rq[4], rv[4];
#pragma unroll
        for (int j = 0; j < 4; ++j) { const int pc = ht + j * 256, r = pc >> 4, c8 = (pc & 15) * 8; const bf16_t* src = F.PROJ() + (size_t)(row0 + r) * LDP + h * 128 + c8;
            rk[j] = *(const u32x4*)(src + C_K); rq[j] = *(const u32x4*)(src + C_Q); rv[j] = *(const u32x4*)(src + C_V); }
        if (ht < 64) {
            const float* sm = F.SMALL() + (size_t)(row0 + lane) * 64;
            const float na = -__expf(F.in[18][h]), dtb = F.in[17][h];
            float v = na * softplusf_(sm[40 + h] + dtb);
            const float be = sigmoidf_(sm[32 + h]);
#pragma unroll
            for (int o = 1; o < 64; o <<= 1) { const float t = __shfl_up(v, o); if (lane >= o) v += t; }
            gc[lane] = v; bt[lane] = be; egc[lane] = __expf(v);
            ((float*)(F.ws + WS_GC))[(size_t)it * 64 + lane] = v;
        }
#pragma unroll
        for (int j = 0; j < 4; ++j) { const int pc = ht + j * 256, r = pc >> 4, c8 = (pc & 15) * 8;
            *(LAS u32x4*)(L + O_KT + r * PB + c8 * 2) = rk[j]; *(LAS u32x4*)(L + O_QT + r * PB + c8 * 2) = rq[j]; *(LAS u32x4*)(L + O_VT + r * PB + c8 * 2) = rv[j]; }
    }
    __syncthreads();
    f32x4 kk[4];
    const int lb = hw;
    bf16_t* qkm = (bf16_t*)(F.ws + WS_QKM) + (size_t)it * 4096;
#pragma unroll
    for (int sb = 0; sb < 4; ++sb) {
        kk[sb] = (f32x4){0.f, 0.f, 0.f, 0.f};
        const int l = 16 * lb + i16;
        u32x2 qw = (u32x2){0u, 0u};
        if (sb <= lb) {
            f32x4 qa = (f32x4){0.f, 0.f, 0.f, 0.f};
#pragma unroll
            for (int ks = 0; ks < 4; ++ks) {
                const bf16x8 ks_ = row_frag(L + O_KT, PB, 16 * sb, 32 * ks, lane);
                kk[sb] = MFMA16(row_frag(L + O_KT, PB, 16 * lb, 32 * ks, lane), ks_, kk[sb]);
                qa = MFMA16(ks_, row_frag(L + O_QT, PB, 16 * lb, 32 * ks, lane), qa);
            }
            const float gl = gc[l];
            float qv[4];
#pragma unroll
            for (int r = 0; r < 4; ++r) { const int s_ = 16 * sb + 4 * g + r; const float e = __expf(gl - gc[s_]) * qa[r]; qv[r] = (s_ <= l) ? e : 0.f; }
            qw = pack4(qv[0], qv[1], qv[2], qv[3]);
        }
        *(u32x2*)(qkm + l * 64 + 16 * sb + 4 * g) = qw;
    }
    __syncthreads();
#pragma unroll
    for (int sb = 0; sb < 4; ++sb) {
        if (sb <= lb) {
#pragma unroll
            for (int r = 0; r < 4; ++r) { const int l = 16 * lb + 4 * g + r, s_ = 16 * sb + i16;
                const float a = (s_ < l) ? bt[l] * kk[sb][r] * __expf(gc[l] - gc[s_]) : 0.f;
                *(LAS float*)(L + O_QT + l * PB + s_ * 4) = a; }
        }
    }
    __syncthreads();
    float x[64];
    {
        const bool isv = ht < 128;
        LAS const unsigned char* colp = L + (isv ? O_VT : O_KT) + (ht & 127) * 2;
#pragma unroll
        for (int l = 0; l < 64; ++l) { const float v = bf2f(*(LAS const bf16_t*)(colp + l * PB)); x[l] = v * bt[l] * (isv ? 1.0f : egc[l]); }
    }
#pragma unroll
    for (int l = 1; l < 64; ++l) {
        float acc0 = x[l], acc1 = 0.f;
#pragma unroll
        for (int s4 = 0; s4 < (l + 3) / 4; ++s4) {
            const f32x4 a = *(LAS const f32x4*)(L + O_QT + l * PB + s4 * 16);
#pragma unroll
            for (int j = 0; j < 4; ++j) if (4 * s4 + j < l) { if (j & 1) asm("v_fma_f32 %0, -%1, %2, %0" : "+v"(acc1) : "v"(a[j]), "v"(x[4 * s4 + j])); else asm("v_fma_f32 %0, -%1, %2, %0" : "+v"(acc0) : "v"(a[j]), "v"(x[4 * s4 + j])); }
        }
        x[l] = acc0 + acc1;
        asm volatile("" ::: "memory");
    }
    {
        const bool isv = ht < 128;
        bf16_t* dst = (bf16_t*)(F.ws + (isv ? WS_UT : WS_WT)) + (size_t)it * 8192 + (ht & 127) * 64;
        const float sg = isv ? 1.0f : -1.0f;
#pragma unroll
        for (int q8 = 0; q8 < 8; ++q8) { float o[8];
#pragma unroll
            for (int i = 0; i < 8; ++i) o[i] = sg * x[8 * q8 + i];
            *(u32x4*)(dst + 8 * q8) = pack8(o); }
    }
}

__device__ __forceinline__ bf16x8 frag2(u32x2 lo, u32x2 hi) { return __builtin_bit_cast(bf16x8, (u32x4){lo.x, lo.y, hi.x, hi.y}); }
__device__ __forceinline__ void gdn_prep3(Frame& F, int it, int hb) {
    const int c = it & 31, bh = it >> 5, h = bh & 7, b = bh >> 3;
    const int ht = F.tid & 255, lane = F.lane, hw = F.wave & 3, i16 = lane & 15, g = lane >> 4;
    LAS unsigned char* L = F.lds + hb * 65536;
    constexpr int PB = 272, PAL = 136, PAD = 80, PLI = 40;
    constexpr int O_KT = 0, O_QT = 17408, O_VT = 34816, O_SC = 52224, O_LI = 53248;
    constexpr int O_AL = O_QT, O_AD = O_QT + 8704;
    LAS float* gc = (LAS float*)(L + O_SC); LAS float* bt = gc + 64; LAS float* egc = gc + 128;
    const int row0 = b * SEQ + c * 64;
    __syncthreads();
    {
        u32x4 rk[4], rq[4], rv[4];
#pragma unroll
        for (int j = 0; j < 4; ++j) { const int pc = ht + j * 256, r = pc >> 4, c8 = (pc & 15) * 8; const bf16_t* src = F.PROJ() + (size_t)(row0 + r) * LDP + h * 128 + c8;
            rk[j] = *(const u32x4*)(src + C_K); rq[j] = *(const u32x4*)(src + C_Q); rv[j] = *(const u32x4*)(src + C_V); }
        if (ht < 64) {
            const float* sm = F.SMALL() + (size_t)(row0 + lane) * 64;
            const float na = -__expf(F.in[18][h]), dtb = F.in[17][h];
            float v = na * softplusf_(sm[40 + h] + dtb);
            const float be = sigmoidf_(sm[32 + h]);
#pragma unroll
            for (int o = 1; o < 64; o <<= 1) { const float t = __shfl_up(v, o); if (lane >= o) v += t; }
            gc[lane] = v; bt[lane] = be; egc[lane] = __expf(v);
            ((float*)(F.ws + WS_GC))[(size_t)it * 64 + lane] = v;
        }
#pragma unroll
        for (int j = 0; j < 4; ++j) { const int pc = ht + j * 256, r = pc >> 4, c8 = (pc & 15) * 8;
            *(LAS u32x4*)(L + O_KT + r * PB + c8 * 2) = rk[j]; *(LAS u32x4*)(L + O_QT + r * PB + c8 * 2) = rq[j]; *(LAS u32x4*)(L + O_VT + r * PB + c8 * 2) = rv[j]; }
    }
    __syncthreads();
    const int lb = hw, lq = 16 * lb + i16;
    bf16_t* qkm = (bf16_t*)(F.ws + WS_QKM) + (size_t)it * 4096;
    f32x4 kkt[4];
#pragma unroll
    for (int sb = 0; sb < 4; ++sb) {
        kkt[sb] = (f32x4){0.f, 0.f, 0.f, 0.f};
        u32x2 qw = (u32x2){0u, 0u};
        if (sb <= lb) {
            f32x4 qa = (f32x4){0.f, 0.f, 0.f, 0.f};
#pragma unroll
            for (int ks = 0; ks < 4; ++ks) {
                const bf16x8 ks_ = row_frag(L + O_KT, PB, 16 * sb, 32 * ks, lane);
                kkt[sb] = MFMA16(ks_, row_frag(L + O_KT, PB, 16 * lb, 32 * ks, lane), kkt[sb]);
                qa = MFMA16(ks_, row_frag(L + O_QT, PB, 16 * lb, 32 * ks, lane), qa);
            }
            const float gl = gc[lq];
            float qv[4];
#pragma unroll
            for (int r = 0; r < 4; ++r) { const int s_ = 16 * sb + 4 * g + r; const float e = __expf(gl - gc[s_]) * qa[r]; qv[r] = (s_ <= lq) ? e : 0.f; }
            qw = pack4(qv[0], qv[1], qv[2], qv[3]);
        }
        *(u32x2*)(qkm + lq * 64 + 16 * sb + 4 * g) = qw;
    }
    __syncthreads();
    {
        const float gl = gc[lq], bl = bt[lq];
#pragma unroll
        for (int sb = 0; sb < 4; ++sb) {
            if (sb <= lb) {
                float a[4];
#pragma unroll
                for (int r = 0; r < 4; ++r) { const int s_ = 16 * sb + 4 * g + r; const float e = bl * kkt[sb][r] * __expf(gl - gc[s_]); a[r] = (s_ < lq) ? e : 0.f; }
                if (sb < lb) *(LAS u32x2*)(L + O_AL + lq * PAL + (16 * sb + 4 * g) * 2) = pack4(-a[0], -a[1], -a[2], -a[3]);
                else         *(LAS f32x4*)(L + O_AD + lb * (16 * PAD) + i16 * PAD + g * 16) = (f32x4){a[0], a[1], a[2], a[3]};
            }
        }
    }
    f32x4 R[4][4];
    {
        const bool isv = hw < 2;
        LAS const unsigned char* colp = L + (isv ? O_VT : O_KT) + ((64 * hw + i16) & 127) * 2;
#pragma unroll
        for (int i = 0; i < 4; ++i)
#pragma unroll
            for (int r = 0; r < 4; ++r) { const int l = 16 * i + 4 * g + r; const float sc = bt[l] * (isv ? 1.0f : egc[l]);
#pragma unroll
                for (int ct = 0; ct < 4; ++ct) R[ct][i][r] = bf2f(*(LAS const bf16_t*)(colp + l * PB + ct * 32)) * sc; }
    }
    __syncthreads();
    if (lane < 16) {
        float x[16];
        LAS const unsigned char* ad = L + O_AD + hw * (16 * PAD);
#pragma unroll
        for (int l = 0; l < 16; ++l) {
            float acc = (l == lane) ? 1.0f : 0.f;
#pragma unroll
            for (int s4 = 0; s4 < (l + 3) / 4; ++s4) { const f32x4 a = *(LAS const f32x4*)(ad + l * PAD + s4 * 16);
#pragma unroll
                for (int j = 0; j < 4; ++j) if (4 * s4 + j < l) acc -= a[j] * x[4 * s4 + j]; }
            x[l] = acc;
            { const unsigned w = cvt_pk_bf16(acc, 0.f); *(LAS bf16_t*)(L + O_LI + hw * (16 * PLI) + l * PLI + lane * 2) = (bf16_t)(w & 0xffffu); }
        }
    }
    __syncthreads();
    {
        const bool isv = hw < 2;
        bf16_t* dst = (bf16_t*)(F.ws + (isv ? WS_UT : WS_WT)) + (size_t)it * 8192;
        const unsigned sgn = isv ? 0u : 0x80008000u;
        const u32x2 z2 = (u32x2){0u, 0u};
        u32x2 li[4];
#pragma unroll
        for (int i = 0; i < 4; ++i) li[i] = *(LAS const u32x2*)(L + O_LI + i * (16 * PLI) + i16 * PLI + 4 * g * 2);
#pragma unroll
        for (int ct = 0; ct < 4; ++ct) {
            u32x2 xb[4];
#pragma unroll
            for (int i = 0; i < 4; ++i) {
                f32x4 y = R[ct][i];
                if (i >= 1) {
                    const u32x2 a0 = *(LAS const u32x2*)(L + O_AL + (16 * i + i16) * PAL + (0 + 4 * g) * 2);
                    const u32x2 a1 = i >= 2 ? *(LAS const u32x2*)(L + O_AL + (16 * i + i16) * PAL + (16 + 4 * g) * 2) : z2;
                    y = MFMA16(frag2(a0, a1), frag2(xb[0], i >= 2 ? xb[1] : z2), y);
                }
                if (i == 3) {
                    const u32x2 a2 = *(LAS const u32x2*)(L + O_AL + (48 + i16) * PAL + (32 + 4 * g) * 2);
                    y = MFMA16(frag2(a2, z2), frag2(xb[2], z2), y);
                }
                const f32x4 zacc = {0.f, 0.f, 0.f, 0.f};
                const f32x4 x = MFMA16(frag2(li[i], z2), frag2(pack4(y[0], y[1], y[2], y[3]), z2), zacc);
                xb[i] = pack4(x[0], x[1], x[2], x[3]);
                *(u32x2*)(dst + ((64 * hw + 16 * ct + i16) & 127) * 64 + 16 * i + 4 * g) = (u32x2){xb[i].x ^ sgn, xb[i].y ^ sgn};
            }
        }
    }
}

__device__ __forceinline__ void gdn_scan(Frame& F, int item, int& sit) {
    (void)sit;
    const int dvq = item & 3, bh = item >> 2, h = bh & 7, b = bh >> 3;
    const int tid = F.tid, lane = F.lane, w = F.wave, i16 = lane & 15, g = lane >> 4;
    LAS unsigned char* L = F.lds;
    constexpr int PB = 272, PX = 144, PO = 132;
    constexpr int SET = 67072, O_WT = 0, O_QG = 18432, O_KG = 35840, O_QK = 53248, O_UT = 62464;
    constexpr int O_ST = 2 * SET, O_VN = O_ST + 8704, O_OT = O_VN + 4608;
    static_assert(O_OT + 64 * PO <= MISC_OFF, "gdn LDS map");
    __syncthreads();
    for (int u = tid; u < 8704 / 16; u += 512) *(LAS u32x4*)(L + O_ST + u * 16) = (u32x4){0u, 0u, 0u, 0u};
    f32x4 sacc[2];
    sacc[0] = (f32x4){0.f, 0.f, 0.f, 0.f}; sacc[1] = sacc[0];
    const int lb = w >> 1, eb = w & 1;
    const int r0 = tid >> 4, c8a = (tid & 15) * 8;
    const int xr = tid >> 3, xc8 = (tid & 7) * 8;
    const float* GC = (const float*)(F.ws + WS_GC);
    u32x4 rwA[2], rqA[2], rkA[2], rqkA, ruA, rgA, rwB[2], rqB[2], rkB[2], rqkB, ruB, rgB, gsA, gsB;
    gsA = (u32x4){0u, 0u, 0u, 0u}; gsB = gsA;
    float* SSO = (float*)(F.ws + WS_SSO); const float* gg = F.in[19];
    float gq0A = 0.f, gq1A = 0.f, glastA = 0.f, gq0B = 0.f, gq1B = 0.f, glastB = 0.f, glvA = 1.f, glvB = 1.f;
#define GDN_LOADA(c) do { const size_t it_ = (size_t)bh * 32 + (c); \
        const bf16_t* wt = (const bf16_t*)(F.ws + WS_WT) + it_ * 8192; rwA[0] = *(const u32x4*)(wt + xr * 64 + xc8); rwA[1] = *(const u32x4*)(wt + (xr + 64) * 64 + xc8); \
        const bf16_t* src = F.PROJ() + (size_t)(b * SEQ + (c) * 64) * LDP + h * 128 + c8a; \
        rqA[0] = *(const u32x4*)(src + (size_t)r0 * LDP + C_Q); rqA[1] = *(const u32x4*)(src + (size_t)(r0 + 32) * LDP + C_Q); \
        rkA[0] = *(const u32x4*)(src + (size_t)r0 * LDP + C_K); rkA[1] = *(const u32x4*)(src + (size_t)(r0 + 32) * LDP + C_K); \
        rqkA = *(const u32x4*)((const bf16_t*)(F.ws + WS_QKM) + it_ * 4096 + xr * 64 + xc8); \
        if (tid < 256) ruA = *(const u32x4*)((const bf16_t*)(F.ws + WS_UT) + it_ * 8192 + (dvq * 32 + xr) * 64 + xc8); \
        if (tid < 256) rgA = *(const u32x4*)(F.PROJ() + (size_t)(b * SEQ + (c) * 64 + (tid >> 2)) * LDP + C_GATE + h * 128 + dvq * 32 + (tid & 3) * 8); \
        gq0A = GC[it_ * 64 + r0]; gq1A = GC[it_ * 64 + r0 + 32]; glastA = GC[it_ * 64 + 63]; } while (0)
#define GDN_LOADB(c) do { const size_t it_ = (size_t)bh * 32 + (c); \
        const bf16_t* wt = (const bf16_t*)(F.ws + WS_WT) + it_ * 8192; rwB[0] = *(const u32x4*)(wt + xr * 64 + xc8); rwB[1] = *(const u32x4*)(wt + (xr + 64) * 64 + xc8); \
        const bf16_t* src = F.PROJ() + (size_t)(b * SEQ + (c) * 64) * LDP + h * 128 + c8a; \
        rqB[0] = *(const u32x4*)(src + (size_t)r0 * LDP + C_Q); rqB[1] = *(const u32x4*)(src + (size_t)(r0 + 32) * LDP + C_Q); \
        rkB[0] = *(const u32x4*)(src + (size_t)r0 * LDP + C_K); rkB[1] = *(const u32x4*)(src + (size_t)(r0 + 32) * LDP + C_K); \
        rqkB = *(const u32x4*)((const bf16_t*)(F.ws + WS_QKM) + it_ * 4096 + xr * 64 + xc8); \
        if (tid < 256) ruB = *(const u32x4*)((const bf16_t*)(F.ws + WS_UT) + it_ * 8192 + (dvq * 32 + xr) * 64 + xc8); \
        if (tid < 256) rgB = *(const u32x4*)(F.PROJ() + (size_t)(b * SEQ + (c) * 64 + (tid >> 2)) * LDP + C_GATE + h * 128 + dvq * 32 + (tid & 3) * 8); \
        gq0B = GC[it_ * 64 + r0]; gq1B = GC[it_ * 64 + r0 + 32]; glastB = GC[it_ * 64 + 63]; } while (0)
#define GDN_STAGE(Q, QS) do { \
        *(LAS u32x4*)(L + QS * SET + O_WT + xr * PX + xc8 * 2) = rw##Q[0]; *(LAS u32x4*)(L + QS * SET + O_WT + (xr + 64) * PX + xc8 * 2) = rw##Q[1]; \
        *(LAS u32x4*)(L + QS * SET + O_QK + xr * PX + xc8 * 2) = rqk##Q; \
        if (tid < 256) *(LAS u32x4*)(L + QS * SET + O_UT + xr * PX + xc8 * 2) = ru##Q; \
        gs##Q = rg##Q; glv##Q = __expf(glast##Q); \
        { float t8_[8]; const float eq0_ = __expf(gq0##Q), eq1_ = __expf(gq1##Q), ek0_ = __expf(glast##Q - gq0##Q), ek1_ = __expf(glast##Q - gq1##Q); \
          unpack8(rq##Q[0], t8_); _Pragma("unroll") for (int i_ = 0; i_ < 8; ++i_) t8_[i_] *= eq0_; *(LAS u32x4*)(L + QS * SET + O_QG + r0 * PB + c8a * 2) = pack8(t8_); \
          unpack8(rq##Q[1], t8_); _Pragma("unroll") for (int i_ = 0; i_ < 8; ++i_) t8_[i_] *= eq1_; *(LAS u32x4*)(L + QS * SET + O_QG + (r0 + 32) * PB + c8a * 2) = pack8(t8_); \
          unpack8(rk##Q[0], t8_); _Pragma("unroll") for (int i_ = 0; i_ < 8; ++i_) t8_[i_] *= ek0_; *(LAS u32x4*)(L + QS * SET + O_KG + r0 * PB + c8a * 2) = pack8(t8_); \
          unpack8(rk##Q[1], t8_); _Pragma("unroll") for (int i_ = 0; i_ < 8; ++i_) t8_[i_] *= ek1_; *(LAS u32x4*)(L + QS * SET + O_KG + (r0 + 32) * PB + c8a * 2) = pack8(t8_); } } while (0)
    GDN_LOADA(0); GDN_LOADB(1);
    GDN_STAGE(A, 0);
    GDN_LOADA(2);
    for (int c2 = 0; c2 < SEQ / 128; ++c2) {
        { const int c = 2 * c2;
        LDS_BARRIER();
        if (c > 0 && tid < 256) {
            const int r = tid >> 2, c8 = (tid & 3) * 8; float o[8], gt[8]; unpack8(gsB, gt); float ss = 0.f;
            const f32x4 g0 = *(const f32x4*)(gg + dvq * 32 + c8), g1 = *(const f32x4*)(gg + dvq * 32 + c8 + 4);
#pragma unroll
            for (int i = 0; i < 8; ++i) { const float ov = *(LAS const float*)(L + O_OT + r * PO + (c8 + i) * 4); ss += ov * ov; o[i] = ov * (i < 4 ? g0[i & 3] : g1[i & 3]) * siluf_(gt[i]); }
            *(u32x4*)(F.PROJ() + (size_t)(b * SEQ + (c - 1) * 64 + r) * LDP + C_B + h * 128 + dvq * 32 + c8) = pack8(o);
            ss += __shfl_xor(ss, 1); ss += __shfl_xor(ss, 2);
            if ((tid & 3) == 0) atomicAdd(SSO + (size_t)(b * SEQ + (c - 1) * 64 + r) * 8 + h, ss);
        }
        if (c + 1 < SEQ / 64) {
            GDN_STAGE(B, 1);
            if (c + 3 < SEQ / 64) GDN_LOADB(c + 3);
        }
        f32x4 vacc, oacc = (f32x4){0.f, 0.f, 0.f, 0.f};
        { const u32x2 uw = *(LAS const u32x2*)(L + 0 * SET + O_UT + (16 * eb + i16) * PX + (16 * lb + 4 * g) * 2);
          vacc = (f32x4){bflo(uw.x), bfhi(uw.x), bflo(uw.y), bfhi(uw.y)}; }
#pragma unroll
        for (int ks = 0; ks < 4; ++ks) {
            const bf16x8 bS = row_frag(L + O_ST, PB, 16 * eb, 32 * ks, lane);
            vacc = MFMA16(tr_frag(L + 0 * SET + O_WT, PX, 32 * ks, 16 * lb, lane), bS, vacc);
            oacc = MFMA16(row_frag(L + 0 * SET + O_QG, PB, 16 * lb, 32 * ks, lane), bS, oacc);
        }
        *(LAS u32x2*)(L + O_VN + (16 * eb + i16) * PX + (16 * lb + 4 * g) * 2) = pack4(vacc[0], vacc[1], vacc[2], vacc[3]);
        LDS_BARRIER();
        {
            const bf16x8 bV0 = row_frag(L + O_VN, PX, 16 * eb, 0, lane), bV1 = row_frag(L + O_VN, PX, 16 * eb, 32, lane);
            oacc = MFMA16(row_frag(L + 0 * SET + O_QK, PX, 16 * lb, 0, lane), bV0, oacc);
            if (lb >= 2) oacc = MFMA16(row_frag(L + 0 * SET + O_QK, PX, 16 * lb, 32, lane), bV1, oacc);
#pragma unroll
            for (int r = 0; r < 4; ++r) *(LAS float*)(L + O_OT + (16 * lb + 4 * g + r) * PO + (16 * eb + i16) * 4) = oacc[r];
#pragma unroll
            for (int t2 = 0; t2 < 2; ++t2) {
                const int db = 2 * lb + t2;
                f32x4 sa = sacc[t2] * glvA;
                sa = MFMA16(tr_frag(L + 0 * SET + O_KG, PB, 0, 16 * db, lane), bV0, sa);
                sa = MFMA16(tr_frag(L + 0 * SET + O_KG, PB, 32, 16 * db, lane), bV1, sa);
                sacc[t2] = sa;
                *(LAS u32x2*)(L + O_ST + (16 * eb + i16) * PB + (16 * db + 4 * g) * 2) = pack4(sa[0], sa[1], sa[2], sa[3]);
            }
        }
        }
        { const int c = 2 * c2 + 1;
        LDS_BARRIER();
        if (c > 0 && tid < 256) {
            const int r = tid >> 2, c8 = (tid & 3) * 8; float o[8], gt[8]; unpack8(gsA, gt); float ss = 0.f;
            const f32x4 g0 = *(const f32x4*)(gg + dvq * 32 + c8), g1 = *(const f32x4*)(gg + dvq * 32 + c8 + 4);
#pragma unroll
            for (int i = 0; i < 8; ++i) { const float ov = *(LAS const float*)(L + O_OT + r * PO + (c8 + i) * 4); ss += ov * ov; o[i] = ov * (i < 4 ? g0[i & 3] : g1[i & 3]) * siluf_(gt[i]); }
            *(u32x4*)(F.PROJ() + (size_t)(b * SEQ + (c - 1) * 64 + r) * LDP + C_B + h * 128 + dvq * 32 + c8) = pack8(o);
            ss += __shfl_xor(ss, 1); ss += __shfl_xor(ss, 2);
            if ((tid & 3) == 0) atomicAdd(SSO + (size_t)(b * SEQ + (c - 1) * 64 + r) * 8 + h, ss);
        }
        if (c + 1 < SEQ / 64) {
            GDN_STAGE(A, 0);
            if (c + 3 < SEQ / 64) GDN_LOADA(c + 3);
        }
        f32x4 vacc, oacc = (f32x4){0.f, 0.f, 0.f, 0.f};
        { const u32x2 uw = *(LAS const u32x2*)(L + 1 * SET + O_UT + (16 * eb + i16) * PX + (16 * lb + 4 * g) * 2);
          vacc = (f32x4){bflo(uw.x), bfhi(uw.x), bflo(uw.y), bfhi(uw.y)}; }
#pragma unroll
        for (int ks = 0; ks < 4; ++ks) {
            const bf16x8 bS = row_frag(L + O_ST, PB, 16 * eb, 32 * ks, lane);
            vacc = MFMA16(tr_frag(L + 1 * SET + O_WT, PX, 32 * ks, 16 * lb, lane), bS, vacc);
            oacc = MFMA16(row_frag(L + 1 * SET + O_QG, PB, 16 * lb, 32 * ks, lane), bS, oacc);
        }
        *(LAS u32x2*)(L + O_VN + (16 * eb + i16) * PX + (16 * lb + 4 * g) * 2) = pack4(vacc[0], vacc[1], vacc[2], vacc[3]);
        LDS_BARRIER();
        {
            const bf16x8 bV0 = row_frag(L + O_VN, PX, 16 * eb, 0, lane), bV1 = row_frag(L + O_VN, PX, 16 * eb, 32, lane);
            oacc = MFMA16(row_frag(L + 1 * SET + O_QK, PX, 16 * lb, 0, lane), bV0, oacc);
            if (lb >= 2) oacc = MFMA16(row_frag(L + 1 * SET + O_QK, PX, 16 * lb, 32, lane), bV1, oacc);
#pragma unroll
            for (int r = 0; r < 4; ++r) *(LAS float*)(L + O_OT + (16 * lb + 4 * g + r) * PO + (16 * eb + i16) * 4) = oacc[r];
#pragma unroll
            for (int t2 = 0; t2 < 2; ++t2) {
                const int db = 2 * lb + t2;
                f32x4 sa = sacc[t2] * glvB;
                sa = MFMA16(tr_frag(L + 1 * SET + O_KG, PB, 0, 16 * db, lane), bV0, sa);
                sa = MFMA16(tr_frag(L + 1 * SET + O_KG, PB, 32, 16 * db, lane), bV1, sa);
                sacc[t2] = sa;
                *(LAS u32x2*)(L + O_ST + (16 * eb + i16) * PB + (16 * db + 4 * g) * 2) = pack4(sa[0], sa[1], sa[2], sa[3]);
            }
        }
        }
    }
    LDS_BARRIER();
    if (tid < 256) {
        const int c = SEQ / 64, r = tid >> 2, c8 = (tid & 3) * 8; float o[8], gt[8]; unpack8(gsB, gt); float ss = 0.f;
        const f32x4 g0 = *(const f32x4*)(gg + dvq * 32 + c8), g1 = *(const f32x4*)(gg + dvq * 32 + c8 + 4);
#pragma unroll
        for (int i = 0; i < 8; ++i) { const float ov = *(LAS const float*)(L + O_OT + r * PO + (c8 + i) * 4); ss += ov * ov; o[i] = ov * (i < 4 ? g0[i & 3] : g1[i & 3]) * siluf_(gt[i]); }
        *(u32x4*)(F.PROJ() + (size_t)(b * SEQ + (c - 1) * 64 + r) * LDP + C_B + h * 128 + dvq * 32 + c8) = pack8(o);
        ss += __shfl_xor(ss, 1); ss += __shfl_xor(ss, 2);
        if ((tid & 3) == 0) atomicAdd(SSO + (size_t)(b * SEQ + (c - 1) * 64 + r) * 8 + h, ss);
    }
#undef GDN_LOADA
#undef GDN_LOADB
#undef GDN_STAGE
#pragma unroll
    for (int t2 = 0; t2 < 2; ++t2)
#pragma unroll
        for (int r = 0; r < 4; ++r) F.out[O_GDNP + ((size_t)bh * 128 + 16 * (2 * lb + t2) + 4 * g + r) * 128 + dvq * 32 + 16 * eb + i16] = sacc[t2][r];
}


template <class EpiQ>
__device__ __forceinline__ void small_gemm(Frame& F, const bf16_t* A, int lda, const bf16_t* Bt, int ldb, int K, int N, const EpiQ& q) {
    const int lane = F.lane, w = F.wave, i16 = lane & 15, g = lane >> 4, kp = w & 3, tw = w >> 2;
    LAS float* part = (LAS float*)F.lds;
    const int ntl = 8 * (N / 16), nsteps = K / 128;
    for (int t2 = blockIdx.x; 2 * t2 < ntl; t2 += F.G) {
        const int t = 2 * t2 + tw, rg = t / (N / 16), nb = t % (N / 16);
        const bf16_t* ap = A + (size_t)(16 * rg + i16) * lda + kp * (K / 4) + 8 * g;
        const bf16_t* bp = Bt + (size_t)(16 * nb + i16) * ldb + kp * (K / 4) + 8 * g;
        f32x4 acc = (f32x4){0.f, 0.f, 0.f, 0.f};
        bf16x8 a0[8], b0[8], a1[8], b1[8];
#define SG_LOAD(A_, B_, base) do { _Pragma("unroll") for (int j = 0; j < 8; ++j) if ((base) + j < nsteps) { A_[j] = *(const bf16x8*)(ap + ((base) + j) * 32); B_[j] = *(const bf16x8*)(bp + ((base) + j) * 32); } } while (0)
#define SG_MMA(A_, B_, base) do { _Pragma("unroll") for (int j = 0; j < 8; ++j) if ((base) + j < nsteps) acc = MFMA16(B_[j], A_[j], acc); } while (0)
        SG_LOAD(a0, b0, 0);
        for (int ks = 0; ks < nsteps; ks += 16) {
            SG_LOAD(a1, b1, ks + 8);
            SG_MMA(a0, b0, ks);
            SG_LOAD(a0, b0, ks + 16);
            SG_MMA(a1, b1, ks + 8);
        }
#undef SG_LOAD
#undef SG_MMA
        __syncthreads();
        *(LAS f32x4*)(part + (w * 64 + lane) * 4) = acc;
        __syncthreads();
        if (kp == 0) {
            const f32x4 p1 = *(LAS const f32x4*)(part + ((w + 1) * 64 + lane) * 4), p2 = *(LAS const f32x4*)(part + ((w + 2) * 64 + lane) * 4), p3 = *(LAS const f32x4*)(part + ((w + 3) * 64 + lane) * 4);
            acc = (acc + p1) + (p2 + p3);
            q(MPR + 16 * rg + i16, 16 * nb + 4 * g, acc);
        }
    }
}
struct QT1 { bf16_t* PROJ;
    __device__ __forceinline__ void operator()(int row, int col, f32x4 v) const {
        const u32x2 mw = *(const u32x2*)(PROJ + (size_t)row * LDP + C_MG + col);
        *(u32x2*)(PROJ + (size_t)row * LDP + C_Z + col) = pack4(v[0] * sigmoidf_(bflo(mw.x)), v[1] * sigmoidf_(bfhi(mw.x)), v[2] * sigmoidf_(bflo(mw.y)), v[3] * sigmoidf_(bfhi(mw.y))); } };
struct QMix { bf16_t* PROJ;
    __device__ __forceinline__ void operator()(int row, int col, f32x4 v) const {
        const u32x2 mw = *(const u32x2*)(PROJ + (size_t)row * LDP + C_MG + 1024 + col), tw = *(const u32x2*)(PROJ + (size_t)row * LDP + C_Z + col);
        *(u32x2*)(PROJ + (size_t)row * LDP + C_Q + col) = pack4(bflo(tw.x) + v[0] * sigmoidf_(bflo(mw.x)), bfhi(tw.x) + v[1] * sigmoidf_(bfhi(mw.x)), bflo(tw.y) + v[2] * sigmoidf_(bflo(mw.y)), bfhi(tw.y) + v[3] * sigmoidf_(bfhi(mw.y))); } };
template <int MODE> struct QResid { bf16_t* PROJ; const float* xs; int res_col, dstb_col; float* SS;
    __device__ __forceinline__ void operator()(int row, int col, f32x4 v) const {
        f32x4 r;
        if (MODE == 0) r = *(const f32x4*)(xs + (size_t)(row - MPR) * D + col);
        else { const u32x2 rw = *(const u32x2*)(PROJ + (size_t)row * LDP + res_col + col); r = (f32x4){bflo(rw.x), bfhi(rw.x), bflo(rw.y), bfhi(rw.y)}; }
        const f32x4 x = r + v;
        *(u32x2*)(PROJ + (size_t)row * LDP + dstb_col + col) = pack4(x[0], x[1], x[2], x[3]);
        float ss = (x[0] * x[0] + x[1] * x[1]) + (x[2] * x[2] + x[3] * x[3]);
        ss += __shfl_xor(ss, 16); ss += __shfl_xor(ss, 32);
        if ((threadIdx.x & 48) == 0) atomicAdd(SS + row, ss); } };
struct QPE { bf16_t* PROJ;
    __device__ __forceinline__ void operator()(int row, int col, f32x4 v) const { *(u32x2*)(PROJ + (size_t)row * LDP + C_Z + col) = pack4(v[0], v[1], v[2], v[3]); } };
__device__ __forceinline__ void small_mix(Frame& F, const bf16_t* WT) {
    const int lane = F.lane, w = F.wave, i16 = lane & 15, g = lane >> 4, kp = w & 3, tw = w >> 2;
    LAS float* part = (LAS float*)F.lds;
    const int t = 2 * (int)blockIdx.x + tw, rg = t / (D / 16), nb = t % (D / 16);
    const bf16_t* arow = F.PROJ() + (size_t)(MPR + 16 * rg + i16) * LDP;
    const bf16_t* brow = WT + (size_t)(16 * nb + i16) * 3072;
    const bf16_t* ap = arow + C_XS + kp * 512 + 8 * g; const bf16_t* bp = brow + kp * 512 + 8 * g;
    const bf16_t* ap2 = arow + C_B + kp * 256 + 8 * g; const bf16_t* bp2 = brow + 2048 + kp * 256 + 8 * g;
    f32x4 acc1 = (f32x4){0.f, 0.f, 0.f, 0.f}, acc2 = acc1;
    bf16x8 a0[8], b0[8], a1[8], b1[8];
#pragma unroll
    for (int j = 0; j < 8; ++j) { a0[j] = *(const bf16x8*)(ap + j * 32); b0[j] = *(const bf16x8*)(bp + j * 32); }
#pragma unroll
    for (int j = 0; j < 8; ++j) { a1[j] = *(const bf16x8*)(ap + (8 + j) * 32); b1[j] = *(const bf16x8*)(bp + (8 + j) * 32); }
#pragma unroll
    for (int j = 0; j < 8; ++j) acc1 = MFMA16(b0[j], a0[j], acc1);
#pragma unroll
    for (int j = 0; j < 8; ++j) { a0[j] = *(const bf16x8*)(ap2 + j * 32); b0[j] = *(const bf16x8*)(bp2 + j * 32); }
#pragma unroll
    for (int j = 0; j < 8; ++j) acc1 = MFMA16(b1[j], a1[j], acc1);
#pragma unroll
    for (int j = 0; j < 8; ++j) acc2 = MFMA16(b0[j], a0[j], acc2);
    __syncthreads();
    *(LAS f32x4*)(part + (w * 64 + lane) * 8) = acc1; *(LAS f32x4*)(part + (w * 64 + lane) * 8 + 4) = acc2;
    __syncthreads();
    if (kp == 0) {
#pragma unroll
        for (int q = 1; q < 4; ++q) { acc1 += *(LAS const f32x4*)(part + ((w + q) * 64 + lane) * 8); acc2 += *(LAS const f32x4*)(part + ((w + q) * 64 + lane) * 8 + 4); }
        const int row = MPR + 16 * rg + i16, col = 16 * nb + 4 * g;
        const u32x2 m1 = *(const u32x2*)(F.PROJ() + (size_t)row * LDP + C_MG + col), m2 = *(const u32x2*)(F.PROJ() + (size_t)row * LDP + C_MG + 1024 + col);
        *(u32x2*)(F.PROJ() + (size_t)row * LDP + C_Q + col) = pack4(acc1[0] * sigmoidf_(bflo(m1.x)) + acc2[0] * sigmoidf_(bflo(m2.x)), acc1[1] * sigmoidf_(bfhi(m1.x)) + acc2[1] * sigmoidf_(bfhi(m2.x)),
                                                                  acc1[2] * sigmoidf_(bflo(m1.y)) + acc2[2] * sigmoidf_(bflo(m2.y)), acc1[3] * sigmoidf_(bfhi(m1.y)) + acc2[3] * sigmoidf_(bfhi(m2.y)));
    }
}

__device__ __forceinline__ void small_x3_final(Frame& F, const bf16_t* A, int lda, const bf16_t* Bt, int ldb, const bf16_t* WPP, const float* SS2, float* SS3, unsigned* cnt, unsigned* bar) {
    const int lane = F.lane, w = F.wave, i16 = lane & 15, g = lane >> 4, kp = w & 3, tw = w >> 2;
    LAS float* part = (LAS float*)F.lds;
    const int t = 2 * (int)blockIdx.x + tw, rg = t / (D / 16), nb = t % (D / 16);
    const bf16_t* ap = A + (size_t)(16 * rg + i16) * lda + kp * (D / 4) + 8 * g;
    const bf16_t* bp = Bt + (size_t)(16 * nb + i16) * ldb + kp * (D / 4) + 8 * g;
    const bf16_t* ap2 = F.PB() + (size_t)(MPR + 16 * rg + i16) * 256 + kp * 64 + 8 * g;
    const bf16_t* bp2 = WPP + (size_t)(16 * nb + i16) * 256 + kp * 64 + 8 * g;
    f32x4 acc = (f32x4){0.f, 0.f, 0.f, 0.f}, acc2 = acc;
    {   bf16x8 av[10], bv[10];
#pragma unroll
        for (int j = 0; j < 8; ++j) { av[j] = *(const bf16x8*)(ap + j * 32); bv[j] = *(const bf16x8*)(bp + j * 32); }
#pragma unroll
        for (int j = 0; j < 2; ++j) { av[8 + j] = *(const bf16x8*)(ap2 + j * 32); bv[8 + j] = *(const bf16x8*)(bp2 + j * 32); }
#pragma unroll
        for (int j = 0; j < 8; ++j) acc = MFMA16(bv[j], av[j], acc);
#pragma unroll
        for (int j = 0; j < 2; ++j) acc2 = MFMA16(bv[8 + j], av[8 + j], acc2);
    }
    __syncthreads();
    *(LAS f32x4*)(part + (w * 64 + lane) * 8) = acc; *(LAS f32x4*)(part + (w * 64 + lane) * 8 + 4) = acc2;
    __syncthreads();
    const int row = MPR + 16 * rg + i16, col = 16 * nb + 4 * g;
    f32x4 x = (f32x4){0.f, 0.f, 0.f, 0.f};
    if (kp == 0) {
#pragma unroll
        for (int q = 1; q < 4; ++q) { acc += *(LAS const f32x4*)(part + ((w + q) * 64 + lane) * 8); acc2 += *(LAS const f32x4*)(part + ((w + q) * 64 + lane) * 8 + 4); }
        const float r = rsqrtf(SS2[row] * (1.0f / D) + EPS);
        const u32x2 aw = *(const u32x2*)(F.PROJ() + (size_t)row * LDP + C_GATE + col);
        const f32x4 a = (f32x4){bflo(aw.x), bfhi(aw.x), bflo(aw.y), bfhi(aw.y)};
#pragma unroll
        for (int i = 0; i < 4; ++i) x[i] = a[i] + acc2[i] * sigmoidf_(r * acc[i]);
        float ss = (x[0] * x[0] + x[1] * x[1]) + (x[2] * x[2] + x[3] * x[3]);
        ss += __shfl_xor(ss, 16); ss += __shfl_xor(ss, 32);
        if (g == 0) atomicAdd(SS3 + row, ss);
    }
    asm volatile("s_waitcnt vmcnt(0)" ::: "memory");
    __syncthreads();
    if (F.tid == 0) { unsigned* c = cnt + 64 * rg; (void)xb_add(c, 1u); unsigned sp = 0u;
        while (xb_ld(c) < 32u) { __builtin_amdgcn_s_sleep(1); if ((++sp & 255u) == 0u) { if (xb_ld(&bar[XB_TMO])) break; if (sp > XB_SPIN_CAP) { atomicAdd(&bar[XB_TMO], 1u); break; } } } }
    __syncthreads();
    if (kp == 0) {
        const float r3 = rsqrtf(__uint_as_float(xb_ld((unsigned*)(SS3 + row))) * (1.0f / D) + EPS);
        const f32x4 gq = *(const f32x4*)(F.in[29] + col);
        *(f32x4*)(F.out + O_YS + (size_t)(row - MPR) * D + col) = x * r3 * gq;
    }
}

struct GdnSmp2In { f32x4 S[8]; u32x4 k8, q8; u32x2 v4; float araw, braw; };
__device__ __forceinline__ void gdn_smp2_load(const Frame& F, int it, int e4, int dg, GdnSmp2In& r) {
    const int sq = it >> 3, h = it & 7;
    const float* sp = F.in[6] + ((size_t)(sq * 8 + h) * 128 + dg * 8) * 128 + e4 * 4;
#pragma unroll
    for (int j = 0; j < 8; ++j) r.S[j] = *(const f32x4*)(sp + (size_t)j * 128);
    const bf16_t* row = F.PROJ() + (size_t)(MPR + sq) * LDP;
    r.k8 = *(const u32x4*)(row + C_K + h * 128 + dg * 8); r.q8 = *(const u32x4*)(row + C_Q + h * 128 + dg * 8);
    r.v4 = *(const u32x2*)(row + C_V + h * 128 + e4 * 4);
    const float* sm = F.SMALL() + (size_t)(MPR + sq) * 64;
    r.araw = sm[40 + h]; r.braw = sm[32 + h];
}
__device__ __forceinline__ void gdn_sample2_regs(const Frame& F) {
    const int tid = F.tid, e4 = tid & 31, dg = tid >> 5, w = F.wave, lane = F.lane;
    LAS f32x4* pa = (LAS f32x4*)F.lds;
    LAS f32x4* pb = (LAS f32x4*)(F.lds + 4096);
    constexpr int NIT = NSMP * 8;
    int it = blockIdx.x;
    if (it >= NIT) return;
    GdnSmp2In cur, nxt;
    gdn_smp2_load(F, it, e4, dg, cur);
    for (; it < NIT; it += F.G) {
        const bool more = it + F.G < NIT;
        if (more) gdn_smp2_load(F, it + F.G, e4, dg, nxt);
        const int sq = it >> 3, h = it & 7;
        const float eg = __expf(-__expf(F.in[18][h]) * softplusf_(cur.araw + F.in[17][h])), bt = sigmoidf_(cur.braw);
        float k8[8], q8[8]; unpack8(cur.k8, k8); unpack8(cur.q8, q8);
        f32x4 ks = (f32x4){0.f, 0.f, 0.f, 0.f};
#pragma unroll
        for (int j = 0; j < 8; ++j) ks += cur.S[j] * k8[j];
#pragma unroll
        for (int i = 0; i < 4; ++i) ks[i] += __shfl_xor(ks[i], 32);
        __syncthreads();
        if (lane < 32) pa[w * 32 + e4] = ks;
        __syncthreads();
        f32x4 kS = pa[e4];
#pragma unroll
        for (int ww = 1; ww < 8; ++ww) kS += pa[ww * 32 + e4];
        const f32x4 vv = (f32x4){bflo(cur.v4.x), bfhi(cur.v4.x), bflo(cur.v4.y), bfhi(cur.v4.y)};
        const f32x4 vn = (vv - kS * eg) * bt;
        f32x4 op = (f32x4){0.f, 0.f, 0.f, 0.f};
        float* dp = F.out + O_GDNS + ((size_t)(sq * 8 + h) * 128 + dg * 8) * 128 + e4 * 4;
#pragma unroll
        for (int j = 0; j < 8; ++j) { const f32x4 sn = cur.S[j] * eg + vn * k8[j]; op += sn * q8[j]; *(f32x4*)(dp + (size_t)j * 128) = sn; }
#pragma unroll
        for (int i = 0; i < 4; ++i) op[i] += __shfl_xor(op[i], 32);
        if (lane < 32) pb[w * 32 + e4] = op;
        __syncthreads();
        if (dg == 0) {
            f32x4 o = pb[e4];
#pragma unroll
            for (int ww = 1; ww < 8; ++ww) o += pb[ww * 32 + e4];
            float ss = (o[0] * o[0] + o[1] * o[1]) + (o[2] * o[2] + o[3] * o[3]);
            ss += __shfl_xor(ss, 1); ss += __shfl_xor(ss, 2); ss += __shfl_xor(ss, 4); ss += __shfl_xor(ss, 8); ss += __shfl_xor(ss, 16);
            const float rn = rsqrtf(ss * (1.0f / 128.0f) + EPS);
            const u32x2 gw = *(const u32x2*)(F.PROJ() + (size_t)(MPR + sq) * LDP + C_GATE + h * 128 + e4 * 4);
            const f32x4 gn = *(const f32x4*)(F.in[19] + e4 * 4);
            *(u32x2*)(F.PROJ() + (size_t)(MPR + sq) * LDP + C_B + h * 128 + e4 * 4) = pack4(o[0] * rn * gn[0] * siluf_(bflo(gw.x)), o[1] * rn * gn[1] * siluf_(bfhi(gw.x)), o[2] * rn * gn[2] * siluf_(bflo(gw.y)), o[3] * rn * gn[3] * siluf_(bfhi(gw.y)));
        }
        if (more) cur = nxt;
    }
}

__device__ __forceinline__ void gdn_sample2(const Frame& F) {
    constexpr int NIT = NSMP * 8, SLOT = 65536 + 4096;
    constexpr int O_PA = 2 * SLOT, O_PB = O_PA + 2048, O_HP = O_PB + 2048;
    static_assert(O_HP + 256 <= MISC_OFF, "gdn sample ring");
    const int w = F.wave, lane = F.lane;
    LAS unsigned char* L = F.lds;
    const int first = blockIdx.x, n = first < NIT ? (NIT - 1 - first) / F.G + 1 : 0;
    LAS float* hp = (LAS float*)(L + O_HP);
    __syncthreads();
    if (F.tid < 8) { hp[F.tid] = -__expf(F.in[18][F.tid]); hp[8 + F.tid] = F.in[17][F.tid]; }
    __syncthreads();
    if (w < 4) {
#define GSL_ISSUE(k_) do { const int it_ = first + (k_) * F.G, sq_ = it_ >> 3, h_ = it_ & 7; \
            const char* sp_ = (const char*)(F.in[6] + (size_t)it_ * 16384) + (size_t)((w * 16) * 64 + lane) * 16; \
            LAS unsigned char* sl_ = L + ((k_) & 1) * SLOT + w * 16384; \
            _Pragma("unroll") for (int j_ = 0; j_ < 16; ++j_) __builtin_amdgcn_global_load_lds((const unsigned*)(sp_ + j_ * 1024), (LAS unsigned*)(sl_ + j_ * 1024), 16, 0, 0); \
            const bf16_t* row_ = F.PROJ() + (size_t)(MPR + sq_) * LDP + h_ * 128 + (lane & 15) * 8; \
            const char* op_ = w == 0 ? (const char*)(row_ + C_K) : w == 1 ? (const char*)(row_ + C_Q) : w == 2 ? (const char*)(row_ + C_V) \
                            : (lane & 16) ? (const char*)(F.SMALL() + (size_t)(MPR + sq_) * 64 + 32 + (lane & 3) * 4) : (const char*)(row_ + C_GATE); \
            __builtin_amdgcn_global_load_lds((const unsigned*)op_, (LAS unsigned*)(L + ((k_) & 1) * SLOT + 65536 + w * 1024), 16, 0, 0); } while (0)
        if (n > 0) GSL_ISSUE(0);
        if (n > 1) GSL_ISSUE(1);
        for (int k = 0; k < n; ++k) {
            if (k + 1 < n) asm volatile("s_waitcnt vmcnt(17)" ::: "memory"); else asm volatile("s_waitcnt vmcnt(0)" ::: "memory");
            __builtin_amdgcn_s_barrier(); asm volatile("" ::: "memory");
            __builtin_amdgcn_s_barrier(); asm volatile("" ::: "memory");
            if (k + 2 < n) GSL_ISSUE(k + 2);
            __builtin_amdgcn_s_barrier(); asm volatile("" ::: "memory");
        }
#undef GSL_ISSUE
    } else {
        const int cw = w - 4, e4 = lane & 31, dgl = lane >> 5, d0 = (cw * 2 + dgl) * 16;
        LAS f32x4* pa = (LAS f32x4*)(L + O_PA); LAS f32x4* pb = (LAS f32x4*)(L + O_PB);
        for (int k = 0; k < n; ++k) {
            asm volatile("s_waitcnt lgkmcnt(0)" ::: "memory"); __builtin_amdgcn_s_barrier(); asm volatile("" ::: "memory");
            const int it = first + k * F.G, sq = it >> 3, h = it & 7;
            LAS const unsigned char* sl = L + (k & 1) * SLOT;
            f32x4 S[16];
#pragma unroll
            for (int j = 0; j < 16; ++j) S[j] = *(LAS const f32x4*)(sl + (size_t)(d0 + j) * 512 + e4 * 16);
            float k16[16], q16[16];
            { unpack8(*(LAS const u32x4*)(sl + 65536 + d0 * 2), *(float (*)[8])&k16[0]); unpack8(*(LAS const u32x4*)(sl + 65536 + d0 * 2 + 16), *(float (*)[8])&k16[8]);
              unpack8(*(LAS const u32x4*)(sl + 65536 + 1024 + d0 * 2), *(float (*)[8])&q16[0]); unpack8(*(LAS const u32x4*)(sl + 65536 + 1024 + d0 * 2 + 16), *(float (*)[8])&q16[8]); }
            const u32x2 v4 = *(LAS const u32x2*)(sl + 65536 + 2048 + e4 * 8), gw = *(LAS const u32x2*)(sl + 65536 + 3072 + e4 * 8);
            const float braw = *(LAS const float*)(sl + 65536 + 3072 + 256 + h * 4), araw = *(LAS const float*)(sl + 65536 + 3072 + 256 + 32 + h * 4);
            const float eg = __expf(hp[h] * softplusf_(araw + hp[8 + h])), bt = sigmoidf_(braw);
            f32x4 ks = (f32x4){0.f, 0.f, 0.f, 0.f};
#pragma unroll
            for (int j = 0; j < 16; ++j) ks += S[j] * k16[j];
#pragma unroll
            for (int i = 0; i < 4; ++i) ks[i] += __shfl_xor(ks[i], 32);
            if (lane < 32) pa[cw * 32 + e4] = ks;
            asm volatile("s_waitcnt lgkmcnt(0)" ::: "memory"); __builtin_amdgcn_s_barrier(); asm volatile("" ::: "memory");
            const f32x4 kS = (pa[e4] + pa[32 + e4]) + (pa[64 + e4] + pa[96 + e4]);
            const f32x4 vv = (f32x4){bflo(v4.x), bfhi(v4.x), bflo(v4.y), bfhi(v4.y)};
            const f32x4 vn = (vv - kS * eg) * bt;
            f32x4 op = (f32x4){0.f, 0.f, 0.f, 0.f};
            float* dp = F.out + O_GDNS + ((size_t)it * 128 + d0) * 128 + e4 * 4;
#pragma unroll
            for (int j = 0; j < 16; ++j) { const f32x4 sn = S[j] * eg + vn * k16[j]; op += sn * q16[j]; *(f32x4*)(dp + (size_t)j * 128) = sn; }
#pragma unroll
            for (int i = 0; i < 4; ++i) op[i] += __shfl_xor(op[i], 32);
            if (lane < 32) pb[cw * 32 + e4] = op;
            asm volatile("s_waitcnt lgkmcnt(0)" ::: "memory"); __builtin_amdgcn_s_barrier(); asm volatile("" ::: "memory");
            if (cw == 0 && lane < 32) {
                const f32x4 o = (pb[e4] + pb[32 + e4]) + (pb[64 + e4] + pb[96 + e4]);
                float ss = (o[0] * o[0] + o[1] * o[1]) + (o[2] * o[2] + o[3] * o[3]);
                ss += __shfl_xor(ss, 1); ss += __shfl_xor(ss, 2); ss += __shfl_xor(ss, 4); ss += __shfl_xor(ss, 8); ss += __shfl_xor(ss, 16);
                const float rn = rsqrtf(ss * (1.0f / 128.0f) + EPS);
                const f32x4 gn = *(const f32x4*)(F.in[19] + e4 * 4);
                *(u32x2*)(F.PROJ() + (size_t)(MPR + sq) * LDP + C_B + h * 128 + e4 * 4) = pack4(o[0] * rn * gn[0] * siluf_(bflo(gw.x)), o[1] * rn * gn[1] * siluf_(bfhi(gw.x)), o[2] * rn * gn[2] * siluf_(bflo(gw.y)), o[3] * rn * gn[3] * siluf_(bfhi(gw.y)));
            }
        }
    }
}

#ifdef PROBE_A
#define STAMPF(k) do { if (blockIdx.x == 0 && F.tid == 0) ((volatile LAS unsigned*)(F.lds + MISC_OFF))[16 + (k)] = (unsigned)__builtin_amdgcn_s_memrealtime(); } while (0)
#else
#define STAMPF(k) do { } while (0)
#endif
__device__ __forceinline__ void p3_scan(Frame& F) {
    int sit = NSMP * 32;
    if (F.G == 256) {
        const int xcd = blockIdx.x & 7, idx = blockIdx.x >> 3, grp = xcd * 4 + (idx >> 3);
        ssd_chunked(F, (grp >> 2) * 32 + (grp & 3) * 8 + (idx & 7), sit);
    } else
    for (int it = blockIdx.x; it < NBATCH * 32; it += F.G) ssd_chunked(F, it, sit);
    __syncthreads(); STAMPF(15);
    for (int pr = blockIdx.x; pr < 1024; pr += F.G) gdn_prep3(F, 2 * pr + (F.tid >> 8), F.tid >> 8);
    __syncthreads(); STAMPF(16);
    ssd_sample_stream(F, blockIdx.x);
}
__device__ __forceinline__ void sample_ynorm(Frame& F) {
    const int gw = blockIdx.x * NWAVES + F.wave, NGW = F.G * NWAVES, lane = F.lane;
    for (int u = gw; u < NSMP * 4; u += NGW) {
        bf16_t* row = F.PROJ() + (size_t)(MPR + (u >> 2)) * LDP;
        const int c = (u & 3) * 512 + lane * 8;
        float y[8], z[8]; unpack8(*(const u32x4*)(row + C_XS + c), y); unpack8(*(const u32x4*)(row + C_Z + c), z);
        float ss = 0.f;
#pragma unroll
        for (int i = 0; i < 8; ++i) { y[i] *= siluf_(z[i]); ss += y[i] * y[i]; }
        const float r = rsqrtf(wave_sum(ss) * (1.0f / 512.0f) + EPS);
#pragma unroll
        for (int i = 0; i < 8; ++i) y[i] *= r;
        *(u32x4*)(row + C_XS + c) = pack8(y);
    }
}
__device__ __forceinline__ void p3b_scan(Frame& F) {
    int sit = NSMP * 32;
    sample_ynorm(F);
    if (F.G == 256) {
        const int xcd = blockIdx.x & 7, idx = blockIdx.x >> 3;
        gdn_scan(F, (xcd * 8 + (idx >> 2)) * 4 + (idx & 3), sit);
    } else
    for (int it = blockIdx.x; it < NBATCH * 32; it += F.G) gdn_scan(F, it, sit);
    __syncthreads(); STAMPF(17);
    gdn_sample2(F);
}

__device__ __forceinline__ void p4_norm(Frame& F) {
    const int gw = blockIdx.x * NWAVES + F.wave, NGW = F.G * NWAVES, lane = F.lane;
    const float* gs = F.in[15]; const float* gg = F.in[19];
    for (int m = gw; m < MTOT; m += NGW) {
        bf16_t* row = F.PROJ() + (size_t)m * LDP;
#pragma unroll
        for (int g = 0; g < 4; ++g) {
            const int c = g * 512 + lane * 8;
            float y[8], z[8]; unpack8(*(const u32x4*)(row + C_XS + c), y); unpack8(*(const u32x4*)(row + C_Z + c), z);
            float ss = 0.f;
#pragma unroll
            for (int i = 0; i < 8; ++i) { y[i] *= siluf_(z[i]); ss += y[i] * y[i]; }
            const float r = rsqrtf(wave_sum(ss) * (1.0f / 512.0f) + EPS);
            const f32x4 g0 = *(const f32x4*)(gs + c), g1 = *(const f32x4*)(gs + c + 4);
#pragma unroll
            for (int i = 0; i < 4; ++i) { y[i] *= r * g0[i]; y[4 + i] *= r * g1[i]; }
            *(u32x4*)(row + C_XS + c) = pack8(y);
        }
#pragma unroll
        for (int hh = 0; hh < 2; ++hh) {
            const int c = hh * 512 + lane * 8;
            float o[8], gt[8]; unpack8(*(const u32x4*)(row + C_V + c), o); unpack8(*(const u32x4*)(row + C_GATE + c), gt);
            float ss = 0.f;
#pragma unroll
            for (int i = 0; i < 8; ++i) ss += o[i] * o[i];
            ss += __shfl_xor(ss, 1); ss += __shfl_xor(ss, 2); ss += __shfl_xor(ss, 4); ss += __shfl_xor(ss, 8);
            const float r = rsqrtf(ss * (1.0f / 128.0f) + EPS);
            const int e = (lane & 15) * 8;
            const f32x4 g0 = *(const f32x4*)(gg + e), g1 = *(const f32x4*)(gg + e + 4);
#pragma unroll
            for (int i = 0; i < 4; ++i) { o[i] = o[i] * r * g0[i] * siluf_(gt[i]); o[4 + i] = o[4 + i] * r * g1[i] * siluf_(gt[4 + i]); }
            *(u32x4*)(row + C_V + c) = pack8(o);
        }
    }
}

__device__ __forceinline__ void p12_final(Frame& F) {
    const int gw = blockIdx.x * NWAVES + F.wave, NGW = F.G * NWAVES, lane = F.lane;
    const float* gf = F.in[29];
    for (int m = gw; m < MTOT; m += NGW) {
        float* orow = F.out + (m < MPR ? O_Y + (size_t)m * D : O_YS + (size_t)(m - MPR) * D);
        const bf16_t* xrow = F.PROJ() + (size_t)m * LDP + C_K;
        const u32x4 xa = *(const u32x4*)(xrow + lane * 8), xb = *(const u32x4*)(xrow + 512 + lane * 8);
        const float r = rsqrtf(F.SS3()[m] * (1.0f / D) + EPS);
        float x[8];
        unpack8(xa, x);
        { const int c = lane * 8; const f32x4 g0 = *(const f32x4*)(gf + c), g1 = *(const f32x4*)(gf + c + 4);
          *(f32x4*)(orow + c) = (f32x4){x[0] * r * g0[0], x[1] * r * g0[1], x[2] * r * g0[2], x[3] * r * g0[3]}; *(f32x4*)(orow + c + 4) = (f32x4){x[4] * r * g1[0], x[5] * r * g1[1], x[6] * r * g1[2], x[7] * r * g1[3]}; }
        unpack8(xb, x);
        { const int c = 512 + lane * 8; const f32x4 g0 = *(const f32x4*)(gf + c), g1 = *(const f32x4*)(gf + c + 4);
          *(f32x4*)(orow + c) = (f32x4){x[0] * r * g0[0], x[1] * r * g0[1], x[2] * r * g0[2], x[3] * r * g0[3]}; *(f32x4*)(orow + c + 4) = (f32x4){x[4] * r * g1[0], x[5] * r * g1[1], x[6] * r * g1[2], x[7] * r * g1[3]}; }
    }
}

__global__ void __launch_bounds__(NWAVES * 64, 2) mega_fwd(Args args) {
    extern __shared__ __attribute__((aligned(16))) unsigned char lds_raw[];
    Frame F;
    F.lds = (LAS unsigned char*)lds_raw;
    F.tid = threadIdx.x; F.lane = F.tid & 63; F.wave = __builtin_amdgcn_readfirstlane(F.tid >> 6); F.G = gridDim.x;
    F.in = args.in;
    F.out = args.out; F.ws = args.ws;
    unsigned char* ws = args.ws;
    const int lo = args.ph_lo, hi = args.ph_hi;
#if MK_ONE_LAUNCH
    volatile LAS unsigned* MISC = (volatile LAS unsigned*)(F.lds + MISC_OFF);
    if (F.tid < 32) MISC[F.tid] = 0u;
    __syncthreads();
    XcdBarrier bar = xcd_barrier_post((unsigned*)(ws + WS_BAR), MISC + 8);
#ifdef PROBE_A
#define STAMP(k) do { if (blockIdx.x == 0 && F.tid == 0) MISC[16 + (k)] = (unsigned)__builtin_amdgcn_s_memrealtime(); } while (0)
#else
#define STAMP(k) do { } while (0)
#endif
#define SEAM(k) do { if (lo <= (k) && (k) + 1 < hi) xcd_barrier(bar); STAMP((k) + 1); } while (0)
#else
#define SEAM(k) do { } while (0)
#endif
#ifndef PHASE_MASK
#define PHASE_MASK 0xffff
#endif
#define IN(k) (((PHASE_MASK >> (k)) & 1) && lo <= (k) && (k) < hi)
#ifndef REP_PHASE
#define REP_PHASE -1
#endif
#define NREP(k) ((REP_PHASE == (k)) ? 2 : 1)
    const int bid = (int)blockIdx.x;
    typedef pg8::StaticOrder SO;
    STAMP(0);

    if (IN(0)) { p0_prologue(F, 0, bid * NWAVES + F.wave, F.G * NWAVES); SEAM(0); }
    if (IN(1)) {
        pg8::Gemm g{F.XN(), (const bf16_t*)(ws + WS_WIN), MP, NPROJ, D, D, D}; SO S; S.init(MP, NPROJ, F.G, bid);
        EpiInProj E{F.PROJ(), F.HALO(), F.SMALL(), F.in[10], F.in[11], F.in[16], (LAS float*)(F.lds + RT_OFF)};
        pg8::gemm_phase<EpiInProj, SO>(F.lds, g, S, E);
        {
            const int rem = S.nwg % F.G, nidle = rem ? F.G - rem : F.G, me = rem ? bid - rem : bid;
            if (me >= 0) p0_prologue(F, 1, me * NWAVES + F.wave, nidle * NWAVES);
        }
        SEAM(1);
    }
    if (IN(2)) { p2_conv(F); SEAM(2); }
    if (IN(3)) { p3_scan(F); SEAM(3); }
    if (IN(4)) { p3b_scan(F); SEAM(4); }
    if (IN(6)) {
        pg8::Gemm g{F.PROJ() + C_XS, (const bf16_t*)(ws + WS_WBS), MPR, D, 3072, LDP, 3072}; SO S; S.init(MPR, D, F.G, bid);
        LAS float* rt = (LAS float*)(F.lds + RT_OFF);
        { Unit u0; if (S.next(0, u0) && F.tid < 256) {
              const float* sy = (const float*)(ws + WS_SSY) + (size_t)(u0.pm * 256 + F.tid) * 4; const float* so = (const float*)(ws + WS_SSO) + (size_t)(u0.pm * 256 + F.tid) * 8;
              float ry[4], ro[8];
#pragma unroll
              for (int q = 0; q < 4; ++q) ry[q] = rsqrtf(sy[q] * (1.0f / 512.0f) + EPS);
#pragma unroll
              for (int q = 0; q < 8; ++q) ro[q] = rsqrtf(so[q] * (1.0f / 128.0f) + EPS);
              rt[F.tid] = ry[0] / ry[1]; rt[256 + F.tid] = ry[1] / ry[2]; rt[512 + F.tid] = ry[2] / ry[3]; rt[768 + F.tid] = ry[3] / ro[0];
#pragma unroll
              for (int q = 0; q < 7; ++q) rt[(4 + q) * 256 + F.tid] = ro[q] / ro[q + 1];
              rt[15 * 256 + F.tid] = ro[7]; }
          __syncthreads(); }
        EpiMixCat E{F.PROJ(), rt + 15 * 256};
        pg8::gemm_phase<EpiMixCat, SO>(F.lds, g, S, E);
        small_mix(F, (const bf16_t*)(ws + WS_WBS)); SEAM(7);
    }
    if (IN(8)) {
        pg8::Gemm g{F.PROJ() + C_Q, (const bf16_t*)(ws + WS_WOUT), MPR, D, D, LDP, D}; SO S; S.init(MPR, D, F.G, bid);
        EpiResid<0> E{F.PROJ(), F.in[0], F.in[1], 0, C_K, F.SS1()};
        pg8::gemm_phase<EpiResid<0>, SO>(F.lds, g, S, E);
        small_gemm(F, F.PROJ() + (size_t)MPR * LDP + C_Q, LDP, (const bf16_t*)(ws + WS_WOUT), D, D, D, QResid<0>{F.PROJ(), F.in[1], 0, C_K, F.SS1()}); SEAM(8);
    }
    if (IN(9)) {
        pg8::Gemm g{F.PROJ() + C_K, (const bf16_t*)(ws + WS_WFI), MP, 2 * DFF, D, LDP, D}; SO S; S.init(MP, 2 * DFF, F.G, bid);
        EpiSwiGLU E{F.PROJ(), F.SS1()};
        for (int rp = 0; rp < NREP(9); ++rp) { pg8::gemm_phase<EpiSwiGLU, SO>(F.lds, g, S, E); if (rp + 1 < NREP(9)) xcd_barrier(bar); } SEAM(9);
    }
    if (IN(10)) {
        pg8::Gemm g{F.PROJ() + C_XS, (const bf16_t*)(ws + WS_WFO), MPR, D, DFF, LDP, DFF}; SO S; S.init(MPR, D, F.G, bid);
        EpiResid<1> E{F.PROJ(), nullptr, nullptr, C_K, C_GATE, F.SS2()};
        pg8::gemm_phase<EpiResid<1>, SO>(F.lds, g, S, E);
        small_gemm(F, F.PROJ() + (size_t)MPR * LDP + C_XS, LDP, (const bf16_t*)(ws + WS_WFO), DFF, DFF, D, QResid<1>{F.PROJ(), nullptr, C_K, C_GATE, F.SS2()}); SEAM(10);
    }
    if (IN(11)) {
        pg8::Gemm g{F.PB(), (const bf16_t*)(ws + WS_WPP), MPR, D, 256, 256, 256}; SO S; S.init(MPR, D, F.G, bid);
        EpiPE E{F.PROJ()};
        pg8::gemm_phase<EpiPE, SO>(F.lds, g, S, E);
        STAMP(12);
    }
    if (IN(12)) {
        pg8::Gemm g{F.PROJ() + C_GATE, (const bf16_t*)(ws + WS_WPG), MPR, D, D, LDP, D}; SO S; S.init(MPR, D, F.G, bid);
        EpiX3 E{F.PROJ(), F.SS2(), F.SS3(), F.out, (unsigned*)(ws + WS_XCNT), (unsigned*)(ws + WS_BAR), F.in[29], (LAS float*)(F.lds + RT_OFF)};
        pg8::gemm_phase<EpiX3, SO>(F.lds, g, S, E);
        small_x3_final(F, F.PROJ() + (size_t)MPR * LDP + C_GATE, LDP, (const bf16_t*)(ws + WS_WPG), D, (const bf16_t*)(ws + WS_WPP), F.SS2(), F.SS3(), (unsigned*)(ws + WS_XCNT2), (unsigned*)(ws + WS_BAR));
    }
#ifdef PROBE_A
    STAMP(14);
    __syncthreads();
    if (blockIdx.x == 0) {
        const float tb = (float)(MISC[16 + PROBE_B] - MISC[16 + PROBE_A]) * 0.01f;
        const float sc = 1.0f + sqrtf(tb * PROBE_SCALE);
        for (int i = F.tid; i < 73728; i += NWAVES * 64) F.out[O_GCONVP + i] *= sc;
    }
#endif
#undef IN
#undef SEAM
}

constexpr int NPHASES = 14;

extern "C" void kernel_launch(void* const* d_in, const int* in_sizes, int n_in, void* d_out, int out_size, void* d_ws, size_t ws_size, hipStream_t stream) {
    static int grid = 0;
    if (grid == 0) {
        if (n_in != 30 || ws_size < WS_END) { fprintf(stderr, "kernel_launch: bad call: n_in %d ws %zu (need %zu)\n", n_in, ws_size, (size_t)WS_END); grid = -1; return; }
        int dev = 0, cus = 0, per_cu = 0;
        if (hipGetDevice(&dev) != hipSuccess || hipDeviceGetAttribute(&cus, hipDeviceAttributeMultiprocessorCount, dev) != hipSuccess) { grid = -1; return; }
        if (hipFuncSetAttribute((const void*)mega_fwd, hipFuncAttributeMaxDynamicSharedMemorySize, LDS_BYTES) != hipSuccess) { fprintf(stderr, "kernel_launch: hipFuncSetAttribute failed\n"); grid = -1; return; }
        if (hipOccupancyMaxActiveBlocksPerMultiprocessor(&per_cu, (const void*)mega_fwd, NWAVES * 64, LDS_BYTES) != hipSuccess || per_cu < 1) { fprintf(stderr, "kernel_launch: occupancy query says %d\n", per_cu); per_cu = 1; }
        (void)hipGetLastError();
        if (cus < 256) { fprintf(stderr, "kernel_launch: this kernel needs 256 CUs (one workgroup per CU, one 256x256 unit per workgroup in the N = 1024 GEMM phases); device has %d\n", cus); grid = -1; return; }
        grid = 256;
    }
    if (grid < 0) return;
    (void)hipMemsetAsync((char*)d_ws + WS_SSY, 0, SS2_BYTES + CTL_BYTES, stream);
    Args a{};
    for (int i = 0; i < 30; ++i) a.in[i] = (const float*)d_in[i];
    a.out = (float*)d_out; a.ws = (unsigned char*)d_ws;
#if MK_ONE_LAUNCH
    a.ph_lo = 0; a.ph_hi = NPHASES;
    void* kargs[] = {&a};
    hipError_t e = hipLaunchCooperativeKernel((const void*)mega_fwd, dim3(grid), dim3(NWAVES * 64), kargs, LDS_BYTES, stream);
    if (e != hipSuccess) fprintf(stderr, "cooperative launch failed: %s (grid %d)\n", hipGetErrorString(e), grid);
#else
    for (int ph = 0; ph < NPHASES; ++ph) {
        a.ph_lo = ph; a.ph_hi = ph + 1;
        hipLaunchKernelGGL(mega_fwd, dim3(grid), dim3(NWAVES * 64), LDS_BYTES, stream, a);
    }
#endif
}
```

```cpp
#include <hip/hip_runtime.h>
#include <hip/hip_cooperative_groups.h>
#include <cstdio>
#include <cstdint>
namespace cg = cooperative_groups;

#define PROBE_SCALE 1e-6f
#ifndef MK_ONE_LAUNCH
#define MK_ONE_LAUNCH 1
#endif

#define LAS __attribute__((address_space(3)))
typedef unsigned short bf16_t;
typedef short bf16x8 __attribute__((ext_vector_type(8)));
typedef float f32x4 __attribute__((ext_vector_type(4)));
typedef float f32x2 __attribute__((ext_vector_type(2)));
typedef unsigned u32x4 __attribute__((ext_vector_type(4)));
typedef unsigned u32x2 __attribute__((ext_vector_type(2)));

constexpr int D = 1024, SEQ = 2048, NBATCH = 8, MPR = NBATCH * SEQ, NSMP = 128, MTOT = MPR + NSMP, MP = 16640;
constexpr int LDP = 11264, LDF = LDP / 2;
constexpr int C_Z = 0, C_XS = 2048, C_B = 4096, C_C = 4608, C_Q = 5120, C_K = 6144, C_V = 7168, C_GATE = 8192, C_MG = 9216;
constexpr int NIN = 11312;
constexpr int NPROJ = 11520;
constexpr int DFF = 2816;
constexpr float EPS = 1e-6f;
constexpr int CONV_FUSE_LO = 8, CONV_FUSE_HI = 32;
constexpr int NCH = 6144;

constexpr size_t O_Y = 0, O_YS = 16777216, O_SSMP = 16908288, O_SCONVP = 19005440, O_GDNP = 19079168, O_GCONVP = 20127744,
                 O_SSMS = 20201472, O_SCONVS = 53755904, O_GDNS = 54935552, O_GCONVS = 71712768;

constexpr int RT_OFF = 132096;
constexpr size_t MiB = 1u << 20;
constexpr size_t WS_CTL = 502 * MiB, CTL_BYTES = 1 * MiB;
constexpr size_t WS_BAR = WS_CTL + 16384;
constexpr size_t WS_XCNT = WS_CTL + 32768, WS_XCNT2 = WS_CTL + 49152;
constexpr size_t WS_SS1 = WS_CTL + 65536, WS_SS2 = WS_SS1 + 69632, WS_SS3 = WS_SS2 + 69632;
constexpr size_t WS_WIN = 1 * MiB, WS_WBS = 25 * MiB, WS_WBG = 29 * MiB, WS_WOUT = 31 * MiB, WS_WFI = 33 * MiB, WS_WFO = 44 * MiB, WS_WPG = 50 * MiB, WS_WPP = 52 * MiB;
constexpr size_t WS_XN = 53 * MiB, WS_PB = 86 * MiB, WS_SMALL = 95 * MiB, WS_HALO = 100 * MiB, WS_PROJ = 110 * MiB;
constexpr size_t WS_END0 = WS_PROJ + (size_t)MP * LDP * 2;
constexpr size_t WS_WT = WS_XN, WS_QKM = WS_WIN, WS_UT = 468 * MiB, WS_GC = 500 * MiB;
constexpr size_t WS_SSY = 501 * MiB, WS_SSO = WS_SSY + 512 * 1024, SS2_BYTES = 1024 * 1024;
constexpr size_t WS_END = WS_CTL + CTL_BYTES;
static_assert(WS_SSY + SS2_BYTES == WS_CTL, "one memset region");
static_assert(WS_END0 <= WS_UT && WS_UT + 32 * MiB <= WS_GC, "ws map 2");
static_assert(WS_END <= 512 * MiB, "ws map");
static_assert(WS_SS3 + 69632 <= WS_CTL + CTL_BYTES, "ctl");

typedef __bf16 bf16x2_t __attribute__((ext_vector_type(2)));
__device__ __forceinline__ unsigned cvt_pk_bf16(float lo, float hi) { const f32x2 v = {lo, hi}; const bf16x2_t b = __builtin_convertvector(v, bf16x2_t); return __builtin_bit_cast(unsigned, b); }
__device__ __forceinline__ float bflo(unsigned w) { return __uint_as_float(w << 16); }
__device__ __forceinline__ float bfhi(unsigned w) { return __uint_as_float(w & 0xffff0000u); }
__device__ __forceinline__ float bf2f(bf16_t b) { return __uint_as_float((unsigned)b << 16); }
__device__ __forceinline__ void unpack8(const u32x4 w, float (&f)[8]) { f[0] = bflo(w.x); f[1] = bfhi(w.x); f[2] = bflo(w.y); f[3] = bfhi(w.y); f[4] = bflo(w.z); f[5] = bfhi(w.z); f[6] = bflo(w.w); f[7] = bfhi(w.w); }
__device__ __forceinline__ u32x4 pack8(const float (&f)[8]) { u32x4 w; w.x = cvt_pk_bf16(f[0], f[1]); w.y = cvt_pk_bf16(f[2], f[3]); w.z = cvt_pk_bf16(f[4], f[5]); w.w = cvt_pk_bf16(f[6], f[7]); return w; }
__device__ __forceinline__ float sigmoidf_(float x) { return __builtin_amdgcn_rcpf(1.0f + __builtin_amdgcn_exp2f(-1.4426950408889634f * x)); }
__device__ __forceinline__ float siluf_(float x) { return x * sigmoidf_(x); }
__device__ __forceinline__ float softplusf_(float x) { return x > 20.f ? x : log1pf(__expf(x)); }
template <int CTRL> __device__ __forceinline__ float dpp_mov(float v) { return __builtin_bit_cast(float, __builtin_amdgcn_update_dpp(0, __builtin_bit_cast(int, v), CTRL, 0xF, 0xF, true)); }
template <int J> __device__ __forceinline__ float dpp_prev(float x, float pv) {
    int t = __builtin_amdgcn_update_dpp(0, __builtin_bit_cast(int, pv), 0x120 + J, 0xF, 0xF, true);
    t = __builtin_amdgcn_update_dpp(t, __builtin_bit_cast(int, x), 0x110 + J, 0xF, 0xF, false);
    return __builtin_bit_cast(float, t);
}
__device__ __forceinline__ float row16_sum(float v) {
    v += dpp_mov<0xB1>(v);
    v += dpp_mov<0x4E>(v);
    v += dpp_mov<0x124>(v);
    v += dpp_mov<0x128>(v);
    return v;
}
__device__ __forceinline__ float wave_sum(float v) {
#pragma unroll
    for (int o = 1; o < 64; o <<= 1) v += __shfl_xor(v, o);
    return v;
}

namespace pg8 {
constexpr int BM = 256, BK = 64, HALF = 128, HTB = HALF * BK * 2, STAGE_BYTES = 8 * HTB, NXCD = 8, WGM = 8;
__host__ __device__ __forceinline__ int lds_byte(int r, int c) { const int st = (r >> 4) * 2 + (c >> 5), rr = r & 15, cc = c & 31, ob = rr * 64 + cc * 2; return st * 1024 + (ob ^ (((ob >> 9) & 1) << 5)); }
__host__ __device__ __forceinline__ void stage_rc(int b, int& R, int& C) { const int st = b / 1024, sb = b % 1024, swz = sb ^ (((sb >> 9) & 1) << 5); R = (st >> 1) * 16 + swz / 64; C = (st & 1) * 32 + (swz % 64) / 2; }
__host__ __device__ __forceinline__ int perm32(int rho) { const int n = rho >> 4, i = rho & 15; return 8 * (i >> 2) + 4 * n + (i & 3); }

struct Unit { int pm, pn; };
struct Gemm { const bf16_t* A; const bf16_t* Bt; int M, N, K, lda, ldb; };

struct StaticOrder {
    int nM, nN, nwg, G, c;
    __host__ __device__ __forceinline__ void init(int M, int N, int G_, int c_) { nM = M / BM; nN = N / BM; nwg = nM * nN; G = G_; c = c_; }
    __host__ __device__ __forceinline__ bool next(int i, Unit& u) const {
        const long L = (long)i * G + c; if (L >= nwg) return false;
        int wgid = (int)L; { const int q = nwg / NXCD, r = nwg % NXCD, xcd = wgid % NXCD, off = wgid / NXCD; wgid = (xcd < r ? xcd * (q + 1) : r * (q + 1) + (xcd - r) * q) + off; }
        const int nig = WGM * nN, gid = wgid / nig, fm = gid * WGM, gsz = (nM - fm) < WGM ? (nM - fm) : WGM;
        u.pm = fm + ((wgid % nig) % gsz); u.pn = (wgid % nig) / gsz; return true;
    }
    __device__ __forceinline__ void a_ready(const Unit&) const {}
    __device__ __forceinline__ void done(const Unit&) const {}
};

template <class Epi, class Sched, bool ALIGN_EPI = true, bool SP2 = true>
__device__ __forceinline__ void gemm_phase(LAS unsigned char* lds, const Gemm g, const Sched& S, const Epi& E) {
    const int tid = threadIdx.x, wid = __builtin_amdgcn_readfirstlane(tid >> 6), lane = tid & 63, wr = wid >> 2, wc = wid & 3, fr = lane & 15, fq = lane >> 4;
    int nt = g.K / BK / Epi::NSEG; asm volatile("" : "+s"(nt));
    unsigned voffA, voffB;
    { int R, C; stage_rc(tid * 16, R, C); const int Rb = Epi::PERM ? ((R & ~31) + perm32(R & 31)) : R;
      voffA = (unsigned)(R * g.lda + C) * 2u; voffB = (unsigned)(Rb * g.ldb + C) * 2u; }
    const size_t s64A = (size_t)64 * g.lda * 2, s64B = (size_t)64 * g.ldb * 2;
    const size_t kstep = (size_t)(BK * 2);
    const size_t hstepA = (size_t)HALF * g.lda * 2, hstepB = (size_t)HALF * g.ldb * 2;
    const size_t tstepA = 2 * hstepA, tstepB = 2 * hstepB;
    const unsigned ldsw = (unsigned)wid * 1024u;
    const int aoff = lds_byte(wr * 64 + fr, fq * 8), boff = lds_byte(wc * 32 + fr, fq * 8);
#define PG8_SA(b, h) (((b) * 2 + (h)) * HTB)
#define PG8_SB(b, h) ((4 + (b) * 2 + (h)) * HTB)
#define PG8_STAGE(bufoff, gbase, voff) do { _Pragma("unroll") for (int _i = 0; _i < 2; ++_i) \
        __builtin_amdgcn_global_load_lds((const unsigned*)((const char*)(gbase) + (size_t)_i * (voff##_s64) + (voff)), (LAS unsigned*)(lds + (bufoff) + ldsw + _i * 8192), 16, 0, 0); } while (0)
#define voffA_s64 s64A
#define voffB_s64 s64B
#define PG8_LDA(dst, b, h) do { _Pragma("unroll") for (int m = 0; m < 4; ++m) _Pragma("unroll") for (int k = 0; k < 2; ++k) dst[m][k] = *(const LAS bf16x8*)(lds + PG8_SA(b, h) + aoff + m * 2048 + k * 1024); } while (0)
#define PG8_LDB(dst, b, h) do { _Pragma("unroll") for (int n = 0; n < 2; ++n) _Pragma("unroll") for (int k = 0; k < 2; ++k) dst[n][k] = *(const LAS bf16x8*)(lds + PG8_SB(b, h) + boff + n * 2048 + k * 1024); } while (0)
#define PG8_MMA(ai, bj, At, Bt) do { __builtin_amdgcn_s_setprio(1); _Pragma("unroll") for (int m = 0; m < 4; ++m) _Pragma("unroll") for (int n = 0; n < 2; ++n) _Pragma("unroll") for (int k = 0; k < 2; ++k) \
        acc[ai][bj][m][n] = __builtin_amdgcn_mfma_f32_16x16x32_bf16(Bt[n][k], At[m][k], acc[ai][bj][m][n], 0, 0, 0); __builtin_amdgcn_s_setprio(0); } while (0)
#define PG8_WAIT_V(n) asm volatile("s_waitcnt vmcnt(" #n ")" ::: "memory")
#define PG8_WAIT_L(n) asm volatile("s_waitcnt lgkmcnt(" #n ")" ::: "memory")
#define PG8_BAR __builtin_amdgcn_s_barrier()
#define PG8_SCHED __builtin_amdgcn_sched_barrier(0)
    Unit cur, nxt; int ui = 0;
    if (!S.next(0, cur)) return;
    f32x4 acc[2][2][4][2];
#pragma unroll
    for (int a = 0; a < 2; ++a)
#pragma unroll
        for (int b = 0; b < 2; ++b)
#pragma unroll
            for (int m = 0; m < 4; ++m)
#pragma unroll
                for (int n = 0; n < 2; ++n) acc[a][b][m][n] = (f32x4){0.f, 0.f, 0.f, 0.f};
    bf16x8 At[4][2], B0[2][2], B1[2][2];
    const char* cA = (const char*)g.A + (size_t)cur.pm * tstepA; const char* cB = (const char*)g.Bt + (size_t)cur.pn * tstepB;
    S.a_ready(cur);
    if constexpr (SP2) {
        PG8_STAGE(PG8_SB(0, 0), cB, voffB); PG8_STAGE(PG8_SB(0, 1), cB + hstepB, voffB); PG8_STAGE(PG8_SA(0, 0), cA, voffA); PG8_STAGE(PG8_SA(0, 1), cA + hstepA, voffA);
        if (wr == 1) PG8_BAR;
        PG8_WAIT_V(2); PG8_BAR;
        PG8_STAGE(PG8_SB(1, 0), cB + kstep, voffB); PG8_STAGE(PG8_SA(1, 0), cA + kstep, voffA); PG8_STAGE(PG8_SB(1, 1), cB + hstepB + kstep, voffB);
        PG8_WAIT_V(6); PG8_BAR;
    } else {
        PG8_STAGE(PG8_SB(0, 0), cB, voffB); PG8_STAGE(PG8_SA(0, 0), cA, voffA); PG8_STAGE(PG8_SB(0, 1), cB + hstepB, voffB); PG8_STAGE(PG8_SA(0, 1), cA + hstepA, voffA);
        if (wr == 1) PG8_BAR;
        PG8_WAIT_V(4); PG8_BAR;
        PG8_STAGE(PG8_SB(1, 0), cB + kstep, voffB); PG8_STAGE(PG8_SA(1, 0), cA + kstep, voffA); PG8_STAGE(PG8_SB(1, 1), cB + hstepB + kstep, voffB);
        PG8_WAIT_V(6); PG8_BAR;
    }
    for (;;) {
        const bool has_next = S.next(ui + 1, nxt);
        const char* uA = has_next ? (const char*)g.A + (size_t)nxt.pm * tstepA : cA; const char* uB = has_next ? (const char*)g.Bt + (size_t)nxt.pn * tstepB : cB;
        const char* sA = cA; const char* sB = cB;
#pragma unroll
        for (int part = 0; part < Epi::NPART; ++part) {
        const int seg0 = part == 0 ? 0 : Epi::SPLIT, seg1 = part == Epi::NPART - 1 ? Epi::NSEG : Epi::SPLIT;
#pragma nounroll
        for (int seg = seg0; seg < seg1; ++seg) {
        const bool lastseg = (seg == Epi::NSEG - 1);
        int ntc = nt; if constexpr (Epi::NSEG == 12) ntc = seg < 4 ? 8 : 2;
        const char* nA = lastseg ? uA : sA + (size_t)ntc * kstep; const char* nB = lastseg ? uB : sB + (size_t)ntc * kstep;
        for (int t = 0; t < ntc; t += 2) {
            const bool last = (t == ntc - 2);
            const char* a1 = sA + (size_t)(t + 1) * kstep;
            const char* a2 = last ? nA : sA + (size_t)(t + 2) * kstep; const char* b2 = last ? nB : sB + (size_t)(t + 2) * kstep;
            const char* a3 = a2 + kstep; const char* b3 = b2 + kstep;
            if (last && lastseg && has_next) S.a_ready(nxt);
            if constexpr (SP2) {
            PG8_LDB(B0, 0, 0); PG8_LDB(B1, 0, 1); PG8_SCHED; PG8_LDA(At, 0, 0); PG8_STAGE(PG8_SA(1, 1), a1 + hstepA, voffA);
            PG8_WAIT_V(8); PG8_WAIT_L(0); PG8_BAR; PG8_MMA(0, 0, At, B0); PG8_MMA(0, 1, At, B1); PG8_BAR; PG8_SCHED;
            PG8_LDA(At, 0, 1); PG8_STAGE(PG8_SB(0, 0), b2, voffB); PG8_STAGE(PG8_SB(0, 1), b2 + hstepB, voffB); PG8_STAGE(PG8_SA(0, 0), a2, voffA);
            PG8_WAIT_V(8); PG8_WAIT_L(0); PG8_BAR; PG8_MMA(1, 0, At, B0); PG8_MMA(1, 1, At, B1); PG8_BAR; PG8_SCHED;
            PG8_LDB(B0, 1, 0); PG8_LDB(B1, 1, 1); PG8_SCHED; PG8_LDA(At, 1, 0); PG8_STAGE(PG8_SA(0, 1), a2 + hstepA, voffA);
            PG8_WAIT_V(8); PG8_WAIT_L(0); PG8_BAR; PG8_MMA(0, 0, At, B0); PG8_MMA(0, 1, At, B1); PG8_BAR; PG8_SCHED;
            PG8_LDA(At, 1, 1); PG8_STAGE(PG8_SB(1, 0), b3, voffB); PG8_STAGE(PG8_SB(1, 1), b3 + hstepB, voffB); PG8_STAGE(PG8_SA(1, 0), a3, voffA);
            PG8_WAIT_V(8); PG8_WAIT_L(0); PG8_BAR; PG8_MMA(1, 0, At, B0); PG8_MMA(1, 1, At, B1); PG8_BAR; PG8_SCHED;
            } else {
            PG8_LDB(B0, 0, 0); PG8_SCHED; PG8_LDA(At, 0, 0); PG8_STAGE(PG8_SA(1, 1), a1 + hstepA, voffA);
            PG8_WAIT_L(8); PG8_BAR; PG8_WAIT_L(0); PG8_MMA(0, 0, At, B0); PG8_BAR; PG8_SCHED;
            PG8_LDB(B1, 0, 1); PG8_STAGE(PG8_SB(0, 0), b2, voffB);
            PG8_BAR; PG8_WAIT_L(0); PG8_MMA(0, 1, At, B1); PG8_BAR;
            PG8_LDA(At, 0, 1); PG8_STAGE(PG8_SA(0, 0), a2, voffA);
            PG8_BAR; PG8_WAIT_L(0); PG8_MMA(1, 0, At, B0); PG8_BAR; PG8_SCHED;
            PG8_STAGE(PG8_SB(0, 1), b2 + hstepB, voffB);
            PG8_WAIT_V(6); PG8_BAR; PG8_MMA(1, 1, At, B1); PG8_BAR;
            PG8_LDB(B0, 1, 0); PG8_SCHED; PG8_LDA(At, 1, 0); PG8_STAGE(PG8_SA(0, 1), a2 + hstepA, voffA);
            PG8_WAIT_L(8); PG8_BAR; PG8_WAIT_L(0); PG8_MMA(0, 0, At, B0); PG8_BAR; PG8_SCHED;
            PG8_LDB(B1, 1, 1); PG8_STAGE(PG8_SB(1, 0), b3, voffB);
            PG8_BAR; PG8_WAIT_L(0); PG8_MMA(0, 1, At, B1); PG8_BAR;
            PG8_LDA(At, 1, 1); PG8_STAGE(PG8_SA(1, 0), a3, voffA);
            PG8_BAR; PG8_WAIT_L(0); PG8_MMA(1, 0, At, B0); PG8_BAR; PG8_SCHED;
            PG8_STAGE(PG8_SB(1, 1), b3 + hstepB, voffB);
            PG8_WAIT_V(6); PG8_BAR; PG8_MMA(1, 1, At, B1); PG8_BAR;
            }
        }
        if constexpr (Epi::NSEG > 1) { if (!lastseg) { if (seg != seg1 - 1) E.khook(acc, seg, cur, wr, wc, fr, fq, (LAS const float*)(lds + RT_OFF)); sA = nA; sB = nB; } }
        }
        if constexpr (Epi::NPART > 1) { if (part + 1 < Epi::NPART) { __builtin_amdgcn_sched_barrier(0); E.parthook(acc, cur, wr, wc, fr, fq, (LAS const float*)(lds + RT_OFF)); __builtin_amdgcn_sched_barrier(0); } }
        }
        if constexpr (ALIGN_EPI) { if (wr == 0) PG8_BAR; }
        E(acc, cur, wr, wc, fr, fq); S.done(cur);
        if (!has_next) break;
#pragma unroll
        for (int a = 0; a < 2; ++a)
#pragma unroll
            for (int b = 0; b < 2; ++b)
#pragma unroll
                for (int m = 0; m < 4; ++m)
#pragma unroll
                    for (int n = 0; n < 2; ++n) acc[a][b][m][n] = (f32x4){0.f, 0.f, 0.f, 0.f};
        cur = nxt; cA = uA; cB = uB; ++ui;
        if constexpr (ALIGN_EPI) { if (wr == 1) PG8_BAR; }
    }
    PG8_WAIT_V(0);
    if constexpr (!ALIGN_EPI) { if (wr == 0) PG8_BAR; }
    PG8_BAR;
#undef PG8_SA
#undef PG8_SB
#undef PG8_STAGE
#undef voffA_s64
#undef voffB_s64
#undef PG8_LDA
#undef PG8_LDB
#undef PG8_MMA
#undef PG8_WAIT_V
#undef PG8_WAIT_L
#undef PG8_BAR
#undef PG8_SCHED
}
}
using pg8::Unit;


#define XB_TMO      128
#define XB_XCNT(j)  (256  + 64 * (j))
#define XB_XSUB(j)  (1280 + 64 * (j))
#define XB_XGEN(j)  (2304 + 64 * (j))
#define XB_TOP      3328
#define XB_TOPGEN   3392
#define XCD_BAR_WORDS 3456
#define XB_SPIN_CAP (1u << 22)
__device__ __forceinline__ unsigned xb_ld(unsigned* p)              { return __hip_atomic_load(p, __ATOMIC_RELAXED, __HIP_MEMORY_SCOPE_AGENT); }
__device__ __forceinline__ unsigned xb_add(unsigned* p, unsigned v) { return __hip_atomic_fetch_add(p, v, __ATOMIC_RELAXED, __HIP_MEMORY_SCOPE_AGENT); }
__device__ __forceinline__ unsigned xb_xcc_id() { return (unsigned)__builtin_amdgcn_s_getreg((3 << 11) | 20) & 0xFu; }
#define XB_SPIN(cond, bar) do { unsigned _sp = 0; while (cond) { __builtin_amdgcn_s_sleep(1); \
    if ((++_sp & 255u) == 0u) { if (xb_ld(&(bar)[XB_TMO])) break; if (_sp > XB_SPIN_CAP) { atomicAdd(&(bar)[XB_TMO], 1u); break; } } } } while (0)
struct XcdBarrier { unsigned* bar; unsigned x; volatile LAS unsigned* st; };
__device__ __forceinline__ XcdBarrier xcd_barrier_post(unsigned* bar, volatile LAS unsigned* st) {
    XcdBarrier b; b.bar = bar; b.x = xb_xcc_id(); b.st = st;
    if (threadIdx.x == 0) (void)xb_add(&bar[XB_XCNT(b.x)], 1u);
    return b;
}
__device__ __forceinline__ void xcd_barrier_complete(unsigned* bar, unsigned x, unsigned& nloc, unsigned& nx) {
    const unsigned G = gridDim.x * gridDim.y * gridDim.z;
    unsigned sum, cnt, mine, sp = 0u;
    for (;;) {
        sum = 0u; cnt = 0u; mine = 0u;
#pragma unroll
        for (unsigned j = 0; j < 16; ++j) { const unsigned c = xb_ld(&bar[XB_XCNT(j)]); sum += c; cnt += (c > 0u) ? 1u : 0u; mine = (j == x) ? c : mine; }
        if (sum == G) break;
        __builtin_amdgcn_s_sleep(1);
        if ((++sp & 255u) == 0u) { if (xb_ld(&bar[XB_TMO])) break; if (sp > XB_SPIN_CAP) { atomicAdd(&bar[XB_TMO], 1u); break; } }
    }
    nloc = mine > 0u ? mine : 1u; nx = cnt > 0u ? cnt : 1u;
}
__device__ __forceinline__ void xcd_barrier(const XcdBarrier& b) {
    asm volatile("s_waitcnt vmcnt(0)" ::: "memory");
    __syncthreads();
    if (threadIdx.x == 0) {
        unsigned* bar = b.bar;
        __builtin_amdgcn_s_waitcnt(0);
        unsigned nloc = b.st[0], nx = b.st[1];
        if (nloc == 0u) { xcd_barrier_complete(bar, b.x, nloc, nx); b.st[0] = nloc; b.st[1] = nx; }
        const unsigned old = xb_add(&bar[XB_XSUB(b.x)], 1u);
        const unsigned gen = old / nloc;
        if (old + 1u == (gen + 1u) * nloc) {
            __builtin_amdgcn_fence(__ATOMIC_RELEASE, "agent");
            asm volatile("s_waitcnt vmcnt(0)" ::: "memory");
            const unsigned og = xb_add(&bar[XB_TOP], 1u);
            const unsigned tg = og / nx;
            if (og + 1u == (tg + 1u) * nx) xb_add(&bar[XB_TOPGEN], 1u);
            else XB_SPIN(xb_ld(&bar[XB_TOPGEN]) == tg, bar);
            __builtin_amdgcn_fence(__ATOMIC_ACQUIRE, "agent");
            xb_add(&bar[XB_XGEN(b.x)], 1u);
            asm volatile("s_waitcnt vmcnt(0)" ::: "memory");
        } else {
            XB_SPIN(xb_ld(&bar[XB_XGEN(b.x)]) == gen, bar);
            __builtin_amdgcn_fence(__ATOMIC_ACQUIRE, "agent");
            asm volatile("s_waitcnt vmcnt(0)" ::: "memory");
        }
    }
    __syncthreads();
}

struct Args {
    const float* in[30];
    float* out;
    unsigned char* ws;
    int ph_lo, ph_hi;
};

struct Frame {
    LAS unsigned char* lds;
    int tid, lane, wave, G;
    const float* const* in;
    float* out;
    unsigned char* ws;
    __device__ __forceinline__ bf16_t* PROJ() const { return (bf16_t*)(ws + WS_PROJ); }
    __device__ __forceinline__ bf16_t* HALO() const { return (bf16_t*)(ws + WS_HALO); }
    __device__ __forceinline__ float* SMALL() const { return (float*)(ws + WS_SMALL); }
    __device__ __forceinline__ bf16_t* XN() const { return (bf16_t*)(ws + WS_XN); }
    __device__ __forceinline__ bf16_t* PB() const { return (bf16_t*)(ws + WS_PB); }
    __device__ __forceinline__ float* SS1() const { return (float*)(ws + WS_SS1); }
    __device__ __forceinline__ float* SS2() const { return (float*)(ws + WS_SS2); }
    __device__ __forceinline__ float* SS3() const { return (float*)(ws + WS_SS3); }
};

constexpr int NWAVES = 8;
constexpr int RING_BYTES = 131072, LDS_BYTES = 162816, MISC_OFF = LDS_BYTES - 1024;

struct EpiInProj {
    static constexpr bool PERM = true; static constexpr int NSEG = 1; static constexpr int NPART = 1, SPLIT = 0;
    bf16_t* PROJ; bf16_t* HALO; float* SMALL; const float* cws; const float* cbs; const float* cwg; LAS float* nt_;
    __device__ __forceinline__ void operator()(const f32x4 (&acc)[2][2][4][2], const Unit& u, int wr, int wc, int fr, int fq) const {
        const int row0 = u.pm * 256 + wr * 64 + fr;
        if (u.pn >= CONV_FUSE_LO && u.pn < CONV_FUSE_HI && u.pm < MPR / 256) {
            f32x4 (&av)[2][2][4][2] = const_cast<f32x4 (&)[2][2][4][2]>(acc);
            const bool is_ssm = u.pn < 20, nrm = u.pn >= 20 && u.pn < 28;
            const int col0 = u.pn * 256 + wc * 32 + 8 * fq, cc0 = col0 - C_XS, wc0 = is_ssm ? cc0 : cc0 - 3072;
            const float* cw = is_ssm ? cws : cwg;
#pragma unroll
            for (int bj = 0; bj < 2; ++bj) {
                float w0[8], w1[8], w2[8], w3[8], bs[8];
                { const float* wp = cw + wc0 + bj * 128;
#pragma unroll
                  for (int h = 0; h < 2; ++h) { const f32x4 a0 = *(const f32x4*)(wp + 4 * h), a1 = *(const f32x4*)(wp + 3072 + 4 * h), a2 = *(const f32x4*)(wp + 2 * 3072 + 4 * h), a3 = *(const f32x4*)(wp + 3 * 3072 + 4 * h);
                      f32x4 bb = (f32x4){0.f, 0.f, 0.f, 0.f}; if (is_ssm) bb = *(const f32x4*)(cbs + wc0 + bj * 128 + 4 * h);
#pragma unroll
                      for (int i = 0; i < 4; ++i) { w0[4 * h + i] = a0[i]; w1[4 * h + i] = a1[i]; w2[4 * h + i] = a2[i]; w3[4 * h + i] = a3[i]; bs[4 * h + i] = bb[i]; } } }
#pragma unroll
                for (int ai = 0; ai < 2; ++ai)
#pragma unroll
                    for (int mm = 0; mm < 4; ++mm) {
                        const int m = 3 - mm, mp = m > 0 ? m - 1 : 0;
                        const int row = row0 + ai * 128 + m * 16;
                        if (m == 3) {
                            const f32x4 v0 = av[ai][bj][3][0], v1 = av[ai][bj][3][1];
                            u32x4 w; w.x = cvt_pk_bf16(v0[0], v0[1]); w.y = cvt_pk_bf16(v0[2], v0[3]); w.z = cvt_pk_bf16(v1[0], v1[1]); w.w = cvt_pk_bf16(v1[2], v1[3]);
                            if (fr >= 13) *(u32x4*)(HALO + ((size_t)(row >> 6) * 3 + (fr - 13)) * NCH + cc0 + bj * 128) = w;
                        }
                        float o[8], ss = 0.f;
#pragma unroll
                        for (int e = 0; e < 8; ++e) {
                            const float x = av[ai][bj][m][e >> 2][e & 3], pv = av[ai][bj][mp][e >> 2][e & 3];
                            const float t1 = dpp_prev<1>(x, pv), t2 = dpp_prev<2>(x, pv), t3 = dpp_prev<3>(x, pv);
                            float v = w3[e] * x + bs[e]; v += w2[e] * t1; v += w1[e] * t2; v += w0[e] * t3;
                            v = siluf_(v); ss += v * v;
                            o[e] = (m == 0 && fr < 3) ? x : v;
                        }
                        if (nrm) {
                            av[ai][bj][m][0] = (f32x4){o[0], o[1], o[2], o[3]}; av[ai][bj][m][1] = (f32x4){o[4], o[5], o[6], o[7]};
                            ss += __shfl_xor(ss, 16); ss += __shfl_xor(ss, 32);
                            if (fq == 0) nt_[((ai * 128 + wr * 64 + m * 16 + fr) * 2 + bj) * 4 + wc] = ss;
                        } else __builtin_nontemporal_store(pack8(o), (u32x4*)(PROJ + (size_t)row * LDP + col0 + bj * 128));
                    }
            }
            if (nrm) {
                asm volatile("s_waitcnt lgkmcnt(0)" ::: "memory"); __builtin_amdgcn_s_barrier(); asm volatile("" ::: "memory");
                const float qs = u.pn < 24 ? 0.08838834764831845f : 1.0f;
#pragma unroll
                for (int ai = 0; ai < 2; ++ai)
#pragma unroll
                    for (int m = 0; m < 4; ++m) {
                        const int rl = ai * 128 + wr * 64 + m * 16 + fr;
#pragma unroll
                        for (int bj = 0; bj < 2; ++bj) {
                            const f32x4 pq = *(LAS const f32x4*)(nt_ + (rl * 2 + bj) * 4);
                            float rn = rsqrtf((pq[0] + pq[1]) + (pq[2] + pq[3]) + EPS) * qs;
                            if (m == 0 && fr < 3) rn = 1.0f;
                            const f32x4 v0 = av[ai][bj][m][0] * rn, v1 = av[ai][bj][m][1] * rn;
                            u32x4 w; w.x = cvt_pk_bf16(v0[0], v0[1]); w.y = cvt_pk_bf16(v0[2], v0[3]); w.z = cvt_pk_bf16(v1[0], v1[1]); w.w = cvt_pk_bf16(v1[2], v1[3]);
                            __builtin_nontemporal_store(w, (u32x4*)(PROJ + (size_t)(u.pm * 256 + rl) * LDP + col0 + bj * 128));
                        }
                    }
            }
        } else if (u.pn < 44) {
            const int col0 = u.pn * 256 + wc * 32 + 8 * fq;
            const bool conv_tile = (u.pn >= 8 && u.pn < 32);
#pragma unroll
            for (int ai = 0; ai < 2; ++ai)
#pragma unroll
                for (int m = 0; m < 4; ++m) {
                    const int row = row0 + ai * 128 + m * 16;
                    bf16_t* rowp = PROJ + (size_t)row * LDP + col0;
#pragma unroll
                    for (int bj = 0; bj < 2; ++bj) {
                        const f32x4 v0 = acc[ai][bj][m][0], v1 = acc[ai][bj][m][1];
                        u32x4 w; w.x = cvt_pk_bf16(v0[0], v0[1]); w.y = cvt_pk_bf16(v0[2], v0[3]); w.z = cvt_pk_bf16(v1[0], v1[1]); w.w = cvt_pk_bf16(v1[2], v1[3]);
                        __builtin_nontemporal_store(w, (u32x4*)(rowp + bj * 128));
                        if (m == 3 && conv_tile && fr >= 13) {
                            bf16_t* hp = HALO + ((size_t)(row >> 6) * 3 + (fr - 13)) * NCH + (col0 - C_XS) + bj * 128;
                            *(u32x4*)hp = w;
                        }
                    }
                }
        } else {
            if (wc < 2) {
                const int col0 = wc * 32 + 8 * fq;
#pragma unroll
                for (int ai = 0; ai < 2; ++ai)
#pragma unroll
                    for (int m = 0; m < 4; ++m) {
                        const int row = row0 + ai * 128 + m * 16;
                        float* sp = SMALL + (size_t)row * 64 + col0;
                        *(f32x4*)sp = acc[ai][0][m][0]; *(f32x4*)(sp + 4) = acc[ai][0][m][1];
                    }
            }
        }
    }
};

struct EpiT1 {
    static constexpr bool PERM = true; static constexpr int NSEG = 4; static constexpr int NPART = 1, SPLIT = 0;
    bf16_t* PROJ; LAS const float* rl;
    __device__ __forceinline__ void khook(f32x4 (&acc)[2][2][4][2], int b, int wr, int fr, LAS const float* rt) const {
#pragma unroll
        for (int ai = 0; ai < 2; ++ai)
#pragma unroll
            for (int m = 0; m < 4; ++m) { const float rr = rt[b * 256 + ai * 128 + wr * 64 + m * 16 + fr];
#pragma unroll
                for (int bj = 0; bj < 2; ++bj) { acc[ai][bj][m][0] *= rr; acc[ai][bj][m][1] *= rr; } }
    }
    __device__ __forceinline__ void operator()(const f32x4 (&acc)[2][2][4][2], const Unit& u, int wr, int wc, int fr, int fq) const {
        const int row0 = u.pm * 256 + wr * 64 + fr, col0 = u.pn * 256 + wc * 32 + 8 * fq;
#pragma unroll
        for (int ai = 0; ai < 2; ++ai)
#pragma unroll
            for (int m = 0; m < 4; ++m) {
                const int row = row0 + ai * 128 + m * 16;
                const float rlast = rl[ai * 128 + wr * 64 + m * 16 + fr];
#pragma unroll
                for (int bj = 0; bj < 2; ++bj) {
                    const int col = col0 + bj * 128;
                    const u32x4 mgw = *(const u32x4*)(PROJ + (size_t)row * LDP + C_MG + col);
                    float mg[8]; unpack8(mgw, mg);
                    const f32x4 v0 = acc[ai][bj][m][0], v1 = acc[ai][bj][m][1];
                    float o[8];
#pragma unroll
                    for (int i = 0; i < 4; ++i) { o[i] = v0[i] * rlast * sigmoidf_(mg[i]); o[4 + i] = v1[i] * rlast * sigmoidf_(mg[4 + i]); }
                    *(u32x4*)(PROJ + (size_t)row * LDP + C_Z + col) = pack8(o);
                }
            }
    }
};

struct EpiMix {
    static constexpr bool PERM = true; static constexpr int NSEG = 8; static constexpr int NPART = 1, SPLIT = 0;
    bf16_t* PROJ; LAS const float* rl;
    __device__ __forceinline__ void khook(f32x4 (&acc)[2][2][4][2], int b, int wr, int fr, LAS const float* rt) const {
#pragma unroll
        for (int ai = 0; ai < 2; ++ai)
#pragma unroll
            for (int m = 0; m < 4; ++m) { const float rr = rt[b * 256 + ai * 128 + wr * 64 + m * 16 + fr];
#pragma unroll
                for (int bj = 0; bj < 2; ++bj) { acc[ai][bj][m][0] *= rr; acc[ai][bj][m][1] *= rr; } }
    }
    __device__ __forceinline__ void operator()(const f32x4 (&acc)[2][2][4][2], const Unit& u, int wr, int wc, int fr, int fq) const {
        const int row0 = u.pm * 256 + wr * 64 + fr, col0 = u.pn * 256 + wc * 32 + 8 * fq;
#pragma unroll
        for (int ai = 0; ai < 2; ++ai)
#pragma unroll
            for (int m = 0; m < 4; ++m) {
                const int row = row0 + ai * 128 + m * 16;
                const float rlast = rl[ai * 128 + wr * 64 + m * 16 + fr];
#pragma unroll
                for (int bj = 0; bj < 2; ++bj) {
                    const int col = col0 + bj * 128;
                    const u32x4 mgw = *(const u32x4*)(PROJ + (size_t)row * LDP + C_MG + 1024 + col);
                    float mg[8]; unpack8(mgw, mg);
                    float t1v[8]; unpack8(*(const u32x4*)(PROJ + (size_t)row * LDP + C_Z + col), t1v);
                    const f32x4 v0 = acc[ai][bj][m][0], v1 = acc[ai][bj][m][1];
                    float o[8];
#pragma unroll
                    for (int i = 0; i < 4; ++i) { o[i] = t1v[i] + v0[i] * rlast * sigmoidf_(mg[i]); o[4 + i] = t1v[4 + i] + v1[i] * rlast * sigmoidf_(mg[4 + i]); }
                    *(u32x4*)(PROJ + (size_t)row * LDP + C_Q + col) = pack8(o);
                }
            }
    }
};

struct EpiMixCat {
    static constexpr bool PERM = true; static constexpr int NSEG = 12; static constexpr int NPART = 2, SPLIT = 4;
    bf16_t* PROJ; LAS const float* rl;
    __device__ __forceinline__ void khook(f32x4 (&acc)[2][2][4][2], int seg, const Unit&, int wr, int, int fr, int, LAS const float* rt) const {
#pragma unroll
        for (int ai = 0; ai < 2; ++ai)
#pragma unroll
            for (int m = 0; m < 4; ++m) { const float rr = rt[seg * 256 + ai * 128 + wr * 64 + m * 16 + fr];
#pragma unroll
                for (int bj = 0; bj < 2; ++bj) { acc[ai][bj][m][0] *= rr; acc[ai][bj][m][1] *= rr; } }
    }
    __device__ __forceinline__ void parthook(f32x4 (&acc)[2][2][4][2], const Unit& u, int wr, int wc, int fr, int fq, LAS const float* rt) const {
        const int row0 = u.pm * 256 + wr * 64 + fr, col0 = u.pn * 256 + wc * 32 + 8 * fq;
#pragma unroll
        for (int ai = 0; ai < 2; ++ai) {
            int rowa = row0 + ai * 128; asm volatile("" : "+v"(rowa));
            u32x4 w1[4][2], w2[4][2];
#pragma unroll
            for (int m = 0; m < 4; ++m)
#pragma unroll
                for (int bj = 0; bj < 2; ++bj) {
                    const unsigned goff = (unsigned)(rowa + m * 16) * (unsigned)(LDP * 2) + (unsigned)(C_MG + col0 + bj * 128) * 2u;
                    w1[m][bj] = *(const u32x4*)((const char*)PROJ + goff); w2[m][bj] = *(const u32x4*)((const char*)PROJ + goff + 2048);
                }
            __builtin_amdgcn_sched_barrier(0);
#pragma unroll
            for (int m = 0; m < 4; ++m) {
                const float rr = rt[3 * 256 + ai * 128 + wr * 64 + m * 16 + fr];
#pragma unroll
                for (int bj = 0; bj < 2; ++bj) {
#pragma unroll
                    for (int q = 0; q < 4; ++q) {
                        const float flo = rr * (1.0f + __builtin_amdgcn_exp2f(-1.4426950408889634f * bflo(w2[m][bj][q]))) * __builtin_amdgcn_rcpf(1.0f + __builtin_amdgcn_exp2f(-1.4426950408889634f * bflo(w1[m][bj][q])));
                        const float fhi = rr * (1.0f + __builtin_amdgcn_exp2f(-1.4426950408889634f * bfhi(w2[m][bj][q]))) * __builtin_amdgcn_rcpf(1.0f + __builtin_amdgcn_exp2f(-1.4426950408889634f * bfhi(w1[m][bj][q])));
                        acc[ai][bj][m][q >> 1][2 * (q & 1)] *= flo; acc[ai][bj][m][q >> 1][2 * (q & 1) + 1] *= fhi;
                    }
                }
            }
            __builtin_amdgcn_sched_barrier(0);
        }
    }
    __device__ __forceinline__ void operator()(const f32x4 (&acc)[2][2][4][2], const Unit& u, int wr, int wc, int fr, int fq) const {
        const int row0 = u.pm * 256 + wr * 64 + fr, col0 = u.pn * 256 + wc * 32 + 8 * fq;
#pragma unroll
        for (int ai = 0; ai < 2; ++ai)
#pragma unroll
            for (int m = 0; m < 4; ++m) {
                const int row = row0 + ai * 128 + m * 16;
                const float rlast = rl[ai * 128 + wr * 64 + m * 16 + fr];
#pragma unroll
                for (int bj = 0; bj < 2; ++bj) {
                    const int col = col0 + bj * 128;
                    float mg[8]; unpack8(*(const u32x4*)(PROJ + (size_t)row * LDP + C_MG + 1024 + col), mg);
                    const f32x4 v0 = acc[ai][bj][m][0], v1 = acc[ai][bj][m][1];
                    float o[8];
#pragma unroll
                    for (int i = 0; i < 4; ++i) { o[i] = v0[i] * rlast * sigmoidf_(mg[i]); o[4 + i] = v1[i] * rlast * sigmoidf_(mg[4 + i]); }
                    *(u32x4*)(PROJ + (size_t)row * LDP + C_Q + col) = pack8(o);
                }
            }
    }
};

template <int MODE> struct EpiResid {
    static constexpr bool PERM = true; static constexpr int NSEG = 1; static constexpr int NPART = 1, SPLIT = 0;
    bf16_t* PROJ; const float* xp; const float* xs; int res_col, dstb_col; float* SS;
    __device__ __forceinline__ void operator()(const f32x4 (&acc)[2][2][4][2], const Unit& u, int wr, int wc, int fr, int fq) const {
        const int row0 = u.pm * 256 + wr * 64 + fr, col0 = u.pn * 256 + wc * 32 + 8 * fq;
#pragma unroll
        for (int ai = 0; ai < 2; ++ai)
#pragma unroll
            for (int m = 0; m < 4; ++m) {
                const int row = row0 + ai * 128 + m * 16;
                float ss = 0.f;
#pragma unroll
                for (int bj = 0; bj < 2; ++bj) {
                    const int col = col0 + bj * 128;
                    f32x4 r0 = (f32x4){0.f, 0.f, 0.f, 0.f}, r1 = r0;
                    if (MODE == 0) {
                        if (row < MTOT) { const float* rp = (row < MPR ? xp + (size_t)row * D : xs + (size_t)(row - MPR) * D) + col; r0 = *(const f32x4*)rp; r1 = *(const f32x4*)(rp + 4); }
                    } else {
                        float rv[8]; unpack8(*(const u32x4*)(PROJ + (size_t)row * LDP + res_col + col), rv);
                        r0 = (f32x4){rv[0], rv[1], rv[2], rv[3]}; r1 = (f32x4){rv[4], rv[5], rv[6], rv[7]};
                    }
                    const f32x4 x0 = r0 + acc[ai][bj][m][0], x1 = r1 + acc[ai][bj][m][1];
                    u32x4 w; w.x = cvt_pk_bf16(x0[0], x0[1]); w.y = cvt_pk_bf16(x0[2], x0[3]); w.z = cvt_pk_bf16(x1[0], x1[1]); w.w = cvt_pk_bf16(x1[2], x1[3]);
                    *(u32x4*)(PROJ + (size_t)row * LDP + dstb_col + col) = w;
                    ss += (x0[0] * x0[0] + x0[1] * x0[1]) + (x0[2] * x0[2] + x0[3] * x0[3]) + (x1[0] * x1[0] + x1[1] * x1[1]) + (x1[2] * x1[2] + x1[3] * x1[3]);
                }
                ss += __shfl_xor(ss, 16); ss += __shfl_xor(ss, 32);
                if (fq == 0) atomicAdd(SS + row, ss);
            }
    }
};

struct EpiSwiGLU {
    static constexpr bool PERM = true; static constexpr int NSEG = 1; static constexpr int NPART = 1, SPLIT = 0;
    bf16_t* PROJ; const float* SS;
    __device__ __forceinline__ void operator()(const f32x4 (&acc)[2][2][4][2], const Unit& u, int wr, int wc, int fr, int fq) const {
        const int row0 = u.pm * 256 + wr * 64 + fr, col0 = u.pn * 128 + wc * 32 + 8 * fq;
#pragma unroll
        for (int ai = 0; ai < 2; ++ai)
#pragma unroll
            for (int m = 0; m < 4; ++m) {
                const int row = row0 + ai * 128 + m * 16;
                const float r = rsqrtf(SS[row] * (1.0f / D) + EPS);
                const f32x4 g0 = acc[ai][0][m][0], g1 = acc[ai][0][m][1], u0 = acc[ai][1][m][0], u1 = acc[ai][1][m][1];
                float o[8];
#pragma unroll
                for (int i = 0; i < 4; ++i) { o[i] = siluf_(r * g0[i]) * (r * u0[i]); o[4 + i] = siluf_(r * g1[i]) * (r * u1[i]); }
                __builtin_nontemporal_store(pack8(o), (u32x4*)(PROJ + (size_t)row * LDP + C_XS + col0));
            }
    }
};

struct EpiPE {
    static constexpr bool PERM = true; static constexpr int NSEG = 1; static constexpr int NPART = 1, SPLIT = 0;
    bf16_t* PROJ;
    __device__ __forceinline__ void operator()(const f32x4 (&acc)[2][2][4][2], const Unit& u, int wr, int wc, int fr, int fq) const {
        const int row0 = u.pm * 256 + wr * 64 + fr, col0 = u.pn * 256 + wc * 32 + 8 * fq;
#pragma unroll
        for (int ai = 0; ai < 2; ++ai)
#pragma unroll
            for (int m = 0; m < 4; ++m) {
                const int row = row0 + ai * 128 + m * 16;
#pragma unroll
                for (int bj = 0; bj < 2; ++bj) {
                    const f32x4 v0 = acc[ai][bj][m][0], v1 = acc[ai][bj][m][1];
                    u32x4 w; w.x = cvt_pk_bf16(v0[0], v0[1]); w.y = cvt_pk_bf16(v0[2], v0[3]); w.z = cvt_pk_bf16(v1[0], v1[1]); w.w = cvt_pk_bf16(v1[2], v1[3]);
                    *(u32x4*)(PROJ + (size_t)row * LDP + C_Z + col0 + bj * 128) = w;
                }
            }
    }
};

struct EpiX3 {
    static constexpr bool PERM = true; static constexpr int NSEG = 1; static constexpr int NPART = 1, SPLIT = 0;
    bf16_t* PROJ; const float* SS2; float* SS3; float* out; unsigned* cnt; unsigned* bar; const float* gf; LAS float* rt;
    __device__ __forceinline__ void operator()(const f32x4 (&acc_)[2][2][4][2], const Unit& u, int wr, int wc, int fr, int fq) const {
        f32x4 (&acc)[2][2][4][2] = const_cast<f32x4 (&)[2][2][4][2]>(acc_);
        const int row0 = u.pm * 256 + wr * 64 + fr, col0 = u.pn * 256 + wc * 32 + 8 * fq;
#pragma unroll
        for (int ai = 0; ai < 2; ++ai)
#pragma unroll
            for (int m = 0; m < 4; ++m) {
                const int row = row0 + ai * 128 + m * 16;
                const float r = rsqrtf(SS2[row] * (1.0f / D) + EPS);
                float ss = 0.f;
#pragma unroll
                for (int bj = 0; bj < 2; ++bj) {
                    const int col = col0 + bj * 128;
                    float xa[8], pa[8]; unpack8(*(const u32x4*)(PROJ + (size_t)row * LDP + C_GATE + col), xa); unpack8(*(const u32x4*)(PROJ + (size_t)row * LDP + C_Z + col), pa);
                    const f32x4 a0 = (f32x4){xa[0], xa[1], xa[2], xa[3]}, a1 = (f32x4){xa[4], xa[5], xa[6], xa[7]}, p0 = (f32x4){pa[0], pa[1], pa[2], pa[3]}, p1 = (f32x4){pa[4], pa[5], pa[6], pa[7]};
                    const f32x4 v0 = acc[ai][bj][m][0], v1 = acc[ai][bj][m][1];
                    f32x4 x0, x1;
#pragma unroll
                    for (int i = 0; i < 4; ++i) { x0[i] = a0[i] + p0[i] * sigmoidf_(r * v0[i]); x1[i] = a1[i] + p1[i] * sigmoidf_(r * v1[i]); }
                    acc[ai][bj][m][0] = x0; acc[ai][bj][m][1] = x1;
                    ss += (x0[0] * x0[0] + x0[1] * x0[1]) + (x0[2] * x0[2] + x0[3] * x0[3]) + (x1[0] * x1[0] + x1[1] * x1[1]) + (x1[2] * x1[2] + x1[3] * x1[3]);
                }
                ss += __shfl_xor(ss, 16); ss += __shfl_xor(ss, 32);
                if (fq == 0) atomicAdd(SS3 + row, ss);
            }
        asm volatile("s_waitcnt vmcnt(0)" ::: "memory");
        unsigned* c = cnt + 64 * u.pm;
        if ((threadIdx.x & 63) == 0) (void)xb_add(c, 1u);
        if (threadIdx.x < 64) { unsigned sp = 0u; while ((unsigned)__builtin_amdgcn_readfirstlane(xb_ld(c)) < 32u) { __builtin_amdgcn_s_sleep(1);
            if ((++sp & 255u) == 0u) { if (xb_ld(&bar[XB_TMO])) break; if (sp > XB_SPIN_CAP) { atomicAdd(&bar[XB_TMO], 1u); break; } } } }
        asm volatile("s_waitcnt vmcnt(0) lgkmcnt(0)" ::: "memory"); __builtin_amdgcn_s_barrier(); asm volatile("" ::: "memory");
        if (threadIdx.x < 256) rt[threadIdx.x] = rsqrtf(__uint_as_float(xb_ld((unsigned*)(SS3 + u.pm * 256 + threadIdx.x))) * (1.0f / D) + EPS);
        asm volatile("s_waitcnt vmcnt(0) lgkmcnt(0)" ::: "memory"); __builtin_amdgcn_s_barrier(); asm volatile("" ::: "memory");
        f32x4 gq[2][2];
#pragma unroll
        for (int bj = 0; bj < 2; ++bj) { gq[bj][0] = *(const f32x4*)(gf + col0 + bj * 128); gq[bj][1] = *(const f32x4*)(gf + col0 + bj * 128 + 4); }
#pragma unroll
        for (int ai = 0; ai < 2; ++ai)
#pragma unroll
            for (int m = 0; m < 4; ++m) {
                const int rl = ai * 128 + wr * 64 + m * 16 + fr;
                const float r3 = rt[rl];
                float* orow = out + O_Y + (size_t)(u.pm * 256 + rl) * D + col0;
#pragma unroll
                for (int bj = 0; bj < 2; ++bj) {
                    *(f32x4*)(orow + bj * 128) = acc[ai][bj][m][0] * r3 * gq[bj][0];
                    *(f32x4*)(orow + bj * 128 + 4) = acc[ai][bj][m][1] * r3 * gq[bj][1];
                }
            }
    }
};

struct MapIdent { __device__ __forceinline__ int operator()(int n) const { return n; } };
struct MapWin {
    __device__ __forceinline__ int operator()(int n) const {
        if (n < 5120) return n;
        if (n < 9216) return n + 32;
        if (n < 11264) return n + 48;
        const int j = n - 11264;
        if (j < 32) return 5120 + j;
        if (j < 48) return 9216 + j;
        return -1;
    }
};
struct MapFfn {
    __device__ __forceinline__ int operator()(int n) const { const int j = n >> 8, r = n & 255; return r < 128 ? 128 * j + r : DFF + 128 * j + (r - 128); }
};
template <class Map>
__device__ __forceinline__ void transpose_item(const float* W, int K, int Nsrc, int Ndst, bf16_t* WT, const float* gain, LAS float* scr, int item, int lane, Map map) {
    const int nblk = Ndst / 32, kb = item / nblk, nb = item % nblk, k0 = 64 * kb, n0 = 32 * nb;
    const int sc = map(n0 + (lane & 31));
    float tv[32];
#pragma unroll
    for (int i = 0; i < 32; ++i) { const int kk = 2 * i + (lane >> 5); tv[i] = sc >= 0 ? W[(size_t)(k0 + kk) * Nsrc + sc] : 0.f; }
#pragma unroll
    for (int i = 0; i < 32; ++i) { const int kk = 2 * i + (lane >> 5); float v = tv[i]; if (gain) v *= gain[k0 + kk]; scr[kk * 33 + (lane & 31)] = v; }
    asm volatile("s_waitcnt lgkmcnt(0)" ::: "memory");
    const int c = lane & 7;
#pragma unroll
    for (int j = 0; j < 4; ++j) { const int n = (lane >> 3) + 8 * j; const LAS float* s = scr + (8 * c) * 33 + n;
        u32x4 o; o.x = cvt_pk_bf16(s[0 * 33], s[1 * 33]); o.y = cvt_pk_bf16(s[2 * 33], s[3 * 33]); o.z = cvt_pk_bf16(s[4 * 33], s[5 * 33]); o.w = cvt_pk_bf16(s[6 * 33], s[7 * 33]);
        *(u32x4*)(WT + (size_t)(n0 + n) * K + k0 + 8 * c) = o; }
    asm volatile("s_waitcnt lgkmcnt(0)" ::: "memory");
}

struct TItem { const float* W; const float* gain; bf16_t* WT; int K, Nsrc, k0, n0, sc, ldk, koff; };
__device__ __forceinline__ TItem p0_decode(const Frame& F, int it, int lane) {
    constexpr int I_WIN = 16 * (NPROJ / 32), I_WBS = 32 * 32, I_WBG = 16 * 32, I_WOUT = 16 * 32, I_WFI = 16 * (2 * DFF / 32), I_WFO = (DFF / 64) * 32, I_WPG = 16 * 32;
    unsigned char* ws = F.ws;
    TItem t; int r = it, Ndst, mapid = 0; t.ldk = 0; t.koff = 0;
    if (r < I_WIN) { t.W = F.in[9]; t.gain = nullptr; t.WT = (bf16_t*)(ws + WS_WIN); t.K = D; t.Nsrc = NIN; Ndst = NPROJ; mapid = 1; }
    else if ((r -= I_WIN) < I_WBS) { t.W = F.in[20]; t.gain = F.in[15];     t.WT = (bf16_t*)(ws + WS_WBS); t.K = 2048; t.Nsrc = D; Ndst = D; t.ldk = 3072; t.koff = 0; }
    else if ((r -= I_WBS) < I_WBG) { t.W = F.in[21]; t.gain = nullptr; t.WT = (bf16_t*)(ws + WS_WBS); t.K = D; t.Nsrc = D; Ndst = D; t.ldk = 3072; t.koff = 2048; }
    else if ((r -= I_WBG) < I_WOUT) { t.W = F.in[22]; t.gain = nullptr; t.WT = (bf16_t*)(ws + WS_WOUT); t.K = D; t.Nsrc = D; Ndst = D; }
    else if ((r -= I_WOUT) < I_WFI) { t.W = F.in[24]; t.gain = F.in[23]; t.WT = (bf16_t*)(ws + WS_WFI); t.K = D; t.Nsrc = 2 * DFF; Ndst = 2 * DFF; mapid = 2; }
    else if ((r -= I_WFI) < I_WFO) { t.W = F.in[25]; t.gain = nullptr; t.WT = (bf16_t*)(ws + WS_WFO); t.K = DFF; t.Nsrc = D; Ndst = D; }
    else if ((r -= I_WFO) < I_WPG) { t.W = F.in[27]; t.gain = F.in[26]; t.WT = (bf16_t*)(ws + WS_WPG); t.K = D; t.Nsrc = D; Ndst = D; }
    else { r -= I_WPG; t.W = F.in[28]; t.gain = nullptr; t.WT = (bf16_t*)(ws + WS_WPP); t.K = 256; t.Nsrc = D; Ndst = D; }
    if (t.ldk == 0) t.ldk = t.K;
    const int nblk = Ndst / 32; t.k0 = 64 * (r / nblk); t.n0 = 32 * (r % nblk);
    const int n = t.n0 + 4 * (lane & 7);
    t.sc = mapid == 1 ? MapWin()(n) : mapid == 2 ? MapFfn()(n) : n;
    return t;
}
__device__ __forceinline__ void p0_load(const TItem& t, int lane, f32x4 (&tv)[8]) {
#pragma unroll
    for (int i = 0; i < 8; ++i) { const int kk = 8 * i + (lane >> 3); tv[i] = t.sc >= 0 ? *(const f32x4*)(t.W + (size_t)(t.k0 + kk) * t.Nsrc + t.sc) : (f32x4){0.f, 0.f, 0.f, 0.f}; }
}
__device__ __forceinline__ void p0_finish(const TItem& t, int lane, const f32x4 (&tv)[8], LAS float* scr) {
#pragma unroll
    for (int i = 0; i < 8; ++i) { const int kk = 8 * i + (lane >> 3); f32x4 v = tv[i]; if (t.gain) v = v * t.gain[t.k0 + kk];
#pragma unroll
        for (int e = 0; e < 4; ++e) scr[kk * 33 + 4 * (lane & 7) + e] = v[e]; }
    asm volatile("s_waitcnt lgkmcnt(0)" ::: "memory");
    const int c = lane & 7;
#pragma unroll
    for (int j = 0; j < 4; ++j) { const int n = (lane >> 3) + 8 * j; const LAS float* sp = scr + (8 * c) * 33 + n;
        u32x4 o; o.x = cvt_pk_bf16(sp[0 * 33], sp[1 * 33]); o.y = cvt_pk_bf16(sp[2 * 33], sp[3 * 33]); o.z = cvt_pk_bf16(sp[4 * 33], sp[5 * 33]); o.w = cvt_pk_bf16(sp[6 * 33], sp[7 * 33]);
        *(u32x4*)(t.WT + (size_t)(t.n0 + n) * t.ldk + t.koff + t.k0 + 8 * c) = o; }
    asm volatile("s_waitcnt lgkmcnt(0)" ::: "memory");
}
__device__ __forceinline__ void p0_prologue(Frame& F, int mode, int gw, int NGW) {
    LAS float* scr = (LAS float*)(F.lds + F.wave * 16384);
    const int lane = F.lane;
    constexpr int I_WIN = 16 * (NPROJ / 32);
    constexpr int NITEMS = I_WIN + 32 * 32 + 16 * 32 + 16 * 32 + 16 * (2 * DFF / 32) + (DFF / 64) * 32 + 16 * 32 + 4 * 32;
    const int it_lo = mode == 0 ? 0 : I_WIN, it_hi = mode == 0 ? I_WIN : NITEMS;
    if (it_lo + gw < it_hi) {
        TItem cur = p0_decode(F, it_lo + gw, lane); f32x4 tv[8]; p0_load(cur, lane, tv);
        for (int it = it_lo + gw; it < it_hi; it += NGW) {
            const bool more = it + NGW < it_hi;
            TItem nxt = cur; f32x4 tn[8];
            if (more) { nxt = p0_decode(F, it + NGW, lane); p0_load(nxt, lane, tn); }
            p0_finish(cur, lane, tv, scr);
            if (more) { cur = nxt;
#pragma unroll
                for (int i = 0; i < 8; ++i) tv[i] = tn[i]; }
        }
    }
    if (mode == 0) {
        const float* gmix = F.in[8];
        for (int m0 = gw; m0 < MP; m0 += 4 * NGW) {
            f32x4 v[4][4];
#pragma unroll
            for (int q = 0; q < 4; ++q) { const int m = m0 + q * NGW;
                if (m < MTOT) {
                    const float* xrow = m < MPR ? F.in[0] + (size_t)m * D : F.in[1] + (size_t)(m - MPR) * D;
#pragma unroll
                    for (int j = 0; j < 4; ++j) v[q][j] = ((const f32x4*)xrow)[64 * j + lane];
                } else {
#pragma unroll
                    for (int j = 0; j < 4; ++j) v[q][j] = (f32x4){0.f, 0.f, 0.f, 0.f};
                } }
#pragma unroll
            for (int q = 0; q < 4; ++q) { const int m = m0 + q * NGW;
                if (m < MP) {
                    u32x2* o8 = (u32x2*)(F.XN() + (size_t)m * D) + lane;
                    float sq = 0.f;
#pragma unroll
                    for (int j = 0; j < 4; ++j) sq += (v[q][j][0] * v[q][j][0] + v[q][j][1] * v[q][j][1]) + (v[q][j][2] * v[q][j][2] + v[q][j][3] * v[q][j][3]);
                    const float rs = rsqrtf(wave_sum(sq) * (1.0f / D) + EPS);
#pragma unroll
                    for (int j = 0; j < 4; ++j) { const f32x4 gv = ((const f32x4*)gmix)[64 * j + lane]; const f32x4 y = v[q][j] * rs * gv;
                        o8[64 * j] = (u32x2){cvt_pk_bf16(y[0], y[1]), cvt_pk_bf16(y[2], y[3])}; }
                } }
        }
    } else {
        for (int m0 = gw; m0 < MP; m0 += 8 * NGW) {
            f32x4 pv[8];
#pragma unroll
            for (int q = 0; q < 8; ++q) { const int m = m0 + q * NGW;
                pv[q] = m < MTOT ? ((const f32x4*)(m < MPR ? F.in[2] + (size_t)m * 256 : F.in[3] + (size_t)(m - MPR) * 256))[lane] : (f32x4){0.f, 0.f, 0.f, 0.f}; }
#pragma unroll
            for (int q = 0; q < 8; ++q) { const int m = m0 + q * NGW;
                if (m < MP) ((u32x2*)(F.PB() + (size_t)m * 256))[lane] = (u32x2){cvt_pk_bf16(pv[q][0], pv[q][1]), cvt_pk_bf16(pv[q][2], pv[q][3])}; }
        }
    }
}

__device__ __forceinline__ void p2_conv(Frame& F) {
    const int gt = blockIdx.x * (NWAVES * 64) + F.tid, NT = F.G * NWAVES * 64;
    constexpr int NCG = NCH / 8;
    constexpr int NU_F = (MPR / 64) * NCG, NU_S = NSMP * NCG;
    for (int u = gt; u < NU_F + NU_S; u += NT) {
        const bool smp = u >= NU_F;
        const int uu = smp ? u - NU_F : u;
        const int ch = uu / NCG, cgi = uu % NCG;
        const bool is_ssm = cgi < 384;
        const int cc = is_ssm ? cgi * 8 : (cgi - 384) * 8;
        const int kind = is_ssm ? 0 : 1 + (cgi - 384) / 128;
        const float* cw = is_ssm ? F.in[10] : F.in[16];
        float w[4][8], bias[8];
#pragma unroll
        for (int j = 0; j < 4; ++j) { const f32x4 a = *(const f32x4*)(cw + j * 3072 + cc), b = *(const f32x4*)(cw + j * 3072 + cc + 4);
#pragma unroll
            for (int i = 0; i < 4; ++i) { w[j][i] = a[i]; w[j][4 + i] = b[i]; } }
        if (is_ssm) { const f32x4 a = *(const f32x4*)(F.in[11] + cc), b = *(const f32x4*)(F.in[11] + cc + 4);
#pragma unroll
            for (int i = 0; i < 4; ++i) { bias[i] = a[i]; bias[4 + i] = b[i]; } }
        else {
#pragma unroll
            for (int i = 0; i < 8; ++i) bias[i] = 0.f; }
        float h0[8], h1[8], h2[8];
        const int pcol = C_XS + cgi * 8;
        if (smp) {
            const float* st = (is_ssm ? F.in[5] : F.in[7]) + (size_t)ch * 3 * 3072 + cc;
#pragma unroll
            for (int i = 0; i < 8; ++i) { h0[i] = st[i]; h1[i] = st[3072 + i]; h2[i] = st[2 * 3072 + i]; }
            bf16_t* rp = F.PROJ() + (size_t)(MPR + ch) * LDP + pcol;
            float x[8]; unpack8(*(const u32x4*)rp, x);
            float o[8]; float ss = 0.f;
#pragma unroll
            for (int i = 0; i < 8; ++i) { float v = w[0][i] * h0[i] + w[1][i] * h1[i] + w[2][i] * h2[i] + w[3][i] * x[i] + bias[i]; v = siluf_(v); o[i] = v; ss += v * v; }
            if (kind == 1 || kind == 2) {
                ss = row16_sum(ss);
                const float rn = rsqrtf(ss + EPS) * (kind == 1 ? 0.08838834764831845f : 1.0f);
#pragma unroll
                for (int i = 0; i < 8; ++i) o[i] *= rn;
            }
            *(u32x4*)rp = pack8(o);
            float* ns = F.out + (is_ssm ? O_SCONVS : O_GCONVS) + (size_t)ch * 3 * 3072 + cc;
#pragma unroll
            for (int i = 0; i < 8; ++i) { ns[i] = h1[i]; ns[3072 + i] = h2[i]; ns[2 * 3072 + i] = x[i]; }
            continue;
        }
        const int rowbase = ch * 64, t0 = rowbase & (SEQ - 1);
        if (t0 == 0) {
#pragma unroll
            for (int i = 0; i < 8; ++i) { h0[i] = 0.f; h1[i] = 0.f; h2[i] = 0.f; }
        } else {
            const bf16_t* hp = F.HALO() + (size_t)(ch - 1) * 3 * NCH + cgi * 8;
            unpack8(*(const u32x4*)hp, h0); unpack8(*(const u32x4*)(hp + NCH), h1); unpack8(*(const u32x4*)(hp + 2 * NCH), h2);
        }
        const bool lastc = (t0 == SEQ - 64);
        float* ns = F.out + (is_ssm ? O_SCONVP : O_GCONVP) + (size_t)(rowbase >> 11) * 3 * 3072 + cc;
        bf16_t* rp = F.PROJ() + (size_t)rowbase * LDP + pcol;
        u32x4 raw[3];
#pragma unroll
        for (int r = 0; r < 3; ++r) raw[r] = *(const u32x4*)(rp + (size_t)r * LDP);
#pragma unroll
        for (int r = 0; r < 3; ++r) {
            float x[8]; unpack8(raw[r], x);
            float o[8]; float ss = 0.f;
#pragma unroll
            for (int i = 0; i < 8; ++i) { float v = w[0][i] * h0[i] + w[1][i] * h1[i] + w[2][i] * h2[i] + w[3][i] * x[i] + bias[i]; v = siluf_(v); o[i] = v; ss += v * v; }
            if (kind == 1 || kind == 2) {
                ss = row16_sum(ss);
                const float rn = rsqrtf(ss + EPS) * (kind == 1 ? 0.08838834764831845f : 1.0f);
#pragma unroll
                for (int i = 0; i < 8; ++i) o[i] *= rn;
            }
            *(u32x4*)(rp + (size_t)r * LDP) = pack8(o);
#pragma unroll
            for (int i = 0; i < 8; ++i) { h0[i] = h1[i]; h1[i] = h2[i]; h2[i] = x[i]; }
        }
        if (lastc) {
            const bf16_t* hp = F.HALO() + (size_t)ch * 3 * NCH + cgi * 8;
#pragma unroll
            for (int r = 0; r < 3; ++r) { float x[8]; unpack8(*(const u32x4*)(hp + (size_t)r * NCH), x);
#pragma unroll
                for (int i = 0; i < 8; ++i) ns[r * 3072 + i] = x[i]; }
        }
    }
}

__device__ __forceinline__ void ssd_item(Frame& F, int item) {
    const bool smp = item >= NBATCH * 32;
    const int sq = smp ? (item - NBATCH * 32) >> 5 : item >> 5, h = item & 31, g = h >> 3;
    const int row0 = smp ? MPR + sq : sq * SEQ, T = smp ? 1 : SEQ;
    const int tid = F.tid, p = tid >> 3, nq = tid & 7;
    LAS bf16_t* Bs = (LAS bf16_t*)(F.lds);
    LAS bf16_t* Cs = (LAS bf16_t*)(F.lds + 16384);
    LAS bf16_t* Xs = (LAS bf16_t*)(F.lds + 32768);
    LAS float* dts = (LAS float*)(F.lds + 40960);
    LAS float* decs = (LAS float*)(F.lds + 41216);
    LAS float* Ys = (LAS float*)(F.lds + 41472);
    float hst[16];
    if (smp) {
        const float* sp = F.in[4] + ((size_t)(sq * 32 + h) * 64 + p) * 128 + nq * 16;
#pragma unroll
        for (int i = 0; i < 4; ++i) { const f32x4 v = ((const f32x4*)sp)[i]; hst[4 * i] = v[0]; hst[4 * i + 1] = v[1]; hst[4 * i + 2] = v[2]; hst[4 * i + 3] = v[3]; }
    } else {
#pragma unroll
        for (int i = 0; i < 16; ++i) hst[i] = 0.f;
    }
    const float a_h = -__expf(F.in[13][h]), dtb = F.in[12][h], Dh = F.in[14][h];
    for (int tb = 0; tb < T; tb += 64) {
        const int rows = (T - tb) < 64 ? (T - tb) : 64;
#pragma unroll
        for (int i = 0; i < 2; ++i) {
            const int pc = tid + i * 512, r = pc >> 4, c8 = (pc & 15) * 8;
            if (r < rows) {
                const bf16_t* src = F.PROJ() + (size_t)(row0 + tb + r) * LDP;
                *(LAS u32x4*)(Bs + r * 128 + c8) = *(const u32x4*)(src + C_B + g * 128 + c8);
                *(LAS u32x4*)(Cs + r * 128 + c8) = *(const u32x4*)(src + C_C + g * 128 + c8);
            }
        }
        { const int r = tid >> 3, c8 = (tid & 7) * 8;
          if (r < rows) *(LAS u32x4*)(Xs + r * 64 + c8) = *(const u32x4*)(F.PROJ() + (size_t)(row0 + tb + r) * LDP + C_XS + h * 64 + c8); }
        if (tid < rows) { const float dt = softplusf_(F.SMALL()[(size_t)(row0 + tb + tid) * 64 + h] + dtb); dts[tid] = dt; decs[tid] = __expf(dt * a_h); }
        __syncthreads();
        for (int tt = 0; tt < rows; ++tt) {
            const float xv = bf2f(Xs[tt * 64 + p]), dtv = dts[tt], dc = decs[tt], dx = dtv * xv;
            float bv[16], cv[16];
            { float t8[8]; unpack8(*(const LAS u32x4*)(Bs + tt * 128 + nq * 16), t8);
#pragma unroll
              for (int i = 0; i < 8; ++i) bv[i] = t8[i];
              unpack8(*(const LAS u32x4*)(Bs + tt * 128 + nq * 16 + 8), t8);
#pragma unroll
              for (int i = 0; i < 8; ++i) bv[8 + i] = t8[i];
              unpack8(*(const LAS u32x4*)(Cs + tt * 128 + nq * 16), t8);
#pragma unroll
              for (int i = 0; i < 8; ++i) cv[i] = t8[i];
              unpack8(*(const LAS u32x4*)(Cs + tt * 128 + nq * 16 + 8), t8);
#pragma unroll
              for (int i = 0; i < 8; ++i) cv[8 + i] = t8[i]; }
            float yp = 0.f;
#pragma unroll
            for (int i = 0; i < 16; ++i) { hst[i] = dc * hst[i] + dx * bv[i]; yp += cv[i] * hst[i]; }
            yp += __shfl_xor(yp, 1); yp += __shfl_xor(yp, 2); yp += __shfl_xor(yp, 4);
            if (nq == 0) Ys[tt * 64 + p] = yp + Dh * xv;
        }
        __syncthreads();
        { const int r = tid >> 3, c8 = (tid & 7) * 8;
          if (r < rows) { float o[8];
#pragma unroll
              for (int i = 0; i < 8; ++i) o[i] = Ys[r * 64 + c8 + i];
              *(u32x4*)(F.PROJ() + (size_t)(row0 + tb + r) * LDP + C_XS + h * 64 + c8) = pack8(o); } }
        __syncthreads();
    }
    float* op = F.out + (smp ? O_SSMS : O_SSMP) + ((size_t)(sq * 32 + h) * 64 + p) * 128 + nq * 16;
#pragma unroll
    for (int i = 0; i < 4; ++i) ((f32x4*)op)[i] = (f32x4){hst[4 * i], hst[4 * i + 1], hst[4 * i + 2], hst[4 * i + 3]};
}

__device__ __forceinline__ void gdn_item(Frame& F, int item) {
    const bool smp = item >= NBATCH * 32;
    const int sq = smp ? (item - NBATCH * 32) >> 5 : item >> 5, h = (item >> 2) & 7, dvq = item & 3;
    const int row0 = smp ? MPR + sq : sq * SEQ, T = smp ? 1 : SEQ;
    const int tid = F.tid, e = tid >> 4, kg = tid & 15;
    LAS bf16_t* Qs = (LAS bf16_t*)(F.lds);
    LAS bf16_t* Ks = (LAS bf16_t*)(F.lds + 16384);
    LAS bf16_t* Vs = (LAS bf16_t*)(F.lds + 32768);
    LAS float* egs = (LAS float*)(F.lds + 36864);
    LAS float* bts = (LAS float*)(F.lds + 37120);
    LAS float* Os = (LAS float*)(F.lds + 37376);
    float S[8];
    const size_t sbase = ((size_t)(sq * 8 + h) * 128 + kg * 8) * 128 + dvq * 32 + e;
    if (smp) {
#pragma unroll
        for (int j = 0; j < 8; ++j) S[j] = F.in[6][sbase + (size_t)j * 128];
    } else {
#pragma unroll
        for (int j = 0; j < 8; ++j) S[j] = 0.f;
    }
    const float na = -__expf(F.in[18][h]), dtb = F.in[17][h];
    for (int tb = 0; tb < T; tb += 64) {
        const int rows = (T - tb) < 64 ? (T - tb) : 64;
#pragma unroll
        for (int i = 0; i < 2; ++i) {
            const int pc = tid + i * 512, r = pc >> 4, c8 = (pc & 15) * 8;
            if (r < rows) {
                const bf16_t* src = F.PROJ() + (size_t)(row0 + tb + r) * LDP;
                *(LAS u32x4*)(Qs + r * 128 + c8) = *(const u32x4*)(src + C_Q + h * 128 + c8);
                *(LAS u32x4*)(Ks + r * 128 + c8) = *(const u32x4*)(src + C_K + h * 128 + c8);
            }
        }
        if (tid < 256) { const int r = tid >> 2, c8 = (tid & 3) * 8;
          if (r < rows) *(LAS u32x4*)(Vs + r * 32 + c8) = *(const u32x4*)(F.PROJ() + (size_t)(row0 + tb + r) * LDP + C_V + h * 128 + dvq * 32 + c8); }
        if (tid < rows) { const float* sm = F.SMALL() + (size_t)(row0 + tb + tid) * 64;
            egs[tid] = __expf(na * softplusf_(sm[40 + h] + dtb)); bts[tid] = sigmoidf_(sm[32 + h]); }
        __syncthreads();
        for (int tt = 0; tt < rows; ++tt) {
            float k8[8], q8[8];
            unpack8(*(const LAS u32x4*)(Ks + tt * 128 + kg * 8), k8);
            unpack8(*(const LAS u32x4*)(Qs + tt * 128 + kg * 8), q8);
            const float eg = egs[tt], bt = bts[tt], v = bf2f(Vs[tt * 32 + e]);
            float ks = 0.f;
#pragma unroll
            for (int j = 0; j < 8; ++j) ks += k8[j] * S[j];
            ks += __shfl_xor(ks, 1); ks += __shfl_xor(ks, 2); ks += __shfl_xor(ks, 4); ks += __shfl_xor(ks, 8);
            const float vn = bt * (v - eg * ks);
            float op = 0.f;
#pragma unroll
            for (int j = 0; j < 8; ++j) { S[j] = eg * S[j] + k8[j] * vn; op += q8[j] * S[j]; }
            op += __shfl_xor(op, 1); op += __shfl_xor(op, 2); op += __shfl_xor(op, 4); op += __shfl_xor(op, 8);
            if (kg == 0) Os[tt * 32 + e] = op;
        }
        __syncthreads();
        if (tid < 256) { const int r = tid >> 2, c8 = (tid & 3) * 8;
          if (r < rows) { float o[8];
#pragma unroll
              for (int i = 0; i < 8; ++i) o[i] = Os[r * 32 + c8 + i];
              *(u32x4*)(F.PROJ() + (size_t)(row0 + tb + r) * LDP + C_B + h * 128 + dvq * 32 + c8) = pack8(o); } }
        __syncthreads();
    }
    float* op = F.out + (smp ? O_GDNS : O_GDNP);
#pragma unroll
    for (int j = 0; j < 8; ++j) op[sbase + (size_t)j * 128] = S[j];
}


typedef short v4i16 __attribute__((ext_vector_type(4)));
__device__ __forceinline__ bf16x8 row_frag(LAS const unsigned char* base, int pitch, int row0, int k0, int lane) {
    return *(const LAS bf16x8*)(base + (row0 + (lane & 15)) * pitch + (k0 + 8 * (lane >> 4)) * 2);
}
__device__ __forceinline__ bf16x8 tr_frag(LAS const unsigned char* base, int pitch, int k0, int col0, int lane) {
    const int g = lane >> 4, m = lane & 15, q = m >> 2, pp = m & 3;
    LAS const unsigned char* a0 = base + (k0 + 8 * g + q) * pitch + (col0 + 4 * pp) * 2;
    const v4i16 lo = __builtin_amdgcn_ds_read_tr16_b64_v4i16((LAS v4i16*)a0);
    const v4i16 hi = __builtin_amdgcn_ds_read_tr16_b64_v4i16((LAS v4i16*)(a0 + 4 * pitch));
    return (bf16x8){lo[0], lo[1], lo[2], lo[3], hi[0], hi[1], hi[2], hi[3]};
}
#define LDS_BARRIER() do { asm volatile("s_waitcnt lgkmcnt(0)" ::: "memory"); __builtin_amdgcn_s_barrier(); asm volatile("" ::: "memory"); } while (0)
#define MFMA16(a, b, c) __builtin_amdgcn_mfma_f32_16x16x32_bf16((a), (b), (c), 0, 0, 0)
__device__ __forceinline__ u32x2 pack4(float a, float b, float c, float d) { return (u32x2){cvt_pk_bf16(a, b), cvt_pk_bf16(c, d)}; }

struct SsdSmpIn { f32x4 st[4]; u32x2 b[4], c[4]; float x, dtraw; };
__device__ __forceinline__ void ssd_smp_load(const Frame& F, int it, int p, int nq, SsdSmpIn& r) {
    const int sq = it >> 5, h = it & 31, g4 = h >> 3;
    const float* sp = F.in[4] + ((size_t)(sq * 32 + h) * 64 + p) * 128 + nq * 4;
#pragma unroll
    for (int j = 0; j < 4; ++j) r.st[j] = *(const f32x4*)(sp + 32 * j);
    const bf16_t* row = F.PROJ() + (size_t)(MPR + sq) * LDP;
#pragma unroll
    for (int j = 0; j < 4; ++j) { r.b[j] = *(const u32x2*)(row + C_B + g4 * 128 + 32 * j + 4 * nq); r.c[j] = *(const u32x2*)(row + C_C + g4 * 128 + 32 * j + 4 * nq); }
    r.x = bf2f(row[C_XS + h * 64 + p]);
    r.dtraw = F.SMALL()[(size_t)(MPR + sq) * 64 + h];
}
__device__ __forceinline__ void ssd_smp_run(const Frame& F, int it, int p, int nq, const SsdSmpIn& r) {
    const int sq = it >> 5, h = it & 31;
    const float a_h = -__expf(F.in[13][h]), dt = softplusf_(r.dtraw + F.in[12][h]), dc = __expf(dt * a_h), dx = dt * r.x;
    float yp = 0.f; f32x4 o[4];
#pragma unroll
    for (int j = 0; j < 4; ++j) {
        const float bv[4] = {bflo(r.b[j].x), bfhi(r.b[j].x), bflo(r.b[j].y), bfhi(r.b[j].y)}, cv[4] = {bflo(r.c[j].x), bfhi(r.c[j].x), bflo(r.c[j].y), bfhi(r.c[j].y)};
#pragma unroll
        for (int i = 0; i < 4; ++i) { const float hv = dc * r.st[j][i] + dx * bv[i]; o[j][i] = hv; yp += cv[i] * hv; }
    }
    yp += __shfl_xor(yp, 1); yp += __shfl_xor(yp, 2); yp += __shfl_xor(yp, 4);
    float* op = F.out + O_SSMS + ((size_t)(sq * 32 + h) * 64 + p) * 128 + nq * 4;
#pragma unroll
    for (int j = 0; j < 4; ++j) *(f32x4*)(op + 32 * j) = o[j];
    if (nq == 0) { const unsigned w = cvt_pk_bf16(yp + F.in[14][h] * r.x, 0.f); F.PROJ()[(size_t)(MPR + sq) * LDP + C_XS + h * 64 + p] = (bf16_t)(w & 0xffffu); }
}
__device__ __forceinline__ void ssd_sample_stream_regs(const Frame& F, int first) {
    const int p = F.tid >> 3, nq = F.tid & 7;
    constexpr int NIT = NSMP * 32;
    SsdSmpIn r[4];
#pragma unroll
    for (int j = 0; j < 4; ++j) if (first + j * F.G < NIT) ssd_smp_load(F, first + j * F.G, p, nq, r[j]);
    for (int it0 = first; it0 < NIT; it0 += 4 * F.G) {
#pragma unroll
        for (int j = 0; j < 4; ++j) {
            const int it = it0 + j * F.G;
            if (it < NIT) { ssd_smp_run(F, it, p, nq, r[j]); if (it + 4 * F.G < NIT) ssd_smp_load(F, it + 4 * F.G, p, nq, r[j]); }
        }
    }
}
__device__ __forceinline__ void ssd_sample_stream(const Frame& F, int first) {
    constexpr int NIT = NSMP * 32, SLOT = 36864;
    static_assert(4 * SLOT + 512 <= MISC_OFF, "ssd sample ring");
    const int w = F.wave, lane = F.lane;
    LAS unsigned char* L = F.lds;
    const int n = first < NIT ? (NIT - 1 - first) / F.G + 1 : 0;
    LAS float* hp = (LAS float*)(L + 4 * SLOT);
    __syncthreads();
    if (F.tid < 32) { hp[F.tid] = -__expf(F.in[13][F.tid]); hp[32 + F.tid] = F.in[12][F.tid]; hp[64 + F.tid] = F.in[14][F.tid]; }
    __syncthreads();
    if (w < 4) {
#define SSL_ISSUE(k_) do { const int it_ = first + (k_) * F.G, sq_ = it_ >> 5, h_ = it_ & 31; \
            const char* sp_ = (const char*)(F.in[4] + (size_t)it_ * 8192) + (size_t)((w * 8) * 64 + lane) * 16; \
            LAS unsigned char* sl_ = L + ((k_) & 3) * SLOT + w * 8192; \
            _Pragma("unroll") for (int j_ = 0; j_ < 8; ++j_) __builtin_amdgcn_global_load_lds((const unsigned*)(sp_ + j_ * 1024), (LAS unsigned*)(sl_ + j_ * 1024), 16, 0, 0); \
            const bf16_t* row_ = F.PROJ() + (size_t)(MPR + sq_) * LDP; \
            const char* op_ = w == 0 ? (const char*)(row_ + C_B + (h_ >> 3) * 128 + (lane & 15) * 8) : w == 1 ? (const char*)(row_ + C_C + (h_ >> 3) * 128 + (lane & 15) * 8) \
                            : w == 2 ? (const char*)(row_ + C_XS + h_ * 64 + (lane & 7) * 8) : (const char*)(F.SMALL() + (size_t)(MPR + sq_) * 64 + (h_ & ~3)); \
            __builtin_amdgcn_global_load_lds((const unsigned*)op_, (LAS unsigned*)(L + ((k_) & 3) * SLOT + 32768 + w * 1024), 16, 0, 0); } while (0)
        if (n > 0) SSL_ISSUE(0);
        if (n > 1) SSL_ISSUE(1);
        if (n > 2) SSL_ISSUE(2);
        for (int k = 0; k < n; ++k) {
            const int younger = n - 1 - k;
            if (younger >= 2) asm volatile("s_waitcnt vmcnt(18)" ::: "memory"); else if (younger == 1) asm volatile("s_waitcnt vmcnt(9)" ::: "memory"); else asm volatile("s_waitcnt vmcnt(0)" ::: "memory");
            __builtin_amdgcn_s_barrier(); asm volatile("" ::: "memory");
            if (k + 3 < n) SSL_ISSUE(k + 3);
        }
#undef SSL_ISSUE
    } else {
        const int cw = w - 4, nb = lane & 31, hi = lane >> 5;
        for (int k = 0; k < n; ++k) {
            asm volatile("s_waitcnt lgkmcnt(0)" ::: "memory"); __builtin_amdgcn_s_barrier(); asm volatile("" ::: "memory");
            const int it = first + k * F.G, sq = it >> 5, h = it & 31;
            LAS const unsigned char* sl = L + (k & 3) * SLOT;
            const float a_h = hp[h], dtb = hp[32 + h], Dh = hp[64 + h];
            const float dt = softplusf_(*(LAS const float*)(sl + 32768 + 3 * 1024 + (h & 3) * 4) + dtb), dc = __expf(dt * a_h);
            const u32x2 bw = *(LAS const u32x2*)(sl + 32768 + nb * 8), cwd = *(LAS const u32x2*)(sl + 32768 + 1024 + nb * 8);
            const f32x4 bv = (f32x4){bflo(bw.x), bfhi(bw.x), bflo(bw.y), bfhi(bw.y)}, cv = (f32x4){bflo(cwd.x), bfhi(cwd.x), bflo(cwd.y), bfhi(cwd.y)};
            float* op = F.out + O_SSMS + (size_t)it * 8192;
            bf16_t* yrow = F.PROJ() + (size_t)(MPR + sq) * LDP + C_XS + h * 64;
#pragma unroll
            for (int j = 0; j < 8; ++j) {
                const int piece = (cw * 8 + j) * 64 + lane, pr = (cw * 8 + j) * 2 + hi;
                const f32x4 hv = *(LAS const f32x4*)(sl + piece * 16);
                const float xv = bf2f(*(LAS const bf16_t*)(sl + 32768 + 2048 + pr * 2));
                const f32x4 o = hv * dc + bv * (dt * xv);
                *(f32x4*)(op + piece * 4) = o;
                float yp = (cv[0] * o[0] + cv[1] * o[1]) + (cv[2] * o[2] + cv[3] * o[3]);
                yp += __shfl_xor(yp, 1); yp += __shfl_xor(yp, 2); yp += __shfl_xor(yp, 4); yp += __shfl_xor(yp, 8); yp += __shfl_xor(yp, 16);
                if (nb == 0) { const unsigned wv = cvt_pk_bf16(yp + Dh * xv, 0.f); yrow[pr] = (bf16_t)(wv & 0xffffu); }
            }
        }
    }
}
struct GdnSmpIn { float S[8]; u32x4 k8, q8; float v, araw, braw; };
__device__ __forceinline__ void gdn_smp_load(const Frame& F, int it, int e, int kg, GdnSmpIn& r) {
    const int sq = it >> 5, h = (it >> 2) & 7, dvq = it & 3;
    const float* sp = F.in[6] + ((size_t)(sq * 8 + h) * 128 + kg * 8) * 128 + dvq * 32 + e;
#pragma unroll
    for (int j = 0; j < 8; ++j) r.S[j] = sp[(size_t)j * 128];
    const bf16_t* row = F.PROJ() + (size_t)(MPR + sq) * LDP;
    r.k8 = *(const u32x4*)(row + C_K + h * 128 + kg * 8); r.q8 = *(const u32x4*)(row + C_Q + h * 128 + kg * 8);
    r.v = bf2f(row[C_V + h * 128 + dvq * 32 + e]);
    const float* sm = F.SMALL() + (size_t)(MPR + sq) * 64;
    r.araw = sm[40 + h]; r.braw = sm[32 + h];
}
__device__ __forceinline__ void gdn_smp_run(const Frame& F, int it, int e, int kg, const GdnSmpIn& r) {
    const int sq = it >> 5, h = (it >> 2) & 7, dvq = it & 3;
    const float eg = __expf(-__expf(F.in[18][h]) * softplusf_(r.araw + F.in[17][h])), bt = sigmoidf_(r.braw);
    float k8[8], q8[8]; unpack8(r.k8, k8); unpack8(r.q8, q8);
    float ks = 0.f;
#pragma unroll
    for (int j = 0; j < 8; ++j) ks += k8[j] * r.S[j];
    ks += __shfl_xor(ks, 1); ks += __shfl_xor(ks, 2); ks += __shfl_xor(ks, 4); ks += __shfl_xor(ks, 8);
    const float vn = bt * (r.v - eg * ks);
    float op = 0.f, Sn[8];
#pragma unroll
    for (int j = 0; j < 8; ++j) { Sn[j] = eg * r.S[j] + k8[j] * vn; op += q8[j] * Sn[j]; }
    op += __shfl_xor(op, 1); op += __shfl_xor(op, 2); op += __shfl_xor(op, 4); op += __shfl_xor(op, 8);
    float* dp = F.out + O_GDNS + ((size_t)(sq * 8 + h) * 128 + kg * 8) * 128 + dvq * 32 + e;
#pragma unroll
    for (int j = 0; j < 8; ++j) dp[(size_t)j * 128] = Sn[j];
    if (kg == 0) { const unsigned w = cvt_pk_bf16(op, 0.f); F.PROJ()[(size_t)(MPR + sq) * LDP + C_V + h * 128 + dvq * 32 + e] = (bf16_t)(w & 0xffffu); }
}
__device__ __forceinline__ void gdn_sample_stream(const Frame& F, int first) {
    const int e = F.tid >> 4, kg = F.tid & 15;
    constexpr int NIT = NSMP * 32;
    for (int it0 = first; it0 < NIT; it0 += 4 * F.G) {
        GdnSmpIn r[4];
#pragma unroll
        for (int j = 0; j < 4; ++j) if (it0 + j * F.G < NIT) gdn_smp_load(F, it0 + j * F.G, e, kg, r[j]);
#pragma unroll
        for (int j = 0; j < 4; ++j) if (it0 + j * F.G < NIT) gdn_smp_run(F, it0 + j * F.G, e, kg, r[j]);
    }
}


__device__ __forceinline__ void ssd_chunked(Frame& F, int item, int& sit) {
    (void)sit;
    const int b = item >> 5, h = item & 31, g4 = h >> 3;
    const int tid = F.tid, lane = F.lane, w = F.wave, i16 = lane & 15, g = lane >> 4;
    LAS unsigned char* L = F.lds;
    constexpr int PB = 272, PX = 144, PY = 260;
    constexpr int SET = 45120, O_BT = 0, O_CT = 17408, O_XT = 34816, O_SC = 44032;
    constexpr int O_XD = 2 * SET, O_MT = O_XD + 9216, O_SL = O_MT + 9216, O_YT = O_SL + 17408;
    static_assert(O_YT + 64 * PY <= MISC_OFF, "ssd LDS map");
    LAS float* acumA = (LAS float*)(L + O_SC); LAS float* dtlA = acumA + 64; LAS float* sclA = acumA + 128; LAS float* eacA = acumA + 192; LAS float* cdecpA = acumA + 256;
    LAS float* acumB = (LAS float*)(L + SET + O_SC); LAS float* dtlB = acumB + 64; LAS float* sclB = acumB + 128; LAS float* eacB = acumB + 192; LAS float* cdecpB = acumB + 256;
    __syncthreads();
    for (int u = tid; u < 17408 / 16; u += 512) *(LAS u32x4*)(L + O_SL + u * 16) = (u32x4){0u, 0u, 0u, 0u};
    f32x4 sacc[4];
#pragma unroll
    for (int pb = 0; pb < 4; ++pb) sacc[pb] = (f32x4){0.f, 0.f, 0.f, 0.f};
    const float a_h = -__expf(F.in[13][h]), dtb = F.in[12][h], Dh = F.in[14][h];
    const int row00 = b * SEQ;
    u32x4 rbA[2], rcA[2], rxA, rzA, rbB[2], rcB[2], rxB, rzB, zsA, zsB; float rdtA = 0.f, rdtB = 0.f;
    zsA = (u32x4){0u, 0u, 0u, 0u}; zsB = zsA;
    float* SSY = (float*)(F.ws + WS_SSY);
    const int br0 = tid >> 4, bc8 = (tid & 15) * 8;
    const int xr = tid >> 3, xc8 = (tid & 7) * 8;
#define SSD_LOADA(c) do { const bf16_t* src = F.PROJ() + (size_t)(row00 + (c) * 64) * LDP; \
        rbA[0] = *(const u32x4*)(src + (size_t)br0 * LDP + C_B + g4 * 128 + bc8); rbA[1] = *(const u32x4*)(src + (size_t)(br0 + 32) * LDP + C_B + g4 * 128 + bc8); \
        rcA[0] = *(const u32x4*)(src + (size_t)br0 * LDP + C_C + g4 * 128 + bc8); rcA[1] = *(const u32x4*)(src + (size_t)(br0 + 32) * LDP + C_C + g4 * 128 + bc8); \
        rxA = *(const u32x4*)(src + (size_t)xr * LDP + C_XS + h * 64 + xc8); \
        rzA = *(const u32x4*)(src + (size_t)xr * LDP + C_Z + h * 64 + xc8); \
        if (tid < 64) rdtA = F.SMALL()[(size_t)(row00 + (c) * 64 + tid) * 64 + h]; } while (0)
#define SSD_LOADB(c) do { const bf16_t* src = F.PROJ() + (size_t)(row00 + (c) * 64) * LDP; \
        rbB[0] = *(const u32x4*)(src + (size_t)br0 * LDP + C_B + g4 * 128 + bc8); rbB[1] = *(const u32x4*)(src + (size_t)(br0 + 32) * LDP + C_B + g4 * 128 + bc8); \
        rcB[0] = *(const u32x4*)(src + (size_t)br0 * LDP + C_C + g4 * 128 + bc8); rcB[1] = *(const u32x4*)(src + (size_t)(br0 + 32) * LDP + C_C + g4 * 128 + bc8); \
        rxB = *(const u32x4*)(src + (size_t)xr * LDP + C_XS + h * 64 + xc8); \
        rzB = *(const u32x4*)(src + (size_t)xr * LDP + C_Z + h * 64 + xc8); \
        if (tid < 64) rdtB = F.SMALL()[(size_t)(row00 + (c) * 64 + tid) * 64 + h]; } while (0)
#define SSD_STAGE(Q, QS) do { \
        *(LAS u32x4*)(L + QS * SET + O_BT + br0 * PB + bc8 * 2) = rb##Q[0]; *(LAS u32x4*)(L + QS * SET + O_BT + (br0 + 32) * PB + bc8 * 2) = rb##Q[1]; \
        *(LAS u32x4*)(L + QS * SET + O_CT + br0 * PB + bc8 * 2) = rc##Q[0]; *(LAS u32x4*)(L + QS * SET + O_CT + (br0 + 32) * PB + bc8 * 2) = rc##Q[1]; \
        *(LAS u32x4*)(L + QS * SET + O_XT + xr * PX + xc8 * 2) = rx##Q; zs##Q = rz##Q; \
        if (tid < 64) { \
            const float dt_ = softplusf_(rdt##Q + dtb); float v_ = dt_ * a_h; \
            _Pragma("unroll") for (int o_ = 1; o_ < 64; o_ <<= 1) { const float t_ = __shfl_up(v_, o_); if (lane >= o_) v_ += t_; } \
            const float last_ = __shfl(v_, 63); \
            acum##Q[lane] = v_; dtl##Q[lane] = dt_; scl##Q[lane] = dt_ * __expf(last_ - v_); eac##Q[lane] = __expf(v_); \
            if (lane == 63) cdecp##Q[0] = __expf(v_); } } while (0)
    SSD_LOADA(0); SSD_LOADB(1);
    SSD_STAGE(A, 0);
    SSD_LOADA(2);
    for (int c2 = 0; c2 < SEQ / 128; ++c2) {
        { const int c = 2 * c2;
        LDS_BARRIER();
        if (c > 0) {
            float o[8], z8[8]; unpack8(zsB, z8); float ss = 0.f;
#pragma unroll
            for (int i = 0; i < 8; ++i) { o[i] = *(LAS const float*)(L + O_YT + xr * PY + (xc8 + i) * 4) * siluf_(z8[i]); ss += o[i] * o[i]; }
            *(u32x4*)(F.PROJ() + (size_t)(row00 + (c - 1) * 64 + xr) * LDP + C_XS + h * 64 + xc8) = pack8(o);
            ss += __shfl_xor(ss, 1); ss += __shfl_xor(ss, 2); ss += __shfl_xor(ss, 4);
            if ((tid & 7) == 0) atomicAdd(SSY + (size_t)(row00 + (c - 1) * 64 + xr) * 4 + g4, ss);
        }
        if (c + 1 < SEQ / 64) {
            SSD_STAGE(B, 1);
            if (c + 3 < SEQ / 64) SSD_LOADB(c + 3);
        }
        { float x8[8]; unpack8(*(LAS const u32x4*)(L + 0 * SET + O_XT + xr * PX + xc8 * 2), x8); const float sc = sclA[xr];
#pragma unroll
          for (int i = 0; i < 8; ++i) x8[i] *= sc;
          *(LAS u32x4*)(L + O_XD + xr * PX + xc8 * 2) = pack8(x8); }
#pragma unroll
        for (int tt = 0; tt < 2; ++tt) {
            const int t = 2 * w + tt, lb = t >> 2, sb = t & 3;
            const int l = 16 * lb + i16;
            u32x2 mw = (u32x2){0u, 0u};
            if (sb <= lb) {
                f32x4 acc = (f32x4){0.f, 0.f, 0.f, 0.f};
#pragma unroll
                for (int ks = 0; ks < 4; ++ks) acc = MFMA16(row_frag(L + 0 * SET + O_BT, PB, 16 * sb, 32 * ks, lane), row_frag(L + 0 * SET + O_CT, PB, 16 * lb, 32 * ks, lane), acc);
                const float al = acumA[l];
                float mv[4];
#pragma unroll
                for (int r = 0; r < 4; ++r) { const int s = 16 * sb + 4 * g + r; const float e = __expf(al - acumA[s]) * dtlA[s] * acc[r]; mv[r] = (s <= l) ? e : 0.f; }
                mw = pack4(mv[0], mv[1], mv[2], mv[3]);
            }
            *(LAS u32x2*)(L + O_MT + l * PX + (16 * sb + 4 * g) * 2) = mw;
        }
        f32x4 yacc[2];
        const int lb = w >> 1;
#pragma unroll
        for (int tt = 0; tt < 2; ++tt) {
            const int pb = 2 * (w & 1) + tt;
            f32x4 acc = (f32x4){0.f, 0.f, 0.f, 0.f};
#pragma unroll
            for (int ks = 0; ks < 4; ++ks) acc = MFMA16(row_frag(L + 0 * SET + O_CT, PB, 16 * lb, 32 * ks, lane), row_frag(L + O_SL, PB, 16 * pb, 32 * ks, lane), acc);
#pragma unroll
            for (int r = 0; r < 4; ++r) acc[r] *= eacA[16 * lb + 4 * g + r];
            yacc[tt] = acc;
        }
        LDS_BARRIER();
#pragma unroll
        for (int tt = 0; tt < 2; ++tt) {
            const int pb = 2 * (w & 1) + tt;
            f32x4 acc = yacc[tt];
            acc = MFMA16(row_frag(L + O_MT, PX, 16 * lb, 0, lane), tr_frag(L + 0 * SET + O_XT, PX, 0, 16 * pb, lane), acc);
            if (lb >= 2) acc = MFMA16(row_frag(L + O_MT, PX, 16 * lb, 32, lane), tr_frag(L + 0 * SET + O_XT, PX, 32, 16 * pb, lane), acc);
#pragma unroll
            for (int r = 0; r < 4; ++r) { const int l = 16 * lb + 4 * g + r, p = 16 * pb + i16;
                const float xv = bf2f(*(LAS const bf16_t*)(L + 0 * SET + O_XT + l * PX + p * 2));
                *(LAS float*)(L + O_YT + l * PY + p * 4) = acc[r] + Dh * xv; }
        }
        { const float cdec = cdecpA[0];
#pragma unroll
          for (int pb = 0; pb < 4; ++pb) sacc[pb] *= cdec;
#pragma unroll
          for (int ks = 0; ks < 2; ++ks) {
              const bf16x8 a = tr_frag(L + 0 * SET + O_BT, PB, 32 * ks, 16 * w, lane);
#pragma unroll
              for (int pb = 0; pb < 4; ++pb) sacc[pb] = MFMA16(a, tr_frag(L + O_XD, PX, 32 * ks, 16 * pb, lane), sacc[pb]);
          }
#pragma unroll
          for (int pb = 0; pb < 4; ++pb) *(LAS u32x2*)(L + O_SL + (16 * pb + i16) * PB + (16 * w + 4 * g) * 2) = pack4(sacc[pb][0], sacc[pb][1], sacc[pb][2], sacc[pb][3]);
        }
        }
        { const int c = 2 * c2 + 1;
        LDS_BARRIER();
        if (c > 0) {
            float o[8], z8[8]; unpack8(zsA, z8); float ss = 0.f;
#pragma unroll
            for (int i = 0; i < 8; ++i) { o[i] = *(LAS const float*)(L + O_YT + xr * PY + (xc8 + i) * 4) * siluf_(z8[i]); ss += o[i] * o[i]; }
            *(u32x4*)(F.PROJ() + (size_t)(row00 + (c - 1) * 64 + xr) * LDP + C_XS + h * 64 + xc8) = pack8(o);
            ss += __shfl_xor(ss, 1); ss += __shfl_xor(ss, 2); ss += __shfl_xor(ss, 4);
            if ((tid & 7) == 0) atomicAdd(SSY + (size_t)(row00 + (c - 1) * 64 + xr) * 4 + g4, ss);
        }
        if (c + 1 < SEQ / 64) {
            SSD_STAGE(A, 0);
            if (c + 3 < SEQ / 64) SSD_LOADA(c + 3);
        }
        { float x8[8]; unpack8(*(LAS const u32x4*)(L + 1 * SET + O_XT + xr * PX + xc8 * 2), x8); const float sc = sclB[xr];
#pragma unroll
          for (int i = 0; i < 8; ++i) x8[i] *= sc;
          *(LAS u32x4*)(L + O_XD + xr * PX + xc8 * 2) = pack8(x8); }
#pragma unroll
        for (int tt = 0; tt < 2; ++tt) {
            const int t = 2 * w + tt, lb = t >> 2, sb = t & 3;
            const int l = 16 * lb + i16;
            u32x2 mw = (u32x2){0u, 0u};
            if (sb <= lb) {
                f32x4 acc = (f32x4){0.f, 0.f, 0.f, 0.f};
#pragma unroll
                for (int ks = 0; ks < 4; ++ks) acc = MFMA16(row_frag(L + 1 * SET + O_BT, PB, 16 * sb, 32 * ks, lane), row_frag(L + 1 * SET + O_CT, PB, 16 * lb, 32 * ks, lane), acc);
                const float al = acumB[l];
                float mv[4];
#pragma unroll
                for (int r = 0; r < 4; ++r) { const int s = 16 * sb + 4 * g + r; const float e = __expf(al - acumB[s]) * dtlB[s] * acc[r]; mv[r] = (s <= l) ? e : 0.f; }
                mw = pack4(mv[0], mv[1], mv[2], mv[3]);
            }
            *(LAS u32x2*)(L + O_MT + l * PX + (16 * sb + 4 * g) * 2) = mw;
        }
        f32x4 yacc[2];
        const int lb = w >> 1;
#pragma unroll
        for (int tt = 0; tt < 2; ++tt) {
            const int pb = 2 * (w & 1) + tt;
            f32x4 acc = (f32x4){0.f, 0.f, 0.f, 0.f};
#pragma unroll
            for (int ks = 0; ks < 4; ++ks) acc = MFMA16(row_frag(L + 1 * SET + O_CT, PB, 16 * lb, 32 * ks, lane), row_frag(L + O_SL, PB, 16 * pb, 32 * ks, lane), acc);
#pragma unroll
            for (int r = 0; r < 4; ++r) acc[r] *= eacB[16 * lb + 4 * g + r];
            yacc[tt] = acc;
        }
        LDS_BARRIER();
#pragma unroll
        for (int tt = 0; tt < 2; ++tt) {
            const int pb = 2 * (w & 1) + tt;
            f32x4 acc = yacc[tt];
            acc = MFMA16(row_frag(L + O_MT, PX, 16 * lb, 0, lane), tr_frag(L + 1 * SET + O_XT, PX, 0, 16 * pb, lane), acc);
            if (lb >= 2) acc = MFMA16(row_frag(L + O_MT, PX, 16 * lb, 32, lane), tr_frag(L + 1 * SET + O_XT, PX, 32, 16 * pb, lane), acc);
#pragma unroll
            for (int r = 0; r < 4; ++r) { const int l = 16 * lb + 4 * g + r, p = 16 * pb + i16;
                const float xv = bf2f(*(LAS const bf16_t*)(L + 1 * SET + O_XT + l * PX + p * 2));
                *(LAS float*)(L + O_YT + l * PY + p * 4) = acc[r] + Dh * xv; }
        }
        { const float cdec = cdecpB[0];
#pragma unroll
          for (int pb = 0; pb < 4; ++pb) sacc[pb] *= cdec;
#pragma unroll
          for (int ks = 0; ks < 2; ++ks) {
              const bf16x8 a = tr_frag(L + 1 * SET + O_BT, PB, 32 * ks, 16 * w, lane);
#pragma unroll
              for (int pb = 0; pb < 4; ++pb) sacc[pb] = MFMA16(a, tr_frag(L + O_XD, PX, 32 * ks, 16 * pb, lane), sacc[pb]);
          }
#pragma unroll
          for (int pb = 0; pb < 4; ++pb) *(LAS u32x2*)(L + O_SL + (16 * pb + i16) * PB + (16 * w + 4 * g) * 2) = pack4(sacc[pb][0], sacc[pb][1], sacc[pb][2], sacc[pb][3]);
        }
        }
    }
    LDS_BARRIER();
    {
        float o[8], z8[8]; unpack8(zsB, z8); float ss = 0.f;
#pragma unroll
        for (int i = 0; i < 8; ++i) { o[i] = *(LAS const float*)(L + O_YT + xr * PY + (xc8 + i) * 4) * siluf_(z8[i]); ss += o[i] * o[i]; }
        *(u32x4*)(F.PROJ() + (size_t)(row00 + (SEQ / 64 - 1) * 64 + xr) * LDP + C_XS + h * 64 + xc8) = pack8(o);
        ss += __shfl_xor(ss, 1); ss += __shfl_xor(ss, 2); ss += __shfl_xor(ss, 4);
        if ((tid & 7) == 0) atomicAdd(SSY + (size_t)(row00 + (SEQ / 64 - 1) * 64 + xr) * 4 + g4, ss);
    }
#undef SSD_LOADA
#undef SSD_LOADB
#undef SSD_STAGE
#pragma unroll
    for (int pb = 0; pb < 4; ++pb) *(f32x4*)(F.out + O_SSMP + ((size_t)(b * 32 + h) * 64 + 16 * pb + i16) * 128 + 16 * w + 4 * g) = sacc[pb];
}


__device__ __forceinline__ void gdn_prep(Frame& F, int it, int hb) {
    const int c = it & 31, bh = it >> 5, h = bh & 7, b = bh >> 3;
    const int ht = F.tid & 255, lane = F.lane, hw = F.wave & 3, i16 = lane & 15, g = lane >> 4;
    LAS unsigned char* L = F.lds + hb * 65536;
    constexpr int PB = 272;
    constexpr int O_KT = 0, O_QT = 17408, O_VT = 34816, O_SC = 52224;
    LAS float* gc = (LAS float*)(L + O_SC); LAS float* bt = gc + 64; LAS float* egc = gc + 128;
    const int row0 = b * SEQ + c * 64;
    __syncthreads();
    {
        u32x4 rk[4], rq[4], rv[4];
#pragma unroll
        for (int j = 0; j < 4; ++j) { const int pc = ht + j * 256, r = pc >> 4, c8 = (pc & 15) * 8; const bf16_t* src = F.PROJ() + (size_t)(row0 + r) * LDP + h * 128 + c8;
            rk[j] = *(const u32x4*)(src + C_K); rq[j] = *(const u32x4*)(src + C_Q); rv[j] = *(const u32x4*)(src + C_V); }
        if (ht < 64) {
            const float* sm = F.SMALL() + (size_t)(row0 + lane) * 64;
            const float na = -__expf(F.in[18][h]), dtb = F.in[17][h];
            float v = na * softplusf_(sm[40 + h] + dtb);
            const float be = sigmoidf_(sm[32 + h]);
#pragma unroll
            for (int o = 1; o < 64; o <<= 1) { const float t = __shfl_up(v, o); if (lane >= o) v += t; }
            gc[lane] = v; bt[lane] = be; egc[lane] = __expf(v);
            ((float*)(F.ws + WS_GC))[(size_t)it * 64 + lane] = v;
        }
#pragma unroll
        for (int j = 0; j < 4; ++j) { const int pc = ht + j * 256, r = pc >> 4, c8 = (pc & 15) * 8;
            *(LAS u32x4*)(L + O_KT + r * PB + c8 * 2) = rk[j]; *(LAS u32x4*)(L + O_QT + r * PB + c8 * 2) = rq[j]; *(LAS u32x4*)(L + O_VT + r * PB + c8 * 2) = rv[j]; }
    }
    __syncthreads();
    f32x4 kk[4];
    const int lb = hw;
    bf16_t* qkm = (bf16_t*)(F.ws + WS_QKM) + (size_t)it * 4096;
#pragma unroll
    for (int sb = 0; sb < 4; ++sb) {
        kk[sb] = (f32x4){0.f, 0.f, 0.f, 0.f};
        const int l = 16 * lb + i16;
        u32x2 qw = (u32x2){0u, 0u};
        if (sb <= lb) {
            f32x4 qa = (f32x4){0.f, 0.f, 0.f, 0.f};
#pragma unroll
            for (int ks = 0; ks < 4; ++ks) {
                const bf16x8 ks_ = row_frag(L + O_KT, PB, 16 * sb, 32 * ks, lane);
                kk[sb] = MFMA16(row_frag(L + O_KT, PB, 16 * lb, 32 * ks, lane), ks_, kk[sb]);
                qa = MFMA16(ks_, row_frag(L + O_QT, PB, 16 * lb, 32 * ks, lane), qa);
            }
            const float gl = gc[l];
            float qv[4];
#pragma unroll
            for (int r = 0; r < 4; ++r) { const int s_ = 16 * sb + 4 * g + r; const float e = __expf(gl - gc[s_]) * qa[r]; qv[r] = (s_ <= l) ? e : 0.f; }
            qw = pack4(qv[0], qv[1], qv[2], qv[3]);
        }
        *(u32x2*)(qkm + l * 64 + 16 * sb + 4 * g) = qw;
    }
    __syncthreads();
#pragma unroll
    for (int sb = 0; sb < 4; ++sb) {
        if (sb <= lb) {
#pragma unroll
            for (int r = 0; r < 4; ++r) { const int l = 16 * lb + 4 * g + r, s_ = 16 * sb + i16;
                const float a = (s_ < l) ? bt[l] * kk[sb][r] * __expf(gc[l] - gc[s_]) : 0.f;
                *(LAS float*)(L + O_QT + l * PB + s_ * 4) = a; }
        }
    }
    __syncthreads();
    float x[64];
    {
        const bool isv = ht < 128;
        LAS const unsigned char* colp = L + (isv ? O_VT : O_KT) + (ht & 127) * 2;
#pragma unroll
        for (int l = 0; l < 64; ++l) { const float v = bf2f(*(LAS const bf16_t*)(colp + l * PB)); x[l] = v * bt[l] * (isv ? 1.0f : egc[l]); }
    }
#pragma unroll
    for (int l = 1; l < 64; ++l) {
        float acc0 = x[l], acc1 = 0.f;
#pragma unroll
        for (int s4 = 0; s4 < (l + 3) / 4; ++s4) {
            const f32x4 a = *(LAS const f32x4*)(L + O_QT + l * PB + s4 * 16);
#pragma unroll
            for (int j = 0; j < 4; ++j) if (4 * s4 + j < l) { if (j & 1) asm("v_fma_f32 %0, -%1, %2, %0" : "+v"(acc1) : "v"(a[j]), "v"(x[4 * s4 + j])); else asm("v_fma_f32 %0, -%1, %2, %0" : "+v"(acc0) : "v"(a[j]), "v"(x[4 * s4 + j])); }
        }
        x[l] = acc0 + acc1;
        asm volatile("" ::: "memory");
    }
    {
        const bool isv = ht < 128;
        bf16_t* dst = (bf16_t*)(F.ws + (isv ? WS_UT : WS_WT)) + (size_t)it * 8192 + (ht & 127) * 64;
        const float sg = isv ? 1.0f : -1.0f;
#pragma unroll
        for (int q8 = 0; q8 < 8; ++q8) { float o[8];
#pragma unroll
            for (int i = 0; i < 8; ++i) o[i] = sg * x[8 * q8 + i];
            *(u32x4*)(dst + 8 * q8) = pack8(o); }
    }
}

__device__ __forceinline__ bf16x8 frag2(u32x2 lo, u32x2 hi) { return __builtin_bit_cast(bf16x8, (u32x4){lo.x, lo.y, hi.x, hi.y}); }
struct PrepIn { u32x4 rk[4], rq[4], rv[4]; float araw, braw; };
__device__ __forceinline__ void prep_load(const Frame& F, int it, PrepIn& r) {
    const int c = it & 31, bh = it >> 5, h = bh & 7, b = bh >> 3, ht = F.tid & 255, row0 = b * SEQ + c * 64;
#pragma unroll
    for (int j = 0; j < 4; ++j) { const int pc = ht + j * 256, rr = pc >> 4, c8 = (pc & 15) * 8; const bf16_t* src = F.PROJ() + (size_t)(row0 + rr) * LDP + h * 128 + c8;
        r.rk[j] = *(const u32x4*)(src + C_K); r.rq[j] = *(const u32x4*)(src + C_Q); r.rv[j] = *(const u32x4*)(src + C_V); }
    r.araw = 0.f; r.braw = 0.f;
    if (ht < 64) { const float* sm = F.SMALL() + (size_t)(row0 + F.lane) * 64; r.araw = sm[40 + h]; r.braw = sm[32 + h]; }
}
__device__ __forceinline__ void gdn_prep3(Frame& F, int it, int hb, PrepIn& cur, int it_next, bool more) {
    const int c = it & 31, bh = it >> 5, h = bh & 7, b = bh >> 3;
    const int ht = F.tid & 255, lane = F.lane, hw = F.wave & 3, i16 = lane & 15, g = lane >> 4;
    LAS unsigned char* L = F.lds + hb * 65536;
    constexpr int PB = 272, PAL = 136, PAD = 80, PLI = 40;
    constexpr int O_KT = 0, O_QT = 17408, O_VT = 34816, O_SC = 52224, O_LI = 53248;
    constexpr int O_AL = O_QT, O_AD = O_QT + 8704;
    LAS float* gc = (LAS float*)(L + O_SC); LAS float* bt = gc + 64; LAS float* egc = gc + 128;
    (void)b; (void)c;
    LDS_BARRIER();
    PrepIn nxt;
    {
        if (ht < 64) {
            const float na = -__expf(F.in[18][h]), dtb = F.in[17][h];
            float v = na * softplusf_(cur.araw + dtb);
            const float be = sigmoidf_(cur.braw);
#pragma unroll
            for (int o = 1; o < 64; o <<= 1) { const float t = __shfl_up(v, o); if (lane >= o) v += t; }
            gc[lane] = v; bt[lane] = be; egc[lane] = __expf(v);
            ((float*)(F.ws + WS_GC))[(size_t)it * 64 + lane] = v;
        }
#pragma unroll
        for (int j = 0; j < 4; ++j) { const int pc = ht + j * 256, r = pc >> 4, c8 = (pc & 15) * 8;
            *(LAS u32x4*)(L + O_KT + r * PB + c8 * 2) = cur.rk[j]; *(LAS u32x4*)(L + O_QT + r * PB + c8 * 2) = cur.rq[j]; *(LAS u32x4*)(L + O_VT + r * PB + c8 * 2) = cur.rv[j]; }
    }
    LDS_BARRIER();
    const int lb = hw, lq = 16 * lb + i16;
    bf16_t* qkm = (bf16_t*)(F.ws + WS_QKM) + (size_t)it * 4096;
    f32x4 kkt[4];
#pragma unroll
    for (int sb = 0; sb < 4; ++sb) {
        kkt[sb] = (f32x4){0.f, 0.f, 0.f, 0.f};
        u32x2 qw = (u32x2){0u, 0u};
        if (sb <= lb) {
            f32x4 qa = (f32x4){0.f, 0.f, 0.f, 0.f};
#pragma unroll
            for (int ks = 0; ks < 4; ++ks) {
                const bf16x8 ks_ = row_frag(L + O_KT, PB, 16 * sb, 32 * ks, lane);
                kkt[sb] = MFMA16(ks_, row_frag(L + O_KT, PB, 16 * lb, 32 * ks, lane), kkt[sb]);
                qa = MFMA16(ks_, row_frag(L + O_QT, PB, 16 * lb, 32 * ks, lane), qa);
            }
            const float gl = gc[lq];
            float qv[4];
#pragma unroll
            for (int r = 0; r < 4; ++r) { const int s_ = 16 * sb + 4 * g + r; const float e = __expf(gl - gc[s_]) * qa[r]; qv[r] = (s_ <= lq) ? e : 0.f; }
            qw = pack4(qv[0], qv[1], qv[2], qv[3]);
        }
        *(u32x2*)(qkm + lq * 64 + 16 * sb + 4 * g) = qw;
    }
    LDS_BARRIER();
    {
        const float gl = gc[lq], bl = bt[lq];
#pragma unroll
        for (int sb = 0; sb < 4; ++sb) {
            if (sb <= lb) {
                float a[4];
#pragma unroll
                for (int r = 0; r < 4; ++r) { const int s_ = 16 * sb + 4 * g + r; const float e = bl * kkt[sb][r] * __expf(gl - gc[s_]); a[r] = (s_ < lq) ? e : 0.f; }
                if (sb < lb) *(LAS u32x2*)(L + O_AL + lq * PAL + (16 * sb + 4 * g) * 2) = pack4(-a[0], -a[1], -a[2], -a[3]);
                else         *(LAS f32x4*)(L + O_AD + lb * (16 * PAD) + i16 * PAD + g * 16) = (f32x4){a[0], a[1], a[2], a[3]};
            }
        }
    }
    f32x4 R[4][4];
    {
        const bool isv = hw < 2;
        LAS const unsigned char* colp = L + (isv ? O_VT : O_KT) + ((64 * hw + i16) & 127) * 2;
#pragma unroll
        for (int i = 0; i < 4; ++i)
#pragma unroll
            for (int r = 0; r < 4; ++r) { const int l = 16 * i + 4 * g + r; const float sc = bt[l] * (isv ? 1.0f : egc[l]);
#pragma unroll
                for (int ct = 0; ct < 4; ++ct) R[ct][i][r] = bf2f(*(LAS const bf16_t*)(colp + l * PB + ct * 32)) * sc; }
    }
    LDS_BARRIER();
    if (lane < 16) {
        float x[16];
        LAS const unsigned char* ad = L + O_AD + hw * (16 * PAD);
#pragma unroll
        for (int l = 0; l < 16; ++l) {
            float acc = (l == lane) ? 1.0f : 0.f;
#pragma unroll
            for (int s4 = 0; s4 < (l + 3) / 4; ++s4) { const f32x4 a = *(LAS const f32x4*)(ad + l * PAD + s4 * 16);
#pragma unroll
                for (int j = 0; j < 4; ++j) if (4 * s4 + j < l) acc -= a[j] * x[4 * s4 + j]; }
            x[l] = acc;
            { const unsigned w = cvt_pk_bf16(acc, 0.f); *(LAS bf16_t*)(L + O_LI + hw * (16 * PLI) + l * PLI + lane * 2) = (bf16_t)(w & 0xffffu); }
        }
    }
    LDS_BARRIER();
    {
        const bool isv = hw < 2;
        bf16_t* dst = (bf16_t*)(F.ws + (isv ? WS_UT : WS_WT)) + (size_t)it * 8192;
        const unsigned sgn = isv ? 0u : 0x80008000u;
        const u32x2 z2 = (u32x2){0u, 0u};
        u32x2 li[4];
#pragma unroll
        for (int i = 0; i < 4; ++i) li[i] = *(LAS const u32x2*)(L + O_LI + i * (16 * PLI) + i16 * PLI + 4 * g * 2);
#pragma unroll
        for (int ct = 0; ct < 4; ++ct) {
            u32x2 xb[4];
#pragma unroll
            for (int i = 0; i < 4; ++i) {
                f32x4 y = R[ct][i];
                if (i >= 1) {
                    const u32x2 a0 = *(LAS const u32x2*)(L + O_AL + (16 * i + i16) * PAL + (0 + 4 * g) * 2);
                    const u32x2 a1 = i >= 2 ? *(LAS const u32x2*)(L + O_AL + (16 * i + i16) * PAL + (16 + 4 * g) * 2) : z2;
                    y = MFMA16(frag2(a0, a1), frag2(xb[0], i >= 2 ? xb[1] : z2), y);
                }
                if (i == 3) {
                    const u32x2 a2 = *(LAS const u32x2*)(L + O_AL + (48 + i16) * PAL + (32 + 4 * g) * 2);
                    y = MFMA16(frag2(a2, z2), frag2(xb[2], z2), y);
                }
                const f32x4 zacc = {0.f, 0.f, 0.f, 0.f};
                const f32x4 x = MFMA16(frag2(li[i], z2), frag2(pack4(y[0], y[1], y[2], y[3]), z2), zacc);
                xb[i] = pack4(x[0], x[1], x[2], x[3]);
                *(u32x2*)(dst + ((64 * hw + 16 * ct + i16) & 127) * 64 + 16 * i + 4 * g) = (u32x2){xb[i].x ^ sgn, xb[i].y ^ sgn};
            }
        }
    }
    if (more) cur = nxt;
}

__device__ __forceinline__ void gdn_scan(Frame& F, int item, int& sit) {
    (void)sit;
    const int dvq = item & 3, bh = item >> 2, h = bh & 7, b = bh >> 3;
    const int tid = F.tid, lane = F.lane, w = F.wave, i16 = lane & 15, g = lane >> 4;
    LAS unsigned char* L = F.lds;
    constexpr int PB = 272, PX = 144, PO = 132;
    constexpr int SET = 67072, O_WT = 0, O_QG = 18432, O_KG = 35840, O_QK = 53248, O_UT = 62464;
    constexpr int O_ST = 2 * SET, O_VN = O_ST + 8704, O_OT = O_VN + 4608;
    static_assert(O_OT + 64 * PO <= MISC_OFF, "gdn LDS map");
    __syncthreads();
    for (int u = tid; u < 8704 / 16; u += 512) *(LAS u32x4*)(L + O_ST + u * 16) = (u32x4){0u, 0u, 0u, 0u};
    f32x4 sacc[2];
    sacc[0] = (f32x4){0.f, 0.f, 0.f, 0.f}; sacc[1] = sacc[0];
    const int lb = w >> 1, eb = w & 1;
    const int r0 = tid >> 4, c8a = (tid & 15) * 8;
    const int xr = tid >> 3, xc8 = (tid & 7) * 8;
    const float* GC = (const float*)(F.ws + WS_GC);
    u32x4 rwA[2], rqA[2], rkA[2], rqkA, ruA, rgA, rwB[2], rqB[2], rkB[2], rqkB, ruB, rgB, gsA, gsB;
    gsA = (u32x4){0u, 0u, 0u, 0u}; gsB = gsA;
    float* SSO = (float*)(F.ws + WS_SSO); const float* gg = F.in[19];
    float gq0A = 0.f, gq1A = 0.f, glastA = 0.f, gq0B = 0.f, gq1B = 0.f, glastB = 0.f, glvA = 1.f, glvB = 1.f;
#define GDN_LOADA(c) do { const size_t it_ = (size_t)bh * 32 + (c); \
        const bf16_t* wt = (const bf16_t*)(F.ws + WS_WT) + it_ * 8192; rwA[0] = *(const u32x4*)(wt + xr * 64 + xc8); rwA[1] = *(const u32x4*)(wt + (xr + 64) * 64 + xc8); \
        const bf16_t* src = F.PROJ() + (size_t)(b * SEQ + (c) * 64) * LDP + h * 128 + c8a; \
        rqA[0] = *(const u32x4*)(src + (size_t)r0 * LDP + C_Q); rqA[1] = *(const u32x4*)(src + (size_t)(r0 + 32) * LDP + C_Q); \
        rkA[0] = *(const u32x4*)(src + (size_t)r0 * LDP + C_K); rkA[1] = *(const u32x4*)(src + (size_t)(r0 + 32) * LDP + C_K); \
        rqkA = *(const u32x4*)((const bf16_t*)(F.ws + WS_QKM) + it_ * 4096 + xr * 64 + xc8); \
        if (tid < 256) ruA = *(const u32x4*)((const bf16_t*)(F.ws + WS_UT) + it_ * 8192 + (dvq * 32 + xr) * 64 + xc8); \
        if (tid < 256) rgA = *(const u32x4*)(F.PROJ() + (size_t)(b * SEQ + (c) * 64 + (tid >> 2)) * LDP + C_GATE + h * 128 + dvq * 32 + (tid & 3) * 8); \
        gq0A = GC[it_ * 64 + r0]; gq1A = GC[it_ * 64 + r0 + 32]; glastA = GC[it_ * 64 + 63]; } while (0)
#define GDN_LOADB(c) do { const size_t it_ = (size_t)bh * 32 + (c); \
        const bf16_t* wt = (const bf16_t*)(F.ws + WS_WT) + it_ * 8192; rwB[0] = *(const u32x4*)(wt + xr * 64 + xc8); rwB[1] = *(const u32x4*)(wt + (xr + 64) * 64 + xc8); \
        const bf16_t* src = F.PROJ() + (size_t)(b * SEQ + (c) * 64) * LDP + h * 128 + c8a; \
        rqB[0] = *(const u32x4*)(src + (size_t)r0 * LDP + C_Q); rqB[1] = *(const u32x4*)(src + (size_t)(r0 + 32) * LDP + C_Q); \
        rkB[0] = *(const u32x4*)(src + (size_t)r0 * LDP + C_K); rkB[1] = *(const u32x4*)(src + (size_t)(r0 + 32) * LDP + C_K); \
        rqkB = *(const u32x4*)((const bf16_t*)(F.ws + WS_QKM) + it_ * 4096 + xr * 64 + xc8); \
        if (tid < 256) ruB = *(const u32x4*)((const bf16_t*)(F.ws + WS_UT) + it_ * 8192 + (dvq * 32 + xr) * 64 + xc8); \
        if (tid < 256) rgB = *(const u32x4*)(F.PROJ() + (size_t)(b * SEQ + (c) * 64 + (tid >> 2)) * LDP + C_GATE + h * 128 + dvq * 32 + (tid & 3) * 8); \
        gq0B = GC[it_ * 64 + r0]; gq1B = GC[it_ * 64 + r0 + 32]; glastB = GC[it_ * 64 + 63]; } while (0)
#define GDN_STAGE(Q, QS) do { \
        *(LAS u32x4*)(L + QS * SET + O_WT + xr * PX + xc8 * 2) = rw##Q[0]; *(LAS u32x4*)(L + QS * SET + O_WT + (xr + 64) * PX + xc8 * 2) = rw##Q[1]; \
        *(LAS u32x4*)(L + QS * SET + O_QK + xr * PX + xc8 * 2) = rqk##Q; \
        if (tid < 256) *(LAS u32x4*)(L + QS * SET + O_UT + xr * PX + xc8 * 2) = ru##Q; \
        gs##Q = rg##Q; glv##Q = __expf(glast##Q); \
        { float t8_[8]; const float eq0_ = __expf(gq0##Q), eq1_ = __expf(gq1##Q), ek0_ = __expf(glast##Q - gq0##Q), ek1_ = __expf(glast##Q - gq1##Q); \
          unpack8(rq##Q[0], t8_); _Pragma("unroll") for (int i_ = 0; i_ < 8; ++i_) t8_[i_] *= eq0_; *(LAS u32x4*)(L + QS * SET + O_QG + r0 * PB + c8a * 2) = pack8(t8_); \
          unpack8(rq##Q[1], t8_); _Pragma("unroll") for (int i_ = 0; i_ < 8; ++i_) t8_[i_] *= eq1_; *(LAS u32x4*)(L + QS * SET + O_QG + (r0 + 32) * PB + c8a * 2) = pack8(t8_); \
          unpack8(rk##Q[0], t8_); _Pragma("unroll") for (int i_ = 0; i_ < 8; ++i_) t8_[i_] *= ek0_; *(LAS u32x4*)(L + QS * SET + O_KG + r0 * PB + c8a * 2) = pack8(t8_); \
          unpack8(rk##Q[1], t8_); _Pragma("unroll") for (int i_ = 0; i_ < 8; ++i_) t8_[i_] *= ek1_; *(LAS u32x4*)(L + QS * SET + O_KG + (r0 + 32) * PB + c8a * 2) = pack8(t8_); } } while (0)
    GDN_LOADA(0); GDN_LOADB(1);
    GDN_STAGE(A, 0);
    GDN_LOADA(2);
    for (int c2 = 0; c2 < SEQ / 128; ++c2) {
        { const int c = 2 * c2;
        LDS_BARRIER();
        if (c > 0 && tid < 256) {
            const int r = tid >> 2, c8 = (tid & 3) * 8; float o[8], gt[8]; unpack8(gsB, gt); float ss = 0.f;
            const f32x4 g0 = *(const f32x4*)(gg + dvq * 32 + c8), g1 = *(const f32x4*)(gg + dvq * 32 + c8 + 4);
#pragma unroll
            for (int i = 0; i < 8; ++i) { const float ov = *(LAS const float*)(L + O_OT + r * PO + (c8 + i) * 4); ss += ov * ov; o[i] = ov * (i < 4 ? g0[i & 3] : g1[i & 3]) * siluf_(gt[i]); }
            *(u32x4*)(F.PROJ() + (size_t)(b * SEQ + (c - 1) * 64 + r) * LDP + C_B + h * 128 + dvq * 32 + c8) = pack8(o);
            ss += __shfl_xor(ss, 1); ss += __shfl_xor(ss, 2);
            if ((tid & 3) == 0) atomicAdd(SSO + (size_t)(b * SEQ + (c - 1) * 64 + r) * 8 + h, ss);
        }
        if (c + 1 < SEQ / 64) {
            GDN_STAGE(B, 1);
            if (c + 3 < SEQ / 64) GDN_LOADB(c + 3);
        }
        f32x4 vacc, oacc = (f32x4){0.f, 0.f, 0.f, 0.f};
        { const u32x2 uw = *(LAS const u32x2*)(L + 0 * SET + O_UT + (16 * eb + i16) * PX + (16 * lb + 4 * g) * 2);
          vacc = (f32x4){bflo(uw.x), bfhi(uw.x), bflo(uw.y), bfhi(uw.y)}; }
#pragma unroll
        for (int ks = 0; ks < 4; ++ks) {
            const bf16x8 bS = row_frag(L + O_ST, PB, 16 * eb, 32 * ks, lane);
            vacc = MFMA16(tr_frag(L + 0 * SET + O_WT, PX, 32 * ks, 16 * lb, lane), bS, vacc);
            oacc = MFMA16(row_frag(L + 0 * SET + O_QG, PB, 16 * lb, 32 * ks, lane), bS, oacc);
        }
        *(LAS u32x2*)(L + O_VN + (16 * eb + i16) * PX + (16 * lb + 4 * g) * 2) = pack4(vacc[0], vacc[1], vacc[2], vacc[3]);
        LDS_BARRIER();
        {
            const bf16x8 bV0 = row_frag(L + O_VN, PX, 16 * eb, 0, lane), bV1 = row_frag(L + O_VN, PX, 16 * eb, 32, lane);
            oacc = MFMA16(row_frag(L + 0 * SET + O_QK, PX, 16 * lb, 0, lane), bV0, oacc);
            if (lb >= 2) oacc = MFMA16(row_frag(L + 0 * SET + O_QK, PX, 16 * lb, 32, lane), bV1, oacc);
#pragma unroll
            for (int r = 0; r < 4; ++r) *(LAS float*)(L + O_OT + (16 * lb + 4 * g + r) * PO + (16 * eb + i16) * 4) = oacc[r];
#pragma unroll
            for (int t2 = 0; t2 < 2; ++t2) {
                const int db = 2 * lb + t2;
                f32x4 sa = sacc[t2] * glvA;
                sa = MFMA16(tr_frag(L + 0 * SET + O_KG, PB, 0, 16 * db, lane), bV0, sa);
                sa = MFMA16(tr_frag(L + 0 * SET + O_KG, PB, 32, 16 * db, lane), bV1, sa);
                sacc[t2] = sa;
                *(LAS u32x2*)(L + O_ST + (16 * eb + i16) * PB + (16 * db + 4 * g) * 2) = pack4(sa[0], sa[1], sa[2], sa[3]);
            }
        }
        }
        { const int c = 2 * c2 + 1;
        LDS_BARRIER();
        if (c > 0 && tid < 256) {
            const int r = tid >> 2, c8 = (tid & 3) * 8; float o[8], gt[8]; unpack8(gsA, gt); float ss = 0.f;
            const f32x4 g0 = *(const f32x4*)(gg + dvq * 32 + c8), g1 = *(const f32x4*)(gg + dvq * 32 + c8 + 4);
#pragma unroll
            for (int i = 0; i < 8; ++i) { const float ov = *(LAS const float*)(L + O_OT + r * PO + (c8 + i) * 4); ss += ov * ov; o[i] = ov * (i < 4 ? g0[i & 3] : g1[i & 3]) * siluf_(gt[i]); }
            *(u32x4*)(F.PROJ() + (size_t)(b * SEQ + (c - 1) * 64 + r) * LDP + C_B + h * 128 + dvq * 32 + c8) = pack8(o);
            ss += __shfl_xor(ss, 1); ss += __shfl_xor(ss, 2);
            if ((tid & 3) == 0) atomicAdd(SSO + (size_t)(b * SEQ + (c - 1) * 64 + r) * 8 + h, ss);
        }
        if (c + 1 < SEQ / 64) {
            GDN_STAGE(A, 0);
            if (c + 3 < SEQ / 64) GDN_LOADA(c + 3);
        }
        f32x4 vacc, oacc = (f32x4){0.f, 0.f, 0.f, 0.f};
        { const u32x2 uw = *(LAS const u32x2*)(L + 1 * SET + O_UT + (16 * eb + i16) * PX + (16 * lb + 4 * g) * 2);
          vacc = (f32x4){bflo(uw.x), bfhi(uw.x), bflo(uw.y), bfhi(uw.y)}; }
#pragma unroll
        for (int ks = 0; ks < 4; ++ks) {
            const bf16x8 bS = row_frag(L + O_ST, PB, 16 * eb, 32 * ks, lane);
            vacc = MFMA16(tr_frag(L + 1 * SET + O_WT, PX, 32 * ks, 16 * lb, lane), bS, vacc);
            oacc = MFMA16(row_frag(L + 1 * SET + O_QG, PB, 16 * lb, 32 * ks, lane), bS, oacc);
        }
        *(LAS u32x2*)(L + O_VN + (16 * eb + i16) * PX + (16 * lb + 4 * g) * 2) = pack4(vacc[0], vacc[1], vacc[2], vacc[3]);
        LDS_BARRIER();
        {
            const bf16x8 bV0 = row_frag(L + O_VN, PX, 16 * eb, 0, lane), bV1 = row_frag(L + O_VN, PX, 16 * eb, 32, lane);
            oacc = MFMA16(row_frag(L + 1 * SET + O_QK, PX, 16 * lb, 0, lane), bV0, oacc);
            if (lb >= 2) oacc = MFMA16(row_frag(L + 1 * SET + O_QK, PX, 16 * lb, 32, lane), bV1, oacc);
#pragma unroll
            for (int r = 0; r < 4; ++r) *(LAS float*)(L + O_OT + (16 * lb + 4 * g + r) * PO + (16 * eb + i16) * 4) = oacc[r];
#pragma unroll
            for (int t2 = 0; t2 < 2; ++t2) {
                const int db = 2 * lb + t2;
                f32x4 sa = sacc[t2] * glvB;
                sa = MFMA16(tr_frag(L + 1 * SET + O_KG, PB, 0, 16 * db, lane), bV0, sa);
                sa = MFMA16(tr_frag(L + 1 * SET + O_KG, PB, 32, 16 * db, lane), bV1, sa);
                sacc[t2] = sa;
                *(LAS u32x2*)(L + O_ST + (16 * eb + i16) * PB + (16 * db + 4 * g) * 2) = pack4(sa[0], sa[1], sa[2], sa[3]);
            }
        }
        }
    }
    LDS_BARRIER();
    if (tid < 256) {
        const int c = SEQ / 64, r = tid >> 2, c8 = (tid & 3) * 8; float o[8], gt[8]; unpack8(gsB, gt); float ss = 0.f;
        const f32x4 g0 = *(const f32x4*)(gg + dvq * 32 + c8), g1 = *(const f32x4*)(gg + dvq * 32 + c8 + 4);
#pragma unroll
        for (int i = 0; i < 8; ++i) { const float ov = *(LAS const float*)(L + O_OT + r * PO + (c8 + i) * 4); ss += ov * ov; o[i] = ov * (i < 4 ? g0[i & 3] : g1[i & 3]) * siluf_(gt[i]); }
        *(u32x4*)(F.PROJ() + (size_t)(b * SEQ + (c - 1) * 64 + r) * LDP + C_B + h * 128 + dvq * 32 + c8) = pack8(o);
        ss += __shfl_xor(ss, 1); ss += __shfl_xor(ss, 2);
        if ((tid & 3) == 0) atomicAdd(SSO + (size_t)(b * SEQ + (c - 1) * 64 + r) * 8 + h, ss);
    }
#undef GDN_LOADA
#undef GDN_LOADB
#undef GDN_STAGE
#pragma unroll
    for (int t2 = 0; t2 < 2; ++t2)
#pragma unroll
        for (int r = 0; r < 4; ++r) F.out[O_GDNP + ((size_t)bh * 128 + 16 * (2 * lb + t2) + 4 * g + r) * 128 + dvq * 32 + 16 * eb + i16] = sacc[t2][r];
}


template <class EpiQ>
__device__ __forceinline__ void small_gemm(Frame& F, const bf16_t* A, int lda, const bf16_t* Bt, int ldb, int K, int N, const EpiQ& q) {
    const int lane = F.lane, w = F.wave, i16 = lane & 15, g = lane >> 4, kp = w & 3, tw = w >> 2;
    LAS float* part = (LAS float*)F.lds;
    const int ntl = 8 * (N / 16), nsteps = K / 128;
    for (int t2 = blockIdx.x; 2 * t2 < ntl; t2 += F.G) {
        const int t = 2 * t2 + tw, rg = t / (N / 16), nb = t % (N / 16);
        const bf16_t* ap = A + (size_t)(16 * rg + i16) * lda + kp * (K / 4) + 8 * g;
        const bf16_t* bp = Bt + (size_t)(16 * nb + i16) * ldb + kp * (K / 4) + 8 * g;
        f32x4 acc = (f32x4){0.f, 0.f, 0.f, 0.f};
        bf16x8 a0[8], b0[8], a1[8], b1[8];
#define SG_LOAD(A_, B_, base) do { _Pragma("unroll") for (int j = 0; j < 8; ++j) if ((base) + j < nsteps) { A_[j] = *(const bf16x8*)(ap + ((base) + j) * 32); B_[j] = *(const bf16x8*)(bp + ((base) + j) * 32); } } while (0)
#define SG_MMA(A_, B_, base) do { _Pragma("unroll") for (int j = 0; j < 8; ++j) if ((base) + j < nsteps) acc = MFMA16(B_[j], A_[j], acc); } while (0)
        SG_LOAD(a0, b0, 0);
        for (int ks = 0; ks < nsteps; ks += 16) {
            SG_LOAD(a1, b1, ks + 8);
            SG_MMA(a0, b0, ks);
            SG_LOAD(a0, b0, ks + 16);
            SG_MMA(a1, b1, ks + 8);
        }
#undef SG_LOAD
#undef SG_MMA
        __syncthreads();
        *(LAS f32x4*)(part + (w * 64 + lane) * 4) = acc;
        __syncthreads();
        if (kp == 0) {
            const f32x4 p1 = *(LAS const f32x4*)(part + ((w + 1) * 64 + lane) * 4), p2 = *(LAS const f32x4*)(part + ((w + 2) * 64 + lane) * 4), p3 = *(LAS const f32x4*)(part + ((w + 3) * 64 + lane) * 4);
            acc = (acc + p1) + (p2 + p3);
            q(MPR + 16 * rg + i16, 16 * nb + 4 * g, acc);
        }
    }
}
struct QT1 { bf16_t* PROJ;
    __device__ __forceinline__ void operator()(int row, int col, f32x4 v) const {
        const u32x2 mw = *(const u32x2*)(PROJ + (size_t)row * LDP + C_MG + col);
        *(u32x2*)(PROJ + (size_t)row * LDP + C_Z + col) = pack4(v[0] * sigmoidf_(bflo(mw.x)), v[1] * sigmoidf_(bfhi(mw.x)), v[2] * sigmoidf_(bflo(mw.y)), v[3] * sigmoidf_(bfhi(mw.y))); } };
struct QMix { bf16_t* PROJ;
    __device__ __forceinline__ void operator()(int row, int col, f32x4 v) const {
        const u32x2 mw = *(const u32x2*)(PROJ + (size_t)row * LDP + C_MG + 1024 + col), tw = *(const u32x2*)(PROJ + (size_t)row * LDP + C_Z + col);
        *(u32x2*)(PROJ + (size_t)row * LDP + C_Q + col) = pack4(bflo(tw.x) + v[0] * sigmoidf_(bflo(mw.x)), bfhi(tw.x) + v[1] * sigmoidf_(bfhi(mw.x)), bflo(tw.y) + v[2] * sigmoidf_(bflo(mw.y)), bfhi(tw.y) + v[3] * sigmoidf_(bfhi(mw.y))); } };
template <int MODE> struct QResid { bf16_t* PROJ; const float* xs; int res_col, dstb_col; float* SS;
    __device__ __forceinline__ void operator()(int row, int col, f32x4 v) const {
        f32x4 r;
        if (MODE == 0) r = *(const f32x4*)(xs + (size_t)(row - MPR) * D + col);
        else { const u32x2 rw = *(const u32x2*)(PROJ + (size_t)row * LDP + res_col + col); r = (f32x4){bflo(rw.x), bfhi(rw.x), bflo(rw.y), bfhi(rw.y)}; }
        const f32x4 x = r + v;
        *(u32x2*)(PROJ + (size_t)row * LDP + dstb_col + col) = pack4(x[0], x[1], x[2], x[3]);
        float ss = (x[0] * x[0] + x[1] * x[1]) + (x[2] * x[2] + x[3] * x[3]);
        ss += __shfl_xor(ss, 16); ss += __shfl_xor(ss, 32);
        if ((threadIdx.x & 48) == 0) atomicAdd(SS + row, ss); } };
struct QPE { bf16_t* PROJ;
    __device__ __forceinline__ void operator()(int row, int col, f32x4 v) const { *(u32x2*)(PROJ + (size_t)row * LDP + C_Z + col) = pack4(v[0], v[1], v[2], v[3]); } };
__device__ __forceinline__ void small_mix(Frame& F, const bf16_t* WT) {
    const int lane = F.lane, w = F.wave, i16 = lane & 15, g = lane >> 4, kp = w & 3, tw = w >> 2;
    LAS float* part = (LAS float*)F.lds;
    const int t = 2 * (int)blockIdx.x + tw, rg = t / (D / 16), nb = t % (D / 16);
    const bf16_t* arow = F.PROJ() + (size_t)(MPR + 16 * rg + i16) * LDP;
    const bf16_t* brow = WT + (size_t)(16 * nb + i16) * 3072;
    const bf16_t* ap = arow + C_XS + kp * 512 + 8 * g; const bf16_t* bp = brow + kp * 512 + 8 * g;
    const bf16_t* ap2 = arow + C_B + kp * 256 + 8 * g; const bf16_t* bp2 = brow + 2048 + kp * 256 + 8 * g;
    f32x4 acc1 = (f32x4){0.f, 0.f, 0.f, 0.f}, acc2 = acc1;
    bf16x8 a0[8], b0[8], a1[8], b1[8];
#pragma unroll
    for (int j = 0; j < 8; ++j) { a0[j] = *(const bf16x8*)(ap + j * 32); b0[j] = *(const bf16x8*)(bp + j * 32); }
#pragma unroll
    for (int j = 0; j < 8; ++j) { a1[j] = *(const bf16x8*)(ap + (8 + j) * 32); b1[j] = *(const bf16x8*)(bp + (8 + j) * 32); }
#pragma unroll
    for (int j = 0; j < 8; ++j) acc1 = MFMA16(b0[j], a0[j], acc1);
#pragma unroll
    for (int j = 0; j < 8; ++j) { a0[j] = *(const bf16x8*)(ap2 + j * 32); b0[j] = *(const bf16x8*)(bp2 + j * 32); }
#pragma unroll
    for (int j = 0; j < 8; ++j) acc1 = MFMA16(b1[j], a1[j], acc1);
#pragma unroll
    for (int j = 0; j < 8; ++j) acc2 = MFMA16(b0[j], a0[j], acc2);
    __syncthreads();
    *(LAS f32x4*)(part + (w * 64 + lane) * 8) = acc1; *(LAS f32x4*)(part + (w * 64 + lane) * 8 + 4) = acc2;
    __syncthreads();
    if (kp == 0) {
#pragma unroll
        for (int q = 1; q < 4; ++q) { acc1 += *(LAS const f32x4*)(part + ((w + q) * 64 + lane) * 8); acc2 += *(LAS const f32x4*)(part + ((w + q) * 64 + lane) * 8 + 4); }
        const int row = MPR + 16 * rg + i16, col = 16 * nb + 4 * g;
        const u32x2 m1 = *(const u32x2*)(F.PROJ() + (size_t)row * LDP + C_MG + col), m2 = *(const u32x2*)(F.PROJ() + (size_t)row * LDP + C_MG + 1024 + col);
        *(u32x2*)(F.PROJ() + (size_t)row * LDP + C_Q + col) = pack4(acc1[0] * sigmoidf_(bflo(m1.x)) + acc2[0] * sigmoidf_(bflo(m2.x)), acc1[1] * sigmoidf_(bfhi(m1.x)) + acc2[1] * sigmoidf_(bfhi(m2.x)),
                                                                  acc1[2] * sigmoidf_(bflo(m1.y)) + acc2[2] * sigmoidf_(bflo(m2.y)), acc1[3] * sigmoidf_(bfhi(m1.y)) + acc2[3] * sigmoidf_(bfhi(m2.y)));
    }
}

__device__ __forceinline__ void small_x3_final(Frame& F, const bf16_t* A, int lda, const bf16_t* Bt, int ldb, const bf16_t* WPP, const float* SS2, float* SS3, unsigned* cnt, unsigned* bar) {
    const int lane = F.lane, w = F.wave, i16 = lane & 15, g = lane >> 4, kp = w & 3, tw = w >> 2;
    LAS float* part = (LAS float*)F.lds;
    const int t = 2 * (int)blockIdx.x + tw, rg = t / (D / 16), nb = t % (D / 16);
    const bf16_t* ap = A + (size_t)(16 * rg + i16) * lda + kp * (D / 4) + 8 * g;
    const bf16_t* bp = Bt + (size_t)(16 * nb + i16) * ldb + kp * (D / 4) + 8 * g;
    const bf16_t* ap2 = F.PB() + (size_t)(MPR + 16 * rg + i16) * 256 + kp * 64 + 8 * g;
    const bf16_t* bp2 = WPP + (size_t)(16 * nb + i16) * 256 + kp * 64 + 8 * g;
    f32x4 acc = (f32x4){0.f, 0.f, 0.f, 0.f}, acc2 = acc;
    {   bf16x8 av[10], bv[10];
#pragma unroll
        for (int j = 0; j < 8; ++j) { av[j] = *(const bf16x8*)(ap + j * 32); bv[j] = *(const bf16x8*)(bp + j * 32); }
#pragma unroll
        for (int j = 0; j < 2; ++j) { av[8 + j] = *(const bf16x8*)(ap2 + j * 32); bv[8 + j] = *(const bf16x8*)(bp2 + j * 32); }
#pragma unroll
        for (int j = 0; j < 8; ++j) acc = MFMA16(bv[j], av[j], acc);
#pragma unroll
        for (int j = 0; j < 2; ++j) acc2 = MFMA16(bv[8 + j], av[8 + j], acc2);
    }
    __syncthreads();
    *(LAS f32x4*)(part + (w * 64 + lane) * 8) = acc; *(LAS f32x4*)(part + (w * 64 + lane) * 8 + 4) = acc2;
    __syncthreads();
    const int row = MPR + 16 * rg + i16, col = 16 * nb + 4 * g;
    f32x4 x = (f32x4){0.f, 0.f, 0.f, 0.f};
    if (kp == 0) {
#pragma unroll
        for (int q = 1; q < 4; ++q) { acc += *(LAS const f32x4*)(part + ((w + q) * 64 + lane) * 8); acc2 += *(LAS const f32x4*)(part + ((w + q) * 64 + lane) * 8 + 4); }
        const float r = rsqrtf(SS2[row] * (1.0f / D) + EPS);
        const u32x2 aw = *(const u32x2*)(F.PROJ() + (size_t)row * LDP + C_GATE + col);
        const f32x4 a = (f32x4){bflo(aw.x), bfhi(aw.x), bflo(aw.y), bfhi(aw.y)};
#pragma unroll
        for (int i = 0; i < 4; ++i) x[i] = a[i] + acc2[i] * sigmoidf_(r * acc[i]);
        float ss = (x[0] * x[0] + x[1] * x[1]) + (x[2] * x[2] + x[3] * x[3]);
        ss += __shfl_xor(ss, 16); ss += __shfl_xor(ss, 32);
        if (g == 0) atomicAdd(SS3 + row, ss);
    }
    asm volatile("s_waitcnt vmcnt(0)" ::: "memory");
    __syncthreads();
    if (F.tid == 0) { unsigned* c = cnt + 64 * rg; (void)xb_add(c, 1u); unsigned sp = 0u;
        while (xb_ld(c) < 32u) { __builtin_amdgcn_s_sleep(1); if ((++sp & 255u) == 0u) { if (xb_ld(&bar[XB_TMO])) break; if (sp > XB_SPIN_CAP) { atomicAdd(&bar[XB_TMO], 1u); break; } } } }
    __syncthreads();
    if (kp == 0) {
        const float r3 = rsqrtf(__uint_as_float(xb_ld((unsigned*)(SS3 + row))) * (1.0f / D) + EPS);
        const f32x4 gq = *(const f32x4*)(F.in[29] + col);
        *(f32x4*)(F.out + O_YS + (size_t)(row - MPR) * D + col) = x * r3 * gq;
    }
}

struct GdnSmp2In { f32x4 S[8]; u32x4 k8, q8; u32x2 v4; float araw, braw; };
__device__ __forceinline__ void gdn_smp2_load(const Frame& F, int it, int e4, int dg, GdnSmp2In& r) {
    const int sq = it >> 3, h = it & 7;
    const float* sp = F.in[6] + ((size_t)(sq * 8 + h) * 128 + dg * 8) * 128 + e4 * 4;
#pragma unroll
    for (int j = 0; j < 8; ++j) r.S[j] = *(const f32x4*)(sp + (size_t)j * 128);
    const bf16_t* row = F.PROJ() + (size_t)(MPR + sq) * LDP;
    r.k8 = *(const u32x4*)(row + C_K + h * 128 + dg * 8); r.q8 = *(const u32x4*)(row + C_Q + h * 128 + dg * 8);
    r.v4 = *(const u32x2*)(row + C_V + h * 128 + e4 * 4);
    const float* sm = F.SMALL() + (size_t)(MPR + sq) * 64;
    r.araw = sm[40 + h]; r.braw = sm[32 + h];
}
__device__ __forceinline__ void gdn_sample2_regs(const Frame& F) {
    const int tid = F.tid, e4 = tid & 31, dg = tid >> 5, w = F.wave, lane = F.lane;
    LAS f32x4* pa = (LAS f32x4*)F.lds;
    LAS f32x4* pb = (LAS f32x4*)(F.lds + 4096);
    constexpr int NIT = NSMP * 8;
    int it = blockIdx.x;
    if (it >= NIT) return;
    GdnSmp2In cur, nxt;
    gdn_smp2_load(F, it, e4, dg, cur);
    for (; it < NIT; it += F.G) {
        const bool more = it + F.G < NIT;
        if (more) gdn_smp2_load(F, it + F.G, e4, dg, nxt);
        const int sq = it >> 3, h = it & 7;
        const float eg = __expf(-__expf(F.in[18][h]) * softplusf_(cur.araw + F.in[17][h])), bt = sigmoidf_(cur.braw);
        float k8[8], q8[8]; unpack8(cur.k8, k8); unpack8(cur.q8, q8);
        f32x4 ks = (f32x4){0.f, 0.f, 0.f, 0.f};
#pragma unroll
        for (int j = 0; j < 8; ++j) ks += cur.S[j] * k8[j];
#pragma unroll
        for (int i = 0; i < 4; ++i) ks[i] += __shfl_xor(ks[i], 32);
        __syncthreads();
        if (lane < 32) pa[w * 32 + e4] = ks;
        __syncthreads();
        f32x4 kS = pa[e4];
#pragma unroll
        for (int ww = 1; ww < 8; ++ww) kS += pa[ww * 32 + e4];
        const f32x4 vv = (f32x4){bflo(cur.v4.x), bfhi(cur.v4.x), bflo(cur.v4.y), bfhi(cur.v4.y)};
        const f32x4 vn = (vv - kS * eg) * bt;
        f32x4 op = (f32x4){0.f, 0.f, 0.f, 0.f};
        float* dp = F.out + O_GDNS + ((size_t)(sq * 8 + h) * 128 + dg * 8) * 128 + e4 * 4;
#pragma unroll
        for (int j = 0; j < 8; ++j) { const f32x4 sn = cur.S[j] * eg + vn * k8[j]; op += sn * q8[j]; *(f32x4*)(dp + (size_t)j * 128) = sn; }
#pragma unroll
        for (int i = 0; i < 4; ++i) op[i] += __shfl_xor(op[i], 32);
        if (lane < 32) pb[w * 32 + e4] = op;
        __syncthreads();
        if (dg == 0) {
            f32x4 o = pb[e4];
#pragma unroll
            for (int ww = 1; ww < 8; ++ww) o += pb[ww * 32 + e4];
            float ss = (o[0] * o[0] + o[1] * o[1]) + (o[2] * o[2] + o[3] * o[3]);
            ss += __shfl_xor(ss, 1); ss += __shfl_xor(ss, 2); ss += __shfl_xor(ss, 4); ss += __shfl_xor(ss, 8); ss += __shfl_xor(ss, 16);
            const float rn = rsqrtf(ss * (1.0f / 128.0f) + EPS);
            const u32x2 gw = *(const u32x2*)(F.PROJ() + (size_t)(MPR + sq) * LDP + C_GATE + h * 128 + e4 * 4);
            const f32x4 gn = *(const f32x4*)(F.in[19] + e4 * 4);
            *(u32x2*)(F.PROJ() + (size_t)(MPR + sq) * LDP + C_B + h * 128 + e4 * 4) = pack4(o[0] * rn * gn[0] * siluf_(bflo(gw.x)), o[1] * rn * gn[1] * siluf_(bfhi(gw.x)), o[2] * rn * gn[2] * siluf_(bflo(gw.y)), o[3] * rn * gn[3] * siluf_(bfhi(gw.y)));
        }
        if (more) cur = nxt;
    }
}

__device__ __forceinline__ void gdn_sample2(const Frame& F) {
    constexpr int NIT = NSMP * 8, SLOT = 65536 + 4096;
    constexpr int O_PA = 2 * SLOT, O_PB = O_PA + 2048, O_HP = O_PB + 2048;
    static_assert(O_HP + 256 <= MISC_OFF, "gdn sample ring");
    const int w = F.wave, lane = F.lane;
    LAS unsigned char* L = F.lds;
    const int first = blockIdx.x, n = first < NIT ? (NIT - 1 - first) / F.G + 1 : 0;
    LAS float* hp = (LAS float*)(L + O_HP);
    __syncthreads();
    if (F.tid < 8) { hp[F.tid] = -__expf(F.in[18][F.tid]); hp[8 + F.tid] = F.in[17][F.tid]; }
    __syncthreads();
    if (w < 4) {
#define GSL_ISSUE(k_) do { const int it_ = first + (k_) * F.G, sq_ = it_ >> 3, h_ = it_ & 7; \
            const char* sp_ = (const char*)(F.in[6] + (size_t)it_ * 16384) + (size_t)((w * 16) * 64 + lane) * 16; \
            LAS unsigned char* sl_ = L + ((k_) & 1) * SLOT + w * 16384; \
            _Pragma("unroll") for (int j_ = 0; j_ < 16; ++j_) __builtin_amdgcn_global_load_lds((const unsigned*)(sp_ + j_ * 1024), (LAS unsigned*)(sl_ + j_ * 1024), 16, 0, 0); \
            const bf16_t* row_ = F.PROJ() + (size_t)(MPR + sq_) * LDP + h_ * 128 + (lane & 15) * 8; \
            const char* op_ = w == 0 ? (const char*)(row_ + C_K) : w == 1 ? (const char*)(row_ + C_Q) : w == 2 ? (const char*)(row_ + C_V) \
                            : (lane & 16) ? (const char*)(F.SMALL() + (size_t)(MPR + sq_) * 64 + 32 + (lane & 3) * 4) : (const char*)(row_ + C_GATE); \
            __builtin_amdgcn_global_load_lds((const unsigned*)op_, (LAS unsigned*)(L + ((k_) & 1) * SLOT + 65536 + w * 1024), 16, 0, 0); } while (0)
        if (n > 0) GSL_ISSUE(0);
        if (n > 1) GSL_ISSUE(1);
        for (int k = 0; k < n; ++k) {
            if (k + 1 < n) asm volatile("s_waitcnt vmcnt(17)" ::: "memory"); else asm volatile("s_waitcnt vmcnt(0)" ::: "memory");
            __builtin_amdgcn_s_barrier(); asm volatile("" ::: "memory");
            __builtin_amdgcn_s_barrier(); asm volatile("" ::: "memory");
            if (k + 2 < n) GSL_ISSUE(k + 2);
            __builtin_amdgcn_s_barrier(); asm volatile("" ::: "memory");
        }
#undef GSL_ISSUE
    } else {
        const int cw = w - 4, e4 = lane & 31, dgl = lane >> 5, d0 = (cw * 2 + dgl) * 16;
        LAS f32x4* pa = (LAS f32x4*)(L + O_PA); LAS f32x4* pb = (LAS f32x4*)(L + O_PB);
        for (int k = 0; k < n; ++k) {
            asm volatile("s_waitcnt lgkmcnt(0)" ::: "memory"); __builtin_amdgcn_s_barrier(); asm volatile("" ::: "memory");
            const int it = first + k * F.G, sq = it >> 3, h = it & 7;
            LAS const unsigned char* sl = L + (k & 1) * SLOT;
            f32x4 S[16];
#pragma unroll
            for (int j = 0; j < 16; ++j) S[j] = *(LAS const f32x4*)(sl + (size_t)(d0 + j) * 512 + e4 * 16);
            float k16[16], q16[16];
            { unpack8(*(LAS const u32x4*)(sl + 65536 + d0 * 2), *(float (*)[8])&k16[0]); unpack8(*(LAS const u32x4*)(sl + 65536 + d0 * 2 + 16), *(float (*)[8])&k16[8]);
              unpack8(*(LAS const u32x4*)(sl + 65536 + 1024 + d0 * 2), *(float (*)[8])&q16[0]); unpack8(*(LAS const u32x4*)(sl + 65536 + 1024 + d0 * 2 + 16), *(float (*)[8])&q16[8]); }
            const u32x2 v4 = *(LAS const u32x2*)(sl + 65536 + 2048 + e4 * 8), gw = *(LAS const u32x2*)(sl + 65536 + 3072 + e4 * 8);
            const float braw = *(LAS const float*)(sl + 65536 + 3072 + 256 + h * 4), araw = *(LAS const float*)(sl + 65536 + 3072 + 256 + 32 + h * 4);
            const float eg = __expf(hp[h] * softplusf_(araw + hp[8 + h])), bt = sigmoidf_(braw);
            f32x4 ks = (f32x4){0.f, 0.f, 0.f, 0.f};
#pragma unroll
            for (int j = 0; j < 16; ++j) ks += S[j] * k16[j];
#pragma unroll
            for (int i = 0; i < 4; ++i) ks[i] += __shfl_xor(ks[i], 32);
            if (lane < 32) pa[cw * 32 + e4] = ks;
            asm volatile("s_waitcnt lgkmcnt(0)" ::: "memory"); __builtin_amdgcn_s_barrier(); asm volatile("" ::: "memory");
            const f32x4 kS = (pa[e4] + pa[32 + e4]) + (pa[64 + e4] + pa[96 + e4]);
            const f32x4 vv = (f32x4){bflo(v4.x), bfhi(v4.x), bflo(v4.y), bfhi(v4.y)};
            const f32x4 vn = (vv - kS * eg) * bt;
            f32x4 op = (f32x4){0.f, 0.f, 0.f, 0.f};
            float* dp = F.out + O_GDNS + ((size_t)it * 128 + d0) * 128 + e4 * 4;
#pragma unroll
            for (int j = 0; j < 16; ++j) { const f32x4 sn = S[j] * eg + vn * k16[j]; op += sn * q16[j]; *(f32x4*)(dp + (size_t)j * 128) = sn; }
#pragma unroll
            for (int i = 0; i < 4; ++i) op[i] += __shfl_xor(op[i], 32);
            if (lane < 32) pb[cw * 32 + e4] = op;
            asm volatile("s_waitcnt lgkmcnt(0)" ::: "memory"); __builtin_amdgcn_s_barrier(); asm volatile("" ::: "memory");
            if (cw == 0 && lane < 32) {
                const f32x4 o = (pb[e4] + pb[32 + e4]) + (pb[64 + e4] + pb[96 + e4]);
                float ss = (o[0] * o[0] + o[1] * o[1]) + (o[2] * o[2] + o[3] * o[3]);
                ss += __shfl_xor(ss, 1); ss += __shfl_xor(ss, 2); ss += __shfl_xor(ss, 4); ss += __shfl_xor(ss, 8); ss += __shfl_xor(ss, 16);
                const float rn = rsqrtf(ss * (1.0f / 128.0f) + EPS);
                const f32x4 gn = *(const f32x4*)(F.in[19] + e4 * 4);
                *(u32x2*)(F.PROJ() + (size_t)(MPR + sq) * LDP + C_B + h * 128 + e4 * 4) = pack4(o[0] * rn * gn[0] * siluf_(bflo(gw.x)), o[1] * rn * gn[1] * siluf_(bfhi(gw.x)), o[2] * rn * gn[2] * siluf_(bflo(gw.y)), o[3] * rn * gn[3] * siluf_(bfhi(gw.y)));
            }
        }
    }
}

#ifdef PROBE_A
#define STAMPF(k) do { if (blockIdx.x == 0 && F.tid == 0) ((volatile LAS unsigned*)(F.lds + MISC_OFF))[16 + (k)] = (unsigned)__builtin_amdgcn_s_memrealtime(); } while (0)
#else
#define STAMPF(k) do { } while (0)
#endif
__device__ __forceinline__ void p3_scan(Frame& F) {
    int sit = NSMP * 32;
    if (F.G == 256) {
        const int xcd = blockIdx.x & 7, idx = blockIdx.x >> 3, grp = xcd * 4 + (idx >> 3);
        ssd_chunked(F, (grp >> 2) * 32 + (grp & 3) * 8 + (idx & 7), sit);
    } else
    for (int it = blockIdx.x; it < NBATCH * 32; it += F.G) ssd_chunked(F, it, sit);
    __syncthreads(); STAMPF(15);
    { const int hb = F.tid >> 8;
      for (int pr = blockIdx.x; pr < 1024; pr += F.G) { PrepIn pin; prep_load(F, 2 * pr + hb, pin); gdn_prep3(F, 2 * pr + hb, hb, pin, 0, false); } }
    __syncthreads(); STAMPF(16);
    ssd_sample_stream(F, blockIdx.x);
}
__device__ __forceinline__ void sample_ynorm(Frame& F) {
    const int gw = blockIdx.x * NWAVES + F.wave, NGW = F.G * NWAVES, lane = F.lane;
    for (int u = gw; u < NSMP * 4; u += NGW) {
        bf16_t* row = F.PROJ() + (size_t)(MPR + (u >> 2)) * LDP;
        const int c = (u & 3) * 512 + lane * 8;
        float y[8], z[8]; unpack8(*(const u32x4*)(row + C_XS + c), y); unpack8(*(const u32x4*)(row + C_Z + c), z);
        float ss = 0.f;
#pragma unroll
        for (int i = 0; i < 8; ++i) { y[i] *= siluf_(z[i]); ss += y[i] * y[i]; }
        const float r = rsqrtf(wave_sum(ss) * (1.0f / 512.0f) + EPS);
#pragma unroll
        for (int i = 0; i < 8; ++i) y[i] *= r;
        *(u32x4*)(row + C_XS + c) = pack8(y);
    }
}
__device__ __forceinline__ void p3b_scan(Frame& F) {
    int sit = NSMP * 32;
    sample_ynorm(F);
    if (F.G == 256) {
        const int xcd = blockIdx.x & 7, idx = blockIdx.x >> 3;
        gdn_scan(F, (xcd * 8 + (idx >> 2)) * 4 + (idx & 3), sit);
    } else
    for (int it = blockIdx.x; it < NBATCH * 32; it += F.G) gdn_scan(F, it, sit);
    __syncthreads(); STAMPF(17);
    gdn_sample2(F);
}

__device__ __forceinline__ void p4_norm(Frame& F) {
    const int gw = blockIdx.x * NWAVES + F.wave, NGW = F.G * NWAVES, lane = F.lane;
    const float* gs = F.in[15]; const float* gg = F.in[19];
    for (int m = gw; m < MTOT; m += NGW) {
        bf16_t* row = F.PROJ() + (size_t)m * LDP;
#pragma unroll
        for (int g = 0; g < 4; ++g) {
            const int c = g * 512 + lane * 8;
            float y[8], z[8]; unpack8(*(const u32x4*)(row + C_XS + c), y); unpack8(*(const u32x4*)(row + C_Z + c), z);
            float ss = 0.f;
#pragma unroll
            for (int i = 0; i < 8; ++i) { y[i] *= siluf_(z[i]); ss += y[i] * y[i]; }
            const float r = rsqrtf(wave_sum(ss) * (1.0f / 512.0f) + EPS);
            const f32x4 g0 = *(const f32x4*)(gs + c), g1 = *(const f32x4*)(gs + c + 4);
#pragma unroll
            for (int i = 0; i < 4; ++i) { y[i] *= r * g0[i]; y[4 + i] *= r * g1[i]; }
            *(u32x4*)(row + C_XS + c) = pack8(y);
        }
#pragma unroll
        for (int hh = 0; hh < 2; ++hh) {
            const int c = hh * 512 + lane * 8;
            float o[8], gt[8]; unpack8(*(const u32x4*)(row + C_V + c), o); unpack8(*(const u32x4*)(row + C_GATE + c), gt);
            float ss = 0.f;
#pragma unroll
            for (int i = 0; i < 8; ++i) ss += o[i] * o[i];
            ss += __shfl_xor(ss, 1); ss += __shfl_xor(ss, 2); ss += __shfl_xor(ss, 4); ss += __shfl_xor(ss, 8);
            const float r = rsqrtf(ss * (1.0f / 128.0f) + EPS);
            const int e = (lane & 15) * 8;
            const f32x4 g0 = *(const f32x4*)(gg + e), g1 = *(const f32x4*)(gg + e + 4);
#pragma unroll
            for (int i = 0; i < 4; ++i) { o[i] = o[i] * r * g0[i] * siluf_(gt[i]); o[4 + i] = o[4 + i] * r * g1[i] * siluf_(gt[4 + i]); }
            *(u32x4*)(row + C_V + c) = pack8(o);
        }
    }
}

__device__ __forceinline__ void p12_final(Frame& F) {
    const int gw = blockIdx.x * NWAVES + F.wave, NGW = F.G * NWAVES, lane = F.lane;
    const float* gf = F.in[29];
    for (int m = gw; m < MTOT; m += NGW) {
        float* orow = F.out + (m < MPR ? O_Y + (size_t)m * D : O_YS + (size_t)(m - MPR) * D);
        const bf16_t* xrow = F.PROJ() + (size_t)m * LDP + C_K;
        const u32x4 xa = *(const u32x4*)(xrow + lane * 8), xb = *(const u32x4*)(xrow + 512 + lane * 8);
        const float r = rsqrtf(F.SS3()[m] * (1.0f / D) + EPS);
        float x[8];
        unpack8(xa, x);
        { const int c = lane * 8; const f32x4 g0 = *(const f32x4*)(gf + c), g1 = *(const f32x4*)(gf + c + 4);
          *(f32x4*)(orow + c) = (f32x4){x[0] * r * g0[0], x[1] * r * g0[1], x[2] * r * g0[2], x[3] * r * g0[3]}; *(f32x4*)(orow + c + 4) = (f32x4){x[4] * r * g1[0], x[5] * r * g1[1], x[6] * r * g1[2], x[7] * r * g1[3]}; }
        unpack8(xb, x);
        { const int c = 512 + lane * 8; const f32x4 g0 = *(const f32x4*)(gf + c), g1 = *(const f32x4*)(gf + c + 4);
          *(f32x4*)(orow + c) = (f32x4){x[0] * r * g0[0], x[1] * r * g0[1], x[2] * r * g0[2], x[3] * r * g0[3]}; *(f32x4*)(orow + c + 4) = (f32x4){x[4] * r * g1[0], x[5] * r * g1[1], x[6] * r * g1[2], x[7] * r * g1[3]}; }
    }
}

__global__ void __launch_bounds__(NWAVES * 64, 2) mega_fwd(Args args) {
    extern __shared__ __attribute__((aligned(16))) unsigned char lds_raw[];
    Frame F;
    F.lds = (LAS unsigned char*)lds_raw;
    F.tid = threadIdx.x; F.lane = F.tid & 63; F.wave = __builtin_amdgcn_readfirstlane(F.tid >> 6); F.G = gridDim.x;
    F.in = args.in;
    F.out = args.out; F.ws = args.ws;
    unsigned char* ws = args.ws;
    const int lo = args.ph_lo, hi = args.ph_hi;
#if MK_ONE_LAUNCH
    volatile LAS unsigned* MISC = (volatile LAS unsigned*)(F.lds + MISC_OFF);
    if (F.tid < 32) MISC[F.tid] = 0u;
    __syncthreads();
    XcdBarrier bar = xcd_barrier_post((unsigned*)(ws + WS_BAR), MISC + 8);
#ifdef PROBE_A
#define STAMP(k) do { if (blockIdx.x == 0 && F.tid == 0) MISC[16 + (k)] = (unsigned)__builtin_amdgcn_s_memrealtime(); } while (0)
#else
#define STAMP(k) do { } while (0)
#endif
#define SEAM(k) do { if (lo <= (k) && (k) + 1 < hi) xcd_barrier(bar); STAMP((k) + 1); } while (0)
#else
#define SEAM(k) do { } while (0)
#endif
#ifndef PHASE_MASK
#define PHASE_MASK 0xffff
#endif
#define IN(k) (((PHASE_MASK >> (k)) & 1) && lo <= (k) && (k) < hi)
#ifndef REP_PHASE
#define REP_PHASE -1
#endif
#define NREP(k) ((REP_PHASE == (k)) ? 2 : 1)
    const int bid = (int)blockIdx.x;
    typedef pg8::StaticOrder SO;
    STAMP(0);

    if (IN(0)) { p0_prologue(F, 0, bid * NWAVES + F.wave, F.G * NWAVES); SEAM(0); }
    if (IN(1)) {
        pg8::Gemm g{F.XN(), (const bf16_t*)(ws + WS_WIN), MP, NPROJ, D, D, D}; SO S; S.init(MP, NPROJ, F.G, bid);
        EpiInProj E{F.PROJ(), F.HALO(), F.SMALL(), F.in[10], F.in[11], F.in[16], (LAS float*)(F.lds + RT_OFF)};
        pg8::gemm_phase<EpiInProj, SO>(F.lds, g, S, E);
        {
            const int rem = S.nwg % F.G, nidle = rem ? F.G - rem : F.G, me = rem ? bid - rem : bid;
            if (me >= 0) p0_prologue(F, 1, me * NWAVES + F.wave, nidle * NWAVES);
        }
        SEAM(1);
    }
    if (IN(2)) { p2_conv(F); SEAM(2); }
    if (IN(3)) { p3_scan(F); SEAM(3); }
    if (IN(4)) { p3b_scan(F); SEAM(4); }
    if (IN(6)) {
        pg8::Gemm g{F.PROJ() + C_XS, (const bf16_t*)(ws + WS_WBS), MPR, D, 3072, LDP, 3072}; SO S; S.init(MPR, D, F.G, bid);
        LAS float* rt = (LAS float*)(F.lds + RT_OFF);
        { Unit u0; if (S.next(0, u0) && F.tid < 256) {
              const float* sy = (const float*)(ws + WS_SSY) + (size_t)(u0.pm * 256 + F.tid) * 4; const float* so = (const float*)(ws + WS_SSO) + (size_t)(u0.pm * 256 + F.tid) * 8;
              float ry[4], ro[8];
#pragma unroll
              for (int q = 0; q < 4; ++q) ry[q] = rsqrtf(sy[q] * (1.0f / 512.0f) + EPS);
#pragma unroll
              for (int q = 0; q < 8; ++q) ro[q] = rsqrtf(so[q] * (1.0f / 128.0f) + EPS);
              rt[F.tid] = ry[0] / ry[1]; rt[256 + F.tid] = ry[1] / ry[2]; rt[512 + F.tid] = ry[2] / ry[3]; rt[768 + F.tid] = ry[3] / ro[0];
#pragma unroll
              for (int q = 0; q < 7; ++q) rt[(4 + q) * 256 + F.tid] = ro[q] / ro[q + 1];
              rt[15 * 256 + F.tid] = ro[7]; }
          __syncthreads(); }
        EpiMixCat E{F.PROJ(), rt + 15 * 256};
        pg8::gemm_phase<EpiMixCat, SO>(F.lds, g, S, E);
        small_mix(F, (const bf16_t*)(ws + WS_WBS)); SEAM(7);
    }
    if (IN(8)) {
        pg8::Gemm g{F.PROJ() + C_Q, (const bf16_t*)(ws + WS_WOUT), MPR, D, D, LDP, D}; SO S; S.init(MPR, D, F.G, bid);
        EpiResid<0> E{F.PROJ(), F.in[0], F.in[1], 0, C_K, F.SS1()};
        pg8::gemm_phase<EpiResid<0>, SO>(F.lds, g, S, E);
        small_gemm(F, F.PROJ() + (size_t)MPR * LDP + C_Q, LDP, (const bf16_t*)(ws + WS_WOUT), D, D, D, QResid<0>{F.PROJ(), F.in[1], 0, C_K, F.SS1()}); SEAM(8);
    }
    if (IN(9)) {
        pg8::Gemm g{F.PROJ() + C_K, (const bf16_t*)(ws + WS_WFI), MP, 2 * DFF, D, LDP, D}; SO S; S.init(MP, 2 * DFF, F.G, bid);
        EpiSwiGLU E{F.PROJ(), F.SS1()};
        for (int rp = 0; rp < NREP(9); ++rp) { pg8::gemm_phase<EpiSwiGLU, SO>(F.lds, g, S, E); if (rp + 1 < NREP(9)) xcd_barrier(bar); } SEAM(9);
    }
    if (IN(10)) {
        pg8::Gemm g{F.PROJ() + C_XS, (const bf16_t*)(ws + WS_WFO), MPR, D, DFF, LDP, DFF}; SO S; S.init(MPR, D, F.G, bid);
        EpiResid<1> E{F.PROJ(), nullptr, nullptr, C_K, C_GATE, F.SS2()};
        pg8::gemm_phase<EpiResid<1>, SO>(F.lds, g, S, E);
        small_gemm(F, F.PROJ() + (size_t)MPR * LDP + C_XS, LDP, (const bf16_t*)(ws + WS_WFO), DFF, DFF, D, QResid<1>{F.PROJ(), nullptr, C_K, C_GATE, F.SS2()}); SEAM(10);
    }
    if (IN(11)) {
        pg8::Gemm g{F.PB(), (const bf16_t*)(ws + WS_WPP), MPR, D, 256, 256, 256}; SO S; S.init(MPR, D, F.G, bid);
        EpiPE E{F.PROJ()};
        pg8::gemm_phase<EpiPE, SO>(F.lds, g, S, E);
        STAMP(12);
    }
    if (IN(12)) {
        pg8::Gemm g{F.PROJ() + C_GATE, (const bf16_t*)(ws + WS_WPG), MPR, D, D, LDP, D}; SO S; S.init(MPR, D, F.G, bid);
        EpiX3 E{F.PROJ(), F.SS2(), F.SS3(), F.out, (unsigned*)(ws + WS_XCNT), (unsigned*)(ws + WS_BAR), F.in[29], (LAS float*)(F.lds + RT_OFF)};
        pg8::gemm_phase<EpiX3, SO>(F.lds, g, S, E);
        small_x3_final(F, F.PROJ() + (size_t)MPR * LDP + C_GATE, LDP, (const bf16_t*)(ws + WS_WPG), D, (const bf16_t*)(ws + WS_WPP), F.SS2(), F.SS3(), (unsigned*)(ws + WS_XCNT2), (unsigned*)(ws + WS_BAR));
    }
#ifdef PROBE_A
    STAMP(14);
    __syncthreads();
    if (blockIdx.x == 0) {
        const float tb = (float)(MISC[16 + PROBE_B] - MISC[16 + PROBE_A]) * 0.01f;
        const float sc = 1.0f + sqrtf(tb * PROBE_SCALE);
        for (int i = F.tid; i < 73728; i += NWAVES * 64) F.out[O_GCONVP + i] *= sc;
    }
#endif
#undef IN
#undef SEAM
}

constexpr int NPHASES = 14;

extern "C" void kernel_launch(void* const* d_in, const int* in_sizes, int n_in, void* d_out, int out_size, void* d_ws, size_t ws_size, hipStream_t stream) {
    static int grid = 0;
    if (grid == 0) {
        if (n_in != 30 || ws_size < WS_END) { fprintf(stderr, "kernel_launch: bad call: n_in %d ws %zu (need %zu)\n", n_in, ws_size, (size_t)WS_END); grid = -1; return; }
        int dev = 0, cus = 0, per_cu = 0;
        if (hipGetDevice(&dev) != hipSuccess || hipDeviceGetAttribute(&cus, hipDeviceAttributeMultiprocessorCount, dev) != hipSuccess) { grid = -1; return; }
        if (hipFuncSetAttribute((const void*)mega_fwd, hipFuncAttributeMaxDynamicSharedMemorySize, LDS_BYTES) != hipSuccess) { fprintf(stderr, "kernel_launch: hipFuncSetAttribute failed\n"); grid = -1; return; }
        if (hipOccupancyMaxActiveBlocksPerMultiprocessor(&per_cu, (const void*)mega_fwd, NWAVES * 64, LDS_BYTES) != hipSuccess || per_cu < 1) { fprintf(stderr, "kernel_launch: occupancy query says %d\n", per_cu); per_cu = 1; }
        (void)hipGetLastError();
        if (cus < 256) { fprintf(stderr, "kernel_launch: this kernel needs 256 CUs (one workgroup per CU, one 256x256 unit per workgroup in the N = 1024 GEMM phases); device has %d\n", cus); grid = -1; return; }
        grid = 256;
    }
    if (grid < 0) return;
    (void)hipMemsetAsync((char*)d_ws + WS_SSY, 0, SS2_BYTES + CTL_BYTES, stream);
    Args a{};
    for (int i = 0; i < 30; ++i) a.in[i] = (const float*)d_in[i];
    a.out = (float*)d_out; a.ws = (unsigned char*)d_ws;
#if MK_ONE_LAUNCH
    a.ph_lo = 0; a.ph_hi = NPHASES;
    void* kargs[] = {&a};
    hipError_t e = hipLaunchCooperativeKernel((const void*)mega_fwd, dim3(grid), dim3(NWAVES * 64), kargs, LDS_BYTES, stream);
    if (e != hipSuccess) fprintf(stderr, "cooperative launch failed: %s (grid %d)\n", hipGetErrorString(e), grid);
#else
    for (int ph = 0; ph < NPHASES; ++ph) {
        a.ph_lo = ph; a.ph_hi = ph + 1;
        hipLaunchKernelGGL(mega_fwd, dim3(grid), dim3(NWAVES * 64), LDS_BYTES, stream, a);
    }
#endif
}
```

```cpp
#include <hip/hip_runtime.h>
#include <hip/hip_cooperative_groups.h>
#include <cstdio>
#include <cstdint>
namespace cg = cooperative_groups;

#define PROBE_SCALE 1e-6f
#ifndef MK_ONE_LAUNCH
#define MK_ONE_LAUNCH 1
#endif

#define LAS __attribute__((address_space(3)))
typedef unsigned short bf16_t;
typedef short bf16x8 __attribute__((ext_vector_type(8)));
typedef float f32x4 __attribute__((ext_vector_type(4)));
typedef float f32x2 __attribute__((ext_vector_type(2)));
typedef unsigned u32x4 __attribute__((ext_vector_type(4)));
typedef unsigned u32x2 __attribute__((ext_vector_type(2)));

constexpr int D = 1024, SEQ = 2048, NBATCH = 8, MPR = NBATCH * SEQ, NSMP = 128, MTOT = MPR + NSMP, MP = 16640;
constexpr int LDP = 11264, LDF = LDP / 2;
constexpr int C_Z = 0, C_XS = 2048, C_B = 4096, C_C = 4608, C_Q = 5120, C_K = 6144, C_V = 7168, C_GATE = 8192, C_MG = 9216;
constexpr int NIN = 11312;
constexpr int NPROJ = 11520;
constexpr int DFF = 2816;
constexpr float EPS = 1e-6f;
constexpr int CONV_FUSE_LO = 8, CONV_FUSE_HI = 32;
constexpr int NCH = 6144;

constexpr size_t O_Y = 0, O_YS = 16777216, O_SSMP = 16908288, O_SCONVP = 19005440, O_GDNP = 19079168, O_GCONVP = 20127744,
                 O_SSMS = 20201472, O_SCONVS = 53755904, O_GDNS = 54935552, O_GCONVS = 71712768;

constexpr int RT_OFF = 132096;
constexpr size_t MiB = 1u << 20;
constexpr size_t WS_CTL = 502 * MiB, CTL_BYTES = 1 * MiB;
constexpr size_t WS_BAR = WS_CTL + 16384;
constexpr size_t WS_XCNT = WS_CTL + 32768, WS_XCNT2 = WS_CTL + 49152;
constexpr size_t WS_SS1 = WS_CTL + 65536, WS_SS2 = WS_SS1 + 69632, WS_SS3 = WS_SS2 + 69632;
constexpr size_t WS_WIN = 1 * MiB, WS_WBS = 25 * MiB, WS_WBG = 29 * MiB, WS_WOUT = 31 * MiB, WS_WFI = 33 * MiB, WS_WFO = 44 * MiB, WS_WPG = 50 * MiB, WS_WPP = 52 * MiB;
constexpr size_t WS_XN = 53 * MiB, WS_PB = 86 * MiB, WS_SMALL = 95 * MiB, WS_HALO = 100 * MiB, WS_PROJ = 110 * MiB;
constexpr size_t WS_END0 = WS_PROJ + (size_t)MP * LDP * 2;
constexpr size_t WS_WT = WS_XN, WS_QKM = WS_WIN, WS_UT = 468 * MiB, WS_GC = 500 * MiB;
constexpr size_t WS_SSY = 501 * MiB, WS_SSO = WS_SSY + 512 * 1024, SS2_BYTES = 1024 * 1024;
constexpr size_t WS_END = WS_CTL + CTL_BYTES;
static_assert(WS_SSY + SS2_BYTES == WS_CTL, "one memset region");
static_assert(WS_END0 <= WS_UT && WS_UT + 32 * MiB <= WS_GC, "ws map 2");
static_assert(WS_END <= 512 * MiB, "ws map");
static_assert(WS_SS3 + 69632 <= WS_CTL + CTL_BYTES, "ctl");

typedef __bf16 bf16x2_t __attribute__((ext_vector_type(2)));
__device__ __forceinline__ unsigned cvt_pk_bf16(float lo, float hi) { const f32x2 v = {lo, hi}; const bf16x2_t b = __builtin_convertvector(v, bf16x2_t); return __builtin_bit_cast(unsigned, b); }
__device__ __forceinline__ float bflo(unsigned w) { return __uint_as_float(w << 16); }
__device__ __forceinline__ float bfhi(unsigned w) { return __uint_as_float(w & 0xffff0000u); }
__device__ __forceinline__ float bf2f(bf16_t b) { return __uint_as_float((unsigned)b << 16); }
__device__ __forceinline__ void unpack8(const u32x4 w, float (&f)[8]) { f[0] = bflo(w.x); f[1] = bfhi(w.x); f[2] = bflo(w.y); f[3] = bfhi(w.y); f[4] = bflo(w.z); f[5] = bfhi(w.z); f[6] = bflo(w.w); f[7] = bfhi(w.w); }
__device__ __forceinline__ u32x4 pack8(const float (&f)[8]) { u32x4 w; w.x = cvt_pk_bf16(f[0], f[1]); w.y = cvt_pk_bf16(f[2], f[3]); w.z = cvt_pk_bf16(f[4], f[5]); w.w = cvt_pk_bf16(f[6], f[7]); return w; }
__device__ __forceinline__ float sigmoidf_(float x) { return __builtin_amdgcn_rcpf(1.0f + __builtin_amdgcn_exp2f(-1.4426950408889634f * x)); }
__device__ __forceinline__ float siluf_(float x) { return x * sigmoidf_(x); }
__device__ __forceinline__ float softplusf_(float x) { return x > 20.f ? x : log1pf(__expf(x)); }
template <int CTRL> __device__ __forceinline__ float dpp_mov(float v) { return __builtin_bit_cast(float, __builtin_amdgcn_update_dpp(0, __builtin_bit_cast(int, v), CTRL, 0xF, 0xF, true)); }
template <int J> __device__ __forceinline__ float dpp_prev(float x, float pv) {
    int t = __builtin_amdgcn_update_dpp(0, __builtin_bit_cast(int, pv), 0x120 + J, 0xF, 0xF, true);
    t = __builtin_amdgcn_update_dpp(t, __builtin_bit_cast(int, x), 0x110 + J, 0xF, 0xF, false);
    return __builtin_bit_cast(float, t);
}
__device__ __forceinline__ float row16_sum(float v) {
    v += dpp_mov<0xB1>(v);
    v += dpp_mov<0x4E>(v);
    v += dpp_mov<0x124>(v);
    v += dpp_mov<0x128>(v);
    return v;
}
__device__ __forceinline__ float wave_sum(float v) {
#pragma unroll
    for (int o = 1; o < 64; o <<= 1) v += __shfl_xor(v, o);
    return v;
}

namespace pg8 {
constexpr int BM = 256, BK = 64, HALF = 128, HTB = HALF * BK * 2, STAGE_BYTES = 8 * HTB, NXCD = 8, WGM = 8;
__host__ __device__ __forceinline__ int lds_byte(int r, int c) { const int st = (r >> 4) * 2 + (c >> 5), rr = r & 15, cc = c & 31, ob = rr * 64 + cc * 2; return st * 1024 + (ob ^ (((ob >> 9) & 1) << 5)); }
__host__ __device__ __forceinline__ void stage_rc(int b, int& R, int& C) { const int st = b / 1024, sb = b % 1024, swz = sb ^ (((sb >> 9) & 1) << 5); R = (st >> 1) * 16 + swz / 64; C = (st & 1) * 32 + (swz % 64) / 2; }
__host__ __device__ __forceinline__ int perm32(int rho) { const int n = rho >> 4, i = rho & 15; return 8 * (i >> 2) + 4 * n + (i & 3); }

struct Unit { int pm, pn; };
struct Gemm { const bf16_t* A; const bf16_t* Bt; int M, N, K, lda, ldb; };

struct StaticOrder {
    int nM, nN, nwg, G, c;
    __host__ __device__ __forceinline__ void init(int M, int N, int G_, int c_) { nM = M / BM; nN = N / BM; nwg = nM * nN; G = G_; c = c_; }
    __host__ __device__ __forceinline__ bool next(int i, Unit& u) const {
        const long L = (long)i * G + c; if (L >= nwg) return false;
        int wgid = (int)L; { const int q = nwg / NXCD, r = nwg % NXCD, xcd = wgid % NXCD, off = wgid / NXCD; wgid = (xcd < r ? xcd * (q + 1) : r * (q + 1) + (xcd - r) * q) + off; }
        const int nig = WGM * nN, gid = wgid / nig, fm = gid * WGM, gsz = (nM - fm) < WGM ? (nM - fm) : WGM;
        u.pm = fm + ((wgid % nig) % gsz); u.pn = (wgid % nig) / gsz; return true;
    }
    __device__ __forceinline__ void a_ready(const Unit&) const {}
    __device__ __forceinline__ void done(const Unit&) const {}
};

template <class Epi, class Sched, bool ALIGN_EPI = true, bool SP2 = true>
__device__ __forceinline__ void gemm_phase(LAS unsigned char* lds, const Gemm g, const Sched& S, const Epi& E) {
    const int tid = threadIdx.x, wid = __builtin_amdgcn_readfirstlane(tid >> 6), lane = tid & 63, wr = wid >> 2, wc = wid & 3, fr = lane & 15, fq = lane >> 4;
    int nt = g.K / BK / Epi::NSEG; asm volatile("" : "+s"(nt));
    unsigned voffA, voffB;
    { int R, C; stage_rc(tid * 16, R, C); const int Rb = Epi::PERM ? ((R & ~31) + perm32(R & 31)) : R;
      voffA = (unsigned)(R * g.lda + C) * 2u; voffB = (unsigned)(Rb * g.ldb + C) * 2u; }
    const size_t s64A = (size_t)64 * g.lda * 2, s64B = (size_t)64 * g.ldb * 2;
    const size_t kstep = (size_t)(BK * 2);
    const size_t hstepA = (size_t)HALF * g.lda * 2, hstepB = (size_t)HALF * g.ldb * 2;
    const size_t tstepA = 2 * hstepA, tstepB = 2 * hstepB;
    const unsigned ldsw = (unsigned)wid * 1024u;
    const int aoff = lds_byte(wr * 64 + fr, fq * 8), boff = lds_byte(wc * 32 + fr, fq * 8);
#define PG8_SA(b, h) (((b) * 2 + (h)) * HTB)
#define PG8_SB(b, h) ((4 + (b) * 2 + (h)) * HTB)
#define PG8_STAGE(bufoff, gbase, voff) do { _Pragma("unroll") for (int _i = 0; _i < 2; ++_i) \
        __builtin_amdgcn_global_load_lds((const unsigned*)((const char*)(gbase) + (size_t)_i * (voff##_s64) + (voff)), (LAS unsigned*)(lds + (bufoff) + ldsw + _i * 8192), 16, 0, 0); } while (0)
#define voffA_s64 s64A
#define voffB_s64 s64B
#define PG8_LDA(dst, b, h) do { _Pragma("unroll") for (int m = 0; m < 4; ++m) _Pragma("unroll") for (int k = 0; k < 2; ++k) dst[m][k] = *(const LAS bf16x8*)(lds + PG8_SA(b, h) + aoff + m * 2048 + k * 1024); } while (0)
#define PG8_LDB(dst, b, h) do { _Pragma("unroll") for (int n = 0; n < 2; ++n) _Pragma("unroll") for (int k = 0; k < 2; ++k) dst[n][k] = *(const LAS bf16x8*)(lds + PG8_SB(b, h) + boff + n * 2048 + k * 1024); } while (0)
#define PG8_MMA(ai, bj, At, Bt) do { __builtin_amdgcn_s_setprio(1); _Pragma("unroll") for (int m = 0; m < 4; ++m) _Pragma("unroll") for (int n = 0; n < 2; ++n) _Pragma("unroll") for (int k = 0; k < 2; ++k) \
        acc[ai][bj][m][n] = __builtin_amdgcn_mfma_f32_16x16x32_bf16(Bt[n][k], At[m][k], acc[ai][bj][m][n], 0, 0, 0); __builtin_amdgcn_s_setprio(0); } while (0)
#define PG8_WAIT_V(n) asm volatile("s_waitcnt vmcnt(" #n ")" ::: "memory")
#define PG8_WAIT_L(n) asm volatile("s_waitcnt lgkmcnt(" #n ")" ::: "memory")
#define PG8_BAR __builtin_amdgcn_s_barrier()
#define PG8_SCHED __builtin_amdgcn_sched_barrier(0)
    Unit cur, nxt; int ui = 0;
    if (!S.next(0, cur)) return;
    f32x4 acc[2][2][4][2];
#pragma unroll
    for (int a = 0; a < 2; ++a)
#pragma unroll
        for (int b = 0; b < 2; ++b)
#pragma unroll
            for (int m = 0; m < 4; ++m)
#pragma unroll
                for (int n = 0; n < 2; ++n) acc[a][b][m][n] = (f32x4){0.f, 0.f, 0.f, 0.f};
    bf16x8 At[4][2], B0[2][2], B1[2][2];
    const char* cA = (const char*)g.A + (size_t)cur.pm * tstepA; const char* cB = (const char*)g.Bt + (size_t)cur.pn * tstepB;
    S.a_ready(cur);
    if constexpr (SP2) {
        PG8_STAGE(PG8_SB(0, 0), cB, voffB); PG8_STAGE(PG8_SB(0, 1), cB + hstepB, voffB); PG8_STAGE(PG8_SA(0, 0), cA, voffA); PG8_STAGE(PG8_SA(0, 1), cA + hstepA, voffA);
        if (wr == 1) PG8_BAR;
        PG8_WAIT_V(2); PG8_BAR;
        PG8_STAGE(PG8_SB(1, 0), cB + kstep, voffB); PG8_STAGE(PG8_SA(1, 0), cA + kstep, voffA); PG8_STAGE(PG8_SB(1, 1), cB + hstepB + kstep, voffB);
        PG8_WAIT_V(6); PG8_BAR;
    } else {
        PG8_STAGE(PG8_SB(0, 0), cB, voffB); PG8_STAGE(PG8_SA(0, 0), cA, voffA); PG8_STAGE(PG8_SB(0, 1), cB + hstepB, voffB); PG8_STAGE(PG8_SA(0, 1), cA + hstepA, voffA);
        if (wr == 1) PG8_BAR;
        PG8_WAIT_V(4); PG8_BAR;
        PG8_STAGE(PG8_SB(1, 0), cB + kstep, voffB); PG8_STAGE(PG8_SA(1, 0), cA + kstep, voffA); PG8_STAGE(PG8_SB(1, 1), cB + hstepB + kstep, voffB);
        PG8_WAIT_V(6); PG8_BAR;
    }
    for (;;) {
        const bool has_next = S.next(ui + 1, nxt);
        const char* uA = has_next ? (const char*)g.A + (size_t)nxt.pm * tstepA : cA; const char* uB = has_next ? (const char*)g.Bt + (size_t)nxt.pn * tstepB : cB;
        const char* sA = cA; const char* sB = cB;
#pragma unroll
        for (int part = 0; part < Epi::NPART; ++part) {
        const int seg0 = part == 0 ? 0 : Epi::SPLIT, seg1 = part == Epi::NPART - 1 ? Epi::NSEG : Epi::SPLIT;
#pragma nounroll
        for (int seg = seg0; seg < seg1; ++seg) {
        const bool lastseg = (seg == Epi::NSEG - 1);
        int ntc = nt; if constexpr (Epi::NSEG == 12) ntc = seg < 4 ? 8 : 2;
        const char* nA = lastseg ? uA : sA + (size_t)ntc * kstep; const char* nB = lastseg ? uB : sB + (size_t)ntc * kstep;
        for (int t = 0; t < ntc; t += 2) {
            const bool last = (t == ntc - 2);
            const char* a1 = sA + (size_t)(t + 1) * kstep;
            const char* a2 = last ? nA : sA + (size_t)(t + 2) * kstep; const char* b2 = last ? nB : sB + (size_t)(t + 2) * kstep;
            const char* a3 = a2 + kstep; const char* b3 = b2 + kstep;
            if (last && lastseg && has_next) S.a_ready(nxt);
            if constexpr (SP2) {
            PG8_LDB(B0, 0, 0); PG8_LDB(B1, 0, 1); PG8_SCHED; PG8_LDA(At, 0, 0); PG8_STAGE(PG8_SA(1, 1), a1 + hstepA, voffA);
            PG8_WAIT_V(8); PG8_WAIT_L(0); PG8_BAR; PG8_MMA(0, 0, At, B0); PG8_MMA(0, 1, At, B1); PG8_BAR; PG8_SCHED;
            PG8_LDA(At, 0, 1); PG8_STAGE(PG8_SB(0, 0), b2, voffB); PG8_STAGE(PG8_SB(0, 1), b2 + hstepB, voffB); PG8_STAGE(PG8_SA(0, 0), a2, voffA);
            PG8_WAIT_V(8); PG8_WAIT_L(0); PG8_BAR; PG8_MMA(1, 0, At, B0); PG8_MMA(1, 1, At, B1); PG8_BAR; PG8_SCHED;
            PG8_LDB(B0, 1, 0); PG8_LDB(B1, 1, 1); PG8_SCHED; PG8_LDA(At, 1, 0); PG8_STAGE(PG8_SA(0, 1), a2 + hstepA, voffA);
            PG8_WAIT_V(8); PG8_WAIT_L(0); PG8_BAR; PG8_MMA(0, 0, At, B0); PG8_MMA(0, 1, At, B1); PG8_BAR; PG8_SCHED;
            PG8_LDA(At, 1, 1); PG8_STAGE(PG8_SB(1, 0), b3, voffB); PG8_STAGE(PG8_SB(1, 1), b3 + hstepB, voffB); PG8_STAGE(PG8_SA(1, 0), a3, voffA);
            PG8_WAIT_V(8); PG8_WAIT_L(0); PG8_BAR; PG8_MMA(1, 0, At, B0); PG8_MMA(1, 1, At, B1); PG8_BAR; PG8_SCHED;
            } else {
            PG8_LDB(B0, 0, 0); PG8_SCHED; PG8_LDA(At, 0, 0); PG8_STAGE(PG8_SA(1, 1), a1 + hstepA, voffA);
            PG8_WAIT_L(8); PG8_BAR; PG8_WAIT_L(0); PG8_MMA(0, 0, At, B0); PG8_BAR; PG8_SCHED;
            PG8_LDB(B1, 0, 1); PG8_STAGE(PG8_SB(0, 0), b2, voffB);
            PG8_BAR; PG8_WAIT_L(0); PG8_MMA(0, 1, At, B1); PG8_BAR;
            PG8_LDA(At, 0, 1); PG8_STAGE(PG8_SA(0, 0), a2, voffA);
            PG8_BAR; PG8_WAIT_L(0); PG8_MMA(1, 0, At, B0); PG8_BAR; PG8_SCHED;
            PG8_STAGE(PG8_SB(0, 1), b2 + hstepB, voffB);
            PG8_WAIT_V(6); PG8_BAR; PG8_MMA(1, 1, At, B1); PG8_BAR;
            PG8_LDB(B0, 1, 0); PG8_SCHED; PG8_LDA(At, 1, 0); PG8_STAGE(PG8_SA(0, 1), a2 + hstepA, voffA);
            PG8_WAIT_L(8); PG8_BAR; PG8_WAIT_L(0); PG8_MMA(0, 0, At, B0); PG8_BAR; PG8_SCHED;
            PG8_LDB(B1, 1, 1); PG8_STAGE(PG8_SB(1, 0), b3, voffB);
            PG8_BAR; PG8_WAIT_L(0); PG8_MMA(0, 1, At, B1); PG8_BAR;
            PG8_LDA(At, 1, 1); PG8_STAGE(PG8_SA(1, 0), a3, voffA);
            PG8_BAR; PG8_WAIT_L(0); PG8_MMA(1, 0, At, B0); PG8_BAR; PG8_SCHED;
            PG8_STAGE(PG8_SB(1, 1), b3 + hstepB, voffB);
            PG8_WAIT_V(6); PG8_BAR; PG8_MMA(1, 1, At, B1); PG8_BAR;
            }
        }
        if constexpr (Epi::NSEG > 1) { if (!lastseg) { if (seg != seg1 - 1) E.khook(acc, seg, cur, wr, wc, fr, fq, (LAS const float*)(lds + RT_OFF)); sA = nA; sB = nB; } }
        }
        if constexpr (Epi::NPART > 1) { if (part + 1 < Epi::NPART) { __builtin_amdgcn_sched_barrier(0); E.parthook(acc, cur, wr, wc, fr, fq, (LAS const float*)(lds + RT_OFF)); __builtin_amdgcn_sched_barrier(0); } }
        }
        if constexpr (ALIGN_EPI) { if (wr == 0) PG8_BAR; }
        E(acc, cur, wr, wc, fr, fq); S.done(cur);
        if (!has_next) break;
#pragma unroll
        for (int a = 0; a < 2; ++a)
#pragma unroll
            for (int b = 0; b < 2; ++b)
#pragma unroll
                for (int m = 0; m < 4; ++m)
#pragma unroll
                    for (int n = 0; n < 2; ++n) acc[a][b][m][n] = (f32x4){0.f, 0.f, 0.f, 0.f};
        cur = nxt; cA = uA; cB = uB; ++ui;
        if constexpr (ALIGN_EPI) { if (wr == 1) PG8_BAR; }
    }
    PG8_WAIT_V(0);
    if constexpr (!ALIGN_EPI) { if (wr == 0) PG8_BAR; }
    PG8_BAR;
#undef PG8_SA
#undef PG8_SB
#undef PG8_STAGE
#undef voffA_s64
#undef voffB_s64
#undef PG8_LDA
#undef PG8_LDB
#undef PG8_MMA
#undef PG8_WAIT_V
#undef PG8_WAIT_L
#undef PG8_BAR
#undef PG8_SCHED
}
}
using pg8::Unit;


#define XB_TMO      128
#define XB_XCNT(j)  (256  + 64 * (j))
#define XB_XSUB(j)  (1280 + 64 * (j))
#define XB_XGEN(j)  (2304 + 64 * (j))
#define XB_TOP      3328
#define XB_TOPGEN   3392
#define XCD_BAR_WORDS 3456
#define XB_SPIN_CAP (1u << 22)
__device__ __forceinline__ unsigned xb_ld(unsigned* p)              { return __hip_atomic_load(p, __ATOMIC_RELAXED, __HIP_MEMORY_SCOPE_AGENT); }
__device__ __forceinline__ unsigned xb_add(unsigned* p, unsigned v) { return __hip_atomic_fetch_add(p, v, __ATOMIC_RELAXED, __HIP_MEMORY_SCOPE_AGENT); }
__device__ __forceinline__ unsigned xb_xcc_id() { return (unsigned)__builtin_amdgcn_s_getreg((3 << 11) | 20) & 0xFu; }
#define XB_SPIN(cond, bar) do { unsigned _sp = 0; while (cond) { __builtin_amdgcn_s_sleep(1); \
    if ((++_sp & 255u) == 0u) { if (xb_ld(&(bar)[XB_TMO])) break; if (_sp > XB_SPIN_CAP) { atomicAdd(&(bar)[XB_TMO], 1u); break; } } } } while (0)
struct XcdBarrier { unsigned* bar; unsigned x; volatile LAS unsigned* st; };
__device__ __forceinline__ XcdBarrier xcd_barrier_post(unsigned* bar, volatile LAS unsigned* st) {
    XcdBarrier b; b.bar = bar; b.x = xb_xcc_id(); b.st = st;
    if (threadIdx.x == 0) (void)xb_add(&bar[XB_XCNT(b.x)], 1u);
    return b;
}
__device__ __forceinline__ void xcd_barrier_complete(unsigned* bar, unsigned x, unsigned& nloc, unsigned& nx) {
    const unsigned G = gridDim.x * gridDim.y * gridDim.z;
    unsigned sum, cnt, mine, sp = 0u;
    for (;;) {
        sum = 0u; cnt = 0u; mine = 0u;
#pragma unroll
        for (unsigned j = 0; j < 16; ++j) { const unsigned c = xb_ld(&bar[XB_XCNT(j)]); sum += c; cnt += (c > 0u) ? 1u : 0u; mine = (j == x) ? c : mine; }
        if (sum == G) break;
        __builtin_amdgcn_s_sleep(1);
        if ((++sp & 255u) == 0u) { if (xb_ld(&bar[XB_TMO])) break; if (sp > XB_SPIN_CAP) { atomicAdd(&bar[XB_TMO], 1u); break; } }
    }
    nloc = mine > 0u ? mine : 1u; nx = cnt > 0u ? cnt : 1u;
}
__device__ __forceinline__ void xcd_barrier(const XcdBarrier& b) {
    asm volatile("s_waitcnt vmcnt(0)" ::: "memory");
    __syncthreads();
    if (threadIdx.x == 0) {
        unsigned* bar = b.bar;
        __builtin_amdgcn_s_waitcnt(0);
        unsigned nloc = b.st[0], nx = b.st[1];
        if (nloc == 0u) { xcd_barrier_complete(bar, b.x, nloc, nx); b.st[0] = nloc; b.st[1] = nx; }
        const unsigned old = xb_add(&bar[XB_XSUB(b.x)], 1u);
        const unsigned gen = old / nloc;
        if (old + 1u == (gen + 1u) * nloc) {
            __builtin_amdgcn_fence(__ATOMIC_RELEASE, "agent");
            asm volatile("s_waitcnt vmcnt(0)" ::: "memory");
            const unsigned og = xb_add(&bar[XB_TOP], 1u);
            const unsigned tg = og / nx;
            if (og + 1u == (tg + 1u) * nx) xb_add(&bar[XB_TOPGEN], 1u);
            else XB_SPIN(xb_ld(&bar[XB_TOPGEN]) == tg, bar);
            __builtin_amdgcn_fence(__ATOMIC_ACQUIRE, "agent");
            xb_add(&bar[XB_XGEN(b.x)], 1u);
            asm volatile("s_waitcnt vmcnt(0)" ::: "memory");
        } else {
            XB_SPIN(xb_ld(&bar[XB_XGEN(b.x)]) == gen, bar);
            __builtin_amdgcn_fence(__ATOMIC_ACQUIRE, "agent");
            asm volatile("s_waitcnt vmcnt(0)" ::: "memory");
        }
    }
    __syncthreads();
}

struct Args {
    const float* in[30];
    float* out;
    unsigned char* ws;
    int ph_lo, ph_hi;
};

struct Frame {
    LAS unsigned char* lds;
    int tid, lane, wave, G;
    const float* const* in;
    float* out;
    unsigned char* ws;
    __device__ __forceinline__ bf16_t* PROJ() const { return (bf16_t*)(ws + WS_PROJ); }
    __device__ __forceinline__ bf16_t* HALO() const { return (bf16_t*)(ws + WS_HALO); }
    __device__ __forceinline__ float* SMALL() const { return (float*)(ws + WS_SMALL); }
    __device__ __forceinline__ bf16_t* XN() const { return (bf16_t*)(ws + WS_XN); }
    __device__ __forceinline__ bf16_t* PB() const { return (bf16_t*)(ws + WS_PB); }
    __device__ __forceinline__ float* SS1() const { return (float*)(ws + WS_SS1); }
    __device__ __forceinline__ float* SS2() const { return (float*)(ws + WS_SS2); }
    __device__ __forceinline__ float* SS3() const { return (float*)(ws + WS_SS3); }
};

constexpr int NWAVES = 8;
constexpr int RING_BYTES = 131072, LDS_BYTES = 162816, MISC_OFF = LDS_BYTES - 1024;

struct EpiInProj {
    static constexpr bool PERM = true; static constexpr int NSEG = 1; static constexpr int NPART = 1, SPLIT = 0;
    bf16_t* PROJ; bf16_t* HALO; float* SMALL; const float* cws; const float* cbs; const float* cwg; LAS float* nt_;
    __device__ __forceinline__ void operator()(const f32x4 (&acc)[2][2][4][2], const Unit& u, int wr, int wc, int fr, int fq) const {
        const int row0 = u.pm * 256 + wr * 64 + fr;
        if (u.pn >= CONV_FUSE_LO && u.pn < CONV_FUSE_HI && u.pm < MPR / 256) {
            f32x4 (&av)[2][2][4][2] = const_cast<f32x4 (&)[2][2][4][2]>(acc);
            const bool is_ssm = u.pn < 20, nrm = u.pn >= 20 && u.pn < 28;
            const int col0 = u.pn * 256 + wc * 32 + 8 * fq, cc0 = col0 - C_XS, wc0 = is_ssm ? cc0 : cc0 - 3072;
            const float* cw = is_ssm ? cws : cwg;
#pragma unroll
            for (int bj = 0; bj < 2; ++bj) {
                float w0[8], w1[8], w2[8], w3[8], bs[8];
                { const float* wp = cw + wc0 + bj * 128;
#pragma unroll
                  for (int h = 0; h < 2; ++h) { const f32x4 a0 = *(const f32x4*)(wp + 4 * h), a1 = *(const f32x4*)(wp + 3072 + 4 * h), a2 = *(const f32x4*)(wp + 2 * 3072 + 4 * h), a3 = *(const f32x4*)(wp + 3 * 3072 + 4 * h);
                      f32x4 bb = (f32x4){0.f, 0.f, 0.f, 0.f}; if (is_ssm) bb = *(const f32x4*)(cbs + wc0 + bj * 128 + 4 * h);
#pragma unroll
                      for (int i = 0; i < 4; ++i) { w0[4 * h + i] = a0[i]; w1[4 * h + i] = a1[i]; w2[4 * h + i] = a2[i]; w3[4 * h + i] = a3[i]; bs[4 * h + i] = bb[i]; } } }
#pragma unroll
                for (int ai = 0; ai < 2; ++ai)
#pragma unroll
                    for (int mm = 0; mm < 4; ++mm) {
                        const int m = 3 - mm, mp = m > 0 ? m - 1 : 0;
                        const int row = row0 + ai * 128 + m * 16;
                        if (m == 3) {
                            const f32x4 v0 = av[ai][bj][3][0], v1 = av[ai][bj][3][1];
                            u32x4 w; w.x = cvt_pk_bf16(v0[0], v0[1]); w.y = cvt_pk_bf16(v0[2], v0[3]); w.z = cvt_pk_bf16(v1[0], v1[1]); w.w = cvt_pk_bf16(v1[2], v1[3]);
                            if (fr >= 13) *(u32x4*)(HALO + ((size_t)(row >> 6) * 3 + (fr - 13)) * NCH + cc0 + bj * 128) = w;
                        }
                        float o[8], ss = 0.f;
#pragma unroll
                        for (int e = 0; e < 8; ++e) {
                            const float x = av[ai][bj][m][e >> 2][e & 3], pv = av[ai][bj][mp][e >> 2][e & 3];
                            const float t1 = dpp_prev<1>(x, pv), t2 = dpp_prev<2>(x, pv), t3 = dpp_prev<3>(x, pv);
                            float v = w3[e] * x + bs[e]; v += w2[e] * t1; v += w1[e] * t2; v += w0[e] * t3;
                            v = siluf_(v); ss += v * v;
                            o[e] = (m == 0 && fr < 3) ? x : v;
                        }
                        if (nrm) {
                            av[ai][bj][m][0] = (f32x4){o[0], o[1], o[2], o[3]}; av[ai][bj][m][1] = (f32x4){o[4], o[5], o[6], o[7]};
                            ss += __shfl_xor(ss, 16); ss += __shfl_xor(ss, 32);
                            if (fq == 0) nt_[((ai * 128 + wr * 64 + m * 16 + fr) * 2 + bj) * 4 + wc] = ss;
                        } else __builtin_nontemporal_store(pack8(o), (u32x4*)(PROJ + (size_t)row * LDP + col0 + bj * 128));
                    }
            }
            if (nrm) {
                asm volatile("s_waitcnt lgkmcnt(0)" ::: "memory"); __builtin_amdgcn_s_barrier(); asm volatile("" ::: "memory");
                const float qs = u.pn < 24 ? 0.08838834764831845f : 1.0f;
#pragma unroll
                for (int ai = 0; ai < 2; ++ai)
#pragma unroll
                    for (int m = 0; m < 4; ++m) {
                        const int rl = ai * 128 + wr * 64 + m * 16 + fr;
#pragma unroll
                        for (int bj = 0; bj < 2; ++bj) {
                            const f32x4 pq = *(LAS const f32x4*)(nt_ + (rl * 2 + bj) * 4);
                            float rn = rsqrtf((pq[0] + pq[1]) + (pq[2] + pq[3]) + EPS) * qs;
                            if (m == 0 && fr < 3) rn = 1.0f;
                            const f32x4 v0 = av[ai][bj][m][0] * rn, v1 = av[ai][bj][m][1] * rn;
                            u32x4 w; w.x = cvt_pk_bf16(v0[0], v0[1]); w.y = cvt_pk_bf16(v0[2], v0[3]); w.z = cvt_pk_bf16(v1[0], v1[1]); w.w = cvt_pk_bf16(v1[2], v1[3]);
                            __builtin_nontemporal_store(w, (u32x4*)(PROJ + (size_t)(u.pm * 256 + rl) * LDP + col0 + bj * 128));
                        }
                    }
            }
        } else if (u.pn < 44) {
            const int col0 = u.pn * 256 + wc * 32 + 8 * fq;
            const bool conv_tile = (u.pn >= 8 && u.pn < 32);
#pragma unroll
            for (int ai = 0; ai < 2; ++ai)
#pragma unroll
                for (int m = 0; m < 4; ++m) {
                    const int row = row0 + ai * 128 + m * 16;
                    bf16_t* rowp = PROJ + (size_t)row * LDP + col0;
#pragma unroll
                    for (int bj = 0; bj < 2; ++bj) {
                        const f32x4 v0 = acc[ai][bj][m][0], v1 = acc[ai][bj][m][1];
                        u32x4 w; w.x = cvt_pk_bf16(v0[0], v0[1]); w.y = cvt_pk_bf16(v0[2], v0[3]); w.z = cvt_pk_bf16(v1[0], v1[1]); w.w = cvt_pk_bf16(v1[2], v1[3]);
                        __builtin_nontemporal_store(w, (u32x4*)(rowp + bj * 128));
                        if (m == 3 && conv_tile && fr >= 13) {
                            bf16_t* hp = HALO + ((size_t)(row >> 6) * 3 + (fr - 13)) * NCH + (col0 - C_XS) + bj * 128;
                            *(u32x4*)hp = w;
                        }
                    }
                }
        } else {
            if (wc < 2) {
                const int col0 = wc * 32 + 8 * fq;
#pragma unroll
                for (int ai = 0; ai < 2; ++ai)
#pragma unroll
                    for (int m = 0; m < 4; ++m) {
                        const int row = row0 + ai * 128 + m * 16;
                        float* sp = SMALL + (size_t)row * 64 + col0;
                        *(f32x4*)sp = acc[ai][0][m][0]; *(f32x4*)(sp + 4) = acc[ai][0][m][1];
                    }
            }
        }
    }
};

struct EpiT1 {
    static constexpr bool PERM = true; static constexpr int NSEG = 4; static constexpr int NPART = 1, SPLIT = 0;
    bf16_t* PROJ; LAS const float* rl;
    __device__ __forceinline__ void khook(f32x4 (&acc)[2][2][4][2], int b, int wr, int fr, LAS const float* rt) const {
#pragma unroll
        for (int ai = 0; ai < 2; ++ai)
#pragma unroll
            for (int m = 0; m < 4; ++m) { const float rr = rt[b * 256 + ai * 128 + wr * 64 + m * 16 + fr];
#pragma unroll
                for (int bj = 0; bj < 2; ++bj) { acc[ai][bj][m][0] *= rr; acc[ai][bj][m][1] *= rr; } }
    }
    __device__ __forceinline__ void operator()(const f32x4 (&acc)[2][2][4][2], const Unit& u, int wr, int wc, int fr, int fq) const {
        const int row0 = u.pm * 256 + wr * 64 + fr, col0 = u.pn * 256 + wc * 32 + 8 * fq;
#pragma unroll
        for (int ai = 0; ai < 2; ++ai)
#pragma unroll
            for (int m = 0; m < 4; ++m) {
                const int row = row0 + ai * 128 + m * 16;
                const float rlast = rl[ai * 128 + wr * 64 + m * 16 + fr];
#pragma unroll
                for (int bj = 0; bj < 2; ++bj) {
                    const int col = col0 + bj * 128;
                    const u32x4 mgw = *(const u32x4*)(PROJ + (size_t)row * LDP + C_MG + col);
                    float mg[8]; unpack8(mgw, mg);
                    const f32x4 v0 = acc[ai][bj][m][0], v1 = acc[ai][bj][m][1];
                    float o[8];
#pragma unroll
                    for (int i = 0; i < 4; ++i) { o[i] = v0[i] * rlast * sigmoidf_(mg[i]); o[4 + i] = v1[i] * rlast * sigmoidf_(mg[4 + i]); }
                    *(u32x4*)(PROJ + (size_t)row * LDP + C_Z + col) = pack8(o);
                }
            }
    }
};

struct EpiMix {
    static constexpr bool PERM = true; static constexpr int NSEG = 8; static constexpr int NPART = 1, SPLIT = 0;
    bf16_t* PROJ; LAS const float* rl;
    __device__ __forceinline__ void khook(f32x4 (&acc)[2][2][4][2], int b, int wr, int fr, LAS const float* rt) const {
#pragma unroll
        for (int ai = 0; ai < 2; ++ai)
#pragma unroll
            for (int m = 0; m < 4; ++m) { const float rr = rt[b * 256 + ai * 128 + wr * 64 + m * 16 + fr];
#pragma unroll
                for (int bj = 0; bj < 2; ++bj) { acc[ai][bj][m][0] *= rr; acc[ai][bj][m][1] *= rr; } }
    }
    __device__ __forceinline__ void operator()(const f32x4 (&acc)[2][2][4][2], const Unit& u, int wr, int wc, int fr, int fq) const {
        const int row0 = u.pm * 256 + wr * 64 + fr, col0 = u.pn * 256 + wc * 32 + 8 * fq;
#pragma unroll
        for (int ai = 0; ai < 2; ++ai)
#pragma unroll
            for (int m = 0; m < 4; ++m) {
                const int row = row0 + ai * 128 + m * 16;
                const float rlast = rl[ai * 128 + wr * 64 + m * 16 + fr];
#pragma unroll
                for (int bj = 0; bj < 2; ++bj) {
                    const int col = col0 + bj * 128;
                    const u32x4 mgw = *(const u32x4*)(PROJ + (size_t)row * LDP + C_MG + 1024 + col);
                    float mg[8]; unpack8(mgw, mg);
                    float t1v[8]; unpack8(*(const u32x4*)(PROJ + (size_t)row * LDP + C_Z + col), t1v);
                    const f32x4 v0 = acc[ai][bj][m][0], v1 = acc[ai][bj][m][1];
                    float o[8];
#pragma unroll
                    for (int i = 0; i < 4; ++i) { o[i] = t1v[i] + v0[i] * rlast * sigmoidf_(mg[i]); o[4 + i] = t1v[4 + i] + v1[i] * rlast * sigmoidf_(mg[4 + i]); }
                    *(u32x4*)(PROJ + (size_t)row * LDP + C_Q + col) = pack8(o);
                }
            }
    }
};

struct EpiMixCat {
    static constexpr bool PERM = true; static constexpr int NSEG = 12; static constexpr int NPART = 2, SPLIT = 4;
    bf16_t* PROJ; LAS const float* rl;
    __device__ __forceinline__ void khook(f32x4 (&acc)[2][2][4][2], int seg, const Unit&, int wr, int, int fr, int, LAS const float* rt) const {
#pragma unroll
        for (int ai = 0; ai < 2; ++ai)
#pragma unroll
            for (int m = 0; m < 4; ++m) { const float rr = rt[seg * 256 + ai * 128 + wr * 64 + m * 16 + fr];
#pragma unroll
                for (int bj = 0; bj < 2; ++bj) { acc[ai][bj][m][0] *= rr; acc[ai][bj][m][1] *= rr; } }
    }
    __device__ __forceinline__ void parthook(f32x4 (&acc)[2][2][4][2], const Unit& u, int wr, int wc, int fr, int fq, LAS const float* rt) const {
        const int row0 = u.pm * 256 + wr * 64 + fr, col0 = u.pn * 256 + wc * 32 + 8 * fq;
#pragma unroll
        for (int ai = 0; ai < 2; ++ai) {
            int rowa = row0 + ai * 128; asm volatile("" : "+v"(rowa));
            u32x4 w1[4][2], w2[4][2];
#pragma unroll
            for (int m = 0; m < 4; ++m)
#pragma unroll
                for (int bj = 0; bj < 2; ++bj) {
                    const unsigned goff = (unsigned)(rowa + m * 16) * (unsigned)(LDP * 2) + (unsigned)(C_MG + col0 + bj * 128) * 2u;
                    w1[m][bj] = *(const u32x4*)((const char*)PROJ + goff); w2[m][bj] = *(const u32x4*)((const char*)PROJ + goff + 2048);
                }
            __builtin_amdgcn_sched_barrier(0);
#pragma unroll
            for (int m = 0; m < 4; ++m) {
                const float rr = rt[3 * 256 + ai * 128 + wr * 64 + m * 16 + fr];
#pragma unroll
                for (int bj = 0; bj < 2; ++bj) {
#pragma unroll
                    for (int q = 0; q < 4; ++q) {
                        const float flo = rr * (1.0f + __builtin_amdgcn_exp2f(-1.4426950408889634f * bflo(w2[m][bj][q]))) * __builtin_amdgcn_rcpf(1.0f + __builtin_amdgcn_exp2f(-1.4426950408889634f * bflo(w1[m][bj][q])));
                        const float fhi = rr * (1.0f + __builtin_amdgcn_exp2f(-1.4426950408889634f * bfhi(w2[m][bj][q]))) * __builtin_amdgcn_rcpf(1.0f + __builtin_amdgcn_exp2f(-1.4426950408889634f * bfhi(w1[m][bj][q])));
                        acc[ai][bj][m][q >> 1][2 * (q & 1)] *= flo; acc[ai][bj][m][q >> 1][2 * (q & 1) + 1] *= fhi;
                    }
                }
            }
            __builtin_amdgcn_sched_barrier(0);
        }
    }
    __device__ __forceinline__ void operator()(const f32x4 (&acc)[2][2][4][2], const Unit& u, int wr, int wc, int fr, int fq) const {
        const int row0 = u.pm * 256 + wr * 64 + fr, col0 = u.pn * 256 + wc * 32 + 8 * fq;
#pragma unroll
        for (int ai = 0; ai < 2; ++ai)
#pragma unroll
            for (int m = 0; m < 4; ++m) {
                const int row = row0 + ai * 128 + m * 16;
                const float rlast = rl[ai * 128 + wr * 64 + m * 16 + fr];
#pragma unroll
                for (int bj = 0; bj < 2; ++bj) {
                    const int col = col0 + bj * 128;
                    float mg[8]; unpack8(*(const u32x4*)(PROJ + (size_t)row * LDP + C_MG + 1024 + col), mg);
                    const f32x4 v0 = acc[ai][bj][m][0], v1 = acc[ai][bj][m][1];
                    float o[8];
#pragma unroll
                    for (int i = 0; i < 4; ++i) { o[i] = v0[i] * rlast * sigmoidf_(mg[i]); o[4 + i] = v1[i] * rlast * sigmoidf_(mg[4 + i]); }
                    *(u32x4*)(PROJ + (size_t)row * LDP + C_Q + col) = pack8(o);
                }
            }
    }
};

template <int MODE> struct EpiResid {
    static constexpr bool PERM = true; static constexpr int NSEG = 1; static constexpr int NPART = 1, SPLIT = 0;
    bf16_t* PROJ; const float* xp; const float* xs; int res_col, dstb_col; float* SS;
    __device__ __forceinline__ void operator()(const f32x4 (&acc)[2][2][4][2], const Unit& u, int wr, int wc, int fr, int fq) const {
        const int row0 = u.pm * 256 + wr * 64 + fr, col0 = u.pn * 256 + wc * 32 + 8 * fq;
#pragma unroll
        for (int ai = 0; ai < 2; ++ai)
#pragma unroll
            for (int m = 0; m < 4; ++m) {
                const int row = row0 + ai * 128 + m * 16;
                float ss = 0.f;
#pragma unroll
                for (int bj = 0; bj < 2; ++bj) {
                    const int col = col0 + bj * 128;
                    f32x4 r0 = (f32x4){0.f, 0.f, 0.f, 0.f}, r1 = r0;
                    if (MODE == 0) {
                        if (row < MTOT) { const float* rp = (row < MPR ? xp + (size_t)row * D : xs + (size_t)(row - MPR) * D) + col; r0 = *(const f32x4*)rp; r1 = *(const f32x4*)(rp + 4); }
                    } else {
                        float rv[8]; unpack8(*(const u32x4*)(PROJ + (size_t)row * LDP + res_col + col), rv);
                        r0 = (f32x4){rv[0], rv[1], rv[2], rv[3]}; r1 = (f32x4){rv[4], rv[5], rv[6], rv[7]};
                    }
                    const f32x4 x0 = r0 + acc[ai][bj][m][0], x1 = r1 + acc[ai][bj][m][1];
                    u32x4 w; w.x = cvt_pk_bf16(x0[0], x0[1]); w.y = cvt_pk_bf16(x0[2], x0[3]); w.z = cvt_pk_bf16(x1[0], x1[1]); w.w = cvt_pk_bf16(x1[2], x1[3]);
                    *(u32x4*)(PROJ + (size_t)row * LDP + dstb_col + col) = w;
                    ss += (x0[0] * x0[0] + x0[1] * x0[1]) + (x0[2] * x0[2] + x0[3] * x0[3]) + (x1[0] * x1[0] + x1[1] * x1[1]) + (x1[2] * x1[2] + x1[3] * x1[3]);
                }
                ss += __shfl_xor(ss, 16); ss += __shfl_xor(ss, 32);
                if (fq == 0) atomicAdd(SS + row, ss);
            }
    }
};

struct EpiSwiGLU {
    static constexpr bool PERM = true; static constexpr int NSEG = 1; static constexpr int NPART = 1, SPLIT = 0;
    bf16_t* PROJ; const float* SS;
    __device__ __forceinline__ void operator()(const f32x4 (&acc)[2][2][4][2], const Unit& u, int wr, int wc, int fr, int fq) const {
        const int row0 = u.pm * 256 + wr * 64 + fr, col0 = u.pn * 128 + wc * 32 + 8 * fq;
#pragma unroll
        for (int ai = 0; ai < 2; ++ai)
#pragma unroll
            for (int m = 0; m < 4; ++m) {
                const int row = row0 + ai * 128 + m * 16;
                const float r = rsqrtf(SS[row] * (1.0f / D) + EPS);
                const f32x4 g0 = acc[ai][0][m][0], g1 = acc[ai][0][m][1], u0 = acc[ai][1][m][0], u1 = acc[ai][1][m][1];
                float o[8];
#pragma unroll
                for (int i = 0; i < 4; ++i) { o[i] = siluf_(r * g0[i]) * (r * u0[i]); o[4 + i] = siluf_(r * g1[i]) * (r * u1[i]); }
                __builtin_nontemporal_store(pack8(o), (u32x4*)(PROJ + (size_t)row * LDP + C_XS + col0));
            }
    }
};

struct EpiPE {
    static constexpr bool PERM = true; static constexpr int NSEG = 1; static constexpr int NPART = 1, SPLIT = 0;
    bf16_t* PROJ;
    __device__ __forceinline__ void operator()(const f32x4 (&acc)[2][2][4][2], const Unit& u, int wr, int wc, int fr, int fq) const {
        const int row0 = u.pm * 256 + wr * 64 + fr, col0 = u.pn * 256 + wc * 32 + 8 * fq;
#pragma unroll
        for (int ai = 0; ai < 2; ++ai)
#pragma unroll
            for (int m = 0; m < 4; ++m) {
                const int row = row0 + ai * 128 + m * 16;
#pragma unroll
                for (int bj = 0; bj < 2; ++bj) {
                    const f32x4 v0 = acc[ai][bj][m][0], v1 = acc[ai][bj][m][1];
                    u32x4 w; w.x = cvt_pk_bf16(v0[0], v0[1]); w.y = cvt_pk_bf16(v0[2], v0[3]); w.z = cvt_pk_bf16(v1[0], v1[1]); w.w = cvt_pk_bf16(v1[2], v1[3]);
                    *(u32x4*)(PROJ + (size_t)row * LDP + C_Z + col0 + bj * 128) = w;
                }
            }
    }
};

struct EpiX3 {
    static constexpr bool PERM = true; static constexpr int NSEG = 1; static constexpr int NPART = 1, SPLIT = 0;
    bf16_t* PROJ; const float* SS2; float* SS3; float* out; unsigned* cnt; unsigned* bar; const float* gf; LAS float* rt;
    __device__ __forceinline__ void operator()(const f32x4 (&acc_)[2][2][4][2], const Unit& u, int wr, int wc, int fr, int fq) const {
        f32x4 (&acc)[2][2][4][2] = const_cast<f32x4 (&)[2][2][4][2]>(acc_);
        const int row0 = u.pm * 256 + wr * 64 + fr, col0 = u.pn * 256 + wc * 32 + 8 * fq;
#pragma unroll
        for (int ai = 0; ai < 2; ++ai)
#pragma unroll
            for (int m = 0; m < 4; ++m) {
                const int row = row0 + ai * 128 + m * 16;
                const float r = rsqrtf(SS2[row] * (1.0f / D) + EPS);
                float ss = 0.f;
#pragma unroll
                for (int bj = 0; bj < 2; ++bj) {
                    const int col = col0 + bj * 128;
                    float xa[8], pa[8]; unpack8(*(const u32x4*)(PROJ + (size_t)row * LDP + C_GATE + col), xa); unpack8(*(const u32x4*)(PROJ + (size_t)row * LDP + C_Z + col), pa);
                    const f32x4 a0 = (f32x4){xa[0], xa[1], xa[2], xa[3]}, a1 = (f32x4){xa[4], xa[5], xa[6], xa[7]}, p0 = (f32x4){pa[0], pa[1], pa[2], pa[3]}, p1 = (f32x4){pa[4], pa[5], pa[6], pa[7]};
                    const f32x4 v0 = acc[ai][bj][m][0], v1 = acc[ai][bj][m][1];
                    f32x4 x0, x1;
#pragma unroll
                    for (int i = 0; i < 4; ++i) { x0[i] = a0[i] + p0[i] * sigmoidf_(r * v0[i]); x1[i] = a1[i] + p1[i] * sigmoidf_(r * v1[i]); }
                    acc[ai][bj][m][0] = x0; acc[ai][bj][m][1] = x1;
                    ss += (x0[0] * x0[0] + x0[1] * x0[1]) + (x0[2] * x0[2] + x0[3] * x0[3]) + (x1[0] * x1[0] + x1[1] * x1[1]) + (x1[2] * x1[2] + x1[3] * x1[3]);
                }
                ss += __shfl_xor(ss, 16); ss += __shfl_xor(ss, 32);
                if (fq == 0) atomicAdd(SS3 + row, ss);
            }
        asm volatile("s_waitcnt vmcnt(0)" ::: "memory");
        unsigned* c = cnt + 64 * u.pm;
        if ((threadIdx.x & 63) == 0) (void)xb_add(c, 1u);
        if (threadIdx.x < 64) { unsigned sp = 0u; while ((unsigned)__builtin_amdgcn_readfirstlane(xb_ld(c)) < 32u) { __builtin_amdgcn_s_sleep(1);
            if ((++sp & 255u) == 0u) { if (xb_ld(&bar[XB_TMO])) break; if (sp > XB_SPIN_CAP) { atomicAdd(&bar[XB_TMO], 1u); break; } } } }
        asm volatile("s_waitcnt vmcnt(0) lgkmcnt(0)" ::: "memory"); __builtin_amdgcn_s_barrier(); asm volatile("" ::: "memory");
        if (threadIdx.x < 256) rt[threadIdx.x] = rsqrtf(__uint_as_float(xb_ld((unsigned*)(SS3 + u.pm * 256 + threadIdx.x))) * (1.0f / D) + EPS);
        asm volatile("s_waitcnt vmcnt(0) lgkmcnt(0)" ::: "memory"); __builtin_amdgcn_s_barrier(); asm volatile("" ::: "memory");
        f32x4 gq[2][2];
#pragma unroll
        for (int bj = 0; bj < 2; ++bj) { gq[bj][0] = *(const f32x4*)(gf + col0 + bj * 128); gq[bj][1] = *(const f32x4*)(gf + col0 + bj * 128 + 4); }
#pragma unroll
        for (int ai = 0; ai < 2; ++ai)
#pragma unroll
            for (int m = 0; m < 4; ++m) {
                const int rl = ai * 128 + wr * 64 + m * 16 + fr;
                const float r3 = rt[rl];
                float* orow = out + O_Y + (size_t)(u.pm * 256 + rl) * D + col0;
#pragma unroll
                for (int bj = 0; bj < 2; ++bj) {
                    *(f32x4*)(orow + bj * 128) = acc[ai][bj][m][0] * r3 * gq[bj][0];
                    *(f32x4*)(orow + bj * 128 + 4) = acc[ai][bj][m][1] * r3 * gq[bj][1];
                }
            }
    }
};

struct MapIdent { __device__ __forceinline__ int operator()(int n) const { return n; } };
struct MapWin {
    __device__ __forceinline__ int operator()(int n) const {
        if (n < 5120) return n;
        if (n < 9216) return n + 32;
        if (n < 11264) return n + 48;
        const int j = n - 11264;
        if (j < 32) return 5120 + j;
        if (j < 48) return 9216 + j;
        return -1;
    }
};
struct MapFfn {
    __device__ __forceinline__ int operator()(int n) const { const int j = n >> 8, r = n & 255; return r < 128 ? 128 * j + r : DFF + 128 * j + (r - 128); }
};
template <class Map>
__device__ __forceinline__ void transpose_item(const float* W, int K, int Nsrc, int Ndst, bf16_t* WT, const float* gain, LAS float* scr, int item, int lane, Map map) {
    const int nblk = Ndst / 32, kb = item / nblk, nb = item % nblk, k0 = 64 * kb, n0 = 32 * nb;
    const int sc = map(n0 + (lane & 31));
    float tv[32];
#pragma unroll
    for (int i = 0; i < 32; ++i) { const int kk = 2 * i + (lane >> 5); tv[i] = sc >= 0 ? W[(size_t)(k0 + kk) * Nsrc + sc] : 0.f; }
#pragma unroll
    for (int i = 0; i < 32; ++i) { const int kk = 2 * i + (lane >> 5); float v = tv[i]; if (gain) v *= gain[k0 + kk]; scr[kk * 33 + (lane & 31)] = v; }
    asm volatile("s_waitcnt lgkmcnt(0)" ::: "memory");
    const int c = lane & 7;
#pragma unroll
    for (int j = 0; j < 4; ++j) { const int n = (lane >> 3) + 8 * j; const LAS float* s = scr + (8 * c) * 33 + n;
        u32x4 o; o.x = cvt_pk_bf16(s[0 * 33], s[1 * 33]); o.y = cvt_pk_bf16(s[2 * 33], s[3 * 33]); o.z = cvt_pk_bf16(s[4 * 33], s[5 * 33]); o.w = cvt_pk_bf16(s[6 * 33], s[7 * 33]);
        *(u32x4*)(WT + (size_t)(n0 + n) * K + k0 + 8 * c) = o; }
    asm volatile("s_waitcnt lgkmcnt(0)" ::: "memory");
}

struct TItem { const float* W; const float* gain; bf16_t* WT; int K, Nsrc, k0, n0, sc, ldk, koff; };
__device__ __forceinline__ TItem p0_decode(const Frame& F, int it, int lane) {
    constexpr int I_WIN = 16 * (NPROJ / 32), I_WBS = 32 * 32, I_WBG = 16 * 32, I_WOUT = 16 * 32, I_WFI = 16 * (2 * DFF / 32), I_WFO = (DFF / 64) * 32, I_WPG = 16 * 32;
    unsigned char* ws = F.ws;
    TItem t; int r = it, Ndst, mapid = 0; t.ldk = 0; t.koff = 0;
    if (r < I_WIN) { t.W = F.in[9]; t.gain = nullptr; t.WT = (bf16_t*)(ws + WS_WIN); t.K = D; t.Nsrc = NIN; Ndst = NPROJ; mapid = 1; }
    else if ((r -= I_WIN) < I_WBS) { t.W = F.in[20]; t.gain = F.in[15];     t.WT = (bf16_t*)(ws + WS_WBS); t.K = 2048; t.Nsrc = D; Ndst = D; t.ldk = 3072; t.koff = 0; }
    else if ((r -= I_WBS) < I_WBG) { t.W = F.in[21]; t.gain = nullptr; t.WT = (bf16_t*)(ws + WS_WBS); t.K = D; t.Nsrc = D; Ndst = D; t.ldk = 3072; t.koff = 2048; }
    else if ((r -= I_WBG) < I_WOUT) { t.W = F.in[22]; t.gain = nullptr; t.WT = (bf16_t*)(ws + WS_WOUT); t.K = D; t.Nsrc = D; Ndst = D; }
    else if ((r -= I_WOUT) < I_WFI) { t.W = F.in[24]; t.gain = F.in[23]; t.WT = (bf16_t*)(ws + WS_WFI); t.K = D; t.Nsrc = 2 * DFF; Ndst = 2 * DFF; mapid = 2; }
    else if ((r -= I_WFI) < I_WFO) { t.W = F.in[25]; t.gain = nullptr; t.WT = (bf16_t*)(ws + WS_WFO); t.K = DFF; t.Nsrc = D; Ndst = D; }
    else if ((r -= I_WFO) < I_WPG) { t.W = F.in[27]; t.gain = F.in[26]; t.WT = (bf16_t*)(ws + WS_WPG); t.K = D; t.Nsrc = D; Ndst = D; }
    else { r -= I_WPG; t.W = F.in[28]; t.gain = nullptr; t.WT = (bf16_t*)(ws + WS_WPP); t.K = 256; t.Nsrc = D; Ndst = D; }
    if (t.ldk == 0) t.ldk = t.K;
    const int nblk = Ndst / 32; t.k0 = 64 * (r / nblk); t.n0 = 32 * (r % nblk);
    const int n = t.n0 + 4 * (lane & 7);
    t.sc = mapid == 1 ? MapWin()(n) : mapid == 2 ? MapFfn()(n) : n;
    return t;
}
__device__ __forceinline__ void p0_load(const TItem& t, int lane, f32x4 (&tv)[8]) {
#pragma unroll
    for (int i = 0; i < 8; ++i) { const int kk = 8 * i + (lane >> 3); tv[i] = t.sc >= 0 ? *(const f32x4*)(t.W + (size_t)(t.k0 + kk) * t.Nsrc + t.sc) : (f32x4){0.f, 0.f, 0.f, 0.f}; }
}
__device__ __forceinline__ void p0_finish(const TItem& t, int lane, const f32x4 (&tv)[8], LAS float* scr) {
#pragma unroll
    for (int i = 0; i < 8; ++i) { const int kk = 8 * i + (lane >> 3); f32x4 v = tv[i]; if (t.gain) v = v * t.gain[t.k0 + kk];
#pragma unroll
        for (int e = 0; e < 4; ++e) scr[kk * 33 + 4 * (lane & 7) + e] = v[e]; }
    asm volatile("s_waitcnt lgkmcnt(0)" ::: "memory");
    const int c = lane & 7;
#pragma unroll
    for (int j = 0; j < 4; ++j) { const int n = (lane >> 3) + 8 * j; const LAS float* sp = scr + (8 * c) * 33 + n;
        u32x4 o; o.x = cvt_pk_bf16(sp[0 * 33], sp[1 * 33]); o.y = cvt_pk_bf16(sp[2 * 33], sp[3 * 33]); o.z = cvt_pk_bf16(sp[4 * 33], sp[5 * 33]); o.w = cvt_pk_bf16(sp[6 * 33], sp[7 * 33]);
        *(u32x4*)(t.WT + (size_t)(t.n0 + n) * t.ldk + t.koff + t.k0 + 8 * c) = o; }
    asm volatile("s_waitcnt lgkmcnt(0)" ::: "memory");
}
__device__ __forceinline__ void p0_prologue(Frame& F, int mode, int gw, int NGW) {
    LAS float* scr = (LAS float*)(F.lds + F.wave * 16384);
    const int lane = F.lane;
    constexpr int I_WIN = 16 * (NPROJ / 32);
    constexpr int NITEMS = I_WIN + 32 * 32 + 16 * 32 + 16 * 32 + 16 * (2 * DFF / 32) + (DFF / 64) * 32 + 16 * 32 + 4 * 32;
    const int it_lo = mode == 0 ? 0 : I_WIN, it_hi = mode == 0 ? I_WIN : NITEMS;
    if (it_lo + gw < it_hi) {
        TItem cur = p0_decode(F, it_lo + gw, lane); f32x4 tv[8]; p0_load(cur, lane, tv);
        for (int it = it_lo + gw; it < it_hi; it += NGW) {
            const bool more = it + NGW < it_hi;
            TItem nxt = cur; f32x4 tn[8];
            if (more) { nxt = p0_decode(F, it + NGW, lane); p0_load(nxt, lane, tn); }
            p0_finish(cur, lane, tv, scr);
            if (more) { cur = nxt;
#pragma unroll
                for (int i = 0; i < 8; ++i) tv[i] = tn[i]; }
        }
    }
    if (mode == 0) {
        const float* gmix = F.in[8];
        for (int m0 = gw; m0 < MP; m0 += 4 * NGW) {
            f32x4 v[4][4];
#pragma unroll
            for (int q = 0; q < 4; ++q) { const int m = m0 + q * NGW;
                if (m < MTOT) {
                    const float* xrow = m < MPR ? F.in[0] + (size_t)m * D : F.in[1] + (size_t)(m - MPR) * D;
#pragma unroll
                    for (int j = 0; j < 4; ++j) v[q][j] = ((const f32x4*)xrow)[64 * j + lane];
                } else {
#pragma unroll
                    for (int j = 0; j < 4; ++j) v[q][j] = (f32x4){0.f, 0.f, 0.f, 0.f};
                } }
#pragma unroll
            for (int q = 0; q < 4; ++q) { const int m = m0 + q * NGW;
                if (m < MP) {
                    u32x2* o8 = (u32x2*)(F.XN() + (size_t)m * D) + lane;
                    float sq = 0.f;
#pragma unroll
                    for (int j = 0; j < 4; ++j) sq += (v[q][j][0] * v[q][j][0] + v[q][j][1] * v[q][j][1]) + (v[q][j][2] * v[q][j][2] + v[q][j][3] * v[q][j][3]);
                    const float rs = rsqrtf(wave_sum(sq) * (1.0f / D) + EPS);
#pragma unroll
                    for (int j = 0; j < 4; ++j) { const f32x4 gv = ((const f32x4*)gmix)[64 * j + lane]; const f32x4 y = v[q][j] * rs * gv;
                        o8[64 * j] = (u32x2){cvt_pk_bf16(y[0], y[1]), cvt_pk_bf16(y[2], y[3])}; }
                } }
        }
    } else {
        for (int m0 = gw; m0 < MP; m0 += 8 * NGW) {
            f32x4 pv[8];
#pragma unroll
            for (int q = 0; q < 8; ++q) { const int m = m0 + q * NGW;
                pv[q] = m < MTOT ? ((const f32x4*)(m < MPR ? F.in[2] + (size_t)m * 256 : F.in[3] + (size_t)(m - MPR) * 256))[lane] : (f32x4){0.f, 0.f, 0.f, 0.f}; }
#pragma unroll
            for (int q = 0; q < 8; ++q) { const int m = m0 + q * NGW;
                if (m < MP) ((u32x2*)(F.PB() + (size_t)m * 256))[lane] = (u32x2){cvt_pk_bf16(pv[q][0], pv[q][1]), cvt_pk_bf16(pv[q][2], pv[q][3])}; }
        }
    }
}

__device__ __forceinline__ void p2_conv(Frame& F) {
    const int gt = blockIdx.x * (NWAVES * 64) + F.tid, NT = F.G * NWAVES * 64;
    constexpr int NCG = NCH / 8;
    constexpr int NU_F = (MPR / 64) * NCG, NU_S = NSMP * NCG;
    for (int u = gt; u < NU_F + NU_S; u += NT) {
        const bool smp = u >= NU_F;
        const int uu = smp ? u - NU_F : u;
        const int ch = uu / NCG, cgi = uu % NCG;
        const bool is_ssm = cgi < 384;
        const int cc = is_ssm ? cgi * 8 : (cgi - 384) * 8;
        const int kind = is_ssm ? 0 : 1 + (cgi - 384) / 128;
        const float* cw = is_ssm ? F.in[10] : F.in[16];
        float w[4][8], bias[8];
#pragma unroll
        for (int j = 0; j < 4; ++j) { const f32x4 a = *(const f32x4*)(cw + j * 3072 + cc), b = *(const f32x4*)(cw + j * 3072 + cc + 4);
#pragma unroll
            for (int i = 0; i < 4; ++i) { w[j][i] = a[i]; w[j][4 + i] = b[i]; } }
        if (is_ssm) { const f32x4 a = *(const f32x4*)(F.in[11] + cc), b = *(const f32x4*)(F.in[11] + cc + 4);
#pragma unroll
            for (int i = 0; i < 4; ++i) { bias[i] = a[i]; bias[4 + i] = b[i]; } }
        else {
#pragma unroll
            for (int i = 0; i < 8; ++i) bias[i] = 0.f; }
        float h0[8], h1[8], h2[8];
        const int pcol = C_XS + cgi * 8;
        if (smp) {
            const float* st = (is_ssm ? F.in[5] : F.in[7]) + (size_t)ch * 3 * 3072 + cc;
#pragma unroll
            for (int i = 0; i < 8; ++i) { h0[i] = st[i]; h1[i] = st[3072 + i]; h2[i] = st[2 * 3072 + i]; }
            bf16_t* rp = F.PROJ() + (size_t)(MPR + ch) * LDP + pcol;
            float x[8]; unpack8(*(const u32x4*)rp, x);
            float o[8]; float ss = 0.f;
#pragma unroll
            for (int i = 0; i < 8; ++i) { float v = w[0][i] * h0[i] + w[1][i] * h1[i] + w[2][i] * h2[i] + w[3][i] * x[i] + bias[i]; v = siluf_(v); o[i] = v; ss += v * v; }
            if (kind == 1 || kind == 2) {
                ss = row16_sum(ss);
                const float rn = rsqrtf(ss + EPS) * (kind == 1 ? 0.08838834764831845f : 1.0f);
#pragma unroll
                for (int i = 0; i < 8; ++i) o[i] *= rn;
            }
            *(u32x4*)rp = pack8(o);
            float* ns = F.out + (is_ssm ? O_SCONVS : O_GCONVS) + (size_t)ch * 3 * 3072 + cc;
#pragma unroll
            for (int i = 0; i < 8; ++i) { ns[i] = h1[i]; ns[3072 + i] = h2[i]; ns[2 * 3072 + i] = x[i]; }
            continue;
        }
        const int rowbase = ch * 64, t0 = rowbase & (SEQ - 1);
        if (t0 == 0) {
#pragma unroll
            for (int i = 0; i < 8; ++i) { h0[i] = 0.f; h1[i] = 0.f; h2[i] = 0.f; }
        } else {
            const bf16_t* hp = F.HALO() + (size_t)(ch - 1) * 3 * NCH + cgi * 8;
            unpack8(*(const u32x4*)hp, h0); unpack8(*(const u32x4*)(hp + NCH), h1); unpack8(*(const u32x4*)(hp + 2 * NCH), h2);
        }
        const bool lastc = (t0 == SEQ - 64);
        float* ns = F.out + (is_ssm ? O_SCONVP : O_GCONVP) + (size_t)(rowbase >> 11) * 3 * 3072 + cc;
        bf16_t* rp = F.PROJ() + (size_t)rowbase * LDP + pcol;
        u32x4 raw[3];
#pragma unroll
        for (int r = 0; r < 3; ++r) raw[r] = *(const u32x4*)(rp + (size_t)r * LDP);
#pragma unroll
        for (int r = 0; r < 3; ++r) {
            float x[8]; unpack8(raw[r], x);
            float o[8]; float ss = 0.f;
#pragma unroll
            for (int i = 0; i < 8; ++i) { float v = w[0][i] * h0[i] + w[1][i] * h1[i] + w[2][i] * h2[i] + w[3][i] * x[i] + bias[i]; v = siluf_(v); o[i] = v; ss += v * v; }
            if (kind == 1 || kind == 2) {
                ss = row16_sum(ss);
                const float rn = rsqrtf(ss + EPS) * (kind == 1 ? 0.08838834764831845f : 1.0f);
#pragma unroll
                for (int i = 0; i < 8; ++i) o[i] *= rn;
            }
            *(u32x4*)(rp + (size_t)r * LDP) = pack8(o);
#pragma unroll
            for (int i = 0; i < 8; ++i) { h0[i] = h1[i]; h1[i] = h2[i]; h2[i] = x[i]; }
        }
        if (lastc) {
            const bf16_t* hp = F.HALO() + (size_t)ch * 3 * NCH + cgi * 8;
#pragma unroll
            for (int r = 0; r < 3; ++r) { float x[8]; unpack8(*(const u32x4*)(hp + (size_t)r * NCH), x);
#pragma unroll
                for (int i = 0; i < 8; ++i) ns[r * 3072 + i] = x[i]; }
        }
    }
}

__device__ __forceinline__ void ssd_item(Frame& F, int item) {
    const bool smp = item >= NBATCH * 32;
    const int sq = smp ? (item - NBATCH * 32) >> 5 : item >> 5, h = item & 31, g = h >> 3;
    const int row0 = smp ? MPR + sq : sq * SEQ, T = smp ? 1 : SEQ;
    const int tid = F.tid, p = tid >> 3, nq = tid & 7;
    LAS bf16_t* Bs = (LAS bf16_t*)(F.lds);
    LAS bf16_t* Cs = (LAS bf16_t*)(F.lds + 16384);
    LAS bf16_t* Xs = (LAS bf16_t*)(F.lds + 32768);
    LAS float* dts = (LAS float*)(F.lds + 40960);
    LAS float* decs = (LAS float*)(F.lds + 41216);
    LAS float* Ys = (LAS float*)(F.lds + 41472);
    float hst[16];
    if (smp) {
        const float* sp = F.in[4] + ((size_t)(sq * 32 + h) * 64 + p) * 128 + nq * 16;
#pragma unroll
        for (int i = 0; i < 4; ++i) { const f32x4 v = ((const f32x4*)sp)[i]; hst[4 * i] = v[0]; hst[4 * i + 1] = v[1]; hst[4 * i + 2] = v[2]; hst[4 * i + 3] = v[3]; }
    } else {
#pragma unroll
        for (int i = 0; i < 16; ++i) hst[i] = 0.f;
    }
    const float a_h = -__expf(F.in[13][h]), dtb = F.in[12][h], Dh = F.in[14][h];
    for (int tb = 0; tb < T; tb += 64) {
        const int rows = (T - tb) < 64 ? (T - tb) : 64;
#pragma unroll
        for (int i = 0; i < 2; ++i) {
            const int pc = tid + i * 512, r = pc >> 4, c8 = (pc & 15) * 8;
            if (r < rows) {
                const bf16_t* src = F.PROJ() + (size_t)(row0 + tb + r) * LDP;
                *(LAS u32x4*)(Bs + r * 128 + c8) = *(const u32x4*)(src + C_B + g * 128 + c8);
                *(LAS u32x4*)(Cs + r * 128 + c8) = *(const u32x4*)(src + C_C + g * 128 + c8);
            }
        }
        { const int r = tid >> 3, c8 = (tid & 7) * 8;
          if (r < rows) *(LAS u32x4*)(Xs + r * 64 + c8) = *(const u32x4*)(F.PROJ() + (size_t)(row0 + tb + r) * LDP + C_XS + h * 64 + c8); }
        if (tid < rows) { const float dt = softplusf_(F.SMALL()[(size_t)(row0 + tb + tid) * 64 + h] + dtb); dts[tid] = dt; decs[tid] = __expf(dt * a_h); }
        __syncthreads();
        for (int tt = 0; tt < rows; ++tt) {
            const float xv = bf2f(Xs[tt * 64 + p]), dtv = dts[tt], dc = decs[tt], dx = dtv * xv;
            float bv[16], cv[16];
            { float t8[8]; unpack8(*(const LAS u32x4*)(Bs + tt * 128 + nq * 16), t8);
#pragma unroll
              for (int i = 0; i < 8; ++i) bv[i] = t8[i];
              unpack8(*(const LAS u32x4*)(Bs + tt * 128 + nq * 16 + 8), t8);
#pragma unroll
              for (int i = 0; i < 8; ++i) bv[8 + i] = t8[i];
              unpack8(*(const LAS u32x4*)(Cs + tt * 128 + nq * 16), t8);
#pragma unroll
              for (int i = 0; i < 8; ++i) cv[i] = t8[i];
              unpack8(*(const LAS u32x4*)(Cs + tt * 128 + nq * 16 + 8), t8);
#pragma unroll
              for (int i = 0; i < 8; ++i) cv[8 + i] = t8[i]; }
            float yp = 0.f;
#pragma unroll
            for (int i = 0; i < 16; ++i) { hst[i] = dc * hst[i] + dx * bv[i]; yp += cv[i] * hst[i]; }
            yp += __shfl_xor(yp, 1); yp += __shfl_xor(yp, 2); yp += __shfl_xor(yp, 4);
            if (nq == 0) Ys[tt * 64 + p] = yp + Dh * xv;
        }
        __syncthreads();
        { const int r = tid >> 3, c8 = (tid & 7) * 8;
          if (r < rows) { float o[8];
#pragma unroll
              for (int i = 0; i < 8; ++i) o[i] = Ys[r * 64 + c8 + i];
              *(u32x4*)(F.PROJ() + (size_t)(row0 + tb + r) * LDP + C_XS + h * 64 + c8) = pack8(o); } }
        __syncthreads();
    }
    float* op = F.out + (smp ? O_SSMS : O_SSMP) + ((size_t)(sq * 32 + h) * 64 + p) * 128 + nq * 16;
#pragma unroll
    for (int i = 0; i < 4; ++i) ((f32x4*)op)[i] = (f32x4){hst[4 * i], hst[4 * i + 1], hst[4 * i + 2], hst[4 * i + 3]};
}

__device__ __forceinline__ void gdn_item(Frame& F, int item) {
    const bool smp = item >= NBATCH * 32;
    const int sq = smp ? (item - NBATCH * 32) >> 5 : item >> 5, h = (item >> 2) & 7, dvq = item & 3;
    const int row0 = smp ? MPR + sq : sq * SEQ, T = smp ? 1 : SEQ;
    const int tid = F.tid, e = tid >> 4, kg = tid & 15;
    LAS bf16_t* Qs = (LAS bf16_t*)(F.lds);
    LAS bf16_t* Ks = (LAS bf16_t*)(F.lds + 16384);
    LAS bf16_t* Vs = (LAS bf16_t*)(F.lds + 32768);
    LAS float* egs = (LAS float*)(F.lds + 36864);
    LAS float* bts = (LAS float*)(F.lds + 37120);
    LAS float* Os = (LAS float*)(F.lds + 37376);
    float S[8];
    const size_t sbase = ((size_t)(sq * 8 + h) * 128 + kg * 8) * 128 + dvq * 32 + e;
    if (smp) {
#pragma unroll
        for (int j = 0; j < 8; ++j) S[j] = F.in[6][sbase + (size_t)j * 128];
    } else {
#pragma unroll
        for (int j = 0; j < 8; ++j) S[j] = 0.f;
    }
    const float na = -__expf(F.in[18][h]), dtb = F.in[17][h];
    for (int tb = 0; tb < T; tb += 64) {
        const int rows = (T - tb) < 64 ? (T - tb) : 64;
#pragma unroll
        for (int i = 0; i < 2; ++i) {
            const int pc = tid + i * 512, r = pc >> 4, c8 = (pc & 15) * 8;
            if (r < rows) {
                const bf16_t* src = F.PROJ() + (size_t)(row0 + tb + r) * LDP;
                *(LAS u32x4*)(Qs + r * 128 + c8) = *(const u32x4*)(src + C_Q + h * 128 + c8);
                *(LAS u32x4*)(Ks + r * 128 + c8) = *(const u32x4*)(src + C_K + h * 128 + c8);
            }
        }
        if (tid < 256) { const int r = tid >> 2, c8 = (tid & 3) * 8;
          if (r < rows) *(LAS u32x4*)(Vs + r * 32 + c8) = *(const u32x4*)(F.PROJ() + (size_t)(row0 + tb + r) * LDP + C_V + h * 128 + dvq * 32 + c8); }
        if (tid < rows) { const float* sm = F.SMALL() + (size_t)(row0 + tb + tid) * 64;
            egs[tid] = __expf(na * softplusf_(sm[40 + h] + dtb)); bts[tid] = sigmoidf_(sm[32 + h]); }
        __syncthreads();
        for (int tt = 0; tt < rows; ++tt) {
            float k8[8], q8[8];
            unpack8(*(const LAS u32x4*)(Ks + tt * 128 + kg * 8), k8);
            unpack8(*(const LAS u32x4*)(Qs + tt * 128 + kg * 8), q8);
            const float eg = egs[tt], bt = bts[tt], v = bf2f(Vs[tt * 32 + e]);
            float ks = 0.f;
#pragma unroll
            for (int j = 0; j < 8; ++j) ks += k8[j] * S[j];
            ks += __shfl_xor(ks, 1); ks += __shfl_xor(ks, 2); ks += __shfl_xor(ks, 4); ks += __shfl_xor(ks, 8);
            const float vn = bt * (v - eg * ks);
            float op = 0.f;
#pragma unroll
            for (int j = 0; j < 8; ++j) { S[j] = eg * S[j] + k8[j] * vn; op += q8[j] * S[j]; }
            op += __shfl_xor(op, 1); op += __shfl_xor(op, 2); op += __shfl_xor(op, 4); op += __shfl_xor(op, 8);
            if (kg == 0) Os[tt * 32 + e] = op;
        }
        __syncthreads();
        if (tid < 256) { const int r = tid >> 2, c8 = (tid & 3) * 8;
          if (r < rows) { float o[8];
#pragma unroll
              for (int i = 0; i < 8; ++i) o[i] = Os[r * 32 + c8 + i];
              *(u32x4*)(F.PROJ() + (size_t)(row0 + tb + r) * LDP + C_B + h * 128 + dvq * 32 + c8) = pack8(o); } }
        __syncthreads();
    }
    float* op = F.out + (smp ? O_GDNS : O_GDNP);
#pragma unroll
    for (int j = 0; j < 8; ++j) op[sbase + (size_t)j * 128] = S[j];
}


typedef short v4i16 __attribute__((ext_vector_type(4)));
__device__ __forceinline__ bf16x8 row_frag(LAS const unsigned char* base, int pitch, int row0, int k0, int lane) {
    return *(const LAS bf16x8*)(base + (row0 + (lane & 15)) * pitch + (k0 + 8 * (lane >> 4)) * 2);
}
__device__ __forceinline__ bf16x8 tr_frag(LAS const unsigned char* base, int pitch, int k0, int col0, int lane) {
    const int g = lane >> 4, m = lane & 15, q = m >> 2, pp = m & 3;
    LAS const unsigned char* a0 = base + (k0 + 8 * g + q) * pitch + (col0 + 4 * pp) * 2;
    const v4i16 lo = __builtin_amdgcn_ds_read_tr16_b64_v4i16((LAS v4i16*)a0);
    const v4i16 hi = __builtin_amdgcn_ds_read_tr16_b64_v4i16((LAS v4i16*)(a0 + 4 * pitch));
    return (bf16x8){lo[0], lo[1], lo[2], lo[3], hi[0], hi[1], hi[2], hi[3]};
}
#define LDS_BARRIER() do { asm volatile("s_waitcnt lgkmcnt(0)" ::: "memory"); __builtin_amdgcn_s_barrier(); asm volatile("" ::: "memory"); } while (0)
#define MFMA16(a, b, c) __builtin_amdgcn_mfma_f32_16x16x32_bf16((a), (b), (c), 0, 0, 0)
__device__ __forceinline__ u32x2 pack4(float a, float b, float c, float d) { return (u32x2){cvt_pk_bf16(a, b), cvt_pk_bf16(c, d)}; }

struct SsdSmpIn { f32x4 st[4]; u32x2 b[4], c[4]; float x, dtraw; };
__device__ __forceinline__ void ssd_smp_load(const Frame& F, int it, int p, int nq, SsdSmpIn& r) {
    const int sq = it >> 5, h = it & 31, g4 = h >> 3;
    const float* sp = F.in[4] + ((size_t)(sq * 32 + h) * 64 + p) * 128 + nq * 4;
#pragma unroll
    for (int j = 0; j < 4; ++j) r.st[j] = *(const f32x4*)(sp + 32 * j);
    const bf16_t* row = F.PROJ() + (size_t)(MPR + sq) * LDP;
#pragma unroll
    for (int j = 0; j < 4; ++j) { r.b[j] = *(const u32x2*)(row + C_B + g4 * 128 + 32 * j + 4 * nq); r.c[j] = *(const u32x2*)(row + C_C + g4 * 128 + 32 * j + 4 * nq); }
    r.x = bf2f(row[C_XS + h * 64 + p]);
    r.dtraw = F.SMALL()[(size_t)(MPR + sq) * 64 + h];
}
__device__ __forceinline__ void ssd_smp_run(const Frame& F, int it, int p, int nq, const SsdSmpIn& r) {
    const int sq = it >> 5, h = it & 31;
    const float a_h = -__expf(F.in[13][h]), dt = softplusf_(r.dtraw + F.in[12][h]), dc = __expf(dt * a_h), dx = dt * r.x;
    float yp = 0.f; f32x4 o[4];
#pragma unroll
    for (int j = 0; j < 4; ++j) {
        const float bv[4] = {bflo(r.b[j].x), bfhi(r.b[j].x), bflo(r.b[j].y), bfhi(r.b[j].y)}, cv[4] = {bflo(r.c[j].x), bfhi(r.c[j].x), bflo(r.c[j].y), bfhi(r.c[j].y)};
#pragma unroll
        for (int i = 0; i < 4; ++i) { const float hv = dc * r.st[j][i] + dx * bv[i]; o[j][i] = hv; yp += cv[i] * hv; }
    }
    yp += __shfl_xor(yp, 1); yp += __shfl_xor(yp, 2); yp += __shfl_xor(yp, 4);
    float* op = F.out + O_SSMS + ((size_t)(sq * 32 + h) * 64 + p) * 128 + nq * 4;
#pragma unroll
    for (int j = 0; j < 4; ++j) *(f32x4*)(op + 32 * j) = o[j];
    if (nq == 0) { const unsigned w = cvt_pk_bf16(yp + F.in[14][h] * r.x, 0.f); F.PROJ()[(size_t)(MPR + sq) * LDP + C_XS + h * 64 + p] = (bf16_t)(w & 0xffffu); }
}
__device__ __forceinline__ void ssd_sample_stream_regs(const Frame& F, int first) {
    const int p = F.tid >> 3, nq = F.tid & 7;
    constexpr int NIT = NSMP * 32;
    SsdSmpIn r[4];
#pragma unroll
    for (int j = 0; j < 4; ++j) if (first + j * F.G < NIT) ssd_smp_load(F, first + j * F.G, p, nq, r[j]);
    for (int it0 = first; it0 < NIT; it0 += 4 * F.G) {
#pragma unroll
        for (int j = 0; j < 4; ++j) {
            const int it = it0 + j * F.G;
            if (it < NIT) { ssd_smp_run(F, it, p, nq, r[j]); if (it + 4 * F.G < NIT) ssd_smp_load(F, it + 4 * F.G, p, nq, r[j]); }
        }
    }
}
__device__ __forceinline__ void ssd_sample_stream(const Frame& F, int first) {
    constexpr int NIT = NSMP * 32, SLOT = 36864;
    static_assert(4 * SLOT + 512 <= MISC_OFF, "ssd sample ring");
    const int w = F.wave, lane = F.lane;
    LAS unsigned char* L = F.lds;
    const int n = first < NIT ? (NIT - 1 - first) / F.G + 1 : 0;
    LAS float* hp = (LAS float*)(L + 4 * SLOT);
    LDS_BARRIER();
    if (F.tid < 32) { hp[F.tid] = -__expf(F.in[13][F.tid]); hp[32 + F.tid] = F.in[12][F.tid]; hp[64 + F.tid] = F.in[14][F.tid]; }
    LDS_BARRIER();
    if (w < 4) {
#define SSL_ISSUE(k_) do { const int it_ = first + (k_) * F.G, sq_ = it_ >> 5, h_ = it_ & 31; \
            const char* sp_ = (const char*)(F.in[4] + (size_t)it_ * 8192) + (size_t)((w * 8) * 64 + lane) * 16; \
            LAS unsigned char* sl_ = L + ((k_) & 3) * SLOT + w * 8192; \
            _Pragma("unroll") for (int j_ = 0; j_ < 8; ++j_) __builtin_amdgcn_global_load_lds((const unsigned*)(sp_ + j_ * 1024), (LAS unsigned*)(sl_ + j_ * 1024), 16, 0, 0); \
            const bf16_t* row_ = F.PROJ() + (size_t)(MPR + sq_) * LDP; \
            const char* op_ = w == 0 ? (const char*)(row_ + C_B + (h_ >> 3) * 128 + (lane & 15) * 8) : w == 1 ? (const char*)(row_ + C_C + (h_ >> 3) * 128 + (lane & 15) * 8) \
                            : w == 2 ? (const char*)(row_ + C_XS + h_ * 64 + (lane & 7) * 8) : (const char*)(F.SMALL() + (size_t)(MPR + sq_) * 64 + (h_ & ~3)); \
            __builtin_amdgcn_global_load_lds((const unsigned*)op_, (LAS unsigned*)(L + ((k_) & 3) * SLOT + 32768 + w * 1024), 16, 0, 0); } while (0)
        if (n > 0) SSL_ISSUE(0);
        if (n > 1) SSL_ISSUE(1);
        if (n > 2) SSL_ISSUE(2);
        for (int k = 0; k < n; ++k) {
            const int younger = n - 1 - k;
            if (younger >= 2) asm volatile("s_waitcnt vmcnt(18)" ::: "memory"); else if (younger == 1) asm volatile("s_waitcnt vmcnt(9)" ::: "memory"); else asm volatile("s_waitcnt vmcnt(0)" ::: "memory");
            __builtin_amdgcn_s_barrier(); asm volatile("" ::: "memory");
            if (k + 3 < n) SSL_ISSUE(k + 3);
        }
#undef SSL_ISSUE
    } else {
        const int cw = w - 4, nb = lane & 31, hi = lane >> 5;
        for (int k = 0; k < n; ++k) {
            asm volatile("s_waitcnt lgkmcnt(0)" ::: "memory"); __builtin_amdgcn_s_barrier(); asm volatile("" ::: "memory");
            const int it = first + k * F.G, sq = it >> 5, h = it & 31;
            LAS const unsigned char* sl = L + (k & 3) * SLOT;
            const float a_h = hp[h], dtb = hp[32 + h], Dh = hp[64 + h];
            const float dt = softplusf_(*(LAS const float*)(sl + 32768 + 3 * 1024 + (h & 3) * 4) + dtb), dc = __expf(dt * a_h);
            const u32x2 bw = *(LAS const u32x2*)(sl + 32768 + nb * 8), cwd = *(LAS const u32x2*)(sl + 32768 + 1024 + nb * 8);
            const f32x4 bv = (f32x4){bflo(bw.x), bfhi(bw.x), bflo(bw.y), bfhi(bw.y)}, cv = (f32x4){bflo(cwd.x), bfhi(cwd.x), bflo(cwd.y), bfhi(cwd.y)};
            float* op = F.out + O_SSMS + (size_t)it * 8192;
            bf16_t* yrow = F.PROJ() + (size_t)(MPR + sq) * LDP + C_XS + h * 64;
#pragma unroll
            for (int j = 0; j < 8; ++j) {
                const int piece = (cw * 8 + j) * 64 + lane, pr = (cw * 8 + j) * 2 + hi;
                const f32x4 hv = *(LAS const f32x4*)(sl + piece * 16);
                const float xv = bf2f(*(LAS const bf16_t*)(sl + 32768 + 2048 + pr * 2));
                const f32x4 o = hv * dc + bv * (dt * xv);
                *(f32x4*)(op + piece * 4) = o;
                float yp = (cv[0] * o[0] + cv[1] * o[1]) + (cv[2] * o[2] + cv[3] * o[3]);
                yp += __shfl_xor(yp, 1); yp += __shfl_xor(yp, 2); yp += __shfl_xor(yp, 4); yp += __shfl_xor(yp, 8); yp += __shfl_xor(yp, 16);
                if (nb == 0) { const unsigned wv = cvt_pk_bf16(yp + Dh * xv, 0.f); yrow[pr] = (bf16_t)(wv & 0xffffu); }
            }
        }
    }
}
struct GdnSmpIn { float S[8]; u32x4 k8, q8; float v, araw, braw; };
__device__ __forceinline__ void gdn_smp_load(const Frame& F, int it, int e, int kg, GdnSmpIn& r) {
    const int sq = it >> 5, h = (it >> 2) & 7, dvq = it & 3;
    const float* sp = F.in[6] + ((size_t)(sq * 8 + h) * 128 + kg * 8) * 128 + dvq * 32 + e;
#pragma unroll
    for (int j = 0; j < 8; ++j) r.S[j] = sp[(size_t)j * 128];
    const bf16_t* row = F.PROJ() + (size_t)(MPR + sq) * LDP;
    r.k8 = *(const u32x4*)(row + C_K + h * 128 + kg * 8); r.q8 = *(const u32x4*)(row + C_Q + h * 128 + kg * 8);
    r.v = bf2f(row[C_V + h * 128 + dvq * 32 + e]);
    const float* sm = F.SMALL() + (size_t)(MPR + sq) * 64;
    r.araw = sm[40 + h]; r.braw = sm[32 + h];
}
__device__ __forceinline__ void gdn_smp_run(const Frame& F, int it, int e, int kg, const GdnSmpIn& r) {
    const int sq = it >> 5, h = (it >> 2) & 7, dvq = it & 3;
    const float eg = __expf(-__expf(F.in[18][h]) * softplusf_(r.araw + F.in[17][h])), bt = sigmoidf_(r.braw);
    float k8[8], q8[8]; unpack8(r.k8, k8); unpack8(r.q8, q8);
    float ks = 0.f;
#pragma unroll
    for (int j = 0; j < 8; ++j) ks += k8[j] * r.S[j];
    ks += __shfl_xor(ks, 1); ks += __shfl_xor(ks, 2); ks += __shfl_xor(ks, 4); ks += __shfl_xor(ks, 8);
    const float vn = bt * (r.v - eg * ks);
    float op = 0.f, Sn[8];
#pragma unroll
    for (int j = 0; j < 8; ++j) { Sn[j] = eg * r.S[j] + k8[j] * vn; op += q8[j] * Sn[j]; }
    op += __shfl_xor(op, 1); op += __shfl_xor(op, 2); op += __shfl_xor(op, 4); op += __shfl_xor(op, 8);
    float* dp = F.out + O_GDNS + ((size_t)(sq * 8 + h) * 128 + kg * 8) * 128 + dvq * 32 + e;
#pragma unroll
    for (int j = 0; j < 8; ++j) dp[(size_t)j * 128] = Sn[j];
    if (kg == 0) { const unsigned w = cvt_pk_bf16(op, 0.f); F.PROJ()[(size_t)(MPR + sq) * LDP + C_V + h * 128 + dvq * 32 + e] = (bf16_t)(w & 0xffffu); }
}
__device__ __forceinline__ void gdn_sample_stream(const Frame& F, int first) {
    const int e = F.tid >> 4, kg = F.tid & 15;
    constexpr int NIT = NSMP * 32;
    for (int it0 = first; it0 < NIT; it0 += 4 * F.G) {
        GdnSmpIn r[4];
#pragma unroll
        for (int j = 0; j < 4; ++j) if (it0 + j * F.G < NIT) gdn_smp_load(F, it0 + j * F.G, e, kg, r[j]);
#pragma unroll
        for (int j = 0; j < 4; ++j) if (it0 + j * F.G < NIT) gdn_smp_run(F, it0 + j * F.G, e, kg, r[j]);
    }
}


__device__ __forceinline__ void ssd_chunked(Frame& F, int item, int& sit) {
    (void)sit;
    const int b = item >> 5, h = item & 31, g4 = h >> 3;
    const int tid = F.tid, lane = F.lane, w = F.wave, i16 = lane & 15, g = lane >> 4;
    LAS unsigned char* L = F.lds;
    constexpr int PB = 272, PX = 144, PY = 260;
    constexpr int SET = 45120, O_BT = 0, O_CT = 17408, O_XT = 34816, O_SC = 44032;
    constexpr int O_XD = 2 * SET, O_MT = O_XD + 9216, O_SL = O_MT + 9216, O_YT = O_SL + 17408;
    static_assert(O_YT + 64 * PY <= MISC_OFF, "ssd LDS map");
    LAS float* acumA = (LAS float*)(L + O_SC); LAS float* dtlA = acumA + 64; LAS float* sclA = acumA + 128; LAS float* eacA = acumA + 192; LAS float* cdecpA = acumA + 256;
    LAS float* acumB = (LAS float*)(L + SET + O_SC); LAS float* dtlB = acumB + 64; LAS float* sclB = acumB + 128; LAS float* eacB = acumB + 192; LAS float* cdecpB = acumB + 256;
    __syncthreads();
    for (int u = tid; u < 17408 / 16; u += 512) *(LAS u32x4*)(L + O_SL + u * 16) = (u32x4){0u, 0u, 0u, 0u};
    f32x4 sacc[4];
#pragma unroll
    for (int pb = 0; pb < 4; ++pb) sacc[pb] = (f32x4){0.f, 0.f, 0.f, 0.f};
    const float a_h = -__expf(F.in[13][h]), dtb = F.in[12][h], Dh = F.in[14][h];
    const int row00 = b * SEQ;
    u32x4 rbA[2], rcA[2], rxA, rzA, rbB[2], rcB[2], rxB, rzB, zsA, zsB; float rdtA = 0.f, rdtB = 0.f;
    zsA = (u32x4){0u, 0u, 0u, 0u}; zsB = zsA;
    float* SSY = (float*)(F.ws + WS_SSY);
    const int br0 = tid >> 4, bc8 = (tid & 15) * 8;
    const int xr = tid >> 3, xc8 = (tid & 7) * 8;
#define SSD_LOADA(c) do { const bf16_t* src = F.PROJ() + (size_t)(row00 + (c) * 64) * LDP; \
        rbA[0] = *(const u32x4*)(src + (size_t)br0 * LDP + C_B + g4 * 128 + bc8); rbA[1] = *(const u32x4*)(src + (size_t)(br0 + 32) * LDP + C_B + g4 * 128 + bc8); \
        rcA[0] = *(const u32x4*)(src + (size_t)br0 * LDP + C_C + g4 * 128 + bc8); rcA[1] = *(const u32x4*)(src + (size_t)(br0 + 32) * LDP + C_C + g4 * 128 + bc8); \
        rxA = *(const u32x4*)(src + (size_t)xr * LDP + C_XS + h * 64 + xc8); \
        rzA = *(const u32x4*)(src + (size_t)xr * LDP + C_Z + h * 64 + xc8); \
        if (tid < 64) rdtA = F.SMALL()[(size_t)(row00 + (c) * 64 + tid) * 64 + h]; } while (0)
#define SSD_LOADB(c) do { const bf16_t* src = F.PROJ() + (size_t)(row00 + (c) * 64) * LDP; \
        rbB[0] = *(const u32x4*)(src + (size_t)br0 * LDP + C_B + g4 * 128 + bc8); rbB[1] = *(const u32x4*)(src + (size_t)(br0 + 32) * LDP + C_B + g4 * 128 + bc8); \
        rcB[0] = *(const u32x4*)(src + (size_t)br0 * LDP + C_C + g4 * 128 + bc8); rcB[1] = *(const u32x4*)(src + (size_t)(br0 + 32) * LDP + C_C + g4 * 128 + bc8); \
        rxB = *(const u32x4*)(src + (size_t)xr * LDP + C_XS + h * 64 + xc8); \
        rzB = *(const u32x4*)(src + (size_t)xr * LDP + C_Z + h * 64 + xc8); \
        if (tid < 64) rdtB = F.SMALL()[(size_t)(row00 + (c) * 64 + tid) * 64 + h]; } while (0)
#define SSD_STAGE(Q, QS) do { \
        *(LAS u32x4*)(L + QS * SET + O_BT + br0 * PB + bc8 * 2) = rb##Q[0]; *(LAS u32x4*)(L + QS * SET + O_BT + (br0 + 32) * PB + bc8 * 2) = rb##Q[1]; \
        *(LAS u32x4*)(L + QS * SET + O_CT + br0 * PB + bc8 * 2) = rc##Q[0]; *(LAS u32x4*)(L + QS * SET + O_CT + (br0 + 32) * PB + bc8 * 2) = rc##Q[1]; \
        *(LAS u32x4*)(L + QS * SET + O_XT + xr * PX + xc8 * 2) = rx##Q; zs##Q = rz##Q; \
        if (tid < 64) { \
            const float dt_ = softplusf_(rdt##Q + dtb); float v_ = dt_ * a_h; \
            _Pragma("unroll") for (int o_ = 1; o_ < 64; o_ <<= 1) { const float t_ = __shfl_up(v_, o_); if (lane >= o_) v_ += t_; } \
            const float last_ = __shfl(v_, 63); \
            acum##Q[lane] = v_; dtl##Q[lane] = dt_; scl##Q[lane] = dt_ * __expf(last_ - v_); eac##Q[lane] = __expf(v_); \
            if (lane == 63) cdecp##Q[0] = __expf(v_); } } while (0)
    SSD_LOADA(0); SSD_LOADB(1);
    SSD_STAGE(A, 0);
    SSD_LOADA(2);
    for (int c2 = 0; c2 < SEQ / 128; ++c2) {
        { const int c = 2 * c2;
        LDS_BARRIER();
        if (c > 0) {
            float o[8], z8[8]; unpack8(zsB, z8); float ss = 0.f;
#pragma unroll
            for (int i = 0; i < 8; ++i) { o[i] = *(LAS const float*)(L + O_YT + xr * PY + (xc8 + i) * 4) * siluf_(z8[i]); ss += o[i] * o[i]; }
            *(u32x4*)(F.PROJ() + (size_t)(row00 + (c - 1) * 64 + xr) * LDP + C_XS + h * 64 + xc8) = pack8(o);
            ss += __shfl_xor(ss, 1); ss += __shfl_xor(ss, 2); ss += __shfl_xor(ss, 4);
            if ((tid & 7) == 0) atomicAdd(SSY + (size_t)(row00 + (c - 1) * 64 + xr) * 4 + g4, ss);
        }
        if (c + 1 < SEQ / 64) {
            SSD_STAGE(B, 1);
            if (c + 3 < SEQ / 64) SSD_LOADB(c + 3);
        }
        { float x8[8]; unpack8(*(LAS const u32x4*)(L + 0 * SET + O_XT + xr * PX + xc8 * 2), x8); const float sc = sclA[xr];
#pragma unroll
          for (int i = 0; i < 8; ++i) x8[i] *= sc;
          *(LAS u32x4*)(L + O_XD + xr * PX + xc8 * 2) = pack8(x8); }
#pragma unroll
        for (int tt = 0; tt < 2; ++tt) {
            const int t = 2 * w + tt, lb = t >> 2, sb = t & 3;
            const int l = 16 * lb + i16;
            u32x2 mw = (u32x2){0u, 0u};
            if (sb <= lb) {
                f32x4 acc = (f32x4){0.f, 0.f, 0.f, 0.f};
#pragma unroll
                for (int ks = 0; ks < 4; ++ks) acc = MFMA16(row_frag(L + 0 * SET + O_BT, PB, 16 * sb, 32 * ks, lane), row_frag(L + 0 * SET + O_CT, PB, 16 * lb, 32 * ks, lane), acc);
                const float al = acumA[l];
                float mv[4];
#pragma unroll
                for (int r = 0; r < 4; ++r) { const int s = 16 * sb + 4 * g + r; const float e = __expf(al - acumA[s]) * dtlA[s] * acc[r]; mv[r] = (s <= l) ? e : 0.f; }
                mw = pack4(mv[0], mv[1], mv[2], mv[3]);
            }
            *(LAS u32x2*)(L + O_MT + l * PX + (16 * sb + 4 * g) * 2) = mw;
        }
        f32x4 yacc[2];
        const int lb = w >> 1;
#pragma unroll
        for (int tt = 0; tt < 2; ++tt) {
            const int pb = 2 * (w & 1) + tt;
            f32x4 acc = (f32x4){0.f, 0.f, 0.f, 0.f};
#pragma unroll
            for (int ks = 0; ks < 4; ++ks) acc = MFMA16(row_frag(L + 0 * SET + O_CT, PB, 16 * lb, 32 * ks, lane), row_frag(L + O_SL, PB, 16 * pb, 32 * ks, lane), acc);
#pragma unroll
            for (int r = 0; r < 4; ++r) acc[r] *= eacA[16 * lb + 4 * g + r];
            yacc[tt] = acc;
        }
        LDS_BARRIER();
#pragma unroll
        for (int tt = 0; tt < 2; ++tt) {
            const int pb = 2 * (w & 1) + tt;
            f32x4 acc = yacc[tt];
            acc = MFMA16(row_frag(L + O_MT, PX, 16 * lb, 0, lane), tr_frag(L + 0 * SET + O_XT, PX, 0, 16 * pb, lane), acc);
            if (lb >= 2) acc = MFMA16(row_frag(L + O_MT, PX, 16 * lb, 32, lane), tr_frag(L + 0 * SET + O_XT, PX, 32, 16 * pb, lane), acc);
#pragma unroll
            for (int r = 0; r < 4; ++r) { const int l = 16 * lb + 4 * g + r, p = 16 * pb + i16;
                const float xv = bf2f(*(LAS const bf16_t*)(L + 0 * SET + O_XT + l * PX + p * 2));
                *(LAS float*)(L + O_YT + l * PY + p * 4) = acc[r] + Dh * xv; }
        }
        { const float cdec = cdecpA[0];
#pragma unroll
          for (int pb = 0; pb < 4; ++pb) sacc[pb] *= cdec;
#pragma unroll
          for (int ks = 0; ks < 2; ++ks) {
              const bf16x8 a = tr_frag(L + 0 * SET + O_BT, PB, 32 * ks, 16 * w, lane);
#pragma unroll
              for (int pb = 0; pb < 4; ++pb) sacc[pb] = MFMA16(a, tr_frag(L + O_XD, PX, 32 * ks, 16 * pb, lane), sacc[pb]);
          }
#pragma unroll
          for (int pb = 0; pb < 4; ++pb) *(LAS u32x2*)(L + O_SL + (16 * pb + i16) * PB + (16 * w + 4 * g) * 2) = pack4(sacc[pb][0], sacc[pb][1], sacc[pb][2], sacc[pb][3]);
        }
        }
        { const int c = 2 * c2 + 1;
        LDS_BARRIER();
        if (c > 0) {
            float o[8], z8[8]; unpack8(zsA, z8); float ss = 0.f;
#pragma unroll
            for (int i = 0; i < 8; ++i) { o[i] = *(LAS const float*)(L + O_YT + xr * PY + (xc8 + i) * 4) * siluf_(z8[i]); ss += o[i] * o[i]; }
            *(u32x4*)(F.PROJ() + (size_t)(row00 + (c - 1) * 64 + xr) * LDP + C_XS + h * 64 + xc8) = pack8(o);
            ss += __shfl_xor(ss, 1); ss += __shfl_xor(ss, 2); ss += __shfl_xor(ss, 4);
            if ((tid & 7) == 0) atomicAdd(SSY + (size_t)(row00 + (c - 1) * 64 + xr) * 4 + g4, ss);
        }
        if (c + 1 < SEQ / 64) {
            SSD_STAGE(A, 0);
            if (c + 3 < SEQ / 64) SSD_LOADA(c + 3);
        }
        { float x8[8]; unpack8(*(LAS const u32x4*)(L + 1 * SET + O_XT + xr * PX + xc8 * 2), x8); const float sc = sclB[xr];
#pragma unroll
          for (int i = 0; i < 8; ++i) x8[i] *= sc;
          *(LAS u32x4*)(L + O_XD + xr * PX + xc8 * 2) = pack8(x8); }
#pragma unroll
        for (int tt = 0; tt < 2; ++tt) {
            const int t = 2 * w + tt, lb = t >> 2, sb = t & 3;
            const int l = 16 * lb + i16;
            u32x2 mw = (u32x2){0u, 0u};
            if (sb <= lb) {
                f32x4 acc = (f32x4){0.f, 0.f, 0.f, 0.f};
#pragma unroll
                for (int ks = 0; ks < 4; ++ks) acc = MFMA16(row_frag(L + 1 * SET + O_BT, PB, 16 * sb, 32 * ks, lane), row_frag(L + 1 * SET + O_CT, PB, 16 * lb, 32 * ks, lane), acc);
                const float al = acumB[l];
                float mv[4];
#pragma unroll
                for (int r = 0; r < 4; ++r) { const int s = 16 * sb + 4 * g + r; const float e = __expf(al - acumB[s]) * dtlB[s] * acc[r]; mv[r] = (s <= l) ? e : 0.f; }
                mw = pack4(mv[0], mv[1], mv[2], mv[3]);
            }
            *(LAS u32x2*)(L + O_MT + l * PX + (16 * sb + 4 * g) * 2) = mw;
        }
        f32x4 yacc[2];
        const int lb = w >> 1;
#pragma unroll
        for (int tt = 0; tt < 2; ++tt) {
            const int pb = 2 * (w & 1) + tt;
            f32x4 acc = (f32x4){0.f, 0.f, 0.f, 0.f};
#pragma unroll
            for (int ks = 0; ks < 4; ++ks) acc = MFMA16(row_frag(L + 1 * SET + O_CT, PB, 16 * lb, 32 * ks, lane), row_frag(L + O_SL, PB, 16 * pb, 32 * ks, lane), acc);
#pragma unroll
            for (int r = 0; r < 4; ++r) acc[r] *= eacB[16 * lb + 4 * g + r];
            yacc[tt] = acc;
        }
        LDS_BARRIER();
#pragma unroll
        for (int tt = 0; tt < 2; ++tt) {
            const int pb = 2 * (w & 1) + tt;
            f32x4 acc = yacc[tt];
            acc = MFMA16(row_frag(L + O_MT, PX, 16 * lb, 0, lane), tr_frag(L + 1 * SET + O_XT, PX, 0, 16 * pb, lane), acc);
            if (lb >= 2) acc = MFMA16(row_frag(L + O_MT, PX, 16 * lb, 32, lane), tr_frag(L + 1 * SET + O_XT, PX, 32, 16 * pb, lane), acc);
#pragma unroll
            for (int r = 0; r < 4; ++r) { const int l = 16 * lb + 4 * g + r, p = 16 * pb + i16;
                const float xv = bf2f(*(LAS const bf16_t*)(L + 1 * SET + O_XT + l * PX + p * 2));
                *(LAS float*)(L + O_YT + l * PY + p * 4) = acc[r] + Dh * xv; }
        }
        { const float cdec = cdecpB[0];
#pragma unroll
          for (int pb = 0; pb < 4; ++pb) sacc[pb] *= cdec;
#pragma unroll
          for (int ks = 0; ks < 2; ++ks) {
              const bf16x8 a = tr_frag(L + 1 * SET + O_BT, PB, 32 * ks, 16 * w, lane);
#pragma unroll
              for (int pb = 0; pb < 4; ++pb) sacc[pb] = MFMA16(a, tr_frag(L + O_XD, PX, 32 * ks, 16 * pb, lane), sacc[pb]);
          }
#pragma unroll
          for (int pb = 0; pb < 4; ++pb) *(LAS u32x2*)(L + O_SL + (16 * pb + i16) * PB + (16 * w + 4 * g) * 2) = pack4(sacc[pb][0], sacc[pb][1], sacc[pb][2], sacc[pb][3]);
        }
        }
    }
    LDS_BARRIER();
    {
        float o[8], z8[8]; unpack8(zsB, z8); float ss = 0.f;
#pragma unroll
        for (int i = 0; i < 8; ++i) { o[i] = *(LAS const float*)(L + O_YT + xr * PY + (xc8 + i) * 4) * siluf_(z8[i]); ss += o[i] * o[i]; }
        *(u32x4*)(F.PROJ() + (size_t)(row00 + (SEQ / 64 - 1) * 64 + xr) * LDP + C_XS + h * 64 + xc8) = pack8(o);
        ss += __shfl_xor(ss, 1); ss += __shfl_xor(ss, 2); ss += __shfl_xor(ss, 4);
        if ((tid & 7) == 0) atomicAdd(SSY + (size_t)(row00 + (SEQ / 64 - 1) * 64 + xr) * 4 + g4, ss);
    }
#undef SSD_LOADA
#undef SSD_LOADB
#undef SSD_STAGE
#pragma unroll
    for (int pb = 0; pb < 4; ++pb) *(f32x4*)(F.out + O_SSMP + ((size_t)(b * 32 + h) * 64 + 16 * pb + i16) * 128 + 16 * w + 4 * g) = sacc[pb];
}


__device__ __forceinline__ void gdn_prep(Frame& F, int it, int hb) {
    const int c = it & 31, bh = it >> 5, h = bh & 7, b = bh >> 3;
    const int ht = F.tid & 255, lane = F.lane, hw = F.wave & 3, i16 = lane & 15, g = lane >> 4;
    LAS unsigned char* L = F.lds + hb * 65536;
    constexpr int PB = 272;
    constexpr int O_KT = 0, O_QT = 17408, O_VT = 34816, O_SC = 52224;
    LAS float* gc = (LAS float*)(L + O_SC); LAS float* bt = gc + 64; LAS float* egc = gc + 128;
    const int row0 = b * SEQ + c * 64;
    __syncthreads();
    {
        u32x4 rk[4], rq[4], rv[4];
#pragma unroll
        for (int j = 0; j < 4; ++j) { const int pc = ht + j * 256, r = pc >> 4, c8 = (pc & 15) * 8; const bf16_t* src = F.PROJ() + (size_t)(row0 + r) * LDP + h * 128 + c8;
            rk[j] = *(const u32x4*)(src + C_K); rq[j] = *(const u32x4*)(src + C_Q); rv[j] = *(const u32x4*)(src + C_V); }
        if (ht < 64) {
            const float* sm = F.SMALL() + (size_t)(row0 + lane) * 64;
            const float na = -__expf(F.in[18][h]), dtb = F.in[17][h];
            float v = na * softplusf_(sm[40 + h] + dtb);
            const float be = sigmoidf_(sm[32 + h]);
#pragma unroll
            for (int o = 1; o < 64; o <<= 1) { const float t = __shfl_up(v, o); if (lane >= o) v += t; }
            gc[lane] = v; bt[lane] = be; egc[lane] = __expf(v);
            ((float*)(F.ws + WS_GC))[(size_t)it * 64 + lane] = v;
        }
#pragma unroll
        for (int j = 0; j < 4; ++j) { const int pc = ht + j * 256, r = pc >> 4, c8 = (pc & 15) * 8;
            *(LAS u32x4*)(L + O_KT + r * PB + c8 * 2) = rk[j]; *(LAS u32x4*)(L + O_QT + r * PB + c8 * 2) = rq[j]; *(LAS u32x4*)(L + O_VT + r * PB + c8 * 2) = rv[j]; }
    }
    __syncthreads();
    f32x4 kk[4];
    const int lb = hw;
    bf16_t* qkm = (bf16_t*)(F.ws + WS_QKM) + (size_t)it * 4096;
#pragma unroll
    for (int sb = 0; sb < 4; ++sb) {
        kk[sb] = (f32x4){0.f, 0.f, 0.f, 0.f};
        const int l = 16 * lb + i16;
        u32x2 qw = (u32x2){0u, 0u};
        if (sb <= lb) {
            f32x4 qa = (f32x4){0.f, 0.f, 0.f, 0.f};
#pragma unroll
            for (int ks = 0; ks < 4; ++ks) {
                const bf16x8 ks_ = row_frag(L + O_KT, PB, 16 * sb, 32 * ks, lane);
                kk[sb] = MFMA16(row_frag(L + O_KT, PB, 16 * lb, 32 * ks, lane), ks_, kk[sb]);
                qa = MFMA16(ks_, row_frag(L + O_QT, PB, 16 * lb, 32 * ks, lane), qa);
            }
            const float gl = gc[l];
            float qv[4];
#pragma unroll
            for (int r = 0; r < 4; ++r) { const int s_ = 16 * sb + 4 * g + r; const float e = __expf(gl - gc[s_]) * qa[r]; qv[r] = (s_ <= l) ? e : 0.f; }
            qw = pack4(qv[0], qv[1], qv[2], qv[3]);
        }
        *(u32x2*)(qkm + l * 64 + 16 * sb + 4 * g) = qw;
    }
    __syncthreads();
#pragma unroll
    for (int sb = 0; sb < 4; ++sb) {
        if (sb <= lb) {
#pragma unroll
            for (int r = 0; r < 4; ++r) { const int l = 16 * lb + 4 * g + r, s_ = 16 * sb + i16;
                const float a = (s_ < l) ? bt[l] * kk[sb][r] * __expf(gc[l] - gc[s_]) : 0.f;
                *(LAS float*)(L + O_QT + l * PB + s_ * 4) = a; }
        }
    }
    __syncthreads();
    float x[64];
    {
        const bool isv = ht < 128;
        LAS const unsigned char* colp = L + (isv ? O_VT : O_KT) + (ht & 127) * 2;
#pragma unroll
        for (int l = 0; l < 64; ++l) { const float v = bf2f(*(LAS const bf16_t*)(colp + l * PB)); x[l] = v * bt[l] * (isv ? 1.0f : egc[l]); }
    }
#pragma unroll
    for (int l = 1; l < 64; ++l) {
        float acc0 = x[l], acc1 = 0.f;
#pragma unroll
        for (int s4 = 0; s4 < (l + 3) / 4; ++s4) {
            const f32x4 a = *(LAS const f32x4*)(L + O_QT + l * PB + s4 * 16);
#pragma unroll
            for (int j = 0; j < 4; ++j) if (4 * s4 + j < l) { if (j & 1) asm("v_fma_f32 %0, -%1, %2, %0" : "+v"(acc1) : "v"(a[j]), "v"(x[4 * s4 + j])); else asm("v_fma_f32 %0, -%1, %2, %0" : "+v"(acc0) : "v"(a[j]), "v"(x[4 * s4 + j])); }
        }
        x[l] = acc0 + acc1;
        asm volatile("" ::: "memory");
    }
    {
        const bool isv = ht < 128;
        bf16_t* dst = (bf16_t*)(F.ws + (isv ? WS_UT : WS_WT)) + (size_t)it * 8192 + (ht & 127) * 64;
        const float sg = isv ? 1.0f : -1.0f;
#pragma unroll
        for (int q8 = 0; q8 < 8; ++q8) { float o[8];
#pragma unroll
            for (int i = 0; i < 8; ++i) o[i] = sg * x[8 * q8 + i];
            *(u32x4*)(dst + 8 * q8) = pack8(o); }
    }
}

__device__ __forceinline__ bf16x8 frag2(u32x2 lo, u32x2 hi) { return __builtin_bit_cast(bf16x8, (u32x4){lo.x, lo.y, hi.x, hi.y}); }
struct PrepIn { u32x4 rk[4], rq[4], rv[4]; float araw, braw; };
__device__ __forceinline__ void prep_load(const Frame& F, int it, PrepIn& r) {
    const int c = it & 31, bh = it >> 5, h = bh & 7, b = bh >> 3, ht = F.tid & 255, row0 = b * SEQ + c * 64;
#pragma unroll
    for (int j = 0; j < 4; ++j) { const int pc = ht + j * 256, rr = pc >> 4, c8 = (pc & 15) * 8; const bf16_t* src = F.PROJ() + (size_t)(row0 + rr) * LDP + h * 128 + c8;
        r.rk[j] = *(const u32x4*)(src + C_K); r.rq[j] = *(const u32x4*)(src + C_Q); r.rv[j] = *(const u32x4*)(src + C_V); }
    r.araw = 0.f; r.braw = 0.f;
    if (ht < 64) { const float* sm = F.SMALL() + (size_t)(row0 + F.lane) * 64; r.araw = sm[40 + h]; r.braw = sm[32 + h]; }
}
__device__ __forceinline__ void gdn_prep3(Frame& F, int it, int hb, PrepIn& cur, int it_next, bool more) {
    const int c = it & 31, bh = it >> 5, h = bh & 7, b = bh >> 3;
    const int ht = F.tid & 255, lane = F.lane, hw = F.wave & 3, i16 = lane & 15, g = lane >> 4;
    LAS unsigned char* L = F.lds + hb * 65536;
    constexpr int PB = 272, PAL = 136, PAD = 80, PLI = 40;
    constexpr int O_KT = 0, O_QT = 17408, O_VT = 34816, O_SC = 52224, O_LI = 53248;
    constexpr int O_AL = O_QT, O_AD = O_QT + 8704;
    LAS float* gc = (LAS float*)(L + O_SC); LAS float* bt = gc + 64; LAS float* egc = gc + 128;
    (void)b; (void)c;
    LDS_BARRIER();
    PrepIn nxt;
    {
        if (ht < 64) {
            const float na = -__expf(F.in[18][h]), dtb = F.in[17][h];
            float v = na * softplusf_(cur.araw + dtb);
            const float be = sigmoidf_(cur.braw);
#pragma unroll
            for (int o = 1; o < 64; o <<= 1) { const float t = __shfl_up(v, o); if (lane >= o) v += t; }
            gc[lane] = v; bt[lane] = be; egc[lane] = __expf(v);
            ((float*)(F.ws + WS_GC))[(size_t)it * 64 + lane] = v;
        }
#pragma unroll
        for (int j = 0; j < 4; ++j) { const int pc = ht + j * 256, r = pc >> 4, c8 = (pc & 15) * 8;
            *(LAS u32x4*)(L + O_KT + r * PB + c8 * 2) = cur.rk[j]; *(LAS u32x4*)(L + O_QT + r * PB + c8 * 2) = cur.rq[j]; *(LAS u32x4*)(L + O_VT + r * PB + c8 * 2) = cur.rv[j]; }
    }
    LDS_BARRIER();
    const int lb = hw, lq = 16 * lb + i16;
    bf16_t* qkm = (bf16_t*)(F.ws + WS_QKM) + (size_t)it * 4096;
    f32x4 kkt[4];
#pragma unroll
    for (int sb = 0; sb < 4; ++sb) {
        kkt[sb] = (f32x4){0.f, 0.f, 0.f, 0.f};
        u32x2 qw = (u32x2){0u, 0u};
        if (sb <= lb) {
            f32x4 qa = (f32x4){0.f, 0.f, 0.f, 0.f};
#pragma unroll
            for (int ks = 0; ks < 4; ++ks) {
                const bf16x8 ks_ = row_frag(L + O_KT, PB, 16 * sb, 32 * ks, lane);
                kkt[sb] = MFMA16(ks_, row_frag(L + O_KT, PB, 16 * lb, 32 * ks, lane), kkt[sb]);
                qa = MFMA16(ks_, row_frag(L + O_QT, PB, 16 * lb, 32 * ks, lane), qa);
            }
            const float gl = gc[lq];
            float qv[4];
#pragma unroll
            for (int r = 0; r < 4; ++r) { const int s_ = 16 * sb + 4 * g + r; const float e = __expf(gl - gc[s_]) * qa[r]; qv[r] = (s_ <= lq) ? e : 0.f; }
            qw = pack4(qv[0], qv[1], qv[2], qv[3]);
        }
        *(u32x2*)(qkm + lq * 64 + 16 * sb + 4 * g) = qw;
    }
    LDS_BARRIER();
    {
        const float gl = gc[lq], bl = bt[lq];
#pragma unroll
        for (int sb = 0; sb < 4; ++sb) {
            if (sb <= lb) {
                float a[4];
#pragma unroll
                for (int r = 0; r < 4; ++r) { const int s_ = 16 * sb + 4 * g + r; const float e = bl * kkt[sb][r] * __expf(gl - gc[s_]); a[r] = (s_ < lq) ? e : 0.f; }
                if (sb < lb) *(LAS u32x2*)(L + O_AL + lq * PAL + (16 * sb + 4 * g) * 2) = pack4(-a[0], -a[1], -a[2], -a[3]);
                else         *(LAS f32x4*)(L + O_AD + lb * (16 * PAD) + i16 * PAD + g * 16) = (f32x4){a[0], a[1], a[2], a[3]};
            }
        }
    }
    f32x4 R[4][4];
    {
        const bool isv = hw < 2;
        LAS const unsigned char* colp = L + (isv ? O_VT : O_KT) + ((64 * hw + i16) & 127) * 2;
#pragma unroll
        for (int i = 0; i < 4; ++i)
#pragma unroll
            for (int r = 0; r < 4; ++r) { const int l = 16 * i + 4 * g + r; const float sc = bt[l] * (isv ? 1.0f : egc[l]);
#pragma unroll
                for (int ct = 0; ct < 4; ++ct) R[ct][i][r] = bf2f(*(LAS const bf16_t*)(colp + l * PB + ct * 32)) * sc; }
    }
    LDS_BARRIER();
    if (lane < 16) {
        float x[16];
        LAS const unsigned char* ad = L + O_AD + hw * (16 * PAD);
#pragma unroll
        for (int l = 0; l < 16; ++l) {
            float acc = (l == lane) ? 1.0f : 0.f;
#pragma unroll
            for (int s4 = 0; s4 < (l + 3) / 4; ++s4) { const f32x4 a = *(LAS const f32x4*)(ad + l * PAD + s4 * 16);
#pragma unroll
                for (int j = 0; j < 4; ++j) if (4 * s4 + j < l) acc -= a[j] * x[4 * s4 + j]; }
            x[l] = acc;
            { const unsigned w = cvt_pk_bf16(acc, 0.f); *(LAS bf16_t*)(L + O_LI + hw * (16 * PLI) + l * PLI + lane * 2) = (bf16_t)(w & 0xffffu); }
        }
    }
    LDS_BARRIER();
    {
        const bool isv = hw < 2;
        bf16_t* dst = (bf16_t*)(F.ws + (isv ? WS_UT : WS_WT)) + (size_t)it * 8192;
        const unsigned sgn = isv ? 0u : 0x80008000u;
        const u32x2 z2 = (u32x2){0u, 0u};
        u32x2 li[4];
#pragma unroll
        for (int i = 0; i < 4; ++i) li[i] = *(LAS const u32x2*)(L + O_LI + i * (16 * PLI) + i16 * PLI + 4 * g * 2);
#pragma unroll
        for (int ct = 0; ct < 4; ++ct) {
            u32x2 xb[4];
#pragma unroll
            for (int i = 0; i < 4; ++i) {
                f32x4 y = R[ct][i];
                if (i >= 1) {
                    const u32x2 a0 = *(LAS const u32x2*)(L + O_AL + (16 * i + i16) * PAL + (0 + 4 * g) * 2);
                    const u32x2 a1 = i >= 2 ? *(LAS const u32x2*)(L + O_AL + (16 * i + i16) * PAL + (16 + 4 * g) * 2) : z2;
                    y = MFMA16(frag2(a0, a1), frag2(xb[0], i >= 2 ? xb[1] : z2), y);
                }
                if (i == 3) {
                    const u32x2 a2 = *(LAS const u32x2*)(L + O_AL + (48 + i16) * PAL + (32 + 4 * g) * 2);
                    y = MFMA16(frag2(a2, z2), frag2(xb[2], z2), y);
                }
                const f32x4 zacc = {0.f, 0.f, 0.f, 0.f};
                const f32x4 x = MFMA16(frag2(li[i], z2), frag2(pack4(y[0], y[1], y[2], y[3]), z2), zacc);
                xb[i] = pack4(x[0], x[1], x[2], x[3]);
                *(u32x2*)(dst + ((64 * hw + 16 * ct + i16) & 127) * 64 + 16 * i + 4 * g) = (u32x2){xb[i].x ^ sgn, xb[i].y ^ sgn};
            }
        }
    }
    if (more) cur = nxt;
}

__device__ __forceinline__ void gdn_scan(Frame& F, int item, int& sit) {
    (void)sit;
    const int dvq = item & 3, bh = item >> 2, h = bh & 7, b = bh >> 3;
    const int tid = F.tid, lane = F.lane, w = F.wave, i16 = lane & 15, g = lane >> 4;
    LAS unsigned char* L = F.lds;
    constexpr int PB = 272, PX = 144, PO = 132;
    constexpr int SET = 67072, O_WT = 0, O_QG = 18432, O_KG = 35840, O_QK = 53248, O_UT = 62464;
    constexpr int O_ST = 2 * SET, O_VN = O_ST + 8704, O_OT = O_VN + 4608;
    static_assert(O_OT + 64 * PO <= MISC_OFF, "gdn LDS map");
    __syncthreads();
    for (int u = tid; u < 8704 / 16; u += 512) *(LAS u32x4*)(L + O_ST + u * 16) = (u32x4){0u, 0u, 0u, 0u};
    f32x4 sacc[2];
    sacc[0] = (f32x4){0.f, 0.f, 0.f, 0.f}; sacc[1] = sacc[0];
    const int lb = w >> 1, eb = w & 1;
    const int r0 = tid >> 4, c8a = (tid & 15) * 8;
    const int xr = tid >> 3, xc8 = (tid & 7) * 8;
    const float* GC = (const float*)(F.ws + WS_GC);
    u32x4 rwA[2], rqA[2], rkA[2], rqkA, ruA, rgA, rwB[2], rqB[2], rkB[2], rqkB, ruB, rgB, gsA, gsB;
    gsA = (u32x4){0u, 0u, 0u, 0u}; gsB = gsA;
    float* SSO = (float*)(F.ws + WS_SSO); const float* gg = F.in[19];
    float gq0A = 0.f, gq1A = 0.f, glastA = 0.f, gq0B = 0.f, gq1B = 0.f, glastB = 0.f, glvA = 1.f, glvB = 1.f;
#define GDN_LOADA(c) do { const size_t it_ = (size_t)bh * 32 + (c); \
        const bf16_t* wt = (const bf16_t*)(F.ws + WS_WT) + it_ * 8192; rwA[0] = *(const u32x4*)(wt + xr * 64 + xc8); rwA[1] = *(const u32x4*)(wt + (xr + 64) * 64 + xc8); \
        const bf16_t* src = F.PROJ() + (size_t)(b * SEQ + (c) * 64) * LDP + h * 128 + c8a; \
        rqA[0] = *(const u32x4*)(src + (size_t)r0 * LDP + C_Q); rqA[1] = *(const u32x4*)(src + (size_t)(r0 + 32) * LDP + C_Q); \
        rkA[0] = *(const u32x4*)(src + (size_t)r0 * LDP + C_K); rkA[1] = *(const u32x4*)(src + (size_t)(r0 + 32) * LDP + C_K); \
        rqkA = *(const u32x4*)((const bf16_t*)(F.ws + WS_QKM) + it_ * 4096 + xr * 64 + xc8); \
        if (tid < 256) ruA = *(const u32x4*)((const bf16_t*)(F.ws + WS_UT) + it_ * 8192 + (dvq * 32 + xr) * 64 + xc8); \
        if (tid < 256) rgA = *(const u32x4*)(F.PROJ() + (size_t)(b * SEQ + (c) * 64 + (tid >> 2)) * LDP + C_GATE + h * 128 + dvq * 32 + (tid & 3) * 8); \
        gq0A = GC[it_ * 64 + r0]; gq1A = GC[it_ * 64 + r0 + 32]; glastA = GC[it_ * 64 + 63]; } while (0)
#define GDN_LOADB(c) do { const size_t it_ = (size_t)bh * 32 + (c); \
        const bf16_t* wt = (const bf16_t*)(F.ws + WS_WT) + it_ * 8192; rwB[0] = *(const u32x4*)(wt + xr * 64 + xc8); rwB[1] = *(const u32x4*)(wt + (xr + 64) * 64 + xc8); \
        const bf16_t* src = F.PROJ() + (size_t)(b * SEQ + (c) * 64) * LDP + h * 128 + c8a; \
        rqB[0] = *(const u32x4*)(src + (size_t)r0 * LDP + C_Q); rqB[1] = *(const u32x4*)(src + (size_t)(r0 + 32) * LDP + C_Q); \
        rkB[0] = *(const u32x4*)(src + (size_t)r0 * LDP + C_K); rkB[1] = *(const u32x4*)(src + (size_t)(r0 + 32) * LDP + C_K); \
        rqkB = *(const u32x4*)((const bf16_t*)(F.ws + WS_QKM) + it_ * 4096 + xr * 64 + xc8); \
        if (tid < 256) ruB = *(const u32x4*)((const bf16_t*)(F.ws + WS_UT) + it_ * 8192 + (dvq * 32 + xr) * 64 + xc8); \
        if (tid < 256) rgB = *(const u32x4*)(F.PROJ() + (size_t)(b * SEQ + (c) * 64 + (tid >> 2)) * LDP + C_GATE + h * 128 + dvq * 32 + (tid & 3) * 8); \
        gq0B = GC[it_ * 64 + r0]; gq1B = GC[it_ * 64 + r0 + 32]; glastB = GC[it_ * 64 + 63]; } while (0)
#define GDN_STAGE(Q, QS) do { \
        *(LAS u32x4*)(L + QS * SET + O_WT + xr * PX + xc8 * 2) = rw##Q[0]; *(LAS u32x4*)(L + QS * SET + O_WT + (xr + 64) * PX + xc8 * 2) = rw##Q[1]; \
        *(LAS u32x4*)(L + QS * SET + O_QK + xr * PX + xc8 * 2) = rqk##Q; \
        if (tid < 256) *(LAS u32x4*)(L + QS * SET + O_UT + xr * PX + xc8 * 2) = ru##Q; \
        gs##Q = rg##Q; glv##Q = __expf(glast##Q); \
        { float t8_[8]; const float eq0_ = __expf(gq0##Q), eq1_ = __expf(gq1##Q), ek0_ = __expf(glast##Q - gq0##Q), ek1_ = __expf(glast##Q - gq1##Q); \
          unpack8(rq##Q[0], t8_); _Pragma("unroll") for (int i_ = 0; i_ < 8; ++i_) t8_[i_] *= eq0_; *(LAS u32x4*)(L + QS * SET + O_QG + r0 * PB + c8a * 2) = pack8(t8_); \
          unpack8(rq##Q[1], t8_); _Pragma("unroll") for (int i_ = 0; i_ < 8; ++i_) t8_[i_] *= eq1_; *(LAS u32x4*)(L + QS * SET + O_QG + (r0 + 32) * PB + c8a * 2) = pack8(t8_); \
          unpack8(rk##Q[0], t8_); _Pragma("unroll") for (int i_ = 0; i_ < 8; ++i_) t8_[i_] *= ek0_; *(LAS u32x4*)(L + QS * SET + O_KG + r0 * PB + c8a * 2) = pack8(t8_); \
          unpack8(rk##Q[1], t8_); _Pragma("unroll") for (int i_ = 0; i_ < 8; ++i_) t8_[i_] *= ek1_; *(LAS u32x4*)(L + QS * SET + O_KG + (r0 + 32) * PB + c8a * 2) = pack8(t8_); } } while (0)
    GDN_LOADA(0); GDN_LOADB(1);
    GDN_STAGE(A, 0);
    GDN_LOADA(2);
    for (int c2 = 0; c2 < SEQ / 128; ++c2) {
        { const int c = 2 * c2;
        LDS_BARRIER();
        if (c > 0 && tid < 256) {
            const int r = tid >> 2, c8 = (tid & 3) * 8; float o[8], gt[8]; unpack8(gsB, gt); float ss = 0.f;
            const f32x4 g0 = *(const f32x4*)(gg + dvq * 32 + c8), g1 = *(const f32x4*)(gg + dvq * 32 + c8 + 4);
#pragma unroll
            for (int i = 0; i < 8; ++i) { const float ov = *(LAS const float*)(L + O_OT + r * PO + (c8 + i) * 4); ss += ov * ov; o[i] = ov * (i < 4 ? g0[i & 3] : g1[i & 3]) * siluf_(gt[i]); }
            *(u32x4*)(F.PROJ() + (size_t)(b * SEQ + (c - 1) * 64 + r) * LDP + C_B + h * 128 + dvq * 32 + c8) = pack8(o);
            ss += __shfl_xor(ss, 1); ss += __shfl_xor(ss, 2);
            if ((tid & 3) == 0) atomicAdd(SSO + (size_t)(b * SEQ + (c - 1) * 64 + r) * 8 + h, ss);
        }
        if (c + 1 < SEQ / 64) {
            GDN_STAGE(B, 1);
            if (c + 3 < SEQ / 64) GDN_LOADB(c + 3);
        }
        f32x4 vacc, oacc = (f32x4){0.f, 0.f, 0.f, 0.f};
        { const u32x2 uw = *(LAS const u32x2*)(L + 0 * SET + O_UT + (16 * eb + i16) * PX + (16 * lb + 4 * g) * 2);
          vacc = (f32x4){bflo(uw.x), bfhi(uw.x), bflo(uw.y), bfhi(uw.y)}; }
#pragma unroll
        for (int ks = 0; ks < 4; ++ks) {
            const bf16x8 bS = row_frag(L + O_ST, PB, 16 * eb, 32 * ks, lane);
            vacc = MFMA16(tr_frag(L + 0 * SET + O_WT, PX, 32 * ks, 16 * lb, lane), bS, vacc);
            oacc = MFMA16(row_frag(L + 0 * SET + O_QG, PB, 16 * lb, 32 * ks, lane), bS, oacc);
        }
        *(LAS u32x2*)(L + O_VN + (16 * eb + i16) * PX + (16 * lb + 4 * g) * 2) = pack4(vacc[0], vacc[1], vacc[2], vacc[3]);
        LDS_BARRIER();
        {
            const bf16x8 bV0 = row_frag(L + O_VN, PX, 16 * eb, 0, lane), bV1 = row_frag(L + O_VN, PX, 16 * eb, 32, lane);
            oacc = MFMA16(row_frag(L + 0 * SET + O_QK, PX, 16 * lb, 0, lane), bV0, oacc);
            if (lb >= 2) oacc = MFMA16(row_frag(L + 0 * SET + O_QK, PX, 16 * lb, 32, lane), bV1, oacc);
#pragma unroll
            for (int r = 0; r < 4; ++r) *(LAS float*)(L + O_OT + (16 * lb + 4 * g + r) * PO + (16 * eb + i16) * 4) = oacc[r];
#pragma unroll
            for (int t2 = 0; t2 < 2; ++t2) {
                const int db = 2 * lb + t2;
                f32x4 sa = sacc[t2] * glvA;
                sa = MFMA16(tr_frag(L + 0 * SET + O_KG, PB, 0, 16 * db, lane), bV0, sa);
                sa = MFMA16(tr_frag(L + 0 * SET + O_KG, PB, 32, 16 * db, lane), bV1, sa);
                sacc[t2] = sa;
                *(LAS u32x2*)(L + O_ST + (16 * eb + i16) * PB + (16 * db + 4 * g) * 2) = pack4(sa[0], sa[1], sa[2], sa[3]);
            }
        }
        }
        { const int c = 2 * c2 + 1;
        LDS_BARRIER();
        if (c > 0 && tid < 256) {
            const int r = tid >> 2, c8 = (tid & 3) * 8; float o[8], gt[8]; unpack8(gsA, gt); float ss = 0.f;
            const f32x4 g0 = *(const f32x4*)(gg + dvq * 32 + c8), g1 = *(const f32x4*)(gg + dvq * 32 + c8 + 4);
#pragma unroll
            for (int i = 0; i < 8; ++i) { const float ov = *(LAS const float*)(L + O_OT + r * PO + (c8 + i) * 4); ss += ov * ov; o[i] = ov * (i < 4 ? g0[i & 3] : g1[i & 3]) * siluf_(gt[i]); }
            *(u32x4*)(F.PROJ() + (size_t)(b * SEQ + (c - 1) * 64 + r) * LDP + C_B + h * 128 + dvq * 32 + c8) = pack8(o);
            ss += __shfl_xor(ss, 1); ss += __shfl_xor(ss, 2);
            if ((tid & 3) == 0) atomicAdd(SSO + (size_t)(b * SEQ + (c - 1) * 64 + r) * 8 + h, ss);
        }
        if (c + 1 < SEQ / 64) {
            GDN_STAGE(A, 0);
            if (c + 3 < SEQ / 64) GDN_LOADA(c + 3);
        }
        f32x4 vacc, oacc = (f32x4){0.f, 0.f, 0.f, 0.f};
        { const u32x2 uw = *(LAS const u32x2*)(L + 1 * SET + O_UT + (16 * eb + i16) * PX + (16 * lb + 4 * g) * 2);
          vacc = (f32x4){bflo(uw.x), bfhi(uw.x), bflo(uw.y), bfhi(uw.y)}; }
#pragma unroll
        for (int ks = 0; ks < 4; ++ks) {
            const bf16x8 bS = row_frag(L + O_ST, PB, 16 * eb, 32 * ks, lane);
            vacc = MFMA16(tr_frag(L + 1 * SET + O_WT, PX, 32 * ks, 16 * lb, lane), bS, vacc);
            oacc = MFMA16(row_frag(L + 1 * SET + O_QG, PB, 16 * lb, 32 * ks, lane), bS, oacc);
        }
        *(LAS u32x2*)(L + O_VN + (16 * eb + i16) * PX + (16 * lb + 4 * g) * 2) = pack4(vacc[0], vacc[1], vacc[2], vacc[3]);
        LDS_BARRIER();
        {
            const bf16x8 bV0 = row_frag(L + O_VN, PX, 16 * eb, 0, lane), bV1 = row_frag(L + O_VN, PX, 16 * eb, 32, lane);
            oacc = MFMA16(row_frag(L + 1 * SET + O_QK, PX, 16 * lb, 0, lane), bV0, oacc);
            if (lb >= 2) oacc = MFMA16(row_frag(L + 1 * SET + O_QK, PX, 16 * lb, 32, lane), bV1, oacc);
#pragma unroll
            for (int r = 0; r < 4; ++r) *(LAS float*)(L + O_OT + (16 * lb + 4 * g + r) * PO + (16 * eb + i16) * 4) = oacc[r];
#pragma unroll
            for (int t2 = 0; t2 < 2; ++t2) {
                const int db = 2 * lb + t2;
                f32x4 sa = sacc[t2] * glvB;
                sa = MFMA16(tr_frag(L + 1 * SET + O_KG, PB, 0, 16 * db, lane), bV0, sa);
                sa = MFMA16(tr_frag(L + 1 * SET + O_KG, PB, 32, 16 * db, lane), bV1, sa);
                sacc[t2] = sa;
                *(LAS u32x2*)(L + O_ST + (16 * eb + i16) * PB + (16 * db + 4 * g) * 2) = pack4(sa[0], sa[1], sa[2], sa[3]);
            }
        }
        }
    }
    LDS_BARRIER();
    if (tid < 256) {
        const int c = SEQ / 64, r = tid >> 2, c8 = (tid & 3) * 8; float o[8], gt[8]; unpack8(gsB, gt); float ss = 0.f;
        const f32x4 g0 = *(const f32x4*)(gg + dvq * 32 + c8), g1 = *(const f32x4*)(gg + dvq * 32 + c8 + 4);
#pragma unroll
        for (int i = 0; i < 8; ++i) { const float ov = *(LAS const float*)(L + O_OT + r * PO + (c8 + i) * 4); ss += ov * ov; o[i] = ov * (i < 4 ? g0[i & 3] : g1[i & 3]) * siluf_(gt[i]); }
        *(u32x4*)(F.PROJ() + (size_t)(b * SEQ + (c - 1) * 64 + r) * LDP + C_B + h * 128 + dvq * 32 + c8) = pack8(o);
        ss += __shfl_xor(ss, 1); ss += __shfl_xor(ss, 2);
        if ((tid & 3) == 0) atomicAdd(SSO + (size_t)(b * SEQ + (c - 1) * 64 + r) * 8 + h, ss);
    }
#undef GDN_LOADA
#undef GDN_LOADB
#undef GDN_STAGE
#pragma unroll
    for (int t2 = 0; t2 < 2; ++t2)
#pragma unroll
        for (int r = 0; r < 4; ++r) F.out[O_GDNP + ((size_t)bh * 128 + 16 * (2 * lb + t2) + 4 * g + r) * 128 + dvq * 32 + 16 * eb + i16] = sacc[t2][r];
}


template <class EpiQ>
__device__ __forceinline__ void small_gemm(Frame& F, const bf16_t* A, int lda, const bf16_t* Bt, int ldb, int K, int N, const EpiQ& q) {
    const int lane = F.lane, w = F.wave, i16 = lane & 15, g = lane >> 4, kp = w & 3, tw = w >> 2;
    LAS float* part = (LAS float*)F.lds;
    const int ntl = 8 * (N / 16), nsteps = K / 128;
    for (int t2 = blockIdx.x; 2 * t2 < ntl; t2 += F.G) {
        const int t = 2 * t2 + tw, rg = t / (N / 16), nb = t % (N / 16);
        const bf16_t* ap = A + (size_t)(16 * rg + i16) * lda + kp * (K / 4) + 8 * g;
        const bf16_t* bp = Bt + (size_t)(16 * nb + i16) * ldb + kp * (K / 4) + 8 * g;
        f32x4 acc = (f32x4){0.f, 0.f, 0.f, 0.f};
        bf16x8 a0[8], b0[8], a1[8], b1[8];
#define SG_LOAD(A_, B_, base) do { _Pragma("unroll") for (int j = 0; j < 8; ++j) if ((base) + j < nsteps) { A_[j] = *(const bf16x8*)(ap + ((base) + j) * 32); B_[j] = *(const bf16x8*)(bp + ((base) + j) * 32); } } while (0)
#define SG_MMA(A_, B_, base) do { _Pragma("unroll") for (int j = 0; j < 8; ++j) if ((base) + j < nsteps) acc = MFMA16(B_[j], A_[j], acc); } while (0)
        SG_LOAD(a0, b0, 0);
        for (int ks = 0; ks < nsteps; ks += 16) {
            SG_LOAD(a1, b1, ks + 8);
            SG_MMA(a0, b0, ks);
            SG_LOAD(a0, b0, ks + 16);
            SG_MMA(a1, b1, ks + 8);
        }
#undef SG_LOAD
#undef SG_MMA
        __syncthreads();
        *(LAS f32x4*)(part + (w * 64 + lane) * 4) = acc;
        __syncthreads();
        if (kp == 0) {
            const f32x4 p1 = *(LAS const f32x4*)(part + ((w + 1) * 64 + lane) * 4), p2 = *(LAS const f32x4*)(part + ((w + 2) * 64 + lane) * 4), p3 = *(LAS const f32x4*)(part + ((w + 3) * 64 + lane) * 4);
            acc = (acc + p1) + (p2 + p3);
            q(MPR + 16 * rg + i16, 16 * nb + 4 * g, acc);
        }
    }
}
struct QT1 { bf16_t* PROJ;
    __device__ __forceinline__ void operator()(int row, int col, f32x4 v) const {
        const u32x2 mw = *(const u32x2*)(PROJ + (size_t)row * LDP + C_MG + col);
        *(u32x2*)(PROJ + (size_t)row * LDP + C_Z + col) = pack4(v[0] * sigmoidf_(bflo(mw.x)), v[1] * sigmoidf_(bfhi(mw.x)), v[2] * sigmoidf_(bflo(mw.y)), v[3] * sigmoidf_(bfhi(mw.y))); } };
struct QMix { bf16_t* PROJ;
    __device__ __forceinline__ void operator()(int row, int col, f32x4 v) const {
        const u32x2 mw = *(const u32x2*)(PROJ + (size_t)row * LDP + C_MG + 1024 + col), tw = *(const u32x2*)(PROJ + (size_t)row * LDP + C_Z + col);
        *(u32x2*)(PROJ + (size_t)row * LDP + C_Q + col) = pack4(bflo(tw.x) + v[0] * sigmoidf_(bflo(mw.x)), bfhi(tw.x) + v[1] * sigmoidf_(bfhi(mw.x)), bflo(tw.y) + v[2] * sigmoidf_(bflo(mw.y)), bfhi(tw.y) + v[3] * sigmoidf_(bfhi(mw.y))); } };
template <int MODE> struct QResid { bf16_t* PROJ; const float* xs; int res_col, dstb_col; float* SS;
    __device__ __forceinline__ void operator()(int row, int col, f32x4 v) const {
        f32x4 r;
        if (MODE == 0) r = *(const f32x4*)(xs + (size_t)(row - MPR) * D + col);
        else { const u32x2 rw = *(const u32x2*)(PROJ + (size_t)row * LDP + res_col + col); r = (f32x4){bflo(rw.x), bfhi(rw.x), bflo(rw.y), bfhi(rw.y)}; }
        const f32x4 x = r + v;
        *(u32x2*)(PROJ + (size_t)row * LDP + dstb_col + col) = pack4(x[0], x[1], x[2], x[3]);
        float ss = (x[0] * x[0] + x[1] * x[1]) + (x[2] * x[2] + x[3] * x[3]);
        ss += __shfl_xor(ss, 16); ss += __shfl_xor(ss, 32);
        if ((threadIdx.x & 48) == 0) atomicAdd(SS + row, ss); } };
struct QPE { bf16_t* PROJ;
    __device__ __forceinline__ void operator()(int row, int col, f32x4 v) const { *(u32x2*)(PROJ + (size_t)row * LDP + C_Z + col) = pack4(v[0], v[1], v[2], v[3]); } };
__device__ __forceinline__ void small_mix(Frame& F, const bf16_t* WT) {
    const int lane = F.lane, w = F.wave, i16 = lane & 15, g = lane >> 4, kp = w & 3, tw = w >> 2;
    LAS float* part = (LAS float*)F.lds;
    const int t = 2 * (int)blockIdx.x + tw, rg = t / (D / 16), nb = t % (D / 16);
    const bf16_t* arow = F.PROJ() + (size_t)(MPR + 16 * rg + i16) * LDP;
    const bf16_t* brow = WT + (size_t)(16 * nb + i16) * 3072;
    const bf16_t* ap = arow + C_XS + kp * 512 + 8 * g; const bf16_t* bp = brow + kp * 512 + 8 * g;
    const bf16_t* ap2 = arow + C_B + kp * 256 + 8 * g; const bf16_t* bp2 = brow + 2048 + kp * 256 + 8 * g;
    f32x4 acc1 = (f32x4){0.f, 0.f, 0.f, 0.f}, acc2 = acc1;
    bf16x8 a0[8], b0[8], a1[8], b1[8];
#pragma unroll
    for (int j = 0; j < 8; ++j) { a0[j] = *(const bf16x8*)(ap + j * 32); b0[j] = *(const bf16x8*)(bp + j * 32); }
#pragma unroll
    for (int j = 0; j < 8; ++j) { a1[j] = *(const bf16x8*)(ap + (8 + j) * 32); b1[j] = *(const bf16x8*)(bp + (8 + j) * 32); }
#pragma unroll
    for (int j = 0; j < 8; ++j) acc1 = MFMA16(b0[j], a0[j], acc1);
#pragma unroll
    for (int j = 0; j < 8; ++j) { a0[j] = *(const bf16x8*)(ap2 + j * 32); b0[j] = *(const bf16x8*)(bp2 + j * 32); }
#pragma unroll
    for (int j = 0; j < 8; ++j) acc1 = MFMA16(b1[j], a1[j], acc1);
#pragma unroll
    for (int j = 0; j < 8; ++j) acc2 = MFMA16(b0[j], a0[j], acc2);
    __syncthreads();
    *(LAS f32x4*)(part + (w * 64 + lane) * 8) = acc1; *(LAS f32x4*)(part + (w * 64 + lane) * 8 + 4) = acc2;
    __syncthreads();
    if (kp == 0) {
#pragma unroll
        for (int q = 1; q < 4; ++q) { acc1 += *(LAS const f32x4*)(part + ((w + q) * 64 + lane) * 8); acc2 += *(LAS const f32x4*)(part + ((w + q) * 64 + lane) * 8 + 4); }
        const int row = MPR + 16 * rg + i16, col = 16 * nb + 4 * g;
        const u32x2 m1 = *(const u32x2*)(F.PROJ() + (size_t)row * LDP + C_MG + col), m2 = *(const u32x2*)(F.PROJ() + (size_t)row * LDP + C_MG + 1024 + col);
        *(u32x2*)(F.PROJ() + (size_t)row * LDP + C_Q + col) = pack4(acc1[0] * sigmoidf_(bflo(m1.x)) + acc2[0] * sigmoidf_(bflo(m2.x)), acc1[1] * sigmoidf_(bfhi(m1.x)) + acc2[1] * sigmoidf_(bfhi(m2.x)),
                                                                  acc1[2] * sigmoidf_(bflo(m1.y)) + acc2[2] * sigmoidf_(bflo(m2.y)), acc1[3] * sigmoidf_(bfhi(m1.y)) + acc2[3] * sigmoidf_(bfhi(m2.y)));
    }
}

__device__ __forceinline__ void small_x3_final(Frame& F, const bf16_t* A, int lda, const bf16_t* Bt, int ldb, const bf16_t* WPP, const float* SS2, float* SS3, unsigned* cnt, unsigned* bar) {
    const int lane = F.lane, w = F.wave, i16 = lane & 15, g = lane >> 4, kp = w & 3, tw = w >> 2;
    LAS float* part = (LAS float*)F.lds;
    const int t = 2 * (int)blockIdx.x + tw, rg = t / (D / 16), nb = t % (D / 16);
    const bf16_t* ap = A + (size_t)(16 * rg + i16) * lda + kp * (D / 4) + 8 * g;
    const bf16_t* bp = Bt + (size_t)(16 * nb + i16) * ldb + kp * (D / 4) + 8 * g;
    const bf16_t* ap2 = F.PB() + (size_t)(MPR + 16 * rg + i16) * 256 + kp * 64 + 8 * g;
    const bf16_t* bp2 = WPP + (size_t)(16 * nb + i16) * 256 + kp * 64 + 8 * g;
    f32x4 acc = (f32x4){0.f, 0.f, 0.f, 0.f}, acc2 = acc;
    {   bf16x8 av[10], bv[10];
#pragma unroll
        for (int j = 0; j < 8; ++j) { av[j] = *(const bf16x8*)(ap + j * 32); bv[j] = *(const bf16x8*)(bp + j * 32); }
#pragma unroll
        for (int j = 0; j < 2; ++j) { av[8 + j] = *(const bf16x8*)(ap2 + j * 32); bv[8 + j] = *(const bf16x8*)(bp2 + j * 32); }
#pragma unroll
        for (int j = 0; j < 8; ++j) acc = MFMA16(bv[j], av[j], acc);
#pragma unroll
        for (int j = 0; j < 2; ++j) acc2 = MFMA16(bv[8 + j], av[8 + j], acc2);
    }
    __syncthreads();
    *(LAS f32x4*)(part + (w * 64 + lane) * 8) = acc; *(LAS f32x4*)(part + (w * 64 + lane) * 8 + 4) = acc2;
    __syncthreads();
    const int row = MPR + 16 * rg + i16, col = 16 * nb + 4 * g;
    f32x4 x = (f32x4){0.f, 0.f, 0.f, 0.f};
    if (kp == 0) {
#pragma unroll
        for (int q = 1; q < 4; ++q) { acc += *(LAS const f32x4*)(part + ((w + q) * 64 + lane) * 8); acc2 += *(LAS const f32x4*)(part + ((w + q) * 64 + lane) * 8 + 4); }
        const float r = rsqrtf(SS2[row] * (1.0f / D) + EPS);
        const u32x2 aw = *(const u32x2*)(F.PROJ() + (size_t)row * LDP + C_GATE + col);
        const f32x4 a = (f32x4){bflo(aw.x), bfhi(aw.x), bflo(aw.y), bfhi(aw.y)};
#pragma unroll
        for (int i = 0; i < 4; ++i) x[i] = a[i] + acc2[i] * sigmoidf_(r * acc[i]);
        float ss = (x[0] * x[0] + x[1] * x[1]) + (x[2] * x[2] + x[3] * x[3]);
        ss += __shfl_xor(ss, 16); ss += __shfl_xor(ss, 32);
        if (g == 0) atomicAdd(SS3 + row, ss);
    }
    asm volatile("s_waitcnt vmcnt(0)" ::: "memory");
    __syncthreads();
    if (F.tid == 0) { unsigned* c = cnt + 64 * rg; (void)xb_add(c, 1u); unsigned sp = 0u;
        while (xb_ld(c) < 32u) { __builtin_amdgcn_s_sleep(1); if ((++sp & 255u) == 0u) { if (xb_ld(&bar[XB_TMO])) break; if (sp > XB_SPIN_CAP) { atomicAdd(&bar[XB_TMO], 1u); break; } } } }
    __syncthreads();
    if (kp == 0) {
        const float r3 = rsqrtf(__uint_as_float(xb_ld((unsigned*)(SS3 + row))) * (1.0f / D) + EPS);
        const f32x4 gq = *(const f32x4*)(F.in[29] + col);
        *(f32x4*)(F.out + O_YS + (size_t)(row - MPR) * D + col) = x * r3 * gq;
    }
}

struct GdnSmp2In { f32x4 S[8]; u32x4 k8, q8; u32x2 v4; float araw, braw; };
__device__ __forceinline__ void gdn_smp2_load(const Frame& F, int it, int e4, int dg, GdnSmp2In& r) {
    const int sq = it >> 3, h = it & 7;
    const float* sp = F.in[6] + ((size_t)(sq * 8 + h) * 128 + dg * 8) * 128 + e4 * 4;
#pragma unroll
    for (int j = 0; j < 8; ++j) r.S[j] = *(const f32x4*)(sp + (size_t)j * 128);
    const bf16_t* row = F.PROJ() + (size_t)(MPR + sq) * LDP;
    r.k8 = *(const u32x4*)(row + C_K + h * 128 + dg * 8); r.q8 = *(const u32x4*)(row + C_Q + h * 128 + dg * 8);
    r.v4 = *(const u32x2*)(row + C_V + h * 128 + e4 * 4);
    const float* sm = F.SMALL() + (size_t)(MPR + sq) * 64;
    r.araw = sm[40 + h]; r.braw = sm[32 + h];
}
__device__ __forceinline__ void gdn_sample2_regs(const Frame& F) {
    const int tid = F.tid, e4 = tid & 31, dg = tid >> 5, w = F.wave, lane = F.lane;
    LAS f32x4* pa = (LAS f32x4*)F.lds;
    LAS f32x4* pb = (LAS f32x4*)(F.lds + 4096);
    constexpr int NIT = NSMP * 8;
    int it = blockIdx.x;
    if (it >= NIT) return;
    GdnSmp2In cur, nxt;
    gdn_smp2_load(F, it, e4, dg, cur);
    for (; it < NIT; it += F.G) {
        const bool more = it + F.G < NIT;
        if (more) gdn_smp2_load(F, it + F.G, e4, dg, nxt);
        const int sq = it >> 3, h = it & 7;
        const float eg = __expf(-__expf(F.in[18][h]) * softplusf_(cur.araw + F.in[17][h])), bt = sigmoidf_(cur.braw);
        float k8[8], q8[8]; unpack8(cur.k8, k8); unpack8(cur.q8, q8);
        f32x4 ks = (f32x4){0.f, 0.f, 0.f, 0.f};
#pragma unroll
        for (int j = 0; j < 8; ++j) ks += cur.S[j] * k8[j];
#pragma unroll
        for (int i = 0; i < 4; ++i) ks[i] += __shfl_xor(ks[i], 32);
        __syncthreads();
        if (lane < 32) pa[w * 32 + e4] = ks;
        __syncthreads();
        f32x4 kS = pa[e4];
#pragma unroll
        for (int ww = 1; ww < 8; ++ww) kS += pa[ww * 32 + e4];
        const f32x4 vv = (f32x4){bflo(cur.v4.x), bfhi(cur.v4.x), bflo(cur.v4.y), bfhi(cur.v4.y)};
        const f32x4 vn = (vv - kS * eg) * bt;
        f32x4 op = (f32x4){0.f, 0.f, 0.f, 0.f};
        float* dp = F.out + O_GDNS + ((size_t)(sq * 8 + h) * 128 + dg * 8) * 128 + e4 * 4;
#pragma unroll
        for (int j = 0; j < 8; ++j) { const f32x4 sn = cur.S[j] * eg + vn * k8[j]; op += sn * q8[j]; *(f32x4*)(dp + (size_t)j * 128) = sn; }
#pragma unroll
        for (int i = 0; i < 4; ++i) op[i] += __shfl_xor(op[i], 32);
        if (lane < 32) pb[w * 32 + e4] = op;
        __syncthreads();
        if (dg == 0) {
            f32x4 o = pb[e4];
#pragma unroll
            for (int ww = 1; ww < 8; ++ww) o += pb[ww * 32 + e4];
            float ss = (o[0] * o[0] + o[1] * o[1]) + (o[2] * o[2] + o[3] * o[3]);
            ss += __shfl_xor(ss, 1); ss += __shfl_xor(ss, 2); ss += __shfl_xor(ss, 4); ss += __shfl_xor(ss, 8); ss += __shfl_xor(ss, 16);
            const float rn = rsqrtf(ss * (1.0f / 128.0f) + EPS);
            const u32x2 gw = *(const u32x2*)(F.PROJ() + (size_t)(MPR + sq) * LDP + C_GATE + h * 128 + e4 * 4);
            const f32x4 gn = *(const f32x4*)(F.in[19] + e4 * 4);
            *(u32x2*)(F.PROJ() + (size_t)(MPR + sq) * LDP + C_B + h * 128 + e4 * 4) = pack4(o[0] * rn * gn[0] * siluf_(bflo(gw.x)), o[1] * rn * gn[1] * siluf_(bfhi(gw.x)), o[2] * rn * gn[2] * siluf_(bflo(gw.y)), o[3] * rn * gn[3] * siluf_(bfhi(gw.y)));
        }
        if (more) cur = nxt;
    }
}

__device__ __forceinline__ void gdn_sample2(const Frame& F) {
    constexpr int NIT = NSMP * 8, SLOT = 65536 + 4096;
    constexpr int O_PA = 2 * SLOT, O_PB = O_PA + 2048, O_HP = O_PB + 2048;
    static_assert(O_HP + 256 <= MISC_OFF, "gdn sample ring");
    const int w = F.wave, lane = F.lane;
    LAS unsigned char* L = F.lds;
    const int first = blockIdx.x, n = first < NIT ? (NIT - 1 - first) / F.G + 1 : 0;
    LAS float* hp = (LAS float*)(L + O_HP);
    LDS_BARRIER();
    if (F.tid < 8) { hp[F.tid] = -__expf(F.in[18][F.tid]); hp[8 + F.tid] = F.in[17][F.tid]; }
    LDS_BARRIER();
    if (w < 4) {
#define GSL_ISSUE(k_) do { const int it_ = first + (k_) * F.G, sq_ = it_ >> 3, h_ = it_ & 7; \
            const char* sp_ = (const char*)(F.in[6] + (size_t)it_ * 16384) + (size_t)((w * 16) * 64 + lane) * 16; \
            LAS unsigned char* sl_ = L + ((k_) & 1) * SLOT + w * 16384; \
            _Pragma("unroll") for (int j_ = 0; j_ < 16; ++j_) __builtin_amdgcn_global_load_lds((const unsigned*)(sp_ + j_ * 1024), (LAS unsigned*)(sl_ + j_ * 1024), 16, 0, 0); \
            const bf16_t* row_ = F.PROJ() + (size_t)(MPR + sq_) * LDP + h_ * 128 + (lane & 15) * 8; \
            const char* op_ = w == 0 ? (const char*)(row_ + C_K) : w == 1 ? (const char*)(row_ + C_Q) : w == 2 ? (const char*)(row_ + C_V) \
                            : (lane & 16) ? (const char*)(F.SMALL() + (size_t)(MPR + sq_) * 64 + 32 + (lane & 3) * 4) : (const char*)(row_ + C_GATE); \
            __builtin_amdgcn_global_load_lds((const unsigned*)op_, (LAS unsigned*)(L + ((k_) & 1) * SLOT + 65536 + w * 1024), 16, 0, 0); } while (0)
        if (n > 0) GSL_ISSUE(0);
        if (n > 1) GSL_ISSUE(1);
        for (int k = 0; k < n; ++k) {
            if (k + 1 < n) asm volatile("s_waitcnt vmcnt(17)" ::: "memory"); else asm volatile("s_waitcnt vmcnt(0)" ::: "memory");
            __builtin_amdgcn_s_barrier(); asm volatile("" ::: "memory");
            __builtin_amdgcn_s_barrier(); asm volatile("" ::: "memory");
            if (k + 2 < n) GSL_ISSUE(k + 2);
            __builtin_amdgcn_s_barrier(); asm volatile("" ::: "memory");
        }
#undef GSL_ISSUE
    } else {
        const int cw = w - 4, e4 = lane & 31, dgl = lane >> 5, d0 = (cw * 2 + dgl) * 16;
        LAS f32x4* pa = (LAS f32x4*)(L + O_PA); LAS f32x4* pb = (LAS f32x4*)(L + O_PB);
        for (int k = 0; k < n; ++k) {
            asm volatile("s_waitcnt lgkmcnt(0)" ::: "memory"); __builtin_amdgcn_s_barrier(); asm volatile("" ::: "memory");
            const int it = first + k * F.G, sq = it >> 3, h = it & 7;
            LAS const unsigned char* sl = L + (k & 1) * SLOT;
            f32x4 S[16];
#pragma unroll
            for (int j = 0; j < 16; ++j) S[j] = *(LAS const f32x4*)(sl + (size_t)(d0 + j) * 512 + e4 * 16);
            float k16[16], q16[16];
            { unpack8(*(LAS const u32x4*)(sl + 65536 + d0 * 2), *(float (*)[8])&k16[0]); unpack8(*(LAS const u32x4*)(sl + 65536 + d0 * 2 + 16), *(float (*)[8])&k16[8]);
              unpack8(*(LAS const u32x4*)(sl + 65536 + 1024 + d0 * 2), *(float (*)[8])&q16[0]); unpack8(*(LAS const u32x4*)(sl + 65536 + 1024 + d0 * 2 + 16), *(float (*)[8])&q16[8]); }
            const u32x2 v4 = *(LAS const u32x2*)(sl + 65536 + 2048 + e4 * 8), gw = *(LAS const u32x2*)(sl + 65536 + 3072 + e4 * 8);
            const float braw = *(LAS const float*)(sl + 65536 + 3072 + 256 + h * 4), araw = *(LAS const float*)(sl + 65536 + 3072 + 256 + 32 + h * 4);
            const float eg = __expf(hp[h] * softplusf_(araw + hp[8 + h])), bt = sigmoidf_(braw);
            f32x4 ks = (f32x4){0.f, 0.f, 0.f, 0.f};
#pragma unroll
            for (int j = 0; j < 16; ++j) ks += S[j] * k16[j];
#pragma unroll
            for (int i = 0; i < 4; ++i) ks[i] += __shfl_xor(ks[i], 32);
            if (lane < 32) pa[cw * 32 + e4] = ks;
            asm volatile("s_waitcnt lgkmcnt(0)" ::: "memory"); __builtin_amdgcn_s_barrier(); asm volatile("" ::: "memory");
            const f32x4 kS = (pa[e4] + pa[32 + e4]) + (pa[64 + e4] + pa[96 + e4]);
            const f32x4 vv = (f32x4){bflo(v4.x), bfhi(v4.x), bflo(v4.y), bfhi(v4.y)};
            const f32x4 vn = (vv - kS * eg) * bt;
            f32x4 op = (f32x4){0.f, 0.f, 0.f, 0.f};
            float* dp = F.out + O_GDNS + ((size_t)it * 128 + d0) * 128 + e4 * 4;
#pragma unroll
            for (int j = 0; j < 16; ++j) { const f32x4 sn = S[j] * eg + vn * k16[j]; op += sn * q16[j]; *(f32x4*)(dp + (size_t)j * 128) = sn; }
#pragma unroll
            for (int i = 0; i < 4; ++i) op[i] += __shfl_xor(op[i], 32);
            if (lane < 32) pb[cw * 32 + e4] = op;
            asm volatile("s_waitcnt lgkmcnt(0)" ::: "memory"); __builtin_amdgcn_s_barrier(); asm volatile("" ::: "memory");
            if (cw == 0 && lane < 32) {
                const f32x4 o = (pb[e4] + pb[32 + e4]) + (pb[64 + e4] + pb[96 + e4]);
                float ss = (o[0] * o[0] + o[1] * o[1]) + (o[2] * o[2] + o[3] * o[3]);
                ss += __shfl_xor(ss, 1); ss += __shfl_xor(ss, 2); ss += __shfl_xor(ss, 4); ss += __shfl_xor(ss, 8); ss += __shfl_xor(ss, 16);
                const float rn = rsqrtf(ss * (1.0f / 128.0f) + EPS);
                const f32x4 gn = *(const f32x4*)(F.in[19] + e4 * 4);
                *(u32x2*)(F.PROJ() + (size_t)(MPR + sq) * LDP + C_B + h * 128 + e4 * 4) = pack4(o[0] * rn * gn[0] * siluf_(bflo(gw.x)), o[1] * rn * gn[1] * siluf_(bfhi(gw.x)), o[2] * rn * gn[2] * siluf_(bflo(gw.y)), o[3] * rn * gn[3] * siluf_(bfhi(gw.y)));
            }
        }
    }
}

#ifdef PROBE_A
#define STAMPF(k) do { if (blockIdx.x == 0 && F.tid == 0) ((volatile LAS unsigned*)(F.lds + MISC_OFF))[16 + (k)] = (unsigned)__builtin_amdgcn_s_memrealtime(); } while (0)
#else
#define STAMPF(k) do { } while (0)
#endif
__device__ __forceinline__ void p3_scan(Frame& F) {
    int sit = NSMP * 32;
    if (F.G == 256) {
        const int xcd = blockIdx.x & 7, idx = blockIdx.x >> 3, grp = xcd * 4 + (idx >> 3);
        ssd_chunked(F, (grp >> 2) * 32 + (grp & 3) * 8 + (idx & 7), sit);
    } else
    for (int it = blockIdx.x; it < NBATCH * 32; it += F.G) ssd_chunked(F, it, sit);
    LDS_BARRIER(); STAMPF(15);
    { const int hb = F.tid >> 8;
      for (int pr = blockIdx.x; pr < 1024; pr += F.G) { PrepIn pin; prep_load(F, 2 * pr + hb, pin); gdn_prep3(F, 2 * pr + hb, hb, pin, 0, false); } }
    LDS_BARRIER(); STAMPF(16);
    ssd_sample_stream(F, blockIdx.x);
}
__device__ __forceinline__ void sample_ynorm(Frame& F) {
    const int gw = blockIdx.x * NWAVES + F.wave, NGW = F.G * NWAVES, lane = F.lane;
    for (int u = gw; u < NSMP * 4; u += NGW) {
        bf16_t* row = F.PROJ() + (size_t)(MPR + (u >> 2)) * LDP;
        const int c = (u & 3) * 512 + lane * 8;
        float y[8], z[8]; unpack8(*(const u32x4*)(row + C_XS + c), y); unpack8(*(const u32x4*)(row + C_Z + c), z);
        float ss = 0.f;
#pragma unroll
        for (int i = 0; i < 8; ++i) { y[i] *= siluf_(z[i]); ss += y[i] * y[i]; }
        const float r = rsqrtf(wave_sum(ss) * (1.0f / 512.0f) + EPS);
#pragma unroll
        for (int i = 0; i < 8; ++i) y[i] *= r;
        *(u32x4*)(row + C_XS + c) = pack8(y);
    }
}
__device__ __forceinline__ void p3b_scan(Frame& F) {
    int sit = NSMP * 32;
    sample_ynorm(F);
    if (F.G == 256) {
        const int xcd = blockIdx.x & 7, idx = blockIdx.x >> 3;
        gdn_scan(F, (xcd * 8 + (idx >> 2)) * 4 + (idx & 3), sit);
    } else
    for (int it = blockIdx.x; it < NBATCH * 32; it += F.G) gdn_scan(F, it, sit);
    LDS_BARRIER(); STAMPF(17);
    gdn_sample2(F);
}

__device__ __forceinline__ void p4_norm(Frame& F) {
    const int gw = blockIdx.x * NWAVES + F.wave, NGW = F.G * NWAVES, lane = F.lane;
    const float* gs = F.in[15]; const float* gg = F.in[19];
    for (int m = gw; m < MTOT; m += NGW) {
        bf16_t* row = F.PROJ() + (size_t)m * LDP;
#pragma unroll
        for (int g = 0; g < 4; ++g) {
            const int c = g * 512 + lane * 8;
            float y[8], z[8]; unpack8(*(const u32x4*)(row + C_XS + c), y); unpack8(*(const u32x4*)(row + C_Z + c), z);
            float ss = 0.f;
#pragma unroll
            for (int i = 0; i < 8; ++i) { y[i] *= siluf_(z[i]); ss += y[i] * y[i]; }
            const float r = rsqrtf(wave_sum(ss) * (1.0f / 512.0f) + EPS);
            const f32x4 g0 = *(const f32x4*)(gs + c), g1 = *(const f32x4*)(gs + c + 4);
#pragma unroll
            for (int i = 0; i < 4; ++i) { y[i] *= r * g0[i]; y[4 + i] *= r * g1[i]; }
            *(u32x4*)(row + C_XS + c) = pack8(y);
        }
#pragma unroll
        for (int hh = 0; hh < 2; ++hh) {
            const int c = hh * 512 + lane * 8;
            float o[8], gt[8]; unpack8(*(const u32x4*)(row + C_V + c), o); unpack8(*(const u32x4*)(row + C_GATE + c), gt);
            float ss = 0.f;
#pragma unroll
            for (int i = 0; i < 8; ++i) ss += o[i] * o[i];
            ss += __shfl_xor(ss, 1); ss += __shfl_xor(ss, 2); ss += __shfl_xor(ss, 4); ss += __shfl_xor(ss, 8);
            const float r = rsqrtf(ss * (1.0f / 128.0f) + EPS);
            const int e = (lane & 15) * 8;
            const f32x4 g0 = *(const f32x4*)(gg + e), g1 = *(const f32x4*)(gg + e + 4);
#pragma unroll
            for (int i = 0; i < 4; ++i) { o[i] = o[i] * r * g0[i] * siluf_(gt[i]); o[4 + i] = o[4 + i] * r * g1[i] * siluf_(gt[4 + i]); }
            *(u32x4*)(row + C_V + c) = pack8(o);
        }
    }
}

__device__ __forceinline__ void p12_final(Frame& F) {
    const int gw = blockIdx.x * NWAVES + F.wave, NGW = F.G * NWAVES, lane = F.lane;
    const float* gf = F.in[29];
    for (int m = gw; m < MTOT; m += NGW) {
        float* orow = F.out + (m < MPR ? O_Y + (size_t)m * D : O_YS + (size_t)(m - MPR) * D);
        const bf16_t* xrow = F.PROJ() + (size_t)m * LDP + C_K;
        const u32x4 xa = *(const u32x4*)(xrow + lane * 8), xb = *(const u32x4*)(xrow + 512 + lane * 8);
        const float r = rsqrtf(F.SS3()[m] * (1.0f / D) + EPS);
        float x[8];
        unpack8(xa, x);
        { const int c = lane * 8; const f32x4 g0 = *(const f32x4*)(gf + c), g1 = *(const f32x4*)(gf + c + 4);
          *(f32x4*)(orow + c) = (f32x4){x[0] * r * g0[0], x[1] * r * g0[1], x[2] * r * g0[2], x[3] * r * g0[3]}; *(f32x4*)(orow + c + 4) = (f32x4){x[4] * r * g1[0], x[5] * r * g1[1], x[6] * r * g1[2], x[7] * r * g1[3]}; }
        unpack8(xb, x);
        { const int c = 512 + lane * 8; const f32x4 g0 = *(const f32x4*)(gf + c), g1 = *(const f32x4*)(gf + c + 4);
          *(f32x4*)(orow + c) = (f32x4){x[0] * r * g0[0], x[1] * r * g0[1], x[2] * r * g0[2], x[3] * r * g0[3]}; *(f32x4*)(orow + c + 4) = (f32x4){x[4] * r * g1[0], x[5] * r * g1[1], x[6] * r * g1[2], x[7] * r * g1[3]}; }
    }
}

__global__ void __launch_bounds__(NWAVES * 64, 2) mega_fwd(Args args) {
    extern __shared__ __attribute__((aligned(16))) unsigned char lds_raw[];
    Frame F;
    F.lds = (LAS unsigned char*)lds_raw;
    F.tid = threadIdx.x; F.lane = F.tid & 63; F.wave = __builtin_amdgcn_readfirstlane(F.tid >> 6); F.G = gridDim.x;
    F.in = args.in;
    F.out = args.out; F.ws = args.ws;
    unsigned char* ws = args.ws;
    const int lo = args.ph_lo, hi = args.ph_hi;
#if MK_ONE_LAUNCH
    volatile LAS unsigned* MISC = (volatile LAS unsigned*)(F.lds + MISC_OFF);
    if (F.tid < 32) MISC[F.tid] = 0u;
    __syncthreads();
    XcdBarrier bar = xcd_barrier_post((unsigned*)(ws + WS_BAR), MISC + 8);
#ifdef PROBE_A
#define STAMP(k) do { if (blockIdx.x == 0 && F.tid == 0) MISC[16 + (k)] = (unsigned)__builtin_amdgcn_s_memrealtime(); } while (0)
#else
#define STAMP(k) do { } while (0)
#endif
#define SEAM(k) do { if (lo <= (k) && (k) + 1 < hi) xcd_barrier(bar); STAMP((k) + 1); } while (0)
#else
#define SEAM(k) do { } while (0)
#endif
#ifndef PHASE_MASK
#define PHASE_MASK 0xffff
#endif
#define IN(k) (((PHASE_MASK >> (k)) & 1) && lo <= (k) && (k) < hi)
#ifndef REP_PHASE
#define REP_PHASE -1
#endif
#define NREP(k) ((REP_PHASE == (k)) ? 2 : 1)
    const int bid = (int)blockIdx.x;
    typedef pg8::StaticOrder SO;
    STAMP(0);

    if (IN(0)) { p0_prologue(F, 0, bid * NWAVES + F.wave, F.G * NWAVES); SEAM(0); }
    if (IN(1)) {
        pg8::Gemm g{F.XN(), (const bf16_t*)(ws + WS_WIN), MP, NPROJ, D, D, D}; SO S; S.init(MP, NPROJ, F.G, bid);
        EpiInProj E{F.PROJ(), F.HALO(), F.SMALL(), F.in[10], F.in[11], F.in[16], (LAS float*)(F.lds + RT_OFF)};
        pg8::gemm_phase<EpiInProj, SO>(F.lds, g, S, E);
        {
            const int rem = S.nwg % F.G, nidle = rem ? F.G - rem : F.G, me = rem ? bid - rem : bid;
            if (me >= 0) p0_prologue(F, 1, me * NWAVES + F.wave, nidle * NWAVES);
        }
        SEAM(1);
    }
    if (IN(2)) { p2_conv(F); SEAM(2); }
    if (IN(3)) { p3_scan(F); SEAM(3); }
    if (IN(4)) { p3b_scan(F); SEAM(4); }
    if (IN(6)) {
        pg8::Gemm g{F.PROJ() + C_XS, (const bf16_t*)(ws + WS_WBS), MPR, D, 3072, LDP, 3072}; SO S; S.init(MPR, D, F.G, bid);
        LAS float* rt = (LAS float*)(F.lds + RT_OFF);
        { Unit u0; if (S.next(0, u0) && F.tid < 256) {
              const float* sy = (const float*)(ws + WS_SSY) + (size_t)(u0.pm * 256 + F.tid) * 4; const float* so = (const float*)(ws + WS_SSO) + (size_t)(u0.pm * 256 + F.tid) * 8;
              float ry[4], ro[8];
#pragma unroll
              for (int q = 0; q < 4; ++q) ry[q] = rsqrtf(sy[q] * (1.0f / 512.0f) + EPS);
#pragma unroll
              for (int q = 0; q < 8; ++q) ro[q] = rsqrtf(so[q] * (1.0f / 128.0f) + EPS);
              rt[F.tid] = ry[0] / ry[1]; rt[256 + F.tid] = ry[1] / ry[2]; rt[512 + F.tid] = ry[2] / ry[3]; rt[768 + F.tid] = ry[3] / ro[0];
#pragma unroll
              for (int q = 0; q < 7; ++q) rt[(4 + q) * 256 + F.tid] = ro[q] / ro[q + 1];
              rt[15 * 256 + F.tid] = ro[7]; }
          __syncthreads(); }
        EpiMixCat E{F.PROJ(), rt + 15 * 256};
        pg8::gemm_phase<EpiMixCat, SO>(F.lds, g, S, E);
        small_mix(F, (const bf16_t*)(ws + WS_WBS)); SEAM(7);
    }
    if (IN(8)) {
        pg8::Gemm g{F.PROJ() + C_Q, (const bf16_t*)(ws + WS_WOUT), MPR, D, D, LDP, D}; SO S; S.init(MPR, D, F.G, bid);
        EpiResid<0> E{F.PROJ(), F.in[0], F.in[1], 0, C_K, F.SS1()};
        pg8::gemm_phase<EpiResid<0>, SO>(F.lds, g, S, E);
        small_gemm(F, F.PROJ() + (size_t)MPR * LDP + C_Q, LDP, (const bf16_t*)(ws + WS_WOUT), D, D, D, QResid<0>{F.PROJ(), F.in[1], 0, C_K, F.SS1()}); SEAM(8);
    }
    if (IN(9)) {
        pg8::Gemm g{F.PROJ() + C_K, (const bf16_t*)(ws + WS_WFI), MP, 2 * DFF, D, LDP, D}; SO S; S.init(MP, 2 * DFF, F.G, bid);
        EpiSwiGLU E{F.PROJ(), F.SS1()};
        for (int rp = 0; rp < NREP(9); ++rp) { pg8::gemm_phase<EpiSwiGLU, SO>(F.lds, g, S, E); if (rp + 1 < NREP(9)) xcd_barrier(bar); } SEAM(9);
    }
    if (IN(10)) {
        pg8::Gemm g{F.PROJ() + C_XS, (const bf16_t*)(ws + WS_WFO), MPR, D, DFF, LDP, DFF}; SO S; S.init(MPR, D, F.G, bid);
        EpiResid<1> E{F.PROJ(), nullptr, nullptr, C_K, C_GATE, F.SS2()};
        pg8::gemm_phase<EpiResid<1>, SO>(F.lds, g, S, E);
        small_gemm(F, F.PROJ() + (size_t)MPR * LDP + C_XS, LDP, (const bf16_t*)(ws + WS_WFO), DFF, DFF, D, QResid<1>{F.PROJ(), nullptr, C_K, C_GATE, F.SS2()}); SEAM(10);
    }
    if (IN(11)) {
        pg8::Gemm g{F.PB(), (const bf16_t*)(ws + WS_WPP), MPR, D, 256, 256, 256}; SO S; S.init(MPR, D, F.G, bid);
        EpiPE E{F.PROJ()};
        pg8::gemm_phase<EpiPE, SO>(F.lds, g, S, E);
        STAMP(12);
    }
    if (IN(12)) {
        pg8::Gemm g{F.PROJ() + C_GATE, (const bf16_t*)(ws + WS_WPG), MPR, D, D, LDP, D}; SO S; S.init(MPR, D, F.G, bid);
        EpiX3 E{F.PROJ(), F.SS2(), F.SS3(), F.out, (unsigned*)(ws + WS_XCNT), (unsigned*)(ws + WS_BAR), F.in[29], (LAS float*)(F.lds + RT_OFF)};
        pg8::gemm_phase<EpiX3, SO>(F.lds, g, S, E);
        small_x3_final(F, F.PROJ() + (size_t)MPR * LDP + C_GATE, LDP, (const bf16_t*)(ws + WS_WPG), D, (const bf16_t*)(ws + WS_WPP), F.SS2(), F.SS3(), (unsigned*)(ws + WS_XCNT2), (unsigned*)(ws + WS_BAR));
    }
#ifdef PROBE_A
    STAMP(14);
    __syncthreads();
    if (blockIdx.x == 0) {
        const float tb = (float)(MISC[16 + PROBE_B] - MISC[16 + PROBE_A]) * 0.01f;
        const float sc = 1.0f + sqrtf(tb * PROBE_SCALE);
        for (int i = F.tid; i < 73728; i += NWAVES * 64) F.out[O_GCONVP + i] *= sc;
    }
#endif
#undef IN
#undef SEAM
}

constexpr int NPHASES = 14;

extern "C" void kernel_launch(void* const* d_in, const int* in_sizes, int n_in, void* d_out, int out_size, void* d_ws, size_t ws_size, hipStream_t stream) {
    static int grid = 0;
    if (grid == 0) {
        if (n_in != 30 || ws_size < WS_END) { fprintf(stderr, "kernel_launch: bad call: n_in %d ws %zu (need %zu)\n", n_in, ws_size, (size_t)WS_END); grid = -1; return; }
        int dev = 0, cus = 0, per_cu = 0;
        if (hipGetDevice(&dev) != hipSuccess || hipDeviceGetAttribute(&cus, hipDeviceAttributeMultiprocessorCount, dev) != hipSuccess) { grid = -1; return; }
        if (hipFuncSetAttribute((const void*)mega_fwd, hipFuncAttributeMaxDynamicSharedMemorySize, LDS_BYTES) != hipSuccess) { fprintf(stderr, "kernel_launch: hipFuncSetAttribute failed\n"); grid = -1; return; }
        if (hipOccupancyMaxActiveBlocksPerMultiprocessor(&per_cu, (const void*)mega_fwd, NWAVES * 64, LDS_BYTES) != hipSuccess || per_cu < 1) { fprintf(stderr, "kernel_launch: occupancy query says %d\n", per_cu); per_cu = 1; }
        (void)hipGetLastError();
        if (cus < 256) { fprintf(stderr, "kernel_launch: this kernel needs 256 CUs (one workgroup per CU, one 256x256 unit per workgroup in the N = 1024 GEMM phases); device has %d\n", cus); grid = -1; return; }
        grid = 256;
    }
    if (grid < 0) return;
    (void)hipMemsetAsync((char*)d_ws + WS_SSY, 0, SS2_BYTES + CTL_BYTES, stream);
    Args a{};
    for (int i = 0; i < 30; ++i) a.in[i] = (const float*)d_in[i];
    a.out = (float*)d_out; a.ws = (unsigned char*)d_ws;
#if MK_ONE_LAUNCH
    a.ph_lo = 0; a.ph_hi = NPHASES;
    void* kargs[] = {&a};
    hipError_t e = hipLaunchCooperativeKernel((const void*)mega_fwd, dim3(grid), dim3(NWAVES * 64), kargs, LDS_BYTES, stream);
    if (e != hipSuccess) fprintf(stderr, "cooperative launch failed: %s (grid %d)\n", hipGetErrorString(e), grid);
#else
    for (int ph = 0; ph < NPHASES; ++ph) {
        a.ph_lo = ph; a.ph_hi = ph + 1;
        hipLaunchKernelGGL(mega_fwd, dim3(grid), dim3(NWAVES * 64), LDS_BYTES, stream, a);
    }
#endif
}
```

```cpp
#include <hip/hip_runtime.h>
#include <hip/hip_cooperative_groups.h>
#include <cstdio>
#include <cstdint>
namespace cg = cooperative_groups;

#define PROBE_SCALE 1e-6f
#ifndef MK_ONE_LAUNCH
#define MK_ONE_LAUNCH 1
#endif

#define LAS __attribute__((address_space(3)))
typedef unsigned short bf16_t;
typedef short bf16x8 __attribute__((ext_vector_type(8)));
typedef float f32x4 __attribute__((ext_vector_type(4)));
typedef float f32x2 __attribute__((ext_vector_type(2)));
typedef unsigned u32x4 __attribute__((ext_vector_type(4)));
typedef unsigned u32x2 __attribute__((ext_vector_type(2)));

constexpr int D = 1024, SEQ = 2048, NBATCH = 8, MPR = NBATCH * SEQ, NSMP = 128, MTOT = MPR + NSMP, MP = 16640;
constexpr int LDP = 11264, LDF = LDP / 2;
constexpr int C_Z = 0, C_XS = 2048, C_B = 4096, C_C = 4608, C_Q = 5120, C_K = 6144, C_V = 7168, C_GATE = 8192, C_MG = 9216;
constexpr int NIN = 11312;
constexpr int NPROJ = 11520;
constexpr int DFF = 2816;
constexpr float EPS = 1e-6f;
constexpr int CONV_FUSE_LO = 8, CONV_FUSE_HI = 32;
constexpr int NCH = 6144;

constexpr size_t O_Y = 0, O_YS = 16777216, O_SSMP = 16908288, O_SCONVP = 19005440, O_GDNP = 19079168, O_GCONVP = 20127744,
                 O_SSMS = 20201472, O_SCONVS = 53755904, O_GDNS = 54935552, O_GCONVS = 71712768;

constexpr int RT_OFF = 132096;
constexpr size_t MiB = 1u << 20;
constexpr size_t WS_CTL = 502 * MiB, CTL_BYTES = 1 * MiB;
constexpr size_t WS_BAR = WS_CTL + 16384;
constexpr size_t WS_XCNT = WS_CTL + 32768, WS_XCNT2 = WS_CTL + 49152;
constexpr size_t WS_SS1 = WS_CTL + 65536, WS_SS2 = WS_SS1 + 69632, WS_SS3 = WS_SS2 + 69632;
constexpr size_t WS_WIN = 1 * MiB, WS_WBS = 25 * MiB, WS_WBG = 29 * MiB, WS_WOUT = 31 * MiB, WS_WFI = 33 * MiB, WS_WFO = 44 * MiB, WS_WPG = 50 * MiB, WS_WPP = 52 * MiB;
constexpr size_t WS_XN = 53 * MiB, WS_PB = 86 * MiB, WS_SMALL = 95 * MiB, WS_HALO = 100 * MiB, WS_PROJ = 110 * MiB;
constexpr size_t WS_END0 = WS_PROJ + (size_t)MP * LDP * 2;
constexpr size_t WS_WT = WS_XN, WS_QKM = WS_WIN, WS_UT = 468 * MiB, WS_GC = 500 * MiB;
constexpr size_t WS_SSY = 501 * MiB, WS_SSO = WS_SSY + 512 * 1024, SS2_BYTES = 1024 * 1024;
constexpr size_t WS_END = WS_CTL + CTL_BYTES;
static_assert(WS_SSY + SS2_BYTES == WS_CTL, "one memset region");
static_assert(WS_END0 <= WS_UT && WS_UT + 32 * MiB <= WS_GC, "ws map 2");
static_assert(WS_END <= 512 * MiB, "ws map");
static_assert(WS_SS3 + 69632 <= WS_CTL + CTL_BYTES, "ctl");

typedef __bf16 bf16x2_t __attribute__((ext_vector_type(2)));
__device__ __forceinline__ unsigned cvt_pk_bf16(float lo, float hi) { const f32x2 v = {lo, hi}; const bf16x2_t b = __builtin_convertvector(v, bf16x2_t); return __builtin_bit_cast(unsigned, b); }
__device__ __forceinline__ float bflo(unsigned w) { return __uint_as_float(w << 16); }
__device__ __forceinline__ float bfhi(unsigned w) { return __uint_as_float(w & 0xffff0000u); }
__device__ __forceinline__ float bf2f(bf16_t b) { return __uint_as_float((unsigned)b << 16); }
__device__ __forceinline__ void unpack8(const u32x4 w, float (&f)[8]) { f[0] = bflo(w.x); f[1] = bfhi(w.x); f[2] = bflo(w.y); f[3] = bfhi(w.y); f[4] = bflo(w.z); f[5] = bfhi(w.z); f[6] = bflo(w.w); f[7] = bfhi(w.w); }
__device__ __forceinline__ u32x4 pack8(const float (&f)[8]) { u32x4 w; w.x = cvt_pk_bf16(f[0], f[1]); w.y = cvt_pk_bf16(f[2], f[3]); w.z = cvt_pk_bf16(f[4], f[5]); w.w = cvt_pk_bf16(f[6], f[7]); return w; }
__device__ __forceinline__ float sigmoidf_(float x) { return __builtin_amdgcn_rcpf(1.0f + __builtin_amdgcn_exp2f(-1.4426950408889634f * x)); }
__device__ __forceinline__ float siluf_(float x) { return x * sigmoidf_(x); }
__device__ __forceinline__ float softplusf_(float x) { return x > 20.f ? x : log1pf(__expf(x)); }
template <int CTRL> __device__ __forceinline__ float dpp_mov(float v) { return __builtin_bit_cast(float, __builtin_amdgcn_update_dpp(0, __builtin_bit_cast(int, v), CTRL, 0xF, 0xF, true)); }
template <int J> __device__ __forceinline__ float dpp_prev(float x, float pv) {
    int t = __builtin_amdgcn_update_dpp(0, __builtin_bit_cast(int, pv), 0x120 + J, 0xF, 0xF, true);
    t = __builtin_amdgcn_update_dpp(t, __builtin_bit_cast(int, x), 0x110 + J, 0xF, 0xF, false);
    return __builtin_bit_cast(float, t);
}
__device__ __forceinline__ float row16_sum(float v) {
    v += dpp_mov<0xB1>(v);
    v += dpp_mov<0x4E>(v);
    v += dpp_mov<0x124>(v);
    v += dpp_mov<0x128>(v);
    return v;
}
__device__ __forceinline__ float wave_incl_scan(float v) {
    v += __builtin_bit_cast(float, __builtin_amdgcn_update_dpp(0, __builtin_bit_cast(int, v), 0x111, 0xF, 0xF, true));
    v += __builtin_bit_cast(float, __builtin_amdgcn_update_dpp(0, __builtin_bit_cast(int, v), 0x112, 0xF, 0xF, true));
    v += __builtin_bit_cast(float, __builtin_amdgcn_update_dpp(0, __builtin_bit_cast(int, v), 0x114, 0xF, 0xF, true));
    v += __builtin_bit_cast(float, __builtin_amdgcn_update_dpp(0, __builtin_bit_cast(int, v), 0x118, 0xF, 0xF, true));
    v += __builtin_bit_cast(float, __builtin_amdgcn_update_dpp(0, __builtin_bit_cast(int, v), 0x142, 0xA, 0xF, false));
    v += __builtin_bit_cast(float, __builtin_amdgcn_update_dpp(0, __builtin_bit_cast(int, v), 0x143, 0xC, 0xF, false));
    return v;
}
__device__ __forceinline__ float xor16_sum(float x) { auto s = __builtin_amdgcn_permlane16_swap(__float_as_uint(x), __float_as_uint(x), false, false); return __uint_as_float(s[0]) + __uint_as_float(s[1]); }
__device__ __forceinline__ float xor32_sum(float x) { auto s = __builtin_amdgcn_permlane32_swap(__float_as_uint(x), __float_as_uint(x), false, false); return __uint_as_float(s[0]) + __uint_as_float(s[1]); }
__device__ __forceinline__ float xrow16_sum(float x) { return xor32_sum(xor16_sum(x)); }
__device__ __forceinline__ float wave_sum(float v) {
    return xrow16_sum(row16_sum(v));
    return v;
}

namespace pg8 {
constexpr int BM = 256, BK = 64, HALF = 128, HTB = HALF * BK * 2, STAGE_BYTES = 8 * HTB, NXCD = 8, WGM = 8;
__host__ __device__ __forceinline__ int lds_byte(int r, int c) { const int st = (r >> 4) * 2 + (c >> 5), rr = r & 15, cc = c & 31, ob = rr * 64 + cc * 2; return st * 1024 + (ob ^ (((ob >> 9) & 1) << 5)); }
__host__ __device__ __forceinline__ void stage_rc(int b, int& R, int& C) { const int st = b / 1024, sb = b % 1024, swz = sb ^ (((sb >> 9) & 1) << 5); R = (st >> 1) * 16 + swz / 64; C = (st & 1) * 32 + (swz % 64) / 2; }
__host__ __device__ __forceinline__ int perm32(int rho) { const int n = rho >> 4, i = rho & 15; return 8 * (i >> 2) + 4 * n + (i & 3); }

struct Unit { int pm, pn; };
struct Gemm { const bf16_t* A; const bf16_t* Bt; int M, N, K, lda, ldb; };

struct StaticOrder {
    int nM, nN, nwg, G, c;
    __host__ __device__ __forceinline__ void init(int M, int N, int G_, int c_) { nM = M / BM; nN = N / BM; nwg = nM * nN; G = G_; c = c_; }
    __host__ __device__ __forceinline__ bool next(int i, Unit& u) const {
        const long L = (long)i * G + c; if (L >= nwg) return false;
        int wgid = (int)L; { const int q = nwg / NXCD, r = nwg % NXCD, xcd = wgid % NXCD, off = wgid / NXCD; wgid = (xcd < r ? xcd * (q + 1) : r * (q + 1) + (xcd - r) * q) + off; }
        const int nig = WGM * nN, gid = wgid / nig, fm = gid * WGM, gsz = (nM - fm) < WGM ? (nM - fm) : WGM;
        u.pm = fm + ((wgid % nig) % gsz); u.pn = (wgid % nig) / gsz; return true;
    }
    __device__ __forceinline__ void a_ready(const Unit&) const {}
    __device__ __forceinline__ void done(const Unit&) const {}
};

template <class Epi, class Sched, bool ALIGN_EPI = true, bool SP2 = true>
__device__ __forceinline__ void gemm_phase(LAS unsigned char* lds, const Gemm g, const Sched& S, const Epi& E) {
    const int tid = threadIdx.x, wid = __builtin_amdgcn_readfirstlane(tid >> 6), lane = tid & 63, wr = wid >> 2, wc = wid & 3, fr = lane & 15, fq = lane >> 4;
    int nt = g.K / BK / Epi::NSEG; asm volatile("" : "+s"(nt));
    unsigned voffA, voffB;
    { int R, C; stage_rc(tid * 16, R, C); const int Rb = Epi::PERM ? ((R & ~31) + perm32(R & 31)) : R;
      voffA = (unsigned)(R * g.lda + C) * 2u; voffB = (unsigned)(Rb * g.ldb + C) * 2u; }
    const size_t s64A = (size_t)64 * g.lda * 2, s64B = (size_t)64 * g.ldb * 2;
    const size_t kstep = (size_t)(BK * 2);
    const size_t hstepA = (size_t)HALF * g.lda * 2, hstepB = (size_t)HALF * g.ldb * 2;
    const size_t tstepA = 2 * hstepA, tstepB = 2 * hstepB;
    const unsigned ldsw = (unsigned)wid * 1024u;
    const int aoff = lds_byte(wr * 64 + fr, fq * 8), boff = lds_byte(wc * 32 + fr, fq * 8);
#define PG8_SA(b, h) (((b) * 2 + (h)) * HTB)
#define PG8_SB(b, h) ((4 + (b) * 2 + (h)) * HTB)
#define PG8_STAGE(bufoff, gbase, voff) do { _Pragma("unroll") for (int _i = 0; _i < 2; ++_i) \
        __builtin_amdgcn_global_load_lds((const unsigned*)((const char*)(gbase) + (size_t)_i * (voff##_s64) + (voff)), (LAS unsigned*)(lds + (bufoff) + ldsw + _i * 8192), 16, 0, 0); } while (0)
#define voffA_s64 s64A
#define voffB_s64 s64B
#define PG8_LDA(dst, b, h) do { _Pragma("unroll") for (int m = 0; m < 4; ++m) _Pragma("unroll") for (int k = 0; k < 2; ++k) dst[m][k] = *(const LAS bf16x8*)(lds + PG8_SA(b, h) + aoff + m * 2048 + k * 1024); } while (0)
#define PG8_LDB(dst, b, h) do { _Pragma("unroll") for (int n = 0; n < 2; ++n) _Pragma("unroll") for (int k = 0; k < 2; ++k) dst[n][k] = *(const LAS bf16x8*)(lds + PG8_SB(b, h) + boff + n * 2048 + k * 1024); } while (0)
#define PG8_MMA(ai, bj, At, Bt) do { __builtin_amdgcn_s_setprio(1); _Pragma("unroll") for (int m = 0; m < 4; ++m) _Pragma("unroll") for (int n = 0; n < 2; ++n) _Pragma("unroll") for (int k = 0; k < 2; ++k) \
        acc[ai][bj][m][n] = __builtin_amdgcn_mfma_f32_16x16x32_bf16(Bt[n][k], At[m][k], acc[ai][bj][m][n], 0, 0, 0); __builtin_amdgcn_s_setprio(0); } while (0)
#define PG8_WAIT_V(n) asm volatile("s_waitcnt vmcnt(" #n ")" ::: "memory")
#define PG8_WAIT_L(n) asm volatile("s_waitcnt lgkmcnt(" #n ")" ::: "memory")
#define PG8_BAR __builtin_amdgcn_s_barrier()
#define PG8_SCHED __builtin_amdgcn_sched_barrier(0)
    Unit cur, nxt; int ui = 0;
    if (!S.next(0, cur)) return;
    int upar = 0; if constexpr (Epi::PREF) E.prefetch(cur, 0);
    f32x4 acc[2][2][4][2];
#pragma unroll
    for (int a = 0; a < 2; ++a)
#pragma unroll
        for (int b = 0; b < 2; ++b)
#pragma unroll
            for (int m = 0; m < 4; ++m)
#pragma unroll
                for (int n = 0; n < 2; ++n) acc[a][b][m][n] = (f32x4){0.f, 0.f, 0.f, 0.f};
    bf16x8 At[4][2], B0[2][2], B1[2][2];
    const char* cA = (const char*)g.A + (size_t)cur.pm * tstepA; const char* cB = (const char*)g.Bt + (size_t)cur.pn * tstepB;
    S.a_ready(cur);
    if constexpr (SP2) {
        PG8_STAGE(PG8_SB(0, 0), cB, voffB); PG8_STAGE(PG8_SB(0, 1), cB + hstepB, voffB); PG8_STAGE(PG8_SA(0, 0), cA, voffA); PG8_STAGE(PG8_SA(0, 1), cA + hstepA, voffA);
        if (wr == 1) PG8_BAR;
        PG8_WAIT_V(2); PG8_BAR;
        PG8_STAGE(PG8_SB(1, 0), cB + kstep, voffB); PG8_STAGE(PG8_SA(1, 0), cA + kstep, voffA); PG8_STAGE(PG8_SB(1, 1), cB + hstepB + kstep, voffB);
        PG8_WAIT_V(6); PG8_BAR;
    } else {
        PG8_STAGE(PG8_SB(0, 0), cB, voffB); PG8_STAGE(PG8_SA(0, 0), cA, voffA); PG8_STAGE(PG8_SB(0, 1), cB + hstepB, voffB); PG8_STAGE(PG8_SA(0, 1), cA + hstepA, voffA);
        if (wr == 1) PG8_BAR;
        PG8_WAIT_V(4); PG8_BAR;
        PG8_STAGE(PG8_SB(1, 0), cB + kstep, voffB); PG8_STAGE(PG8_SA(1, 0), cA + kstep, voffA); PG8_STAGE(PG8_SB(1, 1), cB + hstepB + kstep, voffB);
        PG8_WAIT_V(6); PG8_BAR;
    }
    for (;;) {
        const bool has_next = S.next(ui + 1, nxt);
        const char* uA = has_next ? (const char*)g.A + (size_t)nxt.pm * tstepA : cA; const char* uB = has_next ? (const char*)g.Bt + (size_t)nxt.pn * tstepB : cB;
        const char* sA = cA; const char* sB = cB;
#pragma unroll
        for (int part = 0; part < Epi::NPART; ++part) {
        const int seg0 = part == 0 ? 0 : Epi::SPLIT, seg1 = part == Epi::NPART - 1 ? Epi::NSEG : Epi::SPLIT;
#pragma nounroll
        for (int seg = seg0; seg < seg1; ++seg) {
        const bool lastseg = (seg == Epi::NSEG - 1);
        int ntc = nt; if constexpr (Epi::NSEG == 12) ntc = seg < 4 ? 8 : 2;
        const char* nA = lastseg ? uA : sA + (size_t)ntc * kstep; const char* nB = lastseg ? uB : sB + (size_t)ntc * kstep;
        for (int t = 0; t < ntc; t += 2) {
            const bool last = (t == ntc - 2);
            const char* a1 = sA + (size_t)(t + 1) * kstep;
            const char* a2 = last ? nA : sA + (size_t)(t + 2) * kstep; const char* b2 = last ? nB : sB + (size_t)(t + 2) * kstep;
            const char* a3 = a2 + kstep; const char* b3 = b2 + kstep;
            if (last && lastseg && has_next) S.a_ready(nxt);
            if constexpr (SP2) {
            PG8_LDB(B0, 0, 0); PG8_LDB(B1, 0, 1); PG8_SCHED; PG8_LDA(At, 0, 0); PG8_STAGE(PG8_SA(1, 1), a1 + hstepA, voffA);
            PG8_WAIT_V(8); PG8_WAIT_L(0); PG8_BAR; PG8_MMA(0, 0, At, B0); PG8_MMA(0, 1, At, B1); PG8_BAR; PG8_SCHED;
            PG8_LDA(At, 0, 1); PG8_STAGE(PG8_SB(0, 0), b2, voffB); PG8_STAGE(PG8_SB(0, 1), b2 + hstepB, voffB); PG8_STAGE(PG8_SA(0, 0), a2, voffA);
            PG8_WAIT_V(8); PG8_WAIT_L(0); PG8_BAR; PG8_MMA(1, 0, At, B0); PG8_MMA(1, 1, At, B1); PG8_BAR; PG8_SCHED;
            PG8_LDB(B0, 1, 0); PG8_LDB(B1, 1, 1); PG8_SCHED; PG8_LDA(At, 1, 0); PG8_STAGE(PG8_SA(0, 1), a2 + hstepA, voffA);
            PG8_WAIT_V(8); PG8_WAIT_L(0); PG8_BAR; PG8_MMA(0, 0, At, B0); PG8_MMA(0, 1, At, B1); PG8_BAR; PG8_SCHED;
            PG8_LDA(At, 1, 1); PG8_STAGE(PG8_SB(1, 0), b3, voffB); PG8_STAGE(PG8_SB(1, 1), b3 + hstepB, voffB); PG8_STAGE(PG8_SA(1, 0), a3, voffA);
            PG8_WAIT_V(8); PG8_WAIT_L(0); PG8_BAR; PG8_MMA(1, 0, At, B0); PG8_MMA(1, 1, At, B1); PG8_BAR; PG8_SCHED;
            } else {
            PG8_LDB(B0, 0, 0); PG8_SCHED; PG8_LDA(At, 0, 0); PG8_STAGE(PG8_SA(1, 1), a1 + hstepA, voffA);
            PG8_WAIT_L(8); PG8_BAR; PG8_WAIT_L(0); PG8_MMA(0, 0, At, B0); PG8_BAR; PG8_SCHED;
            PG8_LDB(B1, 0, 1); PG8_STAGE(PG8_SB(0, 0), b2, voffB);
            PG8_BAR; PG8_WAIT_L(0); PG8_MMA(0, 1, At, B1); PG8_BAR;
            PG8_LDA(At, 0, 1); PG8_STAGE(PG8_SA(0, 0), a2, voffA);
            PG8_BAR; PG8_WAIT_L(0); PG8_MMA(1, 0, At, B0); PG8_BAR; PG8_SCHED;
            PG8_STAGE(PG8_SB(0, 1), b2 + hstepB, voffB);
            PG8_WAIT_V(6); PG8_BAR; PG8_MMA(1, 1, At, B1); PG8_BAR;
            PG8_LDB(B0, 1, 0); PG8_SCHED; PG8_LDA(At, 1, 0); PG8_STAGE(PG8_SA(0, 1), a2 + hstepA, voffA);
            PG8_WAIT_L(8); PG8_BAR; PG8_WAIT_L(0); PG8_MMA(0, 0, At, B0); PG8_BAR; PG8_SCHED;
            PG8_LDB(B1, 1, 1); PG8_STAGE(PG8_SB(1, 0), b3, voffB);
            PG8_BAR; PG8_WAIT_L(0); PG8_MMA(0, 1, At, B1); PG8_BAR;
            PG8_LDA(At, 1, 1); PG8_STAGE(PG8_SA(1, 0), a3, voffA);
            PG8_BAR; PG8_WAIT_L(0); PG8_MMA(1, 0, At, B0); PG8_BAR; PG8_SCHED;
            PG8_STAGE(PG8_SB(1, 1), b3 + hstepB, voffB);
            PG8_WAIT_V(6); PG8_BAR; PG8_MMA(1, 1, At, B1); PG8_BAR;
            }
        }
        if constexpr (Epi::NSEG > 1) { if (!lastseg) { if (seg != seg1 - 1) E.khook(acc, seg, cur, wr, wc, fr, fq, (LAS const float*)(lds + RT_OFF)); sA = nA; sB = nB; } }
        }
        if constexpr (Epi::NPART > 1) { if (part + 1 < Epi::NPART) { __builtin_amdgcn_sched_barrier(0); E.parthook(acc, cur, wr, wc, fr, fq, (LAS const float*)(lds + RT_OFF)); __builtin_amdgcn_sched_barrier(0); } }
        }
        if constexpr (ALIGN_EPI) { if (wr == 0) PG8_BAR; }
        if constexpr (Epi::PREF) E.par = upar;
        E(acc, cur, wr, wc, fr, fq); S.done(cur);
        if constexpr (Epi::PREF) { if (has_next) E.prefetch(nxt, upar ^ 1); upar ^= 1; }
        if (!has_next) break;
#pragma unroll
        for (int a = 0; a < 2; ++a)
#pragma unroll
            for (int b = 0; b < 2; ++b)
#pragma unroll
                for (int m = 0; m < 4; ++m)
#pragma unroll
                    for (int n = 0; n < 2; ++n) acc[a][b][m][n] = (f32x4){0.f, 0.f, 0.f, 0.f};
        cur = nxt; cA = uA; cB = uB; ++ui;
        if constexpr (ALIGN_EPI) { if (wr == 1) PG8_BAR; }
    }
    PG8_WAIT_V(0);
    if constexpr (!ALIGN_EPI) { if (wr == 0) PG8_BAR; }
    PG8_BAR;
#undef PG8_SA
#undef PG8_SB
#undef PG8_STAGE
#undef voffA_s64
#undef voffB_s64
#undef PG8_LDA
#undef PG8_LDB
#undef PG8_MMA
#undef PG8_WAIT_V
#undef PG8_WAIT_L
#undef PG8_BAR
#undef PG8_SCHED
}
}
using pg8::Unit;


#define XB_TMO      128
#define XB_XCNT(j)  (256  + 64 * (j))
#define XB_XSUB(j)  (1280 + 64 * (j))
#define XB_XGEN(j)  (2304 + 64 * (j))
#define XB_TOP      3328
#define XB_TOPGEN   3392
#define XCD_BAR_WORDS 3456
#define XB_SPIN_CAP (1u << 22)
__device__ __forceinline__ unsigned xb_ld(unsigned* p)              { return __hip_atomic_load(p, __ATOMIC_RELAXED, __HIP_MEMORY_SCOPE_AGENT); }
__device__ __forceinline__ unsigned xb_add(unsigned* p, unsigned v) { return __hip_atomic_fetch_add(p, v, __ATOMIC_RELAXED, __HIP_MEMORY_SCOPE_AGENT); }
__device__ __forceinline__ unsigned xb_xcc_id() { return (unsigned)__builtin_amdgcn_s_getreg((3 << 11) | 20) & 0xFu; }
#define XB_SPIN(cond, bar) do { unsigned _sp = 0; while (cond) { __builtin_amdgcn_s_sleep(1); \
    if ((++_sp & 255u) == 0u) { if (xb_ld(&(bar)[XB_TMO])) break; if (_sp > XB_SPIN_CAP) { atomicAdd(&(bar)[XB_TMO], 1u); break; } } } } while (0)
struct XcdBarrier { unsigned* bar; unsigned x; volatile LAS unsigned* st; };
__device__ __forceinline__ XcdBarrier xcd_barrier_post(unsigned* bar, volatile LAS unsigned* st) {
    XcdBarrier b; b.bar = bar; b.x = xb_xcc_id(); b.st = st;
    if (threadIdx.x == 0) (void)xb_add(&bar[XB_XCNT(b.x)], 1u);
    return b;
}
__device__ __forceinline__ void xcd_barrier_complete(unsigned* bar, unsigned x, unsigned& nloc, unsigned& nx) {
    const unsigned G = gridDim.x * gridDim.y * gridDim.z;
    unsigned sum, cnt, mine, sp = 0u;
    for (;;) {
        sum = 0u; cnt = 0u; mine = 0u;
#pragma unroll
        for (unsigned j = 0; j < 16; ++j) { const unsigned c = xb_ld(&bar[XB_XCNT(j)]); sum += c; cnt += (c > 0u) ? 1u : 0u; mine = (j == x) ? c : mine; }
        if (sum == G) break;
        __builtin_amdgcn_s_sleep(1);
        if ((++sp & 255u) == 0u) { if (xb_ld(&bar[XB_TMO])) break; if (sp > XB_SPIN_CAP) { atomicAdd(&bar[XB_TMO], 1u); break; } }
    }
    nloc = mine > 0u ? mine : 1u; nx = cnt > 0u ? cnt : 1u;
}
__device__ __forceinline__ void xcd_barrier(const XcdBarrier& b) {
    asm volatile("s_waitcnt vmcnt(0)" ::: "memory");
    __syncthreads();
    if (threadIdx.x == 0) {
        unsigned* bar = b.bar;
        __builtin_amdgcn_s_waitcnt(0);
        unsigned nloc = b.st[0], nx = b.st[1];
        if (nloc == 0u) { xcd_barrier_complete(bar, b.x, nloc, nx); b.st[0] = nloc; b.st[1] = nx; }
        const unsigned old = xb_add(&bar[XB_XSUB(b.x)], 1u);
        const unsigned gen = old / nloc;
        if (old + 1u == (gen + 1u) * nloc) {
            __builtin_amdgcn_fence(__ATOMIC_RELEASE, "agent");
            asm volatile("s_waitcnt vmcnt(0)" ::: "memory");
            const unsigned og = xb_add(&bar[XB_TOP], 1u);
            const unsigned tg = og / nx;
            if (og + 1u == (tg + 1u) * nx) xb_add(&bar[XB_TOPGEN], 1u);
            else XB_SPIN(xb_ld(&bar[XB_TOPGEN]) == tg, bar);
            __builtin_amdgcn_fence(__ATOMIC_ACQUIRE, "agent");
            xb_add(&bar[XB_XGEN(b.x)], 1u);
            asm volatile("s_waitcnt vmcnt(0)" ::: "memory");
        } else {
            XB_SPIN(xb_ld(&bar[XB_XGEN(b.x)]) == gen, bar);
            __builtin_amdgcn_fence(__ATOMIC_ACQUIRE, "agent");
            asm volatile("s_waitcnt vmcnt(0)" ::: "memory");
        }
    }
    __syncthreads();
}

struct Args {
    const float* in[30];
    float* out;
    unsigned char* ws;
    int ph_lo, ph_hi;
};

struct Frame {
    LAS unsigned char* lds;
    int tid, lane, wave, G;
    const float* const* in;
    float* out;
    unsigned char* ws;
    __device__ __forceinline__ bf16_t* PROJ() const { return (bf16_t*)(ws + WS_PROJ); }
    __device__ __forceinline__ bf16_t* HALO() const { return (bf16_t*)(ws + WS_HALO); }
    __device__ __forceinline__ float* SMALL() const { return (float*)(ws + WS_SMALL); }
    __device__ __forceinline__ bf16_t* XN() const { return (bf16_t*)(ws + WS_XN); }
    __device__ __forceinline__ bf16_t* PB() const { return (bf16_t*)(ws + WS_PB); }
    __device__ __forceinline__ float* SS1() const { return (float*)(ws + WS_SS1); }
    __device__ __forceinline__ float* SS2() const { return (float*)(ws + WS_SS2); }
    __device__ __forceinline__ float* SS3() const { return (float*)(ws + WS_SS3); }
};

constexpr int NWAVES = 8;
constexpr int RING_BYTES = 131072, LDS_BYTES = 162816, MISC_OFF = LDS_BYTES - 1024;

struct EpiInProj {
    static constexpr bool PERM = true; static constexpr int NSEG = 1; static constexpr int NPART = 1, SPLIT = 0; static constexpr bool PREF = true;
    bf16_t* PROJ; bf16_t* HALO; float* SMALL; const float* cws; const float* cbs; const float* cwg; mutable int par; LAS float* nt_;
    __device__ __forceinline__ void prefetch(const Unit& n, int p) const {
        if (n.pn >= CONV_FUSE_LO && n.pn < CONV_FUSE_HI && n.pm < MPR / 256) {
            const int w = __builtin_amdgcn_readfirstlane((int)threadIdx.x >> 6), lane = (int)threadIdx.x & 63;
            const bool is_ssm = n.pn < 20;
            if (w < 4 || (w == 4 && is_ssm)) {
                const int tc0 = n.pn * 256 - C_XS - (is_ssm ? 0 : 3072);
                const float* src = (w < 4 ? (is_ssm ? cws : cwg) + w * 3072 : cbs) + tc0 + lane * 4;
                __builtin_amdgcn_global_load_lds((const unsigned*)src, (LAS unsigned*)(nt_ + 2048 + p * 1280 + w * 256), 16, 0, 0);
            }
        }
    }
    __device__ __forceinline__ void operator()(const f32x4 (&acc)[2][2][4][2], const Unit& u, int wr, int wc, int fr, int fq) const {
        const int row0 = u.pm * 256 + wr * 64 + fr;
        if (u.pn >= CONV_FUSE_LO && u.pn < CONV_FUSE_HI && u.pm < MPR / 256) {
            f32x4 (&av)[2][2][4][2] = const_cast<f32x4 (&)[2][2][4][2]>(acc);
            const bool is_ssm = u.pn < 20, nrm = u.pn >= 20 && u.pn < 28;
            const int col0 = u.pn * 256 + wc * 32 + 8 * fq, cc0 = col0 - C_XS, wc0 = is_ssm ? cc0 : cc0 - 3072;
            (void)wc0;
            LAS const float* cwl = nt_ + 2048 + par * 1280;
#pragma unroll
            for (int bj = 0; bj < 2; ++bj) {
                float w0[8], w1[8], w2[8], w3[8], bs[8];
                { LAS const float* wp = cwl + wc * 32 + 8 * fq + bj * 128;
#pragma unroll
                  for (int h = 0; h < 2; ++h) { const f32x4 a0 = *(LAS const f32x4*)(wp + 4 * h), a1 = *(LAS const f32x4*)(wp + 256 + 4 * h), a2 = *(LAS const f32x4*)(wp + 512 + 4 * h), a3 = *(LAS const f32x4*)(wp + 768 + 4 * h);
                      f32x4 bb = (f32x4){0.f, 0.f, 0.f, 0.f}; if (is_ssm) bb = *(LAS const f32x4*)(wp + 1024 + 4 * h);
#pragma unroll
                      for (int i = 0; i < 4; ++i) { w0[4 * h + i] = a0[i]; w1[4 * h + i] = a1[i]; w2[4 * h + i] = a2[i]; w3[4 * h + i] = a3[i]; bs[4 * h + i] = bb[i]; } } }
#pragma unroll
                for (int ai = 0; ai < 2; ++ai)
#pragma unroll
                    for (int mm = 0; mm < 4; ++mm) {
                        const int m = 3 - mm, mp = m > 0 ? m - 1 : 0;
                        const int row = row0 + ai * 128 + m * 16;
                        if (m == 3) {
                            const f32x4 v0 = av[ai][bj][3][0], v1 = av[ai][bj][3][1];
                            u32x4 w; w.x = cvt_pk_bf16(v0[0], v0[1]); w.y = cvt_pk_bf16(v0[2], v0[3]); w.z = cvt_pk_bf16(v1[0], v1[1]); w.w = cvt_pk_bf16(v1[2], v1[3]);
                            if (fr >= 13) *(u32x4*)(HALO + ((size_t)(row >> 6) * 3 + (fr - 13)) * NCH + cc0 + bj * 128) = w;
                        }
                        float o[8], ss = 0.f;
#pragma unroll
                        for (int e = 0; e < 8; ++e) {
                            const float x = av[ai][bj][m][e >> 2][e & 3], pv = av[ai][bj][mp][e >> 2][e & 3];
                            const float t1 = dpp_prev<1>(x, pv), t2 = dpp_prev<2>(x, pv), t3 = dpp_prev<3>(x, pv);
                            float v = w3[e] * x + bs[e]; v += w2[e] * t1; v += w1[e] * t2; v += w0[e] * t3;
                            v = siluf_(v); ss += v * v;
                            o[e] = (m == 0 && fr < 3) ? x : v;
                        }
                        if (nrm) {
                            av[ai][bj][m][0] = (f32x4){o[0], o[1], o[2], o[3]}; av[ai][bj][m][1] = (f32x4){o[4], o[5], o[6], o[7]};
                            ss = xrow16_sum(ss);
                            if (fq == 0) nt_[((ai * 128 + wr * 64 + m * 16 + fr) * 2 + bj) * 4 + wc] = ss;
                        } else __builtin_nontemporal_store(pack8(o), (u32x4*)(PROJ + (size_t)row * LDP + col0 + bj * 128));
                    }
            }
            if (nrm) {
                asm volatile("s_waitcnt lgkmcnt(0)" ::: "memory"); __builtin_amdgcn_s_barrier(); asm volatile("" ::: "memory");
                const float qs = u.pn < 24 ? 0.08838834764831845f : 1.0f;
#pragma unroll
                for (int ai = 0; ai < 2; ++ai)
#pragma unroll
                    for (int m = 0; m < 4; ++m) {
                        const int rl = ai * 128 + wr * 64 + m * 16 + fr;
#pragma unroll
                        for (int bj = 0; bj < 2; ++bj) {
                            const f32x4 pq = *(LAS const f32x4*)(nt_ + (rl * 2 + bj) * 4);
                            float rn = rsqrtf((pq[0] + pq[1]) + (pq[2] + pq[3]) + EPS) * qs;
                            if (m == 0 && fr < 3) rn = 1.0f;
                            const f32x4 v0 = av[ai][bj][m][0] * rn, v1 = av[ai][bj][m][1] * rn;
                            u32x4 w; w.x = cvt_pk_bf16(v0[0], v0[1]); w.y = cvt_pk_bf16(v0[2], v0[3]); w.z = cvt_pk_bf16(v1[0], v1[1]); w.w = cvt_pk_bf16(v1[2], v1[3]);
                            __builtin_nontemporal_store(w, (u32x4*)(PROJ + (size_t)(u.pm * 256 + rl) * LDP + col0 + bj * 128));
                        }
                    }
            }
        } else if (u.pn < 44) {
            const int col0 = u.pn * 256 + wc * 32 + 8 * fq;
            const bool conv_tile = (u.pn >= 8 && u.pn < 32);
#pragma unroll
            for (int ai = 0; ai < 2; ++ai)
#pragma unroll
                for (int m = 0; m < 4; ++m) {
                    const int row = row0 + ai * 128 + m * 16;
                    bf16_t* rowp = PROJ + (size_t)row * LDP + col0;
#pragma unroll
                    for (int bj = 0; bj < 2; ++bj) {
                        const f32x4 v0 = acc[ai][bj][m][0], v1 = acc[ai][bj][m][1];
                        u32x4 w; w.x = cvt_pk_bf16(v0[0], v0[1]); w.y = cvt_pk_bf16(v0[2], v0[3]); w.z = cvt_pk_bf16(v1[0], v1[1]); w.w = cvt_pk_bf16(v1[2], v1[3]);
                        __builtin_nontemporal_store(w, (u32x4*)(rowp + bj * 128));
                        if (m == 3 && conv_tile && fr >= 13) {
                            bf16_t* hp = HALO + ((size_t)(row >> 6) * 3 + (fr - 13)) * NCH + (col0 - C_XS) + bj * 128;
                            *(u32x4*)hp = w;
                        }
                    }
                }
        } else {
            if (wc < 2) {
                const int col0 = wc * 32 + 8 * fq;
#pragma unroll
                for (int ai = 0; ai < 2; ++ai)
#pragma unroll
                    for (int m = 0; m < 4; ++m) {
                        const int row = row0 + ai * 128 + m * 16;
                        float* sp = SMALL + (size_t)row * 64 + col0;
                        *(f32x4*)sp = acc[ai][0][m][0]; *(f32x4*)(sp + 4) = acc[ai][0][m][1];
                    }
            }
        }
    }
};

struct EpiT1 {
    static constexpr bool PERM = true; static constexpr int NSEG = 4; static constexpr int NPART = 1, SPLIT = 0; static constexpr bool PREF = false;
    bf16_t* PROJ; LAS const float* rl;
    __device__ __forceinline__ void khook(f32x4 (&acc)[2][2][4][2], int b, int wr, int fr, LAS const float* rt) const {
#pragma unroll
        for (int ai = 0; ai < 2; ++ai)
#pragma unroll
            for (int m = 0; m < 4; ++m) { const float rr = rt[b * 256 + ai * 128 + wr * 64 + m * 16 + fr];
#pragma unroll
                for (int bj = 0; bj < 2; ++bj) { acc[ai][bj][m][0] *= rr; acc[ai][bj][m][1] *= rr; } }
    }
    __device__ __forceinline__ void operator()(const f32x4 (&acc)[2][2][4][2], const Unit& u, int wr, int wc, int fr, int fq) const {
        const int row0 = u.pm * 256 + wr * 64 + fr, col0 = u.pn * 256 + wc * 32 + 8 * fq;
#pragma unroll
        for (int ai = 0; ai < 2; ++ai)
#pragma unroll
            for (int m = 0; m < 4; ++m) {
                const int row = row0 + ai * 128 + m * 16;
                const float rlast = rl[ai * 128 + wr * 64 + m * 16 + fr];
#pragma unroll
                for (int bj = 0; bj < 2; ++bj) {
                    const int col = col0 + bj * 128;
                    const u32x4 mgw = *(const u32x4*)(PROJ + (size_t)row * LDP + C_MG + col);
                    float mg[8]; unpack8(mgw, mg);
                    const f32x4 v0 = acc[ai][bj][m][0], v1 = acc[ai][bj][m][1];
                    float o[8];
#pragma unroll
                    for (int i = 0; i < 4; ++i) { o[i] = v0[i] * rlast * sigmoidf_(mg[i]); o[4 + i] = v1[i] * rlast * sigmoidf_(mg[4 + i]); }
                    *(u32x4*)(PROJ + (size_t)row * LDP + C_Z + col) = pack8(o);
                }
            }
    }
};

struct EpiMix {
    static constexpr bool PERM = true; static constexpr int NSEG = 8; static constexpr int NPART = 1, SPLIT = 0; static constexpr bool PREF = false;
    bf16_t* PROJ; LAS const float* rl;
    __device__ __forceinline__ void khook(f32x4 (&acc)[2][2][4][2], int b, int wr, int fr, LAS const float* rt) const {
#pragma unroll
        for (int ai = 0; ai < 2; ++ai)
#pragma unroll
            for (int m = 0; m < 4; ++m) { const float rr = rt[b * 256 + ai * 128 + wr * 64 + m * 16 + fr];
#pragma unroll
                for (int bj = 0; bj < 2; ++bj) { acc[ai][bj][m][0] *= rr; acc[ai][bj][m][1] *= rr; } }
    }
    __device__ __forceinline__ void operator()(const f32x4 (&acc)[2][2][4][2], const Unit& u, int wr, int wc, int fr, int fq) const {
        const int row0 = u.pm * 256 + wr * 64 + fr, col0 = u.pn * 256 + wc * 32 + 8 * fq;
#pragma unroll
        for (int ai = 0; ai < 2; ++ai)
#pragma unroll
            for (int m = 0; m < 4; ++m) {
                const int row = row0 + ai * 128 + m * 16;
                const float rlast = rl[ai * 128 + wr * 64 + m * 16 + fr];
#pragma unroll
                for (int bj = 0; bj < 2; ++bj) {
                    const int col = col0 + bj * 128;
                    const u32x4 mgw = *(const u32x4*)(PROJ + (size_t)row * LDP + C_MG + 1024 + col);
                    float mg[8]; unpack8(mgw, mg);
                    float t1v[8]; unpack8(*(const u32x4*)(PROJ + (size_t)row * LDP + C_Z + col), t1v);
                    const f32x4 v0 = acc[ai][bj][m][0], v1 = acc[ai][bj][m][1];
                    float o[8];
#pragma unroll
                    for (int i = 0; i < 4; ++i) { o[i] = t1v[i] + v0[i] * rlast * sigmoidf_(mg[i]); o[4 + i] = t1v[4 + i] + v1[i] * rlast * sigmoidf_(mg[4 + i]); }
                    *(u32x4*)(PROJ + (size_t)row * LDP + C_Q + col) = pack8(o);
                }
            }
    }
};

struct EpiMixCat {
    static constexpr bool PERM = true; static constexpr int NSEG = 12; static constexpr int NPART = 2, SPLIT = 4; static constexpr bool PREF = false;
    bf16_t* PROJ; LAS const float* rl;
    __device__ __forceinline__ void khook(f32x4 (&acc)[2][2][4][2], int seg, const Unit&, int wr, int, int fr, int, LAS const float* rt) const {
#pragma unroll
        for (int ai = 0; ai < 2; ++ai)
#pragma unroll
            for (int m = 0; m < 4; ++m) { const float rr = rt[seg * 256 + ai * 128 + wr * 64 + m * 16 + fr];
#pragma unroll
                for (int bj = 0; bj < 2; ++bj) { acc[ai][bj][m][0] *= rr; acc[ai][bj][m][1] *= rr; } }
    }
    __device__ __forceinline__ void parthook(f32x4 (&acc)[2][2][4][2], const Unit& u, int wr, int wc, int fr, int fq, LAS const float* rt) const {
        const int row0 = u.pm * 256 + wr * 64 + fr, col0 = u.pn * 256 + wc * 32 + 8 * fq;
#pragma unroll
        for (int ai = 0; ai < 2; ++ai) {
            int rowa = row0 + ai * 128; asm volatile("" : "+v"(rowa));
            u32x4 w1[4][2], w2[4][2];
#pragma unroll
            for (int m = 0; m < 4; ++m)
#pragma unroll
                for (int bj = 0; bj < 2; ++bj) {
                    const unsigned goff = (unsigned)(rowa + m * 16) * (unsigned)(LDP * 2) + (unsigned)(C_MG + col0 + bj * 128) * 2u;
                    w1[m][bj] = *(const u32x4*)((const char*)PROJ + goff); w2[m][bj] = *(const u32x4*)((const char*)PROJ + goff + 2048);
                }
            __builtin_amdgcn_sched_barrier(0);
#pragma unroll
            for (int m = 0; m < 4; ++m) {
                const float rr = rt[3 * 256 + ai * 128 + wr * 64 + m * 16 + fr];
#pragma unroll
                for (int bj = 0; bj < 2; ++bj) {
#pragma unroll
                    for (int q = 0; q < 4; ++q) {
                        const float flo = rr * (1.0f + __builtin_amdgcn_exp2f(-1.4426950408889634f * bflo(w2[m][bj][q]))) * __builtin_amdgcn_rcpf(1.0f + __builtin_amdgcn_exp2f(-1.4426950408889634f * bflo(w1[m][bj][q])));
                        const float fhi = rr * (1.0f + __builtin_amdgcn_exp2f(-1.4426950408889634f * bfhi(w2[m][bj][q]))) * __builtin_amdgcn_rcpf(1.0f + __builtin_amdgcn_exp2f(-1.4426950408889634f * bfhi(w1[m][bj][q])));
                        acc[ai][bj][m][q >> 1][2 * (q & 1)] *= flo; acc[ai][bj][m][q >> 1][2 * (q & 1) + 1] *= fhi;
                    }
                }
            }
            __builtin_amdgcn_sched_barrier(0);
        }
    }
    __device__ __forceinline__ void operator()(const f32x4 (&acc)[2][2][4][2], const Unit& u, int wr, int wc, int fr, int fq) const {
        const int row0 = u.pm * 256 + wr * 64 + fr, col0 = u.pn * 256 + wc * 32 + 8 * fq;
        u32x4 mgw[2][4][2];
#pragma unroll
        for (int ai = 0; ai < 2; ++ai)
#pragma unroll
            for (int m = 0; m < 4; ++m)
#pragma unroll
                for (int bj = 0; bj < 2; ++bj) mgw[ai][m][bj] = *(const u32x4*)(PROJ + (size_t)(row0 + ai * 128 + m * 16) * LDP + C_MG + 1024 + col0 + bj * 128);
#pragma unroll
        for (int ai = 0; ai < 2; ++ai)
#pragma unroll
            for (int m = 0; m < 4; ++m) {
                const int row = row0 + ai * 128 + m * 16;
                const float rlast = rl[ai * 128 + wr * 64 + m * 16 + fr];
#pragma unroll
                for (int bj = 0; bj < 2; ++bj) {
                    const int col = col0 + bj * 128;
                    float mg[8]; unpack8(mgw[ai][m][bj], mg);
                    const f32x4 v0 = acc[ai][bj][m][0], v1 = acc[ai][bj][m][1];
                    float o[8];
#pragma unroll
                    for (int i = 0; i < 4; ++i) { o[i] = v0[i] * rlast * sigmoidf_(mg[i]); o[4 + i] = v1[i] * rlast * sigmoidf_(mg[4 + i]); }
                    *(u32x4*)(PROJ + (size_t)row * LDP + C_Q + col) = pack8(o);
                }
            }
    }
};

template <int MODE> struct EpiResid {
    static constexpr bool PERM = true; static constexpr int NSEG = 1; static constexpr int NPART = 1, SPLIT = 0; static constexpr bool PREF = false;
    bf16_t* PROJ; const float* xp; const float* xs; int res_col, dstb_col; float* SS;
    __device__ __forceinline__ void operator()(const f32x4 (&acc)[2][2][4][2], const Unit& u, int wr, int wc, int fr, int fq) const {
        const int row0 = u.pm * 256 + wr * 64 + fr, col0 = u.pn * 256 + wc * 32 + 8 * fq;
#pragma unroll
        for (int ai = 0; ai < 2; ++ai) {
          f32x4 rq0[4][2], rq1[4][2]; u32x4 rqb[4][2];
#pragma unroll
          for (int m = 0; m < 4; ++m)
#pragma unroll
            for (int bj = 0; bj < 2; ++bj) {
                const int row = row0 + ai * 128 + m * 16, col = col0 + bj * 128;
                if (MODE == 0) { rq0[m][bj] = (f32x4){0.f, 0.f, 0.f, 0.f}; rq1[m][bj] = rq0[m][bj];
                    if (row < MTOT) { const float* rp = (row < MPR ? xp + (size_t)row * D : xs + (size_t)(row - MPR) * D) + col; rq0[m][bj] = *(const f32x4*)rp; rq1[m][bj] = *(const f32x4*)(rp + 4); } }
                else rqb[m][bj] = *(const u32x4*)(PROJ + (size_t)row * LDP + res_col + col);
            }
#pragma unroll
            for (int m = 0; m < 4; ++m) {
                const int row = row0 + ai * 128 + m * 16;
                float ss = 0.f;
#pragma unroll
                for (int bj = 0; bj < 2; ++bj) {
                    const int col = col0 + bj * 128;
                    f32x4 r0, r1;
                    if (MODE == 0) { r0 = rq0[m][bj]; r1 = rq1[m][bj]; }
                    else { float rv[8]; unpack8(rqb[m][bj], rv); r0 = (f32x4){rv[0], rv[1], rv[2], rv[3]}; r1 = (f32x4){rv[4], rv[5], rv[6], rv[7]}; }
                    const f32x4 x0 = r0 + acc[ai][bj][m][0], x1 = r1 + acc[ai][bj][m][1];
                    u32x4 w; w.x = cvt_pk_bf16(x0[0], x0[1]); w.y = cvt_pk_bf16(x0[2], x0[3]); w.z = cvt_pk_bf16(x1[0], x1[1]); w.w = cvt_pk_bf16(x1[2], x1[3]);
                    *(u32x4*)(PROJ + (size_t)row * LDP + dstb_col + col) = w;
                    ss += (x0[0] * x0[0] + x0[1] * x0[1]) + (x0[2] * x0[2] + x0[3] * x0[3]) + (x1[0] * x1[0] + x1[1] * x1[1]) + (x1[2] * x1[2] + x1[3] * x1[3]);
                }
                ss = xrow16_sum(ss);
                if (fq == 0) atomicAdd(SS + row, ss);
            }
        }
    }
};

struct EpiSwiGLU {
    static constexpr bool PERM = true; static constexpr int NSEG = 1; static constexpr int NPART = 1, SPLIT = 0; static constexpr bool PREF = true;
    bf16_t* PROJ; const float* SS; mutable int par; LAS float* rt;
    __device__ __forceinline__ void prefetch(const Unit& n, int p) const {
        if (__builtin_amdgcn_readfirstlane((int)threadIdx.x >> 6) == 0)
            __builtin_amdgcn_global_load_lds((const unsigned*)(SS + n.pm * 256 + ((int)threadIdx.x & 63) * 4), (LAS unsigned*)(rt + p * 256), 16, 0, 0);
    }
    __device__ __forceinline__ void operator()(const f32x4 (&acc)[2][2][4][2], const Unit& u, int wr, int wc, int fr, int fq) const {
        const int row0 = u.pm * 256 + wr * 64 + fr, col0 = u.pn * 128 + wc * 32 + 8 * fq;
        float ssv[2][4];
#pragma unroll
        for (int ai = 0; ai < 2; ++ai)
#pragma unroll
            for (int m = 0; m < 4; ++m) ssv[ai][m] = rt[par * 256 + ai * 128 + wr * 64 + m * 16 + fr];
#pragma unroll
        for (int ai = 0; ai < 2; ++ai)
#pragma unroll
            for (int m = 0; m < 4; ++m) {
                const int row = row0 + ai * 128 + m * 16;
                const float r = rsqrtf(ssv[ai][m] * (1.0f / D) + EPS);
                const f32x4 g0 = acc[ai][0][m][0], g1 = acc[ai][0][m][1], u0 = acc[ai][1][m][0], u1 = acc[ai][1][m][1];
                float o[8];
#pragma unroll
                for (int i = 0; i < 4; ++i) { o[i] = siluf_(r * g0[i]) * (r * u0[i]); o[4 + i] = siluf_(r * g1[i]) * (r * u1[i]); }
                __builtin_nontemporal_store(pack8(o), (u32x4*)(PROJ + (size_t)row * LDP + C_XS + col0));
            }
    }
};

struct EpiPE {
    static constexpr bool PERM = true; static constexpr int NSEG = 1; static constexpr int NPART = 1, SPLIT = 0; static constexpr bool PREF = false;
    bf16_t* PROJ;
    __device__ __forceinline__ void operator()(const f32x4 (&acc)[2][2][4][2], const Unit& u, int wr, int wc, int fr, int fq) const {
        const int row0 = u.pm * 256 + wr * 64 + fr, col0 = u.pn * 256 + wc * 32 + 8 * fq;
#pragma unroll
        for (int ai = 0; ai < 2; ++ai)
#pragma unroll
            for (int m = 0; m < 4; ++m) {
                const int row = row0 + ai * 128 + m * 16;
#pragma unroll
                for (int bj = 0; bj < 2; ++bj) {
                    const f32x4 v0 = acc[ai][bj][m][0], v1 = acc[ai][bj][m][1];
                    u32x4 w; w.x = cvt_pk_bf16(v0[0], v0[1]); w.y = cvt_pk_bf16(v0[2], v0[3]); w.z = cvt_pk_bf16(v1[0], v1[1]); w.w = cvt_pk_bf16(v1[2], v1[3]);
                    *(u32x4*)(PROJ + (size_t)row * LDP + C_Z + col0 + bj * 128) = w;
                }
            }
    }
};

struct EpiX3 {
    static constexpr bool PERM = true; static constexpr int NSEG = 1; static constexpr int NPART = 1, SPLIT = 0; static constexpr bool PREF = false;
    bf16_t* PROJ; const float* SS2; float* SS3; float* out; unsigned* cnt; unsigned* bar; const float* gf; LAS float* rt;
    __device__ __forceinline__ void operator()(const f32x4 (&acc_)[2][2][4][2], const Unit& u, int wr, int wc, int fr, int fq) const {
        f32x4 (&acc)[2][2][4][2] = const_cast<f32x4 (&)[2][2][4][2]>(acc_);
        const int row0 = u.pm * 256 + wr * 64 + fr, col0 = u.pn * 256 + wc * 32 + 8 * fq;
#pragma unroll
        for (int ai = 0; ai < 2; ++ai) {
          u32x4 xw[4][2], pw[4][2]; float s2[4];
#pragma unroll
          for (int m = 0; m < 4; ++m) { const int row = row0 + ai * 128 + m * 16; s2[m] = SS2[row];
#pragma unroll
              for (int bj = 0; bj < 2; ++bj) { xw[m][bj] = *(const u32x4*)(PROJ + (size_t)row * LDP + C_GATE + col0 + bj * 128); pw[m][bj] = *(const u32x4*)(PROJ + (size_t)row * LDP + C_Z + col0 + bj * 128); } }
#pragma unroll
            for (int m = 0; m < 4; ++m) {
                const int row = row0 + ai * 128 + m * 16;
                const float r = rsqrtf(s2[m] * (1.0f / D) + EPS);
                float ss = 0.f;
#pragma unroll
                for (int bj = 0; bj < 2; ++bj) {
                    float xa[8], pa[8]; unpack8(xw[m][bj], xa); unpack8(pw[m][bj], pa);
                    const f32x4 a0 = (f32x4){xa[0], xa[1], xa[2], xa[3]}, a1 = (f32x4){xa[4], xa[5], xa[6], xa[7]}, p0 = (f32x4){pa[0], pa[1], pa[2], pa[3]}, p1 = (f32x4){pa[4], pa[5], pa[6], pa[7]};
                    const f32x4 v0 = acc[ai][bj][m][0], v1 = acc[ai][bj][m][1];
                    f32x4 x0, x1;
#pragma unroll
                    for (int i = 0; i < 4; ++i) { x0[i] = a0[i] + p0[i] * sigmoidf_(r * v0[i]); x1[i] = a1[i] + p1[i] * sigmoidf_(r * v1[i]); }
                    acc[ai][bj][m][0] = x0; acc[ai][bj][m][1] = x1;
                    ss += (x0[0] * x0[0] + x0[1] * x0[1]) + (x0[2] * x0[2] + x0[3] * x0[3]) + (x1[0] * x1[0] + x1[1] * x1[1]) + (x1[2] * x1[2] + x1[3] * x1[3]);
                }
                ss = xrow16_sum(ss);
                if (fq == 0) atomicAdd(SS3 + row, ss);
            }
        }
        asm volatile("s_waitcnt vmcnt(0)" ::: "memory");
        unsigned* c = cnt + 64 * u.pm;
        if ((threadIdx.x & 63) == 0) (void)xb_add(c, 1u);
        if (threadIdx.x < 64) { unsigned sp = 0u; while ((unsigned)__builtin_amdgcn_readfirstlane(xb_ld(c)) < 32u) { __builtin_amdgcn_s_sleep(1);
            if ((++sp & 255u) == 0u) { if (xb_ld(&bar[XB_TMO])) break; if (sp > XB_SPIN_CAP) { atomicAdd(&bar[XB_TMO], 1u); break; } } } }
        asm volatile("s_waitcnt vmcnt(0) lgkmcnt(0)" ::: "memory"); __builtin_amdgcn_s_barrier(); asm volatile("" ::: "memory");
        if (threadIdx.x < 256) rt[threadIdx.x] = rsqrtf(__uint_as_float(xb_ld((unsigned*)(SS3 + u.pm * 256 + threadIdx.x))) * (1.0f / D) + EPS);
        asm volatile("s_waitcnt vmcnt(0) lgkmcnt(0)" ::: "memory"); __builtin_amdgcn_s_barrier(); asm volatile("" ::: "memory");
        f32x4 gq[2][2];
#pragma unroll
        for (int bj = 0; bj < 2; ++bj) { gq[bj][0] = *(const f32x4*)(gf + col0 + bj * 128); gq[bj][1] = *(const f32x4*)(gf + col0 + bj * 128 + 4); }
#pragma unroll
        for (int ai = 0; ai < 2; ++ai)
#pragma unroll
            for (int m = 0; m < 4; ++m) {
                const int rl = ai * 128 + wr * 64 + m * 16 + fr;
                const float r3 = rt[rl];
                float* orow = out + O_Y + (size_t)(u.pm * 256 + rl) * D + col0;
#pragma unroll
                for (int bj = 0; bj < 2; ++bj) {
                    *(f32x4*)(orow + bj * 128) = acc[ai][bj][m][0] * r3 * gq[bj][0];
                    *(f32x4*)(orow + bj * 128 + 4) = acc[ai][bj][m][1] * r3 * gq[bj][1];
                }
            }
    }
};

struct MapIdent { __device__ __forceinline__ int operator()(int n) const { return n; } };
struct MapWin {
    __device__ __forceinline__ int operator()(int n) const {
        if (n < 5120) return n;
        if (n < 9216) return n + 32;
        if (n < 11264) return n + 48;
        const int j = n - 11264;
        if (j < 32) return 5120 + j;
        if (j < 48) return 9216 + j;
        return -1;
    }
};
struct MapFfn {
    __device__ __forceinline__ int operator()(int n) const { const int j = n >> 8, r = n & 255; return r < 128 ? 128 * j + r : DFF + 128 * j + (r - 128); }
};
template <class Map>
__device__ __forceinline__ void transpose_item(const float* W, int K, int Nsrc, int Ndst, bf16_t* WT, const float* gain, LAS float* scr, int item, int lane, Map map) {
    const int nblk = Ndst / 32, kb = item / nblk, nb = item % nblk, k0 = 64 * kb, n0 = 32 * nb;
    const int sc = map(n0 + (lane & 31));
    float tv[32];
#pragma unroll
    for (int i = 0; i < 32; ++i) { const int kk = 2 * i + (lane >> 5); tv[i] = sc >= 0 ? W[(size_t)(k0 + kk) * Nsrc + sc] : 0.f; }
#pragma unroll
    for (int i = 0; i < 32; ++i) { const int kk = 2 * i + (lane >> 5); float v = tv[i]; if (gain) v *= gain[k0 + kk]; scr[kk * 33 + (lane & 31)] = v; }
    asm volatile("s_waitcnt lgkmcnt(0)" ::: "memory");
    const int c = lane & 7;
#pragma unroll
    for (int j = 0; j < 4; ++j) { const int n = (lane >> 3) + 8 * j; const LAS float* s = scr + (8 * c) * 33 + n;
        u32x4 o; o.x = cvt_pk_bf16(s[0 * 33], s[1 * 33]); o.y = cvt_pk_bf16(s[2 * 33], s[3 * 33]); o.z = cvt_pk_bf16(s[4 * 33], s[5 * 33]); o.w = cvt_pk_bf16(s[6 * 33], s[7 * 33]);
        *(u32x4*)(WT + (size_t)(n0 + n) * K + k0 + 8 * c) = o; }
    asm volatile("s_waitcnt lgkmcnt(0)" ::: "memory");
}

struct TItem { const float* W; const float* gain; bf16_t* WT; int K, Nsrc, k0, n0, sc, ldk, koff; };
__device__ __forceinline__ TItem p0_decode(const Frame& F, int it, int lane) {
    constexpr int I_WIN = 16 * (NPROJ / 32), I_WBS = 32 * 32, I_WBG = 16 * 32, I_WOUT = 16 * 32, I_WFI = 16 * (2 * DFF / 32), I_WFO = (DFF / 64) * 32, I_WPG = 16 * 32;
    unsigned char* ws = F.ws;
    TItem t; int r = it, Ndst, mapid = 0; t.ldk = 0; t.koff = 0;
    if (r < I_WIN) { t.W = F.in[9]; t.gain = nullptr; t.WT = (bf16_t*)(ws + WS_WIN); t.K = D; t.Nsrc = NIN; Ndst = NPROJ; mapid = 1; }
    else if ((r -= I_WIN) < I_WBS) { t.W = F.in[20]; t.gain = F.in[15];     t.WT = (bf16_t*)(ws + WS_WBS); t.K = 2048; t.Nsrc = D; Ndst = D; t.ldk = 3072; t.koff = 0; }
    else if ((r -= I_WBS) < I_WBG) { t.W = F.in[21]; t.gain = nullptr; t.WT = (bf16_t*)(ws + WS_WBS); t.K = D; t.Nsrc = D; Ndst = D; t.ldk = 3072; t.koff = 2048; }
    else if ((r -= I_WBG) < I_WOUT) { t.W = F.in[22]; t.gain = nullptr; t.WT = (bf16_t*)(ws + WS_WOUT); t.K = D; t.Nsrc = D; Ndst = D; }
    else if ((r -= I_WOUT) < I_WFI) { t.W = F.in[24]; t.gain = F.in[23]; t.WT = (bf16_t*)(ws + WS_WFI); t.K = D; t.Nsrc = 2 * DFF; Ndst = 2 * DFF; mapid = 2; }
    else if ((r -= I_WFI) < I_WFO) { t.W = F.in[25]; t.gain = nullptr; t.WT = (bf16_t*)(ws + WS_WFO); t.K = DFF; t.Nsrc = D; Ndst = D; }
    else if ((r -= I_WFO) < I_WPG) { t.W = F.in[27]; t.gain = F.in[26]; t.WT = (bf16_t*)(ws + WS_WPG); t.K = D; t.Nsrc = D; Ndst = D; }
    else { r -= I_WPG; t.W = F.in[28]; t.gain = nullptr; t.WT = (bf16_t*)(ws + WS_WPP); t.K = 256; t.Nsrc = D; Ndst = D; }
    if (t.ldk == 0) t.ldk = t.K;
    const int nblk = Ndst / 32; t.k0 = 64 * (r / nblk); t.n0 = 32 * (r % nblk);
    const int n = t.n0 + 4 * (lane & 7);
    t.sc = mapid == 1 ? MapWin()(n) : mapid == 2 ? MapFfn()(n) : n;
    return t;
}
__device__ __forceinline__ void p0_load(const TItem& t, int lane, f32x4 (&tv)[8]) {
#pragma unroll
    for (int i = 0; i < 8; ++i) { const int kk = 8 * i + (lane >> 3); tv[i] = t.sc >= 0 ? __builtin_nontemporal_load((const f32x4*)(t.W + (size_t)(t.k0 + kk) * t.Nsrc + t.sc)) : (f32x4){0.f, 0.f, 0.f, 0.f}; }
}
__device__ __forceinline__ void p0_finish(const TItem& t, int lane, const f32x4 (&tv)[8], LAS float* scr) {
#pragma unroll
    for (int i = 0; i < 8; ++i) { const int kk = 8 * i + (lane >> 3); f32x4 v = tv[i]; if (t.gain) v = v * t.gain[t.k0 + kk];
#pragma unroll
        for (int e = 0; e < 4; ++e) scr[kk * 33 + 4 * (lane & 7) + e] = v[e]; }
    asm volatile("s_waitcnt lgkmcnt(0)" ::: "memory");
    const int c = lane & 7;
#pragma unroll
    for (int j = 0; j < 4; ++j) { const int n = (lane >> 3) + 8 * j; const LAS float* sp = scr + (8 * c) * 33 + n;
        u32x4 o; o.x = cvt_pk_bf16(sp[0 * 33], sp[1 * 33]); o.y = cvt_pk_bf16(sp[2 * 33], sp[3 * 33]); o.z = cvt_pk_bf16(sp[4 * 33], sp[5 * 33]); o.w = cvt_pk_bf16(sp[6 * 33], sp[7 * 33]);
        *(u32x4*)(t.WT + (size_t)(t.n0 + n) * t.ldk + t.koff + t.k0 + 8 * c) = o; }
    asm volatile("s_waitcnt lgkmcnt(0)" ::: "memory");
}
__device__ __forceinline__ void p0_prologue(Frame& F, int mode, int gw, int NGW) {
    LAS float* scr = (LAS float*)(F.lds + F.wave * 16384);
    const int lane = F.lane;
    constexpr int I_WIN = 16 * (NPROJ / 32);
    constexpr int NITEMS = I_WIN + 32 * 32 + 16 * 32 + 16 * 32 + 16 * (2 * DFF / 32) + (DFF / 64) * 32 + 16 * 32 + 4 * 32;
    const int it_lo = mode == 0 ? 0 : I_WIN, it_hi = mode == 0 ? I_WIN : NITEMS;
    if (it_lo + gw < it_hi) {
        TItem cur = p0_decode(F, it_lo + gw, lane); f32x4 tv[8]; p0_load(cur, lane, tv);
        for (int it = it_lo + gw; it < it_hi; it += NGW) {
            const bool more = it + NGW < it_hi;
            TItem nxt = cur; f32x4 tn[8];
            if (more) { nxt = p0_decode(F, it + NGW, lane); p0_load(nxt, lane, tn); }
            p0_finish(cur, lane, tv, scr);
            if (more) { cur = nxt;
#pragma unroll
                for (int i = 0; i < 8; ++i) tv[i] = tn[i]; }
        }
    }
    if (mode == 0) {
        const float* gmix = F.in[8];
        for (int m0 = gw; m0 < MP; m0 += 8 * NGW) {
            f32x4 v[8][4];
#pragma unroll
            for (int q = 0; q < 8; ++q) { const int m = m0 + q * NGW;
                if (m < MTOT) {
                    const float* xrow = m < MPR ? F.in[0] + (size_t)m * D : F.in[1] + (size_t)(m - MPR) * D;
#pragma unroll
                    for (int j = 0; j < 4; ++j) v[q][j] = __builtin_nontemporal_load((const f32x4*)xrow + 64 * j + lane);
                } else {
#pragma unroll
                    for (int j = 0; j < 4; ++j) v[q][j] = (f32x4){0.f, 0.f, 0.f, 0.f};
                } }
#pragma unroll
            for (int q = 0; q < 8; ++q) { const int m = m0 + q * NGW;
                if (m < MP) {
                    u32x2* o8 = (u32x2*)(F.XN() + (size_t)m * D) + lane;
                    float sq = 0.f;
#pragma unroll
                    for (int j = 0; j < 4; ++j) sq += (v[q][j][0] * v[q][j][0] + v[q][j][1] * v[q][j][1]) + (v[q][j][2] * v[q][j][2] + v[q][j][3] * v[q][j][3]);
                    const float rs = rsqrtf(wave_sum(sq) * (1.0f / D) + EPS);
#pragma unroll
                    for (int j = 0; j < 4; ++j) { const f32x4 gv = ((const f32x4*)gmix)[64 * j + lane]; const f32x4 y = v[q][j] * rs * gv;
                        o8[64 * j] = (u32x2){cvt_pk_bf16(y[0], y[1]), cvt_pk_bf16(y[2], y[3])}; }
                } }
        }
    } else {
        for (int m0 = gw; m0 < MP; m0 += 8 * NGW) {
            f32x4 pv[8];
#pragma unroll
            for (int q = 0; q < 8; ++q) { const int m = m0 + q * NGW;
                pv[q] = m < MTOT ? __builtin_nontemporal_load((const f32x4*)(m < MPR ? F.in[2] + (size_t)m * 256 : F.in[3] + (size_t)(m - MPR) * 256) + lane) : (f32x4){0.f, 0.f, 0.f, 0.f}; }
#pragma unroll
            for (int q = 0; q < 8; ++q) { const int m = m0 + q * NGW;
                if (m < MP) ((u32x2*)(F.PB() + (size_t)m * 256))[lane] = (u32x2){cvt_pk_bf16(pv[q][0], pv[q][1]), cvt_pk_bf16(pv[q][2], pv[q][3])}; }
        }
    }
}

__device__ __forceinline__ void p2_conv(Frame& F) {
    const int gt = blockIdx.x * (NWAVES * 64) + F.tid, NT = F.G * NWAVES * 64;
    constexpr int NCG = NCH / 8;
    constexpr int NU_F = (MPR / 64) * NCG, NU_S = NSMP * NCG;
    for (int u = gt; u < NU_F + NU_S; u += NT) {
        const bool smp = u >= NU_F;
        const int uu = smp ? u - NU_F : u;
        const int ch = uu / NCG, cgi = uu % NCG;
        const bool is_ssm = cgi < 384;
        const int cc = is_ssm ? cgi * 8 : (cgi - 384) * 8;
        const int kind = is_ssm ? 0 : 1 + (cgi - 384) / 128;
        const float* cw = is_ssm ? F.in[10] : F.in[16];
        float w[4][8], bias[8];
#pragma unroll
        for (int j = 0; j < 4; ++j) { const f32x4 a = *(const f32x4*)(cw + j * 3072 + cc), b = *(const f32x4*)(cw + j * 3072 + cc + 4);
#pragma unroll
            for (int i = 0; i < 4; ++i) { w[j][i] = a[i]; w[j][4 + i] = b[i]; } }
        if (is_ssm) { const f32x4 a = *(const f32x4*)(F.in[11] + cc), b = *(const f32x4*)(F.in[11] + cc + 4);
#pragma unroll
            for (int i = 0; i < 4; ++i) { bias[i] = a[i]; bias[4 + i] = b[i]; } }
        else {
#pragma unroll
            for (int i = 0; i < 8; ++i) bias[i] = 0.f; }
        float h0[8], h1[8], h2[8];
        const int pcol = C_XS + cgi * 8;
        if (smp) {
            const float* st = (is_ssm ? F.in[5] : F.in[7]) + (size_t)ch * 3 * 3072 + cc;
#pragma unroll
            for (int i = 0; i < 8; ++i) { h0[i] = st[i]; h1[i] = st[3072 + i]; h2[i] = st[2 * 3072 + i]; }
            bf16_t* rp = F.PROJ() + (size_t)(MPR + ch) * LDP + pcol;
            float x[8]; unpack8(*(const u32x4*)rp, x);
            float o[8]; float ss = 0.f;
#pragma unroll
            for (int i = 0; i < 8; ++i) { float v = w[0][i] * h0[i] + w[1][i] * h1[i] + w[2][i] * h2[i] + w[3][i] * x[i] + bias[i]; v = siluf_(v); o[i] = v; ss += v * v; }
            if (kind == 1 || kind == 2) {
                ss = row16_sum(ss);
                const float rn = rsqrtf(ss + EPS) * (kind == 1 ? 0.08838834764831845f : 1.0f);
#pragma unroll
                for (int i = 0; i < 8; ++i) o[i] *= rn;
            }
            *(u32x4*)rp = pack8(o);
            float* ns = F.out + (is_ssm ? O_SCONVS : O_GCONVS) + (size_t)ch * 3 * 3072 + cc;
#pragma unroll
            for (int i = 0; i < 8; ++i) { ns[i] = h1[i]; ns[3072 + i] = h2[i]; ns[2 * 3072 + i] = x[i]; }
            continue;
        }
        const int rowbase = ch * 64, t0 = rowbase & (SEQ - 1);
        if (t0 == 0) {
#pragma unroll
            for (int i = 0; i < 8; ++i) { h0[i] = 0.f; h1[i] = 0.f; h2[i] = 0.f; }
        } else {
            const bf16_t* hp = F.HALO() + (size_t)(ch - 1) * 3 * NCH + cgi * 8;
            unpack8(*(const u32x4*)hp, h0); unpack8(*(const u32x4*)(hp + NCH), h1); unpack8(*(const u32x4*)(hp + 2 * NCH), h2);
        }
        const bool lastc = (t0 == SEQ - 64);
        float* ns = F.out + (is_ssm ? O_SCONVP : O_GCONVP) + (size_t)(rowbase >> 11) * 3 * 3072 + cc;
        bf16_t* rp = F.PROJ() + (size_t)rowbase * LDP + pcol;
        u32x4 raw[3];
#pragma unroll
        for (int r = 0; r < 3; ++r) raw[r] = *(const u32x4*)(rp + (size_t)r * LDP);
#pragma unroll
        for (int r = 0; r < 3; ++r) {
            float x[8]; unpack8(raw[r], x);
            float o[8]; float ss = 0.f;
#pragma unroll
            for (int i = 0; i < 8; ++i) { float v = w[0][i] * h0[i] + w[1][i] * h1[i] + w[2][i] * h2[i] + w[3][i] * x[i] + bias[i]; v = siluf_(v); o[i] = v; ss += v * v; }
            if (kind == 1 || kind == 2) {
                ss = row16_sum(ss);
                const float rn = rsqrtf(ss + EPS) * (kind == 1 ? 0.08838834764831845f : 1.0f);
#pragma unroll
                for (int i = 0; i < 8; ++i) o[i] *= rn;
            }
            *(u32x4*)(rp + (size_t)r * LDP) = pack8(o);
#pragma unroll
            for (int i = 0; i < 8; ++i) { h0[i] = h1[i]; h1[i] = h2[i]; h2[i] = x[i]; }
        }
        if (lastc) {
            const bf16_t* hp = F.HALO() + (size_t)ch * 3 * NCH + cgi * 8;
#pragma unroll
            for (int r = 0; r < 3; ++r) { float x[8]; unpack8(*(const u32x4*)(hp + (size_t)r * NCH), x);
#pragma unroll
                for (int i = 0; i < 8; ++i) ns[r * 3072 + i] = x[i]; }
        }
    }
}

__device__ __forceinline__ void ssd_item(Frame& F, int item) {
    const bool smp = item >= NBATCH * 32;
    const int sq = smp ? (item - NBATCH * 32) >> 5 : item >> 5, h = item & 31, g = h >> 3;
    const int row0 = smp ? MPR + sq : sq * SEQ, T = smp ? 1 : SEQ;
    const int tid = F.tid, p = tid >> 3, nq = tid & 7;
    LAS bf16_t* Bs = (LAS bf16_t*)(F.lds);
    LAS bf16_t* Cs = (LAS bf16_t*)(F.lds + 16384);
    LAS bf16_t* Xs = (LAS bf16_t*)(F.lds + 32768);
    LAS float* dts = (LAS float*)(F.lds + 40960);
    LAS float* decs = (LAS float*)(F.lds + 41216);
    LAS float* Ys = (LAS float*)(F.lds + 41472);
    float hst[16];
    if (smp) {
        const float* sp = F.in[4] + ((size_t)(sq * 32 + h) * 64 + p) * 128 + nq * 16;
#pragma unroll
        for (int i = 0; i < 4; ++i) { const f32x4 v = ((const f32x4*)sp)[i]; hst[4 * i] = v[0]; hst[4 * i + 1] = v[1]; hst[4 * i + 2] = v[2]; hst[4 * i + 3] = v[3]; }
    } else {
#pragma unroll
        for (int i = 0; i < 16; ++i) hst[i] = 0.f;
    }
    const float a_h = -__expf(F.in[13][h]), dtb = F.in[12][h], Dh = F.in[14][h];
    for (int tb = 0; tb < T; tb += 64) {
        const int rows = (T - tb) < 64 ? (T - tb) : 64;
#pragma unroll
        for (int i = 0; i < 2; ++i) {
            const int pc = tid + i * 512, r = pc >> 4, c8 = (pc & 15) * 8;
            if (r < rows) {
                const bf16_t* src = F.PROJ() + (size_t)(row0 + tb + r) * LDP;
                *(LAS u32x4*)(Bs + r * 128 + c8) = *(const u32x4*)(src + C_B + g * 128 + c8);
                *(LAS u32x4*)(Cs + r * 128 + c8) = *(const u32x4*)(src + C_C + g * 128 + c8);
            }
        }
        { const int r = tid >> 3, c8 = (tid & 7) * 8;
          if (r < rows) *(LAS u32x4*)(Xs + r * 64 + c8) = *(const u32x4*)(F.PROJ() + (size_t)(row0 + tb + r) * LDP + C_XS + h * 64 + c8); }
        if (tid < rows) { const float dt = softplusf_(F.SMALL()[(size_t)(row0 + tb + tid) * 64 + h] + dtb); dts[tid] = dt; decs[tid] = __expf(dt * a_h); }
        __syncthreads();
        for (int tt = 0; tt < rows; ++tt) {
            const float xv = bf2f(Xs[tt * 64 + p]), dtv = dts[tt], dc = decs[tt], dx = dtv * xv;
            float bv[16], cv[16];
            { float t8[8]; unpack8(*(const LAS u32x4*)(Bs + tt * 128 + nq * 16), t8);
#pragma unroll
              for (int i = 0; i < 8; ++i) bv[i] = t8[i];
              unpack8(*(const LAS u32x4*)(Bs + tt * 128 + nq * 16 + 8), t8);
#pragma unroll
              for (int i = 0; i < 8; ++i) bv[8 + i] = t8[i];
              unpack8(*(const LAS u32x4*)(Cs + tt * 128 + nq * 16), t8);
#pragma unroll
              for (int i = 0; i < 8; ++i) cv[i] = t8[i];
              unpack8(*(const LAS u32x4*)(Cs + tt * 128 + nq * 16 + 8), t8);
#pragma unroll
              for (int i = 0; i < 8; ++i) cv[8 + i] = t8[i]; }
            float yp = 0.f;
#pragma unroll
            for (int i = 0; i < 16; ++i) { hst[i] = dc * hst[i] + dx * bv[i]; yp += cv[i] * hst[i]; }
            yp += __shfl_xor(yp, 1); yp += __shfl_xor(yp, 2); yp += __shfl_xor(yp, 4);
            if (nq == 0) Ys[tt * 64 + p] = yp + Dh * xv;
        }
        __syncthreads();
        { const int r = tid >> 3, c8 = (tid & 7) * 8;
          if (r < rows) { float o[8];
#pragma unroll
              for (int i = 0; i < 8; ++i) o[i] = Ys[r * 64 + c8 + i];
              *(u32x4*)(F.PROJ() + (size_t)(row0 + tb + r) * LDP + C_XS + h * 64 + c8) = pack8(o); } }
        __syncthreads();
    }
    float* op = F.out + (smp ? O_SSMS : O_SSMP) + ((size_t)(sq * 32 + h) * 64 + p) * 128 + nq * 16;
#pragma unroll
    for (int i = 0; i < 4; ++i) ((f32x4*)op)[i] = (f32x4){hst[4 * i], hst[4 * i + 1], hst[4 * i + 2], hst[4 * i + 3]};
}

__device__ __forceinline__ void gdn_item(Frame& F, int item) {
    const bool smp = item >= NBATCH * 32;
    const int sq = smp ? (item - NBATCH * 32) >> 5 : item >> 5, h = (item >> 2) & 7, dvq = item & 3;
    const int row0 = smp ? MPR + sq : sq * SEQ, T = smp ? 1 : SEQ;
    const int tid = F.tid, e = tid >> 4, kg = tid & 15;
    LAS bf16_t* Qs = (LAS bf16_t*)(F.lds);
    LAS bf16_t* Ks = (LAS bf16_t*)(F.lds + 16384);
    LAS bf16_t* Vs = (LAS bf16_t*)(F.lds + 32768);
    LAS float* egs = (LAS float*)(F.lds + 36864);
    LAS float* bts = (LAS float*)(F.lds + 37120);
    LAS float* Os = (LAS float*)(F.lds + 37376);
    float S[8];
    const size_t sbase = ((size_t)(sq * 8 + h) * 128 + kg * 8) * 128 + dvq * 32 + e;
    if (smp) {
#pragma unroll
        for (int j = 0; j < 8; ++j) S[j] = F.in[6][sbase + (size_t)j * 128];
    } else {
#pragma unroll
        for (int j = 0; j < 8; ++j) S[j] = 0.f;
    }
    const float na = -__expf(F.in[18][h]), dtb = F.in[17][h];
    for (int tb = 0; tb < T; tb += 64) {
        const int rows = (T - tb) < 64 ? (T - tb) : 64;
#pragma unroll
        for (int i = 0; i < 2; ++i) {
            const int pc = tid + i * 512, r = pc >> 4, c8 = (pc & 15) * 8;
            if (r < rows) {
                const bf16_t* src = F.PROJ() + (size_t)(row0 + tb + r) * LDP;
                *(LAS u32x4*)(Qs + r * 128 + c8) = *(const u32x4*)(src + C_Q + h * 128 + c8);
                *(LAS u32x4*)(Ks + r * 128 + c8) = *(const u32x4*)(src + C_K + h * 128 + c8);
            }
        }
        if (tid < 256) { const int r = tid >> 2, c8 = (tid & 3) * 8;
          if (r < rows) *(LAS u32x4*)(Vs + r * 32 + c8) = *(const u32x4*)(F.PROJ() + (size_t)(row0 + tb + r) * LDP + C_V + h * 128 + dvq * 32 + c8); }
        if (tid < rows) { const float* sm = F.SMALL() + (size_t)(row0 + tb + tid) * 64;
            egs[tid] = __expf(na * softplusf_(sm[40 + h] + dtb)); bts[tid] = sigmoidf_(sm[32 + h]); }
        __syncthreads();
        for (int tt = 0; tt < rows; ++tt) {
            float k8[8], q8[8];
            unpack8(*(const LAS u32x4*)(Ks + tt * 128 + kg * 8), k8);
            unpack8(*(const LAS u32x4*)(Qs + tt * 128 + kg * 8), q8);
            const float eg = egs[tt], bt = bts[tt], v = bf2f(Vs[tt * 32 + e]);
            float ks = 0.f;
#pragma unroll
            for (int j = 0; j < 8; ++j) ks += k8[j] * S[j];
            ks += __shfl_xor(ks, 1); ks += __shfl_xor(ks, 2); ks += __shfl_xor(ks, 4); ks += __shfl_xor(ks, 8);
            const float vn = bt * (v - eg * ks);
            float op = 0.f;
#pragma unroll
            for (int j = 0; j < 8; ++j) { S[j] = eg * S[j] + k8[j] * vn; op += q8[j] * S[j]; }
            op += __shfl_xor(op, 1); op += __shfl_xor(op, 2); op += __shfl_xor(op, 4); op += __shfl_xor(op, 8);
            if (kg == 0) Os[tt * 32 + e] = op;
        }
        __syncthreads();
        if (tid < 256) { const int r = tid >> 2, c8 = (tid & 3) * 8;
          if (r < rows) { float o[8];
#pragma unroll
              for (int i = 0; i < 8; ++i) o[i] = Os[r * 32 + c8 + i];
              *(u32x4*)(F.PROJ() + (size_t)(row0 + tb + r) * LDP + C_B + h * 128 + dvq * 32 + c8) = pack8(o); } }
        __syncthreads();
    }
    float* op = F.out + (smp ? O_GDNS : O_GDNP);
#pragma unroll
    for (int j = 0; j < 8; ++j) op[sbase + (size_t)j * 128] = S[j];
}


typedef short v4i16 __attribute__((ext_vector_type(4)));
__device__ __forceinline__ bf16x8 row_frag(LAS const unsigned char* base, int pitch, int row0, int k0, int lane) {
    return *(const LAS bf16x8*)(base + (row0 + (lane & 15)) * pitch + (k0 + 8 * (lane >> 4)) * 2);
}
__device__ __forceinline__ bf16x8 tr_frag(LAS const unsigned char* base, int pitch, int k0, int col0, int lane) {
    const int g = lane >> 4, m = lane & 15, q = m >> 2, pp = m & 3;
    LAS const unsigned char* a0 = base + (k0 + 8 * g + q) * pitch + (col0 + 4 * pp) * 2;
    const v4i16 lo = __builtin_amdgcn_ds_read_tr16_b64_v4i16((LAS v4i16*)a0);
    const v4i16 hi = __builtin_amdgcn_ds_read_tr16_b64_v4i16((LAS v4i16*)(a0 + 4 * pitch));
    return (bf16x8){lo[0], lo[1], lo[2], lo[3], hi[0], hi[1], hi[2], hi[3]};
}
#define LDS_BARRIER() do { asm volatile("s_waitcnt lgkmcnt(0)" ::: "memory"); __builtin_amdgcn_s_barrier(); asm volatile("" ::: "memory"); } while (0)
#define MFMA16(a, b, c) __builtin_amdgcn_mfma_f32_16x16x32_bf16((a), (b), (c), 0, 0, 0)
__device__ __forceinline__ u32x2 pack4(float a, float b, float c, float d) { return (u32x2){cvt_pk_bf16(a, b), cvt_pk_bf16(c, d)}; }

struct SsdSmpIn { f32x4 st[4]; u32x2 b[4], c[4]; float x, dtraw; };
__device__ __forceinline__ void ssd_smp_load(const Frame& F, int it, int p, int nq, SsdSmpIn& r) {
    const int sq = it >> 5, h = it & 31, g4 = h >> 3;
    const float* sp = F.in[4] + ((size_t)(sq * 32 + h) * 64 + p) * 128 + nq * 4;
#pragma unroll
    for (int j = 0; j < 4; ++j) r.st[j] = *(const f32x4*)(sp + 32 * j);
    const bf16_t* row = F.PROJ() + (size_t)(MPR + sq) * LDP;
#pragma unroll
    for (int j = 0; j < 4; ++j) { r.b[j] = *(const u32x2*)(row + C_B + g4 * 128 + 32 * j + 4 * nq); r.c[j] = *(const u32x2*)(row + C_C + g4 * 128 + 32 * j + 4 * nq); }
    r.x = bf2f(row[C_XS + h * 64 + p]);
    r.dtraw = F.SMALL()[(size_t)(MPR + sq) * 64 + h];
}
__device__ __forceinline__ void ssd_smp_run(const Frame& F, int it, int p, int nq, const SsdSmpIn& r) {
    const int sq = it >> 5, h = it & 31;
    const float a_h = -__expf(F.in[13][h]), dt = softplusf_(r.dtraw + F.in[12][h]), dc = __expf(dt * a_h), dx = dt * r.x;
    float yp = 0.f; f32x4 o[4];
#pragma unroll
    for (int j = 0; j < 4; ++j) {
        const float bv[4] = {bflo(r.b[j].x), bfhi(r.b[j].x), bflo(r.b[j].y), bfhi(r.b[j].y)}, cv[4] = {bflo(r.c[j].x), bfhi(r.c[j].x), bflo(r.c[j].y), bfhi(r.c[j].y)};
#pragma unroll
        for (int i = 0; i < 4; ++i) { const float hv = dc * r.st[j][i] + dx * bv[i]; o[j][i] = hv; yp += cv[i] * hv; }
    }
    yp += __shfl_xor(yp, 1); yp += __shfl_xor(yp, 2); yp += __shfl_xor(yp, 4);
    float* op = F.out + O_SSMS + ((size_t)(sq * 32 + h) * 64 + p) * 128 + nq * 4;
#pragma unroll
    for (int j = 0; j < 4; ++j) *(f32x4*)(op + 32 * j) = o[j];
    if (nq == 0) { const unsigned w = cvt_pk_bf16(yp + F.in[14][h] * r.x, 0.f); F.PROJ()[(size_t)(MPR + sq) * LDP + C_XS + h * 64 + p] = (bf16_t)(w & 0xffffu); }
}
__device__ __forceinline__ void ssd_sample_stream_regs(const Frame& F, int first) {
    const int p = F.tid >> 3, nq = F.tid & 7;
    constexpr int NIT = NSMP * 32;
    SsdSmpIn r[4];
#pragma unroll
    for (int j = 0; j < 4; ++j) if (first + j * F.G < NIT) ssd_smp_load(F, first + j * F.G, p, nq, r[j]);
    for (int it0 = first; it0 < NIT; it0 += 4 * F.G) {
#pragma unroll
        for (int j = 0; j < 4; ++j) {
            const int it = it0 + j * F.G;
            if (it < NIT) { ssd_smp_run(F, it, p, nq, r[j]); if (it + 4 * F.G < NIT) ssd_smp_load(F, it + 4 * F.G, p, nq, r[j]); }
        }
    }
}
__device__ __forceinline__ void ssd_sample_stream(const Frame& F, int first) {
    constexpr int NIT = NSMP * 32, SLOT = 36864;
    static_assert(4 * SLOT + 512 <= MISC_OFF, "ssd sample ring");
    const int w = F.wave, lane = F.lane;
    LAS unsigned char* L = F.lds;
    const int n = first < NIT ? (NIT - 1 - first) / F.G + 1 : 0;
    LAS float* hp = (LAS float*)(L + 4 * SLOT);
    LDS_BARRIER();
    if (F.tid < 32) { hp[F.tid] = -__expf(F.in[13][F.tid]); hp[32 + F.tid] = F.in[12][F.tid]; hp[64 + F.tid] = F.in[14][F.tid]; }
    LDS_BARRIER();
    if (w < 4) {
#define SSL_ISSUE(k_) do { const int it_ = first + (k_) * F.G, sq_ = it_ >> 5, h_ = it_ & 31; \
            const char* sp_ = (const char*)(F.in[4] + (size_t)it_ * 8192) + (size_t)((w * 8) * 64 + lane) * 16; \
            LAS unsigned char* sl_ = L + ((k_) & 3) * SLOT + w * 8192; \
            _Pragma("unroll") for (int j_ = 0; j_ < 8; ++j_) __builtin_amdgcn_global_load_lds((const unsigned*)(sp_ + j_ * 1024), (LAS unsigned*)(sl_ + j_ * 1024), 16, 0, 0); \
            const bf16_t* row_ = F.PROJ() + (size_t)(MPR + sq_) * LDP; \
            const char* op_ = w == 0 ? (const char*)(row_ + C_B + (h_ >> 3) * 128 + (lane & 15) * 8) : w == 1 ? (const char*)(row_ + C_C + (h_ >> 3) * 128 + (lane & 15) * 8) \
                            : w == 2 ? (const char*)(row_ + C_XS + h_ * 64 + (lane & 7) * 8) : (const char*)(F.SMALL() + (size_t)(MPR + sq_) * 64 + (h_ & ~3)); \
            __builtin_amdgcn_global_load_lds((const unsigned*)op_, (LAS unsigned*)(L + ((k_) & 3) * SLOT + 32768 + w * 1024), 16, 0, 0); } while (0)
        if (n > 0) SSL_ISSUE(0);
        if (n > 1) SSL_ISSUE(1);
        if (n > 2) SSL_ISSUE(2);
        for (int k = 0; k < n; ++k) {
            const int younger = n - 1 - k;
            if (younger >= 2) asm volatile("s_waitcnt vmcnt(18)" ::: "memory"); else if (younger == 1) asm volatile("s_waitcnt vmcnt(9)" ::: "memory"); else asm volatile("s_waitcnt vmcnt(0)" ::: "memory");
            __builtin_amdgcn_s_barrier(); asm volatile("" ::: "memory");
            if (k + 3 < n) SSL_ISSUE(k + 3);
        }
#undef SSL_ISSUE
    } else {
        const int cw = w - 4, nb = lane & 31, hi = lane >> 5;
        for (int k = 0; k < n; ++k) {
            asm volatile("s_waitcnt lgkmcnt(0)" ::: "memory"); __builtin_amdgcn_s_barrier(); asm volatile("" ::: "memory");
            const int it = first + k * F.G, sq = it >> 5, h = it & 31;
            LAS const unsigned char* sl = L + (k & 3) * SLOT;
            const float a_h = hp[h], dtb = hp[32 + h], Dh = hp[64 + h];
            const float dt = softplusf_(*(LAS const float*)(sl + 32768 + 3 * 1024 + (h & 3) * 4) + dtb), dc = __expf(dt * a_h);
            const u32x2 bw = *(LAS const u32x2*)(sl + 32768 + nb * 8), cwd = *(LAS const u32x2*)(sl + 32768 + 1024 + nb * 8);
            const f32x4 bv = (f32x4){bflo(bw.x), bfhi(bw.x), bflo(bw.y), bfhi(bw.y)}, cv = (f32x4){bflo(cwd.x), bfhi(cwd.x), bflo(cwd.y), bfhi(cwd.y)};
            float* op = F.out + O_SSMS + (size_t)it * 8192;
            bf16_t* yrow = F.PROJ() + (size_t)(MPR + sq) * LDP + C_XS + h * 64;
#pragma unroll
            for (int j = 0; j < 8; ++j) {
                const int piece = (cw * 8 + j) * 64 + lane, pr = (cw * 8 + j) * 2 + hi;
                const f32x4 hv = *(LAS const f32x4*)(sl + piece * 16);
                const float xv = bf2f(*(LAS const bf16_t*)(sl + 32768 + 2048 + pr * 2));
                const f32x4 o = hv * dc + bv * (dt * xv);
                *(f32x4*)(op + piece * 4) = o;
                float yp = (cv[0] * o[0] + cv[1] * o[1]) + (cv[2] * o[2] + cv[3] * o[3]);
                yp = xor16_sum(row16_sum(yp));
                if (nb == 0) { const unsigned wv = cvt_pk_bf16(yp + Dh * xv, 0.f); yrow[pr] = (bf16_t)(wv & 0xffffu); }
            }
        }
    }
}
struct GdnSmpIn { float S[8]; u32x4 k8, q8; float v, araw, braw; };
__device__ __forceinline__ void gdn_smp_load(const Frame& F, int it, int e, int kg, GdnSmpIn& r) {
    const int sq = it >> 5, h = (it >> 2) & 7, dvq = it & 3;
    const float* sp = F.in[6] + ((size_t)(sq * 8 + h) * 128 + kg * 8) * 128 + dvq * 32 + e;
#pragma unroll
    for (int j = 0; j < 8; ++j) r.S[j] = sp[(size_t)j * 128];
    const bf16_t* row = F.PROJ() + (size_t)(MPR + sq) * LDP;
    r.k8 = *(const u32x4*)(row + C_K + h * 128 + kg * 8); r.q8 = *(const u32x4*)(row + C_Q + h * 128 + kg * 8);
    r.v = bf2f(row[C_V + h * 128 + dvq * 32 + e]);
    const float* sm = F.SMALL() + (size_t)(MPR + sq) * 64;
    r.araw = sm[40 + h]; r.braw = sm[32 + h];
}
__device__ __forceinline__ void gdn_smp_run(const Frame& F, int it, int e, int kg, const GdnSmpIn& r) {
    const int sq = it >> 5, h = (it >> 2) & 7, dvq = it & 3;
    const float eg = __expf(-__expf(F.in[18][h]) * softplusf_(r.araw + F.in[17][h])), bt = sigmoidf_(r.braw);
    float k8[8], q8[8]; unpack8(r.k8, k8); unpack8(r.q8, q8);
    float ks = 0.f;
#pragma unroll
    for (int j = 0; j < 8; ++j) ks += k8[j] * r.S[j];
    ks += __shfl_xor(ks, 1); ks += __shfl_xor(ks, 2); ks += __shfl_xor(ks, 4); ks += __shfl_xor(ks, 8);
    const float vn = bt * (r.v - eg * ks);
    float op = 0.f, Sn[8];
#pragma unroll
    for (int j = 0; j < 8; ++j) { Sn[j] = eg * r.S[j] + k8[j] * vn; op += q8[j] * Sn[j]; }
    op += __shfl_xor(op, 1); op += __shfl_xor(op, 2); op += __shfl_xor(op, 4); op += __shfl_xor(op, 8);
    float* dp = F.out + O_GDNS + ((size_t)(sq * 8 + h) * 128 + kg * 8) * 128 + dvq * 32 + e;
#pragma unroll
    for (int j = 0; j < 8; ++j) dp[(size_t)j * 128] = Sn[j];
    if (kg == 0) { const unsigned w = cvt_pk_bf16(op, 0.f); F.PROJ()[(size_t)(MPR + sq) * LDP + C_V + h * 128 + dvq * 32 + e] = (bf16_t)(w & 0xffffu); }
}
__device__ __forceinline__ void gdn_sample_stream(const Frame& F, int first) {
    const int e = F.tid >> 4, kg = F.tid & 15;
    constexpr int NIT = NSMP * 32;
    for (int it0 = first; it0 < NIT; it0 += 4 * F.G) {
        GdnSmpIn r[4];
#pragma unroll
        for (int j = 0; j < 4; ++j) if (it0 + j * F.G < NIT) gdn_smp_load(F, it0 + j * F.G, e, kg, r[j]);
#pragma unroll
        for (int j = 0; j < 4; ++j) if (it0 + j * F.G < NIT) gdn_smp_run(F, it0 + j * F.G, e, kg, r[j]);
    }
}


__device__ __forceinline__ void ssd_chunked(Frame& F, int item, int& sit) {
    (void)sit;
    const int b = item >> 5, h = item & 31, g4 = h >> 3;
    const int tid = F.tid, lane = F.lane, w = F.wave, i16 = lane & 15, g = lane >> 4;
    LAS unsigned char* L = F.lds;
    constexpr int PB = 272, PX = 144, PY = 272;
    constexpr int SET = 45120, O_BT = 0, O_CT = 17408, O_XT = 34816, O_SC = 44032;
    constexpr int O_XD = 2 * SET, O_MT = O_XD + 9216, O_SL = O_MT + 9216, O_YT = O_SL + 17408;
    static_assert(O_YT + 64 * PY <= MISC_OFF && O_YT % 16 == 0, "ssd LDS map");
    LAS float* acumA = (LAS float*)(L + O_SC); LAS float* dtlA = acumA + 64; LAS float* sclA = acumA + 128; LAS float* eacA = acumA + 192; LAS float* cdecpA = acumA + 256;
    LAS float* acumB = (LAS float*)(L + SET + O_SC); LAS float* dtlB = acumB + 64; LAS float* sclB = acumB + 128; LAS float* eacB = acumB + 192; LAS float* cdecpB = acumB + 256;
    __syncthreads();
    for (int u = tid; u < 17408 / 16; u += 512) *(LAS u32x4*)(L + O_SL + u * 16) = (u32x4){0u, 0u, 0u, 0u};
    f32x4 sacc[4];
#pragma unroll
    for (int pb = 0; pb < 4; ++pb) sacc[pb] = (f32x4){0.f, 0.f, 0.f, 0.f};
    const float a_h = -__expf(F.in[13][h]), dtb = F.in[12][h], Dh = F.in[14][h];
    const int row00 = b * SEQ;
    u32x4 rbA[2], rcA[2], rxA, rzA, rbB[2], rcB[2], rxB, rzB, zsA, zsB, xsA, xsB; float rdtA = 0.f, rdtB = 0.f;
    zsA = (u32x4){0u, 0u, 0u, 0u}; zsB = zsA; xsA = zsA; xsB = zsA;
    float* SSY = (float*)(F.ws + WS_SSY);
    const int br0 = tid >> 4, bc8 = (tid & 15) * 8;
    const int xr = tid >> 3, xc8 = (tid & 7) * 8;
#define SSD_LOADA(c) do { const bf16_t* src = F.PROJ() + (size_t)(row00 + (c) * 64) * LDP; \
        rbA[0] = *(const u32x4*)(src + (size_t)br0 * LDP + C_B + g4 * 128 + bc8); rbA[1] = *(const u32x4*)(src + (size_t)(br0 + 32) * LDP + C_B + g4 * 128 + bc8); \
        rcA[0] = *(const u32x4*)(src + (size_t)br0 * LDP + C_C + g4 * 128 + bc8); rcA[1] = *(const u32x4*)(src + (size_t)(br0 + 32) * LDP + C_C + g4 * 128 + bc8); \
        rxA = *(const u32x4*)(src + (size_t)xr * LDP + C_XS + h * 64 + xc8); \
        rzA = *(const u32x4*)(src + (size_t)xr * LDP + C_Z + h * 64 + xc8); \
        if (tid < 64) rdtA = F.SMALL()[(size_t)(row00 + (c) * 64 + tid) * 64 + h]; } while (0)
#define SSD_LOADB(c) do { const bf16_t* src = F.PROJ() + (size_t)(row00 + (c) * 64) * LDP; \
        rbB[0] = *(const u32x4*)(src + (size_t)br0 * LDP + C_B + g4 * 128 + bc8); rbB[1] = *(const u32x4*)(src + (size_t)(br0 + 32) * LDP + C_B + g4 * 128 + bc8); \
        rcB[0] = *(const u32x4*)(src + (size_t)br0 * LDP + C_C + g4 * 128 + bc8); rcB[1] = *(const u32x4*)(src + (size_t)(br0 + 32) * LDP + C_C + g4 * 128 + bc8); \
        rxB = *(const u32x4*)(src + (size_t)xr * LDP + C_XS + h * 64 + xc8); \
        rzB = *(const u32x4*)(src + (size_t)xr * LDP + C_Z + h * 64 + xc8); \
        if (tid < 64) rdtB = F.SMALL()[(size_t)(row00 + (c) * 64 + tid) * 64 + h]; } while (0)
#define SSD_STAGE(Q, QS) do { \
        *(LAS u32x4*)(L + QS * SET + O_BT + br0 * PB + bc8 * 2) = rb##Q[0]; *(LAS u32x4*)(L + QS * SET + O_BT + (br0 + 32) * PB + bc8 * 2) = rb##Q[1]; \
        *(LAS u32x4*)(L + QS * SET + O_CT + br0 * PB + bc8 * 2) = rc##Q[0]; *(LAS u32x4*)(L + QS * SET + O_CT + (br0 + 32) * PB + bc8 * 2) = rc##Q[1]; \
        *(LAS u32x4*)(L + QS * SET + O_XT + xr * PX + xc8 * 2) = rx##Q; zs##Q = rz##Q; xs##Q = rx##Q; \
        if (tid < 64) { \
            const float dt_ = softplusf_(rdt##Q + dtb); float v_ = dt_ * a_h; \
            v_ = wave_incl_scan(v_); \
            const float last_ = __builtin_bit_cast(float, __builtin_amdgcn_readlane(__builtin_bit_cast(int, v_), 63)); \
            acum##Q[lane] = v_; dtl##Q[lane] = dt_; scl##Q[lane] = dt_ * __expf(last_ - v_); eac##Q[lane] = __expf(v_); \
            if (lane == 63) cdecp##Q[0] = __expf(v_); } } while (0)
    SSD_LOADA(0); SSD_LOADB(1);
    SSD_STAGE(A, 0);
    SSD_LOADA(2);
    for (int c2 = 0; c2 < SEQ / 128; ++c2) {
        { const int c = 2 * c2;
        LDS_BARRIER();
        if (c > 0) {
            float o[8], z8[8], x8[8]; unpack8(zsB, z8); unpack8(xsB, x8); float ss = 0.f; float yv8[8]; { const f32x4 ya = *(LAS const f32x4*)(L + O_YT + xr * PY + xc8 * 4), yb = *(LAS const f32x4*)(L + O_YT + xr * PY + xc8 * 4 + 16); yv8[0] = ya[0]; yv8[1] = ya[1]; yv8[2] = ya[2]; yv8[3] = ya[3]; yv8[4] = yb[0]; yv8[5] = yb[1]; yv8[6] = yb[2]; yv8[7] = yb[3]; }
#pragma unroll
            for (int i = 0; i < 8; ++i) { o[i] = (yv8[i] + Dh * x8[i]) * siluf_(z8[i]); ss += o[i] * o[i]; }
            *(u32x4*)(F.PROJ() + (size_t)(row00 + (c - 1) * 64 + xr) * LDP + C_XS + h * 64 + xc8) = pack8(o);
            ss += dpp_mov<0xB1>(ss); ss += dpp_mov<0x4E>(ss); ss += dpp_mov<0x141>(ss);
            if ((tid & 7) == 0) atomicAdd(SSY + (size_t)(row00 + (c - 1) * 64 + xr) * 4 + g4, ss);
        }
        if (c + 1 < SEQ / 64) {
            SSD_STAGE(B, 1);
            if (c + 3 < SEQ / 64) SSD_LOADB(c + 3);
        }
        { float x8[8]; unpack8(*(LAS const u32x4*)(L + 0 * SET + O_XT + xr * PX + xc8 * 2), x8); const float sc = sclA[xr];
#pragma unroll
          for (int i = 0; i < 8; ++i) x8[i] *= sc;
          *(LAS u32x4*)(L + O_XD + xr * PX + xc8 * 2) = pack8(x8); }
#pragma unroll
        for (int tt = 0; tt < 2; ++tt) {
            const int t = 2 * w + tt, lb = t >> 2, sb = t & 3;
            const int l = 16 * lb + i16;
            u32x2 mw = (u32x2){0u, 0u};
            if (sb <= lb) {
                f32x4 acc = (f32x4){0.f, 0.f, 0.f, 0.f};
#pragma unroll
                for (int ks = 0; ks < 4; ++ks) acc = MFMA16(row_frag(L + 0 * SET + O_BT, PB, 16 * sb, 32 * ks, lane), row_frag(L + 0 * SET + O_CT, PB, 16 * lb, 32 * ks, lane), acc);
                const float al = acumA[l];
                const f32x4 as4 = *(LAS const f32x4*)(acumA + 16 * sb + 4 * g), dt4 = *(LAS const f32x4*)(dtlA + 16 * sb + 4 * g);
                float mv[4];
#pragma unroll
                for (int r = 0; r < 4; ++r) { const int s = 16 * sb + 4 * g + r; const float e = __expf(al - as4[r]) * dt4[r] * acc[r]; mv[r] = (s <= l) ? e : 0.f; }
                mw = pack4(mv[0], mv[1], mv[2], mv[3]);
            }
            *(LAS u32x2*)(L + O_MT + l * PX + (16 * sb + 4 * g) * 2) = mw;
        }
        f32x4 yacc[2];
        const int lb = w >> 1;
#pragma unroll
        for (int tt = 0; tt < 2; ++tt) {
            const int pb = 2 * (w & 1) + tt;
            f32x4 acc = (f32x4){0.f, 0.f, 0.f, 0.f};
#pragma unroll
            for (int ks = 0; ks < 4; ++ks) acc = MFMA16(row_frag(L + 0 * SET + O_CT, PB, 16 * lb, 32 * ks, lane), row_frag(L + O_SL, PB, 16 * pb, 32 * ks, lane), acc);
            acc *= *(LAS const f32x4*)(eacA + 16 * lb + 4 * g);
            yacc[tt] = acc;
        }
        LDS_BARRIER();
#pragma unroll
        for (int tt = 0; tt < 2; ++tt) {
            const int pb = 2 * (w & 1) + tt;
            f32x4 acc = yacc[tt];
            acc = MFMA16(row_frag(L + O_MT, PX, 16 * lb, 0, lane), tr_frag(L + 0 * SET + O_XT, PX, 0, 16 * pb, lane), acc);
            if (lb >= 2) acc = MFMA16(row_frag(L + O_MT, PX, 16 * lb, 32, lane), tr_frag(L + 0 * SET + O_XT, PX, 32, 16 * pb, lane), acc);
#pragma unroll
            for (int r = 0; r < 4; ++r) { const int l = 16 * lb + 4 * g + r, p = 16 * pb + i16;
                *(LAS float*)(L + O_YT + l * PY + p * 4) = acc[r]; }
        }
        { const float cdec = cdecpA[0];
#pragma unroll
          for (int pb = 0; pb < 4; ++pb) sacc[pb] *= cdec;
#pragma unroll
          for (int ks = 0; ks < 2; ++ks) {
              const bf16x8 a = tr_frag(L + 0 * SET + O_BT, PB, 32 * ks, 16 * w, lane);
#pragma unroll
              for (int pb = 0; pb < 4; ++pb) sacc[pb] = MFMA16(a, tr_frag(L + O_XD, PX, 32 * ks, 16 * pb, lane), sacc[pb]);
          }
#pragma unroll
          for (int pb = 0; pb < 4; ++pb) *(LAS u32x2*)(L + O_SL + (16 * pb + i16) * PB + (16 * w + 4 * g) * 2) = pack4(sacc[pb][0], sacc[pb][1], sacc[pb][2], sacc[pb][3]);
        }
        }
        { const int c = 2 * c2 + 1;
        LDS_BARRIER();
        if (c > 0) {
            float o[8], z8[8], x8[8]; unpack8(zsA, z8); unpack8(xsA, x8); float ss = 0.f; float yv8[8]; { const f32x4 ya = *(LAS const f32x4*)(L + O_YT + xr * PY + xc8 * 4), yb = *(LAS const f32x4*)(L + O_YT + xr * PY + xc8 * 4 + 16); yv8[0] = ya[0]; yv8[1] = ya[1]; yv8[2] = ya[2]; yv8[3] = ya[3]; yv8[4] = yb[0]; yv8[5] = yb[1]; yv8[6] = yb[2]; yv8[7] = yb[3]; }
#pragma unroll
            for (int i = 0; i < 8; ++i) { o[i] = (yv8[i] + Dh * x8[i]) * siluf_(z8[i]); ss += o[i] * o[i]; }
            *(u32x4*)(F.PROJ() + (size_t)(row00 + (c - 1) * 64 + xr) * LDP + C_XS + h * 64 + xc8) = pack8(o);
            ss += dpp_mov<0xB1>(ss); ss += dpp_mov<0x4E>(ss); ss += dpp_mov<0x141>(ss);
            if ((tid & 7) == 0) atomicAdd(SSY + (size_t)(row00 + (c - 1) * 64 + xr) * 4 + g4, ss);
        }
        if (c + 1 < SEQ / 64) {
            SSD_STAGE(A, 0);
            if (c + 3 < SEQ / 64) SSD_LOADA(c + 3);
        }
        { float x8[8]; unpack8(*(LAS const u32x4*)(L + 1 * SET + O_XT + xr * PX + xc8 * 2), x8); const float sc = sclB[xr];
#pragma unroll
          for (int i = 0; i < 8; ++i) x8[i] *= sc;
          *(LAS u32x4*)(L + O_XD + xr * PX + xc8 * 2) = pack8(x8); }
#pragma unroll
        for (int tt = 0; tt < 2; ++tt) {
            const int t = 2 * w + tt, lb = t >> 2, sb = t & 3;
            const int l = 16 * lb + i16;
            u32x2 mw = (u32x2){0u, 0u};
            if (sb <= lb) {
                f32x4 acc = (f32x4){0.f, 0.f, 0.f, 0.f};
#pragma unroll
                for (int ks = 0; ks < 4; ++ks) acc = MFMA16(row_frag(L + 1 * SET + O_BT, PB, 16 * sb, 32 * ks, lane), row_frag(L + 1 * SET + O_CT, PB, 16 * lb, 32 * ks, lane), acc);
                const float al = acumB[l];
                const f32x4 as4 = *(LAS const f32x4*)(acumB + 16 * sb + 4 * g), dt4 = *(LAS const f32x4*)(dtlB + 16 * sb + 4 * g);
                float mv[4];
#pragma unroll
                for (int r = 0; r < 4; ++r) { const int s = 16 * sb + 4 * g + r; const float e = __expf(al - as4[r]) * dt4[r] * acc[r]; mv[r] = (s <= l) ? e : 0.f; }
                mw = pack4(mv[0], mv[1], mv[2], mv[3]);
            }
            *(LAS u32x2*)(L + O_MT + l * PX + (16 * sb + 4 * g) * 2) = mw;
        }
        f32x4 yacc[2];
        const int lb = w >> 1;
#pragma unroll
        for (int tt = 0; tt < 2; ++tt) {
            const int pb = 2 * (w & 1) + tt;
            f32x4 acc = (f32x4){0.f, 0.f, 0.f, 0.f};
#pragma unroll
            for (int ks = 0; ks < 4; ++ks) acc = MFMA16(row_frag(L + 1 * SET + O_CT, PB, 16 * lb, 32 * ks, lane), row_frag(L + O_SL, PB, 16 * pb, 32 * ks, lane), acc);
            acc *= *(LAS const f32x4*)(eacB + 16 * lb + 4 * g);
            yacc[tt] = acc;
        }
        LDS_BARRIER();
#pragma unroll
        for (int tt = 0; tt < 2; ++tt) {
            const int pb = 2 * (w & 1) + tt;
            f32x4 acc = yacc[tt];
            acc = MFMA16(row_frag(L + O_MT, PX, 16 * lb, 0, lane), tr_frag(L + 1 * SET + O_XT, PX, 0, 16 * pb, lane), acc);
            if (lb >= 2) acc = MFMA16(row_frag(L + O_MT, PX, 16 * lb, 32, lane), tr_frag(L + 1 * SET + O_XT, PX, 32, 16 * pb, lane), acc);
#pragma unroll
            for (int r = 0; r < 4; ++r) { const int l = 16 * lb + 4 * g + r, p = 16 * pb + i16;
                *(LAS float*)(L + O_YT + l * PY + p * 4) = acc[r]; }
        }
        { const float cdec = cdecpB[0];
#pragma unroll
          for (int pb = 0; pb < 4; ++pb) sacc[pb] *= cdec;
#pragma unroll
          for (int ks = 0; ks < 2; ++ks) {
              const bf16x8 a = tr_frag(L + 1 * SET + O_BT, PB, 32 * ks, 16 * w, lane);
#pragma unroll
              for (int pb = 0; pb < 4; ++pb) sacc[pb] = MFMA16(a, tr_frag(L + O_XD, PX, 32 * ks, 16 * pb, lane), sacc[pb]);
          }
#pragma unroll
          for (int pb = 0; pb < 4; ++pb) *(LAS u32x2*)(L + O_SL + (16 * pb + i16) * PB + (16 * w + 4 * g) * 2) = pack4(sacc[pb][0], sacc[pb][1], sacc[pb][2], sacc[pb][3]);
        }
        }
    }
    LDS_BARRIER();
    {
        float o[8], z8[8], x8[8]; unpack8(zsB, z8); unpack8(xsB, x8); float ss = 0.f; float yv8[8]; { const f32x4 ya = *(LAS const f32x4*)(L + O_YT + xr * PY + xc8 * 4), yb = *(LAS const f32x4*)(L + O_YT + xr * PY + xc8 * 4 + 16); yv8[0] = ya[0]; yv8[1] = ya[1]; yv8[2] = ya[2]; yv8[3] = ya[3]; yv8[4] = yb[0]; yv8[5] = yb[1]; yv8[6] = yb[2]; yv8[7] = yb[3]; }
#pragma unroll
        for (int i = 0; i < 8; ++i) { o[i] = (yv8[i] + Dh * x8[i]) * siluf_(z8[i]); ss += o[i] * o[i]; }
        *(u32x4*)(F.PROJ() + (size_t)(row00 + (SEQ / 64 - 1) * 64 + xr) * LDP + C_XS + h * 64 + xc8) = pack8(o);
        ss += dpp_mov<0xB1>(ss); ss += dpp_mov<0x4E>(ss); ss += dpp_mov<0x141>(ss);
        if ((tid & 7) == 0) atomicAdd(SSY + (size_t)(row00 + (SEQ / 64 - 1) * 64 + xr) * 4 + g4, ss);
    }
#undef SSD_LOADA
#undef SSD_LOADB
#undef SSD_STAGE
#pragma unroll
    for (int pb = 0; pb < 4; ++pb) *(f32x4*)(F.out + O_SSMP + ((size_t)(b * 32 + h) * 64 + 16 * pb + i16) * 128 + 16 * w + 4 * g) = sacc[pb];
}


__device__ __forceinline__ void gdn_prep(Frame& F, int it, int hb) {
    const int c = it & 31, bh = it >> 5, h = bh & 7, b = bh >> 3;
    const int ht = F.tid & 255, lane = F.lane, hw = F.wave & 3, i16 = lane & 15, g = lane >> 4;
    LAS unsigned char* L = F.lds + hb * 65536;
    constexpr int PB = 272;
    constexpr int O_KT = 0, O_QT = 17408, O_VT = 34816, O_SC = 52224;
    LAS float* gc = (LAS float*)(L + O_SC); LAS float* bt = gc + 64; LAS float* egc = gc + 128;
    const int row0 = b * SEQ + c * 64;
    __syncthreads();
    {
        u32x4 rk[4], rq[4], rv[4];
#pragma unroll
        for (int j = 0; j < 4; ++j) { const int pc = ht + j * 256, r = pc >> 4, c8 = (pc & 15) * 8; const bf16_t* src = F.PROJ() + (size_t)(row0 + r) * LDP + h * 128 + c8;
            rk[j] = *(const u32x4*)(src + C_K); rq[j] = *(const u32x4*)(src + C_Q); rv[j] = *(const u32x4*)(src + C_V); }
        if (ht < 64) {
            const float* sm = F.SMALL() + (size_t)(row0 + lane) * 64;
            const float na = -__expf(F.in[18][h]), dtb = F.in[17][h];
            float v = na * softplusf_(sm[40 + h] + dtb);
            const float be = sigmoidf_(sm[32 + h]);
            v = wave_incl_scan(v);
            gc[lane] = v; bt[lane] = be; egc[lane] = __expf(v);
            ((float*)(F.ws + WS_GC))[(size_t)it * 64 + lane] = v;
        }
#pragma unroll
        for (int j = 0; j < 4; ++j) { const int pc = ht + j * 256, r = pc >> 4, c8 = (pc & 15) * 8;
            *(LAS u32x4*)(L + O_KT + r * PB + c8 * 2) = rk[j]; *(LAS u32x4*)(L + O_QT + r * PB + c8 * 2) = rq[j]; *(LAS u32x4*)(L + O_VT + r * PB + c8 * 2) = rv[j]; }
    }
    __syncthreads();
    f32x4 kk[4];
    const int lb = hw;
    bf16_t* qkm = (bf16_t*)(F.ws + WS_QKM) + (size_t)it * 4096;
#pragma unroll
    for (int sb = 0; sb < 4; ++sb) {
        kk[sb] = (f32x4){0.f, 0.f, 0.f, 0.f};
        const int l = 16 * lb + i16;
        u32x2 qw = (u32x2){0u, 0u};
        if (sb <= lb) {
            f32x4 qa = (f32x4){0.f, 0.f, 0.f, 0.f};
#pragma unroll
            for (int ks = 0; ks < 4; ++ks) {
                const bf16x8 ks_ = row_frag(L + O_KT, PB, 16 * sb, 32 * ks, lane);
                kk[sb] = MFMA16(row_frag(L + O_KT, PB, 16 * lb, 32 * ks, lane), ks_, kk[sb]);
                qa = MFMA16(ks_, row_frag(L + O_QT, PB, 16 * lb, 32 * ks, lane), qa);
            }
            const float gl = gc[l];
            float qv[4];
#pragma unroll
            for (int r = 0; r < 4; ++r) { const int s_ = 16 * sb + 4 * g + r; const float e = __expf(gl - gc[s_]) * qa[r]; qv[r] = (s_ <= l) ? e : 0.f; }
            qw = pack4(qv[0], qv[1], qv[2], qv[3]);
        }
        *(u32x2*)(qkm + l * 64 + 16 * sb + 4 * g) = qw;
    }
    __syncthreads();
#pragma unroll
    for (int sb = 0; sb < 4; ++sb) {
        if (sb <= lb) {
#pragma unroll
            for (int r = 0; r < 4; ++r) { const int l = 16 * lb + 4 * g + r, s_ = 16 * sb + i16;
                const float a = (s_ < l) ? bt[l] * kk[sb][r] * __expf(gc[l] - gc[s_]) : 0.f;
                *(LAS float*)(L + O_QT + l * PB + s_ * 4) = a; }
        }
    }
    __syncthreads();
    float x[64];
    {
        const bool isv = ht < 128;
        LAS const unsigned char* colp = L + (isv ? O_VT : O_KT) + (ht & 127) * 2;
#pragma unroll
        for (int l = 0; l < 64; ++l) { const float v = bf2f(*(LAS const bf16_t*)(colp + l * PB)); x[l] = v * bt[l] * (isv ? 1.0f : egc[l]); }
    }
#pragma unroll
    for (int l = 1; l < 64; ++l) {
        float acc0 = x[l], acc1 = 0.f;
#pragma unroll
        for (int s4 = 0; s4 < (l + 3) / 4; ++s4) {
            const f32x4 a = *(LAS const f32x4*)(L + O_QT + l * PB + s4 * 16);
#pragma unroll
            for (int j = 0; j < 4; ++j) if (4 * s4 + j < l) { if (j & 1) asm("v_fma_f32 %0, -%1, %2, %0" : "+v"(acc1) : "v"(a[j]), "v"(x[4 * s4 + j])); else asm("v_fma_f32 %0, -%1, %2, %0" : "+v"(acc0) : "v"(a[j]), "v"(x[4 * s4 + j])); }
        }
        x[l] = acc0 + acc1;
        asm volatile("" ::: "memory");
    }
    {
        const bool isv = ht < 128;
        bf16_t* dst = (bf16_t*)(F.ws + (isv ? WS_UT : WS_WT)) + (size_t)it * 8192 + (ht & 127) * 64;
        const float sg = isv ? 1.0f : -1.0f;
#pragma unroll
        for (int q8 = 0; q8 < 8; ++q8) { float o[8];
#pragma unroll
            for (int i = 0; i < 8; ++i) o[i] = sg * x[8 * q8 + i];
            *(u32x4*)(dst + 8 * q8) = pack8(o); }
    }
}

__device__ __forceinline__ bf16x8 frag2(u32x2 lo, u32x2 hi) { return __builtin_bit_cast(bf16x8, (u32x4){lo.x, lo.y, hi.x, hi.y}); }
struct PrepIn { u32x4 rk[4], rq[4], rv[4]; float araw, braw; };
__device__ __forceinline__ void prep_load(const Frame& F, int it, PrepIn& r) {
    const int c = it & 31, bh = it >> 5, h = bh & 7, b = bh >> 3, ht = F.tid & 255, row0 = b * SEQ + c * 64;
#pragma unroll
    for (int j = 0; j < 4; ++j) { const int pc = ht + j * 256, rr = pc >> 4, c8 = (pc & 15) * 8; const bf16_t* src = F.PROJ() + (size_t)(row0 + rr) * LDP + h * 128 + c8;
        r.rk[j] = *(const u32x4*)(src + C_K); r.rq[j] = *(const u32x4*)(src + C_Q); r.rv[j] = *(const u32x4*)(src + C_V); }
    r.araw = 0.f; r.braw = 0.f;
    if (ht < 64) { const float* sm = F.SMALL() + (size_t)(row0 + F.lane) * 64; r.araw = sm[40 + h]; r.braw = sm[32 + h]; }
}
__device__ __forceinline__ void gdn_prep3(Frame& F, int it, int hb, PrepIn& cur, int it_next, bool more) {
    const int c = it & 31, bh = it >> 5, h = bh & 7, b = bh >> 3;
    const int ht = F.tid & 255, lane = F.lane, hw = F.wave & 3, i16 = lane & 15, g = lane >> 4;
    LAS unsigned char* L = F.lds + hb * 65536;
    constexpr int PB = 272, PAL = 136, PAD = 80, PLI = 40;
    constexpr int O_KT = 0, O_QT = 17408, O_VT = 34816, O_SC = 52224, O_LI = 53248;
    constexpr int O_AL = O_QT, O_AD = O_QT + 8704;
    LAS float* gc = (LAS float*)(L + O_SC); LAS float* bt = gc + 64; LAS float* egc = gc + 128;
    (void)b; (void)c;
    LDS_BARRIER();
    PrepIn nxt;
    {
        if (ht < 64) {
            const float na = -__expf(F.in[18][h]), dtb = F.in[17][h];
            float v = na * softplusf_(cur.araw + dtb);
            const float be = sigmoidf_(cur.braw);
            v = wave_incl_scan(v);
            gc[lane] = v; bt[lane] = be; egc[lane] = __expf(v);
            ((float*)(F.ws + WS_GC))[(size_t)it * 64 + lane] = v;
        }
#pragma unroll
        for (int j = 0; j < 4; ++j) { const int pc = ht + j * 256, r = pc >> 4, c8 = (pc & 15) * 8;
            *(LAS u32x4*)(L + O_KT + r * PB + c8 * 2) = cur.rk[j]; *(LAS u32x4*)(L + O_QT + r * PB + c8 * 2) = cur.rq[j]; *(LAS u32x4*)(L + O_VT + r * PB + c8 * 2) = cur.rv[j]; }
    }
    LDS_BARRIER();
    const int lb = hw, lq = 16 * lb + i16;
    bf16_t* qkm = (bf16_t*)(F.ws + WS_QKM) + (size_t)it * 4096;
    f32x4 kkt[4];
#pragma unroll
    for (int sb = 0; sb < 4; ++sb) {
        kkt[sb] = (f32x4){0.f, 0.f, 0.f, 0.f};
        u32x2 qw = (u32x2){0u, 0u};
        if (sb <= lb) {
            f32x4 qa = (f32x4){0.f, 0.f, 0.f, 0.f};
#pragma unroll
            for (int ks = 0; ks < 4; ++ks) {
                const bf16x8 ks_ = row_frag(L + O_KT, PB, 16 * sb, 32 * ks, lane);
                kkt[sb] = MFMA16(ks_, row_frag(L + O_KT, PB, 16 * lb, 32 * ks, lane), kkt[sb]);
                qa = MFMA16(ks_, row_frag(L + O_QT, PB, 16 * lb, 32 * ks, lane), qa);
            }
            const float gl = gc[lq];
            float qv[4];
#pragma unroll
            for (int r = 0; r < 4; ++r) { const int s_ = 16 * sb + 4 * g + r; const float e = __expf(gl - gc[s_]) * qa[r]; qv[r] = (s_ <= lq) ? e : 0.f; }
            qw = pack4(qv[0], qv[1], qv[2], qv[3]);
        }
        *(u32x2*)(qkm + lq * 64 + 16 * sb + 4 * g) = qw;
    }
    LDS_BARRIER();
    {
        const float gl = gc[lq], bl = bt[lq];
#pragma unroll
        for (int sb = 0; sb < 4; ++sb) {
            if (sb <= lb) {
                float a[4];
#pragma unroll
                for (int r = 0; r < 4; ++r) { const int s_ = 16 * sb + 4 * g + r; const float e = bl * kkt[sb][r] * __expf(gl - gc[s_]); a[r] = (s_ < lq) ? e : 0.f; }
                if (sb < lb) *(LAS u32x2*)(L + O_AL + lq * PAL + (16 * sb + 4 * g) * 2) = pack4(-a[0], -a[1], -a[2], -a[3]);
                else         *(LAS f32x4*)(L + O_AD + lb * (16 * PAD) + i16 * PAD + g * 16) = (f32x4){a[0], a[1], a[2], a[3]};
            }
        }
    }
    f32x4 R[4][4];
    {
        const bool isv = hw < 2;
        LAS const unsigned char* colp = L + (isv ? O_VT : O_KT) + ((64 * hw + i16) & 127) * 2;
#pragma unroll
        for (int i = 0; i < 4; ++i)
#pragma unroll
            for (int r = 0; r < 4; ++r) { const int l = 16 * i + 4 * g + r; const float sc = bt[l] * (isv ? 1.0f : egc[l]);
#pragma unroll
                for (int ct = 0; ct < 4; ++ct) R[ct][i][r] = bf2f(*(LAS const bf16_t*)(colp + l * PB + ct * 32)) * sc; }
    }
    LDS_BARRIER();
    if (lane < 16) {
        float x[16];
        LAS const unsigned char* ad = L + O_AD + hw * (16 * PAD);
#pragma unroll
        for (int l = 0; l < 16; ++l) {
            float acc = (l == lane) ? 1.0f : 0.f;
#pragma unroll
            for (int s4 = 0; s4 < (l + 3) / 4; ++s4) { const f32x4 a = *(LAS const f32x4*)(ad + l * PAD + s4 * 16);
#pragma unroll
                for (int j = 0; j < 4; ++j) if (4 * s4 + j < l) acc -= a[j] * x[4 * s4 + j]; }
            x[l] = acc;
            { const unsigned w = cvt_pk_bf16(acc, 0.f); *(LAS bf16_t*)(L + O_LI + hw * (16 * PLI) + l * PLI + lane * 2) = (bf16_t)(w & 0xffffu); }
        }
    }
    LDS_BARRIER();
    {
        const bool isv = hw < 2;
        bf16_t* dst = (bf16_t*)(F.ws + (isv ? WS_UT : WS_WT)) + (size_t)it * 8192;
        const unsigned sgn = isv ? 0u : 0x80008000u;
        const u32x2 z2 = (u32x2){0u, 0u};
        u32x2 li[4];
#pragma unroll
        for (int i = 0; i < 4; ++i) li[i] = *(LAS const u32x2*)(L + O_LI + i * (16 * PLI) + i16 * PLI + 4 * g * 2);
#pragma unroll
        for (int ct = 0; ct < 4; ++ct) {
            u32x2 xb[4];
#pragma unroll
            for (int i = 0; i < 4; ++i) {
                f32x4 y = R[ct][i];
                if (i >= 1) {
                    const u32x2 a0 = *(LAS const u32x2*)(L + O_AL + (16 * i + i16) * PAL + (0 + 4 * g) * 2);
                    const u32x2 a1 = i >= 2 ? *(LAS const u32x2*)(L + O_AL + (16 * i + i16) * PAL + (16 + 4 * g) * 2) : z2;
                    y = MFMA16(frag2(a0, a1), frag2(xb[0], i >= 2 ? xb[1] : z2), y);
                }
                if (i == 3) {
                    const u32x2 a2 = *(LAS const u32x2*)(L + O_AL + (48 + i16) * PAL + (32 + 4 * g) * 2);
                    y = MFMA16(frag2(a2, z2), frag2(xb[2], z2), y);
                }
                const f32x4 zacc = {0.f, 0.f, 0.f, 0.f};
                const f32x4 x = MFMA16(frag2(li[i], z2), frag2(pack4(y[0], y[1], y[2], y[3]), z2), zacc);
                xb[i] = pack4(x[0], x[1], x[2], x[3]);
                *(u32x2*)(dst + ((64 * hw + 16 * ct + i16) & 127) * 64 + 16 * i + 4 * g) = (u32x2){xb[i].x ^ sgn, xb[i].y ^ sgn};
            }
        }
    }
    if (more) cur = nxt;
}

__device__ __forceinline__ void gdn_scan(Frame& F, int item, int& sit) {
    (void)sit;
    const int dvq = item & 3, bh = item >> 2, h = bh & 7, b = bh >> 3;
    const int tid = F.tid, lane = F.lane, w = F.wave, i16 = lane & 15, g = lane >> 4;
    LAS unsigned char* L = F.lds;
    constexpr int PB = 272, PX = 144, PO = 144;
    constexpr int SET = 67072, O_WT = 0, O_QG = 18432, O_KG = 35840, O_QK = 53248, O_UT = 62464;
    constexpr int O_ST = 2 * SET, O_VN = O_ST + 8704, O_OT = O_VN + 4608;
    static_assert(O_OT + 64 * PO <= MISC_OFF && O_OT % 16 == 0, "gdn LDS map");
    __syncthreads();
    for (int u = tid; u < 8704 / 16; u += 512) *(LAS u32x4*)(L + O_ST + u * 16) = (u32x4){0u, 0u, 0u, 0u};
    f32x4 sacc[2];
    sacc[0] = (f32x4){0.f, 0.f, 0.f, 0.f}; sacc[1] = sacc[0];
    const int lb = w >> 1, eb = w & 1;
    const int r0 = tid >> 4, c8a = (tid & 15) * 8;
    const int xr = tid >> 3, xc8 = (tid & 7) * 8;
    const float* GC = (const float*)(F.ws + WS_GC);
    u32x4 rwA[2], rqA[2], rkA[2], rqkA, ruA, rgA, rwB[2], rqB[2], rkB[2], rqkB, ruB, rgB, gsA, gsB;
    gsA = (u32x4){0u, 0u, 0u, 0u}; gsB = gsA;
    float* SSO = (float*)(F.ws + WS_SSO); const float* gg = F.in[19];
    const f32x4 g0 = *(const f32x4*)(gg + dvq * 32 + (tid & 3) * 8), g1 = *(const f32x4*)(gg + dvq * 32 + (tid & 3) * 8 + 4);
    float gq0A = 0.f, gq1A = 0.f, glastA = 0.f, gq0B = 0.f, gq1B = 0.f, glastB = 0.f, glvA = 1.f, glvB = 1.f;
#define GDN_LOADA(c) do { const size_t it_ = (size_t)bh * 32 + (c); \
        const bf16_t* wt = (const bf16_t*)(F.ws + WS_WT) + it_ * 8192; rwA[0] = *(const u32x4*)(wt + xr * 64 + xc8); rwA[1] = *(const u32x4*)(wt + (xr + 64) * 64 + xc8); \
        const bf16_t* src = F.PROJ() + (size_t)(b * SEQ + (c) * 64) * LDP + h * 128 + c8a; \
        rqA[0] = *(const u32x4*)(src + (size_t)r0 * LDP + C_Q); rqA[1] = *(const u32x4*)(src + (size_t)(r0 + 32) * LDP + C_Q); \
        rkA[0] = *(const u32x4*)(src + (size_t)r0 * LDP + C_K); rkA[1] = *(const u32x4*)(src + (size_t)(r0 + 32) * LDP + C_K); \
        rqkA = *(const u32x4*)((const bf16_t*)(F.ws + WS_QKM) + it_ * 4096 + xr * 64 + xc8); \
        if (tid < 256) ruA = *(const u32x4*)((const bf16_t*)(F.ws + WS_UT) + it_ * 8192 + (dvq * 32 + xr) * 64 + xc8); \
        if (tid < 256) rgA = *(const u32x4*)(F.PROJ() + (size_t)(b * SEQ + (c) * 64 + (tid >> 2)) * LDP + C_GATE + h * 128 + dvq * 32 + (tid & 3) * 8); \
        gq0A = GC[it_ * 64 + r0]; gq1A = GC[it_ * 64 + r0 + 32]; glastA = GC[it_ * 64 + 63]; } while (0)
#define GDN_LOADB(c) do { const size_t it_ = (size_t)bh * 32 + (c); \
        const bf16_t* wt = (const bf16_t*)(F.ws + WS_WT) + it_ * 8192; rwB[0] = *(const u32x4*)(wt + xr * 64 + xc8); rwB[1] = *(const u32x4*)(wt + (xr + 64) * 64 + xc8); \
        const bf16_t* src = F.PROJ() + (size_t)(b * SEQ + (c) * 64) * LDP + h * 128 + c8a; \
        rqB[0] = *(const u32x4*)(src + (size_t)r0 * LDP + C_Q); rqB[1] = *(const u32x4*)(src + (size_t)(r0 + 32) * LDP + C_Q); \
        rkB[0] = *(const u32x4*)(src + (size_t)r0 * LDP + C_K); rkB[1] = *(const u32x4*)(src + (size_t)(r0 + 32) * LDP + C_K); \
        rqkB = *(const u32x4*)((const bf16_t*)(F.ws + WS_QKM) + it_ * 4096 + xr * 64 + xc8); \
        if (tid < 256) ruB = *(const u32x4*)((const bf16_t*)(F.ws + WS_UT) + it_ * 8192 + (dvq * 32 + xr) * 64 + xc8); \
        if (tid < 256) rgB = *(const u32x4*)(F.PROJ() + (size_t)(b * SEQ + (c) * 64 + (tid >> 2)) * LDP + C_GATE + h * 128 + dvq * 32 + (tid & 3) * 8); \
        gq0B = GC[it_ * 64 + r0]; gq1B = GC[it_ * 64 + r0 + 32]; glastB = GC[it_ * 64 + 63]; } while (0)
#define GDN_STAGE(Q, QS) do { \
        *(LAS u32x4*)(L + QS * SET + O_WT + xr * PX + xc8 * 2) = rw##Q[0]; *(LAS u32x4*)(L + QS * SET + O_WT + (xr + 64) * PX + xc8 * 2) = rw##Q[1]; \
        *(LAS u32x4*)(L + QS * SET + O_QK + xr * PX + xc8 * 2) = rqk##Q; \
        if (tid < 256) *(LAS u32x4*)(L + QS * SET + O_UT + xr * PX + xc8 * 2) = ru##Q; \
        gs##Q = rg##Q; glv##Q = __expf(glast##Q); \
        { float t8_[8]; const float eq0_ = __expf(gq0##Q), eq1_ = __expf(gq1##Q), ek0_ = __expf(glast##Q - gq0##Q), ek1_ = __expf(glast##Q - gq1##Q); \
          unpack8(rq##Q[0], t8_); _Pragma("unroll") for (int i_ = 0; i_ < 8; ++i_) t8_[i_] *= eq0_; *(LAS u32x4*)(L + QS * SET + O_QG + r0 * PB + c8a * 2) = pack8(t8_); \
          unpack8(rq##Q[1], t8_); _Pragma("unroll") for (int i_ = 0; i_ < 8; ++i_) t8_[i_] *= eq1_; *(LAS u32x4*)(L + QS * SET + O_QG + (r0 + 32) * PB + c8a * 2) = pack8(t8_); \
          unpack8(rk##Q[0], t8_); _Pragma("unroll") for (int i_ = 0; i_ < 8; ++i_) t8_[i_] *= ek0_; *(LAS u32x4*)(L + QS * SET + O_KG + r0 * PB + c8a * 2) = pack8(t8_); \
          unpack8(rk##Q[1], t8_); _Pragma("unroll") for (int i_ = 0; i_ < 8; ++i_) t8_[i_] *= ek1_; *(LAS u32x4*)(L + QS * SET + O_KG + (r0 + 32) * PB + c8a * 2) = pack8(t8_); } } while (0)
    GDN_LOADA(0); GDN_LOADB(1);
    GDN_STAGE(A, 0);
    GDN_LOADA(2);
    for (int c2 = 0; c2 < SEQ / 128; ++c2) {
        { const int c = 2 * c2;
        LDS_BARRIER();
        if (c > 0 && tid < 256) {
            const int r = tid >> 2, c8 = (tid & 3) * 8; float o[8], gt[8]; unpack8(gsB, gt); float ss = 0.f; const f32x4 oa4 = *(LAS const f32x4*)(L + O_OT + r * PO + c8 * 4), ob4 = *(LAS const f32x4*)(L + O_OT + r * PO + c8 * 4 + 16);
#pragma unroll
            for (int i = 0; i < 8; ++i) { const float ov = i < 4 ? oa4[i & 3] : ob4[i & 3]; ss += ov * ov; o[i] = ov * (i < 4 ? g0[i & 3] : g1[i & 3]) * siluf_(gt[i]); }
            *(u32x4*)(F.PROJ() + (size_t)(b * SEQ + (c - 1) * 64 + r) * LDP + C_B + h * 128 + dvq * 32 + c8) = pack8(o);
            ss += dpp_mov<0xB1>(ss); ss += dpp_mov<0x4E>(ss);
            if ((tid & 3) == 0) atomicAdd(SSO + (size_t)(b * SEQ + (c - 1) * 64 + r) * 8 + h, ss);
        }
        if (c + 1 < SEQ / 64) {
            GDN_STAGE(B, 1);
            if (c + 3 < SEQ / 64) GDN_LOADB(c + 3);
        }
        f32x4 vacc, oacc = (f32x4){0.f, 0.f, 0.f, 0.f};
        { const u32x2 uw = *(LAS const u32x2*)(L + 0 * SET + O_UT + (16 * eb + i16) * PX + (16 * lb + 4 * g) * 2);
          vacc = (f32x4){bflo(uw.x), bfhi(uw.x), bflo(uw.y), bfhi(uw.y)}; }
#pragma unroll
        for (int ks = 0; ks < 4; ++ks) {
            const bf16x8 bS = row_frag(L + O_ST, PB, 16 * eb, 32 * ks, lane);
            vacc = MFMA16(tr_frag(L + 0 * SET + O_WT, PX, 32 * ks, 16 * lb, lane), bS, vacc);
            oacc = MFMA16(row_frag(L + 0 * SET + O_QG, PB, 16 * lb, 32 * ks, lane), bS, oacc);
        }
        *(LAS u32x2*)(L + O_VN + (16 * eb + i16) * PX + (16 * lb + 4 * g) * 2) = pack4(vacc[0], vacc[1], vacc[2], vacc[3]);
        LDS_BARRIER();
        {
            const bf16x8 bV0 = row_frag(L + O_VN, PX, 16 * eb, 0, lane), bV1 = row_frag(L + O_VN, PX, 16 * eb, 32, lane);
            oacc = MFMA16(row_frag(L + 0 * SET + O_QK, PX, 16 * lb, 0, lane), bV0, oacc);
            if (lb >= 2) oacc = MFMA16(row_frag(L + 0 * SET + O_QK, PX, 16 * lb, 32, lane), bV1, oacc);
#pragma unroll
            for (int r = 0; r < 4; ++r) *(LAS float*)(L + O_OT + (16 * lb + 4 * g + r) * PO + (16 * eb + i16) * 4) = oacc[r];
#pragma unroll
            for (int t2 = 0; t2 < 2; ++t2) {
                const int db = 2 * lb + t2;
                f32x4 sa = sacc[t2] * glvA;
                sa = MFMA16(tr_frag(L + 0 * SET + O_KG, PB, 0, 16 * db, lane), bV0, sa);
                sa = MFMA16(tr_frag(L + 0 * SET + O_KG, PB, 32, 16 * db, lane), bV1, sa);
                sacc[t2] = sa;
                *(LAS u32x2*)(L + O_ST + (16 * eb + i16) * PB + (16 * db + 4 * g) * 2) = pack4(sa[0], sa[1], sa[2], sa[3]);
            }
        }
        }
        { const int c = 2 * c2 + 1;
        LDS_BARRIER();
        if (c > 0 && tid < 256) {
            const int r = tid >> 2, c8 = (tid & 3) * 8; float o[8], gt[8]; unpack8(gsA, gt); float ss = 0.f; const f32x4 oa4 = *(LAS const f32x4*)(L + O_OT + r * PO + c8 * 4), ob4 = *(LAS const f32x4*)(L + O_OT + r * PO + c8 * 4 + 16);
#pragma unroll
            for (int i = 0; i < 8; ++i) { const float ov = i < 4 ? oa4[i & 3] : ob4[i & 3]; ss += ov * ov; o[i] = ov * (i < 4 ? g0[i & 3] : g1[i & 3]) * siluf_(gt[i]); }
            *(u32x4*)(F.PROJ() + (size_t)(b * SEQ + (c - 1) * 64 + r) * LDP + C_B + h * 128 + dvq * 32 + c8) = pack8(o);
            ss += dpp_mov<0xB1>(ss); ss += dpp_mov<0x4E>(ss);
            if ((tid & 3) == 0) atomicAdd(SSO + (size_t)(b * SEQ + (c - 1) * 64 + r) * 8 + h, ss);
        }
        if (c + 1 < SEQ / 64) {
            GDN_STAGE(A, 0);
            if (c + 3 < SEQ / 64) GDN_LOADA(c + 3);
        }
        f32x4 vacc, oacc = (f32x4){0.f, 0.f, 0.f, 0.f};
        { const u32x2 uw = *(LAS const u32x2*)(L + 1 * SET + O_UT + (16 * eb + i16) * PX + (16 * lb + 4 * g) * 2);
          vacc = (f32x4){bflo(uw.x), bfhi(uw.x), bflo(uw.y), bfhi(uw.y)}; }
#pragma unroll
        for (int ks = 0; ks < 4; ++ks) {
            const bf16x8 bS = row_frag(L + O_ST, PB, 16 * eb, 32 * ks, lane);
            vacc = MFMA16(tr_frag(L + 1 * SET + O_WT, PX, 32 * ks, 16 * lb, lane), bS, vacc);
            oacc = MFMA16(row_frag(L + 1 * SET + O_QG, PB, 16 * lb, 32 * ks, lane), bS, oacc);
        }
        *(LAS u32x2*)(L + O_VN + (16 * eb + i16) * PX + (16 * lb + 4 * g) * 2) = pack4(vacc[0], vacc[1], vacc[2], vacc[3]);
        LDS_BARRIER();
        {
            const bf16x8 bV0 = row_frag(L + O_VN, PX, 16 * eb, 0, lane), bV1 = row_frag(L + O_VN, PX, 16 * eb, 32, lane);
            oacc = MFMA16(row_frag(L + 1 * SET + O_QK, PX, 16 * lb, 0, lane), bV0, oacc);
            if (lb >= 2) oacc = MFMA16(row_frag(L + 1 * SET + O_QK, PX, 16 * lb, 32, lane), bV1, oacc);
#pragma unroll
            for (int r = 0; r < 4; ++r) *(LAS float*)(L + O_OT + (16 * lb + 4 * g + r) * PO + (16 * eb + i16) * 4) = oacc[r];
#pragma unroll
            for (int t2 = 0; t2 < 2; ++t2) {
                const int db = 2 * lb + t2;
                f32x4 sa = sacc[t2] * glvB;
                sa = MFMA16(tr_frag(L + 1 * SET + O_KG, PB, 0, 16 * db, lane), bV0, sa);
                sa = MFMA16(tr_frag(L + 1 * SET + O_KG, PB, 32, 16 * db, lane), bV1, sa);
                sacc[t2] = sa;
                *(LAS u32x2*)(L + O_ST + (16 * eb + i16) * PB + (16 * db + 4 * g) * 2) = pack4(sa[0], sa[1], sa[2], sa[3]);
            }
        }
        }
    }
    LDS_BARRIER();
    if (tid < 256) {
        const int c = SEQ / 64, r = tid >> 2, c8 = (tid & 3) * 8; float o[8], gt[8]; unpack8(gsB, gt); float ss = 0.f; const f32x4 oa4 = *(LAS const f32x4*)(L + O_OT + r * PO + c8 * 4), ob4 = *(LAS const f32x4*)(L + O_OT + r * PO + c8 * 4 + 16);
#pragma unroll
        for (int i = 0; i < 8; ++i) { const float ov = i < 4 ? oa4[i & 3] : ob4[i & 3]; ss += ov * ov; o[i] = ov * (i < 4 ? g0[i & 3] : g1[i & 3]) * siluf_(gt[i]); }
        *(u32x4*)(F.PROJ() + (size_t)(b * SEQ + (c - 1) * 64 + r) * LDP + C_B + h * 128 + dvq * 32 + c8) = pack8(o);
        ss += dpp_mov<0xB1>(ss); ss += dpp_mov<0x4E>(ss);
        if ((tid & 3) == 0) atomicAdd(SSO + (size_t)(b * SEQ + (c - 1) * 64 + r) * 8 + h, ss);
    }
#undef GDN_LOADA
#undef GDN_LOADB
#undef GDN_STAGE
#pragma unroll
    for (int t2 = 0; t2 < 2; ++t2)
#pragma unroll
        for (int r = 0; r < 4; ++r) F.out[O_GDNP + ((size_t)bh * 128 + 16 * (2 * lb + t2) + 4 * g + r) * 128 + dvq * 32 + 16 * eb + i16] = sacc[t2][r];
}


template <class EpiQ>
__device__ __forceinline__ void small_gemm(Frame& F, const bf16_t* A, int lda, const bf16_t* Bt, int ldb, int K, int N, const EpiQ& q) {
    const int lane = F.lane, w = F.wave, i16 = lane & 15, g = lane >> 4, kp = w & 3, tw = w >> 2;
    LAS float* part = (LAS float*)F.lds;
    const int ntl = 8 * (N / 16), nsteps = K / 128;
    for (int t2 = blockIdx.x; 2 * t2 < ntl; t2 += F.G) {
        const int t = 2 * t2 + tw, rg = t / (N / 16), nb = t % (N / 16);
        const bf16_t* ap = A + (size_t)(16 * rg + i16) * lda + kp * (K / 4) + 8 * g;
        const bf16_t* bp = Bt + (size_t)(16 * nb + i16) * ldb + kp * (K / 4) + 8 * g;
        f32x4 acc = (f32x4){0.f, 0.f, 0.f, 0.f};
        bf16x8 a0[8], b0[8], a1[8], b1[8];
#define SG_LOAD(A_, B_, base) do { _Pragma("unroll") for (int j = 0; j < 8; ++j) if ((base) + j < nsteps) { A_[j] = *(const bf16x8*)(ap + ((base) + j) * 32); B_[j] = *(const bf16x8*)(bp + ((base) + j) * 32); } } while (0)
#define SG_MMA(A_, B_, base) do { _Pragma("unroll") for (int j = 0; j < 8; ++j) if ((base) + j < nsteps) acc = MFMA16(B_[j], A_[j], acc); } while (0)
        SG_LOAD(a0, b0, 0);
        for (int ks = 0; ks < nsteps; ks += 16) {
            SG_LOAD(a1, b1, ks + 8);
            SG_MMA(a0, b0, ks);
            SG_LOAD(a0, b0, ks + 16);
            SG_MMA(a1, b1, ks + 8);
        }
#undef SG_LOAD
#undef SG_MMA
        LDS_BARRIER();
        *(LAS f32x4*)(part + (w * 64 + lane) * 4) = acc;
        LDS_BARRIER();
        if (kp == 0) {
            const f32x4 p1 = *(LAS const f32x4*)(part + ((w + 1) * 64 + lane) * 4), p2 = *(LAS const f32x4*)(part + ((w + 2) * 64 + lane) * 4), p3 = *(LAS const f32x4*)(part + ((w + 3) * 64 + lane) * 4);
            acc = (acc + p1) + (p2 + p3);
            q(MPR + 16 * rg + i16, 16 * nb + 4 * g, acc);
        }
    }
}
struct QT1 { bf16_t* PROJ;
    __device__ __forceinline__ void operator()(int row, int col, f32x4 v) const {
        const u32x2 mw = *(const u32x2*)(PROJ + (size_t)row * LDP + C_MG + col);
        *(u32x2*)(PROJ + (size_t)row * LDP + C_Z + col) = pack4(v[0] * sigmoidf_(bflo(mw.x)), v[1] * sigmoidf_(bfhi(mw.x)), v[2] * sigmoidf_(bflo(mw.y)), v[3] * sigmoidf_(bfhi(mw.y))); } };
struct QMix { bf16_t* PROJ;
    __device__ __forceinline__ void operator()(int row, int col, f32x4 v) const {
        const u32x2 mw = *(const u32x2*)(PROJ + (size_t)row * LDP + C_MG + 1024 + col), tw = *(const u32x2*)(PROJ + (size_t)row * LDP + C_Z + col);
        *(u32x2*)(PROJ + (size_t)row * LDP + C_Q + col) = pack4(bflo(tw.x) + v[0] * sigmoidf_(bflo(mw.x)), bfhi(tw.x) + v[1] * sigmoidf_(bfhi(mw.x)), bflo(tw.y) + v[2] * sigmoidf_(bflo(mw.y)), bfhi(tw.y) + v[3] * sigmoidf_(bfhi(mw.y))); } };
template <int MODE> struct QResid { bf16_t* PROJ; const float* xs; int res_col, dstb_col; float* SS;
    __device__ __forceinline__ void operator()(int row, int col, f32x4 v) const {
        f32x4 r;
        if (MODE == 0) r = *(const f32x4*)(xs + (size_t)(row - MPR) * D + col);
        else { const u32x2 rw = *(const u32x2*)(PROJ + (size_t)row * LDP + res_col + col); r = (f32x4){bflo(rw.x), bfhi(rw.x), bflo(rw.y), bfhi(rw.y)}; }
        const f32x4 x = r + v;
        *(u32x2*)(PROJ + (size_t)row * LDP + dstb_col + col) = pack4(x[0], x[1], x[2], x[3]);
        float ss = (x[0] * x[0] + x[1] * x[1]) + (x[2] * x[2] + x[3] * x[3]);
        ss = xrow16_sum(ss);
        if ((threadIdx.x & 48) == 0) atomicAdd(SS + row, ss); } };
struct QPE { bf16_t* PROJ;
    __device__ __forceinline__ void operator()(int row, int col, f32x4 v) const { *(u32x2*)(PROJ + (size_t)row * LDP + C_Z + col) = pack4(v[0], v[1], v[2], v[3]); } };
__device__ __forceinline__ void small_mix(Frame& F, const bf16_t* WT) {
    const int lane = F.lane, w = F.wave, i16 = lane & 15, g = lane >> 4, kp = w & 3, tw = w >> 2;
    LAS float* part = (LAS float*)F.lds;
    const int t = 2 * (int)blockIdx.x + tw, rg = t / (D / 16), nb = t % (D / 16);
    const bf16_t* arow = F.PROJ() + (size_t)(MPR + 16 * rg + i16) * LDP;
    const bf16_t* brow = WT + (size_t)(16 * nb + i16) * 3072;
    const bf16_t* ap = arow + C_XS + kp * 512 + 8 * g; const bf16_t* bp = brow + kp * 512 + 8 * g;
    const bf16_t* ap2 = arow + C_B + kp * 256 + 8 * g; const bf16_t* bp2 = brow + 2048 + kp * 256 + 8 * g;
    f32x4 acc1 = (f32x4){0.f, 0.f, 0.f, 0.f}, acc2 = acc1;
    bf16x8 a0[8], b0[8], a1[8], b1[8];
#pragma unroll
    for (int j = 0; j < 8; ++j) { a0[j] = *(const bf16x8*)(ap + j * 32); b0[j] = *(const bf16x8*)(bp + j * 32); }
#pragma unroll
    for (int j = 0; j < 8; ++j) { a1[j] = *(const bf16x8*)(ap + (8 + j) * 32); b1[j] = *(const bf16x8*)(bp + (8 + j) * 32); }
#pragma unroll
    for (int j = 0; j < 8; ++j) acc1 = MFMA16(b0[j], a0[j], acc1);
#pragma unroll
    for (int j = 0; j < 8; ++j) { a0[j] = *(const bf16x8*)(ap2 + j * 32); b0[j] = *(const bf16x8*)(bp2 + j * 32); }
#pragma unroll
    for (int j = 0; j < 8; ++j) acc1 = MFMA16(b1[j], a1[j], acc1);
#pragma unroll
    for (int j = 0; j < 8; ++j) acc2 = MFMA16(b0[j], a0[j], acc2);
    LDS_BARRIER();
    *(LAS f32x4*)(part + (w * 64 + lane) * 8) = acc1; *(LAS f32x4*)(part + (w * 64 + lane) * 8 + 4) = acc2;
    LDS_BARRIER();
    if (kp == 0) {
#pragma unroll
        for (int q = 1; q < 4; ++q) { acc1 += *(LAS const f32x4*)(part + ((w + q) * 64 + lane) * 8); acc2 += *(LAS const f32x4*)(part + ((w + q) * 64 + lane) * 8 + 4); }
        const int row = MPR + 16 * rg + i16, col = 16 * nb + 4 * g;
        const u32x2 m1 = *(const u32x2*)(F.PROJ() + (size_t)row * LDP + C_MG + col), m2 = *(const u32x2*)(F.PROJ() + (size_t)row * LDP + C_MG + 1024 + col);
        *(u32x2*)(F.PROJ() + (size_t)row * LDP + C_Q + col) = pack4(acc1[0] * sigmoidf_(bflo(m1.x)) + acc2[0] * sigmoidf_(bflo(m2.x)), acc1[1] * sigmoidf_(bfhi(m1.x)) + acc2[1] * sigmoidf_(bfhi(m2.x)),
                                                                  acc1[2] * sigmoidf_(bflo(m1.y)) + acc2[2] * sigmoidf_(bflo(m2.y)), acc1[3] * sigmoidf_(bfhi(m1.y)) + acc2[3] * sigmoidf_(bfhi(m2.y)));
    }
}

__device__ __forceinline__ void small_x3_final(Frame& F, const bf16_t* A, int lda, const bf16_t* Bt, int ldb, const bf16_t* WPP, const float* SS2, float* SS3, unsigned* cnt, unsigned* bar) {
    const int lane = F.lane, w = F.wave, i16 = lane & 15, g = lane >> 4, kp = w & 3, tw = w >> 2;
    LAS float* part = (LAS float*)F.lds;
    const int t = 2 * (int)blockIdx.x + tw, rg = t / (D / 16), nb = t % (D / 16);
    const bf16_t* ap = A + (size_t)(16 * rg + i16) * lda + kp * (D / 4) + 8 * g;
    const bf16_t* bp = Bt + (size_t)(16 * nb + i16) * ldb + kp * (D / 4) + 8 * g;
    const bf16_t* ap2 = F.PB() + (size_t)(MPR + 16 * rg + i16) * 256 + kp * 64 + 8 * g;
    const bf16_t* bp2 = WPP + (size_t)(16 * nb + i16) * 256 + kp * 64 + 8 * g;
    f32x4 acc = (f32x4){0.f, 0.f, 0.f, 0.f}, acc2 = acc;
    {   bf16x8 av[10], bv[10];
#pragma unroll
        for (int j = 0; j < 8; ++j) { av[j] = *(const bf16x8*)(ap + j * 32); bv[j] = *(const bf16x8*)(bp + j * 32); }
#pragma unroll
        for (int j = 0; j < 2; ++j) { av[8 + j] = *(const bf16x8*)(ap2 + j * 32); bv[8 + j] = *(const bf16x8*)(bp2 + j * 32); }
#pragma unroll
        for (int j = 0; j < 8; ++j) acc = MFMA16(bv[j], av[j], acc);
#pragma unroll
        for (int j = 0; j < 2; ++j) acc2 = MFMA16(bv[8 + j], av[8 + j], acc2);
    }
    LDS_BARRIER();
    *(LAS f32x4*)(part + (w * 64 + lane) * 8) = acc; *(LAS f32x4*)(part + (w * 64 + lane) * 8 + 4) = acc2;
    LDS_BARRIER();
    const int row = MPR + 16 * rg + i16, col = 16 * nb + 4 * g;
    f32x4 x = (f32x4){0.f, 0.f, 0.f, 0.f};
    if (kp == 0) {
#pragma unroll
        for (int q = 1; q < 4; ++q) { acc += *(LAS const f32x4*)(part + ((w + q) * 64 + lane) * 8); acc2 += *(LAS const f32x4*)(part + ((w + q) * 64 + lane) * 8 + 4); }
        const float r = rsqrtf(SS2[row] * (1.0f / D) + EPS);
        const u32x2 aw = *(const u32x2*)(F.PROJ() + (size_t)row * LDP + C_GATE + col);
        const f32x4 a = (f32x4){bflo(aw.x), bfhi(aw.x), bflo(aw.y), bfhi(aw.y)};
#pragma unroll
        for (int i = 0; i < 4; ++i) x[i] = a[i] + acc2[i] * sigmoidf_(r * acc[i]);
        float ss = (x[0] * x[0] + x[1] * x[1]) + (x[2] * x[2] + x[3] * x[3]);
        ss = xrow16_sum(ss);
        if (g == 0) atomicAdd(SS3 + row, ss);
    }
    asm volatile("s_waitcnt vmcnt(0)" ::: "memory");
    __syncthreads();
    if (F.tid == 0) { unsigned* c = cnt + 64 * rg; (void)xb_add(c, 1u); unsigned sp = 0u;
        while (xb_ld(c) < 32u) { __builtin_amdgcn_s_sleep(1); if ((++sp & 255u) == 0u) { if (xb_ld(&bar[XB_TMO])) break; if (sp > XB_SPIN_CAP) { atomicAdd(&bar[XB_TMO], 1u); break; } } } }
    __syncthreads();
    if (kp == 0) {
        const float r3 = rsqrtf(__uint_as_float(xb_ld((unsigned*)(SS3 + row))) * (1.0f / D) + EPS);
        const f32x4 gq = *(const f32x4*)(F.in[29] + col);
        *(f32x4*)(F.out + O_YS + (size_t)(row - MPR) * D + col) = x * r3 * gq;
    }
}

struct GdnSmp2In { f32x4 S[8]; u32x4 k8, q8; u32x2 v4; float araw, braw; };
__device__ __forceinline__ void gdn_smp2_load(const Frame& F, int it, int e4, int dg, GdnSmp2In& r) {
    const int sq = it >> 3, h = it & 7;
    const float* sp = F.in[6] + ((size_t)(sq * 8 + h) * 128 + dg * 8) * 128 + e4 * 4;
#pragma unroll
    for (int j = 0; j < 8; ++j) r.S[j] = *(const f32x4*)(sp + (size_t)j * 128);
    const bf16_t* row = F.PROJ() + (size_t)(MPR + sq) * LDP;
    r.k8 = *(const u32x4*)(row + C_K + h * 128 + dg * 8); r.q8 = *(const u32x4*)(row + C_Q + h * 128 + dg * 8);
    r.v4 = *(const u32x2*)(row + C_V + h * 128 + e4 * 4);
    const float* sm = F.SMALL() + (size_t)(MPR + sq) * 64;
    r.araw = sm[40 + h]; r.braw = sm[32 + h];
}
__device__ __forceinline__ void gdn_sample2_regs(const Frame& F) {
    const int tid = F.tid, e4 = tid & 31, dg = tid >> 5, w = F.wave, lane = F.lane;
    LAS f32x4* pa = (LAS f32x4*)F.lds;
    LAS f32x4* pb = (LAS f32x4*)(F.lds + 4096);
    constexpr int NIT = NSMP * 8;
    int it = blockIdx.x;
    if (it >= NIT) return;
    GdnSmp2In cur, nxt;
    gdn_smp2_load(F, it, e4, dg, cur);
    for (; it < NIT; it += F.G) {
        const bool more = it + F.G < NIT;
        if (more) gdn_smp2_load(F, it + F.G, e4, dg, nxt);
        const int sq = it >> 3, h = it & 7;
        const float eg = __expf(-__expf(F.in[18][h]) * softplusf_(cur.araw + F.in[17][h])), bt = sigmoidf_(cur.braw);
        float k8[8], q8[8]; unpack8(cur.k8, k8); unpack8(cur.q8, q8);
        f32x4 ks = (f32x4){0.f, 0.f, 0.f, 0.f};
#pragma unroll
        for (int j = 0; j < 8; ++j) ks += cur.S[j] * k8[j];
#pragma unroll
        for (int i = 0; i < 4; ++i) ks[i] = xor32_sum(ks[i]);
        __syncthreads();
        if (lane < 32) pa[w * 32 + e4] = ks;
        __syncthreads();
        f32x4 kS = pa[e4];
#pragma unroll
        for (int ww = 1; ww < 8; ++ww) kS += pa[ww * 32 + e4];
        const f32x4 vv = (f32x4){bflo(cur.v4.x), bfhi(cur.v4.x), bflo(cur.v4.y), bfhi(cur.v4.y)};
        const f32x4 vn = (vv - kS * eg) * bt;
        f32x4 op = (f32x4){0.f, 0.f, 0.f, 0.f};
        float* dp = F.out + O_GDNS + ((size_t)(sq * 8 + h) * 128 + dg * 8) * 128 + e4 * 4;
#pragma unroll
        for (int j = 0; j < 8; ++j) { const f32x4 sn = cur.S[j] * eg + vn * k8[j]; op += sn * q8[j]; *(f32x4*)(dp + (size_t)j * 128) = sn; }
#pragma unroll
        for (int i = 0; i < 4; ++i) op[i] = xor32_sum(op[i]);
        if (lane < 32) pb[w * 32 + e4] = op;
        __syncthreads();
        if (dg == 0) {
            f32x4 o = pb[e4];
#pragma unroll
            for (int ww = 1; ww < 8; ++ww) o += pb[ww * 32 + e4];
            float ss = (o[0] * o[0] + o[1] * o[1]) + (o[2] * o[2] + o[3] * o[3]);
            ss = xor16_sum(row16_sum(ss));
            const float rn = rsqrtf(ss * (1.0f / 128.0f) + EPS);
            const u32x2 gw = *(const u32x2*)(F.PROJ() + (size_t)(MPR + sq) * LDP + C_GATE + h * 128 + e4 * 4);
            const f32x4 gn = *(const f32x4*)(F.in[19] + e4 * 4);
            *(u32x2*)(F.PROJ() + (size_t)(MPR + sq) * LDP + C_B + h * 128 + e4 * 4) = pack4(o[0] * rn * gn[0] * siluf_(bflo(gw.x)), o[1] * rn * gn[1] * siluf_(bfhi(gw.x)), o[2] * rn * gn[2] * siluf_(bflo(gw.y)), o[3] * rn * gn[3] * siluf_(bfhi(gw.y)));
        }
        if (more) cur = nxt;
    }
}

__device__ __forceinline__ void gdn_sample2(const Frame& F) {
    constexpr int NIT = NSMP * 8, SLOT = 65536 + 4096;
    constexpr int O_PA = 2 * SLOT, O_PB = O_PA + 2048, O_HP = O_PB + 2048;
    static_assert(O_HP + 256 <= MISC_OFF, "gdn sample ring");
    const int w = F.wave, lane = F.lane;
    LAS unsigned char* L = F.lds;
    const int first = blockIdx.x, n = first < NIT ? (NIT - 1 - first) / F.G + 1 : 0;
    LAS float* hp = (LAS float*)(L + O_HP);
    LDS_BARRIER();
    if (F.tid < 8) { hp[F.tid] = -__expf(F.in[18][F.tid]); hp[8 + F.tid] = F.in[17][F.tid]; }
    LDS_BARRIER();
    if (w < 4) {
#define GSL_ISSUE(k_) do { const int it_ = first + (k_) * F.G, sq_ = it_ >> 3, h_ = it_ & 7; \
            const char* sp_ = (const char*)(F.in[6] + (size_t)it_ * 16384) + (size_t)((w * 16) * 64 + lane) * 16; \
            LAS unsigned char* sl_ = L + ((k_) & 1) * SLOT + w * 16384; \
            _Pragma("unroll") for (int j_ = 0; j_ < 16; ++j_) __builtin_amdgcn_global_load_lds((const unsigned*)(sp_ + j_ * 1024), (LAS unsigned*)(sl_ + j_ * 1024), 16, 0, 0); \
            const bf16_t* row_ = F.PROJ() + (size_t)(MPR + sq_) * LDP + h_ * 128 + (lane & 15) * 8; \
            const char* op_ = w == 0 ? (const char*)(row_ + C_K) : w == 1 ? (const char*)(row_ + C_Q) : w == 2 ? (const char*)(row_ + C_V) \
                            : (lane & 16) ? (const char*)(F.SMALL() + (size_t)(MPR + sq_) * 64 + 32 + (lane & 3) * 4) : (const char*)(row_ + C_GATE); \
            __builtin_amdgcn_global_load_lds((const unsigned*)op_, (LAS unsigned*)(L + ((k_) & 1) * SLOT + 65536 + w * 1024), 16, 0, 0); } while (0)
        if (n > 0) GSL_ISSUE(0);
        if (n > 1) GSL_ISSUE(1);
        for (int k = 0; k < n; ++k) {
            if (k + 1 < n) asm volatile("s_waitcnt vmcnt(17)" ::: "memory"); else asm volatile("s_waitcnt vmcnt(0)" ::: "memory");
            __builtin_amdgcn_s_barrier(); asm volatile("" ::: "memory");
            __builtin_amdgcn_s_barrier(); asm volatile("" ::: "memory");
            if (k + 2 < n) GSL_ISSUE(k + 2);
            __builtin_amdgcn_s_barrier(); asm volatile("" ::: "memory");
        }
#undef GSL_ISSUE
    } else {
        const int cw = w - 4, e4 = lane & 31, dgl = lane >> 5, d0 = (cw * 2 + dgl) * 16;
        LAS f32x4* pa = (LAS f32x4*)(L + O_PA); LAS f32x4* pb = (LAS f32x4*)(L + O_PB);
        for (int k = 0; k < n; ++k) {
            asm volatile("s_waitcnt lgkmcnt(0)" ::: "memory"); __builtin_amdgcn_s_barrier(); asm volatile("" ::: "memory");
            const int it = first + k * F.G, sq = it >> 3, h = it & 7;
            LAS const unsigned char* sl = L + (k & 1) * SLOT;
            f32x4 S[16];
#pragma unroll
            for (int j = 0; j < 16; ++j) S[j] = *(LAS const f32x4*)(sl + (size_t)(d0 + j) * 512 + e4 * 16);
            float k16[16], q16[16];
            { unpack8(*(LAS const u32x4*)(sl + 65536 + d0 * 2), *(float (*)[8])&k16[0]); unpack8(*(LAS const u32x4*)(sl + 65536 + d0 * 2 + 16), *(float (*)[8])&k16[8]);
              unpack8(*(LAS const u32x4*)(sl + 65536 + 1024 + d0 * 2), *(float (*)[8])&q16[0]); unpack8(*(LAS const u32x4*)(sl + 65536 + 1024 + d0 * 2 + 16), *(float (*)[8])&q16[8]); }
            const u32x2 v4 = *(LAS const u32x2*)(sl + 65536 + 2048 + e4 * 8), gw = *(LAS const u32x2*)(sl + 65536 + 3072 + e4 * 8);
            const float braw = *(LAS const float*)(sl + 65536 + 3072 + 256 + h * 4), araw = *(LAS const float*)(sl + 65536 + 3072 + 256 + 32 + h * 4);
            const float eg = __expf(hp[h] * softplusf_(araw + hp[8 + h])), bt = sigmoidf_(braw);
            f32x4 ks = (f32x4){0.f, 0.f, 0.f, 0.f};
#pragma unroll
            for (int j = 0; j < 16; ++j) ks += S[j] * k16[j];
#pragma unroll
            for (int i = 0; i < 4; ++i) ks[i] = xor32_sum(ks[i]);
            if (lane < 32) pa[cw * 32 + e4] = ks;
            asm volatile("s_waitcnt lgkmcnt(0)" ::: "memory"); __builtin_amdgcn_s_barrier(); asm volatile("" ::: "memory");
            const f32x4 kS = (pa[e4] + pa[32 + e4]) + (pa[64 + e4] + pa[96 + e4]);
            const f32x4 vv = (f32x4){bflo(v4.x), bfhi(v4.x), bflo(v4.y), bfhi(v4.y)};
            const f32x4 vn = (vv - kS * eg) * bt;
            f32x4 op = (f32x4){0.f, 0.f, 0.f, 0.f};
            float* dp = F.out + O_GDNS + ((size_t)it * 128 + d0) * 128 + e4 * 4;
#pragma unroll
            for (int j = 0; j < 16; ++j) { const f32x4 sn = S[j] * eg + vn * k16[j]; op += sn * q16[j]; *(f32x4*)(dp + (size_t)j * 128) = sn; }
#pragma unroll
            for (int i = 0; i < 4; ++i) op[i] = xor32_sum(op[i]);
            if (lane < 32) pb[cw * 32 + e4] = op;
            asm volatile("s_waitcnt lgkmcnt(0)" ::: "memory"); __builtin_amdgcn_s_barrier(); asm volatile("" ::: "memory");
            if (cw == 0 && lane < 32) {
                const f32x4 o = (pb[e4] + pb[32 + e4]) + (pb[64 + e4] + pb[96 + e4]);
                float ss = (o[0] * o[0] + o[1] * o[1]) + (o[2] * o[2] + o[3] * o[3]);
                ss = xor16_sum(row16_sum(ss));
                const float rn = rsqrtf(ss * (1.0f / 128.0f) + EPS);
                const f32x4 gn = *(const f32x4*)(F.in[19] + e4 * 4);
                *(u32x2*)(F.PROJ() + (size_t)(MPR + sq) * LDP + C_B + h * 128 + e4 * 4) = pack4(o[0] * rn * gn[0] * siluf_(bflo(gw.x)), o[1] * rn * gn[1] * siluf_(bfhi(gw.x)), o[2] * rn * gn[2] * siluf_(bflo(gw.y)), o[3] * rn * gn[3] * siluf_(bfhi(gw.y)));
            }
        }
    }
}

#ifdef PROBE_A
#define STAMPF(k) do { if (blockIdx.x == 0 && F.tid == 0) ((volatile LAS unsigned*)(F.lds + MISC_OFF))[16 + (k)] = (unsigned)__builtin_amdgcn_s_memrealtime(); } while (0)
#else
#define STAMPF(k) do { } while (0)
#endif
__device__ __forceinline__ void p3_scan(Frame& F) {
    int sit = NSMP * 32;
    if (F.G == 256) {
        const int xcd = blockIdx.x & 7, idx = blockIdx.x >> 3, grp = xcd * 4 + (idx >> 3);
        ssd_chunked(F, (grp >> 2) * 32 + (grp & 3) * 8 + (idx & 7), sit);
    } else
    for (int it = blockIdx.x; it < NBATCH * 32; it += F.G) ssd_chunked(F, it, sit);
    LDS_BARRIER(); STAMPF(15);
    { const int hb = F.tid >> 8;
      for (int pr = blockIdx.x; pr < 1024; pr += F.G) { PrepIn pin; prep_load(F, 2 * pr + hb, pin); gdn_prep3(F, 2 * pr + hb, hb, pin, 0, false); } }
    LDS_BARRIER(); STAMPF(16);
    ssd_sample_stream(F, blockIdx.x);
}
__device__ __forceinline__ void sample_ynorm(Frame& F) {
    const int gw = blockIdx.x * NWAVES + F.wave, NGW = F.G * NWAVES, lane = F.lane;
    for (int u = gw; u < NSMP * 4; u += NGW) {
        bf16_t* row = F.PROJ() + (size_t)(MPR + (u >> 2)) * LDP;
        const int c = (u & 3) * 512 + lane * 8;
        float y[8], z[8]; unpack8(*(const u32x4*)(row + C_XS + c), y); unpack8(*(const u32x4*)(row + C_Z + c), z);
        float ss = 0.f;
#pragma unroll
        for (int i = 0; i < 8; ++i) { y[i] *= siluf_(z[i]); ss += y[i] * y[i]; }
        const float r = rsqrtf(wave_sum(ss) * (1.0f / 512.0f) + EPS);
#pragma unroll
        for (int i = 0; i < 8; ++i) y[i] *= r;
        *(u32x4*)(row + C_XS + c) = pack8(y);
    }
}
__device__ __forceinline__ void p3b_scan(Frame& F) {
    int sit = NSMP * 32;
    sample_ynorm(F);
    if (F.G == 256) {
        const int xcd = blockIdx.x & 7, idx = blockIdx.x >> 3;
        gdn_scan(F, (xcd * 8 + (idx >> 2)) * 4 + (idx & 3), sit);
    } else
    for (int it = blockIdx.x; it < NBATCH * 32; it += F.G) gdn_scan(F, it, sit);
    LDS_BARRIER(); STAMPF(17);
    gdn_sample2(F);
}

__device__ __forceinline__ void p4_norm(Frame& F) {
    const int gw = blockIdx.x * NWAVES + F.wave, NGW = F.G * NWAVES, lane = F.lane;
    const float* gs = F.in[15]; const float* gg = F.in[19];
    for (int m = gw; m < MTOT; m += NGW) {
        bf16_t* row = F.PROJ() + (size_t)m * LDP;
#pragma unroll
        for (int g = 0; g < 4; ++g) {
            const int c = g * 512 + lane * 8;
            float y[8], z[8]; unpack8(*(const u32x4*)(row + C_XS + c), y); unpack8(*(const u32x4*)(row + C_Z + c), z);
            float ss = 0.f;
#pragma unroll
            for (int i = 0; i < 8; ++i) { y[i] *= siluf_(z[i]); ss += y[i] * y[i]; }
            const float r = rsqrtf(wave_sum(ss) * (1.0f / 512.0f) + EPS);
            const f32x4 g0 = *(const f32x4*)(gs + c), g1 = *(const f32x4*)(gs + c + 4);
#pragma unroll
            for (int i = 0; i < 4; ++i) { y[i] *= r * g0[i]; y[4 + i] *= r * g1[i]; }
            *(u32x4*)(row + C_XS + c) = pack8(y);
        }
#pragma unroll
        for (int hh = 0; hh < 2; ++hh) {
            const int c = hh * 512 + lane * 8;
            float o[8], gt[8]; unpack8(*(const u32x4*)(row + C_V + c), o); unpack8(*(const u32x4*)(row + C_GATE + c), gt);
            float ss = 0.f;
#pragma unroll
            for (int i = 0; i < 8; ++i) ss += o[i] * o[i];
            ss += __shfl_xor(ss, 1); ss += __shfl_xor(ss, 2); ss += __shfl_xor(ss, 4); ss += __shfl_xor(ss, 8);
            const float r = rsqrtf(ss * (1.0f / 128.0f) + EPS);
            const int e = (lane & 15) * 8;
            const f32x4 g0 = *(const f32x4*)(gg + e), g1 = *(const f32x4*)(gg + e + 4);
#pragma unroll
            for (int i = 0; i < 4; ++i) { o[i] = o[i] * r * g0[i] * siluf_(gt[i]); o[4 + i] = o[4 + i] * r * g1[i] * siluf_(gt[4 + i]); }
            *(u32x4*)(row + C_V + c) = pack8(o);
        }
    }
}

__device__ __forceinline__ void p12_final(Frame& F) {
    const int gw = blockIdx.x * NWAVES + F.wave, NGW = F.G * NWAVES, lane = F.lane;
    const float* gf = F.in[29];
    for (int m = gw; m < MTOT; m += NGW) {
        float* orow = F.out + (m < MPR ? O_Y + (size_t)m * D : O_YS + (size_t)(m - MPR) * D);
        const bf16_t* xrow = F.PROJ() + (size_t)m * LDP + C_K;
        const u32x4 xa = *(const u32x4*)(xrow + lane * 8), xb = *(const u32x4*)(xrow + 512 + lane * 8);
        const float r = rsqrtf(F.SS3()[m] * (1.0f / D) + EPS);
        float x[8];
        unpack8(xa, x);
        { const int c = lane * 8; const f32x4 g0 = *(const f32x4*)(gf + c), g1 = *(const f32x4*)(gf + c + 4);
          *(f32x4*)(orow + c) = (f32x4){x[0] * r * g0[0], x[1] * r * g0[1], x[2] * r * g0[2], x[3] * r * g0[3]}; *(f32x4*)(orow + c + 4) = (f32x4){x[4] * r * g1[0], x[5] * r * g1[1], x[6] * r * g1[2], x[7] * r * g1[3]}; }
        unpack8(xb, x);
        { const int c = 512 + lane * 8; const f32x4 g0 = *(const f32x4*)(gf + c), g1 = *(const f32x4*)(gf + c + 4);
          *(f32x4*)(orow + c) = (f32x4){x[0] * r * g0[0], x[1] * r * g0[1], x[2] * r * g0[2], x[3] * r * g0[3]}; *(f32x4*)(orow + c + 4) = (f32x4){x[4] * r * g1[0], x[5] * r * g1[1], x[6] * r * g1[2], x[7] * r * g1[3]}; }
    }
}

__global__ void __launch_bounds__(NWAVES * 64, 2) mega_fwd(Args args) {
    extern __shared__ __attribute__((aligned(16))) unsigned char lds_raw[];
    Frame F;
    F.lds = (LAS unsigned char*)lds_raw;
    F.tid = threadIdx.x; F.lane = F.tid & 63; F.wave = __builtin_amdgcn_readfirstlane(F.tid >> 6); F.G = gridDim.x;
    F.in = args.in;
    F.out = args.out; F.ws = args.ws;
    unsigned char* ws = args.ws;
    const int lo = args.ph_lo, hi = args.ph_hi;
#if MK_ONE_LAUNCH
    volatile LAS unsigned* MISC = (volatile LAS unsigned*)(F.lds + MISC_OFF);
    if (F.tid < 32) MISC[F.tid] = 0u;
    __syncthreads();
    XcdBarrier bar = xcd_barrier_post((unsigned*)(ws + WS_BAR), MISC + 8);
#ifdef PROBE_A
#define STAMP(k) do { if (blockIdx.x == 0 && F.tid == 0) MISC[16 + (k)] = (unsigned)__builtin_amdgcn_s_memrealtime(); } while (0)
#else
#define STAMP(k) do { } while (0)
#endif
#define SEAM(k) do { if (lo <= (k) && (k) + 1 < hi) xcd_barrier(bar); STAMP((k) + 1); } while (0)
#else
#define SEAM(k) do { } while (0)
#endif
#ifndef PHASE_MASK
#define PHASE_MASK 0xffff
#endif
#define IN(k) (((PHASE_MASK >> (k)) & 1) && lo <= (k) && (k) < hi)
#ifndef REP_PHASE
#define REP_PHASE -1
#endif
#define NREP(k) ((REP_PHASE == (k)) ? 2 : 1)
    const int bid = (int)blockIdx.x;
    typedef pg8::StaticOrder SO;
    STAMP(0);

    if (IN(0)) { p0_prologue(F, 0, bid * NWAVES + F.wave, F.G * NWAVES); SEAM(0); }
    if (IN(1)) {
        pg8::Gemm g{F.XN(), (const bf16_t*)(ws + WS_WIN), MP, NPROJ, D, D, D}; SO S; S.init(MP, NPROJ, F.G, bid);
        EpiInProj E{F.PROJ(), F.HALO(), F.SMALL(), F.in[10], F.in[11], F.in[16], 0, (LAS float*)(F.lds + RT_OFF)};
        pg8::gemm_phase<EpiInProj, SO>(F.lds, g, S, E);
        {
            const int rem = S.nwg % F.G, nidle = rem ? F.G - rem : F.G, me = rem ? bid - rem : bid;
            if (me >= 0) p0_prologue(F, 1, me * NWAVES + F.wave, nidle * NWAVES);
        }
        SEAM(1);
    }
    if (IN(2)) { p2_conv(F); SEAM(2); }
    if (IN(3)) { p3_scan(F); SEAM(3); }
    if (IN(4)) { p3b_scan(F); SEAM(4); }
    if (IN(6)) {
        pg8::Gemm g{F.PROJ() + C_XS, (const bf16_t*)(ws + WS_WBS), MPR, D, 3072, LDP, 3072}; SO S; S.init(MPR, D, F.G, bid);
        LAS float* rt = (LAS float*)(F.lds + RT_OFF);
        { Unit u0; if (S.next(0, u0) && F.tid < 256) {
              const float* sy = (const float*)(ws + WS_SSY) + (size_t)(u0.pm * 256 + F.tid) * 4; const float* so = (const float*)(ws + WS_SSO) + (size_t)(u0.pm * 256 + F.tid) * 8;
              float ry[4], ro[8];
#pragma unroll
              for (int q = 0; q < 4; ++q) ry[q] = rsqrtf(sy[q] * (1.0f / 512.0f) + EPS);
#pragma unroll
              for (int q = 0; q < 8; ++q) ro[q] = rsqrtf(so[q] * (1.0f / 128.0f) + EPS);
              rt[F.tid] = ry[0] / ry[1]; rt[256 + F.tid] = ry[1] / ry[2]; rt[512 + F.tid] = ry[2] / ry[3]; rt[768 + F.tid] = ry[3] / ro[0];
#pragma unroll
              for (int q = 0; q < 7; ++q) rt[(4 + q) * 256 + F.tid] = ro[q] / ro[q + 1];
              rt[15 * 256 + F.tid] = ro[7]; }
          __syncthreads(); }
        EpiMixCat E{F.PROJ(), rt + 15 * 256};
        pg8::gemm_phase<EpiMixCat, SO>(F.lds, g, S, E);
        small_mix(F, (const bf16_t*)(ws + WS_WBS)); SEAM(7);
    }
    if (IN(8)) {
        pg8::Gemm g{F.PROJ() + C_Q, (const bf16_t*)(ws + WS_WOUT), MPR, D, D, LDP, D}; SO S; S.init(MPR, D, F.G, bid);
        EpiResid<0> E{F.PROJ(), F.in[0], F.in[1], 0, C_K, F.SS1()};
        pg8::gemm_phase<EpiResid<0>, SO>(F.lds, g, S, E);
        small_gemm(F, F.PROJ() + (size_t)MPR * LDP + C_Q, LDP, (const bf16_t*)(ws + WS_WOUT), D, D, D, QResid<0>{F.PROJ(), F.in[1], 0, C_K, F.SS1()}); SEAM(8);
    }
    if (IN(9)) {
        pg8::Gemm g{F.PROJ() + C_K, (const bf16_t*)(ws + WS_WFI), MP, 2 * DFF, D, LDP, D}; SO S; S.init(MP, 2 * DFF, F.G, bid);
        EpiSwiGLU E{F.PROJ(), F.SS1(), 0, (LAS float*)(F.lds + RT_OFF)};
        for (int rp = 0; rp < NREP(9); ++rp) { pg8::gemm_phase<EpiSwiGLU, SO>(F.lds, g, S, E); if (rp + 1 < NREP(9)) xcd_barrier(bar); } SEAM(9);
    }
    if (IN(10)) {
        pg8::Gemm g{F.PROJ() + C_XS, (const bf16_t*)(ws + WS_WFO), MPR, D, DFF, LDP, DFF}; SO S; S.init(MPR, D, F.G, bid);
        EpiResid<1> E{F.PROJ(), nullptr, nullptr, C_K, C_GATE, F.SS2()};
        pg8::gemm_phase<EpiResid<1>, SO>(F.lds, g, S, E);
        small_gemm(F, F.PROJ() + (size_t)MPR * LDP + C_XS, LDP, (const bf16_t*)(ws + WS_WFO), DFF, DFF, D, QResid<1>{F.PROJ(), nullptr, C_K, C_GATE, F.SS2()}); SEAM(10);
    }
    if (IN(11)) {
        pg8::Gemm g{F.PB(), (const bf16_t*)(ws + WS_WPP), MPR, D, 256, 256, 256}; SO S; S.init(MPR, D, F.G, bid);
        EpiPE E{F.PROJ()};
        pg8::gemm_phase<EpiPE, SO>(F.lds, g, S, E);
        STAMP(12);
    }
    if (IN(12)) {
        pg8::Gemm g{F.PROJ() + C_GATE, (const bf16_t*)(ws + WS_WPG), MPR, D, D, LDP, D}; SO S; S.init(MPR, D, F.G, bid);
        EpiX3 E{F.PROJ(), F.SS2(), F.SS3(), F.out, (unsigned*)(ws + WS_XCNT), (unsigned*)(ws + WS_BAR), F.in[29], (LAS float*)(F.lds + RT_OFF)};
        pg8::gemm_phase<EpiX3, SO>(F.lds, g, S, E);
        small_x3_final(F, F.PROJ() + (size_t)MPR * LDP + C_GATE, LDP, (const bf16_t*)(ws + WS_WPG), D, (const bf16_t*)(ws + WS_WPP), F.SS2(), F.SS3(), (unsigned*)(ws + WS_XCNT2), (unsigned*)(ws + WS_BAR));
    }
#ifdef PROBE_A
    STAMP(14);
    __syncthreads();
    if (blockIdx.x == 0) {
        const float tb = (float)(MISC[16 + PROBE_B] - MISC[16 + PROBE_A]) * 0.01f;
        const float sc = 1.0f + sqrtf(tb * PROBE_SCALE);
        for (int i = F.tid; i < 73728; i += NWAVES * 64) F.out[O_GCONVP + i] *= sc;
    }
#endif
#undef IN
#undef SEAM
}

constexpr int NPHASES = 14;

extern "C" void kernel_launch(void* const* d_in, const int* in_sizes, int n_in, void* d_out, int out_size, void* d_ws, size_t ws_size, hipStream_t stream) {
    static int grid = 0;
    if (grid == 0) {
        if (n_in != 30 || ws_size < WS_END) { fprintf(stderr, "kernel_launch: bad call: n_in %d ws %zu (need %zu)\n", n_in, ws_size, (size_t)WS_END); grid = -1; return; }
        int dev = 0, cus = 0, per_cu = 0;
        if (hipGetDevice(&dev) != hipSuccess || hipDeviceGetAttribute(&cus, hipDeviceAttributeMultiprocessorCount, dev) != hipSuccess) { grid = -1; return; }
        if (hipFuncSetAttribute((const void*)mega_fwd, hipFuncAttributeMaxDynamicSharedMemorySize, LDS_BYTES) != hipSuccess) { fprintf(stderr, "kernel_launch: hipFuncSetAttribute failed\n"); grid = -1; return; }
        if (hipOccupancyMaxActiveBlocksPerMultiprocessor(&per_cu, (const void*)mega_fwd, NWAVES * 64, LDS_BYTES) != hipSuccess || per_cu < 1) { fprintf(stderr, "kernel_launch: occupancy query says %d\n", per_cu); per_cu = 1; }
        (void)hipGetLastError();
        if (cus < 256) { fprintf(stderr, "kernel_launch: this kernel needs 256 CUs (one workgroup per CU, one 256x256 unit per workgroup in the N = 1024 GEMM phases); device has %d\n", cus); grid = -1; return; }
        grid = 256;
    }
    if (grid < 0) return;
    (void)hipMemsetAsync((char*)d_ws + WS_SSY, 0, SS2_BYTES + CTL_BYTES, stream);
    Args a{};
    for (int i = 0; i < 30; ++i) a.in[i] = (const float*)d_in[i];
    a.out = (float*)d_out; a.ws = (unsigned char*)d_ws;
#if MK_ONE_LAUNCH
    a.ph_lo = 0; a.ph_hi = NPHASES;
    void* kargs[] = {&a};
    hipError_t e = hipLaunchCooperativeKernel((const void*)mega_fwd, dim3(grid), dim3(NWAVES * 64), kargs, LDS_BYTES, stream);
    if (e != hipSuccess) fprintf(stderr, "cooperative launch failed: %s (grid %d)\n", hipGetErrorString(e), grid);
#else
    for (int ph = 0; ph < NPHASES; ++ph) {
        a.ph_lo = ph; a.ph_hi = ph + 1;
        hipLaunchKernelGGL(mega_fwd, dim3(grid), dim3(NWAVES * 64), LDS_BYTES, stream, a);
    }
#endif
}
```
